# Optimizing an MI355X kernel written in HIP

```python
import math
import jax
import jax.numpy as jnp
from jax import lax
import numpy as np

D_MODEL = 1024
BATCH = 2
SEQ = 16384
DEPTH = 4

HEAD_DIM = 64
N_HEADS = D_MODEL // HEAD_DIM
ATTN_WIDTH = N_HEADS * HEAD_DIM
ATTN_SCALE = HEAD_DIM ** -0.5
N_MIXERS = 4
Q_BLOCK = 128
ROW_CHUNK = 128
REL_BUCKETS = 32
REL_MAX_DIST = 2048
DILATED_PAIRS = ((128, 1), (512, 4), (2048, 16))
SB_CLIP = 60.0
NSA_KV_HEADS = 4
NSA_GROUP = N_HEADS // NSA_KV_HEADS
NSA_KV_WIDTH = NSA_KV_HEADS * HEAD_DIM
NSA_CMP_LEN = 32
NSA_CMP_STRIDE = 16
NSA_CMP_HIDDEN = 256
NSA_SEL_BLOCK = 64
NSA_TOP_N = 16
NSA_WINDOW = 512
MOBA_BLOCK = 256
MOBA_TOP_K = 3
N_EXPERTS = 16
N_GROUPS = 4
EXPERTS_PER_GROUP = N_EXPERTS // N_GROUPS
MOE_TOP_K = 2
D_EXPERT = 256
MOE_BLOCK = 256
DEEPNORM_ALPHA = (2 * DEPTH) ** 0.25
DEEPNORM_BETA = (8 * DEPTH) ** -0.25
LN_EPS = 1e-5
NEG_INF = -1e30
FORCED_SCORE = 1e9

kernel_name = 'hybrid_sparse_attn_grouped_moe_trunk'


def layer_norm(x, g, b):
    xf = x.astype(jnp.float32)
    mu = xf.mean(-1, keepdims=True)
    var = jnp.square(xf - mu).mean(-1, keepdims=True)
    return ((xf - mu) * lax.rsqrt(var + LN_EPS) * g + b).astype(x.dtype)


def rel_bucket(dist):
    n = jnp.maximum(dist, 0)
    exact = REL_BUCKETS // 2
    logf = jnp.log(jnp.maximum(n, 1).astype(jnp.float32) / exact) / math.log(REL_MAX_DIST / exact)
    large = jnp.minimum(exact + (logf * (REL_BUCKETS - exact)).astype(jnp.int32), REL_BUCKETS - 1)
    return jnp.where(n < exact, n, large)


def rel_bias(table, dist):
    return jnp.moveaxis(table[rel_bucket(dist)], -1, 0).astype(jnp.float32)


def masked_softmax(logits, mask):
    logits = jnp.where(mask, logits.astype(jnp.float32), NEG_INF)
    m = logits.max(-1, keepdims=True)
    p = jnp.where(mask, jnp.exp(logits - m), 0.0)
    denom = jnp.maximum(p.sum(-1, keepdims=True), 1e-30)
    return p / denom, m + jnp.log(denom)


def merge_parts(o, lse):
    w = jax.nn.softmax(lse.astype(jnp.float32), axis=1)
    return jnp.einsum('npr,nprd->nrd', w, o.astype(jnp.float32))


def split_heads(t, h):
    b, s, _ = t.shape
    return t.reshape(b, s, h, HEAD_DIM).transpose(0, 2, 1, 3)


def merge_heads(t):
    b, h, s, d = t.shape
    return t.transpose(0, 2, 1, 3).reshape(b, s, h * d)


def dispatch_attention(q_src, pos_src, gid, k_groups, v_groups, kstart, bias_tbl, tbl_idx):
    n_src, n_slots = gid.shape
    n_groups, blk, _ = k_groups.shape
    R = q_src.shape[1]
    N = n_src * n_slots
    flat_g = gid.reshape(N)
    order = jnp.argsort(flat_g).astype(jnp.int32)
    sorted_g = flat_g[order]
    valid = sorted_g < n_groups
    sg = jnp.minimum(sorted_g, n_groups - 1)
    counts = jnp.zeros((n_groups + 1,), jnp.int32).at[flat_g].add(1)[:n_groups]
    padded = (counts + ROW_CHUNK - 1) // ROW_CHUNK * ROW_CHUNK
    pad_end = jnp.cumsum(padded)
    pad_start = pad_end - padded
    start = jnp.cumsum(counts) - counts
    n_chunks = -(-N // ROW_CHUNK) + n_groups
    P = n_chunks * ROW_CHUNK
    dest = jnp.where(valid, pad_start[sg] + jnp.arange(N) - start[sg], P)
    buf = jnp.full((P,), N, jnp.int32).at[dest].set(order, mode='drop')
    chunk_group = jnp.minimum(jnp.searchsorted(pad_end, jnp.arange(n_chunks) * ROW_CHUNK, side='right'),
                              n_groups - 1).astype(jnp.int32)
    q_pad = jnp.concatenate([q_src, jnp.zeros((1, R, HEAD_DIM), q_src.dtype)], axis=0)
    pos_pad = jnp.concatenate([pos_src, jnp.full((1,), -1, pos_src.dtype)], axis=0)
    off = jnp.arange(blk)

    def chunk(args):
        rows, g = args
        src = rows // n_slots
        qi = q_pad[src]
        dist = pos_pad[src][:, None] - (kstart[g] + off)[None, :]
        bias = bias_tbl[tbl_idx[g]][:, rel_bucket(dist)].astype(jnp.float32)
        logits = jnp.einsum('crd,kd->rck', qi, k_groups[g]).astype(jnp.float32) * ATTN_SCALE + bias
        p, lse = masked_softmax(logits, (dist >= 0)[None])
        o = jnp.einsum('rck,kd->crd', p, v_groups[g].astype(jnp.float32))
        return o, lse[..., 0].T

    o, lse = lax.map(chunk, (buf.reshape(n_chunks, ROW_CHUNK), chunk_group))
    o_all = jnp.zeros((N + 1, R, HEAD_DIM), jnp.float32).at[buf].set(o.reshape(P, R, HEAD_DIM))[:N]
    lse_all = jnp.full((N + 1, R), NEG_INF, jnp.float32).at[buf].set(lse.reshape(P, R))[:N]
    return o_all.reshape(n_src, n_slots, R, HEAD_DIM), lse_all.reshape(n_src, n_slots, R)


def dilated_group(q, k, v, table, window, dilation):
    Bsz, H, S_, _ = q.shape
    L = S_ // dilation
    nb = -(-L // Q_BLOCK)
    Lp = nb * Q_BLOCK
    span = window // dilation
    n_prev = -(-span // Q_BLOCK)

    def streams(t):
        t = t.reshape(Bsz, H, L, dilation, HEAD_DIM).transpose(0, 1, 3, 2, 4)
        t = jnp.pad(t, ((0, 0), (0, 0), (0, 0), (0, Lp - L), (0, 0)))
        return t.reshape(Bsz, H, dilation, nb, Q_BLOCK, HEAD_DIM)

    def band(t):
        tp = jnp.pad(t, ((0, 0), (0, 0), (0, 0), (n_prev, 0), (0, 0), (0, 0)))
        return jnp.concatenate([tp[:, :, :, o:o + nb] for o in range(n_prev + 1)], axis=4)

    qs = streams(q)
    kb, vb = band(streams(k)), band(streams(v))
    a = jnp.arange(Q_BLOCK)
    c = jnp.arange((n_prev + 1) * Q_BLOCK)
    steps = n_prev * Q_BLOCK + a[:, None] - c[None, :]
    key_idx = jnp.arange(nb)[:, None] * Q_BLOCK - n_prev * Q_BLOCK + c[None, :]
    mask = ((steps >= 0) & (steps <= span))[None] & (key_idx >= 0)[:, None, :]
    bias = rel_bias(table, steps * dilation)
    logits = jnp.einsum('bhrnqd,bhrnkd->bhrnqk', qs, kb).astype(jnp.float32) * ATTN_SCALE + bias[:, None, None]
    p, lse = masked_softmax(logits, mask)
    o = jnp.einsum('bhrnqk,bhrnkd->bhrnqd', p.astype(v.dtype), vb)
    o = o.reshape(Bsz, H, dilation, Lp, HEAD_DIM)[:, :, :, :L].transpose(0, 1, 3, 2, 4).reshape(Bsz, H, S_, HEAD_DIM)
    lse = lse[..., 0].reshape(Bsz, H, dilation, Lp)[..., :L].transpose(0, 1, 3, 2).reshape(Bsz, H, S_)
    return o, lse


def mixer_dilated(x, w_in, w_out, table):
    proj = x @ w_in
    gw = 3 * ATTN_WIDTH
    outs, lses = [], []
    for g, (window, dilation) in enumerate(DILATED_PAIRS):
        q, k, v = [split_heads(t, N_HEADS) for t in jnp.split(proj[..., g * gw:(g + 1) * gw], 3, axis=-1)]
        o, lse = dilated_group(q, k, v, table, window, dilation)
        outs.append(o)
        lses.append(lse)
    wts = jax.nn.softmax(jnp.stack(lses), axis=0)
    o = jnp.einsum('gbhs,gbhsd->bhsd', wts, jnp.stack(outs).astype(jnp.float32))
    return merge_heads(o.astype(x.dtype)) @ w_out


def mixer_stick_breaking(x, w_in, w_out):
    q, k, v = [split_heads(t, N_HEADS) for t in jnp.split(x @ w_in, 3, axis=-1)]
    Bsz, H, S_, _ = q.shape
    nb = S_ // Q_BLOCK
    nbp = nb + nb % 2
    pad = ((0, 0), (0, 0), (0, (nbp - nb) * Q_BLOCK), (0, 0))

    def blocks(t):
        return jnp.pad(t, pad).reshape(Bsz, H, nbp, Q_BLOCK, HEAD_DIM)

    qb, kb, vb = blocks(q * ATTN_SCALE), blocks(k), blocks(v)
    a = jnp.arange(Q_BLOCK)
    strict = a[None, :] < a[:, None]
    suffix = (a[:, None] >= a[None, :]).astype(jnp.float32)

    z = jnp.clip(jnp.einsum('bhnqd,bhnkd->bhnqk', qb, kb).astype(jnp.float32), -SB_CLIP, SB_CLIP)
    sp = jnp.where(strict, jnp.log1p(jnp.exp(z)), 0.0)
    r_in = jnp.einsum('bhnqj,js->bhnqs', sp, suffix)
    att = jnp.where(strict, jnp.exp(z - r_in), 0.0)
    acc_d = jnp.einsum('bhnqs,bhnsd->bhnqd', att, vb.astype(jnp.float32))
    r_d = r_in[..., 0]

    def pair(p):
        qb2 = nbp - 1 - p
        init_r2 = lax.dynamic_index_in_dim(r_d, qb2, axis=2, keepdims=False)
        init_a2 = lax.dynamic_index_in_dim(acc_d, qb2, axis=2, keepdims=False)

        def step(carry, kstep):
            r_sum, acc, acc_first = carry
            start2 = kstep == p
            acc_first = jnp.where(start2, acc, acc_first)
            r_sum = jnp.where(start2, init_r2, r_sum)
            acc = jnp.where(start2, init_a2, acc)
            first = kstep < p
            qi = jnp.where(first, p, qb2)
            kj = jnp.where(first, p - 1 - kstep, nbp - 2 - kstep)
            qblk = lax.dynamic_index_in_dim(qb, qi, axis=2, keepdims=False)
            kblk = lax.dynamic_index_in_dim(kb, kj, axis=2, keepdims=False)
            vblk = lax.dynamic_index_in_dim(vb, kj, axis=2, keepdims=False)
            zz = jnp.clip(jnp.einsum('bhqd,bhkd->bhqk', qblk, kblk).astype(jnp.float32), -SB_CLIP, SB_CLIP)
            rr = jnp.einsum('bhqj,js->bhqs', jnp.log1p(jnp.exp(zz)), suffix)
            pv = jnp.einsum('bhqs,bhsd->bhqd', jnp.exp(zz - rr), vblk.astype(jnp.float32))
            acc = acc + jnp.exp(-r_sum)[..., None] * pv
            r_sum = r_sum + rr[..., 0]
            return (r_sum, acc, acc_first), None

        init = (lax.dynamic_index_in_dim(r_d, p, axis=2, keepdims=False),
                lax.dynamic_index_in_dim(acc_d, p, axis=2, keepdims=False),
                jnp.zeros((Bsz, H, Q_BLOCK, HEAD_DIM), jnp.float32))
        (_, acc_b, acc_a), _ = lax.scan(step, init, jnp.arange(nbp - 1))
        return acc_a, acc_b

    out_a, out_b = lax.map(pair, jnp.arange(nbp // 2))
    o = jnp.concatenate([out_a, out_b[::-1]], axis=0)
    o = o.transpose(1, 2, 0, 3, 4).reshape(Bsz, H, nbp * Q_BLOCK, HEAD_DIM)[:, :, :S_]
    return merge_heads(o.astype(x.dtype)) @ w_out


def compress_blocks(t, pos, w1, w2):
    Bsz, G, S_, _ = t.shape
    halves = t.reshape(Bsz, G, S_ // NSA_CMP_STRIDE, NSA_CMP_STRIDE, HEAD_DIM)
    blocks = jnp.concatenate([halves[:, :, :-1], halves[:, :, 1:]], axis=3) + pos
    n_cmp = blocks.shape[2]
    flat = blocks.reshape(Bsz, G, n_cmp, NSA_CMP_LEN * HEAD_DIM)
    return jax.nn.gelu(flat @ w1) @ w2


def mixer_nsa(x, w_in, w_out, table, pos_k, w1_k, w2_k, pos_v, w1_v, w2_v):
    Bsz, S_, _ = x.shape
    G, R = NSA_KV_HEADS, NSA_GROUP
    proj = x @ w_in
    q = proj[..., :ATTN_WIDTH].reshape(Bsz, S_, G, R, HEAD_DIM).transpose(0, 2, 3, 1, 4)
    kv = jnp.split(proj[..., ATTN_WIDTH:ATTN_WIDTH + 6 * NSA_KV_WIDTH], 6, axis=-1)
    k_cmp, v_cmp, k_sel, v_sel, k_win, v_win = [split_heads(t, G) for t in kv]
    gates = jax.nn.sigmoid(proj[..., ATTN_WIDTH + 6 * NSA_KV_WIDTH:].astype(jnp.float32))
    gates = gates.reshape(Bsz, S_, 3, G, R).transpose(2, 0, 3, 4, 1)

    kc = compress_blocks(k_cmp, pos_k, w1_k, w2_k)
    vc = compress_blocks(v_cmp, pos_v, w1_v, w2_v)
    n_cmp = kc.shape[2]
    cmp_end = jnp.arange(n_cmp) * NSA_CMP_STRIDE + NSA_CMP_LEN - 1
    n_sel_blocks = S_ // NSA_SEL_BLOCK
    n_top = min(NSA_TOP_N, n_sel_blocks)
    offs = np.arange(1 - NSA_CMP_LEN // NSA_CMP_STRIDE, NSA_SEL_BLOCK // NSA_CMP_STRIDE)
    ov = np.arange(n_sel_blocks)[:, None] * (NSA_SEL_BLOCK // NSA_CMP_STRIDE) + offs[None]
    ov_valid = jnp.asarray((ov >= 0) & (ov < n_cmp))
    ov_idx = jnp.asarray(np.clip(ov, 0, n_cmp - 1))
    kwin = jnp.pad(k_win, ((0, 0), (0, 0), (NSA_WINDOW, 0), (0, 0)))
    vwin = jnp.pad(v_win, ((0, 0), (0, 0), (NSA_WINDOW, 0), (0, 0)))
    table_gr = table.T.reshape(G, R, REL_BUCKETS)
    nb = S_ // Q_BLOCK
    win_len = NSA_WINDOW + Q_BLOCK
    a = jnp.arange(Q_BLOCK)
    win_steps = NSA_WINDOW + a[:, None] - jnp.arange(win_len)[None, :]
    win_bias = rel_bias(table, win_steps).reshape(G, R, Q_BLOCK, win_len)
    sel_j = jnp.arange(n_sel_blocks)
    qb = q.reshape(Bsz, G, R, nb, Q_BLOCK, HEAD_DIM).transpose(3, 0, 1, 2, 4, 5)

    def block(args):
        qi, i = args
        qpos = i * Q_BLOCK + a
        cdist = qpos[:, None] - cmp_end[None, :]
        lc = jnp.einsum('bgrqd,bgcd->bgrqc', qi, kc).astype(jnp.float32) * ATTN_SCALE
        lc = lc + rel_bias(table, cdist).reshape(G, R, Q_BLOCK, n_cmp)
        pc, _ = masked_softmax(lc, cdist >= 0)
        o_cmp = jnp.einsum('bgrqc,bgcd->bgrqd', pc, vc.astype(jnp.float32))
        imp = (pc.sum(2)[..., ov_idx] * ov_valid).sum(-1)
        cur = qpos // NSA_SEL_BLOCK
        forced = (sel_j[None] == 0) | (sel_j[None] == cur[:, None]) | (sel_j[None] == cur[:, None] - 1)
        causal = sel_j[None] * NSA_SEL_BLOCK <= qpos[:, None]
        score = jnp.where(forced, FORCED_SCORE, jnp.where(causal, imp, NEG_INF))
        sel = lax.top_k(score, n_top)[1]
        kw = lax.dynamic_slice_in_dim(kwin, i * Q_BLOCK, win_len, axis=2)
        vw = lax.dynamic_slice_in_dim(vwin, i * Q_BLOCK, win_len, axis=2)
        wmask = (win_steps < NSA_WINDOW) & (win_steps >= 0) & (qpos[:, None] - win_steps >= 0)
        lw = jnp.einsum('bgrqd,bgkd->bgrqk', qi, kw).astype(jnp.float32) * ATTN_SCALE + win_bias
        pw, _ = masked_softmax(lw, wmask)
        o_win = jnp.einsum('bgrqk,bgkd->bgrqd', pw, vw.astype(jnp.float32))
        return o_cmp, o_win, sel

    o_cmp, o_win, sel = lax.map(block, (qb, jnp.arange(nb)))

    def unblock(t):
        return t.transpose(1, 2, 3, 0, 4, 5).reshape(Bsz, G, R, S_, HEAD_DIM)

    o_cmp, o_win = unblock(o_cmp), unblock(o_win)
    sel = sel.transpose(1, 2, 0, 3, 4).reshape(Bsz, G, S_, n_top)
    qpos_all = jnp.arange(S_)
    valid = sel * NSA_SEL_BLOCK <= qpos_all[:, None]
    n_groups = Bsz * G * n_sel_blocks
    bg = jnp.arange(Bsz * G).reshape(Bsz, G, 1, 1)
    gid = jnp.where(valid, bg * n_sel_blocks + sel, n_groups).reshape(Bsz * G * S_, n_top)
    q_src = q.transpose(0, 1, 3, 2, 4).reshape(Bsz * G * S_, R, HEAD_DIM)
    o_s, lse_s = dispatch_attention(
        q_src, jnp.tile(qpos_all, Bsz * G), gid,
        k_sel.reshape(n_groups, NSA_SEL_BLOCK, HEAD_DIM), v_sel.reshape(n_groups, NSA_SEL_BLOCK, HEAD_DIM),
        jnp.tile(jnp.arange(n_sel_blocks) * NSA_SEL_BLOCK, Bsz * G), table_gr,
        (jnp.arange(n_groups) // n_sel_blocks) % G)
    o_sel = merge_parts(o_s, lse_s).reshape(Bsz, G, S_, R, HEAD_DIM).transpose(0, 1, 3, 2, 4)
    out = gates[0][..., None] * o_cmp + gates[1][..., None] * o_sel + gates[2][..., None] * o_win
    return out.transpose(0, 3, 1, 2, 4).reshape(Bsz, S_, ATTN_WIDTH).astype(x.dtype) @ w_out


def mixer_moba(x, w_in, w_out, table):
    Bsz, S_, _ = x.shape
    H = N_HEADS
    q, k, v = [split_heads(t, H) for t in jnp.split(x @ w_in, 3, axis=-1)]
    nblk = -(-S_ // MOBA_BLOCK)
    Sp = nblk * MOBA_BLOCK
    pad = ((0, 0), (0, 0), (0, Sp - S_), (0, 0))
    qblk = jnp.pad(q, pad).reshape(Bsz, H, nblk, MOBA_BLOCK, HEAD_DIM)
    kblk = jnp.pad(k, pad).reshape(Bsz, H, nblk, MOBA_BLOCK, HEAD_DIM)
    vblk = jnp.pad(v, pad).reshape(Bsz, H, nblk, MOBA_BLOCK, HEAD_DIM)
    c = jnp.arange(MOBA_BLOCK)
    own_dist = c[:, None] - c[None, :]
    lo = jnp.einsum('bhnqd,bhnkd->bhnqk', qblk, kblk).astype(jnp.float32) * ATTN_SCALE + rel_bias(table, own_dist)[:, None]
    p_own, lse_own = masked_softmax(lo, own_dist >= 0)
    o_own = jnp.einsum('bhnqk,bhnkd->bhnqd', p_own, vblk.astype(jnp.float32)).reshape(Bsz, H, Sp, HEAD_DIM)[:, :, :S_]
    lse_own = lse_own[..., 0].reshape(Bsz, H, Sp)[:, :, :S_]
    kmean = kblk.mean(axis=3)
    n_top = max(1, min(MOBA_TOP_K, nblk - 1))
    cur = jnp.arange(S_) // MOBA_BLOCK
    gate = jnp.einsum('bhsd,bhnd->bhsn', q, kmean).astype(jnp.float32)
    gate = jnp.where(jnp.arange(nblk)[None, :] < cur[:, None], gate, NEG_INF)
    sel = lax.top_k(gate, n_top)[1]
    valid = sel < cur[:, None]
    n_groups = Bsz * H * nblk
    bh = jnp.arange(Bsz * H).reshape(Bsz, H, 1, 1)
    gid = jnp.where(valid, bh * nblk + sel, n_groups).reshape(Bsz * H * S_, n_top)
    o_sel, lse_sel = dispatch_attention(
        q.reshape(Bsz * H * S_, 1, HEAD_DIM), jnp.tile(jnp.arange(S_), Bsz * H), gid,
        kblk.reshape(n_groups, MOBA_BLOCK, HEAD_DIM), vblk.reshape(n_groups, MOBA_BLOCK, HEAD_DIM),
        jnp.tile(jnp.arange(nblk) * MOBA_BLOCK, Bsz * H), table.T[:, None, :],
        (jnp.arange(n_groups) // nblk) % H)
    o_all = jnp.concatenate([o_own.reshape(Bsz * H * S_, 1, 1, HEAD_DIM), o_sel], axis=1)
    lse_all = jnp.concatenate([lse_own.reshape(Bsz * H * S_, 1, 1), lse_sel], axis=1)
    o = merge_parts(o_all, lse_all).reshape(Bsz, H, S_, HEAD_DIM)
    return merge_heads(o.astype(x.dtype)) @ w_out


def moe_ffn(x, router_w, router_b, w_gate, w_up, w_down):
    Bsz, S_, D_ = x.shape
    T = Bsz * S_
    xt = x.reshape(T, D_)
    scores = jax.nn.sigmoid((xt @ router_w).astype(jnp.float32))
    biased = (scores + router_b.astype(jnp.float32)).reshape(T, N_GROUPS, EXPERTS_PER_GROUP)
    group_score = lax.top_k(biased, MOE_TOP_K)[0].sum(-1)
    best_group = jnp.argmax(group_score, axis=-1).astype(jnp.int32)
    in_group = jnp.take_along_axis(biased, best_group[:, None, None], axis=1)[:, 0]
    local = lax.top_k(in_group, MOE_TOP_K)[1]
    expert_idx = best_group[:, None] * EXPERTS_PER_GROUP + local
    gate = jnp.take_along_axis(scores, expert_idx, axis=1)
    gate = gate / gate.sum(-1, keepdims=True)
    n_assign = T * MOE_TOP_K
    flat_e = expert_idx.reshape(n_assign)
    order = jnp.argsort(flat_e)
    sorted_e = flat_e[order]
    sorted_tok = (order // MOE_TOP_K).astype(jnp.int32)
    sorted_w = gate.reshape(n_assign)[order]
    counts = jnp.zeros((N_EXPERTS,), jnp.int32).at[flat_e].add(1)
    padded = (counts + MOE_BLOCK - 1) // MOE_BLOCK * MOE_BLOCK
    pad_end = jnp.cumsum(padded)
    pad_start = pad_end - padded
    start = jnp.cumsum(counts) - counts
    dest = pad_start[sorted_e] + jnp.arange(n_assign) - start[sorted_e]
    n_blocks = -(-n_assign // MOE_BLOCK) + N_EXPERTS
    P = n_blocks * MOE_BLOCK
    buf_tok = jnp.full((P,), T, jnp.int32).at[dest].set(sorted_tok)
    buf_w = jnp.zeros((P,), x.dtype).at[dest].set(sorted_w.astype(x.dtype))
    block_expert = jnp.minimum(jnp.searchsorted(pad_end, jnp.arange(n_blocks) * MOE_BLOCK, side='right'), N_EXPERTS - 1)
    x_pad = jnp.concatenate([xt, jnp.zeros((1, D_), xt.dtype)], axis=0)
    xb = x_pad[buf_tok].reshape(n_blocks, MOE_BLOCK, D_)

    def expert_block(args):
        xi, e = args
        return (jax.nn.silu(xi @ w_gate[e]) * (xi @ w_up[e])) @ w_down[e]

    yb = lax.map(expert_block, (xb, block_expert)).reshape(P, D_) * buf_w[:, None]
    y = jnp.zeros((T + 1, D_), yb.dtype).at[buf_tok].add(yb)[:T]
    return y.reshape(Bsz, S_, D_)


def setup_inputs(seed: int = 0) -> dict:
    key = jax.random.key(seed)
    ks = jax.random.split(key, 26)
    n_occ = [len(range(m, DEPTH, N_MIXERS)) for m in range(N_MIXERS)]
    beta = DEEPNORM_BETA

    def normal(k, shape, scale):
        return jax.random.normal(k, shape, jnp.float32) * scale

    def col_scale(pieces):
        return jnp.asarray(np.concatenate([np.full((w,), s, np.float32) for w, s in pieces]))

    qkv_pieces = [(ATTN_WIDTH, 1.0), (ATTN_WIDTH, 1.0), (ATTN_WIDTH, beta)]
    dil_scale = col_scale(qkv_pieces * len(DILATED_PAIRS))
    qkv_scale = col_scale(qkv_pieces)
    nsa_scale = col_scale([(ATTN_WIDTH, 1.0)] + [(NSA_KV_WIDTH, 1.0), (NSA_KV_WIDTH, beta)] * 3 + [(3 * N_HEADS, 1.0)])
    din = D_MODEL ** -0.5
    out_scale = ATTN_WIDTH ** -0.5 * beta
    cmp_in = NSA_CMP_LEN * HEAD_DIM
    return {
        'x': normal(ks[0], (BATCH, SEQ, D_MODEL), 1.0),
        'rel_table': normal(ks[1], (REL_BUCKETS, N_HEADS), 0.1),
        'router_w': normal(ks[2], (D_MODEL, N_EXPERTS), din),
        'router_b': normal(ks[3], (N_EXPERTS,), 0.01),
        'ln1_g': 1.0 + normal(ks[4], (DEPTH, D_MODEL), 0.01),
        'ln1_b': normal(ks[5], (DEPTH, D_MODEL), 0.01),
        'ln2_g': 1.0 + normal(ks[6], (DEPTH, D_MODEL), 0.01),
        'ln2_b': normal(ks[7], (DEPTH, D_MODEL), 0.01),
        'exp_w_gate': normal(ks[8], (DEPTH, N_EXPERTS, D_MODEL, D_EXPERT), din),
        'exp_w_up': normal(ks[9], (DEPTH, N_EXPERTS, D_MODEL, D_EXPERT), din),
        'exp_w_down': normal(ks[10], (DEPTH, N_EXPERTS, D_EXPERT, D_MODEL), D_EXPERT ** -0.5 * beta),
        'dil_w_in': normal(ks[11], (n_occ[0], D_MODEL, 3 * len(DILATED_PAIRS) * ATTN_WIDTH), din) * dil_scale,
        'dil_w_out': normal(ks[12], (n_occ[0], ATTN_WIDTH, D_MODEL), out_scale),
        'sb_w_in': normal(ks[13], (n_occ[1], D_MODEL, 3 * ATTN_WIDTH), din) * qkv_scale,
        'sb_w_out': normal(ks[14], (n_occ[1], ATTN_WIDTH, D_MODEL), out_scale),
        'nsa_w_in': normal(ks[15], (n_occ[2], D_MODEL, ATTN_WIDTH + 6 * NSA_KV_WIDTH + 3 * N_HEADS), din) * nsa_scale,
        'nsa_w_out': normal(ks[16], (n_occ[2], ATTN_WIDTH, D_MODEL), out_scale),
        'nsa_cmp_pos_k': normal(ks[17], (n_occ[2], NSA_CMP_LEN, HEAD_DIM), 0.1),
        'nsa_cmp_w1_k': normal(ks[18], (n_occ[2], cmp_in, NSA_CMP_HIDDEN), cmp_in ** -0.5),
        'nsa_cmp_w2_k': normal(ks[19], (n_occ[2], NSA_CMP_HIDDEN, HEAD_DIM), NSA_CMP_HIDDEN ** -0.5),
        'nsa_cmp_pos_v': normal(ks[20], (n_occ[2], NSA_CMP_LEN, HEAD_DIM), 0.1),
        'nsa_cmp_w1_v': normal(ks[21], (n_occ[2], cmp_in, NSA_CMP_HIDDEN), cmp_in ** -0.5),
        'nsa_cmp_w2_v': normal(ks[22], (n_occ[2], NSA_CMP_HIDDEN, HEAD_DIM), NSA_CMP_HIDDEN ** -0.5),
        'moba_w_in': normal(ks[23], (n_occ[3], D_MODEL, 3 * ATTN_WIDTH), din) * qkv_scale,
        'moba_w_out': normal(ks[24], (n_occ[3], ATTN_WIDTH, D_MODEL), out_scale),
    }


def reference(x, rel_table, router_w, router_b, ln1_g, ln1_b, ln2_g, ln2_b,
              exp_w_gate, exp_w_up, exp_w_down, dil_w_in, dil_w_out, sb_w_in, sb_w_out,
              nsa_w_in, nsa_w_out, nsa_cmp_pos_k, nsa_cmp_w1_k, nsa_cmp_w2_k,
              nsa_cmp_pos_v, nsa_cmp_w1_v, nsa_cmp_w2_v, moba_w_in, moba_w_out):
    for layer in range(DEPTH):
        kind, occ = layer % N_MIXERS, layer // N_MIXERS
        if kind == 0:
            mixed = mixer_dilated(x, dil_w_in[occ], dil_w_out[occ], rel_table)
        elif kind == 1:
            mixed = mixer_stick_breaking(x, sb_w_in[occ], sb_w_out[occ])
        elif kind == 2:
            mixed = mixer_nsa(x, nsa_w_in[occ], nsa_w_out[occ], rel_table,
                              nsa_cmp_pos_k[occ], nsa_cmp_w1_k[occ], nsa_cmp_w2_k[occ],
                              nsa_cmp_pos_v[occ], nsa_cmp_w1_v[occ], nsa_cmp_w2_v[occ])
        else:
            mixed = mixer_moba(x, moba_w_in[occ], moba_w_out[occ], rel_table)
        x = layer_norm(DEEPNORM_ALPHA * x + mixed, ln1_g[layer], ln1_b[layer])
        ffn = moe_ffn(x, router_w, router_b, exp_w_gate[layer], exp_w_up[layer], exp_w_down[layer])
        x = layer_norm(DEEPNORM_ALPHA * x + ffn, ln2_g[layer], ln2_b[layer])
    return x
```

```cpp
#include <hip/hip_runtime.h>
#include <cstdio>
#include <cstdint>
#define DBG 0
#define DBG_LAYER 0

#define LAS __attribute__((address_space(3)))
#define GAS __attribute__((address_space(1)))
#define DI __device__ __forceinline__
typedef unsigned short bf16_t;
typedef short bf16x8 __attribute__((ext_vector_type(8)));
typedef short s16x4 __attribute__((ext_vector_type(4)));
typedef float f32x2 __attribute__((ext_vector_type(2)));
typedef float f32x4 __attribute__((ext_vector_type(4)));
typedef float f32x16 __attribute__((ext_vector_type(16)));
typedef unsigned u32x2 __attribute__((ext_vector_type(2)));
typedef unsigned u32x4 __attribute__((ext_vector_type(4)));

constexpr int BATCH = 2, SEQ = 16384, D = 1024, T = BATCH * SEQ, DEPTH = 4, NH = 16, HD = 64;
constexpr int NE = 16, DEXP = 256;
constexpr float ALPHA = 1.681792830507429f;
constexpr float LN_EPS = 1e-5f;
constexpr int NWAVES = 8, NTHR = 512;

constexpr size_t MiB = 1u << 20;
constexpr size_t WS_CTL = 0;
constexpr size_t WS_TOKINFO = 1 * MiB;
constexpr size_t WS_SMALL = 1 * MiB + 512 * 1024;
constexpr size_t WS_LIST = 2 * MiB;
constexpr size_t WS_WIN = 4 * MiB;
constexpr size_t WS_WOUT = 22 * MiB;
constexpr size_t WS_WEXP1 = 24 * MiB;
constexpr size_t WS_WEXP2 = 40 * MiB;
constexpr size_t WS_WCMP = 48 * MiB;
constexpr size_t WS_ACTB = 52 * MiB;
constexpr size_t WS_BIG = 116 * MiB;
constexpr size_t WS_END = 512 * MiB;
constexpr size_t BIG_Y = 0;
constexpr size_t BIG_H = 64 * MiB;
constexpr size_t BIG_YB = 100 * MiB;
constexpr int PROWS = 2 * T + NE * 256;

constexpr int CW_BAR = 4096;
constexpr int CW_DBG = 8;
constexpr int CW_MOE = 16384;

constexpr int LDS_BYTES = 160 * 1024;
constexpr int STAGE_OFF = 0;
constexpr int AUX_OFF = 128 * 1024;
constexpr int MISC_OFF = LDS_BYTES - 1024;

DI unsigned f2bf(float f) { unsigned u = __builtin_bit_cast(unsigned, f); return (u + 0x7fffu + ((u >> 16) & 1u)) >> 16; }
DI unsigned pk2(float lo, float hi) { return f2bf(lo) | (f2bf(hi) << 16); }
DI unsigned cvt_pk_bf16(float lo, float hi) { unsigned r; asm volatile("v_cvt_pk_bf16_f32 %0, %1, %2" : "=v"(r) : "v"(lo), "v"(hi)); return r; }
DI float u2f(unsigned u) { return __builtin_bit_cast(float, u); }
DI unsigned f2u(float f) { return __builtin_bit_cast(unsigned, f); }
DI float bf_lo(unsigned w) { return __builtin_bit_cast(float, w << 16); }
DI float bf_hi(unsigned w) { return __builtin_bit_cast(float, w & 0xffff0000u); }
DI float wave_sum(float v) {
#pragma unroll
    for (int o = 1; o < 64; o <<= 1) v += __shfl_xor(v, o);
    return v;
}
DI int tid_of(int wv) { int l; asm volatile("v_mbcnt_lo_u32_b32 %0, -1, 0\n\tv_mbcnt_hi_u32_b32 %0, -1, %0" : "=v"(l)); return (wv << 6) | l; }
#define LDS_WAIT() asm volatile("s_waitcnt lgkmcnt(0)" ::: "memory")
#define VM_WAIT() asm volatile("s_waitcnt vmcnt(0)" ::: "memory")

#define XB_TMO      128
#define XB_XCNT(j)  (256  + 64 * (j))
#define XB_XSUB(j)  (1280 + 64 * (j))
#define XB_XGEN(j)  (2304 + 64 * (j))
#define XB_TOP      3328
#define XB_TOPGEN   3392
#define XCD_BAR_WORDS 3456
#define XB_SPIN_CAP (1u << 22)
DI unsigned xb_ld(unsigned* p)              { return __hip_atomic_load(p, __ATOMIC_RELAXED, __HIP_MEMORY_SCOPE_AGENT); }
DI unsigned xb_add(unsigned* p, unsigned v) { return __hip_atomic_fetch_add(p, v, __ATOMIC_RELAXED, __HIP_MEMORY_SCOPE_AGENT); }
DI unsigned xb_xcc_id() { return (unsigned)__builtin_amdgcn_s_getreg((3 << 11) | 20) & 0xFu; }
#define XB_SPIN(cond, bar) do { unsigned _sp = 0; while (cond) { __builtin_amdgcn_s_sleep(1); \
    if ((++_sp & 255u) == 0u) { if (xb_ld(&(bar)[XB_TMO])) break; if (_sp > XB_SPIN_CAP) { atomicAdd(&(bar)[XB_TMO], 1u); break; } } } } while (0)
struct XcdBarrier { unsigned* bar; unsigned x; volatile LAS unsigned* st; int wv; };
DI XcdBarrier xcd_barrier_post(unsigned* bar, volatile LAS unsigned* st) {
    XcdBarrier b; b.bar = bar; b.x = xb_xcc_id(); b.st = st;
    if (threadIdx.x == 0) (void)xb_add(&bar[XB_XCNT(b.x)], 1u);
    return b;
}
DI void xcd_barrier_complete(unsigned* bar, unsigned x, unsigned& nloc, unsigned& nx) {
    const unsigned G = gridDim.x * gridDim.y * gridDim.z;
    unsigned sum, cnt, mine, sp = 0u;
    for (;;) {
        sum = 0u; cnt = 0u; mine = 0u;
#pragma unroll
        for (unsigned j = 0; j < 16; ++j) { const unsigned c = xb_ld(&bar[XB_XCNT(j)]); sum += c; cnt += (c > 0u) ? 1u : 0u; mine = (j == x) ? c : mine; }
        if (sum == G) break;
        __builtin_amdgcn_s_sleep(1);
        if ((++sp & 255u) == 0u) { if (xb_ld(&bar[XB_TMO])) break; if (sp > XB_SPIN_CAP) { atomicAdd(&bar[XB_TMO], 1u); break; } }
    }
    nloc = mine > 0u ? mine : 1u; nx = cnt > 0u ? cnt : 1u;
}
DI void xcd_barrier(const XcdBarrier& b) {
    asm volatile("s_waitcnt vmcnt(0)" ::: "memory");
    __syncthreads();
    if (tid_of(b.wv) == 0) {
        unsigned* bar = b.bar;
        const unsigned bx = xb_xcc_id();
        __builtin_amdgcn_s_waitcnt(0);
        unsigned nloc = b.st[0], nx = b.st[1];
        if (nloc == 0u) { xcd_barrier_complete(bar, bx, nloc, nx); b.st[0] = nloc; b.st[1] = nx; }
        const unsigned old = xb_add(&bar[XB_XSUB(bx)], 1u);
        const unsigned gen = old / nloc;
        if (old + 1u == (gen + 1u) * nloc) {
            __builtin_amdgcn_fence(__ATOMIC_RELEASE, "agent");
            asm volatile("s_waitcnt vmcnt(0)" ::: "memory");
            const unsigned og = xb_add(&bar[XB_TOP], 1u);
            const unsigned tg = og / nx;
            if (og + 1u == (tg + 1u) * nx) xb_add(&bar[XB_TOPGEN], 1u);
            else XB_SPIN(xb_ld(&bar[XB_TOPGEN]) == tg, bar);
            __builtin_amdgcn_fence(__ATOMIC_ACQUIRE, "agent");
            xb_add(&bar[XB_XGEN(bx)], 1u);
            asm volatile("s_waitcnt vmcnt(0)" ::: "memory");
        } else {
            XB_SPIN(xb_ld(&bar[XB_XGEN(bx)]) == gen, bar);
            __builtin_amdgcn_fence(__ATOMIC_ACQUIRE, "agent");
            asm volatile("s_waitcnt vmcnt(0)" ::: "memory");
        }
    }
    __syncthreads();
}

namespace pg8 {
constexpr int BM = 256, BK = 64, HALF = 128, HTB = HALF * BK * 2, STAGE_BYTES = 8 * HTB, NXCD = 8, WGM = 8;
__host__ __device__ __forceinline__ int lds_byte(int r, int c) { const int st = (r >> 4) * 2 + (c >> 5), rr = r & 15, cc = c & 31, ob = rr * 64 + cc * 2; return st * 1024 + (ob ^ (((ob >> 9) & 1) << 5)); }
__host__ __device__ __forceinline__ void stage_rc(int b, int& R, int& C) { const int st = b / 1024, sb = b % 1024, swz = sb ^ (((sb >> 9) & 1) << 5); R = (st >> 1) * 16 + swz / 64; C = (st & 1) * 32 + (swz % 64) / 2; }
__host__ __device__ __forceinline__ int perm32(int rho) { const int n = rho >> 4, i = rho & 15; return 8 * (i >> 2) + 4 * n + (i & 3); }

struct Unit { int pm, pn, e; };

struct TileOrder {
    int nM, nN, nwg, G, c;
    DI void init(int nM_, int nN_, int G_, int c_) { nM = nM_; nN = nN_; nwg = nM * nN; G = G_; c = c_; }
    DI bool next(int i, int& pm, int& pn) const {
        const long L = (long)i * G + c; if (L >= nwg) return false;
        int wgid = (int)L; { const int q = nwg / NXCD, r = nwg % NXCD, xcd = wgid % NXCD, off = wgid / NXCD; wgid = (xcd < r ? xcd * (q + 1) : r * (q + 1) + (xcd - r) * q) + off; }
        const int nig = WGM * nN, gid = wgid / nig, fm = gid * WGM, gsz = (nM - fm) < WGM ? (nM - fm) : WGM;
        pm = fm + ((wgid % nig) % gsz); pn = (wgid % nig) / gsz; return true;
    }
};
struct DenseSched {
    static constexpr bool GATHER = false;
    const char* A; const char* Bt; int K; unsigned lda, kstepA; TileOrder ord;
    DI void init(const void* A_, unsigned lda_, unsigned kstepA_, const void* Bt_, int M, int N, int K_, int G, int c) { A = (const char*)A_; Bt = (const char*)Bt_; K = K_; lda = lda_; kstepA = kstepA_; ord.init(M / BM, N / BM, G, c); }
    DI bool next(int i, Unit& u) const { u.e = 0; return ord.next(i, u.pm, u.pn); }
    DI const char* a_base(const Unit& u) const { return A + (size_t)u.pm * BM * lda; }
    DI const char* b_base(const Unit& u) const { return Bt + (size_t)u.pn * BM * K * 2; }
    DI unsigned row_off(int, int) const { return 0u; }
};

template <class Epi, class Sched>
DI void gemm_phase(LAS unsigned char* lds, const Sched& S, const Epi& E, int wv) {
    int tid = tid_of(wv); asm volatile("" : "+v"(tid));
    const int wid = __builtin_amdgcn_readfirstlane(tid >> 6), lane = tid & 63, wr = wid >> 2, wc = wid & 3, fr = lane & 15, fq = lane >> 4;
    const int K = S.K, nt = K / BK;
    unsigned voffB[2]; int Rr[2]; unsigned Cb[2];
#pragma unroll
    for (int i = 0; i < 2; ++i) { int R, C; stage_rc(tid * 16 + i * 8192, R, C); const int Rb = (R & ~31) + perm32(R & 31);
        voffB[i] = (unsigned)(Rb * K + C) * 2u; Rr[i] = R; Cb[i] = (unsigned)C * 2u; }
    const unsigned kstepA = S.kstepA, kstepB = (unsigned)(BK * 2);
    const size_t hstepB = (size_t)HALF * K * 2;
    const unsigned ldsw = (unsigned)wid * 1024u;
    const int aoff = lds_byte(wr * 64 + fr, fq * 8), boff = lds_byte(wc * 32 + fr, fq * 8);
#define PG8_SA(b, h) (((b) * 2 + (h)) * HTB)
#define PG8_SB(b, h) ((4 + (b) * 2 + (h)) * HTB)
#define PG8_STAGE_A(bufoff, basep, vv, h, koff) do { _Pragma("unroll") for (int _i = 0; _i < 2; ++_i) \
        __builtin_amdgcn_global_load_lds((const unsigned*)((basep) + (vv)[h][_i] + (koff)), (LAS unsigned*)(lds + (bufoff) + ldsw + _i * 8192), 16, 0, 0); } while (0)
#define PG8_STAGE_B(bufoff, ptr) do { _Pragma("unroll") for (int _i = 0; _i < 2; ++_i) \
        __builtin_amdgcn_global_load_lds((const unsigned*)((ptr) + voffB[_i]), (LAS unsigned*)(lds + (bufoff) + ldsw + _i * 8192), 16, 0, 0); } while (0)
#define PG8_LDA(dst, b, h) do { _Pragma("unroll") for (int m = 0; m < 4; ++m) _Pragma("unroll") for (int k = 0; k < 2; ++k) dst[m][k] = *(const LAS bf16x8*)(lds + PG8_SA(b, h) + aoff + m * 2048 + k * 1024); } while (0)
#define PG8_LDB(dst, b, h) do { _Pragma("unroll") for (int n = 0; n < 2; ++n) _Pragma("unroll") for (int k = 0; k < 2; ++k) dst[n][k] = *(const LAS bf16x8*)(lds + PG8_SB(b, h) + boff + n * 2048 + k * 1024); } while (0)
#define PG8_MMA(ai, bj, At, Bt) do { __builtin_amdgcn_s_setprio(1); _Pragma("unroll") for (int m = 0; m < 4; ++m) _Pragma("unroll") for (int n = 0; n < 2; ++n) _Pragma("unroll") for (int k = 0; k < 2; ++k) \
        acc[ai][bj][m][n] = __builtin_amdgcn_mfma_f32_16x16x32_bf16(Bt[n][k], At[m][k], acc[ai][bj][m][n], 0, 0, 0); __builtin_amdgcn_s_setprio(0); } while (0)
#define PG8_WAIT_V(n) asm volatile("s_waitcnt vmcnt(" #n ")" ::: "memory")
#define PG8_WAIT_L(n) asm volatile("s_waitcnt lgkmcnt(" #n ")" ::: "memory")
#define PG8_BAR __builtin_amdgcn_s_barrier()
#define PG8_SCHED __builtin_amdgcn_sched_barrier(0)
    Unit cur, nxt; int ui = 0;
    if (!S.next(0, cur)) return;
    unsigned vA[2][2], vN[2][2];
#pragma unroll
    for (int h = 0; h < 2; ++h)
#pragma unroll
        for (int i = 0; i < 2; ++i) { vA[h][i] = (Sched::GATHER ? S.row_off(0, h * HALF + Rr[i]) : (unsigned)(h * HALF + Rr[i]) * S.lda) + Cb[i]; vN[h][i] = vA[h][i]; }
    f32x4 acc[2][2][4][2];
#pragma unroll
    for (int a = 0; a < 2; ++a)
#pragma unroll
        for (int b = 0; b < 2; ++b)
#pragma unroll
            for (int m = 0; m < 4; ++m)
#pragma unroll
                for (int n = 0; n < 2; ++n) acc[a][b][m][n] = (f32x4){0.f, 0.f, 0.f, 0.f};
    bf16x8 At[4][2], B0[2][2], B1[2][2];
    const char* cA = S.a_base(cur); const char* cB = S.b_base(cur);
    PG8_STAGE_B(PG8_SB(0, 0), cB); PG8_STAGE_A(PG8_SA(0, 0), cA, vA, 0, 0u); PG8_STAGE_B(PG8_SB(0, 1), cB + hstepB); PG8_STAGE_A(PG8_SA(0, 1), cA, vA, 1, 0u);
    if (wr == 1) PG8_BAR;
    PG8_WAIT_V(4); PG8_BAR;
    PG8_STAGE_B(PG8_SB(1, 0), cB + kstepB); PG8_STAGE_A(PG8_SA(1, 0), cA, vA, 0, kstepA); PG8_STAGE_B(PG8_SB(1, 1), cB + hstepB + kstepB);
    PG8_WAIT_V(6); PG8_BAR;
    for (;;) {
        const bool has_next = S.next(ui + 1, nxt);
        const char* nA = has_next ? S.a_base(nxt) : cA; const char* nB = has_next ? S.b_base(nxt) : cB;
        if (Sched::GATHER) {
#pragma unroll
            for (int h = 0; h < 2; ++h)
#pragma unroll
                for (int i = 0; i < 2; ++i) vN[h][i] = has_next ? (S.row_off(ui + 1, h * HALF + Rr[i]) + Cb[i]) : vA[h][i];
        }
        for (int t = 0; t < nt; t += 2) {
            const bool last = (t == nt - 2);
            const unsigned k1 = (unsigned)(t + 1) * kstepA;
            const char* a2p = last ? nA : cA; const unsigned k2 = last ? 0u : (unsigned)(t + 2) * kstepA;
            unsigned v2[2][2];
#pragma unroll
            for (int h = 0; h < 2; ++h)
#pragma unroll
                for (int i = 0; i < 2; ++i) v2[h][i] = (Sched::GATHER && last) ? vN[h][i] : vA[h][i];
            const char* b2 = last ? nB : cB + (size_t)(t + 2) * kstepB; const char* b3 = b2 + kstepB;
            PG8_LDB(B0, 0, 0); PG8_SCHED; PG8_LDA(At, 0, 0); PG8_STAGE_A(PG8_SA(1, 1), cA, vA, 1, k1);
            PG8_WAIT_L(8); PG8_BAR; PG8_WAIT_L(0); PG8_MMA(0, 0, At, B0); PG8_BAR; PG8_SCHED;
            PG8_LDB(B1, 0, 1); PG8_STAGE_B(PG8_SB(0, 0), b2);
            PG8_BAR; PG8_WAIT_L(0); PG8_MMA(0, 1, At, B1); PG8_BAR;
            PG8_LDA(At, 0, 1); PG8_STAGE_A(PG8_SA(0, 0), a2p, v2, 0, k2);
            PG8_BAR; PG8_WAIT_L(0); PG8_MMA(1, 0, At, B0); PG8_BAR; PG8_SCHED;
            PG8_STAGE_B(PG8_SB(0, 1), b2 + hstepB);
            PG8_WAIT_V(6); PG8_BAR; PG8_MMA(1, 1, At, B1); PG8_BAR;
            PG8_LDB(B0, 1, 0); PG8_SCHED; PG8_LDA(At, 1, 0); PG8_STAGE_A(PG8_SA(0, 1), a2p, v2, 1, k2);
            PG8_WAIT_L(8); PG8_BAR; PG8_WAIT_L(0); PG8_MMA(0, 0, At, B0); PG8_BAR; PG8_SCHED;
            PG8_LDB(B1, 1, 1); PG8_STAGE_B(PG8_SB(1, 0), b3);
            PG8_BAR; PG8_WAIT_L(0); PG8_MMA(0, 1, At, B1); PG8_BAR;
            PG8_LDA(At, 1, 1); PG8_STAGE_A(PG8_SA(1, 0), a2p, v2, 0, k2 + kstepA);
            PG8_BAR; PG8_WAIT_L(0); PG8_MMA(1, 0, At, B0); PG8_BAR; PG8_SCHED;
            PG8_STAGE_B(PG8_SB(1, 1), b3 + hstepB);
            PG8_WAIT_V(6); PG8_BAR; PG8_MMA(1, 1, At, B1); PG8_BAR;
        }
        E(acc, cur, wr, wc, fr, fq);
        if (!has_next) break;
#pragma unroll
        for (int a = 0; a < 2; ++a)
#pragma unroll
            for (int b = 0; b < 2; ++b)
#pragma unroll
                for (int m = 0; m < 4; ++m)
#pragma unroll
                    for (int n = 0; n < 2; ++n) acc[a][b][m][n] = (f32x4){0.f, 0.f, 0.f, 0.f};
        cur = nxt; cA = nA; cB = nB; ++ui;
#pragma unroll
        for (int h = 0; h < 2; ++h)
#pragma unroll
            for (int i = 0; i < 2; ++i) vA[h][i] = vN[h][i];
    }
    PG8_WAIT_V(0);
    if (wr == 0) PG8_BAR;
    PG8_BAR;
#undef PG8_SA
#undef PG8_SB
#undef PG8_STAGE_A
#undef PG8_STAGE_B
#undef PG8_LDA
#undef PG8_LDB
#undef PG8_MMA
#undef PG8_WAIT_V
#undef PG8_WAIT_L
#undef PG8_BAR
#undef PG8_SCHED
}

struct EpiStore {
    bf16_t* O; size_t ldc;
    DI void operator()(const f32x4 (&acc)[2][2][4][2], const Unit& u, int wr, int wc, int fr, int fq) const {
        const int row0 = u.pm * BM + wr * 64 + fr, col0 = u.pn * BM + wc * 32 + 8 * fq;
#pragma unroll
        for (int ai = 0; ai < 2; ++ai)
#pragma unroll
            for (int m = 0; m < 4; ++m) { bf16_t* rowp = O + (size_t)(row0 + ai * HALF + m * 16) * ldc + col0;
#pragma unroll
                for (int bj = 0; bj < 2; ++bj) { const f32x4 v0 = acc[ai][bj][m][0], v1 = acc[ai][bj][m][1];
                    u32x4 w; w.x = cvt_pk_bf16(v0[0], v0[1]); w.y = cvt_pk_bf16(v0[2], v0[3]); w.z = cvt_pk_bf16(v1[0], v1[1]); w.w = cvt_pk_bf16(v1[2], v1[3]);
                    *(u32x4*)(rowp + bj * HALF) = w; } }
    }
};
struct EpiSwiglu {
    bf16_t* Hb;
    DI void operator()(const f32x4 (&acc)[2][2][4][2], const Unit& u, int wr, int wc, int fr, int fq) const {
        const int row0 = u.pm * BM + wr * 64 + fr, col0 = u.pn * HALF + wc * 32 + 8 * fq;
#pragma unroll
        for (int ai = 0; ai < 2; ++ai)
#pragma unroll
            for (int m = 0; m < 4; ++m) { bf16_t* rowp = Hb + (size_t)(row0 + ai * HALF + m * 16) * DEXP + col0;
                float o[8];
#pragma unroll
                for (int n = 0; n < 2; ++n)
#pragma unroll
                    for (int j = 0; j < 4; ++j) { const float g = acc[ai][0][m][n][j], up = acc[ai][1][m][n][j];
                        o[n * 4 + j] = g * up * __builtin_amdgcn_rcpf(1.0f + __builtin_amdgcn_exp2f(-1.4426950408889634f * g)); }
                u32x4 w; w.x = cvt_pk_bf16(o[0], o[1]); w.y = cvt_pk_bf16(o[2], o[3]); w.z = cvt_pk_bf16(o[4], o[5]); w.w = cvt_pk_bf16(o[6], o[7]);
                *(u32x4*)rowp = w; }
    }
};

struct EpiNsa {
    bf16_t* Q; bf16_t* KV; float* GT;
    DI void operator()(const f32x4 (&acc)[2][2][4][2], const Unit& u, int wr, int wc, int fr, int fq) const {
        const int row0 = u.pm * BM + wr * 64 + fr;
        if (u.pn < 10) {
            bf16_t* base = (u.pn < 4) ? Q + u.pn * BM : KV + (u.pn - 4) * BM; const size_t ldc = (u.pn < 4) ? 1024 : 1536; const int col0 = wc * 32 + 8 * fq;
#pragma unroll
            for (int ai = 0; ai < 2; ++ai)
#pragma unroll
                for (int m = 0; m < 4; ++m) { bf16_t* rowp = base + (size_t)(row0 + ai * HALF + m * 16) * ldc + col0;
#pragma unroll
                    for (int bj = 0; bj < 2; ++bj) { const f32x4 v0 = acc[ai][bj][m][0], v1 = acc[ai][bj][m][1];
                        u32x4 w; w.x = cvt_pk_bf16(v0[0], v0[1]); w.y = cvt_pk_bf16(v0[2], v0[3]); w.z = cvt_pk_bf16(v1[0], v1[1]); w.w = cvt_pk_bf16(v1[2], v1[3]);
                        *(u32x4*)(rowp + bj * HALF) = w; } }
        } else {
            const int col0 = wc * 32 + 8 * fq;
            if (col0 < 48) {
#pragma unroll
                for (int ai = 0; ai < 2; ++ai)
#pragma unroll
                    for (int m = 0; m < 4; ++m) { float* rowp = GT + (size_t)(row0 + ai * HALF + m * 16) * 48 + col0;
#pragma unroll
                        for (int n = 0; n < 2; ++n) { f32x4 v = acc[ai][0][m][n];
#pragma unroll
                            for (int j = 0; j < 4; ++j) v[j] = __builtin_amdgcn_rcpf(1.0f + __builtin_amdgcn_exp2f(-1.4426950408889634f * v[j]));
                            *(f32x4*)(rowp + 4 * n) = v; } }
            }
        }
    }
};
struct EpiCmp {
    bf16_t* Hd; const float* bias;
    DI void operator()(const f32x4 (&acc)[2][2][4][2], const Unit& u, int wr, int wc, int fr, int fq) const {
        const int row0 = u.pm * BM + wr * 64 + fr, col0 = wc * 32 + 8 * fq; const float* bp = bias + u.e * 256;
#pragma unroll
        for (int bj = 0; bj < 2; ++bj) { const f32x4 b0 = *(const f32x4*)(bp + bj * HALF + col0), b1 = *(const f32x4*)(bp + bj * HALF + col0 + 4);
#pragma unroll
            for (int ai = 0; ai < 2; ++ai)
#pragma unroll
                for (int m = 0; m < 4; ++m) { float o[8];
#pragma unroll
                    for (int j = 0; j < 4; ++j) { o[j] = acc[ai][bj][m][0][j] + b0[j]; o[4 + j] = acc[ai][bj][m][1][j] + b1[j]; }
#pragma unroll
                    for (int j = 0; j < 8; ++j) { const float x = o[j], u2 = 1.5957691216057308f * (x + 0.044715f * x * x * x); o[j] = x * __builtin_amdgcn_rcpf(1.0f + __builtin_amdgcn_exp2f(-1.4426950408889634f * u2)); }
                    u32x4 w; w.x = cvt_pk_bf16(o[0], o[1]); w.y = cvt_pk_bf16(o[2], o[3]); w.z = cvt_pk_bf16(o[4], o[5]); w.w = cvt_pk_bf16(o[6], o[7]);
                    *(u32x4*)(Hd + (size_t)(row0 + ai * HALF + m * 16) * 256 + bj * HALF + col0) = w; } }
    }
};
struct CmpSched {
    static constexpr bool GATHER = false;
    const char* kv6; const char* Bt; int K; unsigned lda, kstepA; int G, c;
    DI bool next(int i, Unit& u) const { const int L = i * G + c; if (L >= 64) return false; u.pm = L; u.pn = 0; u.e = L >> 5; return true; }
    DI const char* a_base(const Unit& u) const { const int j = u.pm >> 5, bg = (u.pm >> 2) & 7, cq = u.pm & 3, b = bg >> 2, g = bg & 3;
        return kv6 + (((size_t)b * SEQ + (size_t)cq * 4096) * 1536 + j * 256 + g * 64) * 2; }
    DI const char* b_base(const Unit& u) const { return Bt + (size_t)(u.pm >> 5) * 256 * 2048 * 2; }
    DI unsigned row_off(int, int) const { return 0u; }
};
}

struct MoeMeta { LAS int* tstart; LAS int* cnt; };
DI int moe_expert_of(const MoeMeta& mm, int rt) { int e = 0;
#pragma unroll
    for (int k = 1; k < 16; ++k) e += (rt >= mm.tstart[k]) ? 1 : 0;
    return e; }
struct Moe1Sched {
    static constexpr bool GATHER = true;
    const char* A; const char* Bt; int K; unsigned lda, kstepA; MoeMeta mm; int ntiles, G, c; LAS unsigned* tab;
    DI bool next(int i, pg8::Unit& u) const { const int L = i * G + c; if (L >= ntiles * 2) return false; u.pm = L % ntiles; u.pn = L / ntiles; u.e = moe_expert_of(mm, u.pm); return true; }
    DI const char* a_base(const pg8::Unit&) const { return A; }
    DI const char* b_base(const pg8::Unit& u) const { return Bt + ((size_t)u.e * 512 + (size_t)u.pn * 256) * 1024 * 2; }
    DI unsigned row_off(int slot, int row) const { return tab[slot * 256 + row]; }
};
struct Moe2Sched {
    static constexpr bool GATHER = false;
    const char* A; const char* Bt; int K; unsigned lda, kstepA; MoeMeta mm; int ntiles, G, c;
    DI bool next(int i, pg8::Unit& u) const { const int L = i * G + c; if (L >= ntiles * 4) return false; u.pm = L % ntiles; u.pn = L / ntiles; u.e = moe_expert_of(mm, u.pm); return true; }
    DI const char* a_base(const pg8::Unit& u) const { return A + (size_t)u.pm * 256 * 512; }
    DI const char* b_base(const pg8::Unit& u) const { return Bt + ((size_t)u.e * 1024 + (size_t)u.pn * 256) * 256 * 2; }
    DI unsigned row_off(int, int) const { return 0u; }
};

struct Args { const float* in[25]; float* out; unsigned char* ws; int wv; int pad; };
enum { IN_X = 0, IN_REL, IN_RW, IN_RB, IN_LN1G, IN_LN1B, IN_LN2G, IN_LN2B, IN_EG, IN_EU, IN_ED, IN_DILIN, IN_DILOUT, IN_SBIN, IN_SBOUT,
       IN_NSAIN, IN_NSAOUT, IN_POSK, IN_W1K, IN_W2K, IN_POSV, IN_W1V, IN_W2V, IN_MOBAIN, IN_MOBAOUT };

DI void transpose_item(const float* W, int K, int N, int Nvalid, bf16_t* WT, int drow0, LAS float* scr, int kb, int nb, int lane) {
    const int k0 = 64 * kb, n0 = 32 * nb;
#pragma unroll 8
    for (int i = 0; i < 32; ++i) { const int kk = 2 * i + (lane >> 5); const int n = n0 + (lane & 31); scr[kk * 33 + (lane & 31)] = (n < Nvalid) ? W[(size_t)(k0 + kk) * N + n] : 0.f; }
    LDS_WAIT(); asm volatile("" ::: "memory");
    const int c = lane & 7;
#pragma unroll
    for (int j = 0; j < 4; ++j) { const int n = (lane >> 3) + 8 * j; const LAS float* s = scr + (8 * c) * 33 + n;
        u32x4 o; o.x = pk2(s[0 * 33], s[1 * 33]); o.y = pk2(s[2 * 33], s[3 * 33]); o.z = pk2(s[4 * 33], s[5 * 33]); o.w = pk2(s[6 * 33], s[7 * 33]);
        *(u32x4*)(WT + (size_t)(drow0 + n) * K + k0 + 8 * c) = o; }
    LDS_WAIT(); asm volatile("" ::: "memory");
}

DI void convert_matrix(const float* W, int K, int N, int Npad, bf16_t* WT, LAS float* scr, int gw, int NGW, int lane) {
    const int nblk = Npad / 32, nitems = (K / 64) * nblk;
    for (int it = gw; it < nitems; it += NGW) { const int kb = it / nblk, nb = it % nblk; transpose_item(W, K, N, N, WT, 32 * nb, scr, kb, nb, lane); }
}
DI void convert_layer_weights(const Args& a, int layer, LAS unsigned char* lds, int gw, int NGW, int wave, int lane) {
    LAS float* scr = (LAS float*)(lds + STAGE_OFF + wave * 16384);
    bf16_t* W1 = (bf16_t*)(a.ws + WS_WEXP1); bf16_t* W2 = (bf16_t*)(a.ws + WS_WEXP2);
    const float* eg = a.in[IN_EG] + (size_t)layer * NE * D * DEXP; const float* eu = a.in[IN_EU] + (size_t)layer * NE * D * DEXP; const float* ed = a.in[IN_ED] + (size_t)layer * NE * DEXP * D;
    constexpr int I_G = (D / 64) * (DEXP / 32);
    constexpr int I_D = (DEXP / 64) * (D / 32);
    constexpr int I_E = 2 * I_G + I_D;
    {
        bf16_t* Win = (bf16_t*)(a.ws + WS_WIN); bf16_t* Wout = (bf16_t*)(a.ws + WS_WOUT);
        if (layer == 0) { convert_matrix(a.in[IN_DILIN], D, 9216, 9216, Win, scr, gw, NGW, lane); convert_matrix(a.in[IN_DILOUT], D, D, D, Wout, scr, gw, NGW, lane); }
        if (layer == 1) { convert_matrix(a.in[IN_SBIN], D, 3072, 3072, Win, scr, gw, NGW, lane); convert_matrix(a.in[IN_SBOUT], D, D, D, Wout, scr, gw, NGW, lane); }
        if (layer == 2) { convert_matrix(a.in[IN_NSAIN], D, 2608, 2816, Win, scr, gw, NGW, lane); convert_matrix(a.in[IN_NSAOUT], D, D, D, Wout, scr, gw, NGW, lane);
            bf16_t* wc = (bf16_t*)(a.ws + WS_WCMP);
            convert_matrix(a.in[IN_W1K], 2048, 256, 256, wc, scr, gw, NGW, lane); convert_matrix(a.in[IN_W1V], 2048, 256, 256, wc + 256 * 2048, scr, gw, NGW, lane);
            convert_matrix(a.in[IN_W2K], 256, 64, 64, wc + 2 * 256 * 2048, scr, gw, NGW, lane); convert_matrix(a.in[IN_W2V], 256, 64, 64, wc + 2 * 256 * 2048 + 64 * 256, scr, gw, NGW, lane);
            float* cb = (float*)(a.ws + WS_WCMP + 2 * MiB + 64 * 1024);
            for (int it = gw; it < 512; it += NGW) { const int j = it >> 8, n = it & 255; const float* pos = a.in[j ? IN_POSV : IN_POSK]; const float* w1 = a.in[j ? IN_W1V : IN_W1K];
                float s = 0.f; for (int k = lane; k < 2048; k += 64) s += pos[k] * w1[(size_t)k * 256 + n];
                s = wave_sum(s); if (lane == 0) cb[it] = s; } }
        if (layer == 3) { convert_matrix(a.in[IN_MOBAIN], D, 3072, 3072, Win, scr, gw, NGW, lane); convert_matrix(a.in[IN_MOBAOUT], D, D, D, Wout, scr, gw, NGW, lane); }
    }
    const int NITEMS = NE * I_E;
    for (int it = gw; it < NITEMS; it += NGW) {
        const int e = it / I_E; int r = it % I_E;
        if (r < I_G) { const int kb = r / (DEXP / 32), nb = r % (DEXP / 32); const int n0 = 32 * nb;
            transpose_item(eg + (size_t)e * D * DEXP, D, DEXP, DEXP, W1, e * 512 + ((n0 >> 7) << 8) + (n0 & 127), scr, kb, nb, lane); continue; }
        r -= I_G;
        if (r < I_G) { const int kb = r / (DEXP / 32), nb = r % (DEXP / 32); const int n0 = 32 * nb;
            transpose_item(eu + (size_t)e * D * DEXP, D, DEXP, DEXP, W1, e * 512 + ((n0 >> 7) << 8) + 128 + (n0 & 127), scr, kb, nb, lane); continue; }
        r -= I_G;
        { const int kb = r / (D / 32), nb = r % (D / 32);
          transpose_item(ed + (size_t)e * DEXP * D, DEXP, D, D, W2, e * 1024 + 32 * nb, scr, kb, nb, lane); }
    }
}

struct RowVec { f32x4 v[4]; };
DI void ln_stats(const RowVec& r, float& mean, float& rstd) {
    float s = 0.f;
#pragma unroll
    for (int j = 0; j < 4; ++j) s += (r.v[j].x + r.v[j].y) + (r.v[j].z + r.v[j].w);
    mean = wave_sum(s) * (1.f / D); float s2 = 0.f;
#pragma unroll
    for (int j = 0; j < 4; ++j) { const f32x4 d = r.v[j] - mean; s2 += (d.x * d.x + d.y * d.y) + (d.z * d.z + d.w * d.w); }
    rstd = 1.f / sqrtf(wave_sum(s2) * (1.f / D) + LN_EPS);
}


constexpr int KSTR = 144;
constexpr int KVT = 64;
constexpr int KV_TILE_BYTES = KVT * KSTR;
constexpr float LOG2E = 1.4426950408889634f, LN2F = 0.6931471805599453f;
DI f32x16 mfma32(bf16x8 a, bf16x8 b, f32x16 c) { return __builtin_amdgcn_mfma_f32_32x32x16_bf16(a, b, c, 0, 0, 0); }
DI f32x16 zero16() { f32x16 z; for (int i = 0; i < 16; ++i) z[i] = 0.f; return z; }
DI void kv_fetch(u32x4& kr, u32x4& vr, const bf16_t* kb, const bf16_t* vb, size_t rstride, int row0, int nrows, int tid) {
    asm volatile("" : "+v"(tid));
    const int row = row0 + (tid >> 3), c16 = tid & 7;
    if (row >= 0 && row < nrows) { kr = *(const u32x4*)(kb + (size_t)row * rstride + c16 * 8); vr = *(const u32x4*)(vb + (size_t)row * rstride + c16 * 8); }
    else { kr = (u32x4){0u, 0u, 0u, 0u}; vr = kr; }
}
DI void kv_store(LAS unsigned char* kl, LAS unsigned char* vl, const u32x4& kr, const u32x4& vr, int tid) {
    asm volatile("" : "+v"(tid));
    const int off = (tid >> 3) * KSTR + (tid & 7) * 16;
    *(LAS u32x4*)(kl + off) = kr; *(LAS u32x4*)(vl + off) = vr;
}
DI f32x16 qk_tile(const LAS unsigned char* kl, int kt, const bf16x8 (&Q)[4], int lane) {
    asm volatile("" : "+v"(lane));
    const int r = lane & 31, h = lane >> 5;
    const int pr = (r & ~12) | ((r & 4) << 1) | ((r & 8) >> 1);
    const LAS unsigned char* p = kl + (kt * 32 + pr) * KSTR + h * 16;
    f32x16 S = zero16();
#pragma unroll
    for (int ks = 0; ks < 4; ++ks) { const bf16x8 A = *(const LAS bf16x8*)(p + ks * 32); S = mfma32(A, Q[ks], S); }
    return S;
}
DI void pv_tile(const LAS unsigned char* vl, int kt, const f32x16& P, f32x16 (&O)[2], int lane) {
    asm volatile("" : "+v"(lane));
    const int i16 = lane & 15, q = i16 >> 2, p = i16 & 3, blk = (lane >> 4) & 1, h = lane >> 5;
#pragma unroll
    for (int s = 0; s < 2; ++s) {
        u32x4 pk; pk.x = cvt_pk_bf16(P[8 * s + 0], P[8 * s + 1]); pk.y = cvt_pk_bf16(P[8 * s + 2], P[8 * s + 3]); pk.z = cvt_pk_bf16(P[8 * s + 4], P[8 * s + 5]); pk.w = cvt_pk_bf16(P[8 * s + 6], P[8 * s + 7]);
        const bf16x8 Bp = __builtin_bit_cast(bf16x8, pk);
        const LAS unsigned char* vp = vl + (kt * 32 + 16 * s + 8 * h + q) * KSTR + (16 * blk + 4 * p) * 2;
#pragma unroll
        for (int dt = 0; dt < 2; ++dt) {
            const s16x4 lo = __builtin_amdgcn_ds_read_tr16_b64_v4i16((LAS s16x4*)(vp + dt * 64));
            const s16x4 hi = __builtin_amdgcn_ds_read_tr16_b64_v4i16((LAS s16x4*)(vp + dt * 64 + 4 * KSTR));
            const bf16x8 A = __builtin_shufflevector(lo, hi, 0, 1, 2, 3, 4, 5, 6, 7);
            O[dt] = mfma32(A, Bp, O[dt]);
        }
    }
}
DI void store_o(bf16_t* orow, const f32x16 (&O)[2], float sc, int h) {
#pragma unroll
    for (int dt = 0; dt < 2; ++dt)
#pragma unroll
        for (int g = 0; g < 4; ++g) { u32x2 w; w.x = cvt_pk_bf16(O[dt][4 * g] * sc, O[dt][4 * g + 1] * sc); w.y = cvt_pk_bf16(O[dt][4 * g + 2] * sc, O[dt][4 * g + 3] * sc);
            *(u32x2*)(orow + dt * 32 + 8 * g + 4 * h) = w; }
}

template <class F>
DI void softmax_tile(f32x16 (&S)[2], float& m, float& l, f32x16 (&O)[2], const F& f) {
    float mx = -1e30f;
#pragma unroll
    for (int sub = 0; sub < 2; ++sub)
#pragma unroll
        for (int i = 0; i < 16; ++i) { float bias = 0.f; const bool valid = f(sub, i, bias);
            const float sl = valid ? S[sub][i] * (0.125f * LOG2E) + bias : -1e30f; S[sub][i] = sl; mx = fmaxf(mx, sl); }
    mx = fmaxf(mx, __shfl_xor(mx, 32));
    const float mnew = fmaxf(m, mx), alpha = __builtin_amdgcn_exp2f(m - mnew), mm = (mnew <= -1e30f) ? 0.f : mnew;
    float ls = 0.f;
#pragma unroll
    for (int sub = 0; sub < 2; ++sub)
#pragma unroll
        for (int i = 0; i < 16; ++i) { const float p = __builtin_amdgcn_exp2f(S[sub][i] - mm); S[sub][i] = p; ls += p; }
    ls += __shfl_xor(ls, 32);
    l = l * alpha + ls; m = mnew;
#pragma unroll
    for (int dt = 0; dt < 2; ++dt)
#pragma unroll
        for (int i = 0; i < 16; ++i) O[dt][i] *= alpha;
}
constexpr size_t WS_BIASG = WS_SMALL + 256 * 1024;
DI void load_bias_table(LAS float* dst, const float* biasG, int head, int tid) {
    for (int i = tid; i < 2048 / 4; i += NTHR) *(LAS f32x4*)(dst + 4 * i) = *(const f32x4*)(biasG + head * 2048 + 4 * i);
}

constexpr size_t BIG_OG = 288 * MiB;
constexpr size_t BIG_LSE = 384 * MiB;
DI void dilated_phase(const Args& a, LAS unsigned char* lds) {
    int tid = tid_of(a.wv); asm volatile("" : "+v"(tid));
    const int lane = tid & 63, wave = __builtin_amdgcn_readfirstlane(tid >> 6), c = lane & 31, h = lane >> 5;
    const bf16_t* qkv = (const bf16_t*)(a.ws + WS_BIG);
    LAS unsigned char* kbuf = lds; LAS unsigned char* vbuf = lds + 2 * KV_TILE_BYTES;
    LAS float* btab = (LAS float*)(lds + 4 * KV_TILE_BYTES);
    const float* biasG = (const float*)(a.ws + WS_BIASG);
    for (int u = blockIdx.x; u < 3072; u += gridDim.x) {
        const int g = u >> 10, hh = (u >> 6) & 15, idx = u & 63;
        const int dsh = 2 * g, d = 1 << dsh;
        const int r = idx & (d - 1), blk = idx >> dsh;
        const int Q0 = blk * 256, q0w = Q0 + 32 * wave, iq = q0w + c;
        const int L = SEQ >> dsh;
        const bf16_t* qb = qkv + (size_t)r * 9216 + g * 3072 + hh * 64;
        const bf16_t* kb = qb + 1024; const bf16_t* vb = qb + 2048;
        const size_t rstride = (size_t)9216 << dsh;
        __syncthreads();
        load_bias_table(btab, biasG, hh, tid);
        bf16x8 Q[4];
        { const bf16_t* qrow = qb + (size_t)iq * rstride;
#pragma unroll
          for (int ks = 0; ks < 4; ++ks) Q[ks] = *(const bf16x8*)(qrow + 16 * ks + 8 * h); }
        f32x16 O[2]; O[0] = zero16(); O[1] = zero16();
        float m = -1e30f, l = 0.f;
        u32x4 kr, vr; int buf = 0;
        kv_fetch(kr, vr, kb, vb, rstride, Q0 - 128, L, tid); kv_store(kbuf, vbuf, kr, vr, tid);
        __syncthreads();
        for (int j = 0; j < 6; ++j) {
            if (j < 5) kv_fetch(kr, vr, kb, vb, rstride, Q0 - 128 + 64 * (j + 1), L, tid);
            const int kr0 = Q0 - 128 + 64 * j;
            if (kr0 <= q0w + 31 && kr0 + 63 >= q0w - 128 && kr0 + 63 >= 0) {
                const LAS unsigned char* kl = kbuf + buf * KV_TILE_BYTES; const LAS unsigned char* vl = vbuf + buf * KV_TILE_BYTES;
                f32x16 S[2]; S[0] = qk_tile(kl, 0, Q, lane); S[1] = qk_tile(kl, 1, Q, lane);
                softmax_tile(S, m, l, O, [&](int sub, int i, float& bias) { const int krow = kr0 + sub * 32 + 16 * (i >> 3) + 8 * h + (i & 7); const int steps = iq - krow;
                    const bool valid = steps >= 0 && steps <= 128 && krow >= 0; const int bi = min(max(steps, 0) << dsh, 2047); bias = btab[bi]; return valid; });
                pv_tile(vl, 0, S[0], O, lane); pv_tile(vl, 1, S[1], O, lane);
            }
            if (j < 5) kv_store(kbuf + (buf ^ 1) * KV_TILE_BYTES, vbuf + (buf ^ 1) * KV_TILE_BYTES, kr, vr, tid);
            __syncthreads();
            buf ^= 1;
        }
        const int tok = (iq << dsh) + r;
        bf16_t* og = (bf16_t*)(a.ws + WS_BIG + BIG_OG) + (size_t)g * SEQ * D;
        float* lse = (float*)(a.ws + WS_BIG + BIG_LSE) + (size_t)g * SEQ * 16;
        store_o(og + (size_t)tok * D + hh * 64, O, 1.f / l, h);
        if (h == 0) lse[tok * 16 + hh] = m + __builtin_amdgcn_logf(l);
    }
}
DI void dilated_merge(const Args& a, int b) {
    const int tid = tid_of(a.wv);
    const bf16_t* og = (const bf16_t*)(a.ws + WS_BIG + BIG_OG); const float* lse = (const float*)(a.ws + WS_BIG + BIG_LSE);
    bf16_t* outb = (bf16_t*)(a.ws + WS_ACTB) + (size_t)b * SEQ * D;
    for (int i = blockIdx.x * NTHR + tid; i < SEQ * 128; i += gridDim.x * NTHR) {
        const int tok = i >> 7, c8 = i & 127, hh = c8 >> 3;
        const float l0 = lse[tok * 16 + hh], l1 = lse[SEQ * 16 + tok * 16 + hh], l2 = lse[2 * SEQ * 16 + tok * 16 + hh];
        const float mx = fmaxf(l0, fmaxf(l1, l2));
        float w0 = __builtin_amdgcn_exp2f(l0 - mx), w1 = __builtin_amdgcn_exp2f(l1 - mx), w2 = __builtin_amdgcn_exp2f(l2 - mx);
        const float inv = 1.f / (w0 + w1 + w2); w0 *= inv; w1 *= inv; w2 *= inv;
        const u32x4 a0 = *(const u32x4*)(og + (size_t)tok * D + c8 * 8), a1 = *(const u32x4*)(og + (size_t)SEQ * D + (size_t)tok * D + c8 * 8), a2 = *(const u32x4*)(og + (size_t)2 * SEQ * D + (size_t)tok * D + c8 * 8);
        u32x4 o;
        o.x = pk2(w0 * bf_lo(a0.x) + w1 * bf_lo(a1.x) + w2 * bf_lo(a2.x), w0 * bf_hi(a0.x) + w1 * bf_hi(a1.x) + w2 * bf_hi(a2.x));
        o.y = pk2(w0 * bf_lo(a0.y) + w1 * bf_lo(a1.y) + w2 * bf_lo(a2.y), w0 * bf_hi(a0.y) + w1 * bf_hi(a1.y) + w2 * bf_hi(a2.y));
        o.z = pk2(w0 * bf_lo(a0.z) + w1 * bf_lo(a1.z) + w2 * bf_lo(a2.z), w0 * bf_hi(a0.z) + w1 * bf_hi(a1.z) + w2 * bf_hi(a2.z));
        o.w = pk2(w0 * bf_lo(a0.w) + w1 * bf_lo(a1.w) + w2 * bf_lo(a2.w), w0 * bf_hi(a0.w) + w1 * bf_hi(a1.w) + w2 * bf_hi(a2.w));
        *(u32x4*)(outb + (size_t)tok * D + c8 * 8) = o;
    }
}

constexpr size_t MB_KMEAN = WS_ACTB, MB_SELW = WS_ACTB + 1 * MiB, MB_LIST = WS_ACTB + 4 * MiB;
constexpr size_t BIG_OSEL = 192 * MiB, BIG_LSESEL = 384 * MiB;
constexpr int CW_MBCNT = 32768, CW_MBCUR = 32768 + 2048;
constexpr int MB_LISTCAP = 49152;
DI void moba_kmean_phase(const Args& a) {
    const int tid = tid_of(a.wv);
    const bf16_t* qkv = (const bf16_t*)(a.ws + WS_BIG);
    float* kmean = (float*)(a.ws + MB_KMEAN);
    for (int i = blockIdx.x * NTHR + tid; i < 2048 * 8; i += gridDim.x * NTHR) {
        const int c8 = i & 7, n = (i >> 3) & 63, bh = i >> 9, b = bh >> 4, hh = bh & 15;
        const bf16_t* kp = qkv + ((size_t)b * SEQ + n * 256) * 3072 + 1024 + hh * 64 + c8 * 8;
        float s[8];
#pragma unroll
        for (int j = 0; j < 8; ++j) s[j] = 0.f;
        for (int k = 0; k < 256; ++k) { const u32x4 v = *(const u32x4*)(kp + (size_t)k * 3072);
            s[0] += bf_lo(v.x); s[1] += bf_hi(v.x); s[2] += bf_lo(v.y); s[3] += bf_hi(v.y); s[4] += bf_lo(v.z); s[5] += bf_hi(v.z); s[6] += bf_lo(v.w); s[7] += bf_hi(v.w); }
#pragma unroll
        for (int j = 0; j < 8; ++j) kmean[((size_t)bh * 64 + n) * 64 + c8 * 8 + j] = s[j] * (1.f / 256.f);
    }
}
DI void moba_gate_phase(const Args& a, LAS unsigned char* lds) {
    int tid = tid_of(a.wv); asm volatile("" : "+v"(tid));
    const int lane = tid & 63, wave = __builtin_amdgcn_readfirstlane(tid >> 6), c = lane & 31, h = lane >> 5;
    const bf16_t* qkv = (const bf16_t*)(a.ws + WS_BIG);
    const float* kmean = (const float*)(a.ws + MB_KMEAN);
    unsigned* selw = (unsigned*)(a.ws + MB_SELW);
    unsigned* cnt = (unsigned*)(a.ws + WS_CTL) + CW_MBCNT;
    LAS unsigned char* khi = lds; LAS unsigned char* klo = lds + KV_TILE_BYTES;
    LAS int* hist = (LAS int*)(lds + 2 * KV_TILE_BYTES);
    for (int u = blockIdx.x; u < 2048; u += gridDim.x) {
        const int qb = u & 63, bh = u >> 6, b = bh >> 4, hh = bh & 15;
        const int t = qb * 256 + 32 * wave + c;
        __syncthreads();
        { const int row = tid >> 3, c16 = tid & 7; const float* kp = kmean + ((size_t)bh * 64 + row) * 64 + c16 * 8;
          const f32x4 v0 = *(const f32x4*)kp, v1 = *(const f32x4*)(kp + 4);
          float v[8] = {v0.x, v0.y, v0.z, v0.w, v1.x, v1.y, v1.z, v1.w}; unsigned hi[8], lo[8];
#pragma unroll
          for (int j = 0; j < 8; ++j) { hi[j] = f2bf(v[j]); lo[j] = f2bf(v[j] - u2f(hi[j] << 16)); }
          u32x4 wh, wl; wh.x = hi[0] | (hi[1] << 16); wh.y = hi[2] | (hi[3] << 16); wh.z = hi[4] | (hi[5] << 16); wh.w = hi[6] | (hi[7] << 16);
          wl.x = lo[0] | (lo[1] << 16); wl.y = lo[2] | (lo[3] << 16); wl.z = lo[4] | (lo[5] << 16); wl.w = lo[6] | (lo[7] << 16);
          kv_store(khi, klo, wh, wl, tid); }
        if (tid < 64) hist[tid] = 0;
        __syncthreads();
        bf16x8 Q[4];
        { const bf16_t* qrow = qkv + ((size_t)b * SEQ + t) * 3072 + hh * 64;
#pragma unroll
          for (int ks = 0; ks < 4; ++ks) Q[ks] = *(const bf16x8*)(qrow + 16 * ks + 8 * h); }
        f32x16 Gs[2];
#pragma unroll
        for (int sub = 0; sub < 2; ++sub) { const f32x16 a0 = qk_tile(khi, sub, Q, lane), a1 = qk_tile(klo, sub, Q, lane);
#pragma unroll
            for (int i = 0; i < 16; ++i) { const int n = sub * 32 + 16 * (i >> 3) + 8 * h + (i & 7); Gs[sub][i] = (n < qb) ? (a0[i] + a1[i]) : -1e30f; } }
        unsigned selpack = 0;
#pragma unroll
        for (int pass = 0; pass < 3; ++pass) {
            float bv = -3e38f; int bn = 64;
#pragma unroll
            for (int sub = 0; sub < 2; ++sub)
#pragma unroll
                for (int i = 0; i < 16; ++i) { const int n = sub * 32 + 16 * (i >> 3) + 8 * h + (i & 7); const float v = Gs[sub][i];
                    if (v > bv || (v == bv && n < bn)) { bv = v; bn = n; } }
            const float pv = __shfl_xor(bv, 32); const int pn = __shfl_xor(bn, 32);
            if (pv > bv || (pv == bv && pn < bn)) { bv = pv; bn = pn; }
            const bool ok = bv > -1e29f;
            selpack |= (ok ? (unsigned)bn : 255u) << (8 * pass);
            if (ok && h == 0) atomicAdd((int*)(hist + bn), 1);
#pragma unroll
            for (int sub = 0; sub < 2; ++sub)
#pragma unroll
                for (int i = 0; i < 16; ++i) { const int n = sub * 32 + 16 * (i >> 3) + 8 * h + (i & 7); if (n == bn) Gs[sub][i] = -3e38f; }
        }
        if (h == 0) selw[(size_t)bh * SEQ + t] = selpack;
        __syncthreads();
        if (tid < 64 && hist[tid] > 0) xb_add(cnt + bh * 64 + tid, (unsigned)hist[tid]);
    }
}
DI void moba_fill_phase(const Args& a, LAS unsigned char* lds) {
    const int tid = tid_of(a.wv);
    const unsigned* selw = (const unsigned*)(a.ws + MB_SELW);
    unsigned* cnt = (unsigned*)(a.ws + WS_CTL) + CW_MBCNT; unsigned* cur = (unsigned*)(a.ws + WS_CTL) + CW_MBCUR;
    unsigned* list = (unsigned*)(a.ws + MB_LIST);
    LAS int* hist = (LAS int*)lds; LAS int* gb = hist + 64; LAS int* off = gb + 64;
    for (int u = blockIdx.x; u < 2048; u += gridDim.x) {
        const int qb = u & 63, bh = u >> 6;
        __syncthreads();
        if (tid < 64) hist[tid] = 0;
        if (tid == 64) { int acc = 0; for (int n = 0; n < 64; ++n) { off[n] = acc; acc += (int)xb_ld(cnt + bh * 64 + n); } }
        __syncthreads();
        unsigned sp = 0xffffffffu; int lp[3] = {0, 0, 0};
        if (tid < 256) { sp = selw[(size_t)bh * SEQ + qb * 256 + tid];
#pragma unroll
            for (int k = 0; k < 3; ++k) { const unsigned n = (sp >> (8 * k)) & 255u; if (n < 64u) lp[k] = atomicAdd((int*)(hist + n), 1); } }
        __syncthreads();
        if (tid < 64 && hist[tid] > 0) gb[tid] = (int)xb_add(cur + bh * 64 + tid, (unsigned)hist[tid]);
        __syncthreads();
        if (tid < 256) {
#pragma unroll
            for (int k = 0; k < 3; ++k) { const unsigned n = (sp >> (8 * k)) & 255u;
                if (n < 64u) list[(size_t)bh * MB_LISTCAP + off[n] + gb[n] + lp[k]] = (unsigned)(qb * 256 + tid) | ((unsigned)k << 14); } }
    }
}
DI void moba_sel_phase(const Args& a, LAS unsigned char* lds) {
    int tid = tid_of(a.wv); asm volatile("" : "+v"(tid));
    const int lane = tid & 63, wave = __builtin_amdgcn_readfirstlane(tid >> 6), c = lane & 31, h = lane >> 5;
    const bf16_t* qkv = (const bf16_t*)(a.ws + WS_BIG);
    const unsigned* cnt = (const unsigned*)(a.ws + WS_CTL) + CW_MBCNT;
    const unsigned* list = (const unsigned*)(a.ws + MB_LIST);
    bf16_t* osel = (bf16_t*)(a.ws + WS_BIG + BIG_OSEL); float* lsesel = (float*)(a.ws + WS_BIG + BIG_LSESEL);
    const float* biasG = (const float*)(a.ws + WS_BIASG);
    LAS unsigned char* kbuf = lds; LAS unsigned char* vbuf = lds + 2 * KV_TILE_BYTES;
    LAS float* btab = (LAS float*)(lds + 4 * KV_TILE_BYTES);
    LAS int* cs = (LAS int*)(lds + 4 * KV_TILE_BYTES + 8192);
    LAS int* eo = cs + 2052;
    LAS int* part = eo + 2052;
    { int cc[4], ee[4], sc = 0, se = 0;
#pragma unroll
      for (int j = 0; j < 4; ++j) { const int v = (int)xb_ld((unsigned*)cnt + tid * 4 + j); ee[j] = se; cc[j] = sc; se += v; sc += (v + 255) >> 8; }
      part[tid] = sc; part[512 + tid] = se;
      __syncthreads();
      if (tid == 0) { int a0 = 0, a1 = 0; for (int i = 0; i < 512; ++i) { const int v0 = part[i], v1 = part[512 + i]; part[i] = a0; part[512 + i] = a1; a0 += v0; a1 += v1; } cs[2048] = a0; eo[2048] = a1; }
      __syncthreads();
#pragma unroll
      for (int j = 0; j < 4; ++j) { cs[tid * 4 + j] = part[tid] + cc[j]; eo[tid * 4 + j] = part[512 + tid] + ee[j]; }
      __syncthreads(); }
    const int NC = cs[2048];
    int cur_hh = -1;
    for (int u = blockIdx.x; u < NC; u += gridDim.x) {
        int lo = 0, hi = 2047;
        while (lo < hi) { const int mid = (lo + hi + 1) >> 1; if (cs[mid] <= u) lo = mid; else hi = mid - 1; }
        const int item = lo, bh = item >> 6, n = item & 63, b = bh >> 4, hh = bh & 15;
        const int chunk = u - cs[item], nent = (int)xb_ld((unsigned*)cnt + item) - chunk * 256;
        const size_t ebase = (size_t)bh * MB_LISTCAP + (eo[item] - eo[bh * 64]) + chunk * 256;
        __syncthreads();
        if (hh != cur_hh) { load_bias_table(btab, biasG, hh, tid); cur_hh = hh; }
        const int e = 32 * wave + c; const bool ev = e < nent;
        const unsigned ent = list[ebase + (ev ? e : 0)];
        const int t = ent & 16383, slot = ent >> 14;
        bf16x8 Q[4];
        { const bf16_t* qrow = qkv + ((size_t)b * SEQ + t) * 3072 + hh * 64;
#pragma unroll
          for (int ks = 0; ks < 4; ++ks) Q[ks] = *(const bf16x8*)(qrow + 16 * ks + 8 * h); }
        const bf16_t* kb = qkv + (size_t)b * SEQ * 3072 + 1024 + hh * 64; const bf16_t* vb = kb + 1024;
        f32x16 O[2]; O[0] = zero16(); O[1] = zero16();
        float m = -1e30f, l = 0.f;
        u32x4 kr, vr; int buf = 0;
        kv_fetch(kr, vr, kb, vb, 3072, n * 256, SEQ, tid); kv_store(kbuf, vbuf, kr, vr, tid);
        __syncthreads();
        for (int j = 0; j < 4; ++j) {
            if (j < 3) kv_fetch(kr, vr, kb, vb, 3072, n * 256 + 64 * (j + 1), SEQ, tid);
            const int k0 = n * 256 + 64 * j;
            if (32 * wave < nent) {
                const LAS unsigned char* kl = kbuf + buf * KV_TILE_BYTES; const LAS unsigned char* vl = vbuf + buf * KV_TILE_BYTES;
                f32x16 S[2]; S[0] = qk_tile(kl, 0, Q, lane); S[1] = qk_tile(kl, 1, Q, lane);
                softmax_tile(S, m, l, O, [&](int sub, int i, float& bias) { const int key = k0 + sub * 32 + 16 * (i >> 3) + 8 * h + (i & 7);
                    bias = btab[min(max(t - key, 0), 2047)]; return true; });
                pv_tile(vl, 0, S[0], O, lane); pv_tile(vl, 1, S[1], O, lane);
            }
            if (j < 3) kv_store(kbuf + (buf ^ 1) * KV_TILE_BYTES, vbuf + (buf ^ 1) * KV_TILE_BYTES, kr, vr, tid);
            __syncthreads();
            buf ^= 1;
        }
        if (ev) { const size_t ob = ((size_t)bh * SEQ + t) * 3 + slot;
            store_o(osel + ob * 64, O, 1.f / l, h);
            if (h == 0) lsesel[ob] = m + __builtin_amdgcn_logf(l); }
    }
}
DI void moba_own_phase(const Args& a, LAS unsigned char* lds) {
    int tid = tid_of(a.wv); asm volatile("" : "+v"(tid));
    const int lane = tid & 63, wave = __builtin_amdgcn_readfirstlane(tid >> 6), c = lane & 31, h = lane >> 5;
    const bf16_t* qkv = (const bf16_t*)(a.ws + WS_BIG);
    const bf16_t* osel = (const bf16_t*)(a.ws + WS_BIG + BIG_OSEL); const float* lsesel = (const float*)(a.ws + WS_BIG + BIG_LSESEL);
    bf16_t* outb = (bf16_t*)(a.ws + WS_ACTB);
    const float* biasG = (const float*)(a.ws + WS_BIASG);
    LAS unsigned char* kbuf = lds; LAS unsigned char* vbuf = lds + 2 * KV_TILE_BYTES;
    LAS float* btab = (LAS float*)(lds + 4 * KV_TILE_BYTES);
    int cur_hh = -1;
    for (int u = blockIdx.x; u < 2048; u += gridDim.x) {
        const int qb = u & 63, bh = u >> 6, b = bh >> 4, hh = bh & 15;
        const int q0w = qb * 256 + 32 * wave, t = q0w + c;
        __syncthreads();
        if (hh != cur_hh) { load_bias_table(btab, biasG, hh, tid); cur_hh = hh; }
        bf16x8 Q[4];
        { const bf16_t* qrow = qkv + ((size_t)b * SEQ + t) * 3072 + hh * 64;
#pragma unroll
          for (int ks = 0; ks < 4; ++ks) Q[ks] = *(const bf16x8*)(qrow + 16 * ks + 8 * h); }
        const bf16_t* kb = qkv + (size_t)b * SEQ * 3072 + 1024 + hh * 64; const bf16_t* vb = kb + 1024;
        f32x16 O[2]; O[0] = zero16(); O[1] = zero16();
        float m = -1e30f, l = 0.f;
        u32x4 kr, vr; int buf = 0;
        kv_fetch(kr, vr, kb, vb, 3072, qb * 256, SEQ, tid); kv_store(kbuf, vbuf, kr, vr, tid);
        __syncthreads();
        for (int j = 0; j < 4; ++j) {
            if (j < 3) kv_fetch(kr, vr, kb, vb, 3072, qb * 256 + 64 * (j + 1), SEQ, tid);
            const int k0 = qb * 256 + 64 * j;
            if (k0 <= q0w + 31) {
                const LAS unsigned char* kl = kbuf + buf * KV_TILE_BYTES; const LAS unsigned char* vl = vbuf + buf * KV_TILE_BYTES;
                f32x16 S[2]; S[0] = qk_tile(kl, 0, Q, lane); S[1] = qk_tile(kl, 1, Q, lane);
                softmax_tile(S, m, l, O, [&](int sub, int i, float& bias) { const int key = k0 + sub * 32 + 16 * (i >> 3) + 8 * h + (i & 7); const int dist = t - key;
                    bias = btab[min(max(dist, 0), 2047)]; return dist >= 0; });
                pv_tile(vl, 0, S[0], O, lane); pv_tile(vl, 1, S[1], O, lane);
            }
            if (j < 3) kv_store(kbuf + (buf ^ 1) * KV_TILE_BYTES, vbuf + (buf ^ 1) * KV_TILE_BYTES, kr, vr, tid);
            __syncthreads();
            buf ^= 1;
        }
        const int nv = qb < 3 ? qb : 3;
        const float lown = m + __builtin_amdgcn_logf(l);
        float ls[3]; float mx = lown;
        const size_t ob = ((size_t)bh * SEQ + t) * 3;
#pragma unroll
        for (int k = 0; k < 3; ++k) { ls[k] = (k < nv) ? lsesel[ob + k] : -1e30f; mx = fmaxf(mx, ls[k]); }
        float wown = __builtin_amdgcn_exp2f(lown - mx), wsum = wown, wk[3];
#pragma unroll
        for (int k = 0; k < 3; ++k) { wk[k] = (k < nv) ? __builtin_amdgcn_exp2f(ls[k] - mx) : 0.f; wsum += wk[k]; }
        const float inv = 1.f / wsum; wown *= inv / l;
#pragma unroll
        for (int dt = 0; dt < 2; ++dt)
#pragma unroll
            for (int i = 0; i < 16; ++i) O[dt][i] *= wown;
#pragma unroll
        for (int k = 0; k < 3; ++k) if (k < nv) { const float w = wk[k] * inv; const bf16_t* orow = osel + (ob + k) * 64;
#pragma unroll
            for (int dt = 0; dt < 2; ++dt)
#pragma unroll
                for (int g = 0; g < 4; ++g) { const u32x2 v = *(const u32x2*)(orow + dt * 32 + 8 * g + 4 * h);
                    O[dt][4 * g] += w * bf_lo(v.x); O[dt][4 * g + 1] += w * bf_hi(v.x); O[dt][4 * g + 2] += w * bf_lo(v.y); O[dt][4 * g + 3] += w * bf_hi(v.y); } }
        store_o(outb + ((size_t)b * SEQ + t) * D + hh * 64, O, 1.f, h);
    }
}

constexpr size_t NS_Q = 0, NS_KV = 64 * MiB, NS_GT = 164 * MiB, NS_HID = 172 * MiB, NS_KC = 180 * MiB;
DI void nsa_kcvc_phase(const Args& a) {
    int tid = tid_of(a.wv); asm volatile("" : "+v"(tid));
    const int lane = tid & 63, wave = __builtin_amdgcn_readfirstlane(tid >> 6), c = lane & 31, h = lane >> 5;
    const bf16_t* hidden = (const bf16_t*)(a.ws + WS_BIG + NS_HID); const bf16_t* w2t = (const bf16_t*)(a.ws + WS_WCMP) + 2 * 256 * 2048;
    bf16_t* kcvc = (bf16_t*)(a.ws + WS_BIG + NS_KC);
    for (int task = blockIdx.x * NWAVES + wave; task < 512; task += gridDim.x * NWAVES) {
        const int j = task >> 8, R0 = (task & 255) * 32;
        const bf16_t* hid = hidden + ((size_t)j * 8192 + R0 + c) * 256; const bf16_t* w2 = w2t + j * 64 * 256;
        f32x16 acc[2]; acc[0] = zero16(); acc[1] = zero16();
#pragma unroll
        for (int ks = 0; ks < 16; ++ks) { const bf16x8 Bv = *(const bf16x8*)(hid + 16 * ks + 8 * h);
#pragma unroll
            for (int dt = 0; dt < 2; ++dt) { const bf16x8 Av = *(const bf16x8*)(w2 + (dt * 32 + c) * 256 + 16 * ks + 8 * h); acc[dt] = mfma32(Av, Bv, acc[dt]); } }
        store_o(kcvc + ((size_t)j * 8192 + R0 + c) * 64, acc, 1.f, h);
    }
}
template <class F>
DI void stats_tile(f32x16 (&sl)[2], float& m, float& l, const F& f) {
    float mx = -1e30f;
#pragma unroll
    for (int sub = 0; sub < 2; ++sub)
#pragma unroll
        for (int i = 0; i < 16; ++i) { float bias = 0.f; const bool valid = f(sub, i, bias); sl[sub][i] = valid ? sl[sub][i] * (0.125f * LOG2E) + bias : -1e30f; mx = fmaxf(mx, sl[sub][i]); }
    mx = fmaxf(mx, __shfl_xor(mx, 32));
    const float mnew = fmaxf(m, mx), mm = (mnew <= -1e30f) ? 0.f : mnew;
    float ls = 0.f;
#pragma unroll
    for (int sub = 0; sub < 2; ++sub)
#pragma unroll
        for (int i = 0; i < 16; ++i) ls += __builtin_amdgcn_exp2f(sl[sub][i] - mm);
    ls += __shfl_xor(ls, 32);
    l = l * __builtin_amdgcn_exp2f(m - mnew) + ls; m = mnew;
}
DI void nsa_attn_phase(const Args& a, LAS unsigned char* lds) {
    int tid = tid_of(a.wv); asm volatile("" : "+v"(tid));
    const int lane = tid & 63, wave = __builtin_amdgcn_readfirstlane(tid >> 6), c = lane & 31, h = lane >> 5, qi = c >> 2, r = c & 3;
    const bf16_t* qb_ = (const bf16_t*)(a.ws + WS_BIG + NS_Q); const bf16_t* kv6 = (const bf16_t*)(a.ws + WS_BIG + NS_KV);
    const float* gates = (const float*)(a.ws + WS_BIG + NS_GT); const bf16_t* kcvc = (const bf16_t*)(a.ws + WS_BIG + NS_KC);
    bf16_t* outb = (bf16_t*)(a.ws + WS_ACTB); const float* biasG = (const float*)(a.ws + WS_BIASG);
    LAS unsigned char* kbuf = lds; LAS unsigned char* vbuf = lds + 2 * KV_TILE_BYTES;
    LAS float* btab = (LAS float*)(lds + 36864);
    LAS float* imp = (LAS float*)(lds + 69632);
    LAS unsigned* selm = (LAS unsigned*)(lds + 136192);
    LAS unsigned* wm = selm + 512;
    LAS int* blist = (LAS int*)(wm + 64);
    int cur_g = -1;
    for (int k = 0;; ++k) {
        const int u = blockIdx.x + k * gridDim.x; if (u >= 2048) break;
        const int bg = u >> 8, ti = u & 255, tile = (k & 1) ? 255 - ti : ti, b = bg >> 2, g = bg & 3;
        const int T0 = tile * 64, tw0 = T0 + 8 * wave, t = tw0 + qi;
        const size_t tokbase = (size_t)b * SEQ;
        __syncthreads();
        if (g != cur_g) { for (int i = tid; i < 2048; i += NTHR) *(LAS f32x4*)(btab + 4 * i) = *(const f32x4*)(biasG + (size_t)(4 * g) * 2048 + 4 * i); cur_g = g; }
        for (int i = tid; i < 64 * 260; i += NTHR) imp[i] = 0.f;
        bf16x8 Q[4];
        { const bf16_t* qrow = qb_ + (tokbase + t) * 1024 + (4 * g + r) * 64;
#pragma unroll
          for (int ks = 0; ks < 4; ++ks) Q[ks] = *(const bf16x8*)(qrow + 16 * ks + 8 * h); }
        const float* gtp = gates + (tokbase + t) * 48 + 4 * g + r;
        const float gt_cmp = gtp[0], gt_sel = gtp[16], gt_win = gtp[32];
        const LAS float* bt = btab + r * 2048;
        f32x16 OUT[2]; OUT[0] = zero16(); OUT[1] = zero16();
        u32x4 kr, vr; int buf = 0;
        const int nct = (T0 + 63 >= 31) ? (((T0 + 32) >> 4) >> 6) + 1 : 0;
        const bf16_t* kcb = kcvc + (size_t)bg * 1024 * 64; const bf16_t* vcb = kcb + (size_t)8192 * 64;
        float mc = -1e30f, lc = 0.f;
        if (nct > 0) {
            kv_fetch(kr, vr, kcb, vcb, 64, 0, 1024, tid); kv_store(kbuf + buf * KV_TILE_BYTES, vbuf + buf * KV_TILE_BYTES, kr, vr, tid);
            __syncthreads();
            for (int j = 0; j < nct; ++j) {
                if (j + 1 < nct) kv_fetch(kr, vr, kcb, vcb, 64, 64 * (j + 1), 1024, tid);
                const int c0 = 64 * j;
                if (16 * c0 + 31 <= tw0 + 7) {
                    const LAS unsigned char* kl = kbuf + buf * KV_TILE_BYTES;
                    f32x16 S[2]; S[0] = qk_tile(kl, 0, Q, lane); S[1] = qk_tile(kl, 1, Q, lane);
                    stats_tile(S, mc, lc, [&](int sub, int i, float& bias) { const int cc = c0 + sub * 32 + 16 * (i >> 3) + 8 * h + (i & 7); const int dist = t - 16 * cc - 31;
                        bias = bt[min(max(dist, 0), 2047)]; return dist >= 0; });
                }
                if (j + 1 < nct) kv_store(kbuf + (buf ^ 1) * KV_TILE_BYTES, vbuf + (buf ^ 1) * KV_TILE_BYTES, kr, vr, tid);
                __syncthreads();
                buf ^= 1;
            }
            const float invl = lc > 0.f ? 1.f / lc : 0.f, mfin = (mc <= -1e30f) ? 0.f : mc;
            f32x16 Oc[2]; Oc[0] = zero16(); Oc[1] = zero16();
            kv_fetch(kr, vr, kcb, vcb, 64, 0, 1024, tid); kv_store(kbuf + buf * KV_TILE_BYTES, vbuf + buf * KV_TILE_BYTES, kr, vr, tid);
            __syncthreads();
            for (int j = 0; j < nct; ++j) {
                if (j + 1 < nct) kv_fetch(kr, vr, kcb, vcb, 64, 64 * (j + 1), 1024, tid);
                const int c0 = 64 * j;
                if (16 * c0 + 31 <= tw0 + 7) {
                    const LAS unsigned char* kl = kbuf + buf * KV_TILE_BYTES; const LAS unsigned char* vl = vbuf + buf * KV_TILE_BYTES;
                    f32x16 S[2]; S[0] = qk_tile(kl, 0, Q, lane); S[1] = qk_tile(kl, 1, Q, lane);
#pragma unroll
                    for (int sub = 0; sub < 2; ++sub)
#pragma unroll
                        for (int i = 0; i < 16; ++i) { const int cc = c0 + sub * 32 + 16 * (i >> 3) + 8 * h + (i & 7); const int dist = t - 16 * cc - 31;
                            const float sl = S[sub][i] * (0.125f * LOG2E) + bt[min(max(dist, 0), 2047)];
                            S[sub][i] = (dist >= 0) ? __builtin_amdgcn_exp2f(sl - mfin) * invl : 0.f; }
#pragma unroll
                    for (int sub = 0; sub < 2; ++sub)
#pragma unroll
                        for (int s = 0; s < 2; ++s) { const int j0 = (c0 + sub * 32 + 16 * s + 8 * h) >> 2;
                            float a0 = (S[sub][8 * s] + S[sub][8 * s + 1]) + (S[sub][8 * s + 2] + S[sub][8 * s + 3]);
                            float a1 = (S[sub][8 * s + 4] + S[sub][8 * s + 5]) + (S[sub][8 * s + 6] + S[sub][8 * s + 7]) + S[sub][8 * s + 3];
                            float a2 = S[sub][8 * s + 7];
                            a0 += __shfl_xor(a0, 1); a1 += __shfl_xor(a1, 1); a2 += __shfl_xor(a2, 1);
                            a0 += __shfl_xor(a0, 2); a1 += __shfl_xor(a1, 2); a2 += __shfl_xor(a2, 2);
                            if (r == 0) { LAS float* ip = imp + (8 * wave + qi) * 260 + j0; atomicAdd((float*)ip, a0); atomicAdd((float*)(ip + 1), a1); atomicAdd((float*)(ip + 2), a2); } }
                    pv_tile(vl, 0, S[0], Oc, lane); pv_tile(vl, 1, S[1], Oc, lane);
                }
                if (j + 1 < nct) kv_store(kbuf + (buf ^ 1) * KV_TILE_BYTES, vbuf + (buf ^ 1) * KV_TILE_BYTES, kr, vr, tid);
                __syncthreads();
                buf ^= 1;
            }
#pragma unroll
            for (int dt = 0; dt < 2; ++dt)
#pragma unroll
                for (int i = 0; i < 16; ++i) OUT[dt][i] += gt_cmp * Oc[dt][i];
        }
        __syncthreads();
        for (int qq = 0; qq < 8; ++qq) {
            const int ql = 8 * wave + qq, tq = T0 + ql, cur = tq >> 6;
            float sc[4]; unsigned selbits = 0;
#pragma unroll
            for (int kk = 0; kk < 4; ++kk) { const int j = lane + 64 * kk; const bool forced = (j == 0) || (j == cur) || (j + 1 == cur);
                sc[kk] = forced ? 1e9f : ((j <= cur) ? imp[ql * 260 + j] : -1e30f); }
            for (int round = 0; round < 16; ++round) {
                float bv = sc[0]; int bj = lane;
#pragma unroll
                for (int kk = 1; kk < 4; ++kk) if (sc[kk] > bv) { bv = sc[kk]; bj = lane + 64 * kk; }
#pragma unroll
                for (int off = 1; off < 64; off <<= 1) { const float ov = __shfl_xor(bv, off); const int oj = __shfl_xor(bj, off); if (ov > bv || (ov == bv && oj < bj)) { bv = ov; bj = oj; } }
                if (!(bv > -1e29f)) break;
#pragma unroll
                for (int kk = 0; kk < 4; ++kk) if (bj == lane + 64 * kk) { sc[kk] = -3e38f; selbits |= 1u << kk; }
            }
#pragma unroll
            for (int kk = 0; kk < 4; ++kk) { const unsigned long long bal = __ballot((selbits >> kk) & 1u);
                if (lane == 0) { selm[ql * 8 + 2 * kk] = (unsigned)bal; selm[ql * 8 + 2 * kk + 1] = (unsigned)(bal >> 32); } }
        }
        __syncthreads();
        if (tid < 64) { unsigned o = 0; for (int q = 0; q < 8; ++q) o |= selm[((tid >> 3) * 8 + q) * 8 + (tid & 7)]; wm[tid] = o; }
        __syncthreads();
        if (tid < 64) {
            int pos = 0;
            for (int kk = 0; kk < 4; ++kk) { const int j = lane + 64 * kk; unsigned o = 0;
                for (int w = 0; w < 8; ++w) o |= wm[w * 8 + (j >> 5)];
                const bool need = (o >> (j & 31)) & 1u; const unsigned long long bal = __ballot(need);
                if (need) blist[1 + pos + __popcll(bal & ((1ull << lane) - 1ull))] = j;
                pos += __popcll(bal); }
            if (lane == 0) blist[0] = pos;
        }
        __syncthreads();
        {
            const int nb = blist[0];
            const bf16_t* ksb = kv6 + tokbase * 1536 + 2 * 256 + g * 64; const bf16_t* vsb = ksb + 256;
            f32x16 O[2]; O[0] = zero16(); O[1] = zero16(); float m = -1e30f, l = 0.f;
            kv_fetch(kr, vr, ksb, vsb, 1536, blist[1] * 64, SEQ, tid); kv_store(kbuf + buf * KV_TILE_BYTES, vbuf + buf * KV_TILE_BYTES, kr, vr, tid);
            __syncthreads();
            for (int jj = 0; jj < nb; ++jj) {
                const int j = blist[1 + jj];
                if (jj + 1 < nb) kv_fetch(kr, vr, ksb, vsb, 1536, blist[2 + jj] * 64, SEQ, tid);
                if ((wm[wave * 8 + (j >> 5)] >> (j & 31)) & 1u) {
                    const LAS unsigned char* kl = kbuf + buf * KV_TILE_BYTES; const LAS unsigned char* vl = vbuf + buf * KV_TILE_BYTES;
                    const bool mine = (selm[(8 * wave + qi) * 8 + (j >> 5)] >> (j & 31)) & 1u;
                    const int k0 = j * 64;
                    f32x16 S[2]; S[0] = qk_tile(kl, 0, Q, lane); S[1] = qk_tile(kl, 1, Q, lane);
                    softmax_tile(S, m, l, O, [&](int sub, int i, float& bias) { const int key = k0 + sub * 32 + 16 * (i >> 3) + 8 * h + (i & 7); const int dist = t - key;
                        bias = bt[min(max(dist, 0), 2047)]; return mine && dist >= 0; });
                    pv_tile(vl, 0, S[0], O, lane); pv_tile(vl, 1, S[1], O, lane);
                }
                if (jj + 1 < nb) kv_store(kbuf + (buf ^ 1) * KV_TILE_BYTES, vbuf + (buf ^ 1) * KV_TILE_BYTES, kr, vr, tid);
                __syncthreads();
                buf ^= 1;
            }
            const float sc_ = gt_sel / l;
#pragma unroll
            for (int dt = 0; dt < 2; ++dt)
#pragma unroll
                for (int i = 0; i < 16; ++i) OUT[dt][i] += sc_ * O[dt][i];
        }
        {
            const int j0w = (T0 >= 511) ? ((T0 - 511) >> 6) : 0, j1w = tile;
            const bf16_t* kwb = kv6 + tokbase * 1536 + 4 * 256 + g * 64; const bf16_t* vwb = kwb + 256;
            f32x16 O[2]; O[0] = zero16(); O[1] = zero16(); float m = -1e30f, l = 0.f;
            kv_fetch(kr, vr, kwb, vwb, 1536, j0w * 64, SEQ, tid); kv_store(kbuf + buf * KV_TILE_BYTES, vbuf + buf * KV_TILE_BYTES, kr, vr, tid);
            __syncthreads();
            for (int j = j0w; j <= j1w; ++j) {
                if (j < j1w) kv_fetch(kr, vr, kwb, vwb, 1536, (j + 1) * 64, SEQ, tid);
                const int k0 = j * 64;
                if (k0 <= tw0 + 7 && k0 + 63 >= tw0 - 511) {
                    const LAS unsigned char* kl = kbuf + buf * KV_TILE_BYTES; const LAS unsigned char* vl = vbuf + buf * KV_TILE_BYTES;
                    f32x16 S[2]; S[0] = qk_tile(kl, 0, Q, lane); S[1] = qk_tile(kl, 1, Q, lane);
                    softmax_tile(S, m, l, O, [&](int sub, int i, float& bias) { const int key = k0 + sub * 32 + 16 * (i >> 3) + 8 * h + (i & 7); const int dist = t - key;
                        bias = bt[min(max(dist, 0), 2047)]; return dist >= 0 && dist < 512; });
                    pv_tile(vl, 0, S[0], O, lane); pv_tile(vl, 1, S[1], O, lane);
                }
                if (j < j1w) kv_store(kbuf + (buf ^ 1) * KV_TILE_BYTES, vbuf + (buf ^ 1) * KV_TILE_BYTES, kr, vr, tid);
                __syncthreads();
                buf ^= 1;
            }
            const float sc_ = gt_win / l;
#pragma unroll
            for (int dt = 0; dt < 2; ++dt)
#pragma unroll
                for (int i = 0; i < 16; ++i) OUT[dt][i] += sc_ * O[dt][i];
        }
        store_o(outb + (tokbase + t) * D + (4 * g + r) * 64, OUT, 1.f, h);
    }
}

DI void sb_phase(const Args& a, LAS unsigned char* lds) {
    int tid = tid_of(a.wv); asm volatile("" : "+v"(tid));
    const int lane = tid & 63, wave = __builtin_amdgcn_readfirstlane(tid >> 6), c = lane & 31, h = lane >> 5;
    const bf16_t* qkv = (const bf16_t*)(a.ws + WS_BIG);
    bf16_t* outb = (bf16_t*)(a.ws + WS_ACTB);
    LAS unsigned char* kbuf = lds; LAS unsigned char* vbuf = lds + 2 * KV_TILE_BYTES;
    volatile LAS int* flags = (volatile LAS int*)(lds + 4 * KV_TILE_BYTES);
    for (int u = blockIdx.x; u < 2048; u += gridDim.x) {
        const int qb = u & 63, hh = (u >> 6) & 15, b = u >> 10;
        const int q0w = qb * 256 + 32 * wave, t = q0w + c;
        const size_t tokbase = (size_t)b * SEQ;
        const bf16_t* kb = qkv + tokbase * 3072 + 1024 + hh * 64;
        const bf16_t* vb = qkv + tokbase * 3072 + 2048 + hh * 64;
        bf16x8 Q[4];
        { const bf16_t* qrow = qkv + (tokbase + t) * 3072 + hh * 64;
#pragma unroll
          for (int ks = 0; ks < 4; ++ks) Q[ks] = *(const bf16x8*)(qrow + 16 * ks + 8 * h); }
        f32x16 O[2]; O[0] = zero16(); O[1] = zero16();
        float rsum = 0.f; bool wdone = false;
        int jt = qb * 4 + 3, buf = 0;
        u32x4 kr, vr;
        kv_fetch(kr, vr, kb, vb, 3072, jt * 64, SEQ, tid); kv_store(kbuf, vbuf, kr, vr, tid);
        __syncthreads();
        for (; jt >= 0; --jt) {
            if (jt > 0) kv_fetch(kr, vr, kb, vb, 3072, (jt - 1) * 64, SEQ, tid);
            const int kb0 = jt * 64;
            if (!wdone && kb0 < q0w + 31) {
                const LAS unsigned char* kl = kbuf + buf * KV_TILE_BYTES; const LAS unsigned char* vl = vbuf + buf * KV_TILE_BYTES;
                f32x16 Z[2], SP[2];
                Z[0] = qk_tile(kl, 0, Q, lane); Z[1] = qk_tile(kl, 1, Q, lane);
                float Tc[2][2];
#pragma unroll
                for (int sub = 0; sub < 2; ++sub)
#pragma unroll
                    for (int s = 0; s < 2; ++s) { float acc = 0.f;
#pragma unroll
                        for (int j = 0; j < 8; ++j) { const int i = 8 * s + j; const int key = kb0 + sub * 32 + 16 * s + 8 * h + j;
                            const float z = fminf(fmaxf(Z[sub][i] * 0.125f, -60.f), 60.f);
                            const float e = __builtin_amdgcn_exp2f(z * LOG2E);
                            const float sp = (key < t) ? __builtin_amdgcn_logf(1.f + e) * LN2F : 0.f;
                            Z[sub][i] = z; SP[sub][i] = sp; acc += sp; }
                        Tc[sub][s] = acc; }
                float Tp[2][2], pr[2][2];
#pragma unroll
                for (int sub = 0; sub < 2; ++sub)
#pragma unroll
                    for (int s = 0; s < 2; ++s) { Tp[sub][s] = __shfl_xor(Tc[sub][s], 32); pr[sub][s] = Tc[sub][s] + Tp[sub][s]; }
                float offp[2][2];
                offp[1][1] = rsum; offp[1][0] = offp[1][1] + pr[1][1]; offp[0][1] = offp[1][0] + pr[1][0]; offp[0][0] = offp[0][1] + pr[0][1];
                rsum = offp[0][0] + pr[0][0];
#pragma unroll
                for (int sub = 0; sub < 2; ++sub)
#pragma unroll
                    for (int s = 0; s < 2; ++s) { float run = offp[sub][s] + (h == 0 ? Tp[sub][s] : 0.f);
#pragma unroll
                        for (int j = 7; j >= 0; --j) { const int i = 8 * s + j; const int key = kb0 + sub * 32 + 16 * s + 8 * h + j;
                            run += SP[sub][i];
                            SP[sub][i] = (key < t) ? __builtin_amdgcn_exp2f((Z[sub][i] - run) * LOG2E) : 0.f; } }
                pv_tile(vl, 0, SP[0], O, lane); pv_tile(vl, 1, SP[1], O, lane);
                wdone = __all(rsum > 110.f);
            }
            if (lane == 0) flags[buf * 8 + wave] = wdone ? 1 : 0;
            if (jt > 0) kv_store(kbuf + (buf ^ 1) * KV_TILE_BYTES, vbuf + (buf ^ 1) * KV_TILE_BYTES, kr, vr, tid);
            __syncthreads();
            int alld = 1;
#pragma unroll
            for (int w = 0; w < 8; ++w) alld &= flags[buf * 8 + w];
            buf ^= 1;
            if (alld) break;
        }
        store_o(outb + (tokbase + t) * D + hh * 64, O, 1.f, h);
        __syncthreads();
    }
}

#ifndef DBG
#define DBG 0
#endif
#if DBG
DI float dbg_block_max(float v, LAS float* red) {
#pragma unroll
    for (int o = 1; o < 64; o <<= 1) v = fmaxf(v, __shfl_xor(v, o));
    __syncthreads();
    if ((threadIdx.x & 63) == 0) red[threadIdx.x >> 6] = v;
    __syncthreads();
    float r = red[0];
    for (int i = 1; i < 8; ++i) r = fmaxf(r, red[i]);
    __syncthreads();
    return r;
}
DI float dbg_block_sum(float v, LAS float* red) {
#pragma unroll
    for (int o = 1; o < 64; o <<= 1) v += __shfl_xor(v, o);
    __syncthreads();
    if ((threadIdx.x & 63) == 0) red[threadIdx.x >> 6] = v;
    __syncthreads();
    float r = 0.f;
    for (int i = 0; i < 8; ++i) r += red[i];
    __syncthreads();
    return r;
}
DI void dbg_note(unsigned* ctl, int idx, float err) { if (threadIdx.x == 0) atomicMax(ctl + CW_DBG + idx, __builtin_bit_cast(unsigned, err)); }
template <int layer>
DI void dbg_check(const Args& a, LAS unsigned char* lds, int stage, const MoeMeta& mm) {
    if (blockIdx.x >= 64) return;
    const int tid = threadIdx.x;
    const int t = blockIdx.x * 512 + (blockIdx.x * 37) % 512;
    LAS float* x1 = (LAS float*)(lds);
    LAS float* hh = x1 + 1024;
    LAS float* yy = hh + 512;
    LAS float* red = yy + 2048;
    LAS float* scl = red + 16;
    unsigned* ctl = (unsigned*)(a.ws + WS_CTL);
    float* dbgx1 = (float*)(a.ws + WS_SMALL) + blockIdx.x * 1024;
    const float* xout = a.out; const bf16_t* actb = (const bf16_t*)(a.ws + WS_ACTB);
    const u32x4 ti = *(const u32x4*)(a.ws + WS_TOKINFO + (size_t)t * 16);
    const int e0 = ti.x & 15, p0 = ti.x >> 4, e1 = ti.z & 15, p1 = ti.z >> 4;
    const float w0 = u2f(ti.y), w1 = u2f(ti.w);
    __syncthreads();
    if (tid == 0) { scl[16] = w0; scl[17] = w1; }
    __syncthreads();
    if (stage == 1) {
        const float* xin = (layer == 0) ? a.in[IN_X] : nullptr;
        if (xin) {
            float v0 = ALPHA * xin[(size_t)t * D + tid], v1 = ALPHA * xin[(size_t)t * D + tid + 512];
            const float mean = dbg_block_sum(v0 + v1, red) / D;
            const float var = dbg_block_sum((v0 - mean) * (v0 - mean) + (v1 - mean) * (v1 - mean), red) / D;
            const float rstd = 1.f / sqrtf(var + LN_EPS);
            const float* g = a.in[IN_LN1G] + layer * D; const float* b = a.in[IN_LN1B] + layer * D;
            const float r0 = (v0 - mean) * rstd * g[tid] + b[tid], r1 = (v1 - mean) * rstd * g[tid + 512] + b[tid + 512];
            float e = fmaxf(fabsf(r0 - xout[(size_t)t * D + tid]), fabsf(r1 - xout[(size_t)t * D + tid + 512]));
            dbg_note(ctl, 0, dbg_block_max(e, red));
            const float q0 = __builtin_bit_cast(float, (unsigned)actb[(size_t)t * D + tid] << 16), q1 = __builtin_bit_cast(float, (unsigned)actb[(size_t)t * D + tid + 512] << 16);
            e = fmaxf(fabsf(r0 - q0), fabsf(r1 - q1));
            dbg_note(ctl, 1, dbg_block_max(e, red));
        }
        x1[tid] = xout[(size_t)t * D + tid]; x1[tid + 512] = xout[(size_t)t * D + tid + 512];
        dbgx1[tid] = x1[tid]; dbgx1[tid + 512] = x1[tid + 512];
        __syncthreads();
        if (tid < 16) { float s = 0.f; for (int k = 0; k < D; ++k) s += x1[k] * a.in[IN_RW][k * 16 + tid]; scl[tid] = 1.f / (1.f + expf(-s)); }
        __syncthreads();
        if (tid == 0) {
            float bz[16]; for (int e = 0; e < 16; ++e) bz[e] = scl[e] + a.in[IN_RB][e];
            int bg = 0; float bgs = -1e30f;
            for (int g = 0; g < 4; ++g) { float m1 = -1e30f, m2 = -1e30f; for (int k = 0; k < 4; ++k) { const float v = bz[4 * g + k]; if (v > m1) { m2 = m1; m1 = v; } else if (v > m2) m2 = v; }
                if (m1 + m2 > bgs) { bgs = m1 + m2; bg = g; } }
            int i1 = 0; for (int k = 1; k < 4; ++k) if (bz[4 * bg + k] > bz[4 * bg + i1]) i1 = k;
            int i2 = -1; for (int k = 0; k < 4; ++k) if (k != i1 && (i2 < 0 || bz[4 * bg + k] > bz[4 * bg + i2])) i2 = k;
            const float s1 = scl[4 * bg + i1], s2 = scl[4 * bg + i2];
            float err = 0.f;
            if (e0 != 4 * bg + i1 || e1 != 4 * bg + i2) err = 1.f;
            err = fmaxf(err, fabsf(scl[16] - s1 / (s1 + s2))); err = fmaxf(err, fabsf(scl[17] - s2 / (s1 + s2)));
            if (p0 >= mm.cnt[e0] || p1 >= mm.cnt[e1]) err = 2.f;
            else { const unsigned* list = (const unsigned*)(a.ws + WS_LIST); if (list[e0 * 32768 + p0] != (unsigned)t || list[e1 * 32768 + p1] != (unsigned)t) err = 3.f; }
            atomicMax(ctl + CW_DBG + 2, __builtin_bit_cast(unsigned, err));
        }
        return;
    }
    x1[tid] = dbgx1[tid]; x1[tid + 512] = dbgx1[tid + 512];
    __syncthreads();
    const float* eg = a.in[IN_EG] + (size_t)layer * NE * D * DEXP; const float* eu = a.in[IN_EU] + (size_t)layer * NE * D * DEXP; const float* ed = a.in[IN_ED] + (size_t)layer * NE * DEXP * D;
    { const int k = tid >> 8, j = tid & 255, e = k ? e1 : e0;
      float g = 0.f, u = 0.f; for (int i = 0; i < D; ++i) { g += x1[i] * eg[((size_t)e * D + i) * DEXP + j]; u += x1[i] * eu[((size_t)e * D + i) * DEXP + j]; }
      hh[k * 256 + j] = g / (1.f + expf(-g)) * u; }
    __syncthreads();
    const size_t s0 = (size_t)mm.tstart[e0] * 256 + p0, s1 = (size_t)mm.tstart[e1] * 256 + p1;
    if (stage == 2) {
        const bf16_t* hb = (const bf16_t*)(a.ws + WS_BIG + BIG_H);
        const int k = tid >> 8, j = tid & 255; const size_t s = k ? s1 : s0;
        const float got = __builtin_bit_cast(float, (unsigned)hb[s * DEXP + j] << 16);
        const float ref = hh[tid];
        const float rms = sqrtf(dbg_block_sum(ref * ref, red) / 512.f);
        dbg_note(ctl, 3, dbg_block_max(fabsf(got - ref), red) / (rms + 1e-6f));
        return;
    }
    for (int c = tid; c < 2048; c += 512) { const int k = c >> 10, col = c & 1023, e = k ? e1 : e0; float s = 0.f;
        for (int j = 0; j < DEXP; ++j) s += hh[k * 256 + j] * ed[((size_t)e * DEXP + j) * D + col];
        yy[c] = s; }
    __syncthreads();
    if (stage == 3) {
        const bf16_t* yb = (const bf16_t*)(a.ws + WS_BIG + BIG_YB);
        float e = 0.f, sq = 0.f;
        for (int c = tid; c < 2048; c += 512) { const int k = c >> 10, col = c & 1023; const size_t s = k ? s1 : s0;
            const float got = __builtin_bit_cast(float, (unsigned)yb[s * D + col] << 16); e = fmaxf(e, fabsf(got - yy[c])); sq += yy[c] * yy[c]; }
        const float rms = sqrtf(dbg_block_sum(sq, red) / 2048.f);
        dbg_note(ctl, 4, dbg_block_max(e, red) / (rms + 1e-6f));
        return;
    }
    {
        float v0 = ALPHA * x1[tid] + w0 * yy[tid] + w1 * yy[1024 + tid], v1 = ALPHA * x1[tid + 512] + w0 * yy[tid + 512] + w1 * yy[1024 + tid + 512];
        const float mean = dbg_block_sum(v0 + v1, red) / D;
        const float var = dbg_block_sum((v0 - mean) * (v0 - mean) + (v1 - mean) * (v1 - mean), red) / D;
        const float rstd = 1.f / sqrtf(var + LN_EPS);
        const float* g = a.in[IN_LN2G] + layer * D; const float* b = a.in[IN_LN2B] + layer * D;
        const float r0 = (v0 - mean) * rstd * g[tid] + b[tid], r1 = (v1 - mean) * rstd * g[tid + 512] + b[tid + 512];
        const float e = fmaxf(fabsf(r0 - xout[(size_t)t * D + tid]), fabsf(r1 - xout[(size_t)t * D + tid + 512]));
        dbg_note(ctl, 5, dbg_block_max(e, red));
    }
}
DI void dbg_final(const Args& a) {
    unsigned* ctl = (unsigned*)(a.ws + WS_CTL);
    const float tol[6] = {1e-4f, 2e-2f, 1e-3f, 0.12f, 0.12f, 4e-2f};
    int code = 2;
    for (int i = 5; i >= 0; --i) { const float err = __builtin_bit_cast(float, xb_ld(ctl + CW_DBG + i));
        if (!(err <= tol[i])) { const int dg = !(err < 1.f) ? 9 : err >= 0.3f ? 7 : err >= 0.1f ? 5 : err >= 0.03f ? 3 : 1; code = 10 * (i + 1) + dg; } }
#ifdef PROBE
    { const float p0 = (float)xb_ld(ctl + CW_DBG + 10) / 65536.f, p1 = __builtin_bit_cast(float, xb_ld(ctl + CW_DBG + 9));
      const int d0 = p0 < 0.f ? 0 : p0 >= 1.f ? 9 : (int)(p0 * 9.99f), d1 = p1 < 0.f ? 0 : p1 >= 1.f ? 9 : (int)(p1 * 9.99f); code = 10 * d0 + d1; }
#endif
    if (xb_ld(ctl + CW_BAR + XB_TMO)) code = 95;
    const float c = sqrtf((float)code);
    for (size_t i = (size_t)blockIdx.x * NTHR + threadIdx.x; i < (size_t)T * D; i += (size_t)gridDim.x * NTHR) a.out[i] = c;
}
#endif

constexpr bool HAS_MIXER[4] = {true, true, true, true};
template <int layer>
DI void run_layer(const Args& a, LAS unsigned char* lds, const XcdBarrier& bar) {
    const int wave = a.wv;
    const int G = gridDim.x, bid = blockIdx.x;
    const int gw = bid * NWAVES + wave, NGW = G * NWAVES;
    unsigned char* ws = a.ws;
    unsigned* ctl = (unsigned*)(a.ws + WS_CTL);
    bf16_t* actb = (bf16_t*)(ws + WS_ACTB);
    float* xout = a.out;
        bf16_t* bigb = (bf16_t*)(ws + WS_BIG);
        if (layer == 0) {
#pragma unroll 1
            for (int b = 0; b < BATCH; ++b) {
                { pg8::DenseSched S; S.init(actb + (size_t)b * SEQ * D, D * 2, 128, ws + WS_WIN, SEQ, 9216, D, G, bid); pg8::EpiStore E{bigb, (size_t)9216}; pg8::gemm_phase(lds + STAGE_OFF, S, E, a.wv); }
                if (b == 1) dilated_merge(a, 0);
                xcd_barrier(bar);
                dilated_phase(a, lds);
                xcd_barrier(bar);
            }
            dilated_merge(a, 1);
            xcd_barrier(bar);
        }
        if (layer == 1) {
            { pg8::DenseSched S; S.init(actb, D * 2, 128, ws + WS_WIN, T, 3072, D, G, bid); pg8::EpiStore E{bigb, (size_t)3072}; pg8::gemm_phase(lds + STAGE_OFF, S, E, a.wv); }
            xcd_barrier(bar);
            sb_phase(a, lds);
            xcd_barrier(bar);
        }
        if (layer == 2) {
            { pg8::DenseSched S; S.init(actb, D * 2, 128, ws + WS_WIN, T, 2816, D, G, bid);
              pg8::EpiNsa E{(bf16_t*)(ws + WS_BIG + NS_Q), (bf16_t*)(ws + WS_BIG + NS_KV), (float*)(ws + WS_BIG + NS_GT)}; pg8::gemm_phase(lds + STAGE_OFF, S, E, a.wv); }
            xcd_barrier(bar);
            { pg8::CmpSched S; S.kv6 = (const char*)(ws + WS_BIG + NS_KV); S.Bt = (const char*)(ws + WS_WCMP); S.K = 2048; S.lda = 16 * 1536 * 2; S.kstepA = 1536 * 2; S.G = G; S.c = bid;
              pg8::EpiCmp E{(bf16_t*)(ws + WS_BIG + NS_HID), (const float*)(ws + WS_WCMP + 2 * MiB + 64 * 1024)}; pg8::gemm_phase(lds + STAGE_OFF, S, E, a.wv); }
            xcd_barrier(bar);
            nsa_kcvc_phase(a);
            xcd_barrier(bar);
            nsa_attn_phase(a, lds);
            xcd_barrier(bar);
        }
        if (layer == 3) {
            { pg8::DenseSched S; S.init(actb, D * 2, 128, ws + WS_WIN, T, 3072, D, G, bid); pg8::EpiStore E{bigb, (size_t)3072}; pg8::gemm_phase(lds + STAGE_OFF, S, E, a.wv); }
            xcd_barrier(bar);
            moba_kmean_phase(a);
            xcd_barrier(bar);
            moba_gate_phase(a, lds);
            xcd_barrier(bar);
            moba_fill_phase(a, lds);
            xcd_barrier(bar);
            moba_sel_phase(a, lds);
            xcd_barrier(bar);
            moba_own_phase(a, lds);
            xcd_barrier(bar);
        }
        if (HAS_MIXER[layer]) {
            { pg8::DenseSched S; S.init(actb, D * 2, 128, ws + WS_WOUT, T, D, D, G, bid); pg8::EpiStore E{(bf16_t*)(ws + WS_BIG + BIG_Y), (size_t)D}; pg8::gemm_phase(lds + STAGE_OFF, S, E, a.wv); }
            xcd_barrier(bar);
        }
        unsigned* gcount = ctl + CW_MOE + layer * 16 * 64;
        {
            const int tid = tid_of(a.wv), lane = tid & 63;
            LAS float* rwT = (LAS float*)(lds + STAGE_OFF);
            LAS int* lcnt = (LAS int*)(lds + STAGE_OFF + 65536);
            LAS int* gbase = lcnt + 16;
            LAS unsigned* le = (LAS unsigned*)(lcnt + 32);
            LAS float* lg = (LAS float*)(le + 256);
            const float* rw = a.in[IN_RW];
            for (int i = tid; i < 1024 * 16; i += NTHR) { const int k = i >> 4, e = i & 15; rwT[e * 1024 + k] = rw[i]; }
            if (tid < 16) lcnt[tid] = 0;
            __syncthreads();
            const float* xin = (layer == 0) ? a.in[IN_X] : xout;
            const float* g1 = a.in[IN_LN1G] + layer * D; const float* b1 = a.in[IN_LN1B] + layer * D;
            RowVec gv, bv;
#pragma unroll
            for (int j = 0; j < 4; ++j) { gv.v[j] = *(const f32x4*)(g1 + 4 * lane + 256 * j); bv.v[j] = *(const f32x4*)(b1 + 4 * lane + 256 * j); }
            float rbias[16];
#pragma unroll
            for (int e = 0; e < 16; ++e) rbias[e] = a.in[IN_RB][e];
            for (int lt = wave; lt < 128; lt += NWAVES) {
                const int t = bid * 128 + lt;
                if (t >= T) break;
                RowVec r;
#pragma unroll
                for (int j = 0; j < 4; ++j) r.v[j] = *(const f32x4*)(xin + (size_t)t * D + 4 * lane + 256 * j) * ALPHA;
                if (HAS_MIXER[layer]) { const bf16_t* yrow = (const bf16_t*)(ws + WS_BIG + BIG_Y) + (size_t)t * D;
#pragma unroll
                    for (int j = 0; j < 4; ++j) { const u32x2 yv = *(const u32x2*)(yrow + 4 * lane + 256 * j);
                        r.v[j].x += bf_lo(yv.x); r.v[j].y += bf_hi(yv.x); r.v[j].z += bf_lo(yv.y); r.v[j].w += bf_hi(yv.y); } }
                float mean, rstd; ln_stats(r, mean, rstd);
#pragma unroll
                for (int j = 0; j < 4; ++j) { r.v[j] = (r.v[j] - mean) * rstd * gv.v[j] + bv.v[j];
                    *(f32x4*)(xout + (size_t)t * D + 4 * lane + 256 * j) = r.v[j];
                    u32x2 w; w.x = pk2(r.v[j].x, r.v[j].y); w.y = pk2(r.v[j].z, r.v[j].w);
                    *(u32x2*)(actb + (size_t)t * D + 4 * lane + 256 * j) = w; }
                float sc[16];
#pragma unroll
                for (int e = 0; e < 16; ++e) { float s = 0.f;
#pragma unroll
                    for (int j = 0; j < 4; ++j) { const f32x4 w = *(const LAS f32x4*)(rwT + e * 1024 + 4 * lane + 256 * j); s += (r.v[j].x * w.x + r.v[j].y * w.y) + (r.v[j].z * w.z + r.v[j].w * w.w); }
                    sc[e] = wave_sum(s); }
                float bz[16];
#pragma unroll
                for (int e = 0; e < 16; ++e) { sc[e] = 1.f / (1.f + __expf(-sc[e])); bz[e] = sc[e] + rbias[e]; }
                int bg = 0; float bgs = -1e30f;
#pragma unroll
                for (int g = 0; g < 4; ++g) {
                    float m1 = bz[4 * g]; int i1 = 0;
#pragma unroll
                    for (int k = 1; k < 4; ++k) if (bz[4 * g + k] > m1) { m1 = bz[4 * g + k]; i1 = k; }
                    float m2 = -1e30f;
#pragma unroll
                    for (int k = 0; k < 4; ++k) if (k != i1 && bz[4 * g + k] > m2) m2 = bz[4 * g + k];
                    const float gs = m1 + m2;
                    if (gs > bgs) { bgs = gs; bg = g; }
                }
                float v4[4], s4[4];
#pragma unroll
                for (int k = 0; k < 4; ++k) { v4[k] = 0.f; s4[k] = 0.f; }
#pragma unroll
                for (int g = 0; g < 4; ++g) if (g == bg) {
#pragma unroll
                    for (int k = 0; k < 4; ++k) { v4[k] = bz[4 * g + k]; s4[k] = sc[4 * g + k]; } }
                int i1 = 0; float m1 = v4[0];
#pragma unroll
                for (int k = 1; k < 4; ++k) if (v4[k] > m1) { m1 = v4[k]; i1 = k; }
                int i2 = -1; float m2 = -1e30f;
#pragma unroll
                for (int k = 0; k < 4; ++k) if (k != i1 && v4[k] > m2) { m2 = v4[k]; i2 = k; }
                float sg1 = 0.f, sg2 = 0.f;
#pragma unroll
                for (int k = 0; k < 4; ++k) { sg1 = (k == i1) ? s4[k] : sg1; sg2 = (k == i2) ? s4[k] : sg2; }
                const float inv = 1.f / (sg1 + sg2);
                if (lane == 0) {
                    const int e0 = bg * 4 + i1, e1 = bg * 4 + i2;
                    const int p0 = atomicAdd((int*)(lcnt + e0), 1), p1 = atomicAdd((int*)(lcnt + e1), 1);
                    le[lt * 2] = (unsigned)e0 | ((unsigned)p0 << 8); le[lt * 2 + 1] = (unsigned)e1 | ((unsigned)p1 << 8);
                    lg[lt * 2] = sg1 * inv; lg[lt * 2 + 1] = sg2 * inv;
                }
            }
            __syncthreads();
            if (tid < 16) gbase[tid] = (int)xb_add(gcount + tid * 64, (unsigned)lcnt[tid]);
            __syncthreads();
            if (tid < 256) {
                const int lt = tid >> 1, t = bid * 128 + lt;
                if (t < T) {
                    const unsigned w = le[tid]; const int e = w & 255, pos = gbase[e] + (int)(w >> 8);
                    ((unsigned*)(ws + WS_LIST))[e * 32768 + pos] = (unsigned)t;
                    u32x2 ti; ti.x = (unsigned)e | ((unsigned)pos << 4); ti.y = __builtin_bit_cast(unsigned, lg[tid]);
                    *(u32x2*)(ws + WS_TOKINFO + (size_t)(t * 2 + (tid & 1)) * 8) = ti;
                }
            }
        }
        xcd_barrier(bar);

        MoeMeta mm; mm.tstart = (LAS int*)(lds + MISC_OFF + 256); mm.cnt = mm.tstart + 32;
        if (tid_of(a.wv) == 0) { int acc = 0;
            for (int e = 0; e < 16; ++e) { const int c = (int)xb_ld(gcount + e * 64); mm.cnt[e] = c; mm.tstart[e] = acc; acc += (c + 255) >> 8; }
            mm.tstart[16] = acc; }
        __syncthreads();
        const int ntiles = mm.tstart[16];
#if DBG
        if (layer == DBG_LAYER) { dbg_check<layer>(a, lds, 1, mm); __syncthreads(); }
#endif
        {
            Moe1Sched S; S.A = (const char*)actb; S.Bt = (const char*)(ws + WS_WEXP1); S.K = D; S.lda = D * 2; S.kstepA = 128; S.mm = mm; S.ntiles = ntiles; S.G = G; S.c = bid;
            S.tab = (LAS unsigned*)(lds + AUX_OFF);
            const int tid = tid_of(a.wv);
            pg8::Unit u;
            for (int i = 0; i < 8 && S.next(i, u); ++i) {
                if (tid < 256) { const int pos = (u.pm - mm.tstart[u.e]) * 256 + tid;
                    const unsigned tok = (pos < mm.cnt[u.e]) ? ((const unsigned*)(ws + WS_LIST))[u.e * 32768 + pos] : 0u;
                    S.tab[i * 256 + tid] = tok * (unsigned)(D * 2); }
            }
            __syncthreads();
            pg8::EpiSwiglu E{(bf16_t*)(ws + WS_BIG + BIG_H)};
            pg8::gemm_phase(lds + STAGE_OFF, S, E, a.wv);
        }
        xcd_barrier(bar);
#if DBG
        if (layer == DBG_LAYER) { dbg_check<layer>(a, lds, 2, mm); __syncthreads(); }
#endif
        {
            Moe2Sched S; S.A = (const char*)(ws + WS_BIG + BIG_H); S.Bt = (const char*)(ws + WS_WEXP2); S.K = DEXP; S.lda = DEXP * 2; S.kstepA = 128; S.mm = mm; S.ntiles = ntiles; S.G = G; S.c = bid;
            pg8::EpiStore E{(bf16_t*)(ws + WS_BIG + BIG_YB), (size_t)D};
            pg8::gemm_phase(lds + STAGE_OFF, S, E, a.wv);
        }
        xcd_barrier(bar);
#if DBG
        if (layer == DBG_LAYER) { dbg_check<layer>(a, lds, 3, mm); __syncthreads(); }
#endif
        {
            const int tid = tid_of(a.wv), lane = tid & 63;
            const float* g2 = a.in[IN_LN2G] + layer * D; const float* b2 = a.in[IN_LN2B] + layer * D;
            RowVec gv, bv;
#pragma unroll
            for (int j = 0; j < 4; ++j) { gv.v[j] = *(const f32x4*)(g2 + 4 * lane + 256 * j); bv.v[j] = *(const f32x4*)(b2 + 4 * lane + 256 * j); }
            const bf16_t* yb = (const bf16_t*)(ws + WS_BIG + BIG_YB);
            for (int t = gw; t < T; t += NGW) {
                const u32x4 ti = *(const u32x4*)(ws + WS_TOKINFO + (size_t)t * 16);
                const int e0 = ti.x & 15, p0 = ti.x >> 4, e1 = ti.z & 15, p1 = ti.z >> 4;
                const float w0 = u2f(ti.y), w1 = u2f(ti.w);
                const size_t s0 = (size_t)mm.tstart[e0] * 256 + p0, s1 = (size_t)mm.tstart[e1] * 256 + p1;
                RowVec r;
#pragma unroll
                for (int j = 0; j < 4; ++j) {
                    const f32x4 xv = *(const f32x4*)(xout + (size_t)t * D + 4 * lane + 256 * j);
                    const u32x2 y0 = *(const u32x2*)(yb + s0 * D + 4 * lane + 256 * j), y1 = *(const u32x2*)(yb + s1 * D + 4 * lane + 256 * j);
                    r.v[j].x = ALPHA * xv.x + w0 * bf_lo(y0.x) + w1 * bf_lo(y1.x);
                    r.v[j].y = ALPHA * xv.y + w0 * bf_hi(y0.x) + w1 * bf_hi(y1.x);
                    r.v[j].z = ALPHA * xv.z + w0 * bf_lo(y0.y) + w1 * bf_lo(y1.y);
                    r.v[j].w = ALPHA * xv.w + w0 * bf_hi(y0.y) + w1 * bf_hi(y1.y);
                }
                float mean, rstd; ln_stats(r, mean, rstd);
#pragma unroll
                for (int j = 0; j < 4; ++j) { r.v[j] = (r.v[j] - mean) * rstd * gv.v[j] + bv.v[j];
                    *(f32x4*)(xout + (size_t)t * D + 4 * lane + 256 * j) = r.v[j];
                    u32x2 w; w.x = pk2(r.v[j].x, r.v[j].y); w.y = pk2(r.v[j].z, r.v[j].w);
                    *(u32x2*)(actb + (size_t)t * D + 4 * lane + 256 * j) = w; }
            }
            if (layer + 1 < DEPTH) convert_layer_weights(a, layer + 1, lds, gw, NGW, wave, lane);
        }
        xcd_barrier(bar);
#if DBG
        if (layer == DBG_LAYER) { dbg_check<layer>(a, lds, 4, mm); xcd_barrier(bar); }
#endif
}

__global__ void __launch_bounds__(NTHR, 2) fwd(Args a_in) {
    Args a = a_in; a.wv = __builtin_amdgcn_readfirstlane((int)(threadIdx.x >> 6));
    extern __shared__ __attribute__((aligned(16))) unsigned char lds_raw[];
    LAS unsigned char* lds = (LAS unsigned char*)lds_raw;
    volatile LAS unsigned* MISC = (volatile LAS unsigned*)(lds + MISC_OFF);
    const int tid = tid_of(a.wv), lane = tid & 63, wave = a.wv;
    const int G = gridDim.x, bid = blockIdx.x;
    const int gw = bid * NWAVES + wave, NGW = G * NWAVES;
    if (tid < 256) MISC[tid] = 0u;
    __syncthreads();
    unsigned* ctl = (unsigned*)(a.ws + WS_CTL);
    XcdBarrier bar = xcd_barrier_post(ctl + CW_BAR, MISC + 8); bar.wv = a.wv;
    unsigned char* ws = a.ws;
    bf16_t* actb = (bf16_t*)(ws + WS_ACTB);
    float* xout = a.out;

    convert_layer_weights(a, 0, lds, gw, NGW, wave, lane);
    for (int i = bid * NTHR + tid; i < 16 * 2048; i += G * NTHR) { const int hd = i >> 11, n = i & 2047;
        int bk = n; if (n >= 16) { const float lf = logf((float)n / 16.f) / 4.852030263919617f; bk = 16 + (int)(lf * 16.f); bk = bk > 31 ? 31 : bk; }
        ((float*)(a.ws + WS_BIASG))[i] = a.in[IN_REL][bk * 16 + hd] * LOG2E; }
    { const float* x = a.in[IN_X];
      for (size_t i = ((size_t)bid * NTHR + tid) * 8; i < (size_t)T * D; i += (size_t)G * NTHR * 8) {
          const f32x4 v0 = *(const f32x4*)(x + i), v1 = *(const f32x4*)(x + i + 4);
          u32x4 w; w.x = pk2(v0.x, v0.y); w.y = pk2(v0.z, v0.w); w.z = pk2(v1.x, v1.y); w.w = pk2(v1.z, v1.w);
          *(u32x4*)(actb + i) = w; } }
    xcd_barrier(bar);

    run_layer<0>(a, lds, bar);
#if DBG
    if (DBG_LAYER >= 1) run_layer<1>(a, lds, bar);
    if (DBG_LAYER >= 2) run_layer<2>(a, lds, bar);
    if (DBG_LAYER >= 3) run_layer<3>(a, lds, bar);
    dbg_final(a);
#else
    run_layer<1>(a, lds, bar);
    run_layer<2>(a, lds, bar);
    run_layer<3>(a, lds, bar);
#endif
}

extern "C" void kernel_launch(void* const* d_in, const int* in_sizes, int n_in, void* d_out, int out_size, void* d_ws, size_t ws_size, hipStream_t stream) {
    static int grid = 0;
    if (grid == 0) {
        int dev = 0, cus = 0;
        if (n_in != 25 || out_size != T * D || ws_size < WS_END) { fprintf(stderr, "kernel_launch: unexpected shapes (n_in %d out %d ws %zu)\n", n_in, out_size, ws_size); grid = -1; return; }
        if (hipGetDevice(&dev) != hipSuccess || hipDeviceGetAttribute(&cus, hipDeviceAttributeMultiprocessorCount, dev) != hipSuccess) { grid = -1; return; }
        if (hipFuncSetAttribute((const void*)fwd, hipFuncAttributeMaxDynamicSharedMemorySize, LDS_BYTES) != hipSuccess) { grid = -1; return; }
        (void)hipGetLastError();
        grid = cus;
        if (grid != 256) { fprintf(stderr, "kernel_launch: built for 256 CUs, got %d\n", grid); grid = -1; return; }
    }
    if (grid < 0) return;
    (void)hipMemsetAsync(d_ws, 0, 1u << 20, stream);
    Args a{};
    for (int i = 0; i < 25; ++i) a.in[i] = (const float*)d_in[i];
    a.out = (float*)d_out; a.ws = (unsigned char*)d_ws;
    hipLaunchKernelGGL(fwd, dim3(grid), dim3(NTHR), LDS_BYTES, stream, a);
}
```

```cpp
#include <hip/hip_runtime.h>
#include <cstdio>
#include <cstdint>
#define DBG 0
#define DBG_LAYER 0

#define LAS __attribute__((address_space(3)))
#define GAS __attribute__((address_space(1)))
#define DI __device__ __forceinline__
typedef unsigned short bf16_t;
typedef short bf16x8 __attribute__((ext_vector_type(8)));
typedef short s16x4 __attribute__((ext_vector_type(4)));
typedef float f32x2 __attribute__((ext_vector_type(2)));
typedef float f32x4 __attribute__((ext_vector_type(4)));
typedef float f32x16 __attribute__((ext_vector_type(16)));
typedef unsigned u32x2 __attribute__((ext_vector_type(2)));
typedef unsigned u32x4 __attribute__((ext_vector_type(4)));

constexpr int BATCH = 2, SEQ = 16384, D = 1024, T = BATCH * SEQ, DEPTH = 4, NH = 16, HD = 64;
constexpr int NE = 16, DEXP = 256;
constexpr float ALPHA = 1.681792830507429f;
constexpr float LN_EPS = 1e-5f;
constexpr int NWAVES = 8, NTHR = 512;

constexpr size_t MiB = 1u << 20;
constexpr size_t WS_CTL = 0;
constexpr size_t WS_TOKINFO = 1 * MiB;
constexpr size_t WS_SMALL = 1 * MiB + 512 * 1024;
constexpr size_t WS_LIST = 2 * MiB;
constexpr size_t WS_WIN = 4 * MiB;
constexpr size_t WS_WOUT = 22 * MiB;
constexpr size_t WS_WEXP1 = 24 * MiB;
constexpr size_t WS_WEXP2 = 40 * MiB;
constexpr size_t WS_WCMP = 48 * MiB;
constexpr size_t WS_ACTB = 52 * MiB;
constexpr size_t WS_BIG = 116 * MiB;
constexpr size_t WS_END = 512 * MiB;
constexpr size_t BIG_Y = 0;
constexpr size_t BIG_H = 64 * MiB;
constexpr size_t BIG_YB = 100 * MiB;
constexpr int PROWS = 2 * T + NE * 256;

constexpr int CW_BAR = 4096;
constexpr int CW_DBG = 8;
constexpr int CW_MOE = 16384;

constexpr int LDS_BYTES = 160 * 1024;
constexpr int STAGE_OFF = 0;
constexpr int AUX_OFF = 128 * 1024;
constexpr int MISC_OFF = LDS_BYTES - 1024;

DI unsigned f2bf(float f) { unsigned u = __builtin_bit_cast(unsigned, f); return (u + 0x7fffu + ((u >> 16) & 1u)) >> 16; }
DI unsigned pk2(float lo, float hi) { return f2bf(lo) | (f2bf(hi) << 16); }
DI unsigned cvt_pk_bf16(float lo, float hi) { unsigned r; asm volatile("v_cvt_pk_bf16_f32 %0, %1, %2" : "=v"(r) : "v"(lo), "v"(hi)); return r; }
DI float u2f(unsigned u) { return __builtin_bit_cast(float, u); }
DI unsigned f2u(float f) { return __builtin_bit_cast(unsigned, f); }
DI float bf_lo(unsigned w) { return __builtin_bit_cast(float, w << 16); }
DI float bf_hi(unsigned w) { return __builtin_bit_cast(float, w & 0xffff0000u); }
DI float wave_sum(float v) {
#pragma unroll
    for (int o = 1; o < 64; o <<= 1) v += __shfl_xor(v, o);
    return v;
}
DI int tid_of(int wv) { int l; asm volatile("v_mbcnt_lo_u32_b32 %0, -1, 0\n\tv_mbcnt_hi_u32_b32 %0, -1, %0" : "=v"(l)); return (wv << 6) | l; }
#define LDS_WAIT() asm volatile("s_waitcnt lgkmcnt(0)" ::: "memory")
#define VM_WAIT() asm volatile("s_waitcnt vmcnt(0)" ::: "memory")

#define XB_TMO      128
#define XB_XCNT(j)  (256  + 64 * (j))
#define XB_XSUB(j)  (1280 + 64 * (j))
#define XB_XGEN(j)  (2304 + 64 * (j))
#define XB_TOP      3328
#define XB_TOPGEN   3392
#define XCD_BAR_WORDS 3456
#define XB_SPIN_CAP (1u << 22)
DI unsigned xb_ld(unsigned* p)              { return __hip_atomic_load(p, __ATOMIC_RELAXED, __HIP_MEMORY_SCOPE_AGENT); }
DI unsigned xb_add(unsigned* p, unsigned v) { return __hip_atomic_fetch_add(p, v, __ATOMIC_RELAXED, __HIP_MEMORY_SCOPE_AGENT); }
DI unsigned xb_xcc_id() { return (unsigned)__builtin_amdgcn_s_getreg((3 << 11) | 20) & 0xFu; }
#define XB_SPIN(cond, bar) do { unsigned _sp = 0; while (cond) { __builtin_amdgcn_s_sleep(1); \
    if ((++_sp & 255u) == 0u) { if (xb_ld(&(bar)[XB_TMO])) break; if (_sp > XB_SPIN_CAP) { atomicAdd(&(bar)[XB_TMO], 1u); break; } } } } while (0)
struct XcdBarrier { unsigned* bar; unsigned x; volatile LAS unsigned* st; int wv; };
DI XcdBarrier xcd_barrier_post(unsigned* bar, volatile LAS unsigned* st) {
    XcdBarrier b; b.bar = bar; b.x = xb_xcc_id(); b.st = st;
    if (threadIdx.x == 0) (void)xb_add(&bar[XB_XCNT(b.x)], 1u);
    return b;
}
DI void xcd_barrier_complete(unsigned* bar, unsigned x, unsigned& nloc, unsigned& nx) {
    const unsigned G = gridDim.x * gridDim.y * gridDim.z;
    unsigned sum, cnt, mine, sp = 0u;
    for (;;) {
        sum = 0u; cnt = 0u; mine = 0u;
#pragma unroll
        for (unsigned j = 0; j < 16; ++j) { const unsigned c = xb_ld(&bar[XB_XCNT(j)]); sum += c; cnt += (c > 0u) ? 1u : 0u; mine = (j == x) ? c : mine; }
        if (sum == G) break;
        __builtin_amdgcn_s_sleep(1);
        if ((++sp & 255u) == 0u) { if (xb_ld(&bar[XB_TMO])) break; if (sp > XB_SPIN_CAP) { atomicAdd(&bar[XB_TMO], 1u); break; } }
    }
    nloc = mine > 0u ? mine : 1u; nx = cnt > 0u ? cnt : 1u;
}
DI void xcd_barrier(const XcdBarrier& b) {
    asm volatile("s_waitcnt vmcnt(0)" ::: "memory");
    __syncthreads();
    if (tid_of(b.wv) == 0) {
        unsigned* bar = b.bar;
        const unsigned bx = xb_xcc_id();
        __builtin_amdgcn_s_waitcnt(0);
        unsigned nloc = b.st[0], nx = b.st[1];
        if (nloc == 0u) { xcd_barrier_complete(bar, bx, nloc, nx); b.st[0] = nloc; b.st[1] = nx; }
        const unsigned old = xb_add(&bar[XB_XSUB(bx)], 1u);
        const unsigned gen = old / nloc;
        if (old + 1u == (gen + 1u) * nloc) {
            __builtin_amdgcn_fence(__ATOMIC_RELEASE, "agent");
            asm volatile("s_waitcnt vmcnt(0)" ::: "memory");
            const unsigned og = xb_add(&bar[XB_TOP], 1u);
            const unsigned tg = og / nx;
            if (og + 1u == (tg + 1u) * nx) xb_add(&bar[XB_TOPGEN], 1u);
            else XB_SPIN(xb_ld(&bar[XB_TOPGEN]) == tg, bar);
            __builtin_amdgcn_fence(__ATOMIC_ACQUIRE, "agent");
            xb_add(&bar[XB_XGEN(bx)], 1u);
            asm volatile("s_waitcnt vmcnt(0)" ::: "memory");
        } else {
            XB_SPIN(xb_ld(&bar[XB_XGEN(bx)]) == gen, bar);
            __builtin_amdgcn_fence(__ATOMIC_ACQUIRE, "agent");
            asm volatile("s_waitcnt vmcnt(0)" ::: "memory");
        }
    }
    __syncthreads();
}

namespace pg8 {
constexpr int BM = 256, BK = 64, HALF = 128, HTB = HALF * BK * 2, STAGE_BYTES = 8 * HTB, NXCD = 8, WGM = 8;
__host__ __device__ __forceinline__ int lds_byte(int r, int c) { const int st = (r >> 4) * 2 + (c >> 5), rr = r & 15, cc = c & 31, ob = rr * 64 + cc * 2; return st * 1024 + (ob ^ (((ob >> 9) & 1) << 5)); }
__host__ __device__ __forceinline__ void stage_rc(int b, int& R, int& C) { const int st = b / 1024, sb = b % 1024, swz = sb ^ (((sb >> 9) & 1) << 5); R = (st >> 1) * 16 + swz / 64; C = (st & 1) * 32 + (swz % 64) / 2; }
__host__ __device__ __forceinline__ int perm32(int rho) { const int n = rho >> 4, i = rho & 15; return 8 * (i >> 2) + 4 * n + (i & 3); }

struct Unit { int pm, pn, e; };

struct TileOrder {
    int nM, nN, nwg, G, c;
    DI void init(int nM_, int nN_, int G_, int c_) { nM = nM_; nN = nN_; nwg = nM * nN; G = G_; c = c_; }
    DI bool next(int i, int& pm, int& pn) const {
        const long L = (long)i * G + c; if (L >= nwg) return false;
        int wgid = (int)L; { const int q = nwg / NXCD, r = nwg % NXCD, xcd = wgid % NXCD, off = wgid / NXCD; wgid = (xcd < r ? xcd * (q + 1) : r * (q + 1) + (xcd - r) * q) + off; }
        const int nig = WGM * nN, gid = wgid / nig, fm = gid * WGM, gsz = (nM - fm) < WGM ? (nM - fm) : WGM;
        pm = fm + ((wgid % nig) % gsz); pn = (wgid % nig) / gsz; return true;
    }
};
struct DenseSched {
    static constexpr bool GATHER = false;
    const char* A; const char* Bt; int K; unsigned lda, kstepA; TileOrder ord;
    DI void init(const void* A_, unsigned lda_, unsigned kstepA_, const void* Bt_, int M, int N, int K_, int G, int c) { A = (const char*)A_; Bt = (const char*)Bt_; K = K_; lda = lda_; kstepA = kstepA_; ord.init(M / BM, N / BM, G, c); }
    DI bool next(int i, Unit& u) const { u.e = 0; return ord.next(i, u.pm, u.pn); }
    DI const char* a_base(const Unit& u) const { return A + (size_t)u.pm * BM * lda; }
    DI const char* b_base(const Unit& u) const { return Bt + (size_t)u.pn * BM * K * 2; }
    DI unsigned row_off(int, int) const { return 0u; }
};

template <class Epi, class Sched>
DI void gemm_phase(LAS unsigned char* lds, const Sched& S, const Epi& E, int wv) {
    int tid = tid_of(wv); asm volatile("" : "+v"(tid));
    const int wid = __builtin_amdgcn_readfirstlane(tid >> 6), lane = tid & 63, wr = wid >> 2, wc = wid & 3, fr = lane & 15, fq = lane >> 4;
    const int K = S.K, nt = K / BK;
    unsigned voffB[2]; int Rr[2]; unsigned Cb[2];
#pragma unroll
    for (int i = 0; i < 2; ++i) { int R, C; stage_rc(tid * 16 + i * 8192, R, C); const int Rb = (R & ~31) + perm32(R & 31);
        voffB[i] = (unsigned)(Rb * K + C) * 2u; Rr[i] = R; Cb[i] = (unsigned)C * 2u; }
    const unsigned kstepA = S.kstepA, kstepB = (unsigned)(BK * 2);
    const size_t hstepB = (size_t)HALF * K * 2;
    const unsigned ldsw = (unsigned)wid * 1024u;
    const int aoff = lds_byte(wr * 64 + fr, fq * 8), boff = lds_byte(wc * 32 + fr, fq * 8);
#define PG8_SA(b, h) (((b) * 2 + (h)) * HTB)
#define PG8_SB(b, h) ((4 + (b) * 2 + (h)) * HTB)
#define PG8_STAGE_A(bufoff, basep, vv, h, koff) do { _Pragma("unroll") for (int _i = 0; _i < 2; ++_i) \
        __builtin_amdgcn_global_load_lds((const unsigned*)((basep) + (vv)[h][_i] + (koff)), (LAS unsigned*)(lds + (bufoff) + ldsw + _i * 8192), 16, 0, 0); } while (0)
#define PG8_STAGE_B(bufoff, ptr) do { _Pragma("unroll") for (int _i = 0; _i < 2; ++_i) \
        __builtin_amdgcn_global_load_lds((const unsigned*)((ptr) + voffB[_i]), (LAS unsigned*)(lds + (bufoff) + ldsw + _i * 8192), 16, 0, 0); } while (0)
#define PG8_LDA(dst, b, h) do { _Pragma("unroll") for (int m = 0; m < 4; ++m) _Pragma("unroll") for (int k = 0; k < 2; ++k) dst[m][k] = *(const LAS bf16x8*)(lds + PG8_SA(b, h) + aoff + m * 2048 + k * 1024); } while (0)
#define PG8_LDB(dst, b, h) do { _Pragma("unroll") for (int n = 0; n < 2; ++n) _Pragma("unroll") for (int k = 0; k < 2; ++k) dst[n][k] = *(const LAS bf16x8*)(lds + PG8_SB(b, h) + boff + n * 2048 + k * 1024); } while (0)
#define PG8_MMA(ai, bj, At, Bt) do { __builtin_amdgcn_s_setprio(1); _Pragma("unroll") for (int m = 0; m < 4; ++m) _Pragma("unroll") for (int n = 0; n < 2; ++n) _Pragma("unroll") for (int k = 0; k < 2; ++k) \
        acc[ai][bj][m][n] = __builtin_amdgcn_mfma_f32_16x16x32_bf16(Bt[n][k], At[m][k], acc[ai][bj][m][n], 0, 0, 0); __builtin_amdgcn_s_setprio(0); } while (0)
#define PG8_WAIT_V(n) asm volatile("s_waitcnt vmcnt(" #n ")" ::: "memory")
#define PG8_WAIT_L(n) asm volatile("s_waitcnt lgkmcnt(" #n ")" ::: "memory")
#define PG8_BAR __builtin_amdgcn_s_barrier()
#define PG8_SCHED __builtin_amdgcn_sched_barrier(0)
    Unit cur, nxt; int ui = 0;
    if (!S.next(0, cur)) return;
    unsigned vA[2][2], vN[2][2];
#pragma unroll
    for (int h = 0; h < 2; ++h)
#pragma unroll
        for (int i = 0; i < 2; ++i) { vA[h][i] = (Sched::GATHER ? S.row_off(0, h * HALF + Rr[i]) : (unsigned)(h * HALF + Rr[i]) * S.lda) + Cb[i]; vN[h][i] = vA[h][i]; }
    f32x4 acc[2][2][4][2];
#pragma unroll
    for (int a = 0; a < 2; ++a)
#pragma unroll
        for (int b = 0; b < 2; ++b)
#pragma unroll
            for (int m = 0; m < 4; ++m)
#pragma unroll
                for (int n = 0; n < 2; ++n) acc[a][b][m][n] = (f32x4){0.f, 0.f, 0.f, 0.f};
    bf16x8 At[4][2], B0[2][2], B1[2][2];
    const char* cA = S.a_base(cur); const char* cB = S.b_base(cur);
    PG8_STAGE_B(PG8_SB(0, 0), cB); PG8_STAGE_A(PG8_SA(0, 0), cA, vA, 0, 0u); PG8_STAGE_B(PG8_SB(0, 1), cB + hstepB); PG8_STAGE_A(PG8_SA(0, 1), cA, vA, 1, 0u);
    if (wr == 1) PG8_BAR;
    PG8_WAIT_V(4); PG8_BAR;
    PG8_STAGE_B(PG8_SB(1, 0), cB + kstepB); PG8_STAGE_A(PG8_SA(1, 0), cA, vA, 0, kstepA); PG8_STAGE_B(PG8_SB(1, 1), cB + hstepB + kstepB);
    PG8_WAIT_V(6); PG8_BAR;
    for (;;) {
        const bool has_next = S.next(ui + 1, nxt);
        const char* nA = has_next ? S.a_base(nxt) : cA; const char* nB = has_next ? S.b_base(nxt) : cB;
        if (Sched::GATHER) {
#pragma unroll
            for (int h = 0; h < 2; ++h)
#pragma unroll
                for (int i = 0; i < 2; ++i) vN[h][i] = has_next ? (S.row_off(ui + 1, h * HALF + Rr[i]) + Cb[i]) : vA[h][i];
        }
        for (int t = 0; t < nt; t += 2) {
            const bool last = (t == nt - 2);
            const unsigned k1 = (unsigned)(t + 1) * kstepA;
            const char* a2p = last ? nA : cA; const unsigned k2 = last ? 0u : (unsigned)(t + 2) * kstepA;
            unsigned v2[2][2];
#pragma unroll
            for (int h = 0; h < 2; ++h)
#pragma unroll
                for (int i = 0; i < 2; ++i) v2[h][i] = (Sched::GATHER && last) ? vN[h][i] : vA[h][i];
            const char* b2 = last ? nB : cB + (size_t)(t + 2) * kstepB; const char* b3 = b2 + kstepB;
            PG8_LDB(B0, 0, 0); PG8_SCHED; PG8_LDA(At, 0, 0); PG8_STAGE_A(PG8_SA(1, 1), cA, vA, 1, k1);
            PG8_WAIT_L(8); PG8_BAR; PG8_WAIT_L(0); PG8_MMA(0, 0, At, B0); PG8_BAR; PG8_SCHED;
            PG8_LDB(B1, 0, 1); PG8_STAGE_B(PG8_SB(0, 0), b2);
            PG8_BAR; PG8_WAIT_L(0); PG8_MMA(0, 1, At, B1); PG8_BAR;
            PG8_LDA(At, 0, 1); PG8_STAGE_A(PG8_SA(0, 0), a2p, v2, 0, k2);
            PG8_BAR; PG8_WAIT_L(0); PG8_MMA(1, 0, At, B0); PG8_BAR; PG8_SCHED;
            PG8_STAGE_B(PG8_SB(0, 1), b2 + hstepB);
            PG8_WAIT_V(6); PG8_BAR; PG8_MMA(1, 1, At, B1); PG8_BAR;
            PG8_LDB(B0, 1, 0); PG8_SCHED; PG8_LDA(At, 1, 0); PG8_STAGE_A(PG8_SA(0, 1), a2p, v2, 1, k2);
            PG8_WAIT_L(8); PG8_BAR; PG8_WAIT_L(0); PG8_MMA(0, 0, At, B0); PG8_BAR; PG8_SCHED;
            PG8_LDB(B1, 1, 1); PG8_STAGE_B(PG8_SB(1, 0), b3);
            PG8_BAR; PG8_WAIT_L(0); PG8_MMA(0, 1, At, B1); PG8_BAR;
            PG8_LDA(At, 1, 1); PG8_STAGE_A(PG8_SA(1, 0), a2p, v2, 0, k2 + kstepA);
            PG8_BAR; PG8_WAIT_L(0); PG8_MMA(1, 0, At, B0); PG8_BAR; PG8_SCHED;
            PG8_STAGE_B(PG8_SB(1, 1), b3 + hstepB);
            PG8_WAIT_V(6); PG8_BAR; PG8_MMA(1, 1, At, B1); PG8_BAR;
        }
        E(acc, cur, wr, wc, fr, fq);
        if (!has_next) break;
#pragma unroll
        for (int a = 0; a < 2; ++a)
#pragma unroll
            for (int b = 0; b < 2; ++b)
#pragma unroll
                for (int m = 0; m < 4; ++m)
#pragma unroll
                    for (int n = 0; n < 2; ++n) acc[a][b][m][n] = (f32x4){0.f, 0.f, 0.f, 0.f};
        cur = nxt; cA = nA; cB = nB; ++ui;
#pragma unroll
        for (int h = 0; h < 2; ++h)
#pragma unroll
            for (int i = 0; i < 2; ++i) vA[h][i] = vN[h][i];
    }
    PG8_WAIT_V(0);
    if (wr == 0) PG8_BAR;
    PG8_BAR;
#undef PG8_SA
#undef PG8_SB
#undef PG8_STAGE_A
#undef PG8_STAGE_B
#undef PG8_LDA
#undef PG8_LDB
#undef PG8_MMA
#undef PG8_WAIT_V
#undef PG8_WAIT_L
#undef PG8_BAR
#undef PG8_SCHED
}

struct EpiStore {
    bf16_t* O; size_t ldc;
    DI void operator()(const f32x4 (&acc)[2][2][4][2], const Unit& u, int wr, int wc, int fr, int fq) const {
        const int row0 = u.pm * BM + wr * 64 + fr, col0 = u.pn * BM + wc * 32 + 8 * fq;
#pragma unroll
        for (int ai = 0; ai < 2; ++ai)
#pragma unroll
            for (int m = 0; m < 4; ++m) { bf16_t* rowp = O + (size_t)(row0 + ai * HALF + m * 16) * ldc + col0;
#pragma unroll
                for (int bj = 0; bj < 2; ++bj) { const f32x4 v0 = acc[ai][bj][m][0], v1 = acc[ai][bj][m][1];
                    u32x4 w; w.x = cvt_pk_bf16(v0[0], v0[1]); w.y = cvt_pk_bf16(v0[2], v0[3]); w.z = cvt_pk_bf16(v1[0], v1[1]); w.w = cvt_pk_bf16(v1[2], v1[3]);
                    *(u32x4*)(rowp + bj * HALF) = w; } }
    }
};
struct EpiSwiglu {
    bf16_t* Hb;
    DI void operator()(const f32x4 (&acc)[2][2][4][2], const Unit& u, int wr, int wc, int fr, int fq) const {
        const int row0 = u.pm * BM + wr * 64 + fr, col0 = u.pn * HALF + wc * 32 + 8 * fq;
#pragma unroll
        for (int ai = 0; ai < 2; ++ai)
#pragma unroll
            for (int m = 0; m < 4; ++m) { bf16_t* rowp = Hb + (size_t)(row0 + ai * HALF + m * 16) * DEXP + col0;
                float o[8];
#pragma unroll
                for (int n = 0; n < 2; ++n)
#pragma unroll
                    for (int j = 0; j < 4; ++j) { const float g = acc[ai][0][m][n][j], up = acc[ai][1][m][n][j];
                        o[n * 4 + j] = g * up * __builtin_amdgcn_rcpf(1.0f + __builtin_amdgcn_exp2f(-1.4426950408889634f * g)); }
                u32x4 w; w.x = cvt_pk_bf16(o[0], o[1]); w.y = cvt_pk_bf16(o[2], o[3]); w.z = cvt_pk_bf16(o[4], o[5]); w.w = cvt_pk_bf16(o[6], o[7]);
                *(u32x4*)rowp = w; }
    }
};

struct EpiNsa {
    bf16_t* Q; bf16_t* KV; float* GT;
    DI void operator()(const f32x4 (&acc)[2][2][4][2], const Unit& u, int wr, int wc, int fr, int fq) const {
        const int row0 = u.pm * BM + wr * 64 + fr;
        if (u.pn < 10) {
            bf16_t* base = (u.pn < 4) ? Q + u.pn * BM : KV + (u.pn - 4) * BM; const size_t ldc = (u.pn < 4) ? 1024 : 1536; const int col0 = wc * 32 + 8 * fq;
#pragma unroll
            for (int ai = 0; ai < 2; ++ai)
#pragma unroll
                for (int m = 0; m < 4; ++m) { bf16_t* rowp = base + (size_t)(row0 + ai * HALF + m * 16) * ldc + col0;
#pragma unroll
                    for (int bj = 0; bj < 2; ++bj) { const f32x4 v0 = acc[ai][bj][m][0], v1 = acc[ai][bj][m][1];
                        u32x4 w; w.x = cvt_pk_bf16(v0[0], v0[1]); w.y = cvt_pk_bf16(v0[2], v0[3]); w.z = cvt_pk_bf16(v1[0], v1[1]); w.w = cvt_pk_bf16(v1[2], v1[3]);
                        *(u32x4*)(rowp + bj * HALF) = w; } }
        } else {
            const int col0 = wc * 32 + 8 * fq;
            if (col0 < 48) {
#pragma unroll
                for (int ai = 0; ai < 2; ++ai)
#pragma unroll
                    for (int m = 0; m < 4; ++m) { float* rowp = GT + (size_t)(row0 + ai * HALF + m * 16) * 48 + col0;
#pragma unroll
                        for (int n = 0; n < 2; ++n) { f32x4 v = acc[ai][0][m][n];
#pragma unroll
                            for (int j = 0; j < 4; ++j) v[j] = __builtin_amdgcn_rcpf(1.0f + __builtin_amdgcn_exp2f(-1.4426950408889634f * v[j]));
                            *(f32x4*)(rowp + 4 * n) = v; } }
            }
        }
    }
};
struct EpiCmp {
    bf16_t* Hd; const float* bias;
    DI void operator()(const f32x4 (&acc)[2][2][4][2], const Unit& u, int wr, int wc, int fr, int fq) const {
        const int row0 = u.pm * BM + wr * 64 + fr, col0 = wc * 32 + 8 * fq; const float* bp = bias + u.e * 256;
#pragma unroll
        for (int bj = 0; bj < 2; ++bj) { const f32x4 b0 = *(const f32x4*)(bp + bj * HALF + col0), b1 = *(const f32x4*)(bp + bj * HALF + col0 + 4);
#pragma unroll
            for (int ai = 0; ai < 2; ++ai)
#pragma unroll
                for (int m = 0; m < 4; ++m) { float o[8];
#pragma unroll
                    for (int j = 0; j < 4; ++j) { o[j] = acc[ai][bj][m][0][j] + b0[j]; o[4 + j] = acc[ai][bj][m][1][j] + b1[j]; }
#pragma unroll
                    for (int j = 0; j < 8; ++j) { const float x = o[j], u2 = 1.5957691216057308f * (x + 0.044715f * x * x * x); o[j] = x * __builtin_amdgcn_rcpf(1.0f + __builtin_amdgcn_exp2f(-1.4426950408889634f * u2)); }
                    u32x4 w; w.x = cvt_pk_bf16(o[0], o[1]); w.y = cvt_pk_bf16(o[2], o[3]); w.z = cvt_pk_bf16(o[4], o[5]); w.w = cvt_pk_bf16(o[6], o[7]);
                    *(u32x4*)(Hd + (size_t)(row0 + ai * HALF + m * 16) * 256 + bj * HALF + col0) = w; } }
    }
};
struct CmpSched {
    static constexpr bool GATHER = false;
    const char* kv6; const char* Bt; int K; unsigned lda, kstepA; int G, c;
    DI bool next(int i, Unit& u) const { const int L = i * G + c; if (L >= 64) return false; u.pm = L; u.pn = 0; u.e = L >> 5; return true; }
    DI const char* a_base(const Unit& u) const { const int j = u.pm >> 5, bg = (u.pm >> 2) & 7, cq = u.pm & 3, b = bg >> 2, g = bg & 3;
        return kv6 + (((size_t)b * SEQ + (size_t)cq * 4096) * 1536 + j * 256 + g * 64) * 2; }
    DI const char* b_base(const Unit& u) const { return Bt + (size_t)(u.pm >> 5) * 256 * 2048 * 2; }
    DI unsigned row_off(int, int) const { return 0u; }
};
}

struct MoeMeta { LAS int* tstart; LAS int* cnt; };
DI int moe_expert_of(const MoeMeta& mm, int rt) { int e = 0;
#pragma unroll
    for (int k = 1; k < 16; ++k) e += (rt >= mm.tstart[k]) ? 1 : 0;
    return e; }
struct Moe1Sched {
    static constexpr bool GATHER = true;
    const char* A; const char* Bt; int K; unsigned lda, kstepA; MoeMeta mm; int ntiles, G, c; LAS unsigned* tab;
    DI bool next(int i, pg8::Unit& u) const { const int L = i * G + c; if (L >= ntiles * 2) return false; u.pm = L % ntiles; u.pn = L / ntiles; u.e = moe_expert_of(mm, u.pm); return true; }
    DI const char* a_base(const pg8::Unit&) const { return A; }
    DI const char* b_base(const pg8::Unit& u) const { return Bt + ((size_t)u.e * 512 + (size_t)u.pn * 256) * 1024 * 2; }
    DI unsigned row_off(int slot, int row) const { return tab[slot * 256 + row]; }
};
struct Moe2Sched {
    static constexpr bool GATHER = false;
    const char* A; const char* Bt; int K; unsigned lda, kstepA; MoeMeta mm; int ntiles, G, c;
    DI bool next(int i, pg8::Unit& u) const { const int L = i * G + c; if (L >= ntiles * 4) return false; u.pm = L % ntiles; u.pn = L / ntiles; u.e = moe_expert_of(mm, u.pm); return true; }
    DI const char* a_base(const pg8::Unit& u) const { return A + (size_t)u.pm * 256 * 512; }
    DI const char* b_base(const pg8::Unit& u) const { return Bt + ((size_t)u.e * 1024 + (size_t)u.pn * 256) * 256 * 2; }
    DI unsigned row_off(int, int) const { return 0u; }
};

struct Args { const float* in[25]; float* out; unsigned char* ws; int wv; int pad; };
enum { IN_X = 0, IN_REL, IN_RW, IN_RB, IN_LN1G, IN_LN1B, IN_LN2G, IN_LN2B, IN_EG, IN_EU, IN_ED, IN_DILIN, IN_DILOUT, IN_SBIN, IN_SBOUT,
       IN_NSAIN, IN_NSAOUT, IN_POSK, IN_W1K, IN_W2K, IN_POSV, IN_W1V, IN_W2V, IN_MOBAIN, IN_MOBAOUT };

DI void transpose_item(const float* W, int K, int N, int Nvalid, bf16_t* WT, int drow0, LAS float* scr, int kb, int nb, int lane) {
    const int k0 = 64 * kb, n0 = 32 * nb;
#pragma unroll 8
    for (int i = 0; i < 32; ++i) { const int kk = 2 * i + (lane >> 5); const int n = n0 + (lane & 31); scr[kk * 33 + (lane & 31)] = (n < Nvalid) ? W[(size_t)(k0 + kk) * N + n] : 0.f; }
    LDS_WAIT(); asm volatile("" ::: "memory");
    const int c = lane & 7;
#pragma unroll
    for (int j = 0; j < 4; ++j) { const int n = (lane >> 3) + 8 * j; const LAS float* s = scr + (8 * c) * 33 + n;
        u32x4 o; o.x = pk2(s[0 * 33], s[1 * 33]); o.y = pk2(s[2 * 33], s[3 * 33]); o.z = pk2(s[4 * 33], s[5 * 33]); o.w = pk2(s[6 * 33], s[7 * 33]);
        *(u32x4*)(WT + (size_t)(drow0 + n) * K + k0 + 8 * c) = o; }
    LDS_WAIT(); asm volatile("" ::: "memory");
}

DI void convert_matrix(const float* W, int K, int N, int Npad, bf16_t* WT, LAS float* scr, int gw, int NGW, int lane) {
    const int nblk = Npad / 32, nitems = (K / 64) * nblk;
    for (int it = gw; it < nitems; it += NGW) { const int kb = it / nblk, nb = it % nblk; transpose_item(W, K, N, N, WT, 32 * nb, scr, kb, nb, lane); }
}
DI void convert_layer_weights(const Args& a, int layer, LAS unsigned char* lds, int gw, int NGW, int wave, int lane) {
    LAS float* scr = (LAS float*)(lds + STAGE_OFF + wave * 16384);
    bf16_t* W1 = (bf16_t*)(a.ws + WS_WEXP1); bf16_t* W2 = (bf16_t*)(a.ws + WS_WEXP2);
    const float* eg = a.in[IN_EG] + (size_t)layer * NE * D * DEXP; const float* eu = a.in[IN_EU] + (size_t)layer * NE * D * DEXP; const float* ed = a.in[IN_ED] + (size_t)layer * NE * DEXP * D;
    constexpr int I_G = (D / 64) * (DEXP / 32);
    constexpr int I_D = (DEXP / 64) * (D / 32);
    constexpr int I_E = 2 * I_G + I_D;
    {
        bf16_t* Win = (bf16_t*)(a.ws + WS_WIN); bf16_t* Wout = (bf16_t*)(a.ws + WS_WOUT);
        if (layer == 0) { convert_matrix(a.in[IN_DILIN], D, 9216, 9216, Win, scr, gw, NGW, lane); convert_matrix(a.in[IN_DILOUT], D, D, D, Wout, scr, gw, NGW, lane); }
        if (layer == 1) { convert_matrix(a.in[IN_SBIN], D, 3072, 3072, Win, scr, gw, NGW, lane); convert_matrix(a.in[IN_SBOUT], D, D, D, Wout, scr, gw, NGW, lane); }
        if (layer == 2) { convert_matrix(a.in[IN_NSAIN], D, 2608, 2816, Win, scr, gw, NGW, lane); convert_matrix(a.in[IN_NSAOUT], D, D, D, Wout, scr, gw, NGW, lane);
            bf16_t* wc = (bf16_t*)(a.ws + WS_WCMP);
            convert_matrix(a.in[IN_W1K], 2048, 256, 256, wc, scr, gw, NGW, lane); convert_matrix(a.in[IN_W1V], 2048, 256, 256, wc + 256 * 2048, scr, gw, NGW, lane);
            convert_matrix(a.in[IN_W2K], 256, 64, 64, wc + 2 * 256 * 2048, scr, gw, NGW, lane); convert_matrix(a.in[IN_W2V], 256, 64, 64, wc + 2 * 256 * 2048 + 64 * 256, scr, gw, NGW, lane);
            float* cb = (float*)(a.ws + WS_WCMP + 2 * MiB + 64 * 1024);
            for (int it = gw; it < 512; it += NGW) { const int j = it >> 8, n = it & 255; const float* pos = a.in[j ? IN_POSV : IN_POSK]; const float* w1 = a.in[j ? IN_W1V : IN_W1K];
                float s = 0.f; for (int k = lane; k < 2048; k += 64) s += pos[k] * w1[(size_t)k * 256 + n];
                s = wave_sum(s); if (lane == 0) cb[it] = s; } }
        if (layer == 3) { convert_matrix(a.in[IN_MOBAIN], D, 3072, 3072, Win, scr, gw, NGW, lane); convert_matrix(a.in[IN_MOBAOUT], D, D, D, Wout, scr, gw, NGW, lane); }
    }
    const int NITEMS = NE * I_E;
    for (int it = gw; it < NITEMS; it += NGW) {
        const int e = it / I_E; int r = it % I_E;
        if (r < I_G) { const int kb = r / (DEXP / 32), nb = r % (DEXP / 32); const int n0 = 32 * nb;
            transpose_item(eg + (size_t)e * D * DEXP, D, DEXP, DEXP, W1, e * 512 + ((n0 >> 7) << 8) + (n0 & 127), scr, kb, nb, lane); continue; }
        r -= I_G;
        if (r < I_G) { const int kb = r / (DEXP / 32), nb = r % (DEXP / 32); const int n0 = 32 * nb;
            transpose_item(eu + (size_t)e * D * DEXP, D, DEXP, DEXP, W1, e * 512 + ((n0 >> 7) << 8) + 128 + (n0 & 127), scr, kb, nb, lane); continue; }
        r -= I_G;
        { const int kb = r / (D / 32), nb = r % (D / 32);
          transpose_item(ed + (size_t)e * DEXP * D, DEXP, D, D, W2, e * 1024 + 32 * nb, scr, kb, nb, lane); }
    }
}

struct RowVec { f32x4 v[4]; };
DI void ln_stats(const RowVec& r, float& mean, float& rstd) {
    float s = 0.f;
#pragma unroll
    for (int j = 0; j < 4; ++j) s += (r.v[j].x + r.v[j].y) + (r.v[j].z + r.v[j].w);
    mean = wave_sum(s) * (1.f / D); float s2 = 0.f;
#pragma unroll
    for (int j = 0; j < 4; ++j) { const f32x4 d = r.v[j] - mean; s2 += (d.x * d.x + d.y * d.y) + (d.z * d.z + d.w * d.w); }
    rstd = 1.f / sqrtf(wave_sum(s2) * (1.f / D) + LN_EPS);
}


constexpr int KSTR = 144;
constexpr int KVT = 64;
constexpr int KV_TILE_BYTES = KVT * KSTR;
constexpr float LOG2E = 1.4426950408889634f, LN2F = 0.6931471805599453f;
DI f32x16 mfma32(bf16x8 a, bf16x8 b, f32x16 c) { return __builtin_amdgcn_mfma_f32_32x32x16_bf16(a, b, c, 0, 0, 0); }
DI f32x16 zero16() { f32x16 z; for (int i = 0; i < 16; ++i) z[i] = 0.f; return z; }
DI void kv_fetch(u32x4& kr, u32x4& vr, const bf16_t* kb, const bf16_t* vb, size_t rstride, int row0, int nrows, int tid) {
    asm volatile("" : "+v"(tid));
    const int row = row0 + (tid >> 3), c16 = tid & 7;
    if (row >= 0 && row < nrows) { kr = *(const u32x4*)(kb + (size_t)row * rstride + c16 * 8); vr = *(const u32x4*)(vb + (size_t)row * rstride + c16 * 8); }
    else { kr = (u32x4){0u, 0u, 0u, 0u}; vr = kr; }
}
DI void kv_store(LAS unsigned char* kl, LAS unsigned char* vl, const u32x4& kr, const u32x4& vr, int tid) {
    asm volatile("" : "+v"(tid));
    const int off = (tid >> 3) * KSTR + (tid & 7) * 16;
    *(LAS u32x4*)(kl + off) = kr; *(LAS u32x4*)(vl + off) = vr;
}
constexpr int DT_BYTES = 16384;
DI void kv_dma_issue(LAS unsigned char* slot, const bf16_t* kb, const bf16_t* vb, size_t rstride, int row0, int nrows, int wave, int lane) {
    asm volatile("" : "+v"(lane));
    const int rr = lane >> 3, row = min(max(row0 + 8 * wave + rr, 0), nrows - 1), ch = (lane & 7) ^ rr;
    const size_t off = (size_t)row * rstride + ch * 8;
    __builtin_amdgcn_global_load_lds((const unsigned*)(kb + off), (LAS unsigned*)(slot + wave * 1024), 16, 0, 0);
    __builtin_amdgcn_global_load_lds((const unsigned*)(vb + off), (LAS unsigned*)(slot + 8192 + wave * 1024), 16, 0, 0);
}
DI f32x16 qk_tile_sw(const LAS unsigned char* kl, int kt, const bf16x8 (&Q)[4], int lane) {
    asm volatile("" : "+v"(lane));
    const int r = lane & 31, h = lane >> 5;
    const int pr = (r & ~12) | ((r & 4) << 1) | ((r & 8) >> 1), sw = pr & 7;
    const LAS unsigned char* p = kl + (kt * 32 + pr) * 128;
    f32x16 S = zero16();
#pragma unroll
    for (int ks = 0; ks < 4; ++ks) { const bf16x8 A = *(const LAS bf16x8*)(p + (((2 * ks + h) ^ sw) << 4)); S = mfma32(A, Q[ks], S); }
    return S;
}
DI void pv_tile_sw(const LAS unsigned char* vl, int kt, const f32x16& P, f32x16 (&O)[2], int lane) {
    asm volatile("" : "+v"(lane));
    const int i16 = lane & 15, q = i16 >> 2, p = i16 & 3, blk = (lane >> 4) & 1, h = lane >> 5;
#pragma unroll
    for (int s = 0; s < 2; ++s) {
        u32x4 pk; pk.x = cvt_pk_bf16(P[8 * s + 0], P[8 * s + 1]); pk.y = cvt_pk_bf16(P[8 * s + 2], P[8 * s + 3]); pk.z = cvt_pk_bf16(P[8 * s + 4], P[8 * s + 5]); pk.w = cvt_pk_bf16(P[8 * s + 6], P[8 * s + 7]);
        const bf16x8 Bp = __builtin_bit_cast(bf16x8, pk);
        const unsigned vp = (unsigned)(size_t)(vl + (kt * 32 + 16 * s + 8 * h + q) * 128 + 8 * (p & 1));
        const int c0 = 2 * blk + (p >> 1), c1 = 4 + c0;
        const unsigned a0 = vp + ((c0 ^ q) << 4), a1 = vp + 512 + ((c0 ^ (q + 4)) << 4), a2 = vp + ((c1 ^ q) << 4), a3 = vp + 512 + ((c1 ^ (q + 4)) << 4);
        s16x4 lo0, hi0, lo1, hi1;
        asm volatile("ds_read_b64_tr_b16 %0, %4\n\tds_read_b64_tr_b16 %1, %5\n\tds_read_b64_tr_b16 %2, %6\n\tds_read_b64_tr_b16 %3, %7\n\ts_waitcnt lgkmcnt(0)"
                     : "=&v"(lo0), "=&v"(hi0), "=&v"(lo1), "=&v"(hi1) : "v"(a0), "v"(a1), "v"(a2), "v"(a3) : "memory");
        O[0] = mfma32(__builtin_shufflevector(lo0, hi0, 0, 1, 2, 3, 4, 5, 6, 7), Bp, O[0]);
        O[1] = mfma32(__builtin_shufflevector(lo1, hi1, 0, 1, 2, 3, 4, 5, 6, 7), Bp, O[1]);
    }
}
template <int NS, class RowF, class CompF>
DI void kv_dma_pipeline(int n, const RowF& rowf, const CompF& comp, const bf16_t* kb, const bf16_t* vb, size_t rstride, int nrows, LAS unsigned char* ring, int wave, int lane) {
    if (n <= 0) return;
#pragma unroll
    for (int i = 0; i < NS - 1; ++i) if (i < n) kv_dma_issue(ring + i * DT_BYTES, kb, vb, rstride, rowf(i), nrows, wave, lane);
    int sc = 0, sn = NS - 1;
#pragma unroll 1
    for (int j = 0; j < n; ++j) {
        const int rem = min(n - 1 - j, NS - 2);
        if (rem >= 4) asm volatile("s_waitcnt vmcnt(8)" ::: "memory");
        else if (rem == 3) asm volatile("s_waitcnt vmcnt(6)" ::: "memory");
        else if (rem == 2) asm volatile("s_waitcnt vmcnt(4)" ::: "memory");
        else if (rem == 1) asm volatile("s_waitcnt vmcnt(2)" ::: "memory");
        else asm volatile("s_waitcnt vmcnt(0)" ::: "memory");
        __builtin_amdgcn_s_barrier(); asm volatile("" ::: "memory");
        comp(j, ring + sc * DT_BYTES, ring + sc * DT_BYTES + 8192);
        if (j + NS - 1 < n) kv_dma_issue(ring + sn * DT_BYTES, kb, vb, rstride, rowf(j + NS - 1), nrows, wave, lane);
        sc = (sc + 1 == NS) ? 0 : sc + 1; sn = (sn + 1 == NS) ? 0 : sn + 1;
    }
    asm volatile("s_waitcnt lgkmcnt(0)" ::: "memory"); __builtin_amdgcn_s_barrier(); asm volatile("" ::: "memory");
}
DI f32x16 qk_tile(const LAS unsigned char* kl, int kt, const bf16x8 (&Q)[4], int lane) {
    asm volatile("" : "+v"(lane));
    const int r = lane & 31, h = lane >> 5;
    const int pr = (r & ~12) | ((r & 4) << 1) | ((r & 8) >> 1);
    const LAS unsigned char* p = kl + (kt * 32 + pr) * KSTR + h * 16;
    f32x16 S = zero16();
#pragma unroll
    for (int ks = 0; ks < 4; ++ks) { const bf16x8 A = *(const LAS bf16x8*)(p + ks * 32); S = mfma32(A, Q[ks], S); }
    return S;
}
DI void pv_tile(const LAS unsigned char* vl, int kt, const f32x16& P, f32x16 (&O)[2], int lane) {
    asm volatile("" : "+v"(lane));
    const int i16 = lane & 15, q = i16 >> 2, p = i16 & 3, blk = (lane >> 4) & 1, h = lane >> 5;
#pragma unroll
    for (int s = 0; s < 2; ++s) {
        u32x4 pk; pk.x = cvt_pk_bf16(P[8 * s + 0], P[8 * s + 1]); pk.y = cvt_pk_bf16(P[8 * s + 2], P[8 * s + 3]); pk.z = cvt_pk_bf16(P[8 * s + 4], P[8 * s + 5]); pk.w = cvt_pk_bf16(P[8 * s + 6], P[8 * s + 7]);
        const bf16x8 Bp = __builtin_bit_cast(bf16x8, pk);
        const LAS unsigned char* vp = vl + (kt * 32 + 16 * s + 8 * h + q) * KSTR + (16 * blk + 4 * p) * 2;
#pragma unroll
        for (int dt = 0; dt < 2; ++dt) {
            const s16x4 lo = __builtin_amdgcn_ds_read_tr16_b64_v4i16((LAS s16x4*)(vp + dt * 64));
            const s16x4 hi = __builtin_amdgcn_ds_read_tr16_b64_v4i16((LAS s16x4*)(vp + dt * 64 + 4 * KSTR));
            const bf16x8 A = __builtin_shufflevector(lo, hi, 0, 1, 2, 3, 4, 5, 6, 7);
            O[dt] = mfma32(A, Bp, O[dt]);
        }
    }
}
DI void store_o(bf16_t* orow, const f32x16 (&O)[2], float sc, int h) {
#pragma unroll
    for (int dt = 0; dt < 2; ++dt)
#pragma unroll
        for (int g = 0; g < 4; ++g) { u32x2 w; w.x = cvt_pk_bf16(O[dt][4 * g] * sc, O[dt][4 * g + 1] * sc); w.y = cvt_pk_bf16(O[dt][4 * g + 2] * sc, O[dt][4 * g + 3] * sc);
            *(u32x2*)(orow + dt * 32 + 8 * g + 4 * h) = w; }
}

constexpr int BT_PAD = 128, BT_LEN = BT_PAD + 2048;
constexpr int DIST_ANY = 0x3fffffff, DIST_NONE = 0x40000000;
constexpr size_t WS_BIASG = WS_SMALL + 256 * 1024;
DI void load_bias_table(LAS float* dst, const float* biasG, int head, int dsh, int tid) {
    for (int i = tid; i < BT_LEN; i += NTHR) { const int n = i - BT_PAD; dst[i] = (n >= 0) ? biasG[head * 2048 + min(n << dsh, 2047)] : 0.f; }
}
template <int STRIDE, bool MASKED>
DI float logits_tile(f32x16 (&S)[2], const LAS float* P, int D0, int h, int lo, unsigned range) {
    float mx = -1e30f;
#pragma unroll
    for (int sub = 0; sub < 2; ++sub)
#pragma unroll
        for (int s = 0; s < 2; ++s) {
            const int d0 = D0 - (32 * sub + 16 * s + 8 * h) * STRIDE;
            const int base = min(max(d0 - 7 * STRIDE + BT_PAD, 0), BT_LEN - 1 - 7 * STRIDE);
            const LAS float* pb = P + base;
#pragma unroll
            for (int j = 0; j < 8; ++j) { const int i = 8 * s + j;
                float x = S[sub][i] * (0.125f * LOG2E) + pb[(7 - j) * STRIDE];
                if (MASKED) x = ((unsigned)(d0 - j * STRIDE - lo) <= range) ? x : -1e30f;
                S[sub][i] = x; mx = fmaxf(mx, x); }
        }
    return mx;
}
template <int STRIDE, bool MASKED>
DI void softmax_tile(f32x16 (&S)[2], float& m, float& l, f32x16 (&O)[2], const LAS float* P, int D0, int h, int lo, unsigned range) {
    float mx = logits_tile<STRIDE, MASKED>(S, P, D0, h, lo, range);
    mx = fmaxf(mx, __shfl_xor(mx, 32));
    const float mnew = fmaxf(m, mx), mm = (mnew <= -1e30f) ? 0.f : mnew;
    float ls = 0.f;
#pragma unroll
    for (int sub = 0; sub < 2; ++sub)
#pragma unroll
        for (int i = 0; i < 16; ++i) { const float p = __builtin_amdgcn_exp2f(S[sub][i] - mm); S[sub][i] = p; ls += p; }
    ls += __shfl_xor(ls, 32);
    if (!__all(mnew == m)) {
        const float alpha = __builtin_amdgcn_exp2f(m - mnew);
        l *= alpha;
#pragma unroll
        for (int dt = 0; dt < 2; ++dt)
#pragma unroll
            for (int i = 0; i < 16; ++i) O[dt][i] *= alpha;
    }
    l += ls; m = mnew;
}
template <int STRIDE, bool MASKED>
DI void stats_tile(f32x16 (&S)[2], float& m, float& l, const LAS float* P, int D0, int h, int lo, unsigned range) {
    float mx = logits_tile<STRIDE, MASKED>(S, P, D0, h, lo, range);
    mx = fmaxf(mx, __shfl_xor(mx, 32));
    const float mnew = fmaxf(m, mx), mm = (mnew <= -1e30f) ? 0.f : mnew;
    float ls = 0.f;
#pragma unroll
    for (int sub = 0; sub < 2; ++sub)
#pragma unroll
        for (int i = 0; i < 16; ++i) ls += __builtin_amdgcn_exp2f(S[sub][i] - mm);
    ls += __shfl_xor(ls, 32);
    l = l * __builtin_amdgcn_exp2f(m - mnew) + ls; m = mnew;
}

constexpr size_t BIG_OG = 288 * MiB;
constexpr size_t BIG_LSE = 384 * MiB;
DI void dilated_phase(const Args& a, LAS unsigned char* lds) {
    int tid = tid_of(a.wv); asm volatile("" : "+v"(tid));
    const int lane = tid & 63, wave = __builtin_amdgcn_readfirstlane(tid >> 6), c = lane & 31, h = lane >> 5;
    const bf16_t* qkv = (const bf16_t*)(a.ws + WS_BIG);
    LAS unsigned char* kbuf = lds; LAS unsigned char* vbuf = lds + 2 * KV_TILE_BYTES;
    LAS float* btab = (LAS float*)(lds + 4 * KV_TILE_BYTES);
    const float* biasG = (const float*)(a.ws + WS_BIASG);
    for (int u = blockIdx.x; u < 3072; u += gridDim.x) {
        const int g = u >> 10, hh = (u >> 6) & 15, idx = u & 63;
        const int dsh = 2 * g, d = 1 << dsh;
        const int r = idx & (d - 1), blk = idx >> dsh;
        const int Q0 = blk * 256, q0w = Q0 + 32 * wave, iq = q0w + c;
        const int L = SEQ >> dsh;
        const bf16_t* qb = qkv + (size_t)r * 9216 + g * 3072 + hh * 64;
        const bf16_t* kb = qb + 1024; const bf16_t* vb = qb + 2048;
        const size_t rstride = (size_t)9216 << dsh;
        __syncthreads();
        load_bias_table(btab, biasG, hh, dsh, tid);
        bf16x8 Q[4];
        { const bf16_t* qrow = qb + (size_t)iq * rstride;
#pragma unroll
          for (int ks = 0; ks < 4; ++ks) Q[ks] = *(const bf16x8*)(qrow + 16 * ks + 8 * h); }
        f32x16 O[2]; O[0] = zero16(); O[1] = zero16();
        float m = -1e30f, l = 0.f;
        u32x4 kr, vr; int buf = 0;
        kv_fetch(kr, vr, kb, vb, rstride, Q0 - 128, L, tid); kv_store(kbuf, vbuf, kr, vr, tid);
        __syncthreads();
        for (int j = 0; j < 6; ++j) {
            if (j < 5) kv_fetch(kr, vr, kb, vb, rstride, Q0 - 128 + 64 * (j + 1), L, tid);
            const int kr0 = Q0 - 128 + 64 * j;
            if (kr0 <= q0w + 31 && kr0 + 63 >= q0w - 128 && kr0 + 63 >= 0) {
                const LAS unsigned char* kl = kbuf + buf * KV_TILE_BYTES; const LAS unsigned char* vl = vbuf + buf * KV_TILE_BYTES;
                f32x16 S[2]; S[0] = qk_tile(kl, 0, Q, lane); S[1] = qk_tile(kl, 1, Q, lane);
                softmax_tile<1, true>(S, m, l, O, btab, iq - kr0, h, 0, (unsigned)min(128, iq));
                pv_tile(vl, 0, S[0], O, lane); pv_tile(vl, 1, S[1], O, lane);
            }
            if (j < 5) kv_store(kbuf + (buf ^ 1) * KV_TILE_BYTES, vbuf + (buf ^ 1) * KV_TILE_BYTES, kr, vr, tid);
            __syncthreads();
            buf ^= 1;
        }
        const int tok = (iq << dsh) + r;
        bf16_t* og = (bf16_t*)(a.ws + WS_BIG + BIG_OG) + (size_t)g * SEQ * D;
        float* lse = (float*)(a.ws + WS_BIG + BIG_LSE) + (size_t)g * SEQ * 16;
        store_o(og + (size_t)tok * D + hh * 64, O, 1.f / l, h);
        if (h == 0) lse[tok * 16 + hh] = m + __builtin_amdgcn_logf(l);
    }
}
DI void dilated_merge(const Args& a, int b) {
    const int tid = tid_of(a.wv);
    const bf16_t* og = (const bf16_t*)(a.ws + WS_BIG + BIG_OG); const float* lse = (const float*)(a.ws + WS_BIG + BIG_LSE);
    bf16_t* outb = (bf16_t*)(a.ws + WS_ACTB) + (size_t)b * SEQ * D;
    for (int i = blockIdx.x * NTHR + tid; i < SEQ * 128; i += gridDim.x * NTHR) {
        const int tok = i >> 7, c8 = i & 127, hh = c8 >> 3;
        const float l0 = lse[tok * 16 + hh], l1 = lse[SEQ * 16 + tok * 16 + hh], l2 = lse[2 * SEQ * 16 + tok * 16 + hh];
        const float mx = fmaxf(l0, fmaxf(l1, l2));
        float w0 = __builtin_amdgcn_exp2f(l0 - mx), w1 = __builtin_amdgcn_exp2f(l1 - mx), w2 = __builtin_amdgcn_exp2f(l2 - mx);
        const float inv = 1.f / (w0 + w1 + w2); w0 *= inv; w1 *= inv; w2 *= inv;
        const u32x4 a0 = *(const u32x4*)(og + (size_t)tok * D + c8 * 8), a1 = *(const u32x4*)(og + (size_t)SEQ * D + (size_t)tok * D + c8 * 8), a2 = *(const u32x4*)(og + (size_t)2 * SEQ * D + (size_t)tok * D + c8 * 8);
        u32x4 o;
        o.x = pk2(w0 * bf_lo(a0.x) + w1 * bf_lo(a1.x) + w2 * bf_lo(a2.x), w0 * bf_hi(a0.x) + w1 * bf_hi(a1.x) + w2 * bf_hi(a2.x));
        o.y = pk2(w0 * bf_lo(a0.y) + w1 * bf_lo(a1.y) + w2 * bf_lo(a2.y), w0 * bf_hi(a0.y) + w1 * bf_hi(a1.y) + w2 * bf_hi(a2.y));
        o.z = pk2(w0 * bf_lo(a0.z) + w1 * bf_lo(a1.z) + w2 * bf_lo(a2.z), w0 * bf_hi(a0.z) + w1 * bf_hi(a1.z) + w2 * bf_hi(a2.z));
        o.w = pk2(w0 * bf_lo(a0.w) + w1 * bf_lo(a1.w) + w2 * bf_lo(a2.w), w0 * bf_hi(a0.w) + w1 * bf_hi(a1.w) + w2 * bf_hi(a2.w));
        *(u32x4*)(outb + (size_t)tok * D + c8 * 8) = o;
    }
}

constexpr size_t MB_KMEAN = WS_ACTB, MB_SELW = WS_ACTB + 1 * MiB, MB_LIST = WS_ACTB + 4 * MiB;
constexpr size_t BIG_OSEL = 192 * MiB, BIG_LSESEL = 384 * MiB;
constexpr int CW_MBCNT = 32768, CW_MBCUR = 32768 + 2048;
constexpr int MB_LISTCAP = 49152;
DI void moba_kmean_phase(const Args& a) {
    const int tid = tid_of(a.wv);
    const bf16_t* qkv = (const bf16_t*)(a.ws + WS_BIG);
    float* kmean = (float*)(a.ws + MB_KMEAN);
    for (int i = blockIdx.x * NTHR + tid; i < 2048 * 8; i += gridDim.x * NTHR) {
        const int c8 = i & 7, n = (i >> 3) & 63, bh = i >> 9, b = bh >> 4, hh = bh & 15;
        const bf16_t* kp = qkv + ((size_t)b * SEQ + n * 256) * 3072 + 1024 + hh * 64 + c8 * 8;
        float s[8];
#pragma unroll
        for (int j = 0; j < 8; ++j) s[j] = 0.f;
        for (int k = 0; k < 256; ++k) { const u32x4 v = *(const u32x4*)(kp + (size_t)k * 3072);
            s[0] += bf_lo(v.x); s[1] += bf_hi(v.x); s[2] += bf_lo(v.y); s[3] += bf_hi(v.y); s[4] += bf_lo(v.z); s[5] += bf_hi(v.z); s[6] += bf_lo(v.w); s[7] += bf_hi(v.w); }
#pragma unroll
        for (int j = 0; j < 8; ++j) kmean[((size_t)bh * 64 + n) * 64 + c8 * 8 + j] = s[j] * (1.f / 256.f);
    }
}
DI void moba_gate_phase(const Args& a, LAS unsigned char* lds) {
    int tid = tid_of(a.wv); asm volatile("" : "+v"(tid));
    const int lane = tid & 63, wave = __builtin_amdgcn_readfirstlane(tid >> 6), c = lane & 31, h = lane >> 5;
    const bf16_t* qkv = (const bf16_t*)(a.ws + WS_BIG);
    const float* kmean = (const float*)(a.ws + MB_KMEAN);
    unsigned* selw = (unsigned*)(a.ws + MB_SELW);
    unsigned* cnt = (unsigned*)(a.ws + WS_CTL) + CW_MBCNT;
    LAS unsigned char* khi = lds; LAS unsigned char* klo = lds + KV_TILE_BYTES;
    LAS int* hist = (LAS int*)(lds + 2 * KV_TILE_BYTES);
    for (int u = blockIdx.x; u < 2048; u += gridDim.x) {
        const int qb = u & 63, bh = u >> 6, b = bh >> 4, hh = bh & 15;
        const int t = qb * 256 + 32 * wave + c;
        __syncthreads();
        { const int row = tid >> 3, c16 = tid & 7; const float* kp = kmean + ((size_t)bh * 64 + row) * 64 + c16 * 8;
          const f32x4 v0 = *(const f32x4*)kp, v1 = *(const f32x4*)(kp + 4);
          float v[8] = {v0.x, v0.y, v0.z, v0.w, v1.x, v1.y, v1.z, v1.w}; unsigned hi[8], lo[8];
#pragma unroll
          for (int j = 0; j < 8; ++j) { hi[j] = f2bf(v[j]); lo[j] = f2bf(v[j] - u2f(hi[j] << 16)); }
          u32x4 wh, wl; wh.x = hi[0] | (hi[1] << 16); wh.y = hi[2] | (hi[3] << 16); wh.z = hi[4] | (hi[5] << 16); wh.w = hi[6] | (hi[7] << 16);
          wl.x = lo[0] | (lo[1] << 16); wl.y = lo[2] | (lo[3] << 16); wl.z = lo[4] | (lo[5] << 16); wl.w = lo[6] | (lo[7] << 16);
          kv_store(khi, klo, wh, wl, tid); }
        if (tid < 64) hist[tid] = 0;
        __syncthreads();
        bf16x8 Q[4];
        { const bf16_t* qrow = qkv + ((size_t)b * SEQ + t) * 3072 + hh * 64;
#pragma unroll
          for (int ks = 0; ks < 4; ++ks) Q[ks] = *(const bf16x8*)(qrow + 16 * ks + 8 * h); }
        f32x16 Gs[2];
#pragma unroll
        for (int sub = 0; sub < 2; ++sub) { const f32x16 a0 = qk_tile(khi, sub, Q, lane), a1 = qk_tile(klo, sub, Q, lane);
#pragma unroll
            for (int i = 0; i < 16; ++i) { const int n = sub * 32 + 16 * (i >> 3) + 8 * h + (i & 7); Gs[sub][i] = (n < qb) ? (a0[i] + a1[i]) : -1e30f; } }
        unsigned selpack = 0;
#pragma unroll
        for (int pass = 0; pass < 3; ++pass) {
            float bv = -3e38f; int bn = 64;
#pragma unroll
            for (int sub = 0; sub < 2; ++sub)
#pragma unroll
                for (int i = 0; i < 16; ++i) { const int n = sub * 32 + 16 * (i >> 3) + 8 * h + (i & 7); const float v = Gs[sub][i];
                    if (v > bv || (v == bv && n < bn)) { bv = v; bn = n; } }
            const float pv = __shfl_xor(bv, 32); const int pn = __shfl_xor(bn, 32);
            if (pv > bv || (pv == bv && pn < bn)) { bv = pv; bn = pn; }
            const bool ok = bv > -1e29f;
            selpack |= (ok ? (unsigned)bn : 255u) << (8 * pass);
            if (ok && h == 0) atomicAdd((int*)(hist + bn), 1);
#pragma unroll
            for (int sub = 0; sub < 2; ++sub)
#pragma unroll
                for (int i = 0; i < 16; ++i) { const int n = sub * 32 + 16 * (i >> 3) + 8 * h + (i & 7); if (n == bn) Gs[sub][i] = -3e38f; }
        }
        if (h == 0) selw[(size_t)bh * SEQ + t] = selpack;
        __syncthreads();
        if (tid < 64 && hist[tid] > 0) xb_add(cnt + bh * 64 + tid, (unsigned)hist[tid]);
    }
}
DI void moba_fill_phase(const Args& a, LAS unsigned char* lds) {
    const int tid = tid_of(a.wv);
    const unsigned* selw = (const unsigned*)(a.ws + MB_SELW);
    unsigned* cnt = (unsigned*)(a.ws + WS_CTL) + CW_MBCNT; unsigned* cur = (unsigned*)(a.ws + WS_CTL) + CW_MBCUR;
    unsigned* list = (unsigned*)(a.ws + MB_LIST);
    LAS int* hist = (LAS int*)lds; LAS int* gb = hist + 64; LAS int* off = gb + 64;
    for (int u = blockIdx.x; u < 2048; u += gridDim.x) {
        const int qb = u & 63, bh = u >> 6;
        __syncthreads();
        if (tid < 64) hist[tid] = 0;
        if (tid == 64) { int acc = 0; for (int n = 0; n < 64; ++n) { off[n] = acc; acc += (int)xb_ld(cnt + bh * 64 + n); } }
        __syncthreads();
        unsigned sp = 0xffffffffu; int lp[3] = {0, 0, 0};
        if (tid < 256) { sp = selw[(size_t)bh * SEQ + qb * 256 + tid];
#pragma unroll
            for (int k = 0; k < 3; ++k) { const unsigned n = (sp >> (8 * k)) & 255u; if (n < 64u) lp[k] = atomicAdd((int*)(hist + n), 1); } }
        __syncthreads();
        if (tid < 64 && hist[tid] > 0) gb[tid] = (int)xb_add(cur + bh * 64 + tid, (unsigned)hist[tid]);
        __syncthreads();
        if (tid < 256) {
#pragma unroll
            for (int k = 0; k < 3; ++k) { const unsigned n = (sp >> (8 * k)) & 255u;
                if (n < 64u) list[(size_t)bh * MB_LISTCAP + off[n] + gb[n] + lp[k]] = (unsigned)(qb * 256 + tid) | ((unsigned)k << 14); } }
    }
}
DI void moba_sel_phase(const Args& a, LAS unsigned char* lds) {
    int tid = tid_of(a.wv); asm volatile("" : "+v"(tid));
    const int lane = tid & 63, wave = __builtin_amdgcn_readfirstlane(tid >> 6), c = lane & 31, h = lane >> 5;
    const bf16_t* qkv = (const bf16_t*)(a.ws + WS_BIG);
    const unsigned* cnt = (const unsigned*)(a.ws + WS_CTL) + CW_MBCNT;
    const unsigned* list = (const unsigned*)(a.ws + MB_LIST);
    bf16_t* osel = (bf16_t*)(a.ws + WS_BIG + BIG_OSEL); float* lsesel = (float*)(a.ws + WS_BIG + BIG_LSESEL);
    const float* biasG = (const float*)(a.ws + WS_BIASG);
    LAS unsigned char* kbuf = lds; LAS unsigned char* vbuf = lds + 2 * KV_TILE_BYTES;
    LAS float* btab = (LAS float*)(lds + 4 * KV_TILE_BYTES);
    LAS int* cs = (LAS int*)(lds + 4 * KV_TILE_BYTES + BT_LEN * 4);
    LAS int* eo = cs + 2052;
    LAS int* part = eo + 2052;
    { int cc[4], ee[4], sc = 0, se = 0;
#pragma unroll
      for (int j = 0; j < 4; ++j) { const int v = (int)xb_ld((unsigned*)cnt + tid * 4 + j); ee[j] = se; cc[j] = sc; se += v; sc += (v + 255) >> 8; }
      part[tid] = sc; part[512 + tid] = se;
      __syncthreads();
      if (tid == 0) { int a0 = 0, a1 = 0; for (int i = 0; i < 512; ++i) { const int v0 = part[i], v1 = part[512 + i]; part[i] = a0; part[512 + i] = a1; a0 += v0; a1 += v1; } cs[2048] = a0; eo[2048] = a1; }
      __syncthreads();
#pragma unroll
      for (int j = 0; j < 4; ++j) { cs[tid * 4 + j] = part[tid] + cc[j]; eo[tid * 4 + j] = part[512 + tid] + ee[j]; }
      __syncthreads(); }
    const int NC = cs[2048];
    int cur_hh = -1;
    for (int u = blockIdx.x; u < NC; u += gridDim.x) {
        int lo = 0, hi = 2047;
        while (lo < hi) { const int mid = (lo + hi + 1) >> 1; if (cs[mid] <= u) lo = mid; else hi = mid - 1; }
        const int item = lo, bh = item >> 6, n = item & 63, b = bh >> 4, hh = bh & 15;
        const int chunk = u - cs[item], nent = (int)xb_ld((unsigned*)cnt + item) - chunk * 256;
        const size_t ebase = (size_t)bh * MB_LISTCAP + (eo[item] - eo[bh * 64]) + chunk * 256;
        __syncthreads();
        if (hh != cur_hh) { load_bias_table(btab, biasG, hh, 0, tid); cur_hh = hh; }
        const int e = 32 * wave + c; const bool ev = e < nent;
        const unsigned ent = list[ebase + (ev ? e : 0)];
        const int t = ent & 16383, slot = ent >> 14;
        bf16x8 Q[4];
        { const bf16_t* qrow = qkv + ((size_t)b * SEQ + t) * 3072 + hh * 64;
#pragma unroll
          for (int ks = 0; ks < 4; ++ks) Q[ks] = *(const bf16x8*)(qrow + 16 * ks + 8 * h); }
        const bf16_t* kb = qkv + (size_t)b * SEQ * 3072 + 1024 + hh * 64; const bf16_t* vb = kb + 1024;
        f32x16 O[2]; O[0] = zero16(); O[1] = zero16();
        float m = -1e30f, l = 0.f;
        u32x4 kr, vr; int buf = 0;
        kv_fetch(kr, vr, kb, vb, 3072, n * 256, SEQ, tid); kv_store(kbuf, vbuf, kr, vr, tid);
        __syncthreads();
        for (int j = 0; j < 4; ++j) {
            if (j < 3) kv_fetch(kr, vr, kb, vb, 3072, n * 256 + 64 * (j + 1), SEQ, tid);
            const int k0 = n * 256 + 64 * j;
            if (32 * wave < nent) {
                const LAS unsigned char* kl = kbuf + buf * KV_TILE_BYTES; const LAS unsigned char* vl = vbuf + buf * KV_TILE_BYTES;
                f32x16 S[2]; S[0] = qk_tile(kl, 0, Q, lane); S[1] = qk_tile(kl, 1, Q, lane);
                softmax_tile<1, false>(S, m, l, O, btab, t - k0, h, 0, (unsigned)DIST_ANY);
                pv_tile(vl, 0, S[0], O, lane); pv_tile(vl, 1, S[1], O, lane);
            }
            if (j < 3) kv_store(kbuf + (buf ^ 1) * KV_TILE_BYTES, vbuf + (buf ^ 1) * KV_TILE_BYTES, kr, vr, tid);
            __syncthreads();
            buf ^= 1;
        }
        if (ev) { const size_t ob = ((size_t)bh * SEQ + t) * 3 + slot;
            store_o(osel + ob * 64, O, 1.f / l, h);
            if (h == 0) lsesel[ob] = m + __builtin_amdgcn_logf(l); }
    }
}
DI void moba_own_phase(const Args& a, LAS unsigned char* lds) {
    int tid = tid_of(a.wv); asm volatile("" : "+v"(tid));
    const int lane = tid & 63, wave = __builtin_amdgcn_readfirstlane(tid >> 6), c = lane & 31, h = lane >> 5;
    const bf16_t* qkv = (const bf16_t*)(a.ws + WS_BIG);
    const bf16_t* osel = (const bf16_t*)(a.ws + WS_BIG + BIG_OSEL); const float* lsesel = (const float*)(a.ws + WS_BIG + BIG_LSESEL);
    bf16_t* outb = (bf16_t*)(a.ws + WS_ACTB);
    const float* biasG = (const float*)(a.ws + WS_BIASG);
    LAS unsigned char* kbuf = lds; LAS unsigned char* vbuf = lds + 2 * KV_TILE_BYTES;
    LAS float* btab = (LAS float*)(lds + 4 * KV_TILE_BYTES);
    int cur_hh = -1;
    for (int u = blockIdx.x; u < 2048; u += gridDim.x) {
        const int qb = u & 63, bh = u >> 6, b = bh >> 4, hh = bh & 15;
        const int q0w = qb * 256 + 32 * wave, t = q0w + c;
        __syncthreads();
        if (hh != cur_hh) { load_bias_table(btab, biasG, hh, 0, tid); cur_hh = hh; }
        bf16x8 Q[4];
        { const bf16_t* qrow = qkv + ((size_t)b * SEQ + t) * 3072 + hh * 64;
#pragma unroll
          for (int ks = 0; ks < 4; ++ks) Q[ks] = *(const bf16x8*)(qrow + 16 * ks + 8 * h); }
        const bf16_t* kb = qkv + (size_t)b * SEQ * 3072 + 1024 + hh * 64; const bf16_t* vb = kb + 1024;
        f32x16 O[2]; O[0] = zero16(); O[1] = zero16();
        float m = -1e30f, l = 0.f;
        u32x4 kr, vr; int buf = 0;
        kv_fetch(kr, vr, kb, vb, 3072, qb * 256, SEQ, tid); kv_store(kbuf, vbuf, kr, vr, tid);
        __syncthreads();
        for (int j = 0; j < 4; ++j) {
            if (j < 3) kv_fetch(kr, vr, kb, vb, 3072, qb * 256 + 64 * (j + 1), SEQ, tid);
            const int k0 = qb * 256 + 64 * j;
            if (k0 <= q0w + 31) {
                const LAS unsigned char* kl = kbuf + buf * KV_TILE_BYTES; const LAS unsigned char* vl = vbuf + buf * KV_TILE_BYTES;
                f32x16 S[2]; S[0] = qk_tile(kl, 0, Q, lane); S[1] = qk_tile(kl, 1, Q, lane);
                if (k0 + 63 <= q0w) softmax_tile<1, false>(S, m, l, O, btab, t - k0, h, 0, (unsigned)DIST_ANY);
                else softmax_tile<1, true>(S, m, l, O, btab, t - k0, h, 0, (unsigned)DIST_ANY);
                pv_tile(vl, 0, S[0], O, lane); pv_tile(vl, 1, S[1], O, lane);
            }
            if (j < 3) kv_store(kbuf + (buf ^ 1) * KV_TILE_BYTES, vbuf + (buf ^ 1) * KV_TILE_BYTES, kr, vr, tid);
            __syncthreads();
            buf ^= 1;
        }
        const int nv = qb < 3 ? qb : 3;
        const float lown = m + __builtin_amdgcn_logf(l);
        float ls[3]; float mx = lown;
        const size_t ob = ((size_t)bh * SEQ + t) * 3;
#pragma unroll
        for (int k = 0; k < 3; ++k) { ls[k] = (k < nv) ? lsesel[ob + k] : -1e30f; mx = fmaxf(mx, ls[k]); }
        float wown = __builtin_amdgcn_exp2f(lown - mx), wsum = wown, wk[3];
#pragma unroll
        for (int k = 0; k < 3; ++k) { wk[k] = (k < nv) ? __builtin_amdgcn_exp2f(ls[k] - mx) : 0.f; wsum += wk[k]; }
        const float inv = 1.f / wsum; wown *= inv / l;
#pragma unroll
        for (int dt = 0; dt < 2; ++dt)
#pragma unroll
            for (int i = 0; i < 16; ++i) O[dt][i] *= wown;
#pragma unroll
        for (int k = 0; k < 3; ++k) if (k < nv) { const float w = wk[k] * inv; const bf16_t* orow = osel + (ob + k) * 64;
#pragma unroll
            for (int dt = 0; dt < 2; ++dt)
#pragma unroll
                for (int g = 0; g < 4; ++g) { const u32x2 v = *(const u32x2*)(orow + dt * 32 + 8 * g + 4 * h);
                    O[dt][4 * g] += w * bf_lo(v.x); O[dt][4 * g + 1] += w * bf_hi(v.x); O[dt][4 * g + 2] += w * bf_lo(v.y); O[dt][4 * g + 3] += w * bf_hi(v.y); } }
        store_o(outb + ((size_t)b * SEQ + t) * D + hh * 64, O, 1.f, h);
    }
}

constexpr size_t NS_Q = 0, NS_KV = 64 * MiB, NS_GT = 164 * MiB, NS_HID = 172 * MiB, NS_KC = 180 * MiB, NS_KFR = 182 * MiB, NS_VFR = 198 * MiB;
DI void nsa_kcvc_phase(const Args& a, LAS unsigned char* lds) {
    int tid = tid_of(a.wv); asm volatile("" : "+v"(tid));
    {
        const bf16_t* kv6 = (const bf16_t*)(a.ws + WS_BIG + NS_KV); u32x4* kfr = (u32x4*)(a.ws + WS_BIG + NS_KFR); u32x4* vfr = (u32x4*)(a.ws + WS_BIG + NS_VFR);
        for (int tl = blockIdx.x; tl < 2048; tl += gridDim.x) {
            const int bg = tl >> 8, t0 = (tl & 255) * 64, b = bg >> 2, g = bg & 3;
            __syncthreads();
            { const int row = tid >> 3, c16 = tid & 7; const bf16_t* src_ = kv6 + ((size_t)b * SEQ + t0 + row) * 1536 + 2 * 256 + g * 64 + c16 * 8;
              *(LAS u32x4*)(lds + row * KSTR + c16 * 16) = *(const u32x4*)src_; *(LAS u32x4*)(lds + KV_TILE_BYTES + row * KSTR + c16 * 16) = *(const u32x4*)(src_ + 256); }
            __syncthreads();
            { const int f = tid >> 6, ln = tid & 63, r31 = ln & 31, hh = ln >> 5;
              { const int kt = f >> 2, ks = f & 3, pr = (r31 & ~12) | ((r31 & 4) << 1) | ((r31 & 8) >> 1);
                kfr[((size_t)tl * 8 + f) * 64 + ln] = *(const LAS u32x4*)(lds + (kt * 32 + pr) * KSTR + (16 * ks + 8 * hh) * 2); }
              { const int kt = f >> 2, s = (f >> 1) & 1, dt = f & 1; unsigned v[8];
#pragma unroll
                for (int i = 0; i < 8; ++i) v[i] = *(const LAS unsigned short*)(lds + KV_TILE_BYTES + (kt * 32 + 16 * s + 8 * hh + i) * KSTR + (dt * 32 + r31) * 2);
                u32x4 w; w.x = v[0] | (v[1] << 16); w.y = v[2] | (v[3] << 16); w.z = v[4] | (v[5] << 16); w.w = v[6] | (v[7] << 16);
                vfr[((size_t)tl * 8 + f) * 64 + ln] = w; } }
        }
    }
    const int lane = tid & 63, wave = __builtin_amdgcn_readfirstlane(tid >> 6), c = lane & 31, h = lane >> 5;
    const bf16_t* hidden = (const bf16_t*)(a.ws + WS_BIG + NS_HID); const bf16_t* w2t = (const bf16_t*)(a.ws + WS_WCMP) + 2 * 256 * 2048;
    bf16_t* kcvc = (bf16_t*)(a.ws + WS_BIG + NS_KC);
    for (int task = blockIdx.x * NWAVES + wave; task < 512; task += gridDim.x * NWAVES) {
        const int j = task >> 8, R0 = (task & 255) * 32;
        const bf16_t* hid = hidden + ((size_t)j * 8192 + R0 + c) * 256; const bf16_t* w2 = w2t + j * 64 * 256;
        f32x16 acc[2]; acc[0] = zero16(); acc[1] = zero16();
#pragma unroll
        for (int ks = 0; ks < 16; ++ks) { const bf16x8 Bv = *(const bf16x8*)(hid + 16 * ks + 8 * h);
#pragma unroll
            for (int dt = 0; dt < 2; ++dt) { const bf16x8 Av = *(const bf16x8*)(w2 + (dt * 32 + c) * 256 + 16 * ks + 8 * h); acc[dt] = mfma32(Av, Bv, acc[dt]); } }
        store_o(kcvc + ((size_t)j * 8192 + R0 + c) * 64, acc, 1.f, h);
    }
}
DI void nsa_attn_phase(const Args& a, LAS unsigned char* lds) {
    const int wave = a.wv;
#define NSA_VARS int tid = tid_of(a.wv); const int lane = tid & 63, c = lane & 31, h = lane >> 5, qi = c >> 2, r = c & 3, t = tw0 + qi; \
    const LAS float* bt = btab + r * BT_LEN; const float* gtp = gates + (tokbase + t) * 48 + 4 * g + r; (void)bt; (void)h; (void)lane; (void)gtp;
    const bf16_t* qb_ = (const bf16_t*)(a.ws + WS_BIG + NS_Q); const bf16_t* kv6 = (const bf16_t*)(a.ws + WS_BIG + NS_KV);
    const float* gates = (const float*)(a.ws + WS_BIG + NS_GT); const bf16_t* kcvc = (const bf16_t*)(a.ws + WS_BIG + NS_KC);
    bf16_t* outb = (bf16_t*)(a.ws + WS_ACTB); const float* biasG = (const float*)(a.ws + WS_BIASG);
    LAS unsigned char* ring = lds;
    LAS float* imp = (LAS float*)(lds + 49152);
    LAS float* btab = (LAS float*)(lds + 115712);
    LAS unsigned* selm = (LAS unsigned*)(lds + 150528);
    LAS unsigned* wm = selm + 512;
    LAS int* blist = (LAS int*)(wm + 64);
    LAS int* Oacc = (LAS int*)imp;
    LAS int* lacc = (LAS int*)(lds + 154112);
    constexpr float FXS = 16384.f;
    LAS float* mref = (LAS float*)(lds + 155136);
    LAS unsigned long long* qmask = (LAS unsigned long long*)(lds + 156160);
    LAS int* qsel = (LAS int*)(lds + 158208);
    const bf16x8* kfr = (const bf16x8*)(a.ws + WS_BIG + NS_KFR); const bf16x8* vfr = (const bf16x8*)(a.ws + WS_BIG + NS_VFR);
    int cur_g = -1;
    for (int k = 0;; ++k) {
        const int u = blockIdx.x + k * gridDim.x; if (u >= 2048) break;
        const int bg = u >> 8, ti = u & 255, tile = (k & 1) ? 255 - ti : ti, b = bg >> 2, g = bg & 3;
        const int T0 = tile * 64, tw0 = T0 + 8 * wave;
        const size_t tokbase = (size_t)b * SEQ;
        __syncthreads();
        bf16x8 Q[4];
        { NSA_VARS
          if (g != cur_g) { for (int rr = 0; rr < 4; ++rr) load_bias_table(btab + rr * BT_LEN, biasG, 4 * g + rr, 0, tid); cur_g = g; }
          for (int i = tid; i < 64 * 260; i += NTHR) imp[i] = 0.f;
          const bf16_t* qrow = qb_ + (tokbase + t) * 1024 + (4 * g + r) * 64;
#pragma unroll
          for (int ks = 0; ks < 4; ++ks) Q[ks] = *(const bf16x8*)(qrow + 16 * ks + 8 * h); }
        f32x16 OUT[2]; OUT[0] = zero16(); OUT[1] = zero16();
        const int nct = (T0 + 63 >= 31) ? (((T0 + 32) >> 4) >> 6) + 1 : 0;
        const bf16_t* kcb = kcvc + (size_t)bg * 1024 * 64; const bf16_t* vcb = kcb + (size_t)8192 * 64;
        if (nct > 0) {
            NSA_VARS
            const float gt_cmp = gtp[0];
            float mc = -1e30f, lc = 0.f;
            __syncthreads();
            kv_dma_pipeline<3>(nct, [&](int j) { return 64 * j; }, [&](int j, const LAS unsigned char* kl, const LAS unsigned char* vl) {
                const int c0 = 64 * j; (void)vl;
                if (16 * c0 + 31 <= tw0 + 7) {
                    f32x16 S[2]; S[0] = qk_tile_sw(kl, 0, Q, lane); S[1] = qk_tile_sw(kl, 1, Q, lane);
                    if (16 * (c0 + 63) + 31 <= tw0) stats_tile<16, false>(S, mc, lc, bt, t - 16 * c0 - 31, h, 0, (unsigned)DIST_ANY);
                    else stats_tile<16, true>(S, mc, lc, bt, t - 16 * c0 - 31, h, 0, (unsigned)DIST_ANY);
                } }, kcb, vcb, 64, 1024, ring, wave, lane);
            const float invl = lc > 0.f ? 1.f / lc : 0.f, mfin = (mc <= -1e30f) ? 0.f : mc;
            f32x16 Oc[2]; Oc[0] = zero16(); Oc[1] = zero16();
            kv_dma_pipeline<3>(nct, [&](int j) { return 64 * j; }, [&](int j, const LAS unsigned char* kl, const LAS unsigned char* vl) {
                const int c0 = 64 * j;
                if (16 * c0 + 31 <= tw0 + 7) {
                    f32x16 S[2]; S[0] = qk_tile_sw(kl, 0, Q, lane); S[1] = qk_tile_sw(kl, 1, Q, lane);
                    (void)logits_tile<16, true>(S, bt, t - 16 * c0 - 31, h, 0, (unsigned)DIST_ANY);
#pragma unroll
                    for (int sub = 0; sub < 2; ++sub)
#pragma unroll
                        for (int i = 0; i < 16; ++i) S[sub][i] = __builtin_amdgcn_exp2f(S[sub][i] - mfin) * invl;
#pragma unroll
                    for (int sub = 0; sub < 2; ++sub)
#pragma unroll
                        for (int s = 0; s < 2; ++s) { const int j0 = (c0 + sub * 32 + 16 * s + 8 * h) >> 2;
                            float a0 = (S[sub][8 * s] + S[sub][8 * s + 1]) + (S[sub][8 * s + 2] + S[sub][8 * s + 3]);
                            float a1 = (S[sub][8 * s + 4] + S[sub][8 * s + 5]) + (S[sub][8 * s + 6] + S[sub][8 * s + 7]) + S[sub][8 * s + 3];
                            float a2 = S[sub][8 * s + 7];
                            a0 += __shfl_xor(a0, 1); a1 += __shfl_xor(a1, 1); a2 += __shfl_xor(a2, 1);
                            a0 += __shfl_xor(a0, 2); a1 += __shfl_xor(a1, 2); a2 += __shfl_xor(a2, 2);
                            if (r == 0) { LAS float* ip = imp + (8 * wave + qi) * 260 + j0; atomicAdd((float*)ip, a0); atomicAdd((float*)(ip + 1), a1); atomicAdd((float*)(ip + 2), a2); } }
                    pv_tile_sw(vl, 0, S[0], Oc, lane); pv_tile_sw(vl, 1, S[1], Oc, lane);
                } }, kcb, vcb, 64, 1024, ring, wave, lane);
#pragma unroll
            for (int dt = 0; dt < 2; ++dt)
#pragma unroll
                for (int i = 0; i < 16; ++i) OUT[dt][i] += gt_cmp * Oc[dt][i];
        }
        __syncthreads();
#pragma unroll 1
        for (int qq = 0; qq < 8; ++qq) {
            const int lane = tid_of(a.wv) & 63;
            const int ql = 8 * wave + qq, tq = T0 + ql, cur = tq >> 6;
            float sc[4]; unsigned selbits = 0;
#pragma unroll
            for (int kk = 0; kk < 4; ++kk) { const int j = lane + 64 * kk; const bool forced = (j == 0) || (j == cur) || (j + 1 == cur);
                sc[kk] = forced ? 1e9f : ((j <= cur) ? imp[ql * 260 + j] : -1e30f); }
#pragma unroll 1
            for (int round = 0; round < 16; ++round) {
                float bv = sc[0]; int bj = lane;
#pragma unroll
                for (int kk = 1; kk < 4; ++kk) if (sc[kk] > bv) { bv = sc[kk]; bj = lane + 64 * kk; }
#pragma unroll
                for (int off = 1; off < 64; off <<= 1) { const float ov = __shfl_xor(bv, off); const int oj = __shfl_xor(bj, off); if (ov > bv || (ov == bv && oj < bj)) { bv = ov; bj = oj; } }
                if (!(bv > -1e29f)) break;
#pragma unroll
                for (int kk = 0; kk < 4; ++kk) if (bj == lane + 64 * kk) { sc[kk] = -3e38f; selbits |= 1u << kk; }
            }
#pragma unroll
            for (int kk = 0; kk < 4; ++kk) { const unsigned long long bal = __ballot((selbits >> kk) & 1u);
                if (lane == 0) { selm[ql * 8 + 2 * kk] = (unsigned)bal; selm[ql * 8 + 2 * kk + 1] = (unsigned)(bal >> 32); } }
        }
        __syncthreads();
        { const int tid = tid_of(a.wv);
          if (tid < 8) { unsigned o = 0xffffffffu; for (int q = 0; q < 64; ++q) o &= selm[q * 8 + tid]; wm[tid] = o; } }
        __syncthreads();
        { const int lane = tid_of(a.wv) & 63;
#pragma unroll 1
          for (int jj = 0; jj < 32; ++jj) { const int j = wave * 32 + jj; const unsigned w = selm[lane * 8 + (j >> 5)] & ~wm[j >> 5];
              const unsigned long long bal = __ballot((w >> (j & 31)) & 1u); if (lane == 0) qmask[j] = bal; }
          if (wave == 0) { int pos = 0;
              for (int kk = 0; kk < 4; ++kk) { const int j = lane + 64 * kk; const bool need = (wm[j >> 5] >> (j & 31)) & 1u; const unsigned long long bal = __ballot(need);
                  if (need) blist[1 + pos + __popcll(bal & ((1ull << lane) - 1ull))] = j;
                  pos += __popcll(bal); }
              if (lane == 0) blist[0] = pos; } }
        __syncthreads();
        {
            NSA_VARS
            const float gt_win = gtp[32];
            const int j0w = (T0 >= 511) ? ((T0 - 511) >> 6) : 0, j1w = tile;
            const bf16_t* kwb = kv6 + tokbase * 1536 + 4 * 256 + g * 64; const bf16_t* vwb = kwb + 256;
            f32x16 O[2]; O[0] = zero16(); O[1] = zero16(); float m = -1e30f, l = 0.f;
            kv_dma_pipeline<6>(j1w - j0w + 1, [&](int jj) { return (j0w + jj) * 64; }, [&](int jj, const LAS unsigned char* kl, const LAS unsigned char* vl) {
                const int k0 = (j0w + jj) * 64;
                if (k0 <= tw0 + 7 && k0 + 63 >= tw0 - 511) {
                    f32x16 S[2]; S[0] = qk_tile_sw(kl, 0, Q, lane); S[1] = qk_tile_sw(kl, 1, Q, lane);
                    if (k0 + 63 <= tw0 && k0 >= tw0 + 7 - 511) softmax_tile<1, false>(S, m, l, O, bt, t - k0, h, 0, 511u);
                    else softmax_tile<1, true>(S, m, l, O, bt, t - k0, h, 0, 511u);
                    pv_tile_sw(vl, 0, S[0], O, lane); pv_tile_sw(vl, 1, S[1], O, lane);
                } }, kwb, vwb, 1536, SEQ, ring, wave, lane);
            const float sc_ = gt_win / l;
#pragma unroll
            for (int dt = 0; dt < 2; ++dt)
#pragma unroll
                for (int i = 0; i < 16; ++i) OUT[dt][i] += sc_ * O[dt][i];
        }
        {
            NSA_VARS
            const int nb = blist[0];
            const bf16_t* ksb = kv6 + tokbase * 1536 + 2 * 256 + g * 64; const bf16_t* vsb = ksb + 256;
            f32x16 O[2]; O[0] = zero16(); O[1] = zero16(); float m = -1e30f, l = 0.f;
            kv_dma_pipeline<3>(nb, [&](int jj) { return blist[1 + jj] * 64; }, [&](int jj, const LAS unsigned char* kl, const LAS unsigned char* vl) {
                const int j = blist[1 + jj], k0 = j * 64;
                f32x16 S[2]; S[0] = qk_tile_sw(kl, 0, Q, lane); S[1] = qk_tile_sw(kl, 1, Q, lane);
                if (j < tile) softmax_tile<1, false>(S, m, l, O, bt, t - k0, h, 0, (unsigned)DIST_ANY);
                else softmax_tile<1, true>(S, m, l, O, bt, t - k0, h, 0, (unsigned)DIST_ANY);
                pv_tile_sw(vl, 0, S[0], O, lane); pv_tile_sw(vl, 1, S[1], O, lane);
                }, ksb, vsb, 1536, SEQ, ring, wave, lane);
            LAS int* oa = Oacc + ((8 * wave + qi) * 4 + r) * 64;
#pragma unroll
            for (int dt = 0; dt < 2; ++dt)
#pragma unroll
                for (int g4 = 0; g4 < 4; ++g4) { u32x4 w; w.x = (unsigned)(int)(O[dt][4 * g4] * FXS); w.y = (unsigned)(int)(O[dt][4 * g4 + 1] * FXS); w.z = (unsigned)(int)(O[dt][4 * g4 + 2] * FXS); w.w = (unsigned)(int)(O[dt][4 * g4 + 3] * FXS);
                    *(LAS u32x4*)(oa + dt * 32 + 8 * g4 + 4 * h) = w; }
            if (h == 0) { lacc[(8 * wave + qi) * 4 + r] = (int)(l * FXS); mref[(8 * wave + qi) * 4 + r] = m; }
        }
        __syncthreads();
        {
            NSA_VARS
            LAS int* qs = qsel + wave * 8;
#pragma unroll 1
            for (int j = wave; j <= tile; j += 8) {
                const unsigned long long qm = qmask[j];
                if (qm == 0ull) continue;
                const int n = __popcll(qm);
                bf16x8 KA[2][4], VA[2][2][2];
                { const bf16x8* kp = kfr + ((size_t)(bg * 256 + j) * 8) * 64 + lane; const bf16x8* vp = vfr + ((size_t)(bg * 256 + j) * 8) * 64 + lane;
#pragma unroll
                  for (int kt = 0; kt < 2; ++kt) {
#pragma unroll
                    for (int ks = 0; ks < 4; ++ks) KA[kt][ks] = kp[(kt * 4 + ks) * 64];
#pragma unroll
                    for (int s = 0; s < 2; ++s)
#pragma unroll
                        for (int dt = 0; dt < 2; ++dt) VA[kt][s][dt] = vp[((kt * 2 + s) * 2 + dt) * 64]; } }
#pragma unroll 1
                for (int ch = 0; ch * 8 < n; ++ch) {
                    if ((qm >> lane) & 1ull) { const int rk = __popcll(qm & ((1ull << lane) - 1ull)) - 8 * ch; if (rk >= 0 && rk < 8) qs[rk] = lane; }
                    const bool lv = qi < n - 8 * ch;
                    const int ql = qs[lv ? qi : 0], tq = T0 + ql;
                    bf16x8 Qs[4];
                    { const bf16_t* qrow = qb_ + (tokbase + tq) * 1024 + (4 * g + r) * 64;
#pragma unroll
                      for (int ks = 0; ks < 4; ++ks) Qs[ks] = *(const bf16x8*)(qrow + 16 * ks + 8 * h); }
                    f32x16 S[2];
#pragma unroll
                    for (int kt = 0; kt < 2; ++kt) { S[kt] = zero16();
#pragma unroll
                        for (int ks = 0; ks < 4; ++ks) S[kt] = mfma32(KA[kt][ks], Qs[ks], S[kt]); }
                    (void)logits_tile<1, false>(S, bt, tq - j * 64, h, 0, (unsigned)DIST_ANY);
                    const float mr = mref[ql * 4 + r];
                    float ls = 0.f;
#pragma unroll
                    for (int kt = 0; kt < 2; ++kt)
#pragma unroll
                        for (int i = 0; i < 16; ++i) { const float p = lv ? __builtin_amdgcn_exp2f(S[kt][i] - mr) : 0.f; S[kt][i] = p; ls += p; }
                    ls += __shfl_xor(ls, 32);
                    f32x16 Oa[2]; Oa[0] = zero16(); Oa[1] = zero16();
#pragma unroll
                    for (int kt = 0; kt < 2; ++kt)
#pragma unroll
                        for (int s = 0; s < 2; ++s) {
                            u32x4 pk; pk.x = cvt_pk_bf16(S[kt][8 * s + 0], S[kt][8 * s + 1]); pk.y = cvt_pk_bf16(S[kt][8 * s + 2], S[kt][8 * s + 3]); pk.z = cvt_pk_bf16(S[kt][8 * s + 4], S[kt][8 * s + 5]); pk.w = cvt_pk_bf16(S[kt][8 * s + 6], S[kt][8 * s + 7]);
                            const bf16x8 Bp = __builtin_bit_cast(bf16x8, pk);
                            Oa[0] = mfma32(VA[kt][s][0], Bp, Oa[0]); Oa[1] = mfma32(VA[kt][s][1], Bp, Oa[1]); }
                    if (lv) { LAS int* oa = Oacc + (ql * 4 + r) * 64 + 4 * h;
#pragma unroll
                        for (int dt = 0; dt < 2; ++dt)
#pragma unroll
                            for (int i = 0; i < 16; ++i) atomicAdd((int*)(oa + dt * 32 + (i & 3) + 8 * (i >> 2)), (int)(fminf(fmaxf(Oa[dt][i], -60000.f), 60000.f) * FXS));
                        if (h == 0) atomicAdd((int*)(lacc + ql * 4 + r), (int)(fminf(ls, 60000.f) * FXS)); }
                }
            }
        }
        __syncthreads();
        {
            NSA_VARS
            const float gt_sel = gtp[16];
            const LAS int* oa = Oacc + ((8 * wave + qi) * 4 + r) * 64;
            const float sc_ = gt_sel / (float)lacc[(8 * wave + qi) * 4 + r];
#pragma unroll
            for (int dt = 0; dt < 2; ++dt)
#pragma unroll
                for (int g4 = 0; g4 < 4; ++g4) { const u32x4 v = *(const LAS u32x4*)(oa + dt * 32 + 8 * g4 + 4 * h);
                    OUT[dt][4 * g4] += sc_ * (float)(int)v.x; OUT[dt][4 * g4 + 1] += sc_ * (float)(int)v.y; OUT[dt][4 * g4 + 2] += sc_ * (float)(int)v.z; OUT[dt][4 * g4 + 3] += sc_ * (float)(int)v.w; }
        }
        { NSA_VARS
          store_o(outb + (tokbase + t) * D + (4 * g + r) * 64, OUT, 1.f, h); }
    }
#undef NSA_VARS
}

DI void sb_phase(const Args& a, LAS unsigned char* lds) {
    int tid = tid_of(a.wv); asm volatile("" : "+v"(tid));
    const int lane = tid & 63, wave = __builtin_amdgcn_readfirstlane(tid >> 6), c = lane & 31, h = lane >> 5;
    const bf16_t* qkv = (const bf16_t*)(a.ws + WS_BIG);
    bf16_t* outb = (bf16_t*)(a.ws + WS_ACTB);
    LAS unsigned char* kbuf = lds; LAS unsigned char* vbuf = lds + 2 * KV_TILE_BYTES;
    volatile LAS int* flags = (volatile LAS int*)(lds + 4 * KV_TILE_BYTES);
    for (int u = blockIdx.x; u < 2048; u += gridDim.x) {
        const int qb = u & 63, hh = (u >> 6) & 15, b = u >> 10;
        const int q0w = qb * 256 + 32 * wave, t = q0w + c;
        const size_t tokbase = (size_t)b * SEQ;
        const bf16_t* kb = qkv + tokbase * 3072 + 1024 + hh * 64;
        const bf16_t* vb = qkv + tokbase * 3072 + 2048 + hh * 64;
        bf16x8 Q[4];
        { const bf16_t* qrow = qkv + (tokbase + t) * 3072 + hh * 64;
#pragma unroll
          for (int ks = 0; ks < 4; ++ks) Q[ks] = *(const bf16x8*)(qrow + 16 * ks + 8 * h); }
        f32x16 O[2]; O[0] = zero16(); O[1] = zero16();
        float rsum = 0.f; bool wdone = false;
        int jt = qb * 4 + 3, buf = 0;
        u32x4 kr, vr;
        kv_fetch(kr, vr, kb, vb, 3072, jt * 64, SEQ, tid); kv_store(kbuf, vbuf, kr, vr, tid);
        __syncthreads();
        for (; jt >= 0; --jt) {
            if (jt > 0) kv_fetch(kr, vr, kb, vb, 3072, (jt - 1) * 64, SEQ, tid);
            const int kb0 = jt * 64;
            if (!wdone && kb0 < q0w + 31) {
                const LAS unsigned char* kl = kbuf + buf * KV_TILE_BYTES; const LAS unsigned char* vl = vbuf + buf * KV_TILE_BYTES;
                f32x16 Z[2], SP[2];
                Z[0] = qk_tile(kl, 0, Q, lane); Z[1] = qk_tile(kl, 1, Q, lane);
                float Tc[2][2];
#pragma unroll
                for (int sub = 0; sub < 2; ++sub)
#pragma unroll
                    for (int s = 0; s < 2; ++s) { float acc = 0.f;
#pragma unroll
                        for (int j = 0; j < 8; ++j) { const int i = 8 * s + j; const int key = kb0 + sub * 32 + 16 * s + 8 * h + j;
                            const float z = fminf(fmaxf(Z[sub][i] * 0.125f, -60.f), 60.f);
                            const float e = __builtin_amdgcn_exp2f(z * LOG2E);
                            const float sp = (key < t) ? __builtin_amdgcn_logf(1.f + e) * LN2F : 0.f;
                            Z[sub][i] = z; SP[sub][i] = sp; acc += sp; }
                        Tc[sub][s] = acc; }
                float Tp[2][2], pr[2][2];
#pragma unroll
                for (int sub = 0; sub < 2; ++sub)
#pragma unroll
                    for (int s = 0; s < 2; ++s) { Tp[sub][s] = __shfl_xor(Tc[sub][s], 32); pr[sub][s] = Tc[sub][s] + Tp[sub][s]; }
                float offp[2][2];
                offp[1][1] = rsum; offp[1][0] = offp[1][1] + pr[1][1]; offp[0][1] = offp[1][0] + pr[1][0]; offp[0][0] = offp[0][1] + pr[0][1];
                rsum = offp[0][0] + pr[0][0];
#pragma unroll
                for (int sub = 0; sub < 2; ++sub)
#pragma unroll
                    for (int s = 0; s < 2; ++s) { float run = offp[sub][s] + (h == 0 ? Tp[sub][s] : 0.f);
#pragma unroll
                        for (int j = 7; j >= 0; --j) { const int i = 8 * s + j; const int key = kb0 + sub * 32 + 16 * s + 8 * h + j;
                            run += SP[sub][i];
                            SP[sub][i] = (key < t) ? __builtin_amdgcn_exp2f((Z[sub][i] - run) * LOG2E) : 0.f; } }
                pv_tile(vl, 0, SP[0], O, lane); pv_tile(vl, 1, SP[1], O, lane);
                wdone = __all(rsum > 110.f);
            }
            if (lane == 0) flags[buf * 8 + wave] = wdone ? 1 : 0;
            if (jt > 0) kv_store(kbuf + (buf ^ 1) * KV_TILE_BYTES, vbuf + (buf ^ 1) * KV_TILE_BYTES, kr, vr, tid);
            __syncthreads();
            int alld = 1;
#pragma unroll
            for (int w = 0; w < 8; ++w) alld &= flags[buf * 8 + w];
            buf ^= 1;
            if (alld) break;
        }
        store_o(outb + (tokbase + t) * D + hh * 64, O, 1.f, h);
        __syncthreads();
    }
}

#ifndef DBG
#define DBG 0
#endif
#if DBG
DI float dbg_block_max(float v, LAS float* red) {
#pragma unroll
    for (int o = 1; o < 64; o <<= 1) v = fmaxf(v, __shfl_xor(v, o));
    __syncthreads();
    if ((threadIdx.x & 63) == 0) red[threadIdx.x >> 6] = v;
    __syncthreads();
    float r = red[0];
    for (int i = 1; i < 8; ++i) r = fmaxf(r, red[i]);
    __syncthreads();
    return r;
}
DI float dbg_block_sum(float v, LAS float* red) {
#pragma unroll
    for (int o = 1; o < 64; o <<= 1) v += __shfl_xor(v, o);
    __syncthreads();
    if ((threadIdx.x & 63) == 0) red[threadIdx.x >> 6] = v;
    __syncthreads();
    float r = 0.f;
    for (int i = 0; i < 8; ++i) r += red[i];
    __syncthreads();
    return r;
}
DI void dbg_note(unsigned* ctl, int idx, float err) { if (threadIdx.x == 0) atomicMax(ctl + CW_DBG + idx, __builtin_bit_cast(unsigned, err)); }
template <int layer>
DI void dbg_check(const Args& a, LAS unsigned char* lds, int stage, const MoeMeta& mm) {
    if (blockIdx.x >= 64) return;
    const int tid = threadIdx.x;
    const int t = blockIdx.x * 512 + (blockIdx.x * 37) % 512;
    LAS float* x1 = (LAS float*)(lds);
    LAS float* hh = x1 + 1024;
    LAS float* yy = hh + 512;
    LAS float* red = yy + 2048;
    LAS float* scl = red + 16;
    unsigned* ctl = (unsigned*)(a.ws + WS_CTL);
    float* dbgx1 = (float*)(a.ws + WS_SMALL) + blockIdx.x * 1024;
    const float* xout = a.out; const bf16_t* actb = (const bf16_t*)(a.ws + WS_ACTB);
    const u32x4 ti = *(const u32x4*)(a.ws + WS_TOKINFO + (size_t)t * 16);
    const int e0 = ti.x & 15, p0 = ti.x >> 4, e1 = ti.z & 15, p1 = ti.z >> 4;
    const float w0 = u2f(ti.y), w1 = u2f(ti.w);
    __syncthreads();
    if (tid == 0) { scl[16] = w0; scl[17] = w1; }
    __syncthreads();
    if (stage == 1) {
        const float* xin = (layer == 0) ? a.in[IN_X] : nullptr;
        if (xin) {
            float v0 = ALPHA * xin[(size_t)t * D + tid], v1 = ALPHA * xin[(size_t)t * D + tid + 512];
            const float mean = dbg_block_sum(v0 + v1, red) / D;
            const float var = dbg_block_sum((v0 - mean) * (v0 - mean) + (v1 - mean) * (v1 - mean), red) / D;
            const float rstd = 1.f / sqrtf(var + LN_EPS);
            const float* g = a.in[IN_LN1G] + layer * D; const float* b = a.in[IN_LN1B] + layer * D;
            const float r0 = (v0 - mean) * rstd * g[tid] + b[tid], r1 = (v1 - mean) * rstd * g[tid + 512] + b[tid + 512];
            float e = fmaxf(fabsf(r0 - xout[(size_t)t * D + tid]), fabsf(r1 - xout[(size_t)t * D + tid + 512]));
            dbg_note(ctl, 0, dbg_block_max(e, red));
            const float q0 = __builtin_bit_cast(float, (unsigned)actb[(size_t)t * D + tid] << 16), q1 = __builtin_bit_cast(float, (unsigned)actb[(size_t)t * D + tid + 512] << 16);
            e = fmaxf(fabsf(r0 - q0), fabsf(r1 - q1));
            dbg_note(ctl, 1, dbg_block_max(e, red));
        }
        x1[tid] = xout[(size_t)t * D + tid]; x1[tid + 512] = xout[(size_t)t * D + tid + 512];
        dbgx1[tid] = x1[tid]; dbgx1[tid + 512] = x1[tid + 512];
        __syncthreads();
        if (tid < 16) { float s = 0.f; for (int k = 0; k < D; ++k) s += x1[k] * a.in[IN_RW][k * 16 + tid]; scl[tid] = 1.f / (1.f + expf(-s)); }
        __syncthreads();
        if (tid == 0) {
            float bz[16]; for (int e = 0; e < 16; ++e) bz[e] = scl[e] + a.in[IN_RB][e];
            int bg = 0; float bgs = -1e30f;
            for (int g = 0; g < 4; ++g) { float m1 = -1e30f, m2 = -1e30f; for (int k = 0; k < 4; ++k) { const float v = bz[4 * g + k]; if (v > m1) { m2 = m1; m1 = v; } else if (v > m2) m2 = v; }
                if (m1 + m2 > bgs) { bgs = m1 + m2; bg = g; } }
            int i1 = 0; for (int k = 1; k < 4; ++k) if (bz[4 * bg + k] > bz[4 * bg + i1]) i1 = k;
            int i2 = -1; for (int k = 0; k < 4; ++k) if (k != i1 && (i2 < 0 || bz[4 * bg + k] > bz[4 * bg + i2])) i2 = k;
            const float s1 = scl[4 * bg + i1], s2 = scl[4 * bg + i2];
            float err = 0.f;
            if (e0 != 4 * bg + i1 || e1 != 4 * bg + i2) err = 1.f;
            err = fmaxf(err, fabsf(scl[16] - s1 / (s1 + s2))); err = fmaxf(err, fabsf(scl[17] - s2 / (s1 + s2)));
            if (p0 >= mm.cnt[e0] || p1 >= mm.cnt[e1]) err = 2.f;
            else { const unsigned* list = (const unsigned*)(a.ws + WS_LIST); if (list[e0 * 32768 + p0] != (unsigned)t || list[e1 * 32768 + p1] != (unsigned)t) err = 3.f; }
            atomicMax(ctl + CW_DBG + 2, __builtin_bit_cast(unsigned, err));
        }
        return;
    }
    x1[tid] = dbgx1[tid]; x1[tid + 512] = dbgx1[tid + 512];
    __syncthreads();
    const float* eg = a.in[IN_EG] + (size_t)layer * NE * D * DEXP; const float* eu = a.in[IN_EU] + (size_t)layer * NE * D * DEXP; const float* ed = a.in[IN_ED] + (size_t)layer * NE * DEXP * D;
    { const int k = tid >> 8, j = tid & 255, e = k ? e1 : e0;
      float g = 0.f, u = 0.f; for (int i = 0; i < D; ++i) { g += x1[i] * eg[((size_t)e * D + i) * DEXP + j]; u += x1[i] * eu[((size_t)e * D + i) * DEXP + j]; }
      hh[k * 256 + j] = g / (1.f + expf(-g)) * u; }
    __syncthreads();
    const size_t s0 = (size_t)mm.tstart[e0] * 256 + p0, s1 = (size_t)mm.tstart[e1] * 256 + p1;
    if (stage == 2) {
        const bf16_t* hb = (const bf16_t*)(a.ws + WS_BIG + BIG_H);
        const int k = tid >> 8, j = tid & 255; const size_t s = k ? s1 : s0;
        const float got = __builtin_bit_cast(float, (unsigned)hb[s * DEXP + j] << 16);
        const float ref = hh[tid];
        const float rms = sqrtf(dbg_block_sum(ref * ref, red) / 512.f);
        dbg_note(ctl, 3, dbg_block_max(fabsf(got - ref), red) / (rms + 1e-6f));
        return;
    }
    for (int c = tid; c < 2048; c += 512) { const int k = c >> 10, col = c & 1023, e = k ? e1 : e0; float s = 0.f;
        for (int j = 0; j < DEXP; ++j) s += hh[k * 256 + j] * ed[((size_t)e * DEXP + j) * D + col];
        yy[c] = s; }
    __syncthreads();
    if (stage == 3) {
        const bf16_t* yb = (const bf16_t*)(a.ws + WS_BIG + BIG_YB);
        float e = 0.f, sq = 0.f;
        for (int c = tid; c < 2048; c += 512) { const int k = c >> 10, col = c & 1023; const size_t s = k ? s1 : s0;
            const float got = __builtin_bit_cast(float, (unsigned)yb[s * D + col] << 16); e = fmaxf(e, fabsf(got - yy[c])); sq += yy[c] * yy[c]; }
        const float rms = sqrtf(dbg_block_sum(sq, red) / 2048.f);
        dbg_note(ctl, 4, dbg_block_max(e, red) / (rms + 1e-6f));
        return;
    }
    {
        float v0 = ALPHA * x1[tid] + w0 * yy[tid] + w1 * yy[1024 + tid], v1 = ALPHA * x1[tid + 512] + w0 * yy[tid + 512] + w1 * yy[1024 + tid + 512];
        const float mean = dbg_block_sum(v0 + v1, red) / D;
        const float var = dbg_block_sum((v0 - mean) * (v0 - mean) + (v1 - mean) * (v1 - mean), red) / D;
        const float rstd = 1.f / sqrtf(var + LN_EPS);
        const float* g = a.in[IN_LN2G] + layer * D; const float* b = a.in[IN_LN2B] + layer * D;
        const float r0 = (v0 - mean) * rstd * g[tid] + b[tid], r1 = (v1 - mean) * rstd * g[tid + 512] + b[tid + 512];
        const float e = fmaxf(fabsf(r0 - xout[(size_t)t * D + tid]), fabsf(r1 - xout[(size_t)t * D + tid + 512]));
        dbg_note(ctl, 5, dbg_block_max(e, red));
    }
}
DI void dbg_final(const Args& a) {
    unsigned* ctl = (unsigned*)(a.ws + WS_CTL);
    const float tol[6] = {1e-4f, 2e-2f, 1e-3f, 0.12f, 0.12f, 4e-2f};
    int code = 2;
    for (int i = 5; i >= 0; --i) { const float err = __builtin_bit_cast(float, xb_ld(ctl + CW_DBG + i));
        if (!(err <= tol[i])) { const int dg = !(err < 1.f) ? 9 : err >= 0.3f ? 7 : err >= 0.1f ? 5 : err >= 0.03f ? 3 : 1; code = 10 * (i + 1) + dg; } }
#ifdef PROBE
    { const float p0 = (float)xb_ld(ctl + CW_DBG + 10) / 65536.f, p1 = __builtin_bit_cast(float, xb_ld(ctl + CW_DBG + 9));
      const int d0 = p0 < 0.f ? 0 : p0 >= 1.f ? 9 : (int)(p0 * 9.99f), d1 = p1 < 0.f ? 0 : p1 >= 1.f ? 9 : (int)(p1 * 9.99f); code = 10 * d0 + d1; }
#endif
    if (xb_ld(ctl + CW_BAR + XB_TMO)) code = 95;
    const float c = sqrtf((float)code);
    for (size_t i = (size_t)blockIdx.x * NTHR + threadIdx.x; i < (size_t)T * D; i += (size_t)gridDim.x * NTHR) a.out[i] = c;
}
#endif

constexpr bool HAS_MIXER[4] = {true, true, true, true};
template <int layer>
DI void run_layer(const Args& a, LAS unsigned char* lds, const XcdBarrier& bar) {
    const int wave = a.wv;
    const int G = gridDim.x, bid = blockIdx.x;
    const int gw = bid * NWAVES + wave, NGW = G * NWAVES;
    unsigned char* ws = a.ws;
    unsigned* ctl = (unsigned*)(a.ws + WS_CTL);
    bf16_t* actb = (bf16_t*)(ws + WS_ACTB);
    float* xout = a.out;
        bf16_t* bigb = (bf16_t*)(ws + WS_BIG);
        if (layer == 0) {
#pragma unroll 1
            for (int b = 0; b < BATCH; ++b) {
                { pg8::DenseSched S; S.init(actb + (size_t)b * SEQ * D, D * 2, 128, ws + WS_WIN, SEQ, 9216, D, G, bid); pg8::EpiStore E{bigb, (size_t)9216}; pg8::gemm_phase(lds + STAGE_OFF, S, E, a.wv); }
                if (b == 1) dilated_merge(a, 0);
                xcd_barrier(bar);
                dilated_phase(a, lds);
                xcd_barrier(bar);
            }
            dilated_merge(a, 1);
            xcd_barrier(bar);
        }
        if (layer == 1) {
            { pg8::DenseSched S; S.init(actb, D * 2, 128, ws + WS_WIN, T, 3072, D, G, bid); pg8::EpiStore E{bigb, (size_t)3072}; pg8::gemm_phase(lds + STAGE_OFF, S, E, a.wv); }
            xcd_barrier(bar);
            sb_phase(a, lds);
            xcd_barrier(bar);
        }
        if (layer == 2) {
            { pg8::DenseSched S; S.init(actb, D * 2, 128, ws + WS_WIN, T, 2816, D, G, bid);
              pg8::EpiNsa E{(bf16_t*)(ws + WS_BIG + NS_Q), (bf16_t*)(ws + WS_BIG + NS_KV), (float*)(ws + WS_BIG + NS_GT)}; pg8::gemm_phase(lds + STAGE_OFF, S, E, a.wv); }
            xcd_barrier(bar);
            { pg8::CmpSched S; S.kv6 = (const char*)(ws + WS_BIG + NS_KV); S.Bt = (const char*)(ws + WS_WCMP); S.K = 2048; S.lda = 16 * 1536 * 2; S.kstepA = 1536 * 2; S.G = G; S.c = bid;
              pg8::EpiCmp E{(bf16_t*)(ws + WS_BIG + NS_HID), (const float*)(ws + WS_WCMP + 2 * MiB + 64 * 1024)}; pg8::gemm_phase(lds + STAGE_OFF, S, E, a.wv); }
            xcd_barrier(bar);
            nsa_kcvc_phase(a, lds);
            xcd_barrier(bar);
            nsa_attn_phase(a, lds);
            xcd_barrier(bar);
        }
        if (layer == 3) {
            { pg8::DenseSched S; S.init(actb, D * 2, 128, ws + WS_WIN, T, 3072, D, G, bid); pg8::EpiStore E{bigb, (size_t)3072}; pg8::gemm_phase(lds + STAGE_OFF, S, E, a.wv); }
            xcd_barrier(bar);
            moba_kmean_phase(a);
            xcd_barrier(bar);
            moba_gate_phase(a, lds);
            xcd_barrier(bar);
            moba_fill_phase(a, lds);
            xcd_barrier(bar);
            moba_sel_phase(a, lds);
            xcd_barrier(bar);
            moba_own_phase(a, lds);
            xcd_barrier(bar);
        }
        if (HAS_MIXER[layer]) {
            { pg8::DenseSched S; S.init(actb, D * 2, 128, ws + WS_WOUT, T, D, D, G, bid); pg8::EpiStore E{(bf16_t*)(ws + WS_BIG + BIG_Y), (size_t)D}; pg8::gemm_phase(lds + STAGE_OFF, S, E, a.wv); }
            xcd_barrier(bar);
        }
        unsigned* gcount = ctl + CW_MOE + layer * 16 * 64;
        {
            const int tid = tid_of(a.wv), lane = tid & 63;
            LAS float* rwT = (LAS float*)(lds + STAGE_OFF);
            LAS int* lcnt = (LAS int*)(lds + STAGE_OFF + 65536);
            LAS int* gbase = lcnt + 16;
            LAS unsigned* le = (LAS unsigned*)(lcnt + 32);
            LAS float* lg = (LAS float*)(le + 256);
            const float* rw = a.in[IN_RW];
            for (int i = tid; i < 1024 * 16; i += NTHR) { const int k = i >> 4, e = i & 15; rwT[e * 1024 + k] = rw[i]; }
            if (tid < 16) lcnt[tid] = 0;
            __syncthreads();
            const float* xin = (layer == 0) ? a.in[IN_X] : xout;
            const float* g1 = a.in[IN_LN1G] + layer * D; const float* b1 = a.in[IN_LN1B] + layer * D;
            RowVec gv, bv;
#pragma unroll
            for (int j = 0; j < 4; ++j) { gv.v[j] = *(const f32x4*)(g1 + 4 * lane + 256 * j); bv.v[j] = *(const f32x4*)(b1 + 4 * lane + 256 * j); }
            float rbias[16];
#pragma unroll
            for (int e = 0; e < 16; ++e) rbias[e] = a.in[IN_RB][e];
            for (int lt = wave; lt < 128; lt += NWAVES) {
                const int t = bid * 128 + lt;
                if (t >= T) break;
                RowVec r;
#pragma unroll
                for (int j = 0; j < 4; ++j) r.v[j] = *(const f32x4*)(xin + (size_t)t * D + 4 * lane + 256 * j) * ALPHA;
                if (HAS_MIXER[layer]) { const bf16_t* yrow = (const bf16_t*)(ws + WS_BIG + BIG_Y) + (size_t)t * D;
#pragma unroll
                    for (int j = 0; j < 4; ++j) { const u32x2 yv = *(const u32x2*)(yrow + 4 * lane + 256 * j);
                        r.v[j].x += bf_lo(yv.x); r.v[j].y += bf_hi(yv.x); r.v[j].z += bf_lo(yv.y); r.v[j].w += bf_hi(yv.y); } }
                float mean, rstd; ln_stats(r, mean, rstd);
#pragma unroll
                for (int j = 0; j < 4; ++j) { r.v[j] = (r.v[j] - mean) * rstd * gv.v[j] + bv.v[j];
                    *(f32x4*)(xout + (size_t)t * D + 4 * lane + 256 * j) = r.v[j];
                    u32x2 w; w.x = pk2(r.v[j].x, r.v[j].y); w.y = pk2(r.v[j].z, r.v[j].w);
                    *(u32x2*)(actb + (size_t)t * D + 4 * lane + 256 * j) = w; }
                float sc[16];
#pragma unroll
                for (int e = 0; e < 16; ++e) { float s = 0.f;
#pragma unroll
                    for (int j = 0; j < 4; ++j) { const f32x4 w = *(const LAS f32x4*)(rwT + e * 1024 + 4 * lane + 256 * j); s += (r.v[j].x * w.x + r.v[j].y * w.y) + (r.v[j].z * w.z + r.v[j].w * w.w); }
                    sc[e] = wave_sum(s); }
                float bz[16];
#pragma unroll
                for (int e = 0; e < 16; ++e) { sc[e] = 1.f / (1.f + __expf(-sc[e])); bz[e] = sc[e] + rbias[e]; }
                int bg = 0; float bgs = -1e30f;
#pragma unroll
                for (int g = 0; g < 4; ++g) {
                    float m1 = bz[4 * g]; int i1 = 0;
#pragma unroll
                    for (int k = 1; k < 4; ++k) if (bz[4 * g + k] > m1) { m1 = bz[4 * g + k]; i1 = k; }
                    float m2 = -1e30f;
#pragma unroll
                    for (int k = 0; k < 4; ++k) if (k != i1 && bz[4 * g + k] > m2) m2 = bz[4 * g + k];
                    const float gs = m1 + m2;
                    if (gs > bgs) { bgs = gs; bg = g; }
                }
                float v4[4], s4[4];
#pragma unroll
                for (int k = 0; k < 4; ++k) { v4[k] = 0.f; s4[k] = 0.f; }
#pragma unroll
                for (int g = 0; g < 4; ++g) if (g == bg) {
#pragma unroll
                    for (int k = 0; k < 4; ++k) { v4[k] = bz[4 * g + k]; s4[k] = sc[4 * g + k]; } }
                int i1 = 0; float m1 = v4[0];
#pragma unroll
                for (int k = 1; k < 4; ++k) if (v4[k] > m1) { m1 = v4[k]; i1 = k; }
                int i2 = -1; float m2 = -1e30f;
#pragma unroll
                for (int k = 0; k < 4; ++k) if (k != i1 && v4[k] > m2) { m2 = v4[k]; i2 = k; }
                float sg1 = 0.f, sg2 = 0.f;
#pragma unroll
                for (int k = 0; k < 4; ++k) { sg1 = (k == i1) ? s4[k] : sg1; sg2 = (k == i2) ? s4[k] : sg2; }
                const float inv = 1.f / (sg1 + sg2);
                if (lane == 0) {
                    const int e0 = bg * 4 + i1, e1 = bg * 4 + i2;
                    const int p0 = atomicAdd((int*)(lcnt + e0), 1), p1 = atomicAdd((int*)(lcnt + e1), 1);
                    le[lt * 2] = (unsigned)e0 | ((unsigned)p0 << 8); le[lt * 2 + 1] = (unsigned)e1 | ((unsigned)p1 << 8);
                    lg[lt * 2] = sg1 * inv; lg[lt * 2 + 1] = sg2 * inv;
                }
            }
            __syncthreads();
            if (tid < 16) gbase[tid] = (int)xb_add(gcount + tid * 64, (unsigned)lcnt[tid]);
            __syncthreads();
            if (tid < 256) {
                const int lt = tid >> 1, t = bid * 128 + lt;
                if (t < T) {
                    const unsigned w = le[tid]; const int e = w & 255, pos = gbase[e] + (int)(w >> 8);
                    ((unsigned*)(ws + WS_LIST))[e * 32768 + pos] = (unsigned)t;
                    u32x2 ti; ti.x = (unsigned)e | ((unsigned)pos << 4); ti.y = __builtin_bit_cast(unsigned, lg[tid]);
                    *(u32x2*)(ws + WS_TOKINFO + (size_t)(t * 2 + (tid & 1)) * 8) = ti;
                }
            }
        }
        xcd_barrier(bar);

        MoeMeta mm; mm.tstart = (LAS int*)(lds + MISC_OFF + 256); mm.cnt = mm.tstart + 32;
        if (tid_of(a.wv) == 0) { int acc = 0;
            for (int e = 0; e < 16; ++e) { const int c = (int)xb_ld(gcount + e * 64); mm.cnt[e] = c; mm.tstart[e] = acc; acc += (c + 255) >> 8; }
            mm.tstart[16] = acc; }
        __syncthreads();
        const int ntiles = mm.tstart[16];
#if DBG
        if (layer == DBG_LAYER) { dbg_check<layer>(a, lds, 1, mm); __syncthreads(); }
#endif
        {
            Moe1Sched S; S.A = (const char*)actb; S.Bt = (const char*)(ws + WS_WEXP1); S.K = D; S.lda = D * 2; S.kstepA = 128; S.mm = mm; S.ntiles = ntiles; S.G = G; S.c = bid;
            S.tab = (LAS unsigned*)(lds + AUX_OFF);
            const int tid = tid_of(a.wv);
            pg8::Unit u;
            for (int i = 0; i < 8 && S.next(i, u); ++i) {
                if (tid < 256) { const int pos = (u.pm - mm.tstart[u.e]) * 256 + tid;
                    const unsigned tok = (pos < mm.cnt[u.e]) ? ((const unsigned*)(ws + WS_LIST))[u.e * 32768 + pos] : 0u;
                    S.tab[i * 256 + tid] = tok * (unsigned)(D * 2); }
            }
            __syncthreads();
            pg8::EpiSwiglu E{(bf16_t*)(ws + WS_BIG + BIG_H)};
            pg8::gemm_phase(lds + STAGE_OFF, S, E, a.wv);
        }
        xcd_barrier(bar);
#if DBG
        if (layer == DBG_LAYER) { dbg_check<layer>(a, lds, 2, mm); __syncthreads(); }
#endif
        {
            Moe2Sched S; S.A = (const char*)(ws + WS_BIG + BIG_H); S.Bt = (const char*)(ws + WS_WEXP2); S.K = DEXP; S.lda = DEXP * 2; S.kstepA = 128; S.mm = mm; S.ntiles = ntiles; S.G = G; S.c = bid;
            pg8::EpiStore E{(bf16_t*)(ws + WS_BIG + BIG_YB), (size_t)D};
            pg8::gemm_phase(lds + STAGE_OFF, S, E, a.wv);
        }
        xcd_barrier(bar);
#if DBG
        if (layer == DBG_LAYER) { dbg_check<layer>(a, lds, 3, mm); __syncthreads(); }
#endif
        {
            const int tid = tid_of(a.wv), lane = tid & 63;
            const float* g2 = a.in[IN_LN2G] + layer * D; const float* b2 = a.in[IN_LN2B] + layer * D;
            RowVec gv, bv;
#pragma unroll
            for (int j = 0; j < 4; ++j) { gv.v[j] = *(const f32x4*)(g2 + 4 * lane + 256 * j); bv.v[j] = *(const f32x4*)(b2 + 4 * lane + 256 * j); }
            const bf16_t* yb = (const bf16_t*)(ws + WS_BIG + BIG_YB);
            for (int t = gw; t < T; t += NGW) {
                const u32x4 ti = *(const u32x4*)(ws + WS_TOKINFO + (size_t)t * 16);
                const int e0 = ti.x & 15, p0 = ti.x >> 4, e1 = ti.z & 15, p1 = ti.z >> 4;
                const float w0 = u2f(ti.y), w1 = u2f(ti.w);
                const size_t s0 = (size_t)mm.tstart[e0] * 256 + p0, s1 = (size_t)mm.tstart[e1] * 256 + p1;
                RowVec r;
#pragma unroll
                for (int j = 0; j < 4; ++j) {
                    const f32x4 xv = *(const f32x4*)(xout + (size_t)t * D + 4 * lane + 256 * j);
                    const u32x2 y0 = *(const u32x2*)(yb + s0 * D + 4 * lane + 256 * j), y1 = *(const u32x2*)(yb + s1 * D + 4 * lane + 256 * j);
                    r.v[j].x = ALPHA * xv.x + w0 * bf_lo(y0.x) + w1 * bf_lo(y1.x);
                    r.v[j].y = ALPHA * xv.y + w0 * bf_hi(y0.x) + w1 * bf_hi(y1.x);
                    r.v[j].z = ALPHA * xv.z + w0 * bf_lo(y0.y) + w1 * bf_lo(y1.y);
                    r.v[j].w = ALPHA * xv.w + w0 * bf_hi(y0.y) + w1 * bf_hi(y1.y);
                }
                float mean, rstd; ln_stats(r, mean, rstd);
#pragma unroll
                for (int j = 0; j < 4; ++j) { r.v[j] = (r.v[j] - mean) * rstd * gv.v[j] + bv.v[j];
                    *(f32x4*)(xout + (size_t)t * D + 4 * lane + 256 * j) = r.v[j];
                    u32x2 w; w.x = pk2(r.v[j].x, r.v[j].y); w.y = pk2(r.v[j].z, r.v[j].w);
                    *(u32x2*)(actb + (size_t)t * D + 4 * lane + 256 * j) = w; }
            }
            if (layer + 1 < DEPTH) convert_layer_weights(a, layer + 1, lds, gw, NGW, wave, lane);
        }
        xcd_barrier(bar);
#if DBG
        if (layer == DBG_LAYER) { dbg_check<layer>(a, lds, 4, mm); xcd_barrier(bar); }
#endif
}

__global__ void __launch_bounds__(NTHR, 2) fwd(Args a_in) {
    Args a = a_in; a.wv = __builtin_amdgcn_readfirstlane((int)(threadIdx.x >> 6));
    extern __shared__ __attribute__((aligned(16))) unsigned char lds_raw[];
    LAS unsigned char* lds = (LAS unsigned char*)lds_raw;
    volatile LAS unsigned* MISC = (volatile LAS unsigned*)(lds + MISC_OFF);
    const int tid = tid_of(a.wv), lane = tid & 63, wave = a.wv;
    const int G = gridDim.x, bid = blockIdx.x;
    const int gw = bid * NWAVES + wave, NGW = G * NWAVES;
    if (tid < 256) MISC[tid] = 0u;
    __syncthreads();
    unsigned* ctl = (unsigned*)(a.ws + WS_CTL);
    XcdBarrier bar = xcd_barrier_post(ctl + CW_BAR, MISC + 8); bar.wv = a.wv;
    unsigned char* ws = a.ws;
    bf16_t* actb = (bf16_t*)(ws + WS_ACTB);
    float* xout = a.out;

    convert_layer_weights(a, 0, lds, gw, NGW, wave, lane);
    for (int i = bid * NTHR + tid; i < 16 * 2048; i += G * NTHR) { const int hd = i >> 11, n = i & 2047;
        int bk = n; if (n >= 16) { const float lf = logf((float)n / 16.f) / 4.852030263919617f; bk = 16 + (int)(lf * 16.f); bk = bk > 31 ? 31 : bk; }
        ((float*)(a.ws + WS_BIASG))[i] = a.in[IN_REL][bk * 16 + hd] * LOG2E; }
    { const float* x = a.in[IN_X];
      for (size_t i = ((size_t)bid * NTHR + tid) * 8; i < (size_t)T * D; i += (size_t)G * NTHR * 8) {
          const f32x4 v0 = *(const f32x4*)(x + i), v1 = *(const f32x4*)(x + i + 4);
          u32x4 w; w.x = pk2(v0.x, v0.y); w.y = pk2(v0.z, v0.w); w.z = pk2(v1.x, v1.y); w.w = pk2(v1.z, v1.w);
          *(u32x4*)(actb + i) = w; } }
    xcd_barrier(bar);

    run_layer<0>(a, lds, bar);
#if DBG
    if (DBG_LAYER >= 1) run_layer<1>(a, lds, bar);
    if (DBG_LAYER >= 2) run_layer<2>(a, lds, bar);
    if (DBG_LAYER >= 3) run_layer<3>(a, lds, bar);
    dbg_final(a);
#else
    run_layer<1>(a, lds, bar);
    run_layer<2>(a, lds, bar);
    run_layer<3>(a, lds, bar);
#endif
}

extern "C" void kernel_launch(void* const* d_in, const int* in_sizes, int n_in, void* d_out, int out_size, void* d_ws, size_t ws_size, hipStream_t stream) {
    static int grid = 0;
    if (grid == 0) {
        int dev = 0, cus = 0;
        if (n_in != 25 || out_size != T * D || ws_size < WS_END) { fprintf(stderr, "kernel_launch: unexpected shapes (n_in %d out %d ws %zu)\n", n_in, out_size, ws_size); grid = -1; return; }
        if (hipGetDevice(&dev) != hipSuccess || hipDeviceGetAttribute(&cus, hipDeviceAttributeMultiprocessorCount, dev) != hipSuccess) { grid = -1; return; }
        if (hipFuncSetAttribute((const void*)fwd, hipFuncAttributeMaxDynamicSharedMemorySize, LDS_BYTES) != hipSuccess) { grid = -1; return; }
        (void)hipGetLastError();
        grid = cus;
        if (grid != 256) { fprintf(stderr, "kernel_launch: built for 256 CUs, got %d\n", grid); grid = -1; return; }
    }
    if (grid < 0) return;
    (void)hipMemsetAsync(d_ws, 0, 1u << 20, stream);
    Args a{};
    for (int i = 0; i < 25; ++i) a.in[i] = (const float*)d_in[i];
    a.out = (float*)d_out; a.ws = (unsigned char*)d_ws;
    hipLaunchKernelGGL(fwd, dim3(grid), dim3(NTHR), LDS_BYTES, stream, a);
}
```

```cpp
#include <hip/hip_runtime.h>
#include <cstdio>
#include <cstdint>
#define DBG 0
#define DBG_LAYER 0

#define LAS __attribute__((address_space(3)))
#define GAS __attribute__((address_space(1)))
#define DI __device__ __forceinline__
typedef unsigned short bf16_t;
typedef short bf16x8 __attribute__((ext_vector_type(8)));
typedef short s16x4 __attribute__((ext_vector_type(4)));
typedef float f32x2 __attribute__((ext_vector_type(2)));
typedef float f32x4 __attribute__((ext_vector_type(4)));
typedef float f32x16 __attribute__((ext_vector_type(16)));
typedef unsigned u32x2 __attribute__((ext_vector_type(2)));
typedef unsigned u32x4 __attribute__((ext_vector_type(4)));

constexpr int BATCH = 2, SEQ = 16384, D = 1024, T = BATCH * SEQ, DEPTH = 4, NH = 16, HD = 64;
constexpr int NE = 16, DEXP = 256;
constexpr float ALPHA = 1.681792830507429f;
constexpr float LN_EPS = 1e-5f;
constexpr int NWAVES = 8, NTHR = 512;

constexpr size_t MiB = 1u << 20;
constexpr size_t WS_CTL = 0;
constexpr size_t WS_TOKINFO = 1 * MiB;
constexpr size_t WS_SMALL = 1 * MiB + 512 * 1024;
constexpr size_t WS_LIST = 2 * MiB;
constexpr size_t WS_WIN = 4 * MiB;
constexpr size_t WS_WOUT = 22 * MiB;
constexpr size_t WS_WEXP1 = 24 * MiB;
constexpr size_t WS_WEXP2 = 40 * MiB;
constexpr size_t WS_WCMP = 48 * MiB;
constexpr size_t WS_ACTB = 52 * MiB;
constexpr size_t WS_BIG = 116 * MiB;
constexpr size_t WS_END = 512 * MiB;
constexpr size_t BIG_Y = 0;
constexpr size_t BIG_H = 64 * MiB;
constexpr size_t BIG_YB = 100 * MiB;
constexpr size_t BIG_XLO = 240 * MiB;
constexpr int PROWS = 2 * T + NE * 256;

constexpr int CW_BAR = 4096;
constexpr int CW_DBG = 8;
constexpr int CW_MOE = 16384;

constexpr int LDS_BYTES = 160 * 1024;
constexpr int STAGE_OFF = 0;
constexpr int AUX_OFF = 128 * 1024;
constexpr int MISC_OFF = LDS_BYTES - 1024;

DI unsigned f2bf(float f) { unsigned u = __builtin_bit_cast(unsigned, f); return (u + 0x7fffu + ((u >> 16) & 1u)) >> 16; }
DI unsigned pk2(float lo, float hi) { return f2bf(lo) | (f2bf(hi) << 16); }
typedef __bf16 bf16x2_t __attribute__((ext_vector_type(2)));
DI unsigned cvt_pk_bf16(float lo, float hi) { const bf16x2_t r = __builtin_convertvector((f32x2){lo, hi}, bf16x2_t); return __builtin_bit_cast(unsigned, r); }
DI float u2f(unsigned u) { return __builtin_bit_cast(float, u); }
DI unsigned f2u(float f) { return __builtin_bit_cast(unsigned, f); }
DI float bf_lo(unsigned w) { return __builtin_bit_cast(float, w << 16); }
DI float bf_hi(unsigned w) { return __builtin_bit_cast(float, w & 0xffff0000u); }
DI float wave_sum(float v) {
#pragma unroll
    for (int o = 1; o < 64; o <<= 1) v += __shfl_xor(v, o);
    return v;
}
DI int tid_of(int wv) { int l; asm volatile("v_mbcnt_lo_u32_b32 %0, -1, 0\n\tv_mbcnt_hi_u32_b32 %0, -1, %0" : "=v"(l)); return (wv << 6) | l; }
DI float xor32h(float v, int h) { const unsigned u = __builtin_bit_cast(unsigned, v); const u32x2 s = __builtin_amdgcn_permlane32_swap(u, u, false, false);
    return __builtin_bit_cast(float, h ? s.x : s.y); }
DI float quad_xor1(float v) { return __builtin_bit_cast(float, __builtin_amdgcn_update_dpp(0, __builtin_bit_cast(int, v), 0xB1, 0xf, 0xf, false)); }
DI float quad_xor2(float v) { return __builtin_bit_cast(float, __builtin_amdgcn_update_dpp(0, __builtin_bit_cast(int, v), 0x4E, 0xf, 0xf, false)); }
#define LDS_WAIT() asm volatile("s_waitcnt lgkmcnt(0)" ::: "memory")
#define VM_WAIT() asm volatile("s_waitcnt vmcnt(0)" ::: "memory")

#define XB_TMO      128
#define XB_XCNT(j)  (256  + 64 * (j))
#define XB_XSUB(j)  (1280 + 64 * (j))
#define XB_XGEN(j)  (2304 + 64 * (j))
#define XB_TOP      3328
#define XB_TOPGEN   3392
#define XCD_BAR_WORDS 3456
#define XB_SPIN_CAP (1u << 22)
DI unsigned xb_ld(unsigned* p)              { return __hip_atomic_load(p, __ATOMIC_RELAXED, __HIP_MEMORY_SCOPE_AGENT); }
DI unsigned xb_add(unsigned* p, unsigned v) { return __hip_atomic_fetch_add(p, v, __ATOMIC_RELAXED, __HIP_MEMORY_SCOPE_AGENT); }
DI unsigned xb_xcc_id() { return (unsigned)__builtin_amdgcn_s_getreg((3 << 11) | 20) & 0xFu; }
#define XB_SPIN(cond, bar) do { unsigned _sp = 0; while (cond) { __builtin_amdgcn_s_sleep(1); \
    if ((++_sp & 255u) == 0u) { if (xb_ld(&(bar)[XB_TMO])) break; if (_sp > XB_SPIN_CAP) { atomicAdd(&(bar)[XB_TMO], 1u); break; } } } } while (0)
struct XcdBarrier { unsigned* bar; unsigned x; volatile LAS unsigned* st; int wv; };
DI XcdBarrier xcd_barrier_post(unsigned* bar, volatile LAS unsigned* st) {
    XcdBarrier b; b.bar = bar; b.x = xb_xcc_id(); b.st = st;
    if (threadIdx.x == 0) (void)xb_add(&bar[XB_XCNT(b.x)], 1u);
    return b;
}
DI void xcd_barrier_complete(unsigned* bar, unsigned x, unsigned& nloc, unsigned& nx) {
    const unsigned G = gridDim.x * gridDim.y * gridDim.z;
    unsigned sum, cnt, mine, sp = 0u;
    for (;;) {
        sum = 0u; cnt = 0u; mine = 0u;
#pragma unroll
        for (unsigned j = 0; j < 16; ++j) { const unsigned c = xb_ld(&bar[XB_XCNT(j)]); sum += c; cnt += (c > 0u) ? 1u : 0u; mine = (j == x) ? c : mine; }
        if (sum == G) break;
        __builtin_amdgcn_s_sleep(1);
        if ((++sp & 255u) == 0u) { if (xb_ld(&bar[XB_TMO])) break; if (sp > XB_SPIN_CAP) { atomicAdd(&bar[XB_TMO], 1u); break; } }
    }
    nloc = mine > 0u ? mine : 1u; nx = cnt > 0u ? cnt : 1u;
}
DI void xcd_barrier(const XcdBarrier& b) {
    asm volatile("s_waitcnt vmcnt(0)" ::: "memory");
    __syncthreads();
    if (tid_of(b.wv) == 0) {
        unsigned* bar = b.bar;
        const unsigned bx = xb_xcc_id();
        __builtin_amdgcn_s_waitcnt(0);
        unsigned nloc = b.st[0], nx = b.st[1];
        if (nloc == 0u) { xcd_barrier_complete(bar, bx, nloc, nx); b.st[0] = nloc; b.st[1] = nx; }
        const unsigned old = xb_add(&bar[XB_XSUB(bx)], 1u);
        const unsigned gen = old / nloc;
        if (old + 1u == (gen + 1u) * nloc) {
            __builtin_amdgcn_fence(__ATOMIC_RELEASE, "agent");
            asm volatile("s_waitcnt vmcnt(0)" ::: "memory");
            const unsigned og = xb_add(&bar[XB_TOP], 1u);
            const unsigned tg = og / nx;
            if (og + 1u == (tg + 1u) * nx) xb_add(&bar[XB_TOPGEN], 1u);
            else XB_SPIN(xb_ld(&bar[XB_TOPGEN]) == tg, bar);
            __builtin_amdgcn_fence(__ATOMIC_ACQUIRE, "agent");
            xb_add(&bar[XB_XGEN(bx)], 1u);
            asm volatile("s_waitcnt vmcnt(0)" ::: "memory");
        } else {
            XB_SPIN(xb_ld(&bar[XB_XGEN(bx)]) == gen, bar);
            __builtin_amdgcn_fence(__ATOMIC_ACQUIRE, "agent");
            asm volatile("s_waitcnt vmcnt(0)" ::: "memory");
        }
    }
    __syncthreads();
}

namespace pg8 {
constexpr int BM = 256, BK = 64, HALF = 128, HTB = HALF * BK * 2, STAGE_BYTES = 8 * HTB, NXCD = 8, WGM = 8;
__host__ __device__ __forceinline__ int lds_byte(int r, int c) { const int st = (r >> 4) * 2 + (c >> 5), rr = r & 15, cc = c & 31, ob = rr * 64 + cc * 2; return st * 1024 + (ob ^ (((ob >> 9) & 1) << 5)); }
__host__ __device__ __forceinline__ void stage_rc(int b, int& R, int& C) { const int st = b / 1024, sb = b % 1024, swz = sb ^ (((sb >> 9) & 1) << 5); R = (st >> 1) * 16 + swz / 64; C = (st & 1) * 32 + (swz % 64) / 2; }
__host__ __device__ __forceinline__ int perm32(int rho) { const int n = rho >> 4, i = rho & 15; return 8 * (i >> 2) + 4 * n + (i & 3); }

struct Unit { int pm, pn, e; };

struct TileOrder {
    int nM, nN, nwg, G, c;
    DI void init(int nM_, int nN_, int G_, int c_) { nM = nM_; nN = nN_; nwg = nM * nN; G = G_; c = c_; }
    DI bool next(int i, int& pm, int& pn) const {
        const long L = (long)i * G + c; if (L >= nwg) return false;
        int wgid = (int)L; { const int q = nwg / NXCD, r = nwg % NXCD, xcd = wgid % NXCD, off = wgid / NXCD; wgid = (xcd < r ? xcd * (q + 1) : r * (q + 1) + (xcd - r) * q) + off; }
        const int nig = WGM * nN, gid = wgid / nig, fm = gid * WGM, gsz = (nM - fm) < WGM ? (nM - fm) : WGM;
        pm = fm + ((wgid % nig) % gsz); pn = (wgid % nig) / gsz; return true;
    }
};
struct DenseSched {
    static constexpr bool GATHER = false;
    const char* A; const char* Bt; int K; unsigned lda, kstepA; TileOrder ord;
    DI void init(const void* A_, unsigned lda_, unsigned kstepA_, const void* Bt_, int M, int N, int K_, int G, int c) { A = (const char*)A_; Bt = (const char*)Bt_; K = K_; lda = lda_; kstepA = kstepA_; ord.init(M / BM, N / BM, G, c); }
    DI bool next(int i, Unit& u) const { u.e = 0; return ord.next(i, u.pm, u.pn); }
    DI const char* a_base(const Unit& u) const { return A + (size_t)u.pm * BM * lda; }
    DI const char* b_base(const Unit& u) const { return Bt + (size_t)u.pn * BM * K * 2; }
    DI unsigned row_off(int, int) const { return 0u; }
};

template <class Epi, class Sched>
DI void gemm_phase(LAS unsigned char* lds, const Sched& S, const Epi& E, int wv) {
    int tid = tid_of(wv); asm volatile("" : "+v"(tid));
    const int wid = __builtin_amdgcn_readfirstlane(tid >> 6), lane = tid & 63, wr = wid >> 2, wc = wid & 3, fr = lane & 15, fq = lane >> 4;
    const int K = S.K, nt = K / BK;
    unsigned voffB[2]; int Rr[2]; unsigned Cb[2];
#pragma unroll
    for (int i = 0; i < 2; ++i) { int R, C; stage_rc(tid * 16 + i * 8192, R, C); const int Rb = (R & ~31) + perm32(R & 31);
        voffB[i] = (unsigned)(Rb * K + C) * 2u; Rr[i] = R; Cb[i] = (unsigned)C * 2u; }
    const unsigned kstepA = S.kstepA, kstepB = (unsigned)(BK * 2);
    const size_t hstepB = (size_t)HALF * K * 2;
    const unsigned ldsw = (unsigned)wid * 1024u;
    const int aoff = lds_byte(wr * 64 + fr, fq * 8), boff = lds_byte(wc * 32 + fr, fq * 8);
#define PG8_SA(b, h) (((b) * 2 + (h)) * HTB)
#define PG8_SB(b, h) ((4 + (b) * 2 + (h)) * HTB)
#define PG8_STAGE_A(bufoff, basep, vv, h, koff) do { _Pragma("unroll") for (int _i = 0; _i < 2; ++_i) \
        __builtin_amdgcn_global_load_lds((const unsigned*)((basep) + (vv)[h][_i] + (koff)), (LAS unsigned*)(lds + (bufoff) + ldsw + _i * 8192), 16, 0, 0); } while (0)
#define PG8_STAGE_B(bufoff, ptr) do { _Pragma("unroll") for (int _i = 0; _i < 2; ++_i) \
        __builtin_amdgcn_global_load_lds((const unsigned*)((ptr) + voffB[_i]), (LAS unsigned*)(lds + (bufoff) + ldsw + _i * 8192), 16, 0, 0); } while (0)
#define PG8_LDA(dst, b, h) do { _Pragma("unroll") for (int m = 0; m < 4; ++m) _Pragma("unroll") for (int k = 0; k < 2; ++k) dst[m][k] = *(const LAS bf16x8*)(lds + PG8_SA(b, h) + aoff + m * 2048 + k * 1024); } while (0)
#define PG8_LDB(dst, b, h) do { _Pragma("unroll") for (int n = 0; n < 2; ++n) _Pragma("unroll") for (int k = 0; k < 2; ++k) dst[n][k] = *(const LAS bf16x8*)(lds + PG8_SB(b, h) + boff + n * 2048 + k * 1024); } while (0)
#define PG8_MMA(ai, bj, At, Bt) do { __builtin_amdgcn_s_setprio(1); _Pragma("unroll") for (int m = 0; m < 4; ++m) _Pragma("unroll") for (int n = 0; n < 2; ++n) _Pragma("unroll") for (int k = 0; k < 2; ++k) \
        acc[ai][bj][m][n] = __builtin_amdgcn_mfma_f32_16x16x32_bf16(Bt[n][k], At[m][k], acc[ai][bj][m][n], 0, 0, 0); __builtin_amdgcn_s_setprio(0); } while (0)
#define PG8_WAIT_V(n) asm volatile("s_waitcnt vmcnt(" #n ")" ::: "memory")
#define PG8_WAIT_L(n) asm volatile("s_waitcnt lgkmcnt(" #n ")" ::: "memory")
#define PG8_BAR __builtin_amdgcn_s_barrier()
#define PG8_SCHED __builtin_amdgcn_sched_barrier(0)
    Unit cur, nxt; int ui = 0;
    if (!S.next(0, cur)) return;
    unsigned vA[2][2], vN[2][2];
#pragma unroll
    for (int h = 0; h < 2; ++h)
#pragma unroll
        for (int i = 0; i < 2; ++i) { vA[h][i] = (Sched::GATHER ? S.row_off(0, h * HALF + Rr[i]) : (unsigned)(h * HALF + Rr[i]) * S.lda) + Cb[i]; vN[h][i] = vA[h][i]; }
    f32x4 acc[2][2][4][2];
#pragma unroll
    for (int a = 0; a < 2; ++a)
#pragma unroll
        for (int b = 0; b < 2; ++b)
#pragma unroll
            for (int m = 0; m < 4; ++m)
#pragma unroll
                for (int n = 0; n < 2; ++n) acc[a][b][m][n] = (f32x4){0.f, 0.f, 0.f, 0.f};
    bf16x8 At[4][2], B0[2][2], B1[2][2];
    const char* cA = S.a_base(cur); const char* cB = S.b_base(cur);
    PG8_STAGE_B(PG8_SB(0, 0), cB); PG8_STAGE_A(PG8_SA(0, 0), cA, vA, 0, 0u); PG8_STAGE_B(PG8_SB(0, 1), cB + hstepB); PG8_STAGE_A(PG8_SA(0, 1), cA, vA, 1, 0u);
    if (wr == 1) PG8_BAR;
    PG8_WAIT_V(4); PG8_BAR;
    PG8_STAGE_B(PG8_SB(1, 0), cB + kstepB); PG8_STAGE_A(PG8_SA(1, 0), cA, vA, 0, kstepA); PG8_STAGE_B(PG8_SB(1, 1), cB + hstepB + kstepB);
    PG8_WAIT_V(6); PG8_BAR;
    for (;;) {
        const bool has_next = S.next(ui + 1, nxt);
        const char* nA = has_next ? S.a_base(nxt) : cA; const char* nB = has_next ? S.b_base(nxt) : cB;
        if (Sched::GATHER) {
#pragma unroll
            for (int h = 0; h < 2; ++h)
#pragma unroll
                for (int i = 0; i < 2; ++i) vN[h][i] = has_next ? (S.row_off(ui + 1, h * HALF + Rr[i]) + Cb[i]) : vA[h][i];
        }
        for (int t = 0; t < nt; t += 2) {
            const bool last = (t == nt - 2);
            const unsigned k1 = (unsigned)(t + 1) * kstepA;
            const char* a2p = last ? nA : cA; const unsigned k2 = last ? 0u : (unsigned)(t + 2) * kstepA;
            unsigned v2[2][2];
#pragma unroll
            for (int h = 0; h < 2; ++h)
#pragma unroll
                for (int i = 0; i < 2; ++i) v2[h][i] = (Sched::GATHER && last) ? vN[h][i] : vA[h][i];
            const char* b2 = last ? nB : cB + (size_t)(t + 2) * kstepB; const char* b3 = b2 + kstepB;
            PG8_LDB(B0, 0, 0); PG8_SCHED; PG8_LDA(At, 0, 0); PG8_STAGE_A(PG8_SA(1, 1), cA, vA, 1, k1);
            PG8_WAIT_L(8); PG8_BAR; PG8_WAIT_L(0); PG8_MMA(0, 0, At, B0); PG8_BAR; PG8_SCHED;
            PG8_LDB(B1, 0, 1); PG8_STAGE_B(PG8_SB(0, 0), b2);
            PG8_BAR; PG8_WAIT_L(0); PG8_MMA(0, 1, At, B1); PG8_BAR;
            PG8_LDA(At, 0, 1); PG8_STAGE_A(PG8_SA(0, 0), a2p, v2, 0, k2);
            PG8_BAR; PG8_WAIT_L(0); PG8_MMA(1, 0, At, B0); PG8_BAR; PG8_SCHED;
            PG8_STAGE_B(PG8_SB(0, 1), b2 + hstepB);
            PG8_WAIT_V(6); PG8_BAR; PG8_MMA(1, 1, At, B1); PG8_BAR;
            PG8_LDB(B0, 1, 0); PG8_SCHED; PG8_LDA(At, 1, 0); PG8_STAGE_A(PG8_SA(0, 1), a2p, v2, 1, k2);
            PG8_WAIT_L(8); PG8_BAR; PG8_WAIT_L(0); PG8_MMA(0, 0, At, B0); PG8_BAR; PG8_SCHED;
            PG8_LDB(B1, 1, 1); PG8_STAGE_B(PG8_SB(1, 0), b3);
            PG8_BAR; PG8_WAIT_L(0); PG8_MMA(0, 1, At, B1); PG8_BAR;
            PG8_LDA(At, 1, 1); PG8_STAGE_A(PG8_SA(1, 0), a2p, v2, 0, k2 + kstepA);
            PG8_BAR; PG8_WAIT_L(0); PG8_MMA(1, 0, At, B0); PG8_BAR; PG8_SCHED;
            PG8_STAGE_B(PG8_SB(1, 1), b3 + hstepB);
            PG8_WAIT_V(6); PG8_BAR; PG8_MMA(1, 1, At, B1); PG8_BAR;
        }
        E(acc, cur, wr, wc, fr, fq);
        if (!has_next) break;
#pragma unroll
        for (int a = 0; a < 2; ++a)
#pragma unroll
            for (int b = 0; b < 2; ++b)
#pragma unroll
                for (int m = 0; m < 4; ++m)
#pragma unroll
                    for (int n = 0; n < 2; ++n) acc[a][b][m][n] = (f32x4){0.f, 0.f, 0.f, 0.f};
        cur = nxt; cA = nA; cB = nB; ++ui;
#pragma unroll
        for (int h = 0; h < 2; ++h)
#pragma unroll
            for (int i = 0; i < 2; ++i) vA[h][i] = vN[h][i];
    }
    PG8_WAIT_V(0);
    if (wr == 0) PG8_BAR;
    PG8_BAR;
#undef PG8_SA
#undef PG8_SB
#undef PG8_STAGE_A
#undef PG8_STAGE_B
#undef PG8_LDA
#undef PG8_LDB
#undef PG8_MMA
#undef PG8_WAIT_V
#undef PG8_WAIT_L
#undef PG8_BAR
#undef PG8_SCHED
}

struct EpiStore {
    bf16_t* O; size_t ldc;
    DI void operator()(const f32x4 (&acc)[2][2][4][2], const Unit& u, int wr, int wc, int fr, int fq) const {
        const int row0 = u.pm * BM + wr * 64 + fr, col0 = u.pn * BM + wc * 32 + 8 * fq;
#pragma unroll
        for (int ai = 0; ai < 2; ++ai)
#pragma unroll
            for (int m = 0; m < 4; ++m) { bf16_t* rowp = O + (size_t)(row0 + ai * HALF + m * 16) * ldc + col0;
#pragma unroll
                for (int bj = 0; bj < 2; ++bj) { const f32x4 v0 = acc[ai][bj][m][0], v1 = acc[ai][bj][m][1];
                    u32x4 w; w.x = cvt_pk_bf16(v0[0], v0[1]); w.y = cvt_pk_bf16(v0[2], v0[3]); w.z = cvt_pk_bf16(v1[0], v1[1]); w.w = cvt_pk_bf16(v1[2], v1[3]);
                    *(u32x4*)(rowp + bj * HALF) = w; } }
    }
};
struct EpiSwiglu {
    bf16_t* Hb;
    DI void operator()(const f32x4 (&acc)[2][2][4][2], const Unit& u, int wr, int wc, int fr, int fq) const {
        const int row0 = u.pm * BM + wr * 64 + fr, col0 = u.pn * HALF + wc * 32 + 8 * fq;
#pragma unroll
        for (int ai = 0; ai < 2; ++ai)
#pragma unroll
            for (int m = 0; m < 4; ++m) { bf16_t* rowp = Hb + (size_t)(row0 + ai * HALF + m * 16) * DEXP + col0;
                float o[8];
#pragma unroll
                for (int n = 0; n < 2; ++n)
#pragma unroll
                    for (int j = 0; j < 4; ++j) { const float g = acc[ai][0][m][n][j], up = acc[ai][1][m][n][j];
                        o[n * 4 + j] = g * up * __builtin_amdgcn_rcpf(1.0f + __builtin_amdgcn_exp2f(-1.4426950408889634f * g)); }
                u32x4 w; w.x = cvt_pk_bf16(o[0], o[1]); w.y = cvt_pk_bf16(o[2], o[3]); w.z = cvt_pk_bf16(o[4], o[5]); w.w = cvt_pk_bf16(o[6], o[7]);
                *(u32x4*)rowp = w; }
    }
};

struct EpiNsa {
    bf16_t* Q; bf16_t* KV; float* GT;
    DI void operator()(const f32x4 (&acc)[2][2][4][2], const Unit& u, int wr, int wc, int fr, int fq) const {
        const int row0 = u.pm * BM + wr * 64 + fr;
        if (u.pn < 10) {
            bf16_t* base = (u.pn < 4) ? Q + u.pn * BM : KV + (u.pn - 4) * BM; const size_t ldc = (u.pn < 4) ? 1024 : 1536; const int col0 = wc * 32 + 8 * fq;
#pragma unroll
            for (int ai = 0; ai < 2; ++ai)
#pragma unroll
                for (int m = 0; m < 4; ++m) { bf16_t* rowp = base + (size_t)(row0 + ai * HALF + m * 16) * ldc + col0;
#pragma unroll
                    for (int bj = 0; bj < 2; ++bj) { const f32x4 v0 = acc[ai][bj][m][0], v1 = acc[ai][bj][m][1];
                        u32x4 w; w.x = cvt_pk_bf16(v0[0], v0[1]); w.y = cvt_pk_bf16(v0[2], v0[3]); w.z = cvt_pk_bf16(v1[0], v1[1]); w.w = cvt_pk_bf16(v1[2], v1[3]);
                        *(u32x4*)(rowp + bj * HALF) = w; } }
        } else {
            const int col0 = wc * 32 + 8 * fq;
            if (col0 < 48) {
#pragma unroll
                for (int ai = 0; ai < 2; ++ai)
#pragma unroll
                    for (int m = 0; m < 4; ++m) { float* rowp = GT + (size_t)(row0 + ai * HALF + m * 16) * 48 + col0;
#pragma unroll
                        for (int n = 0; n < 2; ++n) { f32x4 v = acc[ai][0][m][n];
#pragma unroll
                            for (int j = 0; j < 4; ++j) v[j] = __builtin_amdgcn_rcpf(1.0f + __builtin_amdgcn_exp2f(-1.4426950408889634f * v[j]));
                            *(f32x4*)(rowp + 4 * n) = v; } }
            }
        }
    }
};
struct EpiCmp {
    bf16_t* Hd; const float* bias;
    DI void operator()(const f32x4 (&acc)[2][2][4][2], const Unit& u, int wr, int wc, int fr, int fq) const {
        const int row0 = u.pm * BM + wr * 64 + fr, col0 = wc * 32 + 8 * fq; const float* bp = bias + u.e * 256;
#pragma unroll
        for (int bj = 0; bj < 2; ++bj) { const f32x4 b0 = *(const f32x4*)(bp + bj * HALF + col0), b1 = *(const f32x4*)(bp + bj * HALF + col0 + 4);
#pragma unroll
            for (int ai = 0; ai < 2; ++ai)
#pragma unroll
                for (int m = 0; m < 4; ++m) { float o[8];
#pragma unroll
                    for (int j = 0; j < 4; ++j) { o[j] = acc[ai][bj][m][0][j] + b0[j]; o[4 + j] = acc[ai][bj][m][1][j] + b1[j]; }
#pragma unroll
                    for (int j = 0; j < 8; ++j) { const float x = o[j], u2 = 1.5957691216057308f * (x + 0.044715f * x * x * x); o[j] = x * __builtin_amdgcn_rcpf(1.0f + __builtin_amdgcn_exp2f(-1.4426950408889634f * u2)); }
                    u32x4 w; w.x = cvt_pk_bf16(o[0], o[1]); w.y = cvt_pk_bf16(o[2], o[3]); w.z = cvt_pk_bf16(o[4], o[5]); w.w = cvt_pk_bf16(o[6], o[7]);
                    *(u32x4*)(Hd + (size_t)(row0 + ai * HALF + m * 16) * 256 + bj * HALF + col0) = w; } }
    }
};
struct CmpSched {
    static constexpr bool GATHER = false;
    const char* kv6; const char* Bt; int K; unsigned lda, kstepA; int G, c;
    DI bool next(int i, Unit& u) const { const int L = i * G + c; if (L >= 64) return false; u.pm = L; u.pn = 0; u.e = L >> 5; return true; }
    DI const char* a_base(const Unit& u) const { const int j = u.pm >> 5, bg = (u.pm >> 2) & 7, cq = u.pm & 3, b = bg >> 2, g = bg & 3;
        return kv6 + (((size_t)b * SEQ + (size_t)cq * 4096) * 1536 + j * 256 + g * 64) * 2; }
    DI const char* b_base(const Unit& u) const { return Bt + (size_t)(u.pm >> 5) * 256 * 2048 * 2; }
    DI unsigned row_off(int, int) const { return 0u; }
};
}

struct MoeMeta { LAS int* tstart; LAS int* cnt; };
DI int moe_expert_of(const MoeMeta& mm, int rt) { int e = 0;
#pragma unroll
    for (int k = 1; k < 16; ++k) e += (rt >= mm.tstart[k]) ? 1 : 0;
    return e; }
struct Moe1Sched {
    static constexpr bool GATHER = true;
    const char* A; const char* Bt; int K; unsigned lda, kstepA; MoeMeta mm; int ntiles, G, c; LAS unsigned* tab;
    DI bool next(int i, pg8::Unit& u) const { const int L = i * G + c; if (L >= ntiles * 2) return false; u.pm = L % ntiles; u.pn = L / ntiles; u.e = moe_expert_of(mm, u.pm); return true; }
    DI const char* a_base(const pg8::Unit&) const { return A; }
    DI const char* b_base(const pg8::Unit& u) const { return Bt + ((size_t)u.e * 512 + (size_t)u.pn * 256) * 1024 * 2; }
    DI unsigned row_off(int slot, int row) const { return tab[slot * 256 + row]; }
};
struct Moe2Sched {
    static constexpr bool GATHER = false;
    const char* A; const char* Bt; int K; unsigned lda, kstepA; MoeMeta mm; int ntiles, G, c;
    DI bool next(int i, pg8::Unit& u) const { const int L = i * G + c; if (L >= ntiles * 4) return false; u.pm = L % ntiles; u.pn = L / ntiles; u.e = moe_expert_of(mm, u.pm); return true; }
    DI const char* a_base(const pg8::Unit& u) const { return A + (size_t)u.pm * 256 * 512; }
    DI const char* b_base(const pg8::Unit& u) const { return Bt + ((size_t)u.e * 1024 + (size_t)u.pn * 256) * 256 * 2; }
    DI unsigned row_off(int, int) const { return 0u; }
};

struct Args { const float* in[25]; float* out; unsigned char* ws; int wv; int pad; };
enum { IN_X = 0, IN_REL, IN_RW, IN_RB, IN_LN1G, IN_LN1B, IN_LN2G, IN_LN2B, IN_EG, IN_EU, IN_ED, IN_DILIN, IN_DILOUT, IN_SBIN, IN_SBOUT,
       IN_NSAIN, IN_NSAOUT, IN_POSK, IN_W1K, IN_W2K, IN_POSV, IN_W1V, IN_W2V, IN_MOBAIN, IN_MOBAOUT };

DI void transpose_item(const float* W, int K, int N, int Nvalid, bf16_t* WT, int drow0, LAS float* scr, int kb, int nb, int lane) {
    const int k0 = 64 * kb, n0 = 32 * nb;
    const int c4 = lane & 7, kr = lane >> 3;
    if (n0 + 32 <= Nvalid) {
#pragma unroll
        for (int i = 0; i < 8; ++i) { const f32x4 v = *(const f32x4*)(W + (size_t)(k0 + kr + 8 * i) * N + n0 + 4 * c4); LAS float* s = scr + (kr + 8 * i) * 33 + 4 * c4;
            s[0] = v.x; s[1] = v.y; s[2] = v.z; s[3] = v.w; }
    } else {
#pragma unroll 8
        for (int i = 0; i < 32; ++i) { const int kk = 2 * i + (lane >> 5); const int n = n0 + (lane & 31); scr[kk * 33 + (lane & 31)] = (n < Nvalid) ? W[(size_t)(k0 + kk) * N + n] : 0.f; }
    }
    LDS_WAIT(); asm volatile("" ::: "memory");
    const int c = lane & 7;
#pragma unroll
    for (int j = 0; j < 4; ++j) { const int n = (lane >> 3) + 8 * j; const LAS float* s = scr + (8 * c) * 33 + n;
        u32x4 o; o.x = pk2(s[0 * 33], s[1 * 33]); o.y = pk2(s[2 * 33], s[3 * 33]); o.z = pk2(s[4 * 33], s[5 * 33]); o.w = pk2(s[6 * 33], s[7 * 33]);
        *(u32x4*)(WT + (size_t)(drow0 + n) * K + k0 + 8 * c) = o; }
    LDS_WAIT(); asm volatile("" ::: "memory");
}
DI void convert_matrix(const float* W, int K, int N, int Npad, bf16_t* WT, LAS float* scr, int gw, int NGW, int lane) {
    const int nblk = Npad / 32, nitems = (K / 64) * nblk;
    for (int it = gw; it < nitems; it += NGW) { const int kb = it / nblk, nb = it % nblk; transpose_item(W, K, N, N, WT, 32 * nb, scr, kb, nb, lane); }
}
DI void convert_layer_weights(const Args& a, int layer, LAS unsigned char* lds, int gw, int NGW, int wave, int lane) {
    LAS float* scr = (LAS float*)(lds + STAGE_OFF + wave * 16384);
    bf16_t* W1 = (bf16_t*)(a.ws + WS_WEXP1); bf16_t* W2 = (bf16_t*)(a.ws + WS_WEXP2);
    const float* eg = a.in[IN_EG] + (size_t)layer * NE * D * DEXP; const float* eu = a.in[IN_EU] + (size_t)layer * NE * D * DEXP; const float* ed = a.in[IN_ED] + (size_t)layer * NE * DEXP * D;
    constexpr int I_G = (D / 64) * (DEXP / 32);
    constexpr int I_D = (DEXP / 64) * (D / 32);
    constexpr int I_E = 2 * I_G + I_D;
    {
        bf16_t* Win = (bf16_t*)(a.ws + WS_WIN); bf16_t* Wout = (bf16_t*)(a.ws + WS_WOUT);
        if (layer == 0) { convert_matrix(a.in[IN_DILIN], D, 9216, 9216, Win, scr, gw, NGW, lane); convert_matrix(a.in[IN_DILOUT], D, D, D, Wout, scr, gw, NGW, lane); }
        if (layer == 1) { convert_matrix(a.in[IN_SBIN], D, 3072, 3072, Win, scr, gw, NGW, lane); convert_matrix(a.in[IN_SBOUT], D, D, D, Wout, scr, gw, NGW, lane); }
        if (layer == 2) { convert_matrix(a.in[IN_NSAIN], D, 2608, 2816, Win, scr, gw, NGW, lane); convert_matrix(a.in[IN_NSAOUT], D, D, D, Wout, scr, gw, NGW, lane);
            bf16_t* wc = (bf16_t*)(a.ws + WS_WCMP);
            convert_matrix(a.in[IN_W1K], 2048, 256, 256, wc, scr, gw, NGW, lane); convert_matrix(a.in[IN_W1V], 2048, 256, 256, wc + 256 * 2048, scr, gw, NGW, lane);
            convert_matrix(a.in[IN_W2K], 256, 64, 64, wc + 2 * 256 * 2048, scr, gw, NGW, lane); convert_matrix(a.in[IN_W2V], 256, 64, 64, wc + 2 * 256 * 2048 + 64 * 256, scr, gw, NGW, lane);
            float* cb = (float*)(a.ws + WS_WCMP + 2 * MiB + 64 * 1024);
            for (int it = gw; it < 512; it += NGW) { const int j = it >> 8, n = it & 255; const float* pos = a.in[j ? IN_POSV : IN_POSK]; const float* w1 = a.in[j ? IN_W1V : IN_W1K];
                float s = 0.f; for (int k = lane; k < 2048; k += 64) s += pos[k] * w1[(size_t)k * 256 + n];
                s = wave_sum(s); if (lane == 0) cb[it] = s; } }
        if (layer == 3) { convert_matrix(a.in[IN_MOBAIN], D, 3072, 3072, Win, scr, gw, NGW, lane); convert_matrix(a.in[IN_MOBAOUT], D, D, D, Wout, scr, gw, NGW, lane); }
    }
    const int NITEMS = NE * I_E;
    for (int it = gw; it < NITEMS; it += NGW) {
        const int e = it / I_E; int r = it % I_E;
        if (r < I_G) { const int kb = r / (DEXP / 32), nb = r % (DEXP / 32); const int n0 = 32 * nb;
            transpose_item(eg + (size_t)e * D * DEXP, D, DEXP, DEXP, W1, e * 512 + ((n0 >> 7) << 8) + (n0 & 127), scr, kb, nb, lane); continue; }
        r -= I_G;
        if (r < I_G) { const int kb = r / (DEXP / 32), nb = r % (DEXP / 32); const int n0 = 32 * nb;
            transpose_item(eu + (size_t)e * D * DEXP, D, DEXP, DEXP, W1, e * 512 + ((n0 >> 7) << 8) + 128 + (n0 & 127), scr, kb, nb, lane); continue; }
        r -= I_G;
        { const int kb = r / (D / 32), nb = r % (D / 32);
          transpose_item(ed + (size_t)e * DEXP * D, DEXP, D, D, W2, e * 1024 + 32 * nb, scr, kb, nb, lane); }
    }
}

struct RowVec { f32x4 v[4]; };
DI void ln_stats(const RowVec& r, float& mean, float& rstd) {
    float s = 0.f;
#pragma unroll
    for (int j = 0; j < 4; ++j) s += (r.v[j].x + r.v[j].y) + (r.v[j].z + r.v[j].w);
    mean = wave_sum(s) * (1.f / D); float s2 = 0.f;
#pragma unroll
    for (int j = 0; j < 4; ++j) { const f32x4 d = r.v[j] - mean; s2 += (d.x * d.x + d.y * d.y) + (d.z * d.z + d.w * d.w); }
    rstd = 1.f / sqrtf(wave_sum(s2) * (1.f / D) + LN_EPS);
}


constexpr int KSTR = 144;
constexpr int KVT = 64;
constexpr int KV_TILE_BYTES = KVT * KSTR;
constexpr float LOG2E = 1.4426950408889634f, LN2F = 0.6931471805599453f;
DI f32x16 mfma32(bf16x8 a, bf16x8 b, f32x16 c) { return __builtin_amdgcn_mfma_f32_32x32x16_bf16(a, b, c, 0, 0, 0); }
DI f32x16 zero16() { f32x16 z; for (int i = 0; i < 16; ++i) z[i] = 0.f; return z; }
DI void kv_fetch(u32x4& kr, u32x4& vr, const bf16_t* kb, const bf16_t* vb, size_t rstride, int row0, int nrows, int tid) {
    asm volatile("" : "+v"(tid));
    const int row = row0 + (tid >> 3), c16 = tid & 7;
    if (row >= 0 && row < nrows) { kr = *(const u32x4*)(kb + (size_t)row * rstride + c16 * 8); vr = *(const u32x4*)(vb + (size_t)row * rstride + c16 * 8); }
    else { kr = (u32x4){0u, 0u, 0u, 0u}; vr = kr; }
}
DI void kv_store(LAS unsigned char* kl, LAS unsigned char* vl, const u32x4& kr, const u32x4& vr, int tid) {
    asm volatile("" ::: "memory"); __builtin_amdgcn_sched_barrier(0);
    asm volatile("" : "+v"(tid));
    const int off = (tid >> 3) * KSTR + (tid & 7) * 16;
    *(LAS u32x4*)(kl + off) = kr; *(LAS u32x4*)(vl + off) = vr;
}
constexpr int DT_BYTES = 16384;
DI void kv_dma_issue(LAS unsigned char* slot, const bf16_t* kb, const bf16_t* vb, size_t rstride, int row0, int nrows, int wave, int lane) {
    asm volatile("" : "+v"(lane));
    const int rr = lane >> 3, row = min(max(row0 + 8 * wave + rr, 0), nrows - 1), ch = (lane & 7) ^ rr;
    const size_t off = (size_t)row * rstride + ch * 8;
    __builtin_amdgcn_global_load_lds((const unsigned*)(kb + off), (LAS unsigned*)(slot + wave * 1024), 16, 0, 0);
    __builtin_amdgcn_global_load_lds((const unsigned*)(vb + off), (LAS unsigned*)(slot + 8192 + wave * 1024), 16, 0, 0);
}
DI f32x16 qk_tile_sw(const LAS unsigned char* kl, int kt, const bf16x8 (&Q)[4], int lane) {
    asm volatile("" : "+v"(lane));
    const int r = lane & 31, h = lane >> 5;
    const int pr = (r & ~12) | ((r & 4) << 1) | ((r & 8) >> 1), sw = pr & 7;
    const LAS unsigned char* p = kl + (kt * 32 + pr) * 128;
    f32x16 S = zero16();
#pragma unroll
    for (int ks = 0; ks < 4; ++ks) { const bf16x8 A = *(const LAS bf16x8*)(p + (((2 * ks + h) ^ sw) << 4)); S = mfma32(A, Q[ks], S); }
    return S;
}
DI void pv_tile_sw(const LAS unsigned char* vl, int kt, const f32x16& P, f32x16 (&O)[2], int lane) {
    asm volatile("" : "+v"(lane));
    const int i16 = lane & 15, q = i16 >> 2, p = i16 & 3, blk = (lane >> 4) & 1, h = lane >> 5;
    const unsigned vp = (unsigned)(size_t)(vl + (kt * 32 + 8 * h + q) * 128 + 8 * (p & 1));
    const int c0 = 2 * blk + (p >> 1), c1 = 4 + c0;
    const unsigned a0 = vp + ((c0 ^ q) << 4), a1 = vp + 512 + ((c0 ^ (q + 4)) << 4), a2 = vp + ((c1 ^ q) << 4), a3 = vp + 512 + ((c1 ^ (q + 4)) << 4);
    s16x4 lo0, hi0, lo1, hi1, lo2, hi2, lo3, hi3;
    asm volatile("ds_read_b64_tr_b16 %0, %8\n\tds_read_b64_tr_b16 %1, %9\n\tds_read_b64_tr_b16 %2, %10\n\tds_read_b64_tr_b16 %3, %11\n\t"
                 "ds_read_b64_tr_b16 %4, %8 offset:2048\n\tds_read_b64_tr_b16 %5, %9 offset:2048\n\tds_read_b64_tr_b16 %6, %10 offset:2048\n\tds_read_b64_tr_b16 %7, %11 offset:2048\n\ts_waitcnt lgkmcnt(0)"
                 : "=&v"(lo0), "=&v"(hi0), "=&v"(lo1), "=&v"(hi1), "=&v"(lo2), "=&v"(hi2), "=&v"(lo3), "=&v"(hi3) : "v"(a0), "v"(a1), "v"(a2), "v"(a3) : "memory");
    { u32x4 pk; pk.x = cvt_pk_bf16(P[0], P[1]); pk.y = cvt_pk_bf16(P[2], P[3]); pk.z = cvt_pk_bf16(P[4], P[5]); pk.w = cvt_pk_bf16(P[6], P[7]);
      const bf16x8 Bp = __builtin_bit_cast(bf16x8, pk);
      O[0] = mfma32(__builtin_shufflevector(lo0, hi0, 0, 1, 2, 3, 4, 5, 6, 7), Bp, O[0]);
      O[1] = mfma32(__builtin_shufflevector(lo1, hi1, 0, 1, 2, 3, 4, 5, 6, 7), Bp, O[1]); }
    { u32x4 pk; pk.x = cvt_pk_bf16(P[8], P[9]); pk.y = cvt_pk_bf16(P[10], P[11]); pk.z = cvt_pk_bf16(P[12], P[13]); pk.w = cvt_pk_bf16(P[14], P[15]);
      const bf16x8 Bp = __builtin_bit_cast(bf16x8, pk);
      O[0] = mfma32(__builtin_shufflevector(lo2, hi2, 0, 1, 2, 3, 4, 5, 6, 7), Bp, O[0]);
      O[1] = mfma32(__builtin_shufflevector(lo3, hi3, 0, 1, 2, 3, 4, 5, 6, 7), Bp, O[1]); }
}
template <int NS, class RowF, class CompF>
DI void kv_dma_pipeline(int n, const RowF& rowf, const CompF& comp, const bf16_t* kb, const bf16_t* vb, size_t rstride, int nrows, LAS unsigned char* ring, int wave, int lane) {
    if (n <= 0) return;
#pragma unroll
    for (int i = 0; i < NS - 1; ++i) if (i < n) kv_dma_issue(ring + i * DT_BYTES, kb, vb, rstride, rowf(i), nrows, wave, lane);
    int sc = 0, sn = NS - 1;
#pragma unroll 1
    for (int j = 0; j < n; ++j) {
        const int rem = min(n - 1 - j, NS - 2);
        if (rem >= 4) asm volatile("s_waitcnt vmcnt(8)" ::: "memory");
        else if (rem == 3) asm volatile("s_waitcnt vmcnt(6)" ::: "memory");
        else if (rem == 2) asm volatile("s_waitcnt vmcnt(4)" ::: "memory");
        else if (rem == 1) asm volatile("s_waitcnt vmcnt(2)" ::: "memory");
        else asm volatile("s_waitcnt vmcnt(0)" ::: "memory");
        __builtin_amdgcn_s_barrier(); asm volatile("" ::: "memory");
        comp(j, ring + sc * DT_BYTES, ring + sc * DT_BYTES + 8192);
        if (j + NS - 1 < n) kv_dma_issue(ring + sn * DT_BYTES, kb, vb, rstride, rowf(j + NS - 1), nrows, wave, lane);
        sc = (sc + 1 == NS) ? 0 : sc + 1; sn = (sn + 1 == NS) ? 0 : sn + 1;
    }
    asm volatile("s_waitcnt lgkmcnt(0)" ::: "memory"); __builtin_amdgcn_s_barrier(); asm volatile("" ::: "memory");
}
template <int NS, class IssueF, class CompF>
DI void kv_dma_stream(int n, const IssueF& issue, const CompF& comp, LAS unsigned char* ring) {
    if (n <= 0) return;
#pragma unroll
    for (int i = 0; i < NS - 1; ++i) if (i < n) issue(i, ring + i * DT_BYTES);
    int sc = 0, sn = NS - 1;
#pragma unroll 1
    for (int j = 0; j < n; ++j) {
        const int rem = min(n - 1 - j, NS - 2);
        if (rem >= 4) asm volatile("s_waitcnt vmcnt(8)" ::: "memory");
        else if (rem == 3) asm volatile("s_waitcnt vmcnt(6)" ::: "memory");
        else if (rem == 2) asm volatile("s_waitcnt vmcnt(4)" ::: "memory");
        else if (rem == 1) asm volatile("s_waitcnt vmcnt(2)" ::: "memory");
        else asm volatile("s_waitcnt vmcnt(0)" ::: "memory");
        __builtin_amdgcn_s_barrier(); asm volatile("" ::: "memory");
        comp(j, ring + sc * DT_BYTES, ring + sc * DT_BYTES + 8192);
        if (j + NS - 1 < n) issue(j + NS - 1, ring + sn * DT_BYTES);
        sc = (sc + 1 == NS) ? 0 : sc + 1; sn = (sn + 1 == NS) ? 0 : sn + 1;
    }
    asm volatile("s_waitcnt lgkmcnt(0)" ::: "memory"); __builtin_amdgcn_s_barrier(); asm volatile("" ::: "memory");
}
DI f32x16 qk_tile(const LAS unsigned char* kl, int kt, const bf16x8 (&Q)[4], int lane) {
    asm volatile("" : "+v"(lane));
    const int r = lane & 31, h = lane >> 5;
    const int pr = (r & ~12) | ((r & 4) << 1) | ((r & 8) >> 1);
    const LAS unsigned char* p = kl + (kt * 32 + pr) * KSTR + h * 16;
    f32x16 S = zero16();
#pragma unroll
    for (int ks = 0; ks < 4; ++ks) { const bf16x8 A = *(const LAS bf16x8*)(p + ks * 32); S = mfma32(A, Q[ks], S); }
    return S;
}
DI void pv_tile(const LAS unsigned char* vl, int kt, const f32x16& P, f32x16 (&O)[2], int lane) {
    asm volatile("" : "+v"(lane));
    const int i16 = lane & 15, q = i16 >> 2, p = i16 & 3, blk = (lane >> 4) & 1, h = lane >> 5;
#pragma unroll
    for (int s = 0; s < 2; ++s) {
        u32x4 pk; pk.x = cvt_pk_bf16(P[8 * s + 0], P[8 * s + 1]); pk.y = cvt_pk_bf16(P[8 * s + 2], P[8 * s + 3]); pk.z = cvt_pk_bf16(P[8 * s + 4], P[8 * s + 5]); pk.w = cvt_pk_bf16(P[8 * s + 6], P[8 * s + 7]);
        const bf16x8 Bp = __builtin_bit_cast(bf16x8, pk);
        const LAS unsigned char* vp = vl + (kt * 32 + 16 * s + 8 * h + q) * KSTR + (16 * blk + 4 * p) * 2;
#pragma unroll
        for (int dt = 0; dt < 2; ++dt) {
            const s16x4 lo = __builtin_amdgcn_ds_read_tr16_b64_v4i16((LAS s16x4*)(vp + dt * 64));
            const s16x4 hi = __builtin_amdgcn_ds_read_tr16_b64_v4i16((LAS s16x4*)(vp + dt * 64 + 4 * KSTR));
            const bf16x8 A = __builtin_shufflevector(lo, hi, 0, 1, 2, 3, 4, 5, 6, 7);
            O[dt] = mfma32(A, Bp, O[dt]);
        }
    }
}
DI void store_o(bf16_t* orow, const f32x16 (&O)[2], float sc, int h) {
#pragma unroll
    for (int dt = 0; dt < 2; ++dt)
#pragma unroll
        for (int g = 0; g < 4; ++g) { u32x2 w; w.x = cvt_pk_bf16(O[dt][4 * g] * sc, O[dt][4 * g + 1] * sc); w.y = cvt_pk_bf16(O[dt][4 * g + 2] * sc, O[dt][4 * g + 3] * sc);
            *(u32x2*)(orow + dt * 32 + 8 * g + 4 * h) = w; }
}

constexpr int BT_PAD = 128, BT_LEN = BT_PAD + 2048;
constexpr int DIST_ANY = 0x3fffffff, DIST_NONE = 0x40000000;
constexpr size_t WS_BIASG = WS_SMALL + 256 * 1024;
DI void load_bias_table(LAS float* dst, const float* biasG, int head, int dsh, int tid, int hicut = 0x3fffffff) {
    for (int i = tid; i < BT_LEN; i += NTHR) { const int n = i - BT_PAD; dst[i] = (n >= 0 && n <= hicut) ? biasG[head * 2048 + min(n << dsh, 2047)] : -1e30f; }
}
template <int STRIDE, bool MASKED>
DI float logits_tile(f32x16 (&S)[2], const LAS float* P, int D0, int h, int lo, unsigned range) {
    float mx = -1e30f;
    if (!MASKED && __all(D0 - 63 * STRIDE >= 1512)) {
        const float cb = P[BT_PAD + 2047];
#pragma unroll
        for (int sub = 0; sub < 2; ++sub)
#pragma unroll
            for (int i = 0; i < 16; ++i) { const float x = S[sub][i] * (0.125f * LOG2E) + cb; S[sub][i] = x; mx = fmaxf(mx, x); }
        return mx;
    }
#pragma unroll
    for (int sub = 0; sub < 2; ++sub)
#pragma unroll
        for (int s = 0; s < 2; ++s) {
            const int d0 = D0 - (32 * sub + 16 * s + 8 * h) * STRIDE;
            const int base = min(max(d0 - 7 * STRIDE + BT_PAD, 0), BT_LEN - 1 - 7 * STRIDE);
            const LAS float* pb = P + base;
#pragma unroll
            for (int j = 0; j < 8; ++j) { const int i = 8 * s + j;
                float x = S[sub][i] * (0.125f * LOG2E) + pb[(7 - j) * STRIDE];
                if (MASKED) x = ((unsigned)(d0 - j * STRIDE - lo) <= range) ? x : -1e30f;
                S[sub][i] = x; mx = fmaxf(mx, x); }
        }
    return mx;
}
template <int STRIDE, bool MASKED>
DI void softmax_tile(f32x16 (&S)[2], float& m, float& l, f32x16 (&O)[2], const LAS float* P, int D0, int h, int lo, unsigned range) {
    float mx = logits_tile<STRIDE, MASKED>(S, P, D0, h, lo, range);
    mx = fmaxf(mx, xor32h(mx, h));
    const float mnew = fmaxf(m, mx), mm = (mnew <= -1e30f) ? 0.f : mnew;
    float ls = 0.f;
#pragma unroll
    for (int sub = 0; sub < 2; ++sub)
#pragma unroll
        for (int i = 0; i < 16; ++i) { const float p = __builtin_amdgcn_exp2f(S[sub][i] - mm); S[sub][i] = p; ls += p; }
    ls += xor32h(ls, h);
    if (!__all(mnew == m)) {
        const float alpha = __builtin_amdgcn_exp2f(m - mnew);
        l *= alpha;
#pragma unroll
        for (int dt = 0; dt < 2; ++dt)
#pragma unroll
            for (int i = 0; i < 16; ++i) O[dt][i] *= alpha;
    }
    l += ls; m = mnew;
}
template <int STRIDE, bool MASKED>
DI void stats_tile(f32x16 (&S)[2], float& m, float& l, const LAS float* P, int D0, int h, int lo, unsigned range) {
    float mx = logits_tile<STRIDE, MASKED>(S, P, D0, h, lo, range);
    mx = fmaxf(mx, xor32h(mx, h));
    const float mnew = fmaxf(m, mx), mm = (mnew <= -1e30f) ? 0.f : mnew;
    float ls = 0.f;
#pragma unroll
    for (int sub = 0; sub < 2; ++sub)
#pragma unroll
        for (int i = 0; i < 16; ++i) ls += __builtin_amdgcn_exp2f(S[sub][i] - mm);
    ls += xor32h(ls, h);
    l = l * __builtin_amdgcn_exp2f(m - mnew) + ls; m = mnew;
}

constexpr size_t BIG_OG = 288 * MiB;
constexpr size_t BIG_LSE = 384 * MiB;
DI void dilated_phase(const Args& a, LAS unsigned char* lds) {
    int tid = tid_of(a.wv); asm volatile("" : "+v"(tid));
    const int lane = tid & 63, wave = a.wv, c = lane & 31, h = lane >> 5;
    const bf16_t* qkv = (const bf16_t*)(a.ws + WS_BIG);
    LAS unsigned char* kbuf = lds; LAS unsigned char* vbuf = lds + 2 * KV_TILE_BYTES;
    LAS float* btab = (LAS float*)(lds + 4 * KV_TILE_BYTES);
    const float* biasG = (const float*)(a.ws + WS_BIASG);
    const int G = gridDim.x, bid = blockIdx.x;
    const int nu = bid < 3072 ? (3072 - bid + G - 1) / G : 0;
    if (nu == 0) return;
#define DL_DESC(k) const int u_ = bid + (k) * G, hh_ = u_ & 15, g_ = (u_ >> 4) >> 6, idx_ = (u_ >> 4) & 63, dsh_ = 2 * g_, r_ = idx_ & ((1 << dsh_) - 1), blk_ = idx_ >> dsh_; \
        const bf16_t* qb_ = qkv + (size_t)r_ * 9216 + g_ * 3072 + hh_ * 64; const size_t rs_ = (size_t)9216 << dsh_; (void)blk_; (void)qb_; (void)rs_;
    int cur_key = -1, buf = 0;
    int hh = 0, g = 0, dsh = 0, r = 0, Q0 = 0, q0w = 0, iq = 0;
    bf16x8 Q[4], Qn[4];
    f32x16 O[2]; float m = -1e30f, l = 0.f;
    u32x4 kr, vr;
    { DL_DESC(0)
      const bf16_t* qrow = qb_ + (size_t)(blk_ * 256 + 32 * wave + c) * rs_;
#pragma unroll
      for (int ks = 0; ks < 4; ++ks) Qn[ks] = *(const bf16x8*)(qrow + 16 * ks + 8 * h);
      kv_fetch(kr, vr, qb_ + 1024, qb_ + 2048, rs_, blk_ * 256 - 128, SEQ >> dsh_, tid); kv_store(kbuf, vbuf, kr, vr, tid); }
    const int total = nu * 6;
#pragma unroll 1
    for (int f = 0; f < total; ++f) {
        const int k = f / 6, j = f - 6 * k;
        if (j == 0) {
            DL_DESC(k)
            hh = hh_; g = g_; dsh = dsh_; r = r_; Q0 = blk_ * 256; q0w = Q0 + 32 * wave; iq = q0w + c;
#pragma unroll
            for (int ks = 0; ks < 4; ++ks) Q[ks] = Qn[ks];
            O[0] = zero16(); O[1] = zero16(); m = -1e30f; l = 0.f;
            if (hh * 4 + g != cur_key) { __syncthreads(); load_bias_table(btab, biasG, hh, dsh, tid, 128); cur_key = hh * 4 + g; }
        }
        __syncthreads();
        if (f + 1 < total) { const int k1 = (f + 1) / 6, j1 = (f + 1) - 6 * k1; DL_DESC(k1)
            kv_fetch(kr, vr, qb_ + 1024, qb_ + 2048, rs_, blk_ * 256 - 128 + 64 * j1, SEQ >> dsh_, tid); }
        { const int kr0 = Q0 - 128 + 64 * j;
          if (kr0 <= q0w + 31 && kr0 + 63 >= q0w - 128 && kr0 + 63 >= 0) {
            const LAS unsigned char* kl = kbuf + buf * KV_TILE_BYTES; const LAS unsigned char* vl = vbuf + buf * KV_TILE_BYTES;
            f32x16 S[2]; S[0] = qk_tile(kl, 0, Q, lane); S[1] = qk_tile(kl, 1, Q, lane);
            if (Q0 > 0) softmax_tile<1, false>(S, m, l, O, btab, iq - kr0, h, 0, 128u);
            else softmax_tile<1, true>(S, m, l, O, btab, iq - kr0, h, 0, (unsigned)min(128, iq));
            pv_tile(vl, 0, S[0], O, lane); pv_tile(vl, 1, S[1], O, lane);
          } }
        if (j == 3 && k + 1 < nu) { DL_DESC(k + 1)
            const bf16_t* qrow = qb_ + (size_t)(blk_ * 256 + 32 * wave + c) * rs_;
#pragma unroll
            for (int ks = 0; ks < 4; ++ks) Qn[ks] = *(const bf16x8*)(qrow + 16 * ks + 8 * h); }
        if (f + 1 < total) kv_store(kbuf + (buf ^ 1) * KV_TILE_BYTES, vbuf + (buf ^ 1) * KV_TILE_BYTES, kr, vr, tid);
        buf ^= 1;
        if (j == 5) {
            const int tok = (iq << dsh) + r;
            bf16_t* og = (bf16_t*)(a.ws + WS_BIG + BIG_OG) + (size_t)g * SEQ * D;
            float* lse = (float*)(a.ws + WS_BIG + BIG_LSE) + (size_t)g * SEQ * 16;
            store_o(og + (size_t)tok * D + hh * 64, O, 1.f / l, h);
            if (h == 0) lse[tok * 16 + hh] = m + __builtin_amdgcn_logf(l);
        }
    }
#undef DL_DESC
}
DI void dilated_merge(const Args& a, int b) {
    const int tid = tid_of(a.wv);
    const bf16_t* og = (const bf16_t*)(a.ws + WS_BIG + BIG_OG); const float* lse = (const float*)(a.ws + WS_BIG + BIG_LSE);
    bf16_t* outb = (bf16_t*)(a.ws + WS_ACTB) + (size_t)b * SEQ * D;
    for (int i = blockIdx.x * NTHR + tid; i < SEQ * 128; i += gridDim.x * NTHR) {
        const int tok = i >> 7, c8 = i & 127, hh = c8 >> 3;
        const float l0 = lse[tok * 16 + hh], l1 = lse[SEQ * 16 + tok * 16 + hh], l2 = lse[2 * SEQ * 16 + tok * 16 + hh];
        const float mx = fmaxf(l0, fmaxf(l1, l2));
        float w0 = __builtin_amdgcn_exp2f(l0 - mx), w1 = __builtin_amdgcn_exp2f(l1 - mx), w2 = __builtin_amdgcn_exp2f(l2 - mx);
        const float inv = 1.f / (w0 + w1 + w2); w0 *= inv; w1 *= inv; w2 *= inv;
        const u32x4 a0 = *(const u32x4*)(og + (size_t)tok * D + c8 * 8), a1 = *(const u32x4*)(og + (size_t)SEQ * D + (size_t)tok * D + c8 * 8), a2 = *(const u32x4*)(og + (size_t)2 * SEQ * D + (size_t)tok * D + c8 * 8);
        u32x4 o;
        o.x = pk2(w0 * bf_lo(a0.x) + w1 * bf_lo(a1.x) + w2 * bf_lo(a2.x), w0 * bf_hi(a0.x) + w1 * bf_hi(a1.x) + w2 * bf_hi(a2.x));
        o.y = pk2(w0 * bf_lo(a0.y) + w1 * bf_lo(a1.y) + w2 * bf_lo(a2.y), w0 * bf_hi(a0.y) + w1 * bf_hi(a1.y) + w2 * bf_hi(a2.y));
        o.z = pk2(w0 * bf_lo(a0.z) + w1 * bf_lo(a1.z) + w2 * bf_lo(a2.z), w0 * bf_hi(a0.z) + w1 * bf_hi(a1.z) + w2 * bf_hi(a2.z));
        o.w = pk2(w0 * bf_lo(a0.w) + w1 * bf_lo(a1.w) + w2 * bf_lo(a2.w), w0 * bf_hi(a0.w) + w1 * bf_hi(a1.w) + w2 * bf_hi(a2.w));
        *(u32x4*)(outb + (size_t)tok * D + c8 * 8) = o;
    }
}

constexpr size_t MB_KMEAN = WS_ACTB, MB_SELW = WS_ACTB + 1 * MiB, MB_LIST = WS_ACTB + 4 * MiB;
constexpr size_t BIG_OSEL = 192 * MiB, BIG_LSESEL = 384 * MiB;
constexpr int CW_MBCNT = 32768, CW_MBCUR = 32768 + 2048;
constexpr int CW_NSAQ = 40960;
constexpr int MB_LISTCAP = 49152;
DI void moba_kmean_phase(const Args& a, LAS unsigned char* lds) {
    const int tid = tid_of(a.wv);
    const bf16_t* qkv = (const bf16_t*)(a.ws + WS_BIG);
    float* kmean = (float*)(a.ws + MB_KMEAN);
    LAS float* part = (LAS float*)lds;
    for (int u = blockIdx.x; u < 2048; u += gridDim.x) {
        const int n = u & 63, bh = u >> 6, b = bh >> 4, hh = bh & 15;
        const bf16_t* kp = qkv + ((size_t)b * SEQ + n * 256 + (tid >> 3)) * 3072 + 1024 + hh * 64 + (tid & 7) * 8;
        float s[8];
#pragma unroll
        for (int j = 0; j < 8; ++j) s[j] = 0.f;
#pragma unroll
        for (int i = 0; i < 4; ++i) { const u32x4 v = *(const u32x4*)(kp + (size_t)(64 * i) * 3072);
            s[0] += bf_lo(v.x); s[1] += bf_hi(v.x); s[2] += bf_lo(v.y); s[3] += bf_hi(v.y); s[4] += bf_lo(v.z); s[5] += bf_hi(v.z); s[6] += bf_lo(v.w); s[7] += bf_hi(v.w); }
        __syncthreads();
        *(LAS f32x4*)(part + (tid >> 3) * 64 + (tid & 7) * 8) = (f32x4){s[0], s[1], s[2], s[3]}; *(LAS f32x4*)(part + (tid >> 3) * 64 + (tid & 7) * 8 + 4) = (f32x4){s[4], s[5], s[6], s[7]};
        __syncthreads();
        if (tid < 64) { float acc = 0.f;
#pragma unroll 8
            for (int gq = 0; gq < 64; ++gq) acc += part[gq * 64 + tid];
            kmean[((size_t)bh * 64 + n) * 64 + tid] = acc * (1.f / 256.f); }
    }
}
DI void moba_gate_phase(const Args& a, LAS unsigned char* lds) {
    int tid = tid_of(a.wv); asm volatile("" : "+v"(tid));
    const int lane = tid & 63, wave = __builtin_amdgcn_readfirstlane(tid >> 6), c = lane & 31, h = lane >> 5;
    const bf16_t* qkv = (const bf16_t*)(a.ws + WS_BIG);
    const float* kmean = (const float*)(a.ws + MB_KMEAN);
    unsigned* selw = (unsigned*)(a.ws + MB_SELW);
    unsigned* cnt = (unsigned*)(a.ws + WS_CTL) + CW_MBCNT;
    LAS unsigned char* khi = lds; LAS unsigned char* klo = lds + KV_TILE_BYTES;
    LAS int* hist = (LAS int*)(lds + 2 * KV_TILE_BYTES);
    int cur_bh = -1;
    for (int u = blockIdx.x; u < 2048; u += gridDim.x) {
        const int bh = u & 31, qb = u >> 5, b = bh >> 4, hh = bh & 15;
        const int t = qb * 256 + 32 * wave + c;
        __syncthreads();
        if (bh != cur_bh) { cur_bh = bh;
          const int row = tid >> 3, c16 = tid & 7; const float* kp = kmean + ((size_t)bh * 64 + row) * 64 + c16 * 8;
          const f32x4 v0 = *(const f32x4*)kp, v1 = *(const f32x4*)(kp + 4);
          float v[8] = {v0.x, v0.y, v0.z, v0.w, v1.x, v1.y, v1.z, v1.w}; unsigned hi[8], lo[8];
#pragma unroll
          for (int j = 0; j < 8; ++j) { hi[j] = f2bf(v[j]); lo[j] = f2bf(v[j] - u2f(hi[j] << 16)); }
          u32x4 wh, wl; wh.x = hi[0] | (hi[1] << 16); wh.y = hi[2] | (hi[3] << 16); wh.z = hi[4] | (hi[5] << 16); wh.w = hi[6] | (hi[7] << 16);
          wl.x = lo[0] | (lo[1] << 16); wl.y = lo[2] | (lo[3] << 16); wl.z = lo[4] | (lo[5] << 16); wl.w = lo[6] | (lo[7] << 16);
          kv_store(khi, klo, wh, wl, tid); }
        if (tid < 64) hist[tid] = 0;
        __syncthreads();
        bf16x8 Q[4];
        { const bf16_t* qrow = qkv + ((size_t)b * SEQ + t) * 3072 + hh * 64;
#pragma unroll
          for (int ks = 0; ks < 4; ++ks) Q[ks] = *(const bf16x8*)(qrow + 16 * ks + 8 * h); }
        f32x16 Gs[2];
#pragma unroll
        for (int sub = 0; sub < 2; ++sub) { const f32x16 a0 = qk_tile(khi, sub, Q, lane), a1 = qk_tile(klo, sub, Q, lane);
#pragma unroll
            for (int i = 0; i < 16; ++i) { const int n = sub * 32 + 16 * (i >> 3) + 8 * h + (i & 7); Gs[sub][i] = (n < qb) ? (a0[i] + a1[i]) : -1e30f; } }
        unsigned selpack = 0;
#pragma unroll
        for (int pass = 0; pass < 3; ++pass) {
            float bv = -3e38f; int bn = 64;
#pragma unroll
            for (int sub = 0; sub < 2; ++sub)
#pragma unroll
                for (int i = 0; i < 16; ++i) { const int n = sub * 32 + 16 * (i >> 3) + 8 * h + (i & 7); const float v = Gs[sub][i];
                    if (v > bv || (v == bv && n < bn)) { bv = v; bn = n; } }
            const float pv = __shfl_xor(bv, 32); const int pn = __shfl_xor(bn, 32);
            if (pv > bv || (pv == bv && pn < bn)) { bv = pv; bn = pn; }
            const bool ok = bv > -1e29f;
            selpack |= (ok ? (unsigned)bn : 255u) << (8 * pass);
            if (ok && h == 0) atomicAdd((int*)(hist + bn), 1);
#pragma unroll
            for (int sub = 0; sub < 2; ++sub)
#pragma unroll
                for (int i = 0; i < 16; ++i) { const int n = sub * 32 + 16 * (i >> 3) + 8 * h + (i & 7); if (n == bn) Gs[sub][i] = -3e38f; }
        }
        if (h == 0) selw[(size_t)bh * SEQ + t] = selpack;
        __syncthreads();
        if (tid < 64 && hist[tid] > 0) xb_add(cnt + bh * 64 + tid, (unsigned)hist[tid]);
    }
}
DI void moba_fill_phase(const Args& a, LAS unsigned char* lds) {
    const int tid = tid_of(a.wv);
    const unsigned* selw = (const unsigned*)(a.ws + MB_SELW);
    unsigned* cnt = (unsigned*)(a.ws + WS_CTL) + CW_MBCNT; unsigned* cur = (unsigned*)(a.ws + WS_CTL) + CW_MBCUR;
    unsigned* list = (unsigned*)(a.ws + MB_LIST);
    LAS int* hist = (LAS int*)lds; LAS int* gb = hist + 64; LAS int* off = gb + 64;
    for (int u = blockIdx.x; u < 2048; u += gridDim.x) {
        const int bh = u & 31, qb = u >> 5;
        __syncthreads();
        if (tid < 64) hist[tid] = 0;
        if (tid >= 64 && tid < 128) { const int n = tid - 64; const int v = (int)xb_ld(cnt + bh * 64 + n); int inc = v;
#pragma unroll
            for (int o = 1; o < 64; o <<= 1) { const int tv = __shfl_up(inc, o); if (n >= o) inc += tv; }
            off[n] = inc - v; }
        __syncthreads();
        unsigned sp = 0xffffffffu; int lp[3] = {0, 0, 0};
        if (tid < 256) { sp = selw[(size_t)bh * SEQ + qb * 256 + tid];
#pragma unroll
            for (int k = 0; k < 3; ++k) { const unsigned n = (sp >> (8 * k)) & 255u; if (n < 64u) lp[k] = atomicAdd((int*)(hist + n), 1); } }
        __syncthreads();
        if (tid < 64 && hist[tid] > 0) gb[tid] = (int)xb_add(cur + bh * 64 + tid, (unsigned)hist[tid]);
        __syncthreads();
        if (tid < 256) {
#pragma unroll
            for (int k = 0; k < 3; ++k) { const unsigned n = (sp >> (8 * k)) & 255u;
                if (n < 64u) list[(size_t)bh * MB_LISTCAP + off[n] + gb[n] + lp[k]] = (unsigned)(qb * 256 + tid) | ((unsigned)k << 14); } }
    }
}
DI void moba_sel_phase(const Args& a, LAS unsigned char* lds) {
    int tid = tid_of(a.wv); asm volatile("" : "+v"(tid));
    const int lane = tid & 63, wave = __builtin_amdgcn_readfirstlane(tid >> 6), c = lane & 31, h = lane >> 5;
    const bf16_t* qkv = (const bf16_t*)(a.ws + WS_BIG);
    const unsigned* cnt = (const unsigned*)(a.ws + WS_CTL) + CW_MBCNT;
    const unsigned* list = (const unsigned*)(a.ws + MB_LIST);
    bf16_t* osel = (bf16_t*)(a.ws + WS_BIG + BIG_OSEL); float* lsesel = (float*)(a.ws + WS_BIG + BIG_LSESEL);
    const float* biasG = (const float*)(a.ws + WS_BIASG);
    LAS unsigned char* kbuf = lds; LAS unsigned char* vbuf = lds + 2 * KV_TILE_BYTES;
    LAS float* btab = (LAS float*)(lds + 4 * KV_TILE_BYTES);
    LAS int* cs = (LAS int*)(lds + 4 * KV_TILE_BYTES + BT_LEN * 4);
    LAS int* eo = cs + 2052;
    LAS int* part = eo + 2052;
    { int cc[4], ee[4], sc = 0, se = 0;
#pragma unroll
      for (int j = 0; j < 4; ++j) { const int v = (int)xb_ld((unsigned*)cnt + tid * 4 + j); ee[j] = se; cc[j] = sc; se += v; sc += (v + 255) >> 8; }
      part[tid] = sc; part[512 + tid] = se;
      __syncthreads();
      if (tid == 0) { int a0 = 0, a1 = 0; for (int i = 0; i < 512; ++i) { const int v0 = part[i], v1 = part[512 + i]; part[i] = a0; part[512 + i] = a1; a0 += v0; a1 += v1; } cs[2048] = a0; eo[2048] = a1; }
      __syncthreads();
#pragma unroll
      for (int j = 0; j < 4; ++j) { cs[tid * 4 + j] = part[tid] + cc[j]; eo[tid * 4 + j] = part[512 + tid] + ee[j]; }
      __syncthreads(); }
    const int NC = cs[2048];
    int cur_hh = -1;
    for (int u = blockIdx.x; u < NC; u += gridDim.x) {
        int lo = 0, hi = 2047;
        while (lo < hi) { const int mid = (lo + hi + 1) >> 1; if (cs[mid] <= u) lo = mid; else hi = mid - 1; }
        const int item = lo, bh = item >> 6, n = item & 63, b = bh >> 4, hh = bh & 15;
        const int chunk = u - cs[item], nent = (int)xb_ld((unsigned*)cnt + item) - chunk * 256;
        const size_t ebase = (size_t)bh * MB_LISTCAP + (eo[item] - eo[bh * 64]) + chunk * 256;
        __syncthreads();
        if (hh != cur_hh) { load_bias_table(btab, biasG, hh, 0, tid); cur_hh = hh; }
        const int e = 32 * wave + c; const bool ev = e < nent;
        const unsigned ent = list[ebase + (ev ? e : 0)];
        const int t = ent & 16383, slot = ent >> 14;
        bf16x8 Q[4];
        { const bf16_t* qrow = qkv + ((size_t)b * SEQ + t) * 3072 + hh * 64;
#pragma unroll
          for (int ks = 0; ks < 4; ++ks) Q[ks] = *(const bf16x8*)(qrow + 16 * ks + 8 * h); }
        const bf16_t* kb = qkv + (size_t)b * SEQ * 3072 + 1024 + hh * 64; const bf16_t* vb = kb + 1024;
        f32x16 O[2]; O[0] = zero16(); O[1] = zero16();
        float m = -1e30f, l = 0.f;
        u32x4 kr, vr; int buf = 0;
        kv_fetch(kr, vr, kb, vb, 3072, n * 256, SEQ, tid); kv_store(kbuf, vbuf, kr, vr, tid);
        __syncthreads();
        for (int j = 0; j < 4; ++j) {
            if (j < 3) kv_fetch(kr, vr, kb, vb, 3072, n * 256 + 64 * (j + 1), SEQ, tid);
            const int k0 = n * 256 + 64 * j;
            if (32 * wave < nent) {
                const LAS unsigned char* kl = kbuf + buf * KV_TILE_BYTES; const LAS unsigned char* vl = vbuf + buf * KV_TILE_BYTES;
                f32x16 S[2]; S[0] = qk_tile(kl, 0, Q, lane); S[1] = qk_tile(kl, 1, Q, lane);
                softmax_tile<1, false>(S, m, l, O, btab, t - k0, h, 0, (unsigned)DIST_ANY);
                pv_tile(vl, 0, S[0], O, lane); pv_tile(vl, 1, S[1], O, lane);
            }
            if (j < 3) kv_store(kbuf + (buf ^ 1) * KV_TILE_BYTES, vbuf + (buf ^ 1) * KV_TILE_BYTES, kr, vr, tid);
            __syncthreads();
            buf ^= 1;
        }
        if (ev) { const size_t ob = ((size_t)bh * SEQ + t) * 3 + slot;
            store_o(osel + ob * 64, O, 1.f / l, h);
            if (h == 0) lsesel[ob] = m + __builtin_amdgcn_logf(l); }
    }
}
DI void moba_own_phase(const Args& a, LAS unsigned char* lds) {
    int tid = tid_of(a.wv); asm volatile("" : "+v"(tid));
    const int lane = tid & 63, wave = __builtin_amdgcn_readfirstlane(tid >> 6), c = lane & 31, h = lane >> 5;
    const bf16_t* qkv = (const bf16_t*)(a.ws + WS_BIG);
    const bf16_t* osel = (const bf16_t*)(a.ws + WS_BIG + BIG_OSEL); const float* lsesel = (const float*)(a.ws + WS_BIG + BIG_LSESEL);
    bf16_t* outb = (bf16_t*)(a.ws + WS_ACTB);
    const float* biasG = (const float*)(a.ws + WS_BIASG);
    LAS unsigned char* kbuf = lds; LAS unsigned char* vbuf = lds + 2 * KV_TILE_BYTES;
    LAS float* btab = (LAS float*)(lds + 4 * KV_TILE_BYTES);
    int cur_hh = -1;
    for (int u = blockIdx.x; u < 2048; u += gridDim.x) {
        const int bh = u & 31, qb = u >> 5, b = bh >> 4, hh = bh & 15;
        const int q0w = qb * 256 + 32 * wave, t = q0w + c;
        __syncthreads();
        if (hh != cur_hh) { load_bias_table(btab, biasG, hh, 0, tid); cur_hh = hh; }
        bf16x8 Q[4];
        { const bf16_t* qrow = qkv + ((size_t)b * SEQ + t) * 3072 + hh * 64;
#pragma unroll
          for (int ks = 0; ks < 4; ++ks) Q[ks] = *(const bf16x8*)(qrow + 16 * ks + 8 * h); }
        const bf16_t* kb = qkv + (size_t)b * SEQ * 3072 + 1024 + hh * 64; const bf16_t* vb = kb + 1024;
        f32x16 O[2]; O[0] = zero16(); O[1] = zero16();
        float m = -1e30f, l = 0.f;
        u32x4 kr, vr; int buf = 0;
        kv_fetch(kr, vr, kb, vb, 3072, qb * 256, SEQ, tid); kv_store(kbuf, vbuf, kr, vr, tid);
        __syncthreads();
        for (int j = 0; j < 4; ++j) {
            if (j < 3) kv_fetch(kr, vr, kb, vb, 3072, qb * 256 + 64 * (j + 1), SEQ, tid);
            const int k0 = qb * 256 + 64 * j;
            if (k0 <= q0w + 31) {
                const LAS unsigned char* kl = kbuf + buf * KV_TILE_BYTES; const LAS unsigned char* vl = vbuf + buf * KV_TILE_BYTES;
                f32x16 S[2]; S[0] = qk_tile(kl, 0, Q, lane); S[1] = qk_tile(kl, 1, Q, lane);
                softmax_tile<1, false>(S, m, l, O, btab, t - k0, h, 0, (unsigned)DIST_ANY);
                pv_tile(vl, 0, S[0], O, lane); pv_tile(vl, 1, S[1], O, lane);
            }
            if (j < 3) kv_store(kbuf + (buf ^ 1) * KV_TILE_BYTES, vbuf + (buf ^ 1) * KV_TILE_BYTES, kr, vr, tid);
            __syncthreads();
            buf ^= 1;
        }
        const int nv = qb < 3 ? qb : 3;
        const float lown = m + __builtin_amdgcn_logf(l);
        float ls[3]; float mx = lown;
        const size_t ob = ((size_t)bh * SEQ + t) * 3;
#pragma unroll
        for (int k = 0; k < 3; ++k) { ls[k] = (k < nv) ? lsesel[ob + k] : -1e30f; mx = fmaxf(mx, ls[k]); }
        float wown = __builtin_amdgcn_exp2f(lown - mx), wsum = wown, wk[3];
#pragma unroll
        for (int k = 0; k < 3; ++k) { wk[k] = (k < nv) ? __builtin_amdgcn_exp2f(ls[k] - mx) : 0.f; wsum += wk[k]; }
        const float inv = 1.f / wsum; wown *= inv / l;
#pragma unroll
        for (int dt = 0; dt < 2; ++dt)
#pragma unroll
            for (int i = 0; i < 16; ++i) O[dt][i] *= wown;
#pragma unroll
        for (int k = 0; k < 3; ++k) if (k < nv) { const float w = wk[k] * inv; const bf16_t* orow = osel + (ob + k) * 64;
#pragma unroll
            for (int dt = 0; dt < 2; ++dt)
#pragma unroll
                for (int g = 0; g < 4; ++g) { const u32x2 v = *(const u32x2*)(orow + dt * 32 + 8 * g + 4 * h);
                    O[dt][4 * g] += w * bf_lo(v.x); O[dt][4 * g + 1] += w * bf_hi(v.x); O[dt][4 * g + 2] += w * bf_lo(v.y); O[dt][4 * g + 3] += w * bf_hi(v.y); } }
        store_o(outb + ((size_t)b * SEQ + t) * D + hh * 64, O, 1.f, h);
    }
}

constexpr size_t NS_Q = 0, NS_KV = 64 * MiB, NS_GT = 164 * MiB, NS_HID = 172 * MiB, NS_KC = 180 * MiB, NS_KFR = 182 * MiB, NS_VFR = 198 * MiB;
DI void nsa_kcvc_phase(const Args& a, LAS unsigned char* lds) {
    int tid = tid_of(a.wv); asm volatile("" : "+v"(tid));
    {
        const bf16_t* kv6 = (const bf16_t*)(a.ws + WS_BIG + NS_KV); u32x4* kfr = (u32x4*)(a.ws + WS_BIG + NS_KFR); u32x4* vfr = (u32x4*)(a.ws + WS_BIG + NS_VFR);
        for (int tl = blockIdx.x; tl < 2048; tl += gridDim.x) {
            const int bg = tl >> 8, t0 = (tl & 255) * 64, b = bg >> 2, g = bg & 3;
            __syncthreads();
            { const int row = tid >> 3, c16 = tid & 7; const bf16_t* src_ = kv6 + ((size_t)b * SEQ + t0 + row) * 1536 + 2 * 256 + g * 64 + c16 * 8;
              *(LAS u32x4*)(lds + row * KSTR + c16 * 16) = *(const u32x4*)src_; *(LAS u32x4*)(lds + KV_TILE_BYTES + row * KSTR + c16 * 16) = *(const u32x4*)(src_ + 256); }
            __syncthreads();
            { const int f = tid >> 6, ln = tid & 63, r31 = ln & 31, hh = ln >> 5;
              { const int kt = f >> 2, ks = f & 3, pr = (r31 & ~12) | ((r31 & 4) << 1) | ((r31 & 8) >> 1);
                kfr[((size_t)tl * 8 + f) * 64 + ln] = *(const LAS u32x4*)(lds + (kt * 32 + pr) * KSTR + (16 * ks + 8 * hh) * 2); }
              { const int kt = f >> 2, s = (f >> 1) & 1, dt = f & 1; unsigned v[8];
#pragma unroll
                for (int i = 0; i < 8; ++i) v[i] = *(const LAS unsigned short*)(lds + KV_TILE_BYTES + (kt * 32 + 16 * s + 8 * hh + i) * KSTR + (dt * 32 + r31) * 2);
                u32x4 w; w.x = v[0] | (v[1] << 16); w.y = v[2] | (v[3] << 16); w.z = v[4] | (v[5] << 16); w.w = v[6] | (v[7] << 16);
                vfr[((size_t)tl * 8 + f) * 64 + ln] = w; } }
        }
    }
    const int lane = tid & 63, wave = __builtin_amdgcn_readfirstlane(tid >> 6), c = lane & 31, h = lane >> 5;
    const bf16_t* hidden = (const bf16_t*)(a.ws + WS_BIG + NS_HID); const bf16_t* w2t = (const bf16_t*)(a.ws + WS_WCMP) + 2 * 256 * 2048;
    bf16_t* kcvc = (bf16_t*)(a.ws + WS_BIG + NS_KC);
    for (int task = blockIdx.x * NWAVES + wave; task < 512; task += gridDim.x * NWAVES) {
        const int j = task >> 8, R0 = (task & 255) * 32;
        const bf16_t* hid = hidden + ((size_t)j * 8192 + R0 + c) * 256; const bf16_t* w2 = w2t + j * 64 * 256;
        f32x16 acc[2]; acc[0] = zero16(); acc[1] = zero16();
#pragma unroll
        for (int ks = 0; ks < 16; ++ks) { const bf16x8 Bv = *(const bf16x8*)(hid + 16 * ks + 8 * h);
#pragma unroll
            for (int dt = 0; dt < 2; ++dt) { const bf16x8 Av = *(const bf16x8*)(w2 + (dt * 32 + c) * 256 + 16 * ks + 8 * h); acc[dt] = mfma32(Av, Bv, acc[dt]); } }
        store_o(kcvc + ((size_t)j * 8192 + R0 + c) * 64, acc, 1.f, h);
    }
}
DI void nsa_attn_phase(const Args& a, LAS unsigned char* lds) {
    const int wave = a.wv;
#define NSA_VARS int tid = tid_of(a.wv); const int lane = tid & 63, c = lane & 31, h = lane >> 5, qi = c >> 2, r = c & 3, t = tw0 + qi; \
    const LAS float* bt = btab + r * (BT_LEN + 8); const float* gtp = gates + (tokbase + t) * 48 + 4 * g + r; (void)bt; (void)h; (void)lane; (void)gtp;
    const bf16_t* qb_ = (const bf16_t*)(a.ws + WS_BIG + NS_Q); const bf16_t* kv6 = (const bf16_t*)(a.ws + WS_BIG + NS_KV);
    const float* gates = (const float*)(a.ws + WS_BIG + NS_GT); const bf16_t* kcvc = (const bf16_t*)(a.ws + WS_BIG + NS_KC);
    bf16_t* outb = (bf16_t*)(a.ws + WS_ACTB); const float* biasG = (const float*)(a.ws + WS_BIASG);
    LAS unsigned char* ring = lds;
    LAS float* imp = (LAS float*)(lds + 49152);
    LAS float* btab = (LAS float*)(lds + 116736);
    LAS unsigned* selm = (LAS unsigned*)(lds + 151808);
    LAS unsigned* wm = selm + 512;
    LAS int* blist = (LAS int*)(wm + 64);
    LAS int* Oacc = (LAS int*)imp;
    constexpr int OAS = 66;
    LAS int* lacc = (LAS int*)(lds + 155392);
    constexpr float FXS = 16384.f;
    LAS float* mref = (LAS float*)(lds + 156416);
    LAS unsigned long long* qmask = (LAS unsigned long long*)(lds + 157440);
    LAS int* qsel = (LAS int*)(lds + 159488);
    const bf16x8* kfr = (const bf16x8*)(a.ws + WS_BIG + NS_KFR); const bf16x8* vfr = (const bf16x8*)(a.ws + WS_BIG + NS_VFR);
    int cur_g = -1;
    unsigned* nsa_ctr = (unsigned*)(a.ws + WS_CTL) + CW_NSAQ;
    volatile LAS int* uword = (volatile LAS int*)(lds + MISC_OFF + 160);
    for (;;) {
        const int bg = blockIdx.x & 7;
        __syncthreads();
        if (tid_of(a.wv) == 0) *uword = (int)xb_add(nsa_ctr + bg * 64, 1u);
        __syncthreads();
        const int uidx = *uword; if (uidx >= 256) break;
        const int tile = 255 - uidx, b = bg >> 2, g = bg & 3;
        const int T0 = tile * 64, tw0 = T0 + 8 * wave;
        const size_t tokbase = (size_t)b * SEQ;
        __syncthreads();
        bf16x8 Q[4];
        { NSA_VARS
          if (g != cur_g) { for (int rr = 0; rr < 4; ++rr) load_bias_table(btab + rr * (BT_LEN + 8), biasG, 4 * g + rr, 0, tid); cur_g = g; }
          for (int i = tid; i < 64 * 260; i += NTHR) imp[i] = 0.f;
          const bf16_t* qrow = qb_ + (tokbase + t) * 1024 + (4 * g + r) * 64;
#pragma unroll
          for (int ks = 0; ks < 4; ++ks) Q[ks] = *(const bf16x8*)(qrow + 16 * ks + 8 * h); }
        f32x16 OUT[2]; OUT[0] = zero16(); OUT[1] = zero16();
        const int nct = (T0 + 63 >= 31) ? (((T0 + 32) >> 4) >> 6) + 1 : 0;
        const int j0w = (T0 >= 511) ? ((T0 - 511) >> 6) : 0, nwin = tile - j0w + 1, nd = tile >= 2 ? 3 : tile + 1;
        const int e1 = nct, e2 = 2 * nct, e3 = e2 + nwin, e4 = e3 + nd;
        const bf16_t* kcb = kcvc + (size_t)bg * 1024 * 64; const bf16_t* vcb = kcb + (size_t)8192 * 64;
        const bf16_t* kvb = kv6 + tokbase * 1536 + g * 64;
        f32x16 O[2]; O[0] = zero16(); O[1] = zero16();
        float m = -1e30f, l = 0.f, mc = -1e30f, lc = 0.f, invl = 0.f, mfin = 0.f;
        __syncthreads();
        kv_dma_stream<3>(e4, [&](int fi, LAS unsigned char* slot) {
                const int lane = tid_of(a.wv) & 63;
                if (fi < e2) kv_dma_issue(slot, kcb, vcb, 64, 64 * (fi < e1 ? fi : fi - e1), 1024, wave, lane);
                else if (fi < e3) kv_dma_issue(slot, kvb + 4 * 256, kvb + 5 * 256, 1536, (j0w + fi - e2) * 64, SEQ, wave, lane);
                else { const int i = fi - e3, blk = (i == 0) ? 0 : (tile >= 2 ? tile - 2 + i : i); kv_dma_issue(slot, kvb + 2 * 256, kvb + 3 * 256, 1536, blk * 64, SEQ, wave, lane); }
            }, [&](int fi, const LAS unsigned char* kl, const LAS unsigned char* vl) {
                NSA_VARS
                if (fi < e1) {
                    const int c0 = 64 * fi;
                    if (16 * c0 + 31 <= tw0 + 7) {
                        f32x16 S[2]; S[0] = qk_tile_sw(kl, 0, Q, lane); S[1] = qk_tile_sw(kl, 1, Q, lane);
                        stats_tile<16, false>(S, mc, lc, bt, t - 16 * c0 - 31, h, 0, (unsigned)DIST_ANY);
                    }
                } else if (fi < e2) {
                    if (fi == e1) { invl = lc > 0.f ? 1.f / lc : 0.f; mfin = (mc <= -1e30f) ? 0.f : mc; }
                    const int c0 = 64 * (fi - e1);
                    if (16 * c0 + 31 <= tw0 + 7) {
                        f32x16 S[2]; S[0] = qk_tile_sw(kl, 0, Q, lane); S[1] = qk_tile_sw(kl, 1, Q, lane);
                        (void)logits_tile<16, false>(S, bt, t - 16 * c0 - 31, h, 0, (unsigned)DIST_ANY);
#pragma unroll
                        for (int sub = 0; sub < 2; ++sub)
#pragma unroll
                            for (int i = 0; i < 16; ++i) S[sub][i] = __builtin_amdgcn_exp2f(S[sub][i] - mfin) * invl;
#pragma unroll
                        for (int sub = 0; sub < 2; ++sub)
#pragma unroll
                            for (int s = 0; s < 2; ++s) { const int j0 = (c0 + sub * 32 + 16 * s + 8 * h) >> 2;
                                float a0 = (S[sub][8 * s] + S[sub][8 * s + 1]) + (S[sub][8 * s + 2] + S[sub][8 * s + 3]);
                                float a1 = (S[sub][8 * s + 4] + S[sub][8 * s + 5]) + (S[sub][8 * s + 6] + S[sub][8 * s + 7]) + S[sub][8 * s + 3];
                                float a2 = S[sub][8 * s + 7];
                                a0 += quad_xor1(a0); a1 += quad_xor1(a1); a2 += quad_xor1(a2);
                                a0 += quad_xor2(a0); a1 += quad_xor2(a1); a2 += quad_xor2(a2);
                                if (r == 0) { LAS float* ip = imp + (8 * wave + qi) * 260 + j0; atomicAdd((float*)ip, a0); atomicAdd((float*)(ip + 1), a1); atomicAdd((float*)(ip + 2), a2); } }
                        pv_tile_sw(vl, 0, S[0], O, lane); pv_tile_sw(vl, 1, S[1], O, lane);
                    }
                    if (fi == e2 - 1) { const float gt_cmp = gtp[0];
#pragma unroll
                        for (int dt = 0; dt < 2; ++dt)
#pragma unroll
                            for (int i = 0; i < 16; ++i) { OUT[dt][i] += gt_cmp * O[dt][i]; O[dt][i] = 0.f; } }
                } else if (fi < e3) {
                    const int k0 = (j0w + fi - e2) * 64;
                    if (k0 <= tw0 + 7 && k0 + 63 >= tw0 - 511) {
                        f32x16 S[2]; S[0] = qk_tile_sw(kl, 0, Q, lane); S[1] = qk_tile_sw(kl, 1, Q, lane);
                        if (k0 >= tw0 + 7 - 511) softmax_tile<1, false>(S, m, l, O, bt, t - k0, h, 0, 511u);
                        else softmax_tile<1, true>(S, m, l, O, bt, t - k0, h, 0, 511u);
                        pv_tile_sw(vl, 0, S[0], O, lane); pv_tile_sw(vl, 1, S[1], O, lane);
                    }
                    if (fi == e3 - 1) { const float sc_ = gtp[32] / l;
#pragma unroll
                        for (int dt = 0; dt < 2; ++dt)
#pragma unroll
                            for (int i = 0; i < 16; ++i) { OUT[dt][i] += sc_ * O[dt][i]; O[dt][i] = 0.f; }
                        m = -1e30f; l = 0.f; }
                } else {
                    const int i = fi - e3, blk = (i == 0) ? 0 : (tile >= 2 ? tile - 2 + i : i), k0 = blk * 64;
                    f32x16 S[2]; S[0] = qk_tile_sw(kl, 0, Q, lane); S[1] = qk_tile_sw(kl, 1, Q, lane);
                    softmax_tile<1, false>(S, m, l, O, bt, t - k0, h, 0, (unsigned)DIST_ANY);
                    pv_tile_sw(vl, 0, S[0], O, lane); pv_tile_sw(vl, 1, S[1], O, lane);
                }
            }, ring);
        __syncthreads();
#pragma unroll 1
        for (int qh = 0; qh < 2; ++qh) {
            const int lane = tid_of(a.wv) & 63;
            const int cur = tile;
            unsigned key[4][4];
#pragma unroll
            for (int q4 = 0; q4 < 4; ++q4) { const int ql = 8 * wave + 4 * qh + q4;
#pragma unroll
                for (int kk = 0; kk < 4; ++kk) { const int j = lane + 64 * kk; const bool forced = (j == 0) || (j == cur) || (j + 1 == cur);
                    key[q4][kk] = forced ? 0xffffffffu : ((j <= cur) ? f2u(imp[ql * 260 + j]) + 1u : 0u); } }
            unsigned prefix[4] = {0u, 0u, 0u, 0u};
#pragma unroll 1
            for (int bit = 31; bit >= 0; --bit) {
#pragma unroll
                for (int q4 = 0; q4 < 4; ++q4) { const unsigned cand = prefix[q4] | (1u << bit); int cnt = 0;
#pragma unroll
                    for (int kk = 0; kk < 4; ++kk) cnt += __popcll(__ballot(key[q4][kk] >= cand));
                    if (cnt >= 16) prefix[q4] = cand; } }
            const unsigned long long ltmask = (1ull << lane) - 1ull;
#pragma unroll
            for (int q4 = 0; q4 < 4; ++q4) { const int ql = 8 * wave + 4 * qh + q4; const unsigned pf = prefix[q4];
                int cgt = 0;
#pragma unroll
                for (int kk = 0; kk < 4; ++kk) cgt += __popcll(__ballot(key[q4][kk] > pf));
                const int need = 16 - cgt; int running = 0;
#pragma unroll
                for (int kk = 0; kk < 4; ++kk) { const unsigned long long eqb = __ballot(key[q4][kk] == pf);
                    const bool take = key[q4][kk] > pf || (pf != 0u && key[q4][kk] == pf && running + __popcll(eqb & ltmask) < need);
                    running += __popcll(eqb);
                    const unsigned long long bal = __ballot(take);
                    if (lane == 0) { selm[ql * 8 + 2 * kk] = (unsigned)bal; selm[ql * 8 + 2 * kk + 1] = (unsigned)(bal >> 32); } } }
        }
        __syncthreads();
        { const int tid = tid_of(a.wv);
          if (tid < 8) { unsigned o = 0u;
              if (tid == 0) o |= 1u;
              if ((tile >> 5) == tid) o |= 1u << (tile & 31);
              if (tile >= 1 && ((tile - 1) >> 5) == tid) o |= 1u << ((tile - 1) & 31);
              wm[tid] = o; } }
        __syncthreads();
        { const int lane = tid_of(a.wv) & 63;
#pragma unroll 1
          for (int jj = 0; jj < 32; ++jj) { const int j = wave * 32 + jj; const unsigned w = selm[lane * 8 + (j >> 5)] & ~wm[j >> 5];
              const unsigned long long bal = __ballot((w >> (j & 31)) & 1u); if (lane == 0) qmask[j] = bal; } }
        {
            NSA_VARS
            LAS int* oa = Oacc + ((8 * wave + qi) * 4 + r) * OAS;
#pragma unroll
            for (int dt = 0; dt < 2; ++dt)
#pragma unroll
                for (int g4 = 0; g4 < 4; ++g4) { u32x2 w0, w1; w0.x = (unsigned)(int)(O[dt][4 * g4] * FXS); w0.y = (unsigned)(int)(O[dt][4 * g4 + 1] * FXS); w1.x = (unsigned)(int)(O[dt][4 * g4 + 2] * FXS); w1.y = (unsigned)(int)(O[dt][4 * g4 + 3] * FXS);
                    *(LAS u32x2*)(oa + dt * 32 + 8 * g4 + 4 * h) = w0; *(LAS u32x2*)(oa + dt * 32 + 8 * g4 + 4 * h + 2) = w1; }
            if (h == 0) { lacc[(8 * wave + qi) * 4 + r] = (int)(l * FXS); mref[(8 * wave + qi) * 4 + r] = m; }
        }
        __syncthreads();
        {
            NSA_VARS
            LAS int* qs = qsel + wave * 8;
            const unsigned long long ltm = (1ull << lane) - 1ull;
            int j = wave; unsigned long long qm = 0ull;
            while (j <= tile) { qm = qmask[j]; if (qm != 0ull) break; j += 8; }
            if (j <= tile) {
                int n = __popcll(qm), ch = 0;
                if ((qm >> lane) & 1ull) { const int rk = __popcll(qm & ltm); if (rk < 8) qs[rk] = lane; }
                bool lv = qi < n; int ql = qs[lv ? qi : 0];
                bf16x8 KA[2][4], VA[2][2][2], Qs[4];
                { const bf16x8* kp = kfr + ((size_t)(bg * 256 + j) * 8) * 64 + lane; const bf16x8* vp = vfr + ((size_t)(bg * 256 + j) * 8) * 64 + lane;
                  const bf16_t* qrow = qb_ + (tokbase + T0 + ql) * 1024 + (4 * g + r) * 64;
#pragma unroll
                  for (int ks = 0; ks < 4; ++ks) Qs[ks] = *(const bf16x8*)(qrow + 16 * ks + 8 * h);
#pragma unroll
                  for (int f8 = 0; f8 < 8; ++f8) KA[f8 >> 2][f8 & 3] = kp[f8 * 64];
#pragma unroll
                  for (int f8 = 0; f8 < 8; ++f8) VA[f8 >> 2][(f8 >> 1) & 1][f8 & 1] = vp[f8 * 64]; }
#pragma unroll 1
                for (;;) {
                    int jn = j, chn = ch + 1, nn = n; unsigned long long qmn = qm;
                    if (chn * 8 >= n) { chn = 0; jn = j + 8; qmn = 0ull; while (jn <= tile) { qmn = qmask[jn]; if (qmn != 0ull) break; jn += 8; } nn = __popcll(qmn); }
                    const bool has_next = jn <= tile, newblk = jn != j;
                    f32x16 S[2];
#pragma unroll
                    for (int kt = 0; kt < 2; ++kt) { S[kt] = zero16();
#pragma unroll
                        for (int ks = 0; ks < 4; ++ks) S[kt] = mfma32(KA[kt][ks], Qs[ks], S[kt]); }
                    const int tq = T0 + ql, D0 = tq - j * 64;
                    const float mr = mref[ql * 4 + r];
                    LAS int* oa = Oacc + (ql * 4 + r) * OAS + 4 * h; LAS int* la = lacc + ql * 4 + r;
                    const bool lvc = lv;
                    if (has_next) {
                        if ((qmn >> lane) & 1ull) { const int rk = __popcll(qmn & ltm) - 8 * chn; if (rk >= 0 && rk < 8) qs[rk] = lane; }
                        lv = qi < nn - 8 * chn; ql = qs[lv ? qi : 0];
                        const bf16_t* qrow = qb_ + (tokbase + T0 + ql) * 1024 + (4 * g + r) * 64;
#pragma unroll
                        for (int ks = 0; ks < 4; ++ks) Qs[ks] = *(const bf16x8*)(qrow + 16 * ks + 8 * h);
                        if (newblk) { const bf16x8* kp = kfr + ((size_t)(bg * 256 + jn) * 8) * 64 + lane;
#pragma unroll
                            for (int f8 = 0; f8 < 8; ++f8) KA[f8 >> 2][f8 & 3] = kp[f8 * 64]; }
                    }
                    (void)logits_tile<1, false>(S, bt, D0, h, 0, (unsigned)DIST_ANY);
                    float ls = 0.f;
#pragma unroll
                    for (int kt = 0; kt < 2; ++kt)
#pragma unroll
                        for (int i = 0; i < 16; ++i) { const float p = lvc ? __builtin_amdgcn_exp2f(S[kt][i] - mr) : 0.f; S[kt][i] = p; ls += p; }
                    ls += xor32h(ls, h);
                    f32x16 Oa[2]; Oa[0] = zero16(); Oa[1] = zero16();
#pragma unroll
                    for (int kt = 0; kt < 2; ++kt)
#pragma unroll
                        for (int s = 0; s < 2; ++s) {
                            u32x4 pk; pk.x = cvt_pk_bf16(S[kt][8 * s + 0], S[kt][8 * s + 1]); pk.y = cvt_pk_bf16(S[kt][8 * s + 2], S[kt][8 * s + 3]); pk.z = cvt_pk_bf16(S[kt][8 * s + 4], S[kt][8 * s + 5]); pk.w = cvt_pk_bf16(S[kt][8 * s + 6], S[kt][8 * s + 7]);
                            const bf16x8 Bp = __builtin_bit_cast(bf16x8, pk);
                            Oa[0] = mfma32(VA[kt][s][0], Bp, Oa[0]); Oa[1] = mfma32(VA[kt][s][1], Bp, Oa[1]); }
                    if (has_next && newblk) { const bf16x8* vp = vfr + ((size_t)(bg * 256 + jn) * 8) * 64 + lane;
#pragma unroll
                        for (int f8 = 0; f8 < 8; ++f8) VA[f8 >> 2][(f8 >> 1) & 1][f8 & 1] = vp[f8 * 64]; }
                    if (lvc) {
#pragma unroll
                        for (int dt = 0; dt < 2; ++dt)
#pragma unroll
                            for (int i = 0; i < 16; ++i) atomicAdd((int*)(oa + dt * 32 + (i & 3) + 8 * (i >> 2)), (int)(Oa[dt][i] * FXS));
                        if (h == 0) atomicAdd((int*)la, (int)(ls * FXS)); }
                    if (!has_next) break;
                    j = jn; ch = chn; qm = qmn; n = nn;
                }
            }
        }
        __syncthreads();
        {
            NSA_VARS
            const float gt_sel = gtp[16];
            const LAS int* oa = Oacc + ((8 * wave + qi) * 4 + r) * OAS;
            const float sc_ = gt_sel / (float)lacc[(8 * wave + qi) * 4 + r];
#pragma unroll
            for (int dt = 0; dt < 2; ++dt)
#pragma unroll
                for (int g4 = 0; g4 < 4; ++g4) { const u32x2 v0 = *(const LAS u32x2*)(oa + dt * 32 + 8 * g4 + 4 * h), v1 = *(const LAS u32x2*)(oa + dt * 32 + 8 * g4 + 4 * h + 2);
                    OUT[dt][4 * g4] += sc_ * (float)(int)v0.x; OUT[dt][4 * g4 + 1] += sc_ * (float)(int)v0.y; OUT[dt][4 * g4 + 2] += sc_ * (float)(int)v1.x; OUT[dt][4 * g4 + 3] += sc_ * (float)(int)v1.y; }
        }
        { NSA_VARS
          store_o(outb + (tokbase + t) * D + (4 * g + r) * 64, OUT, 1.f, h); }
    }
#undef NSA_VARS
}

DI void sb_phase(const Args& a, LAS unsigned char* lds) {
    int tid = tid_of(a.wv); asm volatile("" : "+v"(tid));
    const int lane = tid & 63, wave = __builtin_amdgcn_readfirstlane(tid >> 6), c = lane & 31, h = lane >> 5;
    const bf16_t* qkv = (const bf16_t*)(a.ws + WS_BIG);
    bf16_t* outb = (bf16_t*)(a.ws + WS_ACTB);
    LAS unsigned char* kbuf = lds; LAS unsigned char* vbuf = lds + 2 * KV_TILE_BYTES;
    volatile LAS int* flags = (volatile LAS int*)(lds + 4 * KV_TILE_BYTES);
    for (int u = blockIdx.x; u < 2048; u += gridDim.x) {
        const int qb = u & 63, hh = (u >> 6) & 15, b = u >> 10;
        const int q0w = qb * 256 + 32 * wave, t = q0w + c;
        const size_t tokbase = (size_t)b * SEQ;
        const bf16_t* kb = qkv + tokbase * 3072 + 1024 + hh * 64;
        const bf16_t* vb = qkv + tokbase * 3072 + 2048 + hh * 64;
        bf16x8 Q[4];
        { const bf16_t* qrow = qkv + (tokbase + t) * 3072 + hh * 64;
#pragma unroll
          for (int ks = 0; ks < 4; ++ks) Q[ks] = *(const bf16x8*)(qrow + 16 * ks + 8 * h); }
        f32x16 O[2]; O[0] = zero16(); O[1] = zero16();
        float carry = 1.f; bool wdone = false;
        int jt = qb * 4 + 3, buf = 0;
        u32x4 kr, vr;
        kv_fetch(kr, vr, kb, vb, 3072, jt * 64, SEQ, tid); kv_store(kbuf, vbuf, kr, vr, tid);
        __syncthreads();
        for (; jt >= 0; --jt) {
            if (jt > 0) kv_fetch(kr, vr, kb, vb, 3072, (jt - 1) * 64, SEQ, tid);
            const int kb0 = jt * 64;
            if (!wdone && kb0 < q0w + 31) {
                const LAS unsigned char* kl = kbuf + buf * KV_TILE_BYTES; const LAS unsigned char* vl = vbuf + buf * KV_TILE_BYTES;
                f32x16 SP[2], U[2];
                SP[0] = qk_tile(kl, 0, Q, lane); SP[1] = qk_tile(kl, 1, Q, lane);
                float Tc[2][2];
#pragma unroll
                for (int sub = 0; sub < 2; ++sub)
#pragma unroll
                    for (int s = 0; s < 2; ++s) { float acc = 1.f;
#pragma unroll
                        for (int j = 0; j < 8; ++j) { const int i = 8 * s + j; const int key = kb0 + sub * 32 + 16 * s + 8 * h + j;
                            const float z = __builtin_amdgcn_fmed3f(SP[sub][i] * 0.125f, -60.f, 60.f);
                            const float e = __builtin_amdgcn_exp2f(z * LOG2E);
                            const float u = __builtin_amdgcn_rcpf(1.f + e);
                            const bool valid = key < t;
                            SP[sub][i] = valid ? e * u : 0.f; U[sub][i] = valid ? u : 1.f; acc *= U[sub][i]; }
                        Tc[sub][s] = acc; }
                float Tp[2][2], pr[2][2];
#pragma unroll
                for (int sub = 0; sub < 2; ++sub)
#pragma unroll
                    for (int s = 0; s < 2; ++s) { Tp[sub][s] = xor32h(Tc[sub][s], h); pr[sub][s] = Tc[sub][s] * Tp[sub][s]; }
                float offp[2][2];
                offp[1][1] = carry; offp[1][0] = offp[1][1] * pr[1][1]; offp[0][1] = offp[1][0] * pr[1][0]; offp[0][0] = offp[0][1] * pr[0][1];
                carry = offp[0][0] * pr[0][0];
#pragma unroll
                for (int sub = 0; sub < 2; ++sub)
#pragma unroll
                    for (int s = 0; s < 2; ++s) { float run = offp[sub][s] * (h == 0 ? Tp[sub][s] : 1.f);
#pragma unroll
                        for (int j = 7; j >= 0; --j) { const int i = 8 * s + j; SP[sub][i] *= run; run *= U[sub][i]; } }
                pv_tile(vl, 0, SP[0], O, lane); pv_tile(vl, 1, SP[1], O, lane);
                wdone = __all(carry < 1e-38f);
            }
            if (lane == 0) flags[buf * 8 + wave] = wdone ? 1 : 0;
            if (jt > 0) kv_store(kbuf + (buf ^ 1) * KV_TILE_BYTES, vbuf + (buf ^ 1) * KV_TILE_BYTES, kr, vr, tid);
            __syncthreads();
            int alld = 1;
#pragma unroll
            for (int w = 0; w < 8; ++w) alld &= flags[buf * 8 + w];
            buf ^= 1;
            if (alld) break;
        }
        store_o(outb + (tokbase + t) * D + hh * 64, O, 1.f, h);
        __syncthreads();
    }
}

#ifndef DBG
#define DBG 0
#endif
#if DBG
DI float dbg_block_max(float v, LAS float* red) {
#pragma unroll
    for (int o = 1; o < 64; o <<= 1) v = fmaxf(v, __shfl_xor(v, o));
    __syncthreads();
    if ((threadIdx.x & 63) == 0) red[threadIdx.x >> 6] = v;
    __syncthreads();
    float r = red[0];
    for (int i = 1; i < 8; ++i) r = fmaxf(r, red[i]);
    __syncthreads();
    return r;
}
DI float dbg_block_sum(float v, LAS float* red) {
#pragma unroll
    for (int o = 1; o < 64; o <<= 1) v += __shfl_xor(v, o);
    __syncthreads();
    if ((threadIdx.x & 63) == 0) red[threadIdx.x >> 6] = v;
    __syncthreads();
    float r = 0.f;
    for (int i = 0; i < 8; ++i) r += red[i];
    __syncthreads();
    return r;
}
DI void dbg_note(unsigned* ctl, int idx, float err) { if (threadIdx.x == 0) atomicMax(ctl + CW_DBG + idx, __builtin_bit_cast(unsigned, err)); }
template <int layer>
DI void dbg_check(const Args& a, LAS unsigned char* lds, int stage, const MoeMeta& mm) {
    if (blockIdx.x >= 64) return;
    const int tid = threadIdx.x;
    const int t = blockIdx.x * 512 + (blockIdx.x * 37) % 512;
    LAS float* x1 = (LAS float*)(lds);
    LAS float* hh = x1 + 1024;
    LAS float* yy = hh + 512;
    LAS float* red = yy + 2048;
    LAS float* scl = red + 16;
    unsigned* ctl = (unsigned*)(a.ws + WS_CTL);
    float* dbgx1 = (float*)(a.ws + WS_SMALL) + blockIdx.x * 1024;
    const float* xout = a.out; const bf16_t* actb = (const bf16_t*)(a.ws + WS_ACTB);
    const u32x4 ti = *(const u32x4*)(a.ws + WS_TOKINFO + (size_t)t * 16);
    const int e0 = ti.x & 15, p0 = ti.x >> 4, e1 = ti.z & 15, p1 = ti.z >> 4;
    const float w0 = u2f(ti.y), w1 = u2f(ti.w);
    __syncthreads();
    if (tid == 0) { scl[16] = w0; scl[17] = w1; }
    __syncthreads();
    if (stage == 1) {
        const float* xin = (layer == 0) ? a.in[IN_X] : nullptr;
        if (xin) {
            float v0 = ALPHA * xin[(size_t)t * D + tid], v1 = ALPHA * xin[(size_t)t * D + tid + 512];
            const float mean = dbg_block_sum(v0 + v1, red) / D;
            const float var = dbg_block_sum((v0 - mean) * (v0 - mean) + (v1 - mean) * (v1 - mean), red) / D;
            const float rstd = 1.f / sqrtf(var + LN_EPS);
            const float* g = a.in[IN_LN1G] + layer * D; const float* b = a.in[IN_LN1B] + layer * D;
            const float r0 = (v0 - mean) * rstd * g[tid] + b[tid], r1 = (v1 - mean) * rstd * g[tid + 512] + b[tid + 512];
            float e = fmaxf(fabsf(r0 - xout[(size_t)t * D + tid]), fabsf(r1 - xout[(size_t)t * D + tid + 512]));
            dbg_note(ctl, 0, dbg_block_max(e, red));
            const float q0 = __builtin_bit_cast(float, (unsigned)actb[(size_t)t * D + tid] << 16), q1 = __builtin_bit_cast(float, (unsigned)actb[(size_t)t * D + tid + 512] << 16);
            e = fmaxf(fabsf(r0 - q0), fabsf(r1 - q1));
            dbg_note(ctl, 1, dbg_block_max(e, red));
        }
        x1[tid] = xout[(size_t)t * D + tid]; x1[tid + 512] = xout[(size_t)t * D + tid + 512];
        dbgx1[tid] = x1[tid]; dbgx1[tid + 512] = x1[tid + 512];
        __syncthreads();
        if (tid < 16) { float s = 0.f; for (int k = 0; k < D; ++k) s += x1[k] * a.in[IN_RW][k * 16 + tid]; scl[tid] = 1.f / (1.f + expf(-s)); }
        __syncthreads();
        if (tid == 0) {
            float bz[16]; for (int e = 0; e < 16; ++e) bz[e] = scl[e] + a.in[IN_RB][e];
            int bg = 0; float bgs = -1e30f;
            for (int g = 0; g < 4; ++g) { float m1 = -1e30f, m2 = -1e30f; for (int k = 0; k < 4; ++k) { const float v = bz[4 * g + k]; if (v > m1) { m2 = m1; m1 = v; } else if (v > m2) m2 = v; }
                if (m1 + m2 > bgs) { bgs = m1 + m2; bg = g; } }
            int i1 = 0; for (int k = 1; k < 4; ++k) if (bz[4 * bg + k] > bz[4 * bg + i1]) i1 = k;
            int i2 = -1; for (int k = 0; k < 4; ++k) if (k != i1 && (i2 < 0 || bz[4 * bg + k] > bz[4 * bg + i2])) i2 = k;
            const float s1 = scl[4 * bg + i1], s2 = scl[4 * bg + i2];
            float err = 0.f;
            if (e0 != 4 * bg + i1 || e1 != 4 * bg + i2) err = 1.f;
            err = fmaxf(err, fabsf(scl[16] - s1 / (s1 + s2))); err = fmaxf(err, fabsf(scl[17] - s2 / (s1 + s2)));
            if (p0 >= mm.cnt[e0] || p1 >= mm.cnt[e1]) err = 2.f;
            else { const unsigned* list = (const unsigned*)(a.ws + WS_LIST); if (list[e0 * 32768 + p0] != (unsigned)t || list[e1 * 32768 + p1] != (unsigned)t) err = 3.f; }
            atomicMax(ctl + CW_DBG + 2, __builtin_bit_cast(unsigned, err));
        }
        return;
    }
    x1[tid] = dbgx1[tid]; x1[tid + 512] = dbgx1[tid + 512];
    __syncthreads();
    const float* eg = a.in[IN_EG] + (size_t)layer * NE * D * DEXP; const float* eu = a.in[IN_EU] + (size_t)layer * NE * D * DEXP; const float* ed = a.in[IN_ED] + (size_t)layer * NE * DEXP * D;
    { const int k = tid >> 8, j = tid & 255, e = k ? e1 : e0;
      float g = 0.f, u = 0.f; for (int i = 0; i < D; ++i) { g += x1[i] * eg[((size_t)e * D + i) * DEXP + j]; u += x1[i] * eu[((size_t)e * D + i) * DEXP + j]; }
      hh[k * 256 + j] = g / (1.f + expf(-g)) * u; }
    __syncthreads();
    const size_t s0 = (size_t)mm.tstart[e0] * 256 + p0, s1 = (size_t)mm.tstart[e1] * 256 + p1;
    if (stage == 2) {
        const bf16_t* hb = (const bf16_t*)(a.ws + WS_BIG + BIG_H);
        const int k = tid >> 8, j = tid & 255; const size_t s = k ? s1 : s0;
        const float got = __builtin_bit_cast(float, (unsigned)hb[s * DEXP + j] << 16);
        const float ref = hh[tid];
        const float rms = sqrtf(dbg_block_sum(ref * ref, red) / 512.f);
        dbg_note(ctl, 3, dbg_block_max(fabsf(got - ref), red) / (rms + 1e-6f));
        return;
    }
    for (int c = tid; c < 2048; c += 512) { const int k = c >> 10, col = c & 1023, e = k ? e1 : e0; float s = 0.f;
        for (int j = 0; j < DEXP; ++j) s += hh[k * 256 + j] * ed[((size_t)e * DEXP + j) * D + col];
        yy[c] = s; }
    __syncthreads();
    if (stage == 3) {
        const bf16_t* yb = (const bf16_t*)(a.ws + WS_BIG + BIG_YB);
        float e = 0.f, sq = 0.f;
        for (int c = tid; c < 2048; c += 512) { const int k = c >> 10, col = c & 1023; const size_t s = k ? s1 : s0;
            const float got = __builtin_bit_cast(float, (unsigned)yb[s * D + col] << 16); e = fmaxf(e, fabsf(got - yy[c])); sq += yy[c] * yy[c]; }
        const float rms = sqrtf(dbg_block_sum(sq, red) / 2048.f);
        dbg_note(ctl, 4, dbg_block_max(e, red) / (rms + 1e-6f));
        return;
    }
    {
        float v0 = ALPHA * x1[tid] + w0 * yy[tid] + w1 * yy[1024 + tid], v1 = ALPHA * x1[tid + 512] + w0 * yy[tid + 512] + w1 * yy[1024 + tid + 512];
        const float mean = dbg_block_sum(v0 + v1, red) / D;
        const float var = dbg_block_sum((v0 - mean) * (v0 - mean) + (v1 - mean) * (v1 - mean), red) / D;
        const float rstd = 1.f / sqrtf(var + LN_EPS);
        const float* g = a.in[IN_LN2G] + layer * D; const float* b = a.in[IN_LN2B] + layer * D;
        const float r0 = (v0 - mean) * rstd * g[tid] + b[tid], r1 = (v1 - mean) * rstd * g[tid + 512] + b[tid + 512];
        const float e = fmaxf(fabsf(r0 - xout[(size_t)t * D + tid]), fabsf(r1 - xout[(size_t)t * D + tid + 512]));
        dbg_note(ctl, 5, dbg_block_max(e, red));
    }
}
DI void dbg_final(const Args& a) {
    unsigned* ctl = (unsigned*)(a.ws + WS_CTL);
    const float tol[6] = {1e-4f, 2e-2f, 1e-3f, 0.12f, 0.12f, 4e-2f};
    int code = 2;
    for (int i = 5; i >= 0; --i) { const float err = __builtin_bit_cast(float, xb_ld(ctl + CW_DBG + i));
        if (!(err <= tol[i])) { const int dg = !(err < 1.f) ? 9 : err >= 0.3f ? 7 : err >= 0.1f ? 5 : err >= 0.03f ? 3 : 1; code = 10 * (i + 1) + dg; } }
#ifdef PROBE
    { const float p0 = (float)xb_ld(ctl + CW_DBG + 10) / 65536.f, p1 = __builtin_bit_cast(float, xb_ld(ctl + CW_DBG + 9));
      const int d0 = p0 < 0.f ? 0 : p0 >= 1.f ? 9 : (int)(p0 * 9.99f), d1 = p1 < 0.f ? 0 : p1 >= 1.f ? 9 : (int)(p1 * 9.99f); code = 10 * d0 + d1; }
#endif
    if (xb_ld(ctl + CW_BAR + XB_TMO)) code = 95;
    const float c = sqrtf((float)code);
    for (size_t i = (size_t)blockIdx.x * NTHR + threadIdx.x; i < (size_t)T * D; i += (size_t)gridDim.x * NTHR) a.out[i] = c;
}
#endif


#ifndef PROBE_LO
#define PROBE_LO -1
#define PROBE_HI -1
#define PROBE_MULT 0
#endif
DI void probe_tick(LAS unsigned char* lds, int wv) {
    if (PROBE_LO < 0) return;
    volatile LAS unsigned* M = (volatile LAS unsigned*)(lds + MISC_OFF);
    if (tid_of(wv) == 0) { const unsigned long long now = __builtin_amdgcn_s_memrealtime(); const int k = (int)M[16];
        const unsigned long long last = (unsigned long long)M[18] | ((unsigned long long)M[19] << 32);
        if (k >= PROBE_LO && k <= PROBE_HI) { unsigned long long acc = (unsigned long long)M[20] | ((unsigned long long)M[21] << 32); acc += now - last; M[20] = (unsigned)acc; M[21] = (unsigned)(acc >> 32); }
        M[16] = (unsigned)(k + 1); M[18] = (unsigned)now; M[19] = (unsigned)(now >> 32); }
}
#define GRID_BAR() do { xcd_barrier(bar); probe_tick(lds, a.wv); } while (0)
constexpr bool HAS_MIXER[4] = {true, true, true, true};
template <int layer>
DI void run_layer(const Args& a, LAS unsigned char* lds, const XcdBarrier& bar) {
    const int wave = a.wv;
    const int G = gridDim.x, bid = blockIdx.x;
    const int gw = bid * NWAVES + wave, NGW = G * NWAVES;
    unsigned char* ws = a.ws;
    unsigned* ctl = (unsigned*)(a.ws + WS_CTL);
    bf16_t* actb = (bf16_t*)(ws + WS_ACTB);
    float* xout = a.out;
        bf16_t* bigb = (bf16_t*)(ws + WS_BIG);
        if (layer == 0) {
#pragma unroll 1
            for (int b = 0; b < BATCH; ++b) {
                { pg8::DenseSched S; S.init(actb + (size_t)b * SEQ * D, D * 2, 128, ws + WS_WIN, SEQ, 9216, D, G, bid); pg8::EpiStore E{bigb, (size_t)9216}; pg8::gemm_phase(lds + STAGE_OFF, S, E, a.wv); }
                if (b == 1) dilated_merge(a, 0);
                GRID_BAR();
                dilated_phase(a, lds);
                GRID_BAR();
            }
            dilated_merge(a, 1);
            GRID_BAR();
        }
        if (layer == 1) {
            { pg8::DenseSched S; S.init(actb, D * 2, 128, ws + WS_WIN, T, 3072, D, G, bid); pg8::EpiStore E{bigb, (size_t)3072}; pg8::gemm_phase(lds + STAGE_OFF, S, E, a.wv); }
            GRID_BAR();
            sb_phase(a, lds);
            GRID_BAR();
        }
        if (layer == 2) {
            { pg8::DenseSched S; S.init(actb, D * 2, 128, ws + WS_WIN, T, 2816, D, G, bid);
              pg8::EpiNsa E{(bf16_t*)(ws + WS_BIG + NS_Q), (bf16_t*)(ws + WS_BIG + NS_KV), (float*)(ws + WS_BIG + NS_GT)}; pg8::gemm_phase(lds + STAGE_OFF, S, E, a.wv); }
            GRID_BAR();
            { pg8::CmpSched S; S.kv6 = (const char*)(ws + WS_BIG + NS_KV); S.Bt = (const char*)(ws + WS_WCMP); S.K = 2048; S.lda = 16 * 1536 * 2; S.kstepA = 1536 * 2; S.G = G; S.c = bid;
              pg8::EpiCmp E{(bf16_t*)(ws + WS_BIG + NS_HID), (const float*)(ws + WS_WCMP + 2 * MiB + 64 * 1024)}; pg8::gemm_phase(lds + STAGE_OFF, S, E, a.wv); }
            GRID_BAR();
            nsa_kcvc_phase(a, lds);
            GRID_BAR();
            nsa_attn_phase(a, lds);
            GRID_BAR();
        }
        if (layer == 3) {
            { pg8::DenseSched S; S.init(actb, D * 2, 128, ws + WS_WIN, T, 3072, D, G, bid); pg8::EpiStore E{bigb, (size_t)3072}; pg8::gemm_phase(lds + STAGE_OFF, S, E, a.wv); }
            GRID_BAR();
            moba_kmean_phase(a, lds);
            GRID_BAR();
            moba_gate_phase(a, lds);
            GRID_BAR();
            moba_fill_phase(a, lds);
            GRID_BAR();
            moba_sel_phase(a, lds);
            GRID_BAR();
            moba_own_phase(a, lds);
            GRID_BAR();
        }
        if (HAS_MIXER[layer]) {
            { pg8::DenseSched S; S.init(actb, D * 2, 128, ws + WS_WOUT, T, D, D, G, bid); pg8::EpiStore E{(bf16_t*)(ws + WS_BIG + BIG_Y), (size_t)D}; pg8::gemm_phase(lds + STAGE_OFF, S, E, a.wv); }
            GRID_BAR();
        }
        unsigned* gcount = ctl + CW_MOE + layer * 16 * 64;
        {
            const int tid = tid_of(a.wv), lane = tid & 63;
            constexpr int RWS = 1032;
            LAS bf16_t* rwh = (LAS bf16_t*)(lds + STAGE_OFF);
            LAS bf16_t* rwl = rwh + 17 * RWS;
            LAS int* lcnt = (LAS int*)(lds + STAGE_OFF + 73728);
            LAS int* gbase = lcnt + 16;
            LAS unsigned* le = (LAS unsigned*)(lcnt + 32);
            LAS float* lg = (LAS float*)(le + 256);
            const float* rw = a.in[IN_RW];
            for (int i = tid; i < 1024 * 16; i += NTHR) { const int k = i >> 4, e = i & 15; const float v = rw[i]; const unsigned hi = f2bf(v);
                rwh[e * RWS + k] = (bf16_t)hi; rwl[e * RWS + k] = (bf16_t)f2bf(v - u2f(hi << 16)); }
            for (int i = tid; i < RWS; i += NTHR) { rwh[16 * RWS + i] = 0; rwl[16 * RWS + i] = 0; }
            if (tid < 16) lcnt[tid] = 0;
            const float* xin = (layer == 0) ? a.in[IN_X] : xout;
            const float* g1 = a.in[IN_LN1G] + layer * D; const float* b1 = a.in[IN_LN1B] + layer * D;
            RowVec gv, bv;
#pragma unroll
            for (int j = 0; j < 4; ++j) { gv.v[j] = *(const f32x4*)(g1 + 4 * lane + 256 * j); bv.v[j] = *(const f32x4*)(b1 + 4 * lane + 256 * j); }
            f32x4 px[4]; u32x2 py[4];
            { const int t0_ = bid * 128 + wave;
#pragma unroll
              for (int j = 0; j < 4; ++j) { px[j] = *(const f32x4*)(xin + (size_t)t0_ * D + 4 * lane + 256 * j);
                  py[j] = HAS_MIXER[layer] ? *(const u32x2*)((const bf16_t*)(ws + WS_BIG + BIG_Y) + (size_t)t0_ * D + 4 * lane + 256 * j) : (u32x2){0u, 0u}; } }
            for (int lt = wave; lt < 128; lt += NWAVES) {
                const int t = bid * 128 + lt;
                RowVec r;
#pragma unroll
                for (int j = 0; j < 4; ++j) { r.v[j] = px[j] * ALPHA;
                    r.v[j].x += bf_lo(py[j].x); r.v[j].y += bf_hi(py[j].x); r.v[j].z += bf_lo(py[j].y); r.v[j].w += bf_hi(py[j].y); }
                if (lt + NWAVES < 128) { const int tn = t + NWAVES;
#pragma unroll
                    for (int j = 0; j < 4; ++j) { px[j] = *(const f32x4*)(xin + (size_t)tn * D + 4 * lane + 256 * j);
                        py[j] = HAS_MIXER[layer] ? *(const u32x2*)((const bf16_t*)(ws + WS_BIG + BIG_Y) + (size_t)tn * D + 4 * lane + 256 * j) : (u32x2){0u, 0u}; } }
                float mean, rstd; ln_stats(r, mean, rstd);
#pragma unroll
                for (int j = 0; j < 4; ++j) { r.v[j] = (r.v[j] - mean) * rstd * gv.v[j] + bv.v[j];
                    *(f32x4*)(xout + (size_t)t * D + 4 * lane + 256 * j) = r.v[j];
                    const unsigned h0 = f2bf(r.v[j].x), h1 = f2bf(r.v[j].y), h2 = f2bf(r.v[j].z), h3 = f2bf(r.v[j].w);
                    u32x2 w; w.x = h0 | (h1 << 16); w.y = h2 | (h3 << 16);
                    *(u32x2*)(actb + (size_t)t * D + 4 * lane + 256 * j) = w;
                    }
            }
            asm volatile("s_waitcnt vmcnt(0)" ::: "memory");
            __syncthreads();
            if (wave < 4) {
                const int c = lane & 31, h = lane >> 5, lt = 32 * wave + c, t = bid * 128 + lt;
                const float* xf = xout + (size_t)t * D + 8 * h;
                const int wr_ = c < 16 ? c : 16;
                const LAS bf16_t* ah = rwh + wr_ * RWS + 8 * h; const LAS bf16_t* al = rwl + wr_ * RWS + 8 * h;
                f32x16 acc = zero16();
#pragma unroll 4
                for (int ks = 0; ks < 64; ++ks) {
                    const f32x4 x0 = *(const f32x4*)(xf + 16 * ks), x1 = *(const f32x4*)(xf + 16 * ks + 4);
                    const unsigned q0 = f2bf(x0.x), q1 = f2bf(x0.y), q2 = f2bf(x0.z), q3 = f2bf(x0.w), q4 = f2bf(x1.x), q5 = f2bf(x1.y), q6 = f2bf(x1.z), q7 = f2bf(x1.w);
                    u32x4 ph, pl; ph.x = q0 | (q1 << 16); ph.y = q2 | (q3 << 16); ph.z = q4 | (q5 << 16); ph.w = q6 | (q7 << 16);
                    pl.x = pk2(x0.x - u2f(q0 << 16), x0.y - u2f(q1 << 16)); pl.y = pk2(x0.z - u2f(q2 << 16), x0.w - u2f(q3 << 16));
                    pl.z = pk2(x1.x - u2f(q4 << 16), x1.y - u2f(q5 << 16)); pl.w = pk2(x1.z - u2f(q6 << 16), x1.w - u2f(q7 << 16));
                    const bf16x8 bh = __builtin_bit_cast(bf16x8, ph), bl = __builtin_bit_cast(bf16x8, pl);
                    const bf16x8 wh = *(const LAS bf16x8*)(ah + 16 * ks), wl = *(const LAS bf16x8*)(al + 16 * ks);
                    acc = mfma32(wh, bh, acc); acc = mfma32(wh, bl, acc); acc = mfma32(wl, bh, acc);
                }
                float sc[2][4], bz[2][4];
#pragma unroll
                for (int q = 0; q < 2; ++q)
#pragma unroll
                    for (int k = 0; k < 4; ++k) { sc[q][k] = 1.f / (1.f + __expf(-acc[4 * q + k])); bz[q][k] = sc[q][k] + a.in[IN_RB][8 * q + 4 * h + k]; }
                float gs[2]; int i1[2], i2[2];
#pragma unroll
                for (int q = 0; q < 2; ++q) {
                    float m1 = bz[q][0]; int j1 = 0;
#pragma unroll
                    for (int k = 1; k < 4; ++k) if (bz[q][k] > m1) { m1 = bz[q][k]; j1 = k; }
                    float m2 = -1e30f; int j2 = -1;
#pragma unroll
                    for (int k = 0; k < 4; ++k) if (k != j1 && bz[q][k] > m2) { m2 = bz[q][k]; j2 = k; }
                    gs[q] = m1 + m2; i1[q] = j1; i2[q] = j2; }
                const float o0 = __shfl_xor(gs[0], 32), o1 = __shfl_xor(gs[1], 32);
                const float G0 = h ? o0 : gs[0], G1 = h ? gs[0] : o0, G2 = h ? o1 : gs[1], G3 = h ? gs[1] : o1;
                int bg = 0; float bgs = G0;
                if (G1 > bgs) { bgs = G1; bg = 1; }
                if (G2 > bgs) { bgs = G2; bg = 2; }
                if (G3 > bgs) { bgs = G3; bg = 3; }
                if ((bg & 1) == h) {
                    const int q = bg >> 1;
                    const int j1 = q ? i1[1] : i1[0], j2 = q ? i2[1] : i2[0];
                    float sg1 = 0.f, sg2 = 0.f;
#pragma unroll
                    for (int k = 0; k < 4; ++k) { const float sv = q ? sc[1][k] : sc[0][k]; sg1 = (k == j1) ? sv : sg1; sg2 = (k == j2) ? sv : sg2; }
                    const float inv = 1.f / (sg1 + sg2);
                    const int e0 = bg * 4 + j1, e1 = bg * 4 + j2;
                    const int p0 = atomicAdd((int*)(lcnt + e0), 1), p1 = atomicAdd((int*)(lcnt + e1), 1);
                    le[lt * 2] = (unsigned)e0 | ((unsigned)p0 << 8); le[lt * 2 + 1] = (unsigned)e1 | ((unsigned)p1 << 8);
                    lg[lt * 2] = sg1 * inv; lg[lt * 2 + 1] = sg2 * inv;
                }
            }
            __syncthreads();
            if (tid < 16) gbase[tid] = (int)xb_add(gcount + tid * 64, (unsigned)lcnt[tid]);
            __syncthreads();
            if (tid < 256) {
                const int lt = tid >> 1, t = bid * 128 + lt;
                if (t < T) {
                    const unsigned w = le[tid]; const int e = w & 255, pos = gbase[e] + (int)(w >> 8);
                    ((unsigned*)(ws + WS_LIST))[e * 32768 + pos] = (unsigned)t;
                    u32x2 ti; ti.x = (unsigned)e | ((unsigned)pos << 4); ti.y = __builtin_bit_cast(unsigned, lg[tid]);
                    *(u32x2*)(ws + WS_TOKINFO + (size_t)(t * 2 + (tid & 1)) * 8) = ti;
                }
            }
        }
        GRID_BAR();

        MoeMeta mm; mm.tstart = (LAS int*)(lds + MISC_OFF + 256); mm.cnt = mm.tstart + 32;
        if (tid_of(a.wv) == 0) { int acc = 0;
            for (int e = 0; e < 16; ++e) { const int c = (int)xb_ld(gcount + e * 64); mm.cnt[e] = c; mm.tstart[e] = acc; acc += (c + 255) >> 8; }
            mm.tstart[16] = acc; }
        __syncthreads();
        const int ntiles = mm.tstart[16];
#if DBG
        if (layer == DBG_LAYER) { dbg_check<layer>(a, lds, 1, mm); __syncthreads(); }
#endif
        {
            Moe1Sched S; S.A = (const char*)actb; S.Bt = (const char*)(ws + WS_WEXP1); S.K = D; S.lda = D * 2; S.kstepA = 128; S.mm = mm; S.ntiles = ntiles; S.G = G; S.c = bid;
            S.tab = (LAS unsigned*)(lds + AUX_OFF);
            const int tid = tid_of(a.wv);
            pg8::Unit u;
            for (int i = 0; i < 8 && S.next(i, u); ++i) {
                if (tid < 256) { const int pos = (u.pm - mm.tstart[u.e]) * 256 + tid;
                    const unsigned tok = (pos < mm.cnt[u.e]) ? ((const unsigned*)(ws + WS_LIST))[u.e * 32768 + pos] : 0u;
                    S.tab[i * 256 + tid] = tok * (unsigned)(D * 2); }
            }
            __syncthreads();
            pg8::EpiSwiglu E{(bf16_t*)(ws + WS_BIG + BIG_H)};
            pg8::gemm_phase(lds + STAGE_OFF, S, E, a.wv);
        }
        GRID_BAR();
#if DBG
        if (layer == DBG_LAYER) { dbg_check<layer>(a, lds, 2, mm); __syncthreads(); }
#endif
        {
            Moe2Sched S; S.A = (const char*)(ws + WS_BIG + BIG_H); S.Bt = (const char*)(ws + WS_WEXP2); S.K = DEXP; S.lda = DEXP * 2; S.kstepA = 128; S.mm = mm; S.ntiles = ntiles; S.G = G; S.c = bid;
            pg8::EpiStore E{(bf16_t*)(ws + WS_BIG + BIG_YB), (size_t)D};
            pg8::gemm_phase(lds + STAGE_OFF, S, E, a.wv);
        }
        GRID_BAR();
#if DBG
        if (layer == DBG_LAYER) { dbg_check<layer>(a, lds, 3, mm); __syncthreads(); }
#endif
        {
            const int tid = tid_of(a.wv), lane = tid & 63;
            const float* g2 = a.in[IN_LN2G] + layer * D; const float* b2 = a.in[IN_LN2B] + layer * D;
            RowVec gv, bv;
#pragma unroll
            for (int j = 0; j < 4; ++j) { gv.v[j] = *(const f32x4*)(g2 + 4 * lane + 256 * j); bv.v[j] = *(const f32x4*)(b2 + 4 * lane + 256 * j); }
            const bf16_t* yb = (const bf16_t*)(ws + WS_BIG + BIG_YB);
            u32x4 tiA = *(const u32x4*)(ws + WS_TOKINFO + (size_t)gw * 16);
            u32x4 tiB = (gw + NGW < T) ? *(const u32x4*)(ws + WS_TOKINFO + (size_t)(gw + NGW) * 16) : tiA;
            f32x4 px[4]; u32x2 py0[4], py1[4]; float cw0, cw1;
            { const int e0 = tiA.x & 15, p0 = tiA.x >> 4, e1 = tiA.z & 15, p1 = tiA.z >> 4; cw0 = u2f(tiA.y); cw1 = u2f(tiA.w);
              const size_t s0 = (size_t)mm.tstart[e0] * 256 + p0, s1 = (size_t)mm.tstart[e1] * 256 + p1;
#pragma unroll
              for (int j = 0; j < 4; ++j) { px[j] = *(const f32x4*)(xout + (size_t)gw * D + 4 * lane + 256 * j);
                  py0[j] = *(const u32x2*)(yb + s0 * D + 4 * lane + 256 * j); py1[j] = *(const u32x2*)(yb + s1 * D + 4 * lane + 256 * j); } }
            for (int t = gw; t < T; t += NGW) {
                const float w0 = cw0, w1 = cw1;
                RowVec r;
#pragma unroll
                for (int j = 0; j < 4; ++j) {
                    const f32x4 xv = px[j]; const u32x2 y0 = py0[j], y1 = py1[j];
                    r.v[j].x = ALPHA * xv.x + w0 * bf_lo(y0.x) + w1 * bf_lo(y1.x);
                    r.v[j].y = ALPHA * xv.y + w0 * bf_hi(y0.x) + w1 * bf_hi(y1.x);
                    r.v[j].z = ALPHA * xv.z + w0 * bf_lo(y0.y) + w1 * bf_lo(y1.y);
                    r.v[j].w = ALPHA * xv.w + w0 * bf_hi(y0.y) + w1 * bf_hi(y1.y);
                }
                if (t + NGW < T) { const int tn = t + NGW; const u32x4 ti = tiB;
                    const int e0 = ti.x & 15, p0 = ti.x >> 4, e1 = ti.z & 15, p1 = ti.z >> 4; cw0 = u2f(ti.y); cw1 = u2f(ti.w);
                    const size_t s0 = (size_t)mm.tstart[e0] * 256 + p0, s1 = (size_t)mm.tstart[e1] * 256 + p1;
#pragma unroll
                    for (int j = 0; j < 4; ++j) { px[j] = *(const f32x4*)(xout + (size_t)tn * D + 4 * lane + 256 * j);
                        py0[j] = *(const u32x2*)(yb + s0 * D + 4 * lane + 256 * j); py1[j] = *(const u32x2*)(yb + s1 * D + 4 * lane + 256 * j); }
                    if (tn + NGW < T) tiB = *(const u32x4*)(ws + WS_TOKINFO + (size_t)(tn + NGW) * 16); }
                float mean, rstd; ln_stats(r, mean, rstd);
#pragma unroll
                for (int j = 0; j < 4; ++j) { r.v[j] = (r.v[j] - mean) * rstd * gv.v[j] + bv.v[j];
                    *(f32x4*)(xout + (size_t)t * D + 4 * lane + 256 * j) = r.v[j];
                    u32x2 w; w.x = pk2(r.v[j].x, r.v[j].y); w.y = pk2(r.v[j].z, r.v[j].w);
                    *(u32x2*)(actb + (size_t)t * D + 4 * lane + 256 * j) = w; }
            }
            if (layer + 1 < DEPTH) convert_layer_weights(a, layer + 1, lds, gw, NGW, wave, lane);
        }
        GRID_BAR();
#if DBG
        if (layer == DBG_LAYER) { dbg_check<layer>(a, lds, 4, mm); GRID_BAR(); }
#endif
}

__global__ void __launch_bounds__(NTHR, 2) fwd(Args a_in) {
    Args a = a_in; a.wv = __builtin_amdgcn_readfirstlane((int)(threadIdx.x >> 6));
    extern __shared__ __attribute__((aligned(16))) unsigned char lds_raw[];
    LAS unsigned char* lds = (LAS unsigned char*)lds_raw;
    volatile LAS unsigned* MISC = (volatile LAS unsigned*)(lds + MISC_OFF);
    const int tid = tid_of(a.wv), lane = tid & 63, wave = a.wv;
    const int G = gridDim.x, bid = blockIdx.x;
    const int gw = bid * NWAVES + wave, NGW = G * NWAVES;
    if (tid < 256) MISC[tid] = 0u;
    __syncthreads();
    unsigned* ctl = (unsigned*)(a.ws + WS_CTL);
    XcdBarrier bar = xcd_barrier_post(ctl + CW_BAR, MISC + 8); bar.wv = a.wv;
    if (PROBE_LO >= 0 && tid == 0) { const unsigned long long now = __builtin_amdgcn_s_memrealtime(); MISC[18] = (unsigned)now; MISC[19] = (unsigned)(now >> 32); }
    unsigned char* ws = a.ws;
    bf16_t* actb = (bf16_t*)(ws + WS_ACTB);
    float* xout = a.out;

    convert_layer_weights(a, 0, lds, gw, NGW, wave, lane);
    for (int i = bid * NTHR + tid; i < 16 * 2048; i += G * NTHR) { const int hd = i >> 11, n = i & 2047;
        int bk = n; if (n >= 16) { const float lf = logf((float)n / 16.f) / 4.852030263919617f; bk = 16 + (int)(lf * 16.f); bk = bk > 31 ? 31 : bk; }
        ((float*)(a.ws + WS_BIASG))[i] = a.in[IN_REL][bk * 16 + hd] * LOG2E; }
    { const float* x = a.in[IN_X];
      for (size_t i = ((size_t)bid * NTHR + tid) * 8; i < (size_t)T * D; i += (size_t)G * NTHR * 8) {
          const f32x4 v0 = *(const f32x4*)(x + i), v1 = *(const f32x4*)(x + i + 4);
          u32x4 w; w.x = pk2(v0.x, v0.y); w.y = pk2(v0.z, v0.w); w.z = pk2(v1.x, v1.y); w.w = pk2(v1.z, v1.w);
          *(u32x4*)(actb + i) = w; } }
    GRID_BAR();

    run_layer<0>(a, lds, bar);
#if DBG
    if (DBG_LAYER >= 1) run_layer<1>(a, lds, bar);
    if (DBG_LAYER >= 2) run_layer<2>(a, lds, bar);
    if (DBG_LAYER >= 3) run_layer<3>(a, lds, bar);
    dbg_final(a);
#else
    run_layer<1>(a, lds, bar);
    run_layer<2>(a, lds, bar);
    run_layer<3>(a, lds, bar);
#endif
    if (PROBE_LO >= 0) { __syncthreads(); const unsigned long long acc = (unsigned long long)MISC[20] | ((unsigned long long)MISC[21] << 32); const unsigned long long t0 = __builtin_amdgcn_s_memrealtime();
        while (__builtin_amdgcn_s_memrealtime() - t0 < acc * (unsigned long long)PROBE_MULT) __builtin_amdgcn_s_sleep(8); }
}

extern "C" void kernel_launch(void* const* d_in, const int* in_sizes, int n_in, void* d_out, int out_size, void* d_ws, size_t ws_size, hipStream_t stream) {
    static int grid = 0;
    if (grid == 0) {
        int dev = 0, cus = 0;
        if (n_in != 25 || out_size != T * D || ws_size < WS_END) { fprintf(stderr, "kernel_launch: unexpected shapes (n_in %d out %d ws %zu)\n", n_in, out_size, ws_size); grid = -1; return; }
        if (hipGetDevice(&dev) != hipSuccess || hipDeviceGetAttribute(&cus, hipDeviceAttributeMultiprocessorCount, dev) != hipSuccess) { grid = -1; return; }
        if (hipFuncSetAttribute((const void*)fwd, hipFuncAttributeMaxDynamicSharedMemorySize, LDS_BYTES) != hipSuccess) { grid = -1; return; }
        (void)hipGetLastError();
        grid = cus;
        if (grid != 256) { fprintf(stderr, "kernel_launch: built for 256 CUs, got %d\n", grid); grid = -1; return; }
    }
    if (grid < 0) return;
    (void)hipMemsetAsync(d_ws, 0, 1u << 20, stream);
    Args a{};
    for (int i = 0; i < 25; ++i) a.in[i] = (const float*)d_in[i];
    a.out = (float*)d_out; a.ws = (unsigned char*)d_ws;
    hipLaunchKernelGGL(fwd, dim3(grid), dim3(NTHR), LDS_BYTES, stream, a);
}
```

```cpp
#include <hip/hip_runtime.h>
#include <cstdio>
#include <cstdint>
#define DBG 0
#define DBG_LAYER 0

#define LAS __attribute__((address_space(3)))
#define GAS __attribute__((address_space(1)))
#define DI __device__ __forceinline__
typedef unsigned short bf16_t;
typedef short bf16x8 __attribute__((ext_vector_type(8)));
typedef short s16x4 __attribute__((ext_vector_type(4)));
typedef float f32x2 __attribute__((ext_vector_type(2)));
typedef float f32x4 __attribute__((ext_vector_type(4)));
typedef float f32x16 __attribute__((ext_vector_type(16)));
typedef unsigned u32x2 __attribute__((ext_vector_type(2)));
typedef unsigned u32x4 __attribute__((ext_vector_type(4)));

constexpr int BATCH = 2, SEQ = 16384, D = 1024, T = BATCH * SEQ, DEPTH = 4, NH = 16, HD = 64;
constexpr int NE = 16, DEXP = 256;
constexpr float ALPHA = 1.681792830507429f;
constexpr float LN_EPS = 1e-5f;
constexpr int NWAVES = 8, NTHR = 512;

constexpr size_t MiB = 1u << 20;
constexpr size_t WS_CTL = 0;
constexpr size_t WS_TOKINFO = 1 * MiB;
constexpr size_t WS_SMALL = 1 * MiB + 512 * 1024;
constexpr size_t WS_LIST = 2 * MiB;
constexpr size_t WS_WIN = 4 * MiB;
constexpr size_t WS_WOUT = 22 * MiB;
constexpr size_t WS_WEXP1 = 24 * MiB;
constexpr size_t WS_WEXP2 = 40 * MiB;
constexpr size_t WS_WCMP = 48 * MiB;
constexpr size_t WS_ACTB = 52 * MiB;
constexpr size_t WS_BIG = 116 * MiB;
constexpr size_t WS_END = 512 * MiB;
constexpr size_t BIG_Y = 0;
constexpr size_t BIG_H = 64 * MiB;
constexpr size_t BIG_YB = 100 * MiB;
constexpr size_t BIG_XLO = 240 * MiB;
constexpr int PROWS = 2 * T + NE * 256;

constexpr int CW_BAR = 4096;
constexpr int CW_DBG = 8;
constexpr int CW_MOE = 16384;

constexpr int LDS_BYTES = 160 * 1024;
constexpr int STAGE_OFF = 0;
constexpr int AUX_OFF = 128 * 1024;
constexpr int MISC_OFF = LDS_BYTES - 1024;

DI unsigned f2bf(float f) { unsigned u = __builtin_bit_cast(unsigned, f); return (u + 0x7fffu + ((u >> 16) & 1u)) >> 16; }
DI unsigned pk2(float lo, float hi) { return f2bf(lo) | (f2bf(hi) << 16); }
typedef __bf16 bf16x2_t __attribute__((ext_vector_type(2)));
DI unsigned cvt_pk_bf16(float lo, float hi) { const bf16x2_t r = __builtin_convertvector((f32x2){lo, hi}, bf16x2_t); return __builtin_bit_cast(unsigned, r); }
DI float u2f(unsigned u) { return __builtin_bit_cast(float, u); }
DI unsigned f2u(float f) { return __builtin_bit_cast(unsigned, f); }
DI float bf_lo(unsigned w) { return __builtin_bit_cast(float, w << 16); }
DI float bf_hi(unsigned w) { return __builtin_bit_cast(float, w & 0xffff0000u); }
DI float wave_sum(float v) {
#pragma unroll
    for (int o = 1; o < 64; o <<= 1) v += __shfl_xor(v, o);
    return v;
}
DI int tid_of(int wv) { int l; asm volatile("v_mbcnt_lo_u32_b32 %0, -1, 0\n\tv_mbcnt_hi_u32_b32 %0, -1, %0" : "=v"(l)); return (wv << 6) | l; }
DI float xor32h(float v, int h) { const unsigned u = __builtin_bit_cast(unsigned, v); const u32x2 s = __builtin_amdgcn_permlane32_swap(u, u, false, false);
    return __builtin_bit_cast(float, h ? s.x : s.y); }
DI float quad_xor1(float v) { return __builtin_bit_cast(float, __builtin_amdgcn_update_dpp(0, __builtin_bit_cast(int, v), 0xB1, 0xf, 0xf, false)); }
DI float quad_xor2(float v) { return __builtin_bit_cast(float, __builtin_amdgcn_update_dpp(0, __builtin_bit_cast(int, v), 0x4E, 0xf, 0xf, false)); }
#define LDS_WAIT() asm volatile("s_waitcnt lgkmcnt(0)" ::: "memory")
#define VM_WAIT() asm volatile("s_waitcnt vmcnt(0)" ::: "memory")

#define XB_TMO      128
#define XB_XCNT(j)  (256  + 64 * (j))
#define XB_XSUB(j)  (1280 + 64 * (j))
#define XB_XGEN(j)  (2304 + 64 * (j))
#define XB_TOP      3328
#define XB_TOPGEN   3392
#define XCD_BAR_WORDS 3456
#define XB_SPIN_CAP (1u << 22)
DI unsigned xb_ld(unsigned* p)              { return __hip_atomic_load(p, __ATOMIC_RELAXED, __HIP_MEMORY_SCOPE_AGENT); }
DI unsigned xb_add(unsigned* p, unsigned v) { return __hip_atomic_fetch_add(p, v, __ATOMIC_RELAXED, __HIP_MEMORY_SCOPE_AGENT); }
DI unsigned xb_xcc_id() { return (unsigned)__builtin_amdgcn_s_getreg((3 << 11) | 20) & 0xFu; }
#define XB_SPIN(cond, bar) do { unsigned _sp = 0; while (cond) { __builtin_amdgcn_s_sleep(1); \
    if ((++_sp & 255u) == 0u) { if (xb_ld(&(bar)[XB_TMO])) break; if (_sp > XB_SPIN_CAP) { atomicAdd(&(bar)[XB_TMO], 1u); break; } } } } while (0)
struct XcdBarrier { unsigned* bar; unsigned x; volatile LAS unsigned* st; int wv; };
DI XcdBarrier xcd_barrier_post(unsigned* bar, volatile LAS unsigned* st) {
    XcdBarrier b; b.bar = bar; b.x = xb_xcc_id(); b.st = st;
    if (threadIdx.x == 0) (void)xb_add(&bar[XB_XCNT(b.x)], 1u);
    return b;
}
DI void xcd_barrier_complete(unsigned* bar, unsigned x, unsigned& nloc, unsigned& nx) {
    const unsigned G = gridDim.x * gridDim.y * gridDim.z;
    unsigned sum, cnt, mine, sp = 0u;
    for (;;) {
        sum = 0u; cnt = 0u; mine = 0u;
#pragma unroll
        for (unsigned j = 0; j < 16; ++j) { const unsigned c = xb_ld(&bar[XB_XCNT(j)]); sum += c; cnt += (c > 0u) ? 1u : 0u; mine = (j == x) ? c : mine; }
        if (sum == G) break;
        __builtin_amdgcn_s_sleep(1);
        if ((++sp & 255u) == 0u) { if (xb_ld(&bar[XB_TMO])) break; if (sp > XB_SPIN_CAP) { atomicAdd(&bar[XB_TMO], 1u); break; } }
    }
    nloc = mine > 0u ? mine : 1u; nx = cnt > 0u ? cnt : 1u;
}
DI void xcd_barrier(const XcdBarrier& b) {
    asm volatile("s_waitcnt vmcnt(0)" ::: "memory");
    __syncthreads();
    if (tid_of(b.wv) == 0) {
        unsigned* bar = b.bar;
        const unsigned bx = xb_xcc_id();
        __builtin_amdgcn_s_waitcnt(0);
        unsigned nloc = b.st[0], nx = b.st[1];
        if (nloc == 0u) { xcd_barrier_complete(bar, bx, nloc, nx); b.st[0] = nloc; b.st[1] = nx; }
        const unsigned old = xb_add(&bar[XB_XSUB(bx)], 1u);
        const unsigned gen = old / nloc;
        if (old + 1u == (gen + 1u) * nloc) {
            __builtin_amdgcn_fence(__ATOMIC_RELEASE, "agent");
            asm volatile("s_waitcnt vmcnt(0)" ::: "memory");
            const unsigned og = xb_add(&bar[XB_TOP], 1u);
            const unsigned tg = og / nx;
            if (og + 1u == (tg + 1u) * nx) xb_add(&bar[XB_TOPGEN], 1u);
            else XB_SPIN(xb_ld(&bar[XB_TOPGEN]) == tg, bar);
            __builtin_amdgcn_fence(__ATOMIC_ACQUIRE, "agent");
            xb_add(&bar[XB_XGEN(bx)], 1u);
            asm volatile("s_waitcnt vmcnt(0)" ::: "memory");
        } else {
            XB_SPIN(xb_ld(&bar[XB_XGEN(bx)]) == gen, bar);
            __builtin_amdgcn_fence(__ATOMIC_ACQUIRE, "agent");
            asm volatile("s_waitcnt vmcnt(0)" ::: "memory");
        }
    }
    __syncthreads();
}

namespace pg8 {
constexpr int BM = 256, BK = 64, HALF = 128, HTB = HALF * BK * 2, STAGE_BYTES = 8 * HTB, NXCD = 8, WGM = 8;
__host__ __device__ __forceinline__ int lds_byte(int r, int c) { const int st = (r >> 4) * 2 + (c >> 5), rr = r & 15, cc = c & 31, ob = rr * 64 + cc * 2; return st * 1024 + (ob ^ (((ob >> 9) & 1) << 5)); }
__host__ __device__ __forceinline__ void stage_rc(int b, int& R, int& C) { const int st = b / 1024, sb = b % 1024, swz = sb ^ (((sb >> 9) & 1) << 5); R = (st >> 1) * 16 + swz / 64; C = (st & 1) * 32 + (swz % 64) / 2; }
__host__ __device__ __forceinline__ int perm32(int rho) { const int n = rho >> 4, i = rho & 15; return 8 * (i >> 2) + 4 * n + (i & 3); }

struct Unit { int pm, pn, e; };

struct TileOrder {
    int nM, nN, nwg, G, c;
    DI void init(int nM_, int nN_, int G_, int c_) { nM = nM_; nN = nN_; nwg = nM * nN; G = G_; c = c_; }
    DI bool next(int i, int& pm, int& pn) const {
        const long L = (long)i * G + c; if (L >= nwg) return false;
        int wgid = (int)L; { const int q = nwg / NXCD, r = nwg % NXCD, xcd = wgid % NXCD, off = wgid / NXCD; wgid = (xcd < r ? xcd * (q + 1) : r * (q + 1) + (xcd - r) * q) + off; }
        const int nig = WGM * nN, gid = wgid / nig, fm = gid * WGM, gsz = (nM - fm) < WGM ? (nM - fm) : WGM;
        pm = fm + ((wgid % nig) % gsz); pn = (wgid % nig) / gsz; return true;
    }
};
struct DenseSched {
    static constexpr bool GATHER = false;
    const char* A; const char* Bt; int K; unsigned lda, kstepA; TileOrder ord;
    DI void init(const void* A_, unsigned lda_, unsigned kstepA_, const void* Bt_, int M, int N, int K_, int G, int c) { A = (const char*)A_; Bt = (const char*)Bt_; K = K_; lda = lda_; kstepA = kstepA_; ord.init(M / BM, N / BM, G, c); }
    DI bool next(int i, Unit& u) const { u.e = 0; return ord.next(i, u.pm, u.pn); }
    DI const char* a_base(const Unit& u) const { return A + (size_t)u.pm * BM * lda; }
    DI const char* b_base(const Unit& u) const { return Bt + (size_t)u.pn * BM * K * 2; }
    DI unsigned row_off(int, int) const { return 0u; }
};

template <class Epi, class Sched>
DI void gemm_phase(LAS unsigned char* lds, const Sched& S, const Epi& E, int wv) {
    int tid = tid_of(wv); asm volatile("" : "+v"(tid));
    const int wid = __builtin_amdgcn_readfirstlane(tid >> 6), lane = tid & 63, wr = wid >> 2, wc = wid & 3, fr = lane & 15, fq = lane >> 4;
    const int K = S.K, nt = K / BK;
    unsigned voffB[2]; int Rr[2]; unsigned Cb[2];
#pragma unroll
    for (int i = 0; i < 2; ++i) { int R, C; stage_rc(tid * 16 + i * 8192, R, C); const int Rb = (R & ~31) + perm32(R & 31);
        voffB[i] = (unsigned)(Rb * K + C) * 2u; Rr[i] = R; Cb[i] = (unsigned)C * 2u; }
    const unsigned kstepA = S.kstepA, kstepB = (unsigned)(BK * 2);
    const size_t hstepB = (size_t)HALF * K * 2;
    const unsigned ldsw = (unsigned)wid * 1024u;
    const int aoff = lds_byte(wr * 64 + fr, fq * 8), boff = lds_byte(wc * 32 + fr, fq * 8);
#define PG8_SA(b, h) (((b) * 2 + (h)) * HTB)
#define PG8_SB(b, h) ((4 + (b) * 2 + (h)) * HTB)
#define PG8_STAGE_A(bufoff, basep, vv, h, koff) do { _Pragma("unroll") for (int _i = 0; _i < 2; ++_i) \
        __builtin_amdgcn_global_load_lds((const unsigned*)((basep) + (vv)[h][_i] + (koff)), (LAS unsigned*)(lds + (bufoff) + ldsw + _i * 8192), 16, 0, 0); } while (0)
#define PG8_STAGE_B(bufoff, ptr) do { _Pragma("unroll") for (int _i = 0; _i < 2; ++_i) \
        __builtin_amdgcn_global_load_lds((const unsigned*)((ptr) + voffB[_i]), (LAS unsigned*)(lds + (bufoff) + ldsw + _i * 8192), 16, 0, 0); } while (0)
#define PG8_LDA(dst, b, h) do { _Pragma("unroll") for (int m = 0; m < 4; ++m) _Pragma("unroll") for (int k = 0; k < 2; ++k) dst[m][k] = *(const LAS bf16x8*)(lds + PG8_SA(b, h) + aoff + m * 2048 + k * 1024); } while (0)
#define PG8_LDB(dst, b, h) do { _Pragma("unroll") for (int n = 0; n < 2; ++n) _Pragma("unroll") for (int k = 0; k < 2; ++k) dst[n][k] = *(const LAS bf16x8*)(lds + PG8_SB(b, h) + boff + n * 2048 + k * 1024); } while (0)
#define PG8_MMA(ai, bj, At, Bt) do { __builtin_amdgcn_s_setprio(1); _Pragma("unroll") for (int m = 0; m < 4; ++m) _Pragma("unroll") for (int n = 0; n < 2; ++n) _Pragma("unroll") for (int k = 0; k < 2; ++k) \
        acc[ai][bj][m][n] = __builtin_amdgcn_mfma_f32_16x16x32_bf16(Bt[n][k], At[m][k], acc[ai][bj][m][n], 0, 0, 0); __builtin_amdgcn_s_setprio(0); } while (0)
#define PG8_WAIT_V(n) asm volatile("s_waitcnt vmcnt(" #n ")" ::: "memory")
#define PG8_WAIT_L(n) asm volatile("s_waitcnt lgkmcnt(" #n ")" ::: "memory")
#define PG8_BAR __builtin_amdgcn_s_barrier()
#define PG8_SCHED __builtin_amdgcn_sched_barrier(0)
    Unit cur, nxt; int ui = 0;
    if (!S.next(0, cur)) return;
    unsigned vA[2][2], vN[2][2];
#pragma unroll
    for (int h = 0; h < 2; ++h)
#pragma unroll
        for (int i = 0; i < 2; ++i) { vA[h][i] = (Sched::GATHER ? S.row_off(0, h * HALF + Rr[i]) : (unsigned)(h * HALF + Rr[i]) * S.lda) + Cb[i]; vN[h][i] = vA[h][i]; }
    f32x4 acc[2][2][4][2];
#pragma unroll
    for (int a = 0; a < 2; ++a)
#pragma unroll
        for (int b = 0; b < 2; ++b)
#pragma unroll
            for (int m = 0; m < 4; ++m)
#pragma unroll
                for (int n = 0; n < 2; ++n) acc[a][b][m][n] = (f32x4){0.f, 0.f, 0.f, 0.f};
    bf16x8 At[4][2], B0[2][2], B1[2][2];
    const char* cA = S.a_base(cur); const char* cB = S.b_base(cur);
    PG8_STAGE_B(PG8_SB(0, 0), cB); PG8_STAGE_A(PG8_SA(0, 0), cA, vA, 0, 0u); PG8_STAGE_B(PG8_SB(0, 1), cB + hstepB); PG8_STAGE_A(PG8_SA(0, 1), cA, vA, 1, 0u);
    if (wr == 1) PG8_BAR;
    PG8_WAIT_V(4); PG8_BAR;
    PG8_STAGE_B(PG8_SB(1, 0), cB + kstepB); PG8_STAGE_A(PG8_SA(1, 0), cA, vA, 0, kstepA); PG8_STAGE_B(PG8_SB(1, 1), cB + hstepB + kstepB);
    PG8_WAIT_V(6); PG8_BAR;
    for (;;) {
        const bool has_next = S.next(ui + 1, nxt);
        const char* nA = has_next ? S.a_base(nxt) : cA; const char* nB = has_next ? S.b_base(nxt) : cB;
        if (Sched::GATHER) {
#pragma unroll
            for (int h = 0; h < 2; ++h)
#pragma unroll
                for (int i = 0; i < 2; ++i) vN[h][i] = has_next ? (S.row_off(ui + 1, h * HALF + Rr[i]) + Cb[i]) : vA[h][i];
        }
        for (int t = 0; t < nt; t += 2) {
            const bool last = (t == nt - 2);
            const unsigned k1 = (unsigned)(t + 1) * kstepA;
            const char* a2p = last ? nA : cA; const unsigned k2 = last ? 0u : (unsigned)(t + 2) * kstepA;
            unsigned v2[2][2];
#pragma unroll
            for (int h = 0; h < 2; ++h)
#pragma unroll
                for (int i = 0; i < 2; ++i) v2[h][i] = (Sched::GATHER && last) ? vN[h][i] : vA[h][i];
            const char* b2 = last ? nB : cB + (size_t)(t + 2) * kstepB; const char* b3 = b2 + kstepB;
            PG8_LDB(B0, 0, 0); PG8_SCHED; PG8_LDA(At, 0, 0); PG8_STAGE_A(PG8_SA(1, 1), cA, vA, 1, k1);
            PG8_WAIT_L(8); PG8_BAR; PG8_WAIT_L(0); PG8_MMA(0, 0, At, B0); PG8_BAR; PG8_SCHED;
            PG8_LDB(B1, 0, 1); PG8_STAGE_B(PG8_SB(0, 0), b2);
            PG8_BAR; PG8_WAIT_L(0); PG8_MMA(0, 1, At, B1); PG8_BAR;
            PG8_LDA(At, 0, 1); PG8_STAGE_A(PG8_SA(0, 0), a2p, v2, 0, k2);
            PG8_BAR; PG8_WAIT_L(0); PG8_MMA(1, 0, At, B0); PG8_BAR; PG8_SCHED;
            PG8_STAGE_B(PG8_SB(0, 1), b2 + hstepB);
            PG8_WAIT_V(6); PG8_BAR; PG8_MMA(1, 1, At, B1); PG8_BAR;
            PG8_LDB(B0, 1, 0); PG8_SCHED; PG8_LDA(At, 1, 0); PG8_STAGE_A(PG8_SA(0, 1), a2p, v2, 1, k2);
            PG8_WAIT_L(8); PG8_BAR; PG8_WAIT_L(0); PG8_MMA(0, 0, At, B0); PG8_BAR; PG8_SCHED;
            PG8_LDB(B1, 1, 1); PG8_STAGE_B(PG8_SB(1, 0), b3);
            PG8_BAR; PG8_WAIT_L(0); PG8_MMA(0, 1, At, B1); PG8_BAR;
            PG8_LDA(At, 1, 1); PG8_STAGE_A(PG8_SA(1, 0), a2p, v2, 0, k2 + kstepA);
            PG8_BAR; PG8_WAIT_L(0); PG8_MMA(1, 0, At, B0); PG8_BAR; PG8_SCHED;
            PG8_STAGE_B(PG8_SB(1, 1), b3 + hstepB);
            PG8_WAIT_V(6); PG8_BAR; PG8_MMA(1, 1, At, B1); PG8_BAR;
        }
        E(acc, cur, wr, wc, fr, fq);
        if (!has_next) break;
#pragma unroll
        for (int a = 0; a < 2; ++a)
#pragma unroll
            for (int b = 0; b < 2; ++b)
#pragma unroll
                for (int m = 0; m < 4; ++m)
#pragma unroll
                    for (int n = 0; n < 2; ++n) acc[a][b][m][n] = (f32x4){0.f, 0.f, 0.f, 0.f};
        cur = nxt; cA = nA; cB = nB; ++ui;
#pragma unroll
        for (int h = 0; h < 2; ++h)
#pragma unroll
            for (int i = 0; i < 2; ++i) vA[h][i] = vN[h][i];
    }
    PG8_WAIT_V(0);
    if (wr == 0) PG8_BAR;
    PG8_BAR;
#undef PG8_SA
#undef PG8_SB
#undef PG8_STAGE_A
#undef PG8_STAGE_B
#undef PG8_LDA
#undef PG8_LDB
#undef PG8_MMA
#undef PG8_WAIT_V
#undef PG8_WAIT_L
#undef PG8_BAR
#undef PG8_SCHED
}

struct EpiStore {
    bf16_t* O; size_t ldc;
    DI void operator()(const f32x4 (&acc)[2][2][4][2], const Unit& u, int wr, int wc, int fr, int fq) const {
        const int row0 = u.pm * BM + wr * 64 + fr, col0 = u.pn * BM + wc * 32 + 8 * fq;
#pragma unroll
        for (int ai = 0; ai < 2; ++ai)
#pragma unroll
            for (int m = 0; m < 4; ++m) { bf16_t* rowp = O + (size_t)(row0 + ai * HALF + m * 16) * ldc + col0;
#pragma unroll
                for (int bj = 0; bj < 2; ++bj) { const f32x4 v0 = acc[ai][bj][m][0], v1 = acc[ai][bj][m][1];
                    u32x4 w; w.x = cvt_pk_bf16(v0[0], v0[1]); w.y = cvt_pk_bf16(v0[2], v0[3]); w.z = cvt_pk_bf16(v1[0], v1[1]); w.w = cvt_pk_bf16(v1[2], v1[3]);
                    *(u32x4*)(rowp + bj * HALF) = w; } }
    }
};
struct EpiSwiglu {
    bf16_t* Hb;
    DI void operator()(const f32x4 (&acc)[2][2][4][2], const Unit& u, int wr, int wc, int fr, int fq) const {
        const int row0 = u.pm * BM + wr * 64 + fr, col0 = u.pn * HALF + wc * 32 + 8 * fq;
#pragma unroll
        for (int ai = 0; ai < 2; ++ai)
#pragma unroll
            for (int m = 0; m < 4; ++m) { bf16_t* rowp = Hb + (size_t)(row0 + ai * HALF + m * 16) * DEXP + col0;
                float o[8];
#pragma unroll
                for (int n = 0; n < 2; ++n)
#pragma unroll
                    for (int j = 0; j < 4; ++j) { const float g = acc[ai][0][m][n][j], up = acc[ai][1][m][n][j];
                        o[n * 4 + j] = g * up * __builtin_amdgcn_rcpf(1.0f + __builtin_amdgcn_exp2f(-1.4426950408889634f * g)); }
                u32x4 w; w.x = cvt_pk_bf16(o[0], o[1]); w.y = cvt_pk_bf16(o[2], o[3]); w.z = cvt_pk_bf16(o[4], o[5]); w.w = cvt_pk_bf16(o[6], o[7]);
                *(u32x4*)rowp = w; }
    }
};

struct EpiNsa {
    bf16_t* Q; bf16_t* KV; float* GT;
    DI void operator()(const f32x4 (&acc)[2][2][4][2], const Unit& u, int wr, int wc, int fr, int fq) const {
        const int row0 = u.pm * BM + wr * 64 + fr;
        if (u.pn < 10) {
            bf16_t* base = (u.pn < 4) ? Q + u.pn * BM : KV + (u.pn - 4) * BM; const size_t ldc = (u.pn < 4) ? 1024 : 1536; const int col0 = wc * 32 + 8 * fq;
#pragma unroll
            for (int ai = 0; ai < 2; ++ai)
#pragma unroll
                for (int m = 0; m < 4; ++m) { bf16_t* rowp = base + (size_t)(row0 + ai * HALF + m * 16) * ldc + col0;
#pragma unroll
                    for (int bj = 0; bj < 2; ++bj) { const f32x4 v0 = acc[ai][bj][m][0], v1 = acc[ai][bj][m][1];
                        u32x4 w; w.x = cvt_pk_bf16(v0[0], v0[1]); w.y = cvt_pk_bf16(v0[2], v0[3]); w.z = cvt_pk_bf16(v1[0], v1[1]); w.w = cvt_pk_bf16(v1[2], v1[3]);
                        *(u32x4*)(rowp + bj * HALF) = w; } }
        } else {
            const int col0 = wc * 32 + 8 * fq;
            if (col0 < 48) {
#pragma unroll
                for (int ai = 0; ai < 2; ++ai)
#pragma unroll
                    for (int m = 0; m < 4; ++m) { float* rowp = GT + (size_t)(row0 + ai * HALF + m * 16) * 48 + col0;
#pragma unroll
                        for (int n = 0; n < 2; ++n) { f32x4 v = acc[ai][0][m][n];
#pragma unroll
                            for (int j = 0; j < 4; ++j) v[j] = __builtin_amdgcn_rcpf(1.0f + __builtin_amdgcn_exp2f(-1.4426950408889634f * v[j]));
                            *(f32x4*)(rowp + 4 * n) = v; } }
            }
        }
    }
};
struct EpiCmp {
    bf16_t* Hd; const float* bias;
    DI void operator()(const f32x4 (&acc)[2][2][4][2], const Unit& u, int wr, int wc, int fr, int fq) const {
        const int row0 = u.pm * BM + wr * 64 + fr, col0 = wc * 32 + 8 * fq; const float* bp = bias + u.e * 256;
#pragma unroll
        for (int bj = 0; bj < 2; ++bj) { const f32x4 b0 = *(const f32x4*)(bp + bj * HALF + col0), b1 = *(const f32x4*)(bp + bj * HALF + col0 + 4);
#pragma unroll
            for (int ai = 0; ai < 2; ++ai)
#pragma unroll
                for (int m = 0; m < 4; ++m) { float o[8];
#pragma unroll
                    for (int j = 0; j < 4; ++j) { o[j] = acc[ai][bj][m][0][j] + b0[j]; o[4 + j] = acc[ai][bj][m][1][j] + b1[j]; }
#pragma unroll
                    for (int j = 0; j < 8; ++j) { const float x = o[j], u2 = 1.5957691216057308f * (x + 0.044715f * x * x * x); o[j] = x * __builtin_amdgcn_rcpf(1.0f + __builtin_amdgcn_exp2f(-1.4426950408889634f * u2)); }
                    u32x4 w; w.x = cvt_pk_bf16(o[0], o[1]); w.y = cvt_pk_bf16(o[2], o[3]); w.z = cvt_pk_bf16(o[4], o[5]); w.w = cvt_pk_bf16(o[6], o[7]);
                    *(u32x4*)(Hd + (size_t)(row0 + ai * HALF + m * 16) * 256 + bj * HALF + col0) = w; } }
    }
};
struct CmpSched {
    static constexpr bool GATHER = false;
    const char* kv6; const char* Bt; int K; unsigned lda, kstepA; int G, c;
    DI bool next(int i, Unit& u) const { const int L = i * G + c; if (L >= 64) return false; u.pm = L; u.pn = 0; u.e = L >> 5; return true; }
    DI const char* a_base(const Unit& u) const { const int j = u.pm >> 5, bg = (u.pm >> 2) & 7, cq = u.pm & 3, b = bg >> 2, g = bg & 3;
        return kv6 + (((size_t)b * SEQ + (size_t)cq * 4096) * 1536 + j * 256 + g * 64) * 2; }
    DI const char* b_base(const Unit& u) const { return Bt + (size_t)(u.pm >> 5) * 256 * 2048 * 2; }
    DI unsigned row_off(int, int) const { return 0u; }
};
}

struct MoeMeta { LAS int* tstart; LAS int* cnt; };
DI int moe_expert_of(const MoeMeta& mm, int rt) { int e = 0;
#pragma unroll
    for (int k = 1; k < 16; ++k) e += (rt >= mm.tstart[k]) ? 1 : 0;
    return e; }
struct Moe1Sched {
    static constexpr bool GATHER = true;
    const char* A; const char* Bt; int K; unsigned lda, kstepA; MoeMeta mm; int ntiles, G, c; LAS unsigned* tab;
    DI bool next(int i, pg8::Unit& u) const { const int L = i * G + c; if (L >= ntiles * 2) return false; u.pm = L % ntiles; u.pn = L / ntiles; u.e = moe_expert_of(mm, u.pm); return true; }
    DI const char* a_base(const pg8::Unit&) const { return A; }
    DI const char* b_base(const pg8::Unit& u) const { return Bt + ((size_t)u.e * 512 + (size_t)u.pn * 256) * 1024 * 2; }
    DI unsigned row_off(int slot, int row) const { return tab[slot * 256 + row]; }
};
struct Moe2Sched {
    static constexpr bool GATHER = false;
    const char* A; const char* Bt; int K; unsigned lda, kstepA; MoeMeta mm; int ntiles, G, c;
    DI bool next(int i, pg8::Unit& u) const { const int L = i * G + c; if (L >= ntiles * 4) return false; u.pm = L % ntiles; u.pn = L / ntiles; u.e = moe_expert_of(mm, u.pm); return true; }
    DI const char* a_base(const pg8::Unit& u) const { return A + (size_t)u.pm * 256 * 512; }
    DI const char* b_base(const pg8::Unit& u) const { return Bt + ((size_t)u.e * 1024 + (size_t)u.pn * 256) * 256 * 2; }
    DI unsigned row_off(int, int) const { return 0u; }
};

struct Args { const float* in[25]; float* out; unsigned char* ws; int wv; int pad; };
enum { IN_X = 0, IN_REL, IN_RW, IN_RB, IN_LN1G, IN_LN1B, IN_LN2G, IN_LN2B, IN_EG, IN_EU, IN_ED, IN_DILIN, IN_DILOUT, IN_SBIN, IN_SBOUT,
       IN_NSAIN, IN_NSAOUT, IN_POSK, IN_W1K, IN_W2K, IN_POSV, IN_W1V, IN_W2V, IN_MOBAIN, IN_MOBAOUT };

DI void transpose_item(const float* W, int K, int N, int Nvalid, bf16_t* WT, int drow0, LAS float* scr, int kb, int nb, int lane) {
    const int k0 = 64 * kb, n0 = 32 * nb;
    const int c4 = lane & 7, kr = lane >> 3;
    if (n0 + 32 <= Nvalid) {
#pragma unroll
        for (int i = 0; i < 8; ++i) { const f32x4 v = *(const f32x4*)(W + (size_t)(k0 + kr + 8 * i) * N + n0 + 4 * c4); LAS float* s = scr + (kr + 8 * i) * 33 + 4 * c4;
            s[0] = v.x; s[1] = v.y; s[2] = v.z; s[3] = v.w; }
    } else {
#pragma unroll 8
        for (int i = 0; i < 32; ++i) { const int kk = 2 * i + (lane >> 5); const int n = n0 + (lane & 31); scr[kk * 33 + (lane & 31)] = (n < Nvalid) ? W[(size_t)(k0 + kk) * N + n] : 0.f; }
    }
    LDS_WAIT(); asm volatile("" ::: "memory");
    const int c = lane & 7;
#pragma unroll
    for (int j = 0; j < 4; ++j) { const int n = (lane >> 3) + 8 * j; const LAS float* s = scr + (8 * c) * 33 + n;
        u32x4 o; o.x = pk2(s[0 * 33], s[1 * 33]); o.y = pk2(s[2 * 33], s[3 * 33]); o.z = pk2(s[4 * 33], s[5 * 33]); o.w = pk2(s[6 * 33], s[7 * 33]);
        *(u32x4*)(WT + (size_t)(drow0 + n) * K + k0 + 8 * c) = o; }
    LDS_WAIT(); asm volatile("" ::: "memory");
}
DI void convert_matrix(const float* W, int K, int N, int Npad, bf16_t* WT, LAS float* scr, int gw, int NGW, int lane) {
    const int nblk = Npad / 32, nitems = (K / 64) * nblk;
    for (int it = gw; it < nitems; it += NGW) { const int kb = it / nblk, nb = it % nblk; transpose_item(W, K, N, N, WT, 32 * nb, scr, kb, nb, lane); }
}
DI void convert_layer_weights(const Args& a, int layer, LAS unsigned char* lds, int gw, int NGW, int wave, int lane) {
    LAS float* scr = (LAS float*)(lds + STAGE_OFF + wave * 16384);
    bf16_t* W1 = (bf16_t*)(a.ws + WS_WEXP1); bf16_t* W2 = (bf16_t*)(a.ws + WS_WEXP2);
    const float* eg = a.in[IN_EG] + (size_t)layer * NE * D * DEXP; const float* eu = a.in[IN_EU] + (size_t)layer * NE * D * DEXP; const float* ed = a.in[IN_ED] + (size_t)layer * NE * DEXP * D;
    constexpr int I_G = (D / 64) * (DEXP / 32);
    constexpr int I_D = (DEXP / 64) * (D / 32);
    constexpr int I_E = 2 * I_G + I_D;
    {
        bf16_t* Win = (bf16_t*)(a.ws + WS_WIN); bf16_t* Wout = (bf16_t*)(a.ws + WS_WOUT);
        if (layer == 0) { convert_matrix(a.in[IN_DILIN], D, 9216, 9216, Win, scr, gw, NGW, lane); convert_matrix(a.in[IN_DILOUT], D, D, D, Wout, scr, gw, NGW, lane); }
        if (layer == 1) { convert_matrix(a.in[IN_SBIN], D, 3072, 3072, Win, scr, gw, NGW, lane); convert_matrix(a.in[IN_SBOUT], D, D, D, Wout, scr, gw, NGW, lane); }
        if (layer == 2) { convert_matrix(a.in[IN_NSAIN], D, 2608, 2816, Win, scr, gw, NGW, lane); convert_matrix(a.in[IN_NSAOUT], D, D, D, Wout, scr, gw, NGW, lane);
            bf16_t* wc = (bf16_t*)(a.ws + WS_WCMP);
            convert_matrix(a.in[IN_W1K], 2048, 256, 256, wc, scr, gw, NGW, lane); convert_matrix(a.in[IN_W1V], 2048, 256, 256, wc + 256 * 2048, scr, gw, NGW, lane);
            convert_matrix(a.in[IN_W2K], 256, 64, 64, wc + 2 * 256 * 2048, scr, gw, NGW, lane); convert_matrix(a.in[IN_W2V], 256, 64, 64, wc + 2 * 256 * 2048 + 64 * 256, scr, gw, NGW, lane);
            float* cb = (float*)(a.ws + WS_WCMP + 2 * MiB + 64 * 1024);
            for (int it = gw; it < 512; it += NGW) { const int j = it >> 8, n = it & 255; const float* pos = a.in[j ? IN_POSV : IN_POSK]; const float* w1 = a.in[j ? IN_W1V : IN_W1K];
                float s = 0.f; for (int k = lane; k < 2048; k += 64) s += pos[k] * w1[(size_t)k * 256 + n];
                s = wave_sum(s); if (lane == 0) cb[it] = s; } }
        if (layer == 3) { convert_matrix(a.in[IN_MOBAIN], D, 3072, 3072, Win, scr, gw, NGW, lane); convert_matrix(a.in[IN_MOBAOUT], D, D, D, Wout, scr, gw, NGW, lane); }
    }
    const int NITEMS = NE * I_E;
    for (int it = gw; it < NITEMS; it += NGW) {
        const int e = it / I_E; int r = it % I_E;
        if (r < I_G) { const int kb = r / (DEXP / 32), nb = r % (DEXP / 32); const int n0 = 32 * nb;
            transpose_item(eg + (size_t)e * D * DEXP, D, DEXP, DEXP, W1, e * 512 + ((n0 >> 7) << 8) + (n0 & 127), scr, kb, nb, lane); continue; }
        r -= I_G;
        if (r < I_G) { const int kb = r / (DEXP / 32), nb = r % (DEXP / 32); const int n0 = 32 * nb;
            transpose_item(eu + (size_t)e * D * DEXP, D, DEXP, DEXP, W1, e * 512 + ((n0 >> 7) << 8) + 128 + (n0 & 127), scr, kb, nb, lane); continue; }
        r -= I_G;
        { const int kb = r / (D / 32), nb = r % (D / 32);
          transpose_item(ed + (size_t)e * DEXP * D, DEXP, D, D, W2, e * 1024 + 32 * nb, scr, kb, nb, lane); }
    }
}

struct RowVec { f32x4 v[4]; };
DI void ln_stats(const RowVec& r, float& mean, float& rstd) {
    float s = 0.f;
#pragma unroll
    for (int j = 0; j < 4; ++j) s += (r.v[j].x + r.v[j].y) + (r.v[j].z + r.v[j].w);
    mean = wave_sum(s) * (1.f / D); float s2 = 0.f;
#pragma unroll
    for (int j = 0; j < 4; ++j) { const f32x4 d = r.v[j] - mean; s2 += (d.x * d.x + d.y * d.y) + (d.z * d.z + d.w * d.w); }
    rstd = 1.f / sqrtf(wave_sum(s2) * (1.f / D) + LN_EPS);
}


constexpr int KSTR = 144;
constexpr int KVT = 64;
constexpr int KV_TILE_BYTES = KVT * KSTR;
constexpr float LOG2E = 1.4426950408889634f, LN2F = 0.6931471805599453f;
DI f32x16 mfma32(bf16x8 a, bf16x8 b, f32x16 c) { return __builtin_amdgcn_mfma_f32_32x32x16_bf16(a, b, c, 0, 0, 0); }
DI f32x16 zero16() { f32x16 z; for (int i = 0; i < 16; ++i) z[i] = 0.f; return z; }
DI void kv_fetch(u32x4& kr, u32x4& vr, const bf16_t* kb, const bf16_t* vb, size_t rstride, int row0, int nrows, int tid) {
    asm volatile("" : "+v"(tid));
    const int row = row0 + (tid >> 3), c16 = tid & 7;
    if (row >= 0 && row < nrows) { kr = *(const u32x4*)(kb + (size_t)row * rstride + c16 * 8); vr = *(const u32x4*)(vb + (size_t)row * rstride + c16 * 8); }
    else { kr = (u32x4){0u, 0u, 0u, 0u}; vr = kr; }
}
DI void kv_store(LAS unsigned char* kl, LAS unsigned char* vl, const u32x4& kr, const u32x4& vr, int tid) {
    asm volatile("" ::: "memory"); __builtin_amdgcn_sched_barrier(0);
    asm volatile("" : "+v"(tid));
    const int off = (tid >> 3) * KSTR + (tid & 7) * 16;
    *(LAS u32x4*)(kl + off) = kr; *(LAS u32x4*)(vl + off) = vr;
}
constexpr int DT_BYTES = 16384;
DI void kv_dma_issue(LAS unsigned char* slot, const bf16_t* kb, const bf16_t* vb, size_t rstride, int row0, int nrows, int wave, int lane) {
    asm volatile("" : "+v"(lane));
    const int rr = lane >> 3, row = min(max(row0 + 8 * wave + rr, 0), nrows - 1), ch = (lane & 7) ^ rr;
    const size_t off = (size_t)row * rstride + ch * 8;
    __builtin_amdgcn_global_load_lds((const unsigned*)(kb + off), (LAS unsigned*)(slot + wave * 1024), 16, 0, 0);
    __builtin_amdgcn_global_load_lds((const unsigned*)(vb + off), (LAS unsigned*)(slot + 8192 + wave * 1024), 16, 0, 0);
}
DI f32x16 qk_tile_sw(const LAS unsigned char* kl, int kt, const bf16x8 (&Q)[4], int lane) {
    asm volatile("" : "+v"(lane));
    const int r = lane & 31, h = lane >> 5;
    const int pr = (r & ~12) | ((r & 4) << 1) | ((r & 8) >> 1), sw = pr & 7;
    const LAS unsigned char* p = kl + (kt * 32 + pr) * 128;
    f32x16 S = zero16();
#pragma unroll
    for (int ks = 0; ks < 4; ++ks) { const bf16x8 A = *(const LAS bf16x8*)(p + (((2 * ks + h) ^ sw) << 4)); S = mfma32(A, Q[ks], S); }
    return S;
}
DI void pv_tile_sw(const LAS unsigned char* vl, int kt, const f32x16& P, f32x16 (&O)[2], int lane) {
    asm volatile("" : "+v"(lane));
    const int i16 = lane & 15, q = i16 >> 2, p = i16 & 3, blk = (lane >> 4) & 1, h = lane >> 5;
    const unsigned vp = (unsigned)(size_t)(vl + (kt * 32 + 8 * h + q) * 128 + 8 * (p & 1));
    const int c0 = 2 * blk + (p >> 1), c1 = 4 + c0;
    const unsigned a0 = vp + ((c0 ^ q) << 4), a1 = vp + 512 + ((c0 ^ (q + 4)) << 4), a2 = vp + ((c1 ^ q) << 4), a3 = vp + 512 + ((c1 ^ (q + 4)) << 4);
    s16x4 lo0, hi0, lo1, hi1, lo2, hi2, lo3, hi3;
    asm volatile("ds_read_b64_tr_b16 %0, %8\n\tds_read_b64_tr_b16 %1, %9\n\tds_read_b64_tr_b16 %2, %10\n\tds_read_b64_tr_b16 %3, %11\n\t"
                 "ds_read_b64_tr_b16 %4, %8 offset:2048\n\tds_read_b64_tr_b16 %5, %9 offset:2048\n\tds_read_b64_tr_b16 %6, %10 offset:2048\n\tds_read_b64_tr_b16 %7, %11 offset:2048\n\ts_waitcnt lgkmcnt(0)"
                 : "=&v"(lo0), "=&v"(hi0), "=&v"(lo1), "=&v"(hi1), "=&v"(lo2), "=&v"(hi2), "=&v"(lo3), "=&v"(hi3) : "v"(a0), "v"(a1), "v"(a2), "v"(a3) : "memory");
    { u32x4 pk; pk.x = cvt_pk_bf16(P[0], P[1]); pk.y = cvt_pk_bf16(P[2], P[3]); pk.z = cvt_pk_bf16(P[4], P[5]); pk.w = cvt_pk_bf16(P[6], P[7]);
      const bf16x8 Bp = __builtin_bit_cast(bf16x8, pk);
      O[0] = mfma32(__builtin_shufflevector(lo0, hi0, 0, 1, 2, 3, 4, 5, 6, 7), Bp, O[0]);
      O[1] = mfma32(__builtin_shufflevector(lo1, hi1, 0, 1, 2, 3, 4, 5, 6, 7), Bp, O[1]); }
    { u32x4 pk; pk.x = cvt_pk_bf16(P[8], P[9]); pk.y = cvt_pk_bf16(P[10], P[11]); pk.z = cvt_pk_bf16(P[12], P[13]); pk.w = cvt_pk_bf16(P[14], P[15]);
      const bf16x8 Bp = __builtin_bit_cast(bf16x8, pk);
      O[0] = mfma32(__builtin_shufflevector(lo2, hi2, 0, 1, 2, 3, 4, 5, 6, 7), Bp, O[0]);
      O[1] = mfma32(__builtin_shufflevector(lo3, hi3, 0, 1, 2, 3, 4, 5, 6, 7), Bp, O[1]); }
}
template <int NS, class RowF, class CompF>
DI void kv_dma_pipeline(int n, const RowF& rowf, const CompF& comp, const bf16_t* kb, const bf16_t* vb, size_t rstride, int nrows, LAS unsigned char* ring, int wave, int lane) {
    if (n <= 0) return;
#pragma unroll
    for (int i = 0; i < NS - 1; ++i) if (i < n) kv_dma_issue(ring + i * DT_BYTES, kb, vb, rstride, rowf(i), nrows, wave, lane);
    int sc = 0, sn = NS - 1;
#pragma unroll 1
    for (int j = 0; j < n; ++j) {
        const int rem = min(n - 1 - j, NS - 2);
        if (rem >= 4) asm volatile("s_waitcnt vmcnt(8)" ::: "memory");
        else if (rem == 3) asm volatile("s_waitcnt vmcnt(6)" ::: "memory");
        else if (rem == 2) asm volatile("s_waitcnt vmcnt(4)" ::: "memory");
        else if (rem == 1) asm volatile("s_waitcnt vmcnt(2)" ::: "memory");
        else asm volatile("s_waitcnt vmcnt(0)" ::: "memory");
        __builtin_amdgcn_s_barrier(); asm volatile("" ::: "memory");
        comp(j, ring + sc * DT_BYTES, ring + sc * DT_BYTES + 8192);
        if (j + NS - 1 < n) kv_dma_issue(ring + sn * DT_BYTES, kb, vb, rstride, rowf(j + NS - 1), nrows, wave, lane);
        sc = (sc + 1 == NS) ? 0 : sc + 1; sn = (sn + 1 == NS) ? 0 : sn + 1;
    }
    asm volatile("s_waitcnt lgkmcnt(0)" ::: "memory"); __builtin_amdgcn_s_barrier(); asm volatile("" ::: "memory");
}
template <int NS, class IssueF, class CompF>
DI void kv_dma_stream(int n, const IssueF& issue, const CompF& comp, LAS unsigned char* ring) {
    if (n <= 0) return;
#pragma unroll
    for (int i = 0; i < NS - 1; ++i) if (i < n) issue(i, ring + i * DT_BYTES);
    int sc = 0, sn = NS - 1;
#pragma unroll 1
    for (int j = 0; j < n; ++j) {
        const int rem = min(n - 1 - j, NS - 2);
        if (rem >= 4) asm volatile("s_waitcnt vmcnt(8)" ::: "memory");
        else if (rem == 3) asm volatile("s_waitcnt vmcnt(6)" ::: "memory");
        else if (rem == 2) asm volatile("s_waitcnt vmcnt(4)" ::: "memory");
        else if (rem == 1) asm volatile("s_waitcnt vmcnt(2)" ::: "memory");
        else asm volatile("s_waitcnt vmcnt(0)" ::: "memory");
        __builtin_amdgcn_s_barrier(); asm volatile("" ::: "memory");
        comp(j, ring + sc * DT_BYTES, ring + sc * DT_BYTES + 8192);
        if (j + NS - 1 < n) issue(j + NS - 1, ring + sn * DT_BYTES);
        sc = (sc + 1 == NS) ? 0 : sc + 1; sn = (sn + 1 == NS) ? 0 : sn + 1;
    }
    asm volatile("s_waitcnt lgkmcnt(0)" ::: "memory"); __builtin_amdgcn_s_barrier(); asm volatile("" ::: "memory");
}
DI f32x16 qk_tile(const LAS unsigned char* kl, int kt, const bf16x8 (&Q)[4], int lane) {
    asm volatile("" : "+v"(lane));
    const int r = lane & 31, h = lane >> 5;
    const int pr = (r & ~12) | ((r & 4) << 1) | ((r & 8) >> 1);
    const LAS unsigned char* p = kl + (kt * 32 + pr) * KSTR + h * 16;
    f32x16 S = zero16();
#pragma unroll
    for (int ks = 0; ks < 4; ++ks) { const bf16x8 A = *(const LAS bf16x8*)(p + ks * 32); S = mfma32(A, Q[ks], S); }
    return S;
}
DI void pv_tile(const LAS unsigned char* vl, int kt, const f32x16& P, f32x16 (&O)[2], int lane) {
    asm volatile("" : "+v"(lane));
    const int i16 = lane & 15, q = i16 >> 2, p = i16 & 3, blk = (lane >> 4) & 1, h = lane >> 5;
#pragma unroll
    for (int s = 0; s < 2; ++s) {
        u32x4 pk; pk.x = cvt_pk_bf16(P[8 * s + 0], P[8 * s + 1]); pk.y = cvt_pk_bf16(P[8 * s + 2], P[8 * s + 3]); pk.z = cvt_pk_bf16(P[8 * s + 4], P[8 * s + 5]); pk.w = cvt_pk_bf16(P[8 * s + 6], P[8 * s + 7]);
        const bf16x8 Bp = __builtin_bit_cast(bf16x8, pk);
        const LAS unsigned char* vp = vl + (kt * 32 + 16 * s + 8 * h + q) * KSTR + (16 * blk + 4 * p) * 2;
#pragma unroll
        for (int dt = 0; dt < 2; ++dt) {
            const s16x4 lo = __builtin_amdgcn_ds_read_tr16_b64_v4i16((LAS s16x4*)(vp + dt * 64));
            const s16x4 hi = __builtin_amdgcn_ds_read_tr16_b64_v4i16((LAS s16x4*)(vp + dt * 64 + 4 * KSTR));
            const bf16x8 A = __builtin_shufflevector(lo, hi, 0, 1, 2, 3, 4, 5, 6, 7);
            O[dt] = mfma32(A, Bp, O[dt]);
        }
    }
}
DI void store_o(bf16_t* orow, const f32x16 (&O)[2], float sc, int h) {
#pragma unroll
    for (int dt = 0; dt < 2; ++dt)
#pragma unroll
        for (int g = 0; g < 4; ++g) { u32x2 w; w.x = cvt_pk_bf16(O[dt][4 * g] * sc, O[dt][4 * g + 1] * sc); w.y = cvt_pk_bf16(O[dt][4 * g + 2] * sc, O[dt][4 * g + 3] * sc);
            *(u32x2*)(orow + dt * 32 + 8 * g + 4 * h) = w; }
}

constexpr int BT_PAD = 128, BT_LEN = BT_PAD + 2048;
constexpr int DIST_ANY = 0x3fffffff, DIST_NONE = 0x40000000;
constexpr size_t WS_BIASG = WS_SMALL + 256 * 1024;
DI void load_bias_table(LAS float* dst, const float* biasG, int head, int dsh, int tid, int hicut = 0x3fffffff) {
    for (int i = tid; i < BT_LEN; i += NTHR) { const int n = i - BT_PAD; dst[i] = (n >= 0 && n <= hicut) ? biasG[head * 2048 + min(n << dsh, 2047)] : -1e30f; }
}
template <int STRIDE, bool MASKED>
DI float logits_tile(f32x16 (&S)[2], const LAS float* P, int D0, int h, int lo, unsigned range) {
    float mx = -1e30f;
    if (!MASKED && __all(D0 - 63 * STRIDE >= 1512)) {
        const float cb = P[BT_PAD + 2047];
#pragma unroll
        for (int sub = 0; sub < 2; ++sub)
#pragma unroll
            for (int i = 0; i < 16; ++i) { const float x = S[sub][i] * (0.125f * LOG2E) + cb; S[sub][i] = x; mx = fmaxf(mx, x); }
        return mx;
    }
#pragma unroll
    for (int sub = 0; sub < 2; ++sub)
#pragma unroll
        for (int s = 0; s < 2; ++s) {
            const int d0 = D0 - (32 * sub + 16 * s + 8 * h) * STRIDE;
            const int base = min(max(d0 - 7 * STRIDE + BT_PAD, 0), BT_LEN - 1 - 7 * STRIDE);
            const LAS float* pb = P + base;
#pragma unroll
            for (int j = 0; j < 8; ++j) { const int i = 8 * s + j;
                float x = S[sub][i] * (0.125f * LOG2E) + pb[(7 - j) * STRIDE];
                if (MASKED) x = ((unsigned)(d0 - j * STRIDE - lo) <= range) ? x : -1e30f;
                S[sub][i] = x; mx = fmaxf(mx, x); }
        }
    return mx;
}
template <int STRIDE, bool MASKED>
DI void softmax_tile(f32x16 (&S)[2], float& m, float& l, f32x16 (&O)[2], const LAS float* P, int D0, int h, int lo, unsigned range) {
    float mx = logits_tile<STRIDE, MASKED>(S, P, D0, h, lo, range);
    mx = fmaxf(mx, xor32h(mx, h));
    const float mnew = fmaxf(m, mx), mm = (mnew <= -1e30f) ? 0.f : mnew;
    float ls = 0.f;
#pragma unroll
    for (int sub = 0; sub < 2; ++sub)
#pragma unroll
        for (int i = 0; i < 16; ++i) { const float p = __builtin_amdgcn_exp2f(S[sub][i] - mm); S[sub][i] = p; ls += p; }
    ls += xor32h(ls, h);
    if (!__all(mnew == m)) {
        const float alpha = __builtin_amdgcn_exp2f(m - mnew);
        l *= alpha;
#pragma unroll
        for (int dt = 0; dt < 2; ++dt)
#pragma unroll
            for (int i = 0; i < 16; ++i) O[dt][i] *= alpha;
    }
    l += ls; m = mnew;
}
template <int STRIDE, bool MASKED>
DI void stats_tile(f32x16 (&S)[2], float& m, float& l, const LAS float* P, int D0, int h, int lo, unsigned range) {
    float mx = logits_tile<STRIDE, MASKED>(S, P, D0, h, lo, range);
    mx = fmaxf(mx, xor32h(mx, h));
    const float mnew = fmaxf(m, mx), mm = (mnew <= -1e30f) ? 0.f : mnew;
    float ls = 0.f;
#pragma unroll
    for (int sub = 0; sub < 2; ++sub)
#pragma unroll
        for (int i = 0; i < 16; ++i) ls += __builtin_amdgcn_exp2f(S[sub][i] - mm);
    ls += xor32h(ls, h);
    l = l * __builtin_amdgcn_exp2f(m - mnew) + ls; m = mnew;
}

constexpr size_t BIG_OG = 288 * MiB;
constexpr size_t BIG_LSE = 384 * MiB;
DI void dilated_phase(const Args& a, LAS unsigned char* lds) {
    int tid = tid_of(a.wv); asm volatile("" : "+v"(tid));
    const int lane = tid & 63, wave = a.wv, c = lane & 31, h = lane >> 5;
    const bf16_t* qkv = (const bf16_t*)(a.ws + WS_BIG);
    LAS unsigned char* kbuf = lds; LAS unsigned char* vbuf = lds + 2 * KV_TILE_BYTES;
    LAS float* btab = (LAS float*)(lds + 4 * KV_TILE_BYTES);
    const float* biasG = (const float*)(a.ws + WS_BIASG);
    const int G = gridDim.x, bid = blockIdx.x;
    const int nu = bid < 3072 ? (3072 - bid + G - 1) / G : 0;
    if (nu == 0) return;
#define DL_DESC(k) const int u_ = bid + (k) * G, hh_ = u_ & 15, g_ = (u_ >> 4) >> 6, idx_ = (u_ >> 4) & 63, dsh_ = 2 * g_, r_ = idx_ & ((1 << dsh_) - 1), blk_ = idx_ >> dsh_; \
        const bf16_t* qb_ = qkv + (size_t)r_ * 9216 + g_ * 3072 + hh_ * 64; const size_t rs_ = (size_t)9216 << dsh_; (void)blk_; (void)qb_; (void)rs_;
    int cur_key = -1, buf = 0;
    int hh = 0, g = 0, dsh = 0, r = 0, Q0 = 0, q0w = 0, iq = 0;
    bf16x8 Q[4], Qn[4];
    f32x16 O[2]; float m = -1e30f, l = 0.f;
    u32x4 kr, vr;
    { DL_DESC(0)
      const bf16_t* qrow = qb_ + (size_t)(blk_ * 256 + 32 * wave + c) * rs_;
#pragma unroll
      for (int ks = 0; ks < 4; ++ks) Qn[ks] = *(const bf16x8*)(qrow + 16 * ks + 8 * h);
      kv_fetch(kr, vr, qb_ + 1024, qb_ + 2048, rs_, blk_ * 256 - 128, SEQ >> dsh_, tid); kv_store(kbuf, vbuf, kr, vr, tid); }
    const int total = nu * 6;
#pragma unroll 1
    for (int f = 0; f < total; ++f) {
        const int k = f / 6, j = f - 6 * k;
        if (j == 0) {
            DL_DESC(k)
            hh = hh_; g = g_; dsh = dsh_; r = r_; Q0 = blk_ * 256; q0w = Q0 + 32 * wave; iq = q0w + c;
#pragma unroll
            for (int ks = 0; ks < 4; ++ks) Q[ks] = Qn[ks];
            O[0] = zero16(); O[1] = zero16(); m = -1e30f; l = 0.f;
            if (hh * 4 + g != cur_key) { __syncthreads(); load_bias_table(btab, biasG, hh, dsh, tid, 128); cur_key = hh * 4 + g; }
        }
        __syncthreads();
        if (f + 1 < total) { const int k1 = (f + 1) / 6, j1 = (f + 1) - 6 * k1; DL_DESC(k1)
            kv_fetch(kr, vr, qb_ + 1024, qb_ + 2048, rs_, blk_ * 256 - 128 + 64 * j1, SEQ >> dsh_, tid); }
        { const int kr0 = Q0 - 128 + 64 * j;
          if (kr0 <= q0w + 31 && kr0 + 63 >= q0w - 128 && kr0 + 63 >= 0) {
            const LAS unsigned char* kl = kbuf + buf * KV_TILE_BYTES; const LAS unsigned char* vl = vbuf + buf * KV_TILE_BYTES;
            f32x16 S[2]; S[0] = qk_tile(kl, 0, Q, lane); S[1] = qk_tile(kl, 1, Q, lane);
            if (Q0 > 0) softmax_tile<1, false>(S, m, l, O, btab, iq - kr0, h, 0, 128u);
            else softmax_tile<1, true>(S, m, l, O, btab, iq - kr0, h, 0, (unsigned)min(128, iq));
            pv_tile(vl, 0, S[0], O, lane); pv_tile(vl, 1, S[1], O, lane);
          } }
        if (j == 3 && k + 1 < nu) { DL_DESC(k + 1)
            const bf16_t* qrow = qb_ + (size_t)(blk_ * 256 + 32 * wave + c) * rs_;
#pragma unroll
            for (int ks = 0; ks < 4; ++ks) Qn[ks] = *(const bf16x8*)(qrow + 16 * ks + 8 * h); }
        if (f + 1 < total) kv_store(kbuf + (buf ^ 1) * KV_TILE_BYTES, vbuf + (buf ^ 1) * KV_TILE_BYTES, kr, vr, tid);
        buf ^= 1;
        if (j == 5) {
            const int tok = (iq << dsh) + r;
            bf16_t* og = (bf16_t*)(a.ws + WS_BIG + BIG_OG) + (size_t)g * SEQ * D;
            float* lse = (float*)(a.ws + WS_BIG + BIG_LSE) + (size_t)g * SEQ * 16;
            store_o(og + (size_t)tok * D + hh * 64, O, 1.f / l, h);
            if (h == 0) lse[tok * 16 + hh] = m + __builtin_amdgcn_logf(l);
        }
    }
#undef DL_DESC
}
DI void dilated_merge(const Args& a, int b) {
    const int tid = tid_of(a.wv);
    const bf16_t* og = (const bf16_t*)(a.ws + WS_BIG + BIG_OG); const float* lse = (const float*)(a.ws + WS_BIG + BIG_LSE);
    bf16_t* outb = (bf16_t*)(a.ws + WS_ACTB) + (size_t)b * SEQ * D;
    for (int i = blockIdx.x * NTHR + tid; i < SEQ * 128; i += gridDim.x * NTHR) {
        const int tok = i >> 7, c8 = i & 127, hh = c8 >> 3;
        const float l0 = lse[tok * 16 + hh], l1 = lse[SEQ * 16 + tok * 16 + hh], l2 = lse[2 * SEQ * 16 + tok * 16 + hh];
        const float mx = fmaxf(l0, fmaxf(l1, l2));
        float w0 = __builtin_amdgcn_exp2f(l0 - mx), w1 = __builtin_amdgcn_exp2f(l1 - mx), w2 = __builtin_amdgcn_exp2f(l2 - mx);
        const float inv = 1.f / (w0 + w1 + w2); w0 *= inv; w1 *= inv; w2 *= inv;
        const u32x4 a0 = *(const u32x4*)(og + (size_t)tok * D + c8 * 8), a1 = *(const u32x4*)(og + (size_t)SEQ * D + (size_t)tok * D + c8 * 8), a2 = *(const u32x4*)(og + (size_t)2 * SEQ * D + (size_t)tok * D + c8 * 8);
        u32x4 o;
        o.x = pk2(w0 * bf_lo(a0.x) + w1 * bf_lo(a1.x) + w2 * bf_lo(a2.x), w0 * bf_hi(a0.x) + w1 * bf_hi(a1.x) + w2 * bf_hi(a2.x));
        o.y = pk2(w0 * bf_lo(a0.y) + w1 * bf_lo(a1.y) + w2 * bf_lo(a2.y), w0 * bf_hi(a0.y) + w1 * bf_hi(a1.y) + w2 * bf_hi(a2.y));
        o.z = pk2(w0 * bf_lo(a0.z) + w1 * bf_lo(a1.z) + w2 * bf_lo(a2.z), w0 * bf_hi(a0.z) + w1 * bf_hi(a1.z) + w2 * bf_hi(a2.z));
        o.w = pk2(w0 * bf_lo(a0.w) + w1 * bf_lo(a1.w) + w2 * bf_lo(a2.w), w0 * bf_hi(a0.w) + w1 * bf_hi(a1.w) + w2 * bf_hi(a2.w));
        *(u32x4*)(outb + (size_t)tok * D + c8 * 8) = o;
    }
}

constexpr size_t MB_KMEAN = WS_ACTB, MB_SELW = WS_ACTB + 1 * MiB, MB_LIST = WS_ACTB + 4 * MiB;
constexpr size_t BIG_OSEL = 192 * MiB, BIG_LSESEL = 384 * MiB;
constexpr int CW_MBCNT = 32768, CW_MBCUR = 32768 + 2048;
constexpr int CW_NSAQ = 40960;
constexpr int MB_LISTCAP = 49152;
DI void moba_kmean_phase(const Args& a, LAS unsigned char* lds) {
    const int tid = tid_of(a.wv);
    const bf16_t* qkv = (const bf16_t*)(a.ws + WS_BIG);
    float* kmean = (float*)(a.ws + MB_KMEAN);
    LAS float* part = (LAS float*)lds;
    for (int u = blockIdx.x; u < 2048; u += gridDim.x) {
        const int n = u & 63, bh = u >> 6, b = bh >> 4, hh = bh & 15;
        const bf16_t* kp = qkv + ((size_t)b * SEQ + n * 256 + (tid >> 3)) * 3072 + 1024 + hh * 64 + (tid & 7) * 8;
        float s[8];
#pragma unroll
        for (int j = 0; j < 8; ++j) s[j] = 0.f;
#pragma unroll
        for (int i = 0; i < 4; ++i) { const u32x4 v = *(const u32x4*)(kp + (size_t)(64 * i) * 3072);
            s[0] += bf_lo(v.x); s[1] += bf_hi(v.x); s[2] += bf_lo(v.y); s[3] += bf_hi(v.y); s[4] += bf_lo(v.z); s[5] += bf_hi(v.z); s[6] += bf_lo(v.w); s[7] += bf_hi(v.w); }
        __syncthreads();
        *(LAS f32x4*)(part + (tid >> 3) * 64 + (tid & 7) * 8) = (f32x4){s[0], s[1], s[2], s[3]}; *(LAS f32x4*)(part + (tid >> 3) * 64 + (tid & 7) * 8 + 4) = (f32x4){s[4], s[5], s[6], s[7]};
        __syncthreads();
        if (tid < 64) { float acc = 0.f;
#pragma unroll 8
            for (int gq = 0; gq < 64; ++gq) acc += part[gq * 64 + tid];
            kmean[((size_t)bh * 64 + n) * 64 + tid] = acc * (1.f / 256.f); }
    }
}
DI void moba_gate_phase(const Args& a, LAS unsigned char* lds) {
    int tid = tid_of(a.wv); asm volatile("" : "+v"(tid));
    const int lane = tid & 63, wave = __builtin_amdgcn_readfirstlane(tid >> 6), c = lane & 31, h = lane >> 5;
    const bf16_t* qkv = (const bf16_t*)(a.ws + WS_BIG);
    const float* kmean = (const float*)(a.ws + MB_KMEAN);
    unsigned* selw = (unsigned*)(a.ws + MB_SELW);
    unsigned* cnt = (unsigned*)(a.ws + WS_CTL) + CW_MBCNT;
    LAS unsigned char* khi = lds; LAS unsigned char* klo = lds + KV_TILE_BYTES;
    LAS int* hist = (LAS int*)(lds + 2 * KV_TILE_BYTES);
    int cur_bh = -1;
    for (int u = blockIdx.x; u < 2048; u += gridDim.x) {
        const int bh = u & 31, qb = u >> 5, b = bh >> 4, hh = bh & 15;
        const int t = qb * 256 + 32 * wave + c;
        __syncthreads();
        if (bh != cur_bh) { cur_bh = bh;
          const int row = tid >> 3, c16 = tid & 7; const float* kp = kmean + ((size_t)bh * 64 + row) * 64 + c16 * 8;
          const f32x4 v0 = *(const f32x4*)kp, v1 = *(const f32x4*)(kp + 4);
          float v[8] = {v0.x, v0.y, v0.z, v0.w, v1.x, v1.y, v1.z, v1.w}; unsigned hi[8], lo[8];
#pragma unroll
          for (int j = 0; j < 8; ++j) { hi[j] = f2bf(v[j]); lo[j] = f2bf(v[j] - u2f(hi[j] << 16)); }
          u32x4 wh, wl; wh.x = hi[0] | (hi[1] << 16); wh.y = hi[2] | (hi[3] << 16); wh.z = hi[4] | (hi[5] << 16); wh.w = hi[6] | (hi[7] << 16);
          wl.x = lo[0] | (lo[1] << 16); wl.y = lo[2] | (lo[3] << 16); wl.z = lo[4] | (lo[5] << 16); wl.w = lo[6] | (lo[7] << 16);
          kv_store(khi, klo, wh, wl, tid); }
        if (tid < 64) hist[tid] = 0;
        __syncthreads();
        bf16x8 Q[4];
        { const bf16_t* qrow = qkv + ((size_t)b * SEQ + t) * 3072 + hh * 64;
#pragma unroll
          for (int ks = 0; ks < 4; ++ks) Q[ks] = *(const bf16x8*)(qrow + 16 * ks + 8 * h); }
        f32x16 Gs[2];
#pragma unroll
        for (int sub = 0; sub < 2; ++sub) { const f32x16 a0 = qk_tile(khi, sub, Q, lane), a1 = qk_tile(klo, sub, Q, lane);
#pragma unroll
            for (int i = 0; i < 16; ++i) { const int n = sub * 32 + 16 * (i >> 3) + 8 * h + (i & 7); Gs[sub][i] = (n < qb) ? (a0[i] + a1[i]) : -1e30f; } }
        unsigned selpack = 0;
#pragma unroll
        for (int pass = 0; pass < 3; ++pass) {
            float bv = -3e38f; int bn = 64;
#pragma unroll
            for (int sub = 0; sub < 2; ++sub)
#pragma unroll
                for (int i = 0; i < 16; ++i) { const int n = sub * 32 + 16 * (i >> 3) + 8 * h + (i & 7); const float v = Gs[sub][i];
                    if (v > bv || (v == bv && n < bn)) { bv = v; bn = n; } }
            const float pv = __shfl_xor(bv, 32); const int pn = __shfl_xor(bn, 32);
            if (pv > bv || (pv == bv && pn < bn)) { bv = pv; bn = pn; }
            const bool ok = bv > -1e29f;
            selpack |= (ok ? (unsigned)bn : 255u) << (8 * pass);
            if (ok && h == 0) atomicAdd((int*)(hist + bn), 1);
#pragma unroll
            for (int sub = 0; sub < 2; ++sub)
#pragma unroll
                for (int i = 0; i < 16; ++i) { const int n = sub * 32 + 16 * (i >> 3) + 8 * h + (i & 7); if (n == bn) Gs[sub][i] = -3e38f; }
        }
        if (h == 0) selw[(size_t)bh * SEQ + t] = selpack;
        __syncthreads();
        if (tid < 64 && hist[tid] > 0) xb_add(cnt + bh * 64 + tid, (unsigned)hist[tid]);
    }
}
DI void moba_fill_phase(const Args& a, LAS unsigned char* lds) {
    const int tid = tid_of(a.wv);
    const unsigned* selw = (const unsigned*)(a.ws + MB_SELW);
    unsigned* cnt = (unsigned*)(a.ws + WS_CTL) + CW_MBCNT; unsigned* cur = (unsigned*)(a.ws + WS_CTL) + CW_MBCUR;
    unsigned* list = (unsigned*)(a.ws + MB_LIST);
    LAS int* hist = (LAS int*)lds; LAS int* gb = hist + 64; LAS int* off = gb + 64;
    for (int u = blockIdx.x; u < 2048; u += gridDim.x) {
        const int bh = u & 31, qb = u >> 5;
        __syncthreads();
        if (tid < 64) hist[tid] = 0;
        if (tid >= 64 && tid < 128) { const int n = tid - 64; const int v = (int)xb_ld(cnt + bh * 64 + n); int inc = v;
#pragma unroll
            for (int o = 1; o < 64; o <<= 1) { const int tv = __shfl_up(inc, o); if (n >= o) inc += tv; }
            off[n] = inc - v; }
        __syncthreads();
        unsigned sp = 0xffffffffu; int lp[3] = {0, 0, 0};
        if (tid < 256) { sp = selw[(size_t)bh * SEQ + qb * 256 + tid];
#pragma unroll
            for (int k = 0; k < 3; ++k) { const unsigned n = (sp >> (8 * k)) & 255u; if (n < 64u) lp[k] = atomicAdd((int*)(hist + n), 1); } }
        __syncthreads();
        if (tid < 64 && hist[tid] > 0) gb[tid] = (int)xb_add(cur + bh * 64 + tid, (unsigned)hist[tid]);
        __syncthreads();
        if (tid < 256) {
#pragma unroll
            for (int k = 0; k < 3; ++k) { const unsigned n = (sp >> (8 * k)) & 255u;
                if (n < 64u) list[(size_t)bh * MB_LISTCAP + off[n] + gb[n] + lp[k]] = (unsigned)(qb * 256 + tid) | ((unsigned)k << 14); } }
    }
}
DI void moba_sel_phase(const Args& a, LAS unsigned char* lds) {
    int tid = tid_of(a.wv); asm volatile("" : "+v"(tid));
    const int lane = tid & 63, wave = __builtin_amdgcn_readfirstlane(tid >> 6), c = lane & 31, h = lane >> 5;
    const bf16_t* qkv = (const bf16_t*)(a.ws + WS_BIG);
    const unsigned* cnt = (const unsigned*)(a.ws + WS_CTL) + CW_MBCNT;
    const unsigned* list = (const unsigned*)(a.ws + MB_LIST);
    bf16_t* osel = (bf16_t*)(a.ws + WS_BIG + BIG_OSEL); float* lsesel = (float*)(a.ws + WS_BIG + BIG_LSESEL);
    const float* biasG = (const float*)(a.ws + WS_BIASG);
    LAS unsigned char* kbuf = lds; LAS unsigned char* vbuf = lds + 2 * KV_TILE_BYTES;
    LAS float* btab = (LAS float*)(lds + 4 * KV_TILE_BYTES);
    LAS int* cs = (LAS int*)(lds + 4 * KV_TILE_BYTES + BT_LEN * 4);
    LAS int* eo = cs + 2052;
    LAS int* part = eo + 2052;
    { int cc[4], ee[4], sc = 0, se = 0;
#pragma unroll
      for (int j = 0; j < 4; ++j) { const int v = (int)xb_ld((unsigned*)cnt + tid * 4 + j); ee[j] = se; cc[j] = sc; se += v; sc += (v + 255) >> 8; }
      part[tid] = sc; part[512 + tid] = se;
      __syncthreads();
      if (tid == 0) { int a0 = 0, a1 = 0; for (int i = 0; i < 512; ++i) { const int v0 = part[i], v1 = part[512 + i]; part[i] = a0; part[512 + i] = a1; a0 += v0; a1 += v1; } cs[2048] = a0; eo[2048] = a1; }
      __syncthreads();
#pragma unroll
      for (int j = 0; j < 4; ++j) { cs[tid * 4 + j] = part[tid] + cc[j]; eo[tid * 4 + j] = part[512 + tid] + ee[j]; }
      __syncthreads(); }
    const int NC = cs[2048];
    int cur_hh = -1;
    for (int u = blockIdx.x; u < NC; u += gridDim.x) {
        int lo = 0, hi = 2047;
        while (lo < hi) { const int mid = (lo + hi + 1) >> 1; if (cs[mid] <= u) lo = mid; else hi = mid - 1; }
        const int item = lo, bh = item >> 6, n = item & 63, b = bh >> 4, hh = bh & 15;
        const int chunk = u - cs[item], nent = (int)xb_ld((unsigned*)cnt + item) - chunk * 256;
        const size_t ebase = (size_t)bh * MB_LISTCAP + (eo[item] - eo[bh * 64]) + chunk * 256;
        __syncthreads();
        if (hh != cur_hh) { load_bias_table(btab, biasG, hh, 0, tid); cur_hh = hh; }
        const int e = 32 * wave + c; const bool ev = e < nent;
        const unsigned ent = list[ebase + (ev ? e : 0)];
        const int t = ent & 16383, slot = ent >> 14;
        bf16x8 Q[4];
        { const bf16_t* qrow = qkv + ((size_t)b * SEQ + t) * 3072 + hh * 64;
#pragma unroll
          for (int ks = 0; ks < 4; ++ks) Q[ks] = *(const bf16x8*)(qrow + 16 * ks + 8 * h); }
        const bf16_t* kb = qkv + (size_t)b * SEQ * 3072 + 1024 + hh * 64; const bf16_t* vb = kb + 1024;
        f32x16 O[2]; O[0] = zero16(); O[1] = zero16();
        float m = -1e30f, l = 0.f;
        u32x4 kr, vr; int buf = 0;
        kv_fetch(kr, vr, kb, vb, 3072, n * 256, SEQ, tid); kv_store(kbuf, vbuf, kr, vr, tid);
        __syncthreads();
        for (int j = 0; j < 4; ++j) {
            if (j < 3) kv_fetch(kr, vr, kb, vb, 3072, n * 256 + 64 * (j + 1), SEQ, tid);
            const int k0 = n * 256 + 64 * j;
            if (32 * wave < nent) {
                const LAS unsigned char* kl = kbuf + buf * KV_TILE_BYTES; const LAS unsigned char* vl = vbuf + buf * KV_TILE_BYTES;
                f32x16 S[2]; S[0] = qk_tile(kl, 0, Q, lane); S[1] = qk_tile(kl, 1, Q, lane);
                softmax_tile<1, false>(S, m, l, O, btab, t - k0, h, 0, (unsigned)DIST_ANY);
                pv_tile(vl, 0, S[0], O, lane); pv_tile(vl, 1, S[1], O, lane);
            }
            if (j < 3) kv_store(kbuf + (buf ^ 1) * KV_TILE_BYTES, vbuf + (buf ^ 1) * KV_TILE_BYTES, kr, vr, tid);
            __syncthreads();
            buf ^= 1;
        }
        if (ev) { const size_t ob = ((size_t)bh * SEQ + t) * 3 + slot;
            store_o(osel + ob * 64, O, 1.f / l, h);
            if (h == 0) lsesel[ob] = m + __builtin_amdgcn_logf(l); }
    }
}
DI void moba_own_phase(const Args& a, LAS unsigned char* lds) {
    int tid = tid_of(a.wv); asm volatile("" : "+v"(tid));
    const int lane = tid & 63, wave = __builtin_amdgcn_readfirstlane(tid >> 6), c = lane & 31, h = lane >> 5;
    const bf16_t* qkv = (const bf16_t*)(a.ws + WS_BIG);
    const bf16_t* osel = (const bf16_t*)(a.ws + WS_BIG + BIG_OSEL); const float* lsesel = (const float*)(a.ws + WS_BIG + BIG_LSESEL);
    bf16_t* outb = (bf16_t*)(a.ws + WS_ACTB);
    const float* biasG = (const float*)(a.ws + WS_BIASG);
    LAS unsigned char* kbuf = lds; LAS unsigned char* vbuf = lds + 2 * KV_TILE_BYTES;
    LAS float* btab = (LAS float*)(lds + 4 * KV_TILE_BYTES);
    int cur_hh = -1;
    for (int u = blockIdx.x; u < 2048; u += gridDim.x) {
        const int bh = u & 31, qb = u >> 5, b = bh >> 4, hh = bh & 15;
        const int q0w = qb * 256 + 32 * wave, t = q0w + c;
        __syncthreads();
        if (hh != cur_hh) { load_bias_table(btab, biasG, hh, 0, tid); cur_hh = hh; }
        bf16x8 Q[4];
        { const bf16_t* qrow = qkv + ((size_t)b * SEQ + t) * 3072 + hh * 64;
#pragma unroll
          for (int ks = 0; ks < 4; ++ks) Q[ks] = *(const bf16x8*)(qrow + 16 * ks + 8 * h); }
        const bf16_t* kb = qkv + (size_t)b * SEQ * 3072 + 1024 + hh * 64; const bf16_t* vb = kb + 1024;
        f32x16 O[2]; O[0] = zero16(); O[1] = zero16();
        float m = -1e30f, l = 0.f;
        u32x4 kr, vr; int buf = 0;
        kv_fetch(kr, vr, kb, vb, 3072, qb * 256, SEQ, tid); kv_store(kbuf, vbuf, kr, vr, tid);
        __syncthreads();
        for (int j = 0; j < 4; ++j) {
            if (j < 3) kv_fetch(kr, vr, kb, vb, 3072, qb * 256 + 64 * (j + 1), SEQ, tid);
            const int k0 = qb * 256 + 64 * j;
            if (k0 <= q0w + 31) {
                const LAS unsigned char* kl = kbuf + buf * KV_TILE_BYTES; const LAS unsigned char* vl = vbuf + buf * KV_TILE_BYTES;
                f32x16 S[2]; S[0] = qk_tile(kl, 0, Q, lane); S[1] = qk_tile(kl, 1, Q, lane);
                softmax_tile<1, false>(S, m, l, O, btab, t - k0, h, 0, (unsigned)DIST_ANY);
                pv_tile(vl, 0, S[0], O, lane); pv_tile(vl, 1, S[1], O, lane);
            }
            if (j < 3) kv_store(kbuf + (buf ^ 1) * KV_TILE_BYTES, vbuf + (buf ^ 1) * KV_TILE_BYTES, kr, vr, tid);
            __syncthreads();
            buf ^= 1;
        }
        const int nv = qb < 3 ? qb : 3;
        const float lown = m + __builtin_amdgcn_logf(l);
        float ls[3]; float mx = lown;
        const size_t ob = ((size_t)bh * SEQ + t) * 3;
#pragma unroll
        for (int k = 0; k < 3; ++k) { ls[k] = (k < nv) ? lsesel[ob + k] : -1e30f; mx = fmaxf(mx, ls[k]); }
        float wown = __builtin_amdgcn_exp2f(lown - mx), wsum = wown, wk[3];
#pragma unroll
        for (int k = 0; k < 3; ++k) { wk[k] = (k < nv) ? __builtin_amdgcn_exp2f(ls[k] - mx) : 0.f; wsum += wk[k]; }
        const float inv = 1.f / wsum; wown *= inv / l;
#pragma unroll
        for (int dt = 0; dt < 2; ++dt)
#pragma unroll
            for (int i = 0; i < 16; ++i) O[dt][i] *= wown;
#pragma unroll
        for (int k = 0; k < 3; ++k) if (k < nv) { const float w = wk[k] * inv; const bf16_t* orow = osel + (ob + k) * 64;
#pragma unroll
            for (int dt = 0; dt < 2; ++dt)
#pragma unroll
                for (int g = 0; g < 4; ++g) { const u32x2 v = *(const u32x2*)(orow + dt * 32 + 8 * g + 4 * h);
                    O[dt][4 * g] += w * bf_lo(v.x); O[dt][4 * g + 1] += w * bf_hi(v.x); O[dt][4 * g + 2] += w * bf_lo(v.y); O[dt][4 * g + 3] += w * bf_hi(v.y); } }
        store_o(outb + ((size_t)b * SEQ + t) * D + hh * 64, O, 1.f, h);
    }
}

constexpr size_t NS_Q = 0, NS_KV = 64 * MiB, NS_GT = 164 * MiB, NS_HID = 172 * MiB, NS_KC = 180 * MiB, NS_KFR = 182 * MiB, NS_VFR = 198 * MiB;
DI void nsa_kcvc_phase(const Args& a, LAS unsigned char* lds) {
    int tid = tid_of(a.wv); asm volatile("" : "+v"(tid));
    {
        const bf16_t* kv6 = (const bf16_t*)(a.ws + WS_BIG + NS_KV); u32x4* kfr = (u32x4*)(a.ws + WS_BIG + NS_KFR); u32x4* vfr = (u32x4*)(a.ws + WS_BIG + NS_VFR);
        for (int tl = blockIdx.x; tl < 2048; tl += gridDim.x) {
            const int bg = tl >> 8, t0 = (tl & 255) * 64, b = bg >> 2, g = bg & 3;
            __syncthreads();
            { const int row = tid >> 3, c16 = tid & 7; const bf16_t* src_ = kv6 + ((size_t)b * SEQ + t0 + row) * 1536 + 2 * 256 + g * 64 + c16 * 8;
              *(LAS u32x4*)(lds + row * KSTR + c16 * 16) = *(const u32x4*)src_; *(LAS u32x4*)(lds + KV_TILE_BYTES + row * KSTR + c16 * 16) = *(const u32x4*)(src_ + 256); }
            __syncthreads();
            { const int f = tid >> 6, ln = tid & 63, r31 = ln & 31, hh = ln >> 5;
              { const int kt = f >> 2, ks = f & 3, pr = (r31 & ~12) | ((r31 & 4) << 1) | ((r31 & 8) >> 1);
                kfr[((size_t)tl * 8 + f) * 64 + ln] = *(const LAS u32x4*)(lds + (kt * 32 + pr) * KSTR + (16 * ks + 8 * hh) * 2); }
              { const int kt = f >> 2, s = (f >> 1) & 1, dt = f & 1; unsigned v[8];
#pragma unroll
                for (int i = 0; i < 8; ++i) v[i] = *(const LAS unsigned short*)(lds + KV_TILE_BYTES + (kt * 32 + 16 * s + 8 * hh + i) * KSTR + (dt * 32 + r31) * 2);
                u32x4 w; w.x = v[0] | (v[1] << 16); w.y = v[2] | (v[3] << 16); w.z = v[4] | (v[5] << 16); w.w = v[6] | (v[7] << 16);
                vfr[((size_t)tl * 8 + f) * 64 + ln] = w; } }
        }
    }
    const int lane = tid & 63, wave = __builtin_amdgcn_readfirstlane(tid >> 6), c = lane & 31, h = lane >> 5;
    const bf16_t* hidden = (const bf16_t*)(a.ws + WS_BIG + NS_HID); const bf16_t* w2t = (const bf16_t*)(a.ws + WS_WCMP) + 2 * 256 * 2048;
    bf16_t* kcvc = (bf16_t*)(a.ws + WS_BIG + NS_KC);
    for (int task = blockIdx.x * NWAVES + wave; task < 512; task += gridDim.x * NWAVES) {
        const int j = task >> 8, R0 = (task & 255) * 32;
        const bf16_t* hid = hidden + ((size_t)j * 8192 + R0 + c) * 256; const bf16_t* w2 = w2t + j * 64 * 256;
        f32x16 acc[2]; acc[0] = zero16(); acc[1] = zero16();
#pragma unroll
        for (int ks = 0; ks < 16; ++ks) { const bf16x8 Bv = *(const bf16x8*)(hid + 16 * ks + 8 * h);
#pragma unroll
            for (int dt = 0; dt < 2; ++dt) { const bf16x8 Av = *(const bf16x8*)(w2 + (dt * 32 + c) * 256 + 16 * ks + 8 * h); acc[dt] = mfma32(Av, Bv, acc[dt]); } }
        store_o(kcvc + ((size_t)j * 8192 + R0 + c) * 64, acc, 1.f, h);
    }
}
DI void nsa_attn_phase(const Args& a, LAS unsigned char* lds) {
    const int wave = a.wv;
#define NSA_VARS int tid = tid_of(a.wv); const int lane = tid & 63, c = lane & 31, h = lane >> 5, qi = c >> 2, r = c & 3, t = tw0 + qi; \
    const LAS float* bt = btab + r * (BT_LEN + 8); const float* gtp = gates + (tokbase + t) * 48 + 4 * g + r; (void)bt; (void)h; (void)lane; (void)gtp;
    const bf16_t* qb_ = (const bf16_t*)(a.ws + WS_BIG + NS_Q); const bf16_t* kv6 = (const bf16_t*)(a.ws + WS_BIG + NS_KV);
    const float* gates = (const float*)(a.ws + WS_BIG + NS_GT); const bf16_t* kcvc = (const bf16_t*)(a.ws + WS_BIG + NS_KC);
    bf16_t* outb = (bf16_t*)(a.ws + WS_ACTB); const float* biasG = (const float*)(a.ws + WS_BIASG);
    LAS unsigned char* ring = lds;
    LAS float* imp = (LAS float*)(lds + 49152);
    LAS float* btab = (LAS float*)(lds + 116736);
    LAS unsigned* selm = (LAS unsigned*)(lds + 151808);
    LAS unsigned* wm = selm + 512;
    LAS int* blist = (LAS int*)(wm + 64);
    LAS int* Oacc = (LAS int*)imp;
    constexpr int OAS = 66;
    LAS int* lacc = (LAS int*)(lds + 155392);
    constexpr float FXS = 16384.f;
    LAS float* mref = (LAS float*)(lds + 156416);
    LAS unsigned long long* qmask = (LAS unsigned long long*)(lds + 157440);
    LAS int* qsel = (LAS int*)(lds + 159488);
    const bf16x8* kfr = (const bf16x8*)(a.ws + WS_BIG + NS_KFR); const bf16x8* vfr = (const bf16x8*)(a.ws + WS_BIG + NS_VFR);
    int cur_g = -1;
    unsigned* nsa_ctr = (unsigned*)(a.ws + WS_CTL) + CW_NSAQ;
    volatile LAS int* uword = (volatile LAS int*)(lds + MISC_OFF + 160);
    for (;;) {
        const int bg = blockIdx.x & 7;
        __syncthreads();
        if (tid_of(a.wv) == 0) *uword = (int)xb_add(nsa_ctr + bg * 64, 1u);
        __syncthreads();
        const int uidx = *uword; if (uidx >= 256) break;
        const int tile = 255 - uidx, b = bg >> 2, g = bg & 3;
        const int T0 = tile * 64, tw0 = T0 + 8 * wave;
        const size_t tokbase = (size_t)b * SEQ;
        __syncthreads();
        bf16x8 Q[4];
        { NSA_VARS
          if (g != cur_g) { for (int rr = 0; rr < 4; ++rr) load_bias_table(btab + rr * (BT_LEN + 8), biasG, 4 * g + rr, 0, tid); cur_g = g; }
          for (int i = tid; i < 64 * 260; i += NTHR) imp[i] = 0.f;
          const bf16_t* qrow = qb_ + (tokbase + t) * 1024 + (4 * g + r) * 64;
#pragma unroll
          for (int ks = 0; ks < 4; ++ks) Q[ks] = *(const bf16x8*)(qrow + 16 * ks + 8 * h); }
        f32x16 OUT[2]; OUT[0] = zero16(); OUT[1] = zero16();
        const int nct = (T0 + 63 >= 31) ? (((T0 + 32) >> 4) >> 6) + 1 : 0;
        const int j0w = (T0 >= 511) ? ((T0 - 511) >> 6) : 0, nwin = tile - j0w + 1, nd = tile >= 2 ? 3 : tile + 1;
        const int e1 = nct, e2 = 2 * nct, e3 = e2 + nwin, e4 = e3 + nd;
        const bf16_t* kcb = kcvc + (size_t)bg * 1024 * 64; const bf16_t* vcb = kcb + (size_t)8192 * 64;
        const bf16_t* kvb = kv6 + tokbase * 1536 + g * 64;
        f32x16 O[2]; O[0] = zero16(); O[1] = zero16();
        float m = -1e30f, l = 0.f, mc = -1e30f, lc = 0.f, invl = 0.f, mfin = 0.f;
        __syncthreads();
        kv_dma_stream<3>(e4, [&](int fi, LAS unsigned char* slot) {
                const int lane = tid_of(a.wv) & 63;
                if (fi < e2) kv_dma_issue(slot, kcb, vcb, 64, 64 * (fi < e1 ? fi : fi - e1), 1024, wave, lane);
                else if (fi < e3) kv_dma_issue(slot, kvb + 4 * 256, kvb + 5 * 256, 1536, (j0w + fi - e2) * 64, SEQ, wave, lane);
                else { const int i = fi - e3, blk = (i == 0) ? 0 : (tile >= 2 ? tile - 2 + i : i); kv_dma_issue(slot, kvb + 2 * 256, kvb + 3 * 256, 1536, blk * 64, SEQ, wave, lane); }
            }, [&](int fi, const LAS unsigned char* kl, const LAS unsigned char* vl) {
                NSA_VARS
                if (fi < e1) {
                    const int c0 = 64 * fi;
                    if (16 * c0 + 31 <= tw0 + 7) {
                        f32x16 S[2]; S[0] = qk_tile_sw(kl, 0, Q, lane); S[1] = qk_tile_sw(kl, 1, Q, lane);
                        stats_tile<16, false>(S, mc, lc, bt, t - 16 * c0 - 31, h, 0, (unsigned)DIST_ANY);
                    }
                } else if (fi < e2) {
                    if (fi == e1) { invl = lc > 0.f ? 1.f / lc : 0.f; mfin = (mc <= -1e30f) ? 0.f : mc; }
                    const int c0 = 64 * (fi - e1);
                    if (16 * c0 + 31 <= tw0 + 7) {
                        f32x16 S[2]; S[0] = qk_tile_sw(kl, 0, Q, lane); S[1] = qk_tile_sw(kl, 1, Q, lane);
                        (void)logits_tile<16, false>(S, bt, t - 16 * c0 - 31, h, 0, (unsigned)DIST_ANY);
#pragma unroll
                        for (int sub = 0; sub < 2; ++sub)
#pragma unroll
                            for (int i = 0; i < 16; ++i) S[sub][i] = __builtin_amdgcn_exp2f(S[sub][i] - mfin) * invl;
#pragma unroll
                        for (int sub = 0; sub < 2; ++sub)
#pragma unroll
                            for (int s = 0; s < 2; ++s) { const int j0 = (c0 + sub * 32 + 16 * s + 8 * h) >> 2;
                                float a0 = (S[sub][8 * s] + S[sub][8 * s + 1]) + (S[sub][8 * s + 2] + S[sub][8 * s + 3]);
                                float a1 = (S[sub][8 * s + 4] + S[sub][8 * s + 5]) + (S[sub][8 * s + 6] + S[sub][8 * s + 7]) + S[sub][8 * s + 3];
                                float a2 = S[sub][8 * s + 7];
                                a0 += quad_xor1(a0); a1 += quad_xor1(a1); a2 += quad_xor1(a2);
                                a0 += quad_xor2(a0); a1 += quad_xor2(a1); a2 += quad_xor2(a2);
                                if (r == 0) { LAS float* ip = imp + (8 * wave + qi) * 260 + j0; atomicAdd((float*)ip, a0); atomicAdd((float*)(ip + 1), a1); atomicAdd((float*)(ip + 2), a2); } }
                        pv_tile_sw(vl, 0, S[0], O, lane); pv_tile_sw(vl, 1, S[1], O, lane);
                    }
                    if (fi == e2 - 1) { const float gt_cmp = gtp[0];
#pragma unroll
                        for (int dt = 0; dt < 2; ++dt)
#pragma unroll
                            for (int i = 0; i < 16; ++i) { OUT[dt][i] += gt_cmp * O[dt][i]; O[dt][i] = 0.f; } }
                } else if (fi < e3) {
                    const int k0 = (j0w + fi - e2) * 64;
                    if (k0 <= tw0 + 7 && k0 + 63 >= tw0 - 511) {
                        f32x16 S[2]; S[0] = qk_tile_sw(kl, 0, Q, lane); S[1] = qk_tile_sw(kl, 1, Q, lane);
                        if (k0 >= tw0 + 7 - 511) softmax_tile<1, false>(S, m, l, O, bt, t - k0, h, 0, 511u);
                        else softmax_tile<1, true>(S, m, l, O, bt, t - k0, h, 0, 511u);
                        pv_tile_sw(vl, 0, S[0], O, lane); pv_tile_sw(vl, 1, S[1], O, lane);
                    }
                    if (fi == e3 - 1) { const float sc_ = gtp[32] / l;
#pragma unroll
                        for (int dt = 0; dt < 2; ++dt)
#pragma unroll
                            for (int i = 0; i < 16; ++i) { OUT[dt][i] += sc_ * O[dt][i]; O[dt][i] = 0.f; }
                        m = -1e30f; l = 0.f; }
                } else {
                    const int i = fi - e3, blk = (i == 0) ? 0 : (tile >= 2 ? tile - 2 + i : i), k0 = blk * 64;
                    f32x16 S[2]; S[0] = qk_tile_sw(kl, 0, Q, lane); S[1] = qk_tile_sw(kl, 1, Q, lane);
                    softmax_tile<1, false>(S, m, l, O, bt, t - k0, h, 0, (unsigned)DIST_ANY);
                    pv_tile_sw(vl, 0, S[0], O, lane); pv_tile_sw(vl, 1, S[1], O, lane);
                }
            }, ring);
        __syncthreads();
#pragma unroll 1
        for (int qh = 0; qh < 2; ++qh) {
            const int lane = tid_of(a.wv) & 63;
            const int cur = tile;
            unsigned key[4][4];
#pragma unroll
            for (int q4 = 0; q4 < 4; ++q4) { const int ql = 8 * wave + 4 * qh + q4;
#pragma unroll
                for (int kk = 0; kk < 4; ++kk) { const int j = lane + 64 * kk; const bool forced = (j == 0) || (j == cur) || (j + 1 == cur);
                    key[q4][kk] = forced ? 0xffffffffu : ((j <= cur) ? f2u(imp[ql * 260 + j]) + 1u : 0u); } }
            unsigned prefix[4] = {0u, 0u, 0u, 0u};
#pragma unroll 1
            for (int bit = 31; bit >= 0; --bit) {
#pragma unroll
                for (int q4 = 0; q4 < 4; ++q4) { const unsigned cand = prefix[q4] | (1u << bit); int cnt = 0;
#pragma unroll
                    for (int kk = 0; kk < 4; ++kk) cnt += __popcll(__ballot(key[q4][kk] >= cand));
                    if (cnt >= 16) prefix[q4] = cand; } }
            const unsigned long long ltmask = (1ull << lane) - 1ull;
#pragma unroll
            for (int q4 = 0; q4 < 4; ++q4) { const int ql = 8 * wave + 4 * qh + q4; const unsigned pf = prefix[q4];
                int cgt = 0;
#pragma unroll
                for (int kk = 0; kk < 4; ++kk) cgt += __popcll(__ballot(key[q4][kk] > pf));
                const int need = 16 - cgt; int running = 0;
#pragma unroll
                for (int kk = 0; kk < 4; ++kk) { const unsigned long long eqb = __ballot(key[q4][kk] == pf);
                    const bool take = key[q4][kk] > pf || (pf != 0u && key[q4][kk] == pf && running + __popcll(eqb & ltmask) < need);
                    running += __popcll(eqb);
                    const unsigned long long bal = __ballot(take);
                    if (lane == 0) { selm[ql * 8 + 2 * kk] = (unsigned)bal; selm[ql * 8 + 2 * kk + 1] = (unsigned)(bal >> 32); } } }
        }
        __syncthreads();
        { const int tid = tid_of(a.wv);
          if (tid < 8) { unsigned o = 0u;
              if (tid == 0) o |= 1u;
              if ((tile >> 5) == tid) o |= 1u << (tile & 31);
              if (tile >= 1 && ((tile - 1) >> 5) == tid) o |= 1u << ((tile - 1) & 31);
              wm[tid] = o; } }
        __syncthreads();
        { const int lane = tid_of(a.wv) & 63;
#pragma unroll 1
          for (int jj = 0; jj < 32; ++jj) { const int j = wave * 32 + jj; const unsigned w = selm[lane * 8 + (j >> 5)] & ~wm[j >> 5];
              const unsigned long long bal = __ballot((w >> (j & 31)) & 1u); if (lane == 0) qmask[j] = bal; } }
        {
            NSA_VARS
            LAS int* oa = Oacc + ((8 * wave + qi) * 4 + r) * OAS;
#pragma unroll
            for (int dt = 0; dt < 2; ++dt)
#pragma unroll
                for (int g4 = 0; g4 < 4; ++g4) { u32x2 w0, w1; w0.x = (unsigned)(int)(O[dt][4 * g4] * FXS); w0.y = (unsigned)(int)(O[dt][4 * g4 + 1] * FXS); w1.x = (unsigned)(int)(O[dt][4 * g4 + 2] * FXS); w1.y = (unsigned)(int)(O[dt][4 * g4 + 3] * FXS);
                    *(LAS u32x2*)(oa + dt * 32 + 8 * g4 + 4 * h) = w0; *(LAS u32x2*)(oa + dt * 32 + 8 * g4 + 4 * h + 2) = w1; }
            if (h == 0) { lacc[(8 * wave + qi) * 4 + r] = (int)(l * FXS); mref[(8 * wave + qi) * 4 + r] = m; }
        }
        __syncthreads();
        {
            NSA_VARS
            LAS int* qs = qsel + wave * 8;
            const unsigned long long ltm = (1ull << lane) - 1ull;
            int j = wave; unsigned long long qm = 0ull;
            while (j <= tile) { qm = qmask[j]; if (qm != 0ull) break; j += 8; }
            if (j <= tile) {
                int n = __popcll(qm), ch = 0;
                if ((qm >> lane) & 1ull) { const int rk = __popcll(qm & ltm); if (rk < 8) qs[rk] = lane; }
                bool lv = qi < n; int ql = qs[lv ? qi : 0];
                bf16x8 KA[2][4], VA[2][2][2], Qs[4];
                { const bf16x8* kp = kfr + ((size_t)(bg * 256 + j) * 8) * 64 + lane; const bf16x8* vp = vfr + ((size_t)(bg * 256 + j) * 8) * 64 + lane;
                  const bf16_t* qrow = qb_ + (tokbase + T0 + ql) * 1024 + (4 * g + r) * 64;
#pragma unroll
                  for (int ks = 0; ks < 4; ++ks) Qs[ks] = *(const bf16x8*)(qrow + 16 * ks + 8 * h);
#pragma unroll
                  for (int f8 = 0; f8 < 8; ++f8) KA[f8 >> 2][f8 & 3] = kp[f8 * 64];
#pragma unroll
                  for (int f8 = 0; f8 < 8; ++f8) VA[f8 >> 2][(f8 >> 1) & 1][f8 & 1] = vp[f8 * 64]; }
#pragma unroll 1
                for (;;) {
                    int jn = j, chn = ch + 1, nn = n; unsigned long long qmn = qm;
                    if (chn * 8 >= n) { chn = 0; jn = j + 8; qmn = 0ull; while (jn <= tile) { qmn = qmask[jn]; if (qmn != 0ull) break; jn += 8; } nn = __popcll(qmn); }
                    const bool has_next = jn <= tile, newblk = jn != j;
                    f32x16 S[2];
#pragma unroll
                    for (int kt = 0; kt < 2; ++kt) { S[kt] = zero16();
#pragma unroll
                        for (int ks = 0; ks < 4; ++ks) S[kt] = mfma32(KA[kt][ks], Qs[ks], S[kt]); }
                    const int tq = T0 + ql, D0 = tq - j * 64;
                    const float mr = mref[ql * 4 + r];
                    LAS int* oa = Oacc + (ql * 4 + r) * OAS + 4 * h; LAS int* la = lacc + ql * 4 + r;
                    const bool lvc = lv;
                    if (has_next) {
                        if ((qmn >> lane) & 1ull) { const int rk = __popcll(qmn & ltm) - 8 * chn; if (rk >= 0 && rk < 8) qs[rk] = lane; }
                        lv = qi < nn - 8 * chn; ql = qs[lv ? qi : 0];
                        const bf16_t* qrow = qb_ + (tokbase + T0 + ql) * 1024 + (4 * g + r) * 64;
#pragma unroll
                        for (int ks = 0; ks < 4; ++ks) Qs[ks] = *(const bf16x8*)(qrow + 16 * ks + 8 * h);
                        if (newblk) { const bf16x8* kp = kfr + ((size_t)(bg * 256 + jn) * 8) * 64 + lane;
#pragma unroll
                            for (int f8 = 0; f8 < 8; ++f8) KA[f8 >> 2][f8 & 3] = kp[f8 * 64]; }
                    }
                    (void)logits_tile<1, false>(S, bt, D0, h, 0, (unsigned)DIST_ANY);
                    float ls = 0.f;
#pragma unroll
                    for (int kt = 0; kt < 2; ++kt)
#pragma unroll
                        for (int i = 0; i < 16; ++i) { const float p = lvc ? __builtin_amdgcn_exp2f(S[kt][i] - mr) : 0.f; S[kt][i] = p; ls += p; }
                    ls += xor32h(ls, h);
                    f32x16 Oa[2]; Oa[0] = zero16(); Oa[1] = zero16();
#pragma unroll
                    for (int kt = 0; kt < 2; ++kt)
#pragma unroll
                        for (int s = 0; s < 2; ++s) {
                            u32x4 pk; pk.x = cvt_pk_bf16(S[kt][8 * s + 0], S[kt][8 * s + 1]); pk.y = cvt_pk_bf16(S[kt][8 * s + 2], S[kt][8 * s + 3]); pk.z = cvt_pk_bf16(S[kt][8 * s + 4], S[kt][8 * s + 5]); pk.w = cvt_pk_bf16(S[kt][8 * s + 6], S[kt][8 * s + 7]);
                            const bf16x8 Bp = __builtin_bit_cast(bf16x8, pk);
                            Oa[0] = mfma32(VA[kt][s][0], Bp, Oa[0]); Oa[1] = mfma32(VA[kt][s][1], Bp, Oa[1]); }
                    if (has_next && newblk) { const bf16x8* vp = vfr + ((size_t)(bg * 256 + jn) * 8) * 64 + lane;
#pragma unroll
                        for (int f8 = 0; f8 < 8; ++f8) VA[f8 >> 2][(f8 >> 1) & 1][f8 & 1] = vp[f8 * 64]; }
                    if (lvc) {
#pragma unroll
                        for (int dt = 0; dt < 2; ++dt)
#pragma unroll
                            for (int i = 0; i < 16; ++i) atomicAdd((int*)(oa + dt * 32 + (i & 3) + 8 * (i >> 2)), (int)(Oa[dt][i] * FXS));
                        if (h == 0) atomicAdd((int*)la, (int)(ls * FXS)); }
                    if (!has_next) break;
                    j = jn; ch = chn; qm = qmn; n = nn;
                }
            }
        }
        __syncthreads();
        {
            NSA_VARS
            const float gt_sel = gtp[16];
            const LAS int* oa = Oacc + ((8 * wave + qi) * 4 + r) * OAS;
            const float sc_ = gt_sel / (float)lacc[(8 * wave + qi) * 4 + r];
#pragma unroll
            for (int dt = 0; dt < 2; ++dt)
#pragma unroll
                for (int g4 = 0; g4 < 4; ++g4) { const u32x2 v0 = *(const LAS u32x2*)(oa + dt * 32 + 8 * g4 + 4 * h), v1 = *(const LAS u32x2*)(oa + dt * 32 + 8 * g4 + 4 * h + 2);
                    OUT[dt][4 * g4] += sc_ * (float)(int)v0.x; OUT[dt][4 * g4 + 1] += sc_ * (float)(int)v0.y; OUT[dt][4 * g4 + 2] += sc_ * (float)(int)v1.x; OUT[dt][4 * g4 + 3] += sc_ * (float)(int)v1.y; }
        }
        { NSA_VARS
          store_o(outb + (tokbase + t) * D + (4 * g + r) * 64, OUT, 1.f, h); }
    }
#undef NSA_VARS
}

DI void sb_phase(const Args& a, LAS unsigned char* lds) {
    int tid = tid_of(a.wv); asm volatile("" : "+v"(tid));
    const int lane = tid & 63, wave = __builtin_amdgcn_readfirstlane(tid >> 6), c = lane & 31, h = lane >> 5;
    const bf16_t* qkv = (const bf16_t*)(a.ws + WS_BIG);
    bf16_t* outb = (bf16_t*)(a.ws + WS_ACTB);
    LAS unsigned char* kbuf = lds; LAS unsigned char* vbuf = lds + 2 * KV_TILE_BYTES;
    volatile LAS int* flags = (volatile LAS int*)(lds + 4 * KV_TILE_BYTES);
    for (int u = blockIdx.x; u < 2048; u += gridDim.x) {
        const int qb = u & 63, hh = (u >> 6) & 15, b = u >> 10;
        const int q0w = qb * 256 + 32 * wave, t = q0w + c;
        const size_t tokbase = (size_t)b * SEQ;
        const bf16_t* kb = qkv + tokbase * 3072 + 1024 + hh * 64;
        const bf16_t* vb = qkv + tokbase * 3072 + 2048 + hh * 64;
        bf16x8 Q[4];
        { const bf16_t* qrow = qkv + (tokbase + t) * 3072 + hh * 64;
#pragma unroll
          for (int ks = 0; ks < 4; ++ks) Q[ks] = *(const bf16x8*)(qrow + 16 * ks + 8 * h); }
        f32x16 O[2]; O[0] = zero16(); O[1] = zero16();
        float carry = 1.f; bool wdone = false;
        int jt = qb * 4 + 3, buf = 0;
        u32x4 kr, vr;
        kv_fetch(kr, vr, kb, vb, 3072, jt * 64, SEQ, tid); kv_store(kbuf, vbuf, kr, vr, tid);
        __syncthreads();
        for (; jt >= 0; --jt) {
            if (jt > 0) kv_fetch(kr, vr, kb, vb, 3072, (jt - 1) * 64, SEQ, tid);
            const int kb0 = jt * 64;
            if (!wdone && kb0 < q0w + 31) {
                const LAS unsigned char* kl = kbuf + buf * KV_TILE_BYTES; const LAS unsigned char* vl = vbuf + buf * KV_TILE_BYTES;
                f32x16 SP[2], U[2];
                SP[0] = qk_tile(kl, 0, Q, lane); SP[1] = qk_tile(kl, 1, Q, lane);
                float Tc[2][2];
#pragma unroll
                for (int sub = 0; sub < 2; ++sub)
#pragma unroll
                    for (int s = 0; s < 2; ++s) { float acc = 1.f;
#pragma unroll
                        for (int j = 0; j < 8; ++j) { const int i = 8 * s + j; const int key = kb0 + sub * 32 + 16 * s + 8 * h + j;
                            const float z = __builtin_amdgcn_fmed3f(SP[sub][i] * 0.125f, -60.f, 60.f);
                            const float e = __builtin_amdgcn_exp2f(z * LOG2E);
                            const float u = __builtin_amdgcn_rcpf(1.f + e);
                            const bool valid = key < t;
                            SP[sub][i] = valid ? e * u : 0.f; U[sub][i] = valid ? u : 1.f; acc *= U[sub][i]; }
                        Tc[sub][s] = acc; }
                float Tp[2][2], pr[2][2];
#pragma unroll
                for (int sub = 0; sub < 2; ++sub)
#pragma unroll
                    for (int s = 0; s < 2; ++s) { Tp[sub][s] = xor32h(Tc[sub][s], h); pr[sub][s] = Tc[sub][s] * Tp[sub][s]; }
                float offp[2][2];
                offp[1][1] = carry; offp[1][0] = offp[1][1] * pr[1][1]; offp[0][1] = offp[1][0] * pr[1][0]; offp[0][0] = offp[0][1] * pr[0][1];
                carry = offp[0][0] * pr[0][0];
#pragma unroll
                for (int sub = 0; sub < 2; ++sub)
#pragma unroll
                    for (int s = 0; s < 2; ++s) { float run = offp[sub][s] * (h == 0 ? Tp[sub][s] : 1.f);
#pragma unroll
                        for (int j = 7; j >= 0; --j) { const int i = 8 * s + j; SP[sub][i] *= run; run *= U[sub][i]; } }
                pv_tile(vl, 0, SP[0], O, lane); pv_tile(vl, 1, SP[1], O, lane);
                wdone = __all(carry < 1e-38f);
            }
            if (lane == 0) flags[buf * 8 + wave] = wdone ? 1 : 0;
            if (jt > 0) kv_store(kbuf + (buf ^ 1) * KV_TILE_BYTES, vbuf + (buf ^ 1) * KV_TILE_BYTES, kr, vr, tid);
            __syncthreads();
            int alld = 1;
#pragma unroll
            for (int w = 0; w < 8; ++w) alld &= flags[buf * 8 + w];
            buf ^= 1;
            if (alld) break;
        }
        store_o(outb + (tokbase + t) * D + hh * 64, O, 1.f, h);
        __syncthreads();
    }
}

#ifndef DBG
#define DBG 0
#endif
#if DBG
DI float dbg_block_max(float v, LAS float* red) {
#pragma unroll
    for (int o = 1; o < 64; o <<= 1) v = fmaxf(v, __shfl_xor(v, o));
    __syncthreads();
    if ((threadIdx.x & 63) == 0) red[threadIdx.x >> 6] = v;
    __syncthreads();
    float r = red[0];
    for (int i = 1; i < 8; ++i) r = fmaxf(r, red[i]);
    __syncthreads();
    return r;
}
DI float dbg_block_sum(float v, LAS float* red) {
#pragma unroll
    for (int o = 1; o < 64; o <<= 1) v += __shfl_xor(v, o);
    __syncthreads();
    if ((threadIdx.x & 63) == 0) red[threadIdx.x >> 6] = v;
    __syncthreads();
    float r = 0.f;
    for (int i = 0; i < 8; ++i) r += red[i];
    __syncthreads();
    return r;
}
DI void dbg_note(unsigned* ctl, int idx, float err) { if (threadIdx.x == 0) atomicMax(ctl + CW_DBG + idx, __builtin_bit_cast(unsigned, err)); }
template <int layer>
DI void dbg_check(const Args& a, LAS unsigned char* lds, int stage, const MoeMeta& mm) {
    if (blockIdx.x >= 64) return;
    const int tid = threadIdx.x;
    const int t = blockIdx.x * 512 + (blockIdx.x * 37) % 512;
    LAS float* x1 = (LAS float*)(lds);
    LAS float* hh = x1 + 1024;
    LAS float* yy = hh + 512;
    LAS float* red = yy + 2048;
    LAS float* scl = red + 16;
    unsigned* ctl = (unsigned*)(a.ws + WS_CTL);
    float* dbgx1 = (float*)(a.ws + WS_SMALL) + blockIdx.x * 1024;
    const float* xout = a.out; const bf16_t* actb = (const bf16_t*)(a.ws + WS_ACTB);
    const u32x4 ti = *(const u32x4*)(a.ws + WS_TOKINFO + (size_t)t * 16);
    const int e0 = ti.x & 15, p0 = ti.x >> 4, e1 = ti.z & 15, p1 = ti.z >> 4;
    const float w0 = u2f(ti.y), w1 = u2f(ti.w);
    __syncthreads();
    if (tid == 0) { scl[16] = w0; scl[17] = w1; }
    __syncthreads();
    if (stage == 1) {
        const float* xin = (layer == 0) ? a.in[IN_X] : nullptr;
        if (xin) {
            float v0 = ALPHA * xin[(size_t)t * D + tid], v1 = ALPHA * xin[(size_t)t * D + tid + 512];
            const float mean = dbg_block_sum(v0 + v1, red) / D;
            const float var = dbg_block_sum((v0 - mean) * (v0 - mean) + (v1 - mean) * (v1 - mean), red) / D;
            const float rstd = 1.f / sqrtf(var + LN_EPS);
            const float* g = a.in[IN_LN1G] + layer * D; const float* b = a.in[IN_LN1B] + layer * D;
            const float r0 = (v0 - mean) * rstd * g[tid] + b[tid], r1 = (v1 - mean) * rstd * g[tid + 512] + b[tid + 512];
            float e = fmaxf(fabsf(r0 - xout[(size_t)t * D + tid]), fabsf(r1 - xout[(size_t)t * D + tid + 512]));
            dbg_note(ctl, 0, dbg_block_max(e, red));
            const float q0 = __builtin_bit_cast(float, (unsigned)actb[(size_t)t * D + tid] << 16), q1 = __builtin_bit_cast(float, (unsigned)actb[(size_t)t * D + tid + 512] << 16);
            e = fmaxf(fabsf(r0 - q0), fabsf(r1 - q1));
            dbg_note(ctl, 1, dbg_block_max(e, red));
        }
        x1[tid] = xout[(size_t)t * D + tid]; x1[tid + 512] = xout[(size_t)t * D + tid + 512];
        dbgx1[tid] = x1[tid]; dbgx1[tid + 512] = x1[tid + 512];
        __syncthreads();
        if (tid < 16) { float s = 0.f; for (int k = 0; k < D; ++k) s += x1[k] * a.in[IN_RW][k * 16 + tid]; scl[tid] = 1.f / (1.f + expf(-s)); }
        __syncthreads();
        if (tid == 0) {
            float bz[16]; for (int e = 0; e < 16; ++e) bz[e] = scl[e] + a.in[IN_RB][e];
            int bg = 0; float bgs = -1e30f;
            for (int g = 0; g < 4; ++g) { float m1 = -1e30f, m2 = -1e30f; for (int k = 0; k < 4; ++k) { const float v = bz[4 * g + k]; if (v > m1) { m2 = m1; m1 = v; } else if (v > m2) m2 = v; }
                if (m1 + m2 > bgs) { bgs = m1 + m2; bg = g; } }
            int i1 = 0; for (int k = 1; k < 4; ++k) if (bz[4 * bg + k] > bz[4 * bg + i1]) i1 = k;
            int i2 = -1; for (int k = 0; k < 4; ++k) if (k != i1 && (i2 < 0 || bz[4 * bg + k] > bz[4 * bg + i2])) i2 = k;
            const float s1 = scl[4 * bg + i1], s2 = scl[4 * bg + i2];
            float err = 0.f;
            if (e0 != 4 * bg + i1 || e1 != 4 * bg + i2) err = 1.f;
            err = fmaxf(err, fabsf(scl[16] - s1 / (s1 + s2))); err = fmaxf(err, fabsf(scl[17] - s2 / (s1 + s2)));
            if (p0 >= mm.cnt[e0] || p1 >= mm.cnt[e1]) err = 2.f;
            else { const unsigned* list = (const unsigned*)(a.ws + WS_LIST); if (list[e0 * 32768 + p0] != (unsigned)t || list[e1 * 32768 + p1] != (unsigned)t) err = 3.f; }
            atomicMax(ctl + CW_DBG + 2, __builtin_bit_cast(unsigned, err));
        }
        return;
    }
    x1[tid] = dbgx1[tid]; x1[tid + 512] = dbgx1[tid + 512];
    __syncthreads();
    const float* eg = a.in[IN_EG] + (size_t)layer * NE * D * DEXP; const float* eu = a.in[IN_EU] + (size_t)layer * NE * D * DEXP; const float* ed = a.in[IN_ED] + (size_t)layer * NE * DEXP * D;
    { const int k = tid >> 8, j = tid & 255, e = k ? e1 : e0;
      float g = 0.f, u = 0.f; for (int i = 0; i < D; ++i) { g += x1[i] * eg[((size_t)e * D + i) * DEXP + j]; u += x1[i] * eu[((size_t)e * D + i) * DEXP + j]; }
      hh[k * 256 + j] = g / (1.f + expf(-g)) * u; }
    __syncthreads();
    const size_t s0 = (size_t)mm.tstart[e0] * 256 + p0, s1 = (size_t)mm.tstart[e1] * 256 + p1;
    if (stage == 2) {
        const bf16_t* hb = (const bf16_t*)(a.ws + WS_BIG + BIG_H);
        const int k = tid >> 8, j = tid & 255; const size_t s = k ? s1 : s0;
        const float got = __builtin_bit_cast(float, (unsigned)hb[s * DEXP + j] << 16);
        const float ref = hh[tid];
        const float rms = sqrtf(dbg_block_sum(ref * ref, red) / 512.f);
        dbg_note(ctl, 3, dbg_block_max(fabsf(got - ref), red) / (rms + 1e-6f));
        return;
    }
    for (int c = tid; c < 2048; c += 512) { const int k = c >> 10, col = c & 1023, e = k ? e1 : e0; float s = 0.f;
        for (int j = 0; j < DEXP; ++j) s += hh[k * 256 + j] * ed[((size_t)e * DEXP + j) * D + col];
        yy[c] = s; }
    __syncthreads();
    if (stage == 3) {
        const bf16_t* yb = (const bf16_t*)(a.ws + WS_BIG + BIG_YB);
        float e = 0.f, sq = 0.f;
        for (int c = tid; c < 2048; c += 512) { const int k = c >> 10, col = c & 1023; const size_t s = k ? s1 : s0;
            const float got = __builtin_bit_cast(float, (unsigned)yb[s * D + col] << 16); e = fmaxf(e, fabsf(got - yy[c])); sq += yy[c] * yy[c]; }
        const float rms = sqrtf(dbg_block_sum(sq, red) / 2048.f);
        dbg_note(ctl, 4, dbg_block_max(e, red) / (rms + 1e-6f));
        return;
    }
    {
        float v0 = ALPHA * x1[tid] + w0 * yy[tid] + w1 * yy[1024 + tid], v1 = ALPHA * x1[tid + 512] + w0 * yy[tid + 512] + w1 * yy[1024 + tid + 512];
        const float mean = dbg_block_sum(v0 + v1, red) / D;
        const float var = dbg_block_sum((v0 - mean) * (v0 - mean) + (v1 - mean) * (v1 - mean), red) / D;
        const float rstd = 1.f / sqrtf(var + LN_EPS);
        const float* g = a.in[IN_LN2G] + layer * D; const float* b = a.in[IN_LN2B] + layer * D;
        const float r0 = (v0 - mean) * rstd * g[tid] + b[tid], r1 = (v1 - mean) * rstd * g[tid + 512] + b[tid + 512];
        const float e = fmaxf(fabsf(r0 - xout[(size_t)t * D + tid]), fabsf(r1 - xout[(size_t)t * D + tid + 512]));
        dbg_note(ctl, 5, dbg_block_max(e, red));
    }
}
DI void dbg_final(const Args& a) {
    unsigned* ctl = (unsigned*)(a.ws + WS_CTL);
    const float tol[6] = {1e-4f, 2e-2f, 1e-3f, 0.12f, 0.12f, 4e-2f};
    int code = 2;
    for (int i = 5; i >= 0; --i) { const float err = __builtin_bit_cast(float, xb_ld(ctl + CW_DBG + i));
        if (!(err <= tol[i])) { const int dg = !(err < 1.f) ? 9 : err >= 0.3f ? 7 : err >= 0.1f ? 5 : err >= 0.03f ? 3 : 1; code = 10 * (i + 1) + dg; } }
#ifdef PROBE
    { const float p0 = (float)xb_ld(ctl + CW_DBG + 10) / 65536.f, p1 = __builtin_bit_cast(float, xb_ld(ctl + CW_DBG + 9));
      const int d0 = p0 < 0.f ? 0 : p0 >= 1.f ? 9 : (int)(p0 * 9.99f), d1 = p1 < 0.f ? 0 : p1 >= 1.f ? 9 : (int)(p1 * 9.99f); code = 10 * d0 + d1; }
#endif
    if (xb_ld(ctl + CW_BAR + XB_TMO)) code = 95;
    const float c = sqrtf((float)code);
    for (size_t i = (size_t)blockIdx.x * NTHR + threadIdx.x; i < (size_t)T * D; i += (size_t)gridDim.x * NTHR) a.out[i] = c;
}
#endif


#ifndef PROBE_LO
#define PROBE_LO -1
#define PROBE_HI -1
#define PROBE_MULT 0
#endif
DI void probe_tick(LAS unsigned char* lds, int wv) {
    if (PROBE_LO < 0) return;
    volatile LAS unsigned* M = (volatile LAS unsigned*)(lds + MISC_OFF);
    if (tid_of(wv) == 0) { const unsigned long long now = __builtin_amdgcn_s_memrealtime(); const int k = (int)M[16];
        const unsigned long long last = (unsigned long long)M[18] | ((unsigned long long)M[19] << 32);
        if (k >= PROBE_LO && k <= PROBE_HI) { unsigned long long acc = (unsigned long long)M[20] | ((unsigned long long)M[21] << 32); acc += now - last; M[20] = (unsigned)acc; M[21] = (unsigned)(acc >> 32); }
        M[16] = (unsigned)(k + 1); M[18] = (unsigned)now; M[19] = (unsigned)(now >> 32); }
}
#define GRID_BAR() do { xcd_barrier(bar); probe_tick(lds, a.wv); } while (0)
constexpr bool HAS_MIXER[4] = {true, true, true, true};
template <int layer>
DI void run_layer(const Args& a, LAS unsigned char* lds, const XcdBarrier& bar) {
    const int wave = a.wv;
    const int G = gridDim.x, bid = blockIdx.x;
    const int gw = bid * NWAVES + wave, NGW = G * NWAVES;
    unsigned char* ws = a.ws;
    unsigned* ctl = (unsigned*)(a.ws + WS_CTL);
    bf16_t* actb = (bf16_t*)(ws + WS_ACTB);
    float* xout = a.out;
    bf16_t* xres = (bf16_t*)a.out;
        bf16_t* bigb = (bf16_t*)(ws + WS_BIG);
        if (layer == 0) {
#pragma unroll 1
            for (int b = 0; b < BATCH; ++b) {
                { pg8::DenseSched S; S.init(actb + (size_t)b * SEQ * D, D * 2, 128, ws + WS_WIN, SEQ, 9216, D, G, bid); pg8::EpiStore E{bigb, (size_t)9216}; pg8::gemm_phase(lds + STAGE_OFF, S, E, a.wv); }
                if (b == 1) dilated_merge(a, 0);
                GRID_BAR();
                dilated_phase(a, lds);
                GRID_BAR();
            }
            dilated_merge(a, 1);
            GRID_BAR();
        }
        if (layer == 1) {
            { pg8::DenseSched S; S.init(xres, D * 2, 128, ws + WS_WIN, T, 3072, D, G, bid); pg8::EpiStore E{bigb, (size_t)3072}; pg8::gemm_phase(lds + STAGE_OFF, S, E, a.wv); }
            GRID_BAR();
            sb_phase(a, lds);
            GRID_BAR();
        }
        if (layer == 2) {
            { pg8::DenseSched S; S.init(xres, D * 2, 128, ws + WS_WIN, T, 2816, D, G, bid);
              pg8::EpiNsa E{(bf16_t*)(ws + WS_BIG + NS_Q), (bf16_t*)(ws + WS_BIG + NS_KV), (float*)(ws + WS_BIG + NS_GT)}; pg8::gemm_phase(lds + STAGE_OFF, S, E, a.wv); }
            GRID_BAR();
            { pg8::CmpSched S; S.kv6 = (const char*)(ws + WS_BIG + NS_KV); S.Bt = (const char*)(ws + WS_WCMP); S.K = 2048; S.lda = 16 * 1536 * 2; S.kstepA = 1536 * 2; S.G = G; S.c = bid;
              pg8::EpiCmp E{(bf16_t*)(ws + WS_BIG + NS_HID), (const float*)(ws + WS_WCMP + 2 * MiB + 64 * 1024)}; pg8::gemm_phase(lds + STAGE_OFF, S, E, a.wv); }
            GRID_BAR();
            nsa_kcvc_phase(a, lds);
            GRID_BAR();
            nsa_attn_phase(a, lds);
            GRID_BAR();
        }
        if (layer == 3) {
            { pg8::DenseSched S; S.init(xres, D * 2, 128, ws + WS_WIN, T, 3072, D, G, bid); pg8::EpiStore E{bigb, (size_t)3072}; pg8::gemm_phase(lds + STAGE_OFF, S, E, a.wv); }
            GRID_BAR();
            moba_kmean_phase(a, lds);
            GRID_BAR();
            moba_gate_phase(a, lds);
            GRID_BAR();
            moba_fill_phase(a, lds);
            GRID_BAR();
            moba_sel_phase(a, lds);
            GRID_BAR();
            moba_own_phase(a, lds);
            GRID_BAR();
        }
        if (HAS_MIXER[layer]) {
            { pg8::DenseSched S; S.init(actb, D * 2, 128, ws + WS_WOUT, T, D, D, G, bid); pg8::EpiStore E{(bf16_t*)(ws + WS_BIG + BIG_Y), (size_t)D}; pg8::gemm_phase(lds + STAGE_OFF, S, E, a.wv); }
            GRID_BAR();
        }
        unsigned* gcount = ctl + CW_MOE + layer * 16 * 64;
        {
            const int tid = tid_of(a.wv), lane = tid & 63;
            constexpr int RWS = 1032;
            LAS bf16_t* rwh = (LAS bf16_t*)(lds + STAGE_OFF);
            LAS bf16_t* rwl = rwh + 17 * RWS;
            LAS int* lcnt = (LAS int*)(lds + STAGE_OFF + 73728);
            LAS int* gbase = lcnt + 16;
            LAS unsigned* le = (LAS unsigned*)(lcnt + 32);
            LAS float* lg = (LAS float*)(le + 256);
            const float* rw = a.in[IN_RW];
            for (int i = tid; i < 1024 * 16; i += NTHR) { const int k = i >> 4, e = i & 15; const float v = rw[i]; const unsigned hi = f2bf(v);
                rwh[e * RWS + k] = (bf16_t)hi; rwl[e * RWS + k] = (bf16_t)f2bf(v - u2f(hi << 16)); }
            for (int i = tid; i < RWS; i += NTHR) { rwh[16 * RWS + i] = 0; rwl[16 * RWS + i] = 0; }
            if (tid < 16) lcnt[tid] = 0;
            const float* xin0 = a.in[IN_X];
            const bf16_t* ybig = (const bf16_t*)(ws + WS_BIG + BIG_Y);
            bf16_t* xlo = (bf16_t*)(ws + WS_BIG + BIG_YB);
            const float* g1 = a.in[IN_LN1G] + layer * D; const float* b1 = a.in[IN_LN1B] + layer * D;
            RowVec gv, bv;
#pragma unroll
            for (int j = 0; j < 4; ++j) { gv.v[j] = *(const f32x4*)(g1 + 4 * lane + 256 * j); bv.v[j] = *(const f32x4*)(b1 + 4 * lane + 256 * j); }
            f32x4 pxf[2][4]; u32x2 pxb[2][4], py[2][4];
#define LN1_LOAD(S_, TR_) { _Pragma("unroll") for (int j = 0; j < 4; ++j) { \
                if (layer == 0) pxf[S_][j] = *(const f32x4*)(xin0 + (size_t)(TR_) * D + 4 * lane + 256 * j); \
                else pxb[S_][j] = *(const u32x2*)(xres + (size_t)(TR_) * D + 4 * lane + 256 * j); \
                py[S_][j] = HAS_MIXER[layer] ? *(const u32x2*)(ybig + (size_t)(TR_) * D + 4 * lane + 256 * j) : (u32x2){0u, 0u}; } }
            LN1_LOAD(0, bid * 128 + wave) LN1_LOAD(1, bid * 128 + wave + NWAVES)
            for (int lt = wave; lt < 128; lt += 2 * NWAVES) {
#pragma unroll
                for (int s = 0; s < 2; ++s) {
                    const int t = bid * 128 + lt + NWAVES * s;
                    RowVec r;
#pragma unroll
                    for (int j = 0; j < 4; ++j) {
                        if (layer == 0) r.v[j] = pxf[s][j] * ALPHA;
                        else { r.v[j].x = ALPHA * bf_lo(pxb[s][j].x); r.v[j].y = ALPHA * bf_hi(pxb[s][j].x); r.v[j].z = ALPHA * bf_lo(pxb[s][j].y); r.v[j].w = ALPHA * bf_hi(pxb[s][j].y); }
                        r.v[j].x += bf_lo(py[s][j].x); r.v[j].y += bf_hi(py[s][j].x); r.v[j].z += bf_lo(py[s][j].y); r.v[j].w += bf_hi(py[s][j].y); }
                    if (lt + 2 * NWAVES < 128) LN1_LOAD(s, t + 2 * NWAVES)
                    float mean, rstd; ln_stats(r, mean, rstd);
#pragma unroll
                    for (int j = 0; j < 4; ++j) { r.v[j] = (r.v[j] - mean) * rstd * gv.v[j] + bv.v[j];
                        const unsigned h0 = f2bf(r.v[j].x), h1 = f2bf(r.v[j].y), h2 = f2bf(r.v[j].z), h3 = f2bf(r.v[j].w);
                        u32x2 w; w.x = h0 | (h1 << 16); w.y = h2 | (h3 << 16);
                        *(u32x2*)(actb + (size_t)t * D + 4 * lane + 256 * j) = w;
                        u32x2 wl; wl.x = pk2(r.v[j].x - u2f(h0 << 16), r.v[j].y - u2f(h1 << 16)); wl.y = pk2(r.v[j].z - u2f(h2 << 16), r.v[j].w - u2f(h3 << 16));
                        *(u32x2*)(xlo + (size_t)t * D + 4 * lane + 256 * j) = wl; }
                }
            }
#undef LN1_LOAD
            asm volatile("s_waitcnt vmcnt(0)" ::: "memory");
            __syncthreads();
            if (wave < 4) {
                const int c = lane & 31, h = lane >> 5, lt = 32 * wave + c, t = bid * 128 + lt;
                const bf16_t* xh_ = actb + (size_t)t * D + 8 * h; const bf16_t* xl_ = xlo + (size_t)t * D + 8 * h;
                const int wr_ = c < 16 ? c : 16;
                const LAS bf16_t* ah = rwh + wr_ * RWS + 8 * h; const LAS bf16_t* al = rwl + wr_ * RWS + 8 * h;
                f32x16 acc = zero16();
#pragma unroll 4
                for (int ks = 0; ks < 64; ++ks) {
                    const bf16x8 bh = *(const bf16x8*)(xh_ + 16 * ks), bl = *(const bf16x8*)(xl_ + 16 * ks);
                    const bf16x8 wh = *(const LAS bf16x8*)(ah + 16 * ks), wl = *(const LAS bf16x8*)(al + 16 * ks);
                    acc = mfma32(wh, bh, acc); acc = mfma32(wh, bl, acc); acc = mfma32(wl, bh, acc);
                }
                float sc[2][4], bz[2][4];
#pragma unroll
                for (int q = 0; q < 2; ++q)
#pragma unroll
                    for (int k = 0; k < 4; ++k) { sc[q][k] = 1.f / (1.f + __expf(-acc[4 * q + k])); bz[q][k] = sc[q][k] + a.in[IN_RB][8 * q + 4 * h + k]; }
                float gs[2]; int i1[2], i2[2];
#pragma unroll
                for (int q = 0; q < 2; ++q) {
                    float m1 = bz[q][0]; int j1 = 0;
#pragma unroll
                    for (int k = 1; k < 4; ++k) if (bz[q][k] > m1) { m1 = bz[q][k]; j1 = k; }
                    float m2 = -1e30f; int j2 = -1;
#pragma unroll
                    for (int k = 0; k < 4; ++k) if (k != j1 && bz[q][k] > m2) { m2 = bz[q][k]; j2 = k; }
                    gs[q] = m1 + m2; i1[q] = j1; i2[q] = j2; }
                const float o0 = __shfl_xor(gs[0], 32), o1 = __shfl_xor(gs[1], 32);
                const float G0 = h ? o0 : gs[0], G1 = h ? gs[0] : o0, G2 = h ? o1 : gs[1], G3 = h ? gs[1] : o1;
                int bg = 0; float bgs = G0;
                if (G1 > bgs) { bgs = G1; bg = 1; }
                if (G2 > bgs) { bgs = G2; bg = 2; }
                if (G3 > bgs) { bgs = G3; bg = 3; }
                if ((bg & 1) == h) {
                    const int q = bg >> 1;
                    const int j1 = q ? i1[1] : i1[0], j2 = q ? i2[1] : i2[0];
                    float sg1 = 0.f, sg2 = 0.f;
#pragma unroll
                    for (int k = 0; k < 4; ++k) { const float sv = q ? sc[1][k] : sc[0][k]; sg1 = (k == j1) ? sv : sg1; sg2 = (k == j2) ? sv : sg2; }
                    const float inv = 1.f / (sg1 + sg2);
                    const int e0 = bg * 4 + j1, e1 = bg * 4 + j2;
                    const int p0 = atomicAdd((int*)(lcnt + e0), 1), p1 = atomicAdd((int*)(lcnt + e1), 1);
                    le[lt * 2] = (unsigned)e0 | ((unsigned)p0 << 8); le[lt * 2 + 1] = (unsigned)e1 | ((unsigned)p1 << 8);
                    lg[lt * 2] = sg1 * inv; lg[lt * 2 + 1] = sg2 * inv;
                }
            }
            __syncthreads();
            if (tid < 16) gbase[tid] = (int)xb_add(gcount + tid * 64, (unsigned)lcnt[tid]);
            __syncthreads();
            if (tid < 256) {
                const int lt = tid >> 1, t = bid * 128 + lt;
                if (t < T) {
                    const unsigned w = le[tid]; const int e = w & 255, pos = gbase[e] + (int)(w >> 8);
                    ((unsigned*)(ws + WS_LIST))[e * 32768 + pos] = (unsigned)t;
                    u32x2 ti; ti.x = (unsigned)e | ((unsigned)pos << 4); ti.y = __builtin_bit_cast(unsigned, lg[tid]);
                    *(u32x2*)(ws + WS_TOKINFO + (size_t)(t * 2 + (tid & 1)) * 8) = ti;
                }
            }
        }
        GRID_BAR();

        MoeMeta mm; mm.tstart = (LAS int*)(lds + MISC_OFF + 256); mm.cnt = mm.tstart + 32;
        if (tid_of(a.wv) == 0) { int acc = 0;
            for (int e = 0; e < 16; ++e) { const int c = (int)xb_ld(gcount + e * 64); mm.cnt[e] = c; mm.tstart[e] = acc; acc += (c + 255) >> 8; }
            mm.tstart[16] = acc; }
        __syncthreads();
        const int ntiles = mm.tstart[16];
#if DBG
        if (layer == DBG_LAYER) { dbg_check<layer>(a, lds, 1, mm); __syncthreads(); }
#endif
        {
            Moe1Sched S; S.A = (const char*)actb; S.Bt = (const char*)(ws + WS_WEXP1); S.K = D; S.lda = D * 2; S.kstepA = 128; S.mm = mm; S.ntiles = ntiles; S.G = G; S.c = bid;
            S.tab = (LAS unsigned*)(lds + AUX_OFF);
            const int tid = tid_of(a.wv);
            pg8::Unit u;
            for (int i = 0; i < 8 && S.next(i, u); ++i) {
                if (tid < 256) { const int pos = (u.pm - mm.tstart[u.e]) * 256 + tid;
                    const unsigned tok = (pos < mm.cnt[u.e]) ? ((const unsigned*)(ws + WS_LIST))[u.e * 32768 + pos] : 0u;
                    S.tab[i * 256 + tid] = tok * (unsigned)(D * 2); }
            }
            __syncthreads();
            pg8::EpiSwiglu E{(bf16_t*)(ws + WS_BIG + BIG_H)};
            pg8::gemm_phase(lds + STAGE_OFF, S, E, a.wv);
        }
        GRID_BAR();
#if DBG
        if (layer == DBG_LAYER) { dbg_check<layer>(a, lds, 2, mm); __syncthreads(); }
#endif
        {
            Moe2Sched S; S.A = (const char*)(ws + WS_BIG + BIG_H); S.Bt = (const char*)(ws + WS_WEXP2); S.K = DEXP; S.lda = DEXP * 2; S.kstepA = 128; S.mm = mm; S.ntiles = ntiles; S.G = G; S.c = bid;
            pg8::EpiStore E{(bf16_t*)(ws + WS_BIG + BIG_YB), (size_t)D};
            pg8::gemm_phase(lds + STAGE_OFF, S, E, a.wv);
        }
        GRID_BAR();
#if DBG
        if (layer == DBG_LAYER) { dbg_check<layer>(a, lds, 3, mm); __syncthreads(); }
#endif
        {
            const int tid = tid_of(a.wv), lane = tid & 63;
            const float* g2 = a.in[IN_LN2G] + layer * D; const float* b2 = a.in[IN_LN2B] + layer * D;
            RowVec gv, bv;
#pragma unroll
            for (int j = 0; j < 4; ++j) { gv.v[j] = *(const f32x4*)(g2 + 4 * lane + 256 * j); bv.v[j] = *(const f32x4*)(b2 + 4 * lane + 256 * j); }
            const bf16_t* yb = (const bf16_t*)(ws + WS_BIG + BIG_YB);
            u32x4 tiN[2]; u32x2 px[2][4], py0[2][4], py1[2][4]; float cw0[2], cw1[2];
#define LN2_LOAD(S_, TR_) { const u32x4 ti_ = tiN[S_]; const int e0 = ti_.x & 15, p0 = ti_.x >> 4, e1 = ti_.z & 15, p1 = ti_.z >> 4; cw0[S_] = u2f(ti_.y); cw1[S_] = u2f(ti_.w); \
                const size_t s0 = (size_t)mm.tstart[e0] * 256 + p0, s1 = (size_t)mm.tstart[e1] * 256 + p1; \
                _Pragma("unroll") for (int j = 0; j < 4; ++j) { px[S_][j] = *(const u32x2*)(actb + (size_t)(TR_) * D + 4 * lane + 256 * j); \
                    py0[S_][j] = *(const u32x2*)(yb + s0 * D + 4 * lane + 256 * j); py1[S_][j] = *(const u32x2*)(yb + s1 * D + 4 * lane + 256 * j); } }
            static_assert(T % (2 * 256 * NWAVES) == 0, "LN2 row pairing");
            tiN[0] = *(const u32x4*)(ws + WS_TOKINFO + (size_t)gw * 16); tiN[1] = *(const u32x4*)(ws + WS_TOKINFO + (size_t)(gw + NGW) * 16);
            LN2_LOAD(0, gw) LN2_LOAD(1, gw + NGW)
            if (gw + 2 * NGW < T) { tiN[0] = *(const u32x4*)(ws + WS_TOKINFO + (size_t)(gw + 2 * NGW) * 16); tiN[1] = *(const u32x4*)(ws + WS_TOKINFO + (size_t)(gw + 3 * NGW) * 16); }
            for (int tb = gw; tb < T; tb += 2 * NGW) {
#pragma unroll
                for (int s = 0; s < 2; ++s) {
                    const int t = tb + s * NGW;
                    const float w0 = cw0[s], w1 = cw1[s];
                    RowVec r;
#pragma unroll
                    for (int j = 0; j < 4; ++j) {
                        const u32x2 xv = px[s][j], y0 = py0[s][j], y1 = py1[s][j];
                        r.v[j].x = ALPHA * bf_lo(xv.x) + w0 * bf_lo(y0.x) + w1 * bf_lo(y1.x);
                        r.v[j].y = ALPHA * bf_hi(xv.x) + w0 * bf_hi(y0.x) + w1 * bf_hi(y1.x);
                        r.v[j].z = ALPHA * bf_lo(xv.y) + w0 * bf_lo(y0.y) + w1 * bf_lo(y1.y);
                        r.v[j].w = ALPHA * bf_hi(xv.y) + w0 * bf_hi(y0.y) + w1 * bf_hi(y1.y);
                    }
                    if (t + 2 * NGW < T) { const int tn = t + 2 * NGW;
                        LN2_LOAD(s, tn)
                        if (tn + 2 * NGW < T) tiN[s] = *(const u32x4*)(ws + WS_TOKINFO + (size_t)(tn + 2 * NGW) * 16); }
                    float mean, rstd; ln_stats(r, mean, rstd);
#pragma unroll
                    for (int j = 0; j < 4; ++j) { r.v[j] = (r.v[j] - mean) * rstd * gv.v[j] + bv.v[j];
                        if (layer == DEPTH - 1) *(f32x4*)(xout + (size_t)t * D + 4 * lane + 256 * j) = r.v[j];
                        else { u32x2 w; w.x = pk2(r.v[j].x, r.v[j].y); w.y = pk2(r.v[j].z, r.v[j].w);
                            *(u32x2*)(xres + (size_t)t * D + 4 * lane + 256 * j) = w; } }
                }
            }
#undef LN2_LOAD
            if (layer + 1 < DEPTH) convert_layer_weights(a, layer + 1, lds, gw, NGW, wave, lane);
        }
        GRID_BAR();
#if DBG
        if (layer == DBG_LAYER) { dbg_check<layer>(a, lds, 4, mm); GRID_BAR(); }
#endif
}

__global__ void __launch_bounds__(NTHR, 2) fwd(Args a_in) {
    Args a = a_in; a.wv = __builtin_amdgcn_readfirstlane((int)(threadIdx.x >> 6));
    extern __shared__ __attribute__((aligned(16))) unsigned char lds_raw[];
    LAS unsigned char* lds = (LAS unsigned char*)lds_raw;
    volatile LAS unsigned* MISC = (volatile LAS unsigned*)(lds + MISC_OFF);
    const int tid = tid_of(a.wv), lane = tid & 63, wave = a.wv;
    const int G = gridDim.x, bid = blockIdx.x;
    const int gw = bid * NWAVES + wave, NGW = G * NWAVES;
    if (tid < 256) MISC[tid] = 0u;
    __syncthreads();
    unsigned* ctl = (unsigned*)(a.ws + WS_CTL);
    XcdBarrier bar = xcd_barrier_post(ctl + CW_BAR, MISC + 8); bar.wv = a.wv;
    if (PROBE_LO >= 0 && tid == 0) { const unsigned long long now = __builtin_amdgcn_s_memrealtime(); MISC[18] = (unsigned)now; MISC[19] = (unsigned)(now >> 32); }
    unsigned char* ws = a.ws;
    bf16_t* actb = (bf16_t*)(ws + WS_ACTB);
    float* xout = a.out;

    convert_layer_weights(a, 0, lds, gw, NGW, wave, lane);
    for (int i = bid * NTHR + tid; i < 16 * 2048; i += G * NTHR) { const int hd = i >> 11, n = i & 2047;
        int bk = n; if (n >= 16) { const float lf = logf((float)n / 16.f) / 4.852030263919617f; bk = 16 + (int)(lf * 16.f); bk = bk > 31 ? 31 : bk; }
        ((float*)(a.ws + WS_BIASG))[i] = a.in[IN_REL][bk * 16 + hd] * LOG2E; }
    { const float* x = a.in[IN_X];
      for (size_t i = ((size_t)bid * NTHR + tid) * 8; i < (size_t)T * D; i += (size_t)G * NTHR * 8) {
          const f32x4 v0 = *(const f32x4*)(x + i), v1 = *(const f32x4*)(x + i + 4);
          u32x4 w; w.x = pk2(v0.x, v0.y); w.y = pk2(v0.z, v0.w); w.z = pk2(v1.x, v1.y); w.w = pk2(v1.z, v1.w);
          *(u32x4*)(actb + i) = w; } }
    GRID_BAR();

    run_layer<0>(a, lds, bar);
#if DBG
    if (DBG_LAYER >= 1) run_layer<1>(a, lds, bar);
    if (DBG_LAYER >= 2) run_layer<2>(a, lds, bar);
    if (DBG_LAYER >= 3) run_layer<3>(a, lds, bar);
    dbg_final(a);
#else
    run_layer<1>(a, lds, bar);
    run_layer<2>(a, lds, bar);
    run_layer<3>(a, lds, bar);
#endif
    if (PROBE_LO >= 0) { __syncthreads(); const unsigned long long acc = (unsigned long long)MISC[20] | ((unsigned long long)MISC[21] << 32); const unsigned long long t0 = __builtin_amdgcn_s_memrealtime();
        while (__builtin_amdgcn_s_memrealtime() - t0 < acc * (unsigned long long)PROBE_MULT) __builtin_amdgcn_s_sleep(8); }
}

extern "C" void kernel_launch(void* const* d_in, const int* in_sizes, int n_in, void* d_out, int out_size, void* d_ws, size_t ws_size, hipStream_t stream) {
    static int grid = 0;
    if (grid == 0) {
        int dev = 0, cus = 0;
        if (n_in != 25 || out_size != T * D || ws_size < WS_END) { fprintf(stderr, "kernel_launch: unexpected shapes (n_in %d out %d ws %zu)\n", n_in, out_size, ws_size); grid = -1; return; }
        if (hipGetDevice(&dev) != hipSuccess || hipDeviceGetAttribute(&cus, hipDeviceAttributeMultiprocessorCount, dev) != hipSuccess) { grid = -1; return; }
        if (hipFuncSetAttribute((const void*)fwd, hipFuncAttributeMaxDynamicSharedMemorySize, LDS_BYTES) != hipSuccess) { grid = -1; return; }
        (void)hipGetLastError();
        grid = cus;
        if (grid != 256) { fprintf(stderr, "kernel_launch: built for 256 CUs, got %d\n", grid); grid = -1; return; }
    }
    if (grid < 0) return;
    (void)hipMemsetAsync(d_ws, 0, 1u << 20, stream);
    Args a{};
    for (int i = 0; i < 25; ++i) a.in[i] = (const float*)d_in[i];
    a.out = (float*)d_out; a.ws = (unsigned char*)d_ws;
    hipLaunchKernelGGL(fwd, dim3(grid), dim3(NTHR), LDS_BYTES, stream, a);
}
```

```cpp
#include <hip/hip_runtime.h>
#include <cstdio>
#include <cstdint>
#define DBG 0
#define DBG_LAYER 0

#define LAS __attribute__((address_space(3)))
#define GAS __attribute__((address_space(1)))
#define DI __device__ __forceinline__
typedef unsigned short bf16_t;
typedef short bf16x8 __attribute__((ext_vector_type(8)));
typedef short s16x4 __attribute__((ext_vector_type(4)));
typedef float f32x2 __attribute__((ext_vector_type(2)));
typedef float f32x4 __attribute__((ext_vector_type(4)));
typedef float f32x16 __attribute__((ext_vector_type(16)));
typedef unsigned u32x2 __attribute__((ext_vector_type(2)));
typedef unsigned u32x4 __attribute__((ext_vector_type(4)));

constexpr int BATCH = 2, SEQ = 16384, D = 1024, T = BATCH * SEQ, DEPTH = 4, NH = 16, HD = 64;
constexpr int NE = 16, DEXP = 256;
constexpr float ALPHA = 1.681792830507429f;
constexpr float LN_EPS = 1e-5f;
constexpr int NWAVES = 8, NTHR = 512;

constexpr size_t MiB = 1u << 20;
constexpr size_t WS_CTL = 0;
constexpr size_t WS_TOKINFO = 1 * MiB;
constexpr size_t WS_SMALL = 1 * MiB + 512 * 1024;
constexpr size_t WS_LIST = 2 * MiB;
constexpr size_t WS_WIN = 4 * MiB;
constexpr size_t WS_WOUT = 22 * MiB;
constexpr size_t WS_WEXP1 = 24 * MiB;
constexpr size_t WS_WEXP2 = 40 * MiB;
constexpr size_t WS_WCMP = 48 * MiB;
constexpr size_t WS_ACTB = 52 * MiB;
constexpr size_t WS_BIG = 116 * MiB;
constexpr size_t WS_END = 512 * MiB;
constexpr size_t BIG_Y = 0;
constexpr size_t BIG_H = 64 * MiB;
constexpr size_t BIG_YB = 100 * MiB;
constexpr size_t BIG_XLO = 240 * MiB;
constexpr int PROWS = 2 * T + NE * 256;

constexpr int CW_BAR = 4096;
constexpr int CW_DBG = 8;
constexpr int CW_MOE = 16384;

constexpr int LDS_BYTES = 160 * 1024;
constexpr int STAGE_OFF = 0;
constexpr int AUX_OFF = 128 * 1024;
constexpr int MISC_OFF = LDS_BYTES - 1024;

DI unsigned f2bf(float f) { unsigned u = __builtin_bit_cast(unsigned, f); return (u + 0x7fffu + ((u >> 16) & 1u)) >> 16; }
DI unsigned pk2(float lo, float hi) { return f2bf(lo) | (f2bf(hi) << 16); }
typedef __bf16 bf16x2_t __attribute__((ext_vector_type(2)));
DI unsigned cvt_pk_bf16(float lo, float hi) { const bf16x2_t r = __builtin_convertvector((f32x2){lo, hi}, bf16x2_t); return __builtin_bit_cast(unsigned, r); }
DI float u2f(unsigned u) { return __builtin_bit_cast(float, u); }
DI unsigned f2u(float f) { return __builtin_bit_cast(unsigned, f); }
DI float bf_lo(unsigned w) { return __builtin_bit_cast(float, w << 16); }
DI float bf_hi(unsigned w) { return __builtin_bit_cast(float, w & 0xffff0000u); }
DI float wave_sum(float v) {
#pragma unroll
    for (int o = 1; o < 64; o <<= 1) v += __shfl_xor(v, o);
    return v;
}
DI int tid_of(int wv) { int l; asm volatile("v_mbcnt_lo_u32_b32 %0, -1, 0\n\tv_mbcnt_hi_u32_b32 %0, -1, %0" : "=v"(l)); return (wv << 6) | l; }
DI float xor32h(float v, int h) { const unsigned u = __builtin_bit_cast(unsigned, v); const u32x2 s = __builtin_amdgcn_permlane32_swap(u, u, false, false);
    return __builtin_bit_cast(float, h ? s.x : s.y); }
DI float quad_xor1(float v) { return __builtin_bit_cast(float, __builtin_amdgcn_update_dpp(0, __builtin_bit_cast(int, v), 0xB1, 0xf, 0xf, false)); }
DI float quad_xor2(float v) { return __builtin_bit_cast(float, __builtin_amdgcn_update_dpp(0, __builtin_bit_cast(int, v), 0x4E, 0xf, 0xf, false)); }
#define LDS_WAIT() asm volatile("s_waitcnt lgkmcnt(0)" ::: "memory")
#define VM_WAIT() asm volatile("s_waitcnt vmcnt(0)" ::: "memory")

#define XB_TMO      128
#define XB_XCNT(j)  (256  + 64 * (j))
#define XB_XSUB(j)  (1280 + 64 * (j))
#define XB_XGEN(j)  (2304 + 64 * (j))
#define XB_TOP      3328
#define XB_TOPGEN   3392
#define XCD_BAR_WORDS 3456
#define XB_SPIN_CAP (1u << 22)
DI unsigned xb_ld(unsigned* p)              { return __hip_atomic_load(p, __ATOMIC_RELAXED, __HIP_MEMORY_SCOPE_AGENT); }
DI unsigned xb_add(unsigned* p, unsigned v) { return __hip_atomic_fetch_add(p, v, __ATOMIC_RELAXED, __HIP_MEMORY_SCOPE_AGENT); }
DI unsigned xb_xcc_id() { return (unsigned)__builtin_amdgcn_s_getreg((3 << 11) | 20) & 0xFu; }
#define XB_SPIN(cond, bar) do { unsigned _sp = 0; while (cond) { __builtin_amdgcn_s_sleep(1); \
    if ((++_sp & 255u) == 0u) { if (xb_ld(&(bar)[XB_TMO])) break; if (_sp > XB_SPIN_CAP) { atomicAdd(&(bar)[XB_TMO], 1u); break; } } } } while (0)
struct XcdBarrier { unsigned* bar; unsigned x; volatile LAS unsigned* st; int wv; };
DI XcdBarrier xcd_barrier_post(unsigned* bar, volatile LAS unsigned* st) {
    XcdBarrier b; b.bar = bar; b.x = xb_xcc_id(); b.st = st;
    if (threadIdx.x == 0) (void)xb_add(&bar[XB_XCNT(b.x)], 1u);
    return b;
}
DI void xcd_barrier_complete(unsigned* bar, unsigned x, unsigned& nloc, unsigned& nx) {
    const unsigned G = gridDim.x * gridDim.y * gridDim.z;
    unsigned sum, cnt, mine, sp = 0u;
    for (;;) {
        sum = 0u; cnt = 0u; mine = 0u;
#pragma unroll
        for (unsigned j = 0; j < 16; ++j) { const unsigned c = xb_ld(&bar[XB_XCNT(j)]); sum += c; cnt += (c > 0u) ? 1u : 0u; mine = (j == x) ? c : mine; }
        if (sum == G) break;
        __builtin_amdgcn_s_sleep(1);
        if ((++sp & 255u) == 0u) { if (xb_ld(&bar[XB_TMO])) break; if (sp > XB_SPIN_CAP) { atomicAdd(&bar[XB_TMO], 1u); break; } }
    }
    nloc = mine > 0u ? mine : 1u; nx = cnt > 0u ? cnt : 1u;
}
DI void xcd_barrier(const XcdBarrier& b) {
    asm volatile("s_waitcnt vmcnt(0)" ::: "memory");
    __syncthreads();
    if (tid_of(b.wv) == 0) {
        unsigned* bar = b.bar;
        const unsigned bx = xb_xcc_id();
        __builtin_amdgcn_s_waitcnt(0);
        unsigned nloc = b.st[0], nx = b.st[1];
        if (nloc == 0u) { xcd_barrier_complete(bar, bx, nloc, nx); b.st[0] = nloc; b.st[1] = nx; }
        const unsigned old = xb_add(&bar[XB_XSUB(bx)], 1u);
        const unsigned gen = old / nloc;
        if (old + 1u == (gen + 1u) * nloc) {
            __builtin_amdgcn_fence(__ATOMIC_RELEASE, "agent");
            asm volatile("s_waitcnt vmcnt(0)" ::: "memory");
            const unsigned og = xb_add(&bar[XB_TOP], 1u);
            const unsigned tg = og / nx;
            if (og + 1u == (tg + 1u) * nx) xb_add(&bar[XB_TOPGEN], 1u);
            else XB_SPIN(xb_ld(&bar[XB_TOPGEN]) == tg, bar);
            __builtin_amdgcn_fence(__ATOMIC_ACQUIRE, "agent");
            xb_add(&bar[XB_XGEN(bx)], 1u);
            asm volatile("s_waitcnt vmcnt(0)" ::: "memory");
        } else {
            XB_SPIN(xb_ld(&bar[XB_XGEN(bx)]) == gen, bar);
            __builtin_amdgcn_fence(__ATOMIC_ACQUIRE, "agent");
            asm volatile("s_waitcnt vmcnt(0)" ::: "memory");
        }
    }
    __syncthreads();
}

namespace pg8 {
constexpr int BM = 256, BK = 64, HALF = 128, HTB = HALF * BK * 2, STAGE_BYTES = 8 * HTB, NXCD = 8, WGM = 8;
__host__ __device__ __forceinline__ int lds_byte(int r, int c) { const int st = (r >> 4) * 2 + (c >> 5), rr = r & 15, cc = c & 31, ob = rr * 64 + cc * 2; return st * 1024 + (ob ^ (((ob >> 9) & 1) << 5)); }
__host__ __device__ __forceinline__ void stage_rc(int b, int& R, int& C) { const int st = b / 1024, sb = b % 1024, swz = sb ^ (((sb >> 9) & 1) << 5); R = (st >> 1) * 16 + swz / 64; C = (st & 1) * 32 + (swz % 64) / 2; }
__host__ __device__ __forceinline__ int perm32(int rho) { const int n = rho >> 4, i = rho & 15; return 8 * (i >> 2) + 4 * n + (i & 3); }

struct Unit { int pm, pn, e; };

struct TileOrder {
    int nM, nN, nwg, G, c;
    DI void init(int nM_, int nN_, int G_, int c_) { nM = nM_; nN = nN_; nwg = nM * nN; G = G_; c = c_; }
    DI bool next(int i, int& pm, int& pn) const {
        const long L = (long)i * G + c; if (L >= nwg) return false;
        int wgid = (int)L; { const int q = nwg / NXCD, r = nwg % NXCD, xcd = wgid % NXCD, off = wgid / NXCD; wgid = (xcd < r ? xcd * (q + 1) : r * (q + 1) + (xcd - r) * q) + off; }
        const int nig = WGM * nN, gid = wgid / nig, fm = gid * WGM, gsz = (nM - fm) < WGM ? (nM - fm) : WGM;
        pm = fm + ((wgid % nig) % gsz); pn = (wgid % nig) / gsz; return true;
    }
};
struct DenseSched {
    static constexpr bool GATHER = false;
    const char* A; const char* Bt; int K; unsigned lda, kstepA; TileOrder ord;
    DI void init(const void* A_, unsigned lda_, unsigned kstepA_, const void* Bt_, int M, int N, int K_, int G, int c) { A = (const char*)A_; Bt = (const char*)Bt_; K = K_; lda = lda_; kstepA = kstepA_; ord.init(M / BM, N / BM, G, c); }
    DI bool next(int i, Unit& u) const { u.e = 0; return ord.next(i, u.pm, u.pn); }
    DI const char* a_base(const Unit& u) const { return A + (size_t)u.pm * BM * lda; }
    DI const char* b_base(const Unit& u) const { return Bt + (size_t)u.pn * BM * K * 2; }
    DI unsigned row_off(int, int) const { return 0u; }
};

template <class Epi, class Sched>
DI void gemm_phase(LAS unsigned char* lds, const Sched& S, const Epi& E, int wv) {
    int tid = tid_of(wv); asm volatile("" : "+v"(tid));
    const int wid = __builtin_amdgcn_readfirstlane(tid >> 6), lane = tid & 63, wr = wid >> 2, wc = wid & 3, fr = lane & 15, fq = lane >> 4;
    const int K = S.K, nt = K / BK;
    unsigned voffB[2]; int Rr[2]; unsigned Cb[2];
#pragma unroll
    for (int i = 0; i < 2; ++i) { int R, C; stage_rc(tid * 16 + i * 8192, R, C); const int Rb = (R & ~31) + perm32(R & 31);
        voffB[i] = (unsigned)(Rb * K + C) * 2u; Rr[i] = R; Cb[i] = (unsigned)C * 2u; }
    const unsigned kstepA = S.kstepA, kstepB = (unsigned)(BK * 2);
    const size_t hstepB = (size_t)HALF * K * 2;
    const unsigned ldsw = (unsigned)wid * 1024u;
    const int aoff = lds_byte(wr * 64 + fr, fq * 8), boff = lds_byte(wc * 32 + fr, fq * 8);
#define PG8_SA(b, h) (((b) * 2 + (h)) * HTB)
#define PG8_SB(b, h) ((4 + (b) * 2 + (h)) * HTB)
#define PG8_STAGE_A(bufoff, basep, vv, h, koff) do { _Pragma("unroll") for (int _i = 0; _i < 2; ++_i) \
        __builtin_amdgcn_global_load_lds((const unsigned*)((basep) + (vv)[h][_i] + (koff)), (LAS unsigned*)(lds + (bufoff) + ldsw + _i * 8192), 16, 0, 0); } while (0)
#define PG8_STAGE_B(bufoff, ptr) do { _Pragma("unroll") for (int _i = 0; _i < 2; ++_i) \
        __builtin_amdgcn_global_load_lds((const unsigned*)((ptr) + voffB[_i]), (LAS unsigned*)(lds + (bufoff) + ldsw + _i * 8192), 16, 0, 0); } while (0)
#define PG8_LDA(dst, b, h) do { _Pragma("unroll") for (int m = 0; m < 4; ++m) _Pragma("unroll") for (int k = 0; k < 2; ++k) dst[m][k] = *(const LAS bf16x8*)(lds + PG8_SA(b, h) + aoff + m * 2048 + k * 1024); } while (0)
#define PG8_LDB(dst, b, h) do { _Pragma("unroll") for (int n = 0; n < 2; ++n) _Pragma("unroll") for (int k = 0; k < 2; ++k) dst[n][k] = *(const LAS bf16x8*)(lds + PG8_SB(b, h) + boff + n * 2048 + k * 1024); } while (0)
#define PG8_MMA(ai, bj, At, Bt) do { __builtin_amdgcn_s_setprio(1); _Pragma("unroll") for (int m = 0; m < 4; ++m) _Pragma("unroll") for (int n = 0; n < 2; ++n) _Pragma("unroll") for (int k = 0; k < 2; ++k) \
        acc[ai][bj][m][n] = __builtin_amdgcn_mfma_f32_16x16x32_bf16(Bt[n][k], At[m][k], acc[ai][bj][m][n], 0, 0, 0); __builtin_amdgcn_s_setprio(0); } while (0)
#define PG8_WAIT_V(n) asm volatile("s_waitcnt vmcnt(" #n ")" ::: "memory")
#define PG8_WAIT_L(n) asm volatile("s_waitcnt lgkmcnt(" #n ")" ::: "memory")
#define PG8_BAR __builtin_amdgcn_s_barrier()
#define PG8_SCHED __builtin_amdgcn_sched_barrier(0)
    Unit cur, nxt; int ui = 0;
    if (!S.next(0, cur)) return;
    unsigned vA[2][2], vN[2][2];
#pragma unroll
    for (int h = 0; h < 2; ++h)
#pragma unroll
        for (int i = 0; i < 2; ++i) { vA[h][i] = (Sched::GATHER ? S.row_off(0, h * HALF + Rr[i]) : (unsigned)(h * HALF + Rr[i]) * S.lda) + Cb[i]; vN[h][i] = vA[h][i]; }
    f32x4 acc[2][2][4][2];
#pragma unroll
    for (int a = 0; a < 2; ++a)
#pragma unroll
        for (int b = 0; b < 2; ++b)
#pragma unroll
            for (int m = 0; m < 4; ++m)
#pragma unroll
                for (int n = 0; n < 2; ++n) acc[a][b][m][n] = (f32x4){0.f, 0.f, 0.f, 0.f};
    bf16x8 At[4][2], B0[2][2], B1[2][2];
    const char* cA = S.a_base(cur); const char* cB = S.b_base(cur);
    PG8_STAGE_B(PG8_SB(0, 0), cB); PG8_STAGE_A(PG8_SA(0, 0), cA, vA, 0, 0u); PG8_STAGE_B(PG8_SB(0, 1), cB + hstepB); PG8_STAGE_A(PG8_SA(0, 1), cA, vA, 1, 0u);
    if (wr == 1) PG8_BAR;
    PG8_WAIT_V(4); PG8_BAR;
    PG8_STAGE_B(PG8_SB(1, 0), cB + kstepB); PG8_STAGE_A(PG8_SA(1, 0), cA, vA, 0, kstepA); PG8_STAGE_B(PG8_SB(1, 1), cB + hstepB + kstepB);
    PG8_WAIT_V(6); PG8_BAR;
    for (;;) {
        const bool has_next = S.next(ui + 1, nxt);
        const char* nA = has_next ? S.a_base(nxt) : cA; const char* nB = has_next ? S.b_base(nxt) : cB;
        if (Sched::GATHER) {
#pragma unroll
            for (int h = 0; h < 2; ++h)
#pragma unroll
                for (int i = 0; i < 2; ++i) vN[h][i] = has_next ? (S.row_off(ui + 1, h * HALF + Rr[i]) + Cb[i]) : vA[h][i];
        }
        for (int t = 0; t < nt; t += 2) {
            const bool last = (t == nt - 2);
            const unsigned k1 = (unsigned)(t + 1) * kstepA;
            const char* a2p = last ? nA : cA; const unsigned k2 = last ? 0u : (unsigned)(t + 2) * kstepA;
            unsigned v2[2][2];
#pragma unroll
            for (int h = 0; h < 2; ++h)
#pragma unroll
                for (int i = 0; i < 2; ++i) v2[h][i] = (Sched::GATHER && last) ? vN[h][i] : vA[h][i];
            const char* b2 = last ? nB : cB + (size_t)(t + 2) * kstepB; const char* b3 = b2 + kstepB;
            PG8_LDB(B0, 0, 0); PG8_SCHED; PG8_LDA(At, 0, 0); PG8_STAGE_A(PG8_SA(1, 1), cA, vA, 1, k1);
            PG8_WAIT_L(8); PG8_BAR; PG8_WAIT_L(0); PG8_MMA(0, 0, At, B0); PG8_BAR; PG8_SCHED;
            PG8_LDB(B1, 0, 1); PG8_STAGE_B(PG8_SB(0, 0), b2);
            PG8_BAR; PG8_WAIT_L(0); PG8_MMA(0, 1, At, B1); PG8_BAR;
            PG8_LDA(At, 0, 1); PG8_STAGE_A(PG8_SA(0, 0), a2p, v2, 0, k2);
            PG8_BAR; PG8_WAIT_L(0); PG8_MMA(1, 0, At, B0); PG8_BAR; PG8_SCHED;
            PG8_STAGE_B(PG8_SB(0, 1), b2 + hstepB);
            PG8_WAIT_V(6); PG8_BAR; PG8_MMA(1, 1, At, B1); PG8_BAR;
            PG8_LDB(B0, 1, 0); PG8_SCHED; PG8_LDA(At, 1, 0); PG8_STAGE_A(PG8_SA(0, 1), a2p, v2, 1, k2);
            PG8_WAIT_L(8); PG8_BAR; PG8_WAIT_L(0); PG8_MMA(0, 0, At, B0); PG8_BAR; PG8_SCHED;
            PG8_LDB(B1, 1, 1); PG8_STAGE_B(PG8_SB(1, 0), b3);
            PG8_BAR; PG8_WAIT_L(0); PG8_MMA(0, 1, At, B1); PG8_BAR;
            PG8_LDA(At, 1, 1); PG8_STAGE_A(PG8_SA(1, 0), a2p, v2, 0, k2 + kstepA);
            PG8_BAR; PG8_WAIT_L(0); PG8_MMA(1, 0, At, B0); PG8_BAR; PG8_SCHED;
            PG8_STAGE_B(PG8_SB(1, 1), b3 + hstepB);
            PG8_WAIT_V(6); PG8_BAR; PG8_MMA(1, 1, At, B1); PG8_BAR;
        }
        E(acc, cur, wr, wc, fr, fq);
        if (!has_next) break;
#pragma unroll
        for (int a = 0; a < 2; ++a)
#pragma unroll
            for (int b = 0; b < 2; ++b)
#pragma unroll
                for (int m = 0; m < 4; ++m)
#pragma unroll
                    for (int n = 0; n < 2; ++n) acc[a][b][m][n] = (f32x4){0.f, 0.f, 0.f, 0.f};
        cur = nxt; cA = nA; cB = nB; ++ui;
#pragma unroll
        for (int h = 0; h < 2; ++h)
#pragma unroll
            for (int i = 0; i < 2; ++i) vA[h][i] = vN[h][i];
    }
    PG8_WAIT_V(0);
    if (wr == 0) PG8_BAR;
    PG8_BAR;
#undef PG8_SA
#undef PG8_SB
#undef PG8_STAGE_A
#undef PG8_STAGE_B
#undef PG8_LDA
#undef PG8_LDB
#undef PG8_MMA
#undef PG8_WAIT_V
#undef PG8_WAIT_L
#undef PG8_BAR
#undef PG8_SCHED
}

struct EpiStore {
    bf16_t* O; size_t ldc;
    DI void operator()(const f32x4 (&acc)[2][2][4][2], const Unit& u, int wr, int wc, int fr, int fq) const {
        const int row0 = u.pm * BM + wr * 64 + fr, col0 = u.pn * BM + wc * 32 + 8 * fq;
#pragma unroll
        for (int ai = 0; ai < 2; ++ai)
#pragma unroll
            for (int m = 0; m < 4; ++m) { bf16_t* rowp = O + (size_t)(row0 + ai * HALF + m * 16) * ldc + col0;
#pragma unroll
                for (int bj = 0; bj < 2; ++bj) { const f32x4 v0 = acc[ai][bj][m][0], v1 = acc[ai][bj][m][1];
                    u32x4 w; w.x = cvt_pk_bf16(v0[0], v0[1]); w.y = cvt_pk_bf16(v0[2], v0[3]); w.z = cvt_pk_bf16(v1[0], v1[1]); w.w = cvt_pk_bf16(v1[2], v1[3]);
                    *(u32x4*)(rowp + bj * HALF) = w; } }
    }
};
struct EpiSwiglu {
    bf16_t* Hb;
    DI void operator()(const f32x4 (&acc)[2][2][4][2], const Unit& u, int wr, int wc, int fr, int fq) const {
        const int row0 = u.pm * BM + wr * 64 + fr, col0 = u.pn * HALF + wc * 32 + 8 * fq;
#pragma unroll
        for (int ai = 0; ai < 2; ++ai)
#pragma unroll
            for (int m = 0; m < 4; ++m) { bf16_t* rowp = Hb + (size_t)(row0 + ai * HALF + m * 16) * DEXP + col0;
                float o[8];
#pragma unroll
                for (int n = 0; n < 2; ++n)
#pragma unroll
                    for (int j = 0; j < 4; ++j) { const float g = acc[ai][0][m][n][j], up = acc[ai][1][m][n][j];
                        o[n * 4 + j] = g * up * __builtin_amdgcn_rcpf(1.0f + __builtin_amdgcn_exp2f(-1.4426950408889634f * g)); }
                u32x4 w; w.x = cvt_pk_bf16(o[0], o[1]); w.y = cvt_pk_bf16(o[2], o[3]); w.z = cvt_pk_bf16(o[4], o[5]); w.w = cvt_pk_bf16(o[6], o[7]);
                *(u32x4*)rowp = w; }
    }
};

struct EpiNsa {
    bf16_t* Q; bf16_t* KV; float* GT;
    DI void operator()(const f32x4 (&acc)[2][2][4][2], const Unit& u, int wr, int wc, int fr, int fq) const {
        const int row0 = u.pm * BM + wr * 64 + fr;
        if (u.pn < 10) {
            bf16_t* base = (u.pn < 4) ? Q + u.pn * BM : KV + (u.pn - 4) * BM; const size_t ldc = (u.pn < 4) ? 1024 : 1536; const int col0 = wc * 32 + 8 * fq;
#pragma unroll
            for (int ai = 0; ai < 2; ++ai)
#pragma unroll
                for (int m = 0; m < 4; ++m) { bf16_t* rowp = base + (size_t)(row0 + ai * HALF + m * 16) * ldc + col0;
#pragma unroll
                    for (int bj = 0; bj < 2; ++bj) { const f32x4 v0 = acc[ai][bj][m][0], v1 = acc[ai][bj][m][1];
                        u32x4 w; w.x = cvt_pk_bf16(v0[0], v0[1]); w.y = cvt_pk_bf16(v0[2], v0[3]); w.z = cvt_pk_bf16(v1[0], v1[1]); w.w = cvt_pk_bf16(v1[2], v1[3]);
                        *(u32x4*)(rowp + bj * HALF) = w; } }
        } else {
            const int col0 = wc * 32 + 8 * fq;
            if (col0 < 48) {
#pragma unroll
                for (int ai = 0; ai < 2; ++ai)
#pragma unroll
                    for (int m = 0; m < 4; ++m) { float* rowp = GT + (size_t)(row0 + ai * HALF + m * 16) * 48 + col0;
#pragma unroll
                        for (int n = 0; n < 2; ++n) { f32x4 v = acc[ai][0][m][n];
#pragma unroll
                            for (int j = 0; j < 4; ++j) v[j] = __builtin_amdgcn_rcpf(1.0f + __builtin_amdgcn_exp2f(-1.4426950408889634f * v[j]));
                            *(f32x4*)(rowp + 4 * n) = v; } }
            }
        }
    }
};
struct EpiCmp {
    bf16_t* Hd; const float* bias;
    DI void operator()(const f32x4 (&acc)[2][2][4][2], const Unit& u, int wr, int wc, int fr, int fq) const {
        const int row0 = u.pm * BM + wr * 64 + fr, col0 = wc * 32 + 8 * fq; const float* bp = bias + u.e * 256;
#pragma unroll
        for (int bj = 0; bj < 2; ++bj) { const f32x4 b0 = *(const f32x4*)(bp + bj * HALF + col0), b1 = *(const f32x4*)(bp + bj * HALF + col0 + 4);
#pragma unroll
            for (int ai = 0; ai < 2; ++ai)
#pragma unroll
                for (int m = 0; m < 4; ++m) { float o[8];
#pragma unroll
                    for (int j = 0; j < 4; ++j) { o[j] = acc[ai][bj][m][0][j] + b0[j]; o[4 + j] = acc[ai][bj][m][1][j] + b1[j]; }
#pragma unroll
                    for (int j = 0; j < 8; ++j) { const float x = o[j], u2 = 1.5957691216057308f * (x + 0.044715f * x * x * x); o[j] = x * __builtin_amdgcn_rcpf(1.0f + __builtin_amdgcn_exp2f(-1.4426950408889634f * u2)); }
                    u32x4 w; w.x = cvt_pk_bf16(o[0], o[1]); w.y = cvt_pk_bf16(o[2], o[3]); w.z = cvt_pk_bf16(o[4], o[5]); w.w = cvt_pk_bf16(o[6], o[7]);
                    *(u32x4*)(Hd + (size_t)(row0 + ai * HALF + m * 16) * 256 + bj * HALF + col0) = w; } }
    }
};
struct CmpSched {
    static constexpr bool GATHER = false;
    const char* kv6; const char* Bt; int K; unsigned lda, kstepA; int G, c;
    DI bool next(int i, Unit& u) const { const int L = i * G + c; if (L >= 64) return false; u.pm = L; u.pn = 0; u.e = L >> 5; return true; }
    DI const char* a_base(const Unit& u) const { const int j = u.pm >> 5, bg = (u.pm >> 2) & 7, cq = u.pm & 3, b = bg >> 2, g = bg & 3;
        return kv6 + (((size_t)b * SEQ + (size_t)cq * 4096) * 1536 + j * 256 + g * 64) * 2; }
    DI const char* b_base(const Unit& u) const { return Bt + (size_t)(u.pm >> 5) * 256 * 2048 * 2; }
    DI unsigned row_off(int, int) const { return 0u; }
};
}

struct MoeMeta { LAS int* tstart; LAS int* cnt; };
DI int moe_expert_of(const MoeMeta& mm, int rt) { int e = 0;
#pragma unroll
    for (int k = 1; k < 16; ++k) e += (rt >= mm.tstart[k]) ? 1 : 0;
    return e; }
struct Moe1Sched {
    static constexpr bool GATHER = true;
    const char* A; const char* Bt; int K; unsigned lda, kstepA; MoeMeta mm; int ntiles, G, c; LAS unsigned* tab;
    DI bool next(int i, pg8::Unit& u) const { const int L = i * G + c; if (L >= ntiles * 2) return false; u.pm = L % ntiles; u.pn = L / ntiles; u.e = moe_expert_of(mm, u.pm); return true; }
    DI const char* a_base(const pg8::Unit&) const { return A; }
    DI const char* b_base(const pg8::Unit& u) const { return Bt + ((size_t)u.e * 512 + (size_t)u.pn * 256) * 1024 * 2; }
    DI unsigned row_off(int slot, int row) const { return tab[slot * 256 + row]; }
};
struct Moe2Sched {
    static constexpr bool GATHER = false;
    const char* A; const char* Bt; int K; unsigned lda, kstepA; MoeMeta mm; int ntiles, G, c;
    DI bool next(int i, pg8::Unit& u) const { const int L = i * G + c; if (L >= ntiles * 4) return false; u.pm = L % ntiles; u.pn = L / ntiles; u.e = moe_expert_of(mm, u.pm); return true; }
    DI const char* a_base(const pg8::Unit& u) const { return A + (size_t)u.pm * 256 * 512; }
    DI const char* b_base(const pg8::Unit& u) const { return Bt + ((size_t)u.e * 1024 + (size_t)u.pn * 256) * 256 * 2; }
    DI unsigned row_off(int, int) const { return 0u; }
};

struct Args { const float* in[25]; float* out; unsigned char* ws; int wv; int pad; };
enum { IN_X = 0, IN_REL, IN_RW, IN_RB, IN_LN1G, IN_LN1B, IN_LN2G, IN_LN2B, IN_EG, IN_EU, IN_ED, IN_DILIN, IN_DILOUT, IN_SBIN, IN_SBOUT,
       IN_NSAIN, IN_NSAOUT, IN_POSK, IN_W1K, IN_W2K, IN_POSV, IN_W1V, IN_W2V, IN_MOBAIN, IN_MOBAOUT };

DI void transpose_item(const float* W, int K, int N, int Nvalid, bf16_t* WT, int drow0, LAS float* scr, int kb, int nb, int lane) {
    const int k0 = 64 * kb, n0 = 32 * nb;
    const int c4 = lane & 7, kr = lane >> 3;
    if (n0 + 32 <= Nvalid) {
#pragma unroll
        for (int i = 0; i < 8; ++i) { const f32x4 v = *(const f32x4*)(W + (size_t)(k0 + kr + 8 * i) * N + n0 + 4 * c4); LAS float* s = scr + (kr + 8 * i) * 33 + 4 * c4;
            s[0] = v.x; s[1] = v.y; s[2] = v.z; s[3] = v.w; }
    } else {
#pragma unroll 8
        for (int i = 0; i < 32; ++i) { const int kk = 2 * i + (lane >> 5); const int n = n0 + (lane & 31); scr[kk * 33 + (lane & 31)] = (n < Nvalid) ? W[(size_t)(k0 + kk) * N + n] : 0.f; }
    }
    LDS_WAIT(); asm volatile("" ::: "memory");
    const int c = lane & 7;
#pragma unroll
    for (int j = 0; j < 4; ++j) { const int n = (lane >> 3) + 8 * j; const LAS float* s = scr + (8 * c) * 33 + n;
        u32x4 o; o.x = pk2(s[0 * 33], s[1 * 33]); o.y = pk2(s[2 * 33], s[3 * 33]); o.z = pk2(s[4 * 33], s[5 * 33]); o.w = pk2(s[6 * 33], s[7 * 33]);
        *(u32x4*)(WT + (size_t)(drow0 + n) * K + k0 + 8 * c) = o; }
    LDS_WAIT(); asm volatile("" ::: "memory");
}
DI void convert_matrix(const float* W, int K, int N, int Npad, bf16_t* WT, LAS float* scr, int gw, int NGW, int lane) {
    const int nblk = Npad / 32, nitems = (K / 64) * nblk;
    for (int it = gw; it < nitems; it += NGW) { const int kb = it / nblk, nb = it % nblk; transpose_item(W, K, N, N, WT, 32 * nb, scr, kb, nb, lane); }
}
DI void convert_layer_weights(const Args& a, int layer, LAS unsigned char* lds, int gw, int NGW, int wave, int lane) {
    LAS float* scr = (LAS float*)(lds + STAGE_OFF + wave * 16384);
    bf16_t* W1 = (bf16_t*)(a.ws + WS_WEXP1); bf16_t* W2 = (bf16_t*)(a.ws + WS_WEXP2);
    const float* eg = a.in[IN_EG] + (size_t)layer * NE * D * DEXP; const float* eu = a.in[IN_EU] + (size_t)layer * NE * D * DEXP; const float* ed = a.in[IN_ED] + (size_t)layer * NE * DEXP * D;
    constexpr int I_G = (D / 64) * (DEXP / 32);
    constexpr int I_D = (DEXP / 64) * (D / 32);
    constexpr int I_E = 2 * I_G + I_D;
    {
        bf16_t* Win = (bf16_t*)(a.ws + WS_WIN); bf16_t* Wout = (bf16_t*)(a.ws + WS_WOUT);
        if (layer == 0) { convert_matrix(a.in[IN_DILIN], D, 9216, 9216, Win, scr, gw, NGW, lane); convert_matrix(a.in[IN_DILOUT], D, D, D, Wout, scr, gw, NGW, lane); }
        if (layer == 1) { convert_matrix(a.in[IN_SBIN], D, 3072, 3072, Win, scr, gw, NGW, lane); convert_matrix(a.in[IN_SBOUT], D, D, D, Wout, scr, gw, NGW, lane); }
        if (layer == 2) { convert_matrix(a.in[IN_NSAIN], D, 2608, 2816, Win, scr, gw, NGW, lane); convert_matrix(a.in[IN_NSAOUT], D, D, D, Wout, scr, gw, NGW, lane);
            bf16_t* wc = (bf16_t*)(a.ws + WS_WCMP);
            convert_matrix(a.in[IN_W1K], 2048, 256, 256, wc, scr, gw, NGW, lane); convert_matrix(a.in[IN_W1V], 2048, 256, 256, wc + 256 * 2048, scr, gw, NGW, lane);
            convert_matrix(a.in[IN_W2K], 256, 64, 64, wc + 2 * 256 * 2048, scr, gw, NGW, lane); convert_matrix(a.in[IN_W2V], 256, 64, 64, wc + 2 * 256 * 2048 + 64 * 256, scr, gw, NGW, lane);
            float* cb = (float*)(a.ws + WS_WCMP + 2 * MiB + 64 * 1024);
            for (int it = gw; it < 512; it += NGW) { const int j = it >> 8, n = it & 255; const float* pos = a.in[j ? IN_POSV : IN_POSK]; const float* w1 = a.in[j ? IN_W1V : IN_W1K];
                float s = 0.f; for (int k = lane; k < 2048; k += 64) s += pos[k] * w1[(size_t)k * 256 + n];
                s = wave_sum(s); if (lane == 0) cb[it] = s; } }
        if (layer == 3) { convert_matrix(a.in[IN_MOBAIN], D, 3072, 3072, Win, scr, gw, NGW, lane); convert_matrix(a.in[IN_MOBAOUT], D, D, D, Wout, scr, gw, NGW, lane); }
    }
    const int NITEMS = NE * I_E;
    for (int it = gw; it < NITEMS; it += NGW) {
        const int e = it / I_E; int r = it % I_E;
        if (r < I_G) { const int kb = r / (DEXP / 32), nb = r % (DEXP / 32); const int n0 = 32 * nb;
            transpose_item(eg + (size_t)e * D * DEXP, D, DEXP, DEXP, W1, e * 512 + ((n0 >> 7) << 8) + (n0 & 127), scr, kb, nb, lane); continue; }
        r -= I_G;
        if (r < I_G) { const int kb = r / (DEXP / 32), nb = r % (DEXP / 32); const int n0 = 32 * nb;
            transpose_item(eu + (size_t)e * D * DEXP, D, DEXP, DEXP, W1, e * 512 + ((n0 >> 7) << 8) + 128 + (n0 & 127), scr, kb, nb, lane); continue; }
        r -= I_G;
        { const int kb = r / (D / 32), nb = r % (D / 32);
          transpose_item(ed + (size_t)e * DEXP * D, DEXP, D, D, W2, e * 1024 + 32 * nb, scr, kb, nb, lane); }
    }
}

struct RowVec { f32x4 v[4]; };
DI void ln_stats(const RowVec& r, float& mean, float& rstd) {
    float s = 0.f;
#pragma unroll
    for (int j = 0; j < 4; ++j) s += (r.v[j].x + r.v[j].y) + (r.v[j].z + r.v[j].w);
    mean = wave_sum(s) * (1.f / D); float s2 = 0.f;
#pragma unroll
    for (int j = 0; j < 4; ++j) { const f32x4 d = r.v[j] - mean; s2 += (d.x * d.x + d.y * d.y) + (d.z * d.z + d.w * d.w); }
    rstd = 1.f / sqrtf(wave_sum(s2) * (1.f / D) + LN_EPS);
}


constexpr int KSTR = 144;
constexpr int KVT = 64;
constexpr int KV_TILE_BYTES = KVT * KSTR;
constexpr float LOG2E = 1.4426950408889634f, LN2F = 0.6931471805599453f;
DI f32x16 mfma32(bf16x8 a, bf16x8 b, f32x16 c) { return __builtin_amdgcn_mfma_f32_32x32x16_bf16(a, b, c, 0, 0, 0); }
DI f32x16 zero16() { f32x16 z; for (int i = 0; i < 16; ++i) z[i] = 0.f; return z; }
DI void kv_fetch(u32x4& kr, u32x4& vr, const bf16_t* kb, const bf16_t* vb, size_t rstride, int row0, int nrows, int tid) {
    asm volatile("" : "+v"(tid));
    const int row = row0 + (tid >> 3), c16 = tid & 7;
    if (row >= 0 && row < nrows) { kr = *(const u32x4*)(kb + (size_t)row * rstride + c16 * 8); vr = *(const u32x4*)(vb + (size_t)row * rstride + c16 * 8); }
    else { kr = (u32x4){0u, 0u, 0u, 0u}; vr = kr; }
}
DI void kv_store(LAS unsigned char* kl, LAS unsigned char* vl, const u32x4& kr, const u32x4& vr, int tid) {
    asm volatile("" ::: "memory"); __builtin_amdgcn_sched_barrier(0);
    asm volatile("" : "+v"(tid));
    const int off = (tid >> 3) * KSTR + (tid & 7) * 16;
    *(LAS u32x4*)(kl + off) = kr; *(LAS u32x4*)(vl + off) = vr;
}
constexpr int DT_BYTES = 16384;
DI void kv_dma_issue(LAS unsigned char* slot, const bf16_t* kb, const bf16_t* vb, size_t rstride, int row0, int nrows, int wave, int lane) {
    asm volatile("" : "+v"(lane));
    const int rr = lane >> 3, row = min(max(row0 + 8 * wave + rr, 0), nrows - 1), ch = (lane & 7) ^ rr;
    const size_t off = (size_t)row * rstride + ch * 8;
    __builtin_amdgcn_global_load_lds((const unsigned*)(kb + off), (LAS unsigned*)(slot + wave * 1024), 16, 0, 0);
    __builtin_amdgcn_global_load_lds((const unsigned*)(vb + off), (LAS unsigned*)(slot + 8192 + wave * 1024), 16, 0, 0);
}
DI f32x16 qk_tile_sw(const LAS unsigned char* kl, int kt, const bf16x8 (&Q)[4], int lane) {
    asm volatile("" : "+v"(lane));
    const int r = lane & 31, h = lane >> 5;
    const int pr = (r & ~12) | ((r & 4) << 1) | ((r & 8) >> 1), sw = pr & 7;
    const LAS unsigned char* p = kl + (kt * 32 + pr) * 128;
    f32x16 S = zero16();
#pragma unroll
    for (int ks = 0; ks < 4; ++ks) { const bf16x8 A = *(const LAS bf16x8*)(p + (((2 * ks + h) ^ sw) << 4)); S = mfma32(A, Q[ks], S); }
    return S;
}
DI void pv_tile_sw(const LAS unsigned char* vl, int kt, const f32x16& P, f32x16 (&O)[2], int lane) {
    asm volatile("" : "+v"(lane));
    const int i16 = lane & 15, q = i16 >> 2, p = i16 & 3, blk = (lane >> 4) & 1, h = lane >> 5;
    const unsigned vp = (unsigned)(size_t)(vl + (kt * 32 + 8 * h + q) * 128 + 8 * (p & 1));
    const int c0 = 2 * blk + (p >> 1), c1 = 4 + c0;
    const unsigned a0 = vp + ((c0 ^ q) << 4), a1 = vp + 512 + ((c0 ^ (q + 4)) << 4), a2 = vp + ((c1 ^ q) << 4), a3 = vp + 512 + ((c1 ^ (q + 4)) << 4);
    s16x4 lo0, hi0, lo1, hi1, lo2, hi2, lo3, hi3;
    asm volatile("ds_read_b64_tr_b16 %0, %8\n\tds_read_b64_tr_b16 %1, %9\n\tds_read_b64_tr_b16 %2, %10\n\tds_read_b64_tr_b16 %3, %11\n\t"
                 "ds_read_b64_tr_b16 %4, %8 offset:2048\n\tds_read_b64_tr_b16 %5, %9 offset:2048\n\tds_read_b64_tr_b16 %6, %10 offset:2048\n\tds_read_b64_tr_b16 %7, %11 offset:2048\n\ts_waitcnt lgkmcnt(0)"
                 : "=&v"(lo0), "=&v"(hi0), "=&v"(lo1), "=&v"(hi1), "=&v"(lo2), "=&v"(hi2), "=&v"(lo3), "=&v"(hi3) : "v"(a0), "v"(a1), "v"(a2), "v"(a3) : "memory");
    { u32x4 pk; pk.x = cvt_pk_bf16(P[0], P[1]); pk.y = cvt_pk_bf16(P[2], P[3]); pk.z = cvt_pk_bf16(P[4], P[5]); pk.w = cvt_pk_bf16(P[6], P[7]);
      const bf16x8 Bp = __builtin_bit_cast(bf16x8, pk);
      O[0] = mfma32(__builtin_shufflevector(lo0, hi0, 0, 1, 2, 3, 4, 5, 6, 7), Bp, O[0]);
      O[1] = mfma32(__builtin_shufflevector(lo1, hi1, 0, 1, 2, 3, 4, 5, 6, 7), Bp, O[1]); }
    { u32x4 pk; pk.x = cvt_pk_bf16(P[8], P[9]); pk.y = cvt_pk_bf16(P[10], P[11]); pk.z = cvt_pk_bf16(P[12], P[13]); pk.w = cvt_pk_bf16(P[14], P[15]);
      const bf16x8 Bp = __builtin_bit_cast(bf16x8, pk);
      O[0] = mfma32(__builtin_shufflevector(lo2, hi2, 0, 1, 2, 3, 4, 5, 6, 7), Bp, O[0]);
      O[1] = mfma32(__builtin_shufflevector(lo3, hi3, 0, 1, 2, 3, 4, 5, 6, 7), Bp, O[1]); }
}
template <int NS, class RowF, class CompF>
DI void kv_dma_pipeline(int n, const RowF& rowf, const CompF& comp, const bf16_t* kb, const bf16_t* vb, size_t rstride, int nrows, LAS unsigned char* ring, int wave, int lane) {
    if (n <= 0) return;
#pragma unroll
    for (int i = 0; i < NS - 1; ++i) if (i < n) kv_dma_issue(ring + i * DT_BYTES, kb, vb, rstride, rowf(i), nrows, wave, lane);
    int sc = 0, sn = NS - 1;
#pragma unroll 1
    for (int j = 0; j < n; ++j) {
        const int rem = min(n - 1 - j, NS - 2);
        if (rem >= 4) asm volatile("s_waitcnt vmcnt(8)" ::: "memory");
        else if (rem == 3) asm volatile("s_waitcnt vmcnt(6)" ::: "memory");
        else if (rem == 2) asm volatile("s_waitcnt vmcnt(4)" ::: "memory");
        else if (rem == 1) asm volatile("s_waitcnt vmcnt(2)" ::: "memory");
        else asm volatile("s_waitcnt vmcnt(0)" ::: "memory");
        __builtin_amdgcn_s_barrier(); asm volatile("" ::: "memory");
        comp(j, ring + sc * DT_BYTES, ring + sc * DT_BYTES + 8192);
        if (j + NS - 1 < n) kv_dma_issue(ring + sn * DT_BYTES, kb, vb, rstride, rowf(j + NS - 1), nrows, wave, lane);
        sc = (sc + 1 == NS) ? 0 : sc + 1; sn = (sn + 1 == NS) ? 0 : sn + 1;
    }
    asm volatile("s_waitcnt lgkmcnt(0)" ::: "memory"); __builtin_amdgcn_s_barrier(); asm volatile("" ::: "memory");
}
template <int NS, class IssueF, class CompF>
DI void kv_dma_stream(int n, const IssueF& issue, const CompF& comp, LAS unsigned char* ring) {
    if (n <= 0) return;
#pragma unroll
    for (int i = 0; i < NS - 1; ++i) if (i < n) issue(i, ring + i * DT_BYTES);
    int sc = 0, sn = NS - 1;
#pragma unroll 1
    for (int j = 0; j < n; ++j) {
        const int rem = min(n - 1 - j, NS - 2);
        if (rem >= 4) asm volatile("s_waitcnt vmcnt(8)" ::: "memory");
        else if (rem == 3) asm volatile("s_waitcnt vmcnt(6)" ::: "memory");
        else if (rem == 2) asm volatile("s_waitcnt vmcnt(4)" ::: "memory");
        else if (rem == 1) asm volatile("s_waitcnt vmcnt(2)" ::: "memory");
        else asm volatile("s_waitcnt vmcnt(0)" ::: "memory");
        __builtin_amdgcn_s_barrier(); asm volatile("" ::: "memory");
        comp(j, ring + sc * DT_BYTES, ring + sc * DT_BYTES + 8192);
        if (j + NS - 1 < n) issue(j + NS - 1, ring + sn * DT_BYTES);
        sc = (sc + 1 == NS) ? 0 : sc + 1; sn = (sn + 1 == NS) ? 0 : sn + 1;
    }
    asm volatile("s_waitcnt lgkmcnt(0)" ::: "memory"); __builtin_amdgcn_s_barrier(); asm volatile("" ::: "memory");
}
DI f32x16 qk_tile(const LAS unsigned char* kl, int kt, const bf16x8 (&Q)[4], int lane) {
    asm volatile("" : "+v"(lane));
    const int r = lane & 31, h = lane >> 5;
    const int pr = (r & ~12) | ((r & 4) << 1) | ((r & 8) >> 1);
    const LAS unsigned char* p = kl + (kt * 32 + pr) * KSTR + h * 16;
    f32x16 S = zero16();
#pragma unroll
    for (int ks = 0; ks < 4; ++ks) { const bf16x8 A = *(const LAS bf16x8*)(p + ks * 32); S = mfma32(A, Q[ks], S); }
    return S;
}
DI void pv_tile(const LAS unsigned char* vl, int kt, const f32x16& P, f32x16 (&O)[2], int lane) {
    asm volatile("" : "+v"(lane));
    const int i16 = lane & 15, q = i16 >> 2, p = i16 & 3, blk = (lane >> 4) & 1, h = lane >> 5;
#pragma unroll
    for (int s = 0; s < 2; ++s) {
        u32x4 pk; pk.x = cvt_pk_bf16(P[8 * s + 0], P[8 * s + 1]); pk.y = cvt_pk_bf16(P[8 * s + 2], P[8 * s + 3]); pk.z = cvt_pk_bf16(P[8 * s + 4], P[8 * s + 5]); pk.w = cvt_pk_bf16(P[8 * s + 6], P[8 * s + 7]);
        const bf16x8 Bp = __builtin_bit_cast(bf16x8, pk);
        const LAS unsigned char* vp = vl + (kt * 32 + 16 * s + 8 * h + q) * KSTR + (16 * blk + 4 * p) * 2;
#pragma unroll
        for (int dt = 0; dt < 2; ++dt) {
            const s16x4 lo = __builtin_amdgcn_ds_read_tr16_b64_v4i16((LAS s16x4*)(vp + dt * 64));
            const s16x4 hi = __builtin_amdgcn_ds_read_tr16_b64_v4i16((LAS s16x4*)(vp + dt * 64 + 4 * KSTR));
            const bf16x8 A = __builtin_shufflevector(lo, hi, 0, 1, 2, 3, 4, 5, 6, 7);
            O[dt] = mfma32(A, Bp, O[dt]);
        }
    }
}
DI void store_o(bf16_t* orow, const f32x16 (&O)[2], float sc, int h) {
#pragma unroll
    for (int dt = 0; dt < 2; ++dt)
#pragma unroll
        for (int g = 0; g < 4; ++g) { u32x2 w; w.x = cvt_pk_bf16(O[dt][4 * g] * sc, O[dt][4 * g + 1] * sc); w.y = cvt_pk_bf16(O[dt][4 * g + 2] * sc, O[dt][4 * g + 3] * sc);
            *(u32x2*)(orow + dt * 32 + 8 * g + 4 * h) = w; }
}

constexpr int BT_PAD = 128, BT_LEN = BT_PAD + 2048;
constexpr int DIST_ANY = 0x3fffffff, DIST_NONE = 0x40000000;
constexpr size_t WS_BIASG = WS_SMALL + 256 * 1024;
DI void load_bias_table(LAS float* dst, const float* biasG, int head, int dsh, int tid, int hicut = 0x3fffffff) {
    for (int i = tid; i < BT_LEN; i += NTHR) { const int n = i - BT_PAD; dst[i] = (n >= 0 && n <= hicut) ? biasG[head * 2048 + min(n << dsh, 2047)] : -1e30f; }
}
template <int STRIDE, bool MASKED>
DI float logits_tile(f32x16 (&S)[2], const LAS float* P, int D0, int h, int lo, unsigned range) {
    float mx = -1e30f;
    if (!MASKED && __all(D0 - 63 * STRIDE >= 1512)) {
        const float cb = P[BT_PAD + 2047];
#pragma unroll
        for (int sub = 0; sub < 2; ++sub)
#pragma unroll
            for (int i = 0; i < 16; ++i) { const float x = S[sub][i] * (0.125f * LOG2E) + cb; S[sub][i] = x; mx = fmaxf(mx, x); }
        return mx;
    }
#pragma unroll
    for (int sub = 0; sub < 2; ++sub)
#pragma unroll
        for (int s = 0; s < 2; ++s) {
            const int d0 = D0 - (32 * sub + 16 * s + 8 * h) * STRIDE;
            const int base = min(max(d0 - 7 * STRIDE + BT_PAD, 0), BT_LEN - 1 - 7 * STRIDE);
            const LAS float* pb = P + base;
#pragma unroll
            for (int j = 0; j < 8; ++j) { const int i = 8 * s + j;
                float x = S[sub][i] * (0.125f * LOG2E) + pb[(7 - j) * STRIDE];
                if (MASKED) x = ((unsigned)(d0 - j * STRIDE - lo) <= range) ? x : -1e30f;
                S[sub][i] = x; mx = fmaxf(mx, x); }
        }
    return mx;
}
template <int STRIDE, bool MASKED>
DI void softmax_tile(f32x16 (&S)[2], float& m, float& l, f32x16 (&O)[2], const LAS float* P, int D0, int h, int lo, unsigned range) {
    float mx = logits_tile<STRIDE, MASKED>(S, P, D0, h, lo, range);
    mx = fmaxf(mx, xor32h(mx, h));
    const float mnew = fmaxf(m, mx), mm = (mnew <= -1e30f) ? 0.f : mnew;
    float ls = 0.f;
#pragma unroll
    for (int sub = 0; sub < 2; ++sub)
#pragma unroll
        for (int i = 0; i < 16; ++i) { const float p = __builtin_amdgcn_exp2f(S[sub][i] - mm); S[sub][i] = p; ls += p; }
    ls += xor32h(ls, h);
    if (!__all(mnew == m)) {
        const float alpha = __builtin_amdgcn_exp2f(m - mnew);
        l *= alpha;
#pragma unroll
        for (int dt = 0; dt < 2; ++dt)
#pragma unroll
            for (int i = 0; i < 16; ++i) O[dt][i] *= alpha;
    }
    l += ls; m = mnew;
}
template <int STRIDE, bool MASKED>
DI void stats_tile(f32x16 (&S)[2], float& m, float& l, const LAS float* P, int D0, int h, int lo, unsigned range) {
    float mx = logits_tile<STRIDE, MASKED>(S, P, D0, h, lo, range);
    mx = fmaxf(mx, xor32h(mx, h));
    const float mnew = fmaxf(m, mx), mm = (mnew <= -1e30f) ? 0.f : mnew;
    float ls = 0.f;
#pragma unroll
    for (int sub = 0; sub < 2; ++sub)
#pragma unroll
        for (int i = 0; i < 16; ++i) ls += __builtin_amdgcn_exp2f(S[sub][i] - mm);
    ls += xor32h(ls, h);
    l = l * __builtin_amdgcn_exp2f(m - mnew) + ls; m = mnew;
}

constexpr size_t BIG_OG = 288 * MiB;
constexpr size_t BIG_LSE = 384 * MiB;
DI void dilated_phase(const Args& a, LAS unsigned char* lds) {
    int tid = tid_of(a.wv); asm volatile("" : "+v"(tid));
    const int lane = tid & 63, wave = a.wv, c = lane & 31, h = lane >> 5;
    const bf16_t* qkv = (const bf16_t*)(a.ws + WS_BIG);
    LAS unsigned char* kbuf = lds; LAS unsigned char* vbuf = lds + 2 * KV_TILE_BYTES;
    LAS float* btab = (LAS float*)(lds + 4 * KV_TILE_BYTES);
    const float* biasG = (const float*)(a.ws + WS_BIASG);
    const int G = gridDim.x, bid = blockIdx.x;
    const int nu = bid < 3072 ? (3072 - bid + G - 1) / G : 0;
    if (nu == 0) return;
#define DL_DESC(k) const int u_ = bid + (k) * G, hh_ = u_ & 15, g_ = (u_ >> 4) >> 6, idx_ = (u_ >> 4) & 63, dsh_ = 2 * g_, r_ = idx_ & ((1 << dsh_) - 1), blk_ = idx_ >> dsh_; \
        const bf16_t* qb_ = qkv + (size_t)r_ * 9216 + g_ * 3072 + hh_ * 64; const size_t rs_ = (size_t)9216 << dsh_; (void)blk_; (void)qb_; (void)rs_;
    int cur_key = -1, buf = 0;
    int hh = 0, g = 0, dsh = 0, r = 0, Q0 = 0, q0w = 0, iq = 0;
    bf16x8 Q[4], Qn[4];
    f32x16 O[2]; float m = -1e30f, l = 0.f;
    u32x4 kr, vr;
    { DL_DESC(0)
      const bf16_t* qrow = qb_ + (size_t)(blk_ * 256 + 32 * wave + c) * rs_;
#pragma unroll
      for (int ks = 0; ks < 4; ++ks) Qn[ks] = *(const bf16x8*)(qrow + 16 * ks + 8 * h);
      kv_fetch(kr, vr, qb_ + 1024, qb_ + 2048, rs_, blk_ * 256 - 128, SEQ >> dsh_, tid); kv_store(kbuf, vbuf, kr, vr, tid); }
    const int total = nu * 6;
#pragma unroll 1
    for (int f = 0; f < total; ++f) {
        const int k = f / 6, j = f - 6 * k;
        if (j == 0) {
            DL_DESC(k)
            hh = hh_; g = g_; dsh = dsh_; r = r_; Q0 = blk_ * 256; q0w = Q0 + 32 * wave; iq = q0w + c;
#pragma unroll
            for (int ks = 0; ks < 4; ++ks) Q[ks] = Qn[ks];
            O[0] = zero16(); O[1] = zero16(); m = -1e30f; l = 0.f;
            if (hh * 4 + g != cur_key) { __syncthreads(); load_bias_table(btab, biasG, hh, dsh, tid, 128); cur_key = hh * 4 + g; }
        }
        __syncthreads();
        if (f + 1 < total) { const int k1 = (f + 1) / 6, j1 = (f + 1) - 6 * k1; DL_DESC(k1)
            kv_fetch(kr, vr, qb_ + 1024, qb_ + 2048, rs_, blk_ * 256 - 128 + 64 * j1, SEQ >> dsh_, tid); }
        { const int kr0 = Q0 - 128 + 64 * j;
          if (kr0 <= q0w + 31 && kr0 + 63 >= q0w - 128 && kr0 + 63 >= 0) {
            const LAS unsigned char* kl = kbuf + buf * KV_TILE_BYTES; const LAS unsigned char* vl = vbuf + buf * KV_TILE_BYTES;
            f32x16 S[2]; S[0] = qk_tile(kl, 0, Q, lane); S[1] = qk_tile(kl, 1, Q, lane);
            if (Q0 > 0) softmax_tile<1, false>(S, m, l, O, btab, iq - kr0, h, 0, 128u);
            else softmax_tile<1, true>(S, m, l, O, btab, iq - kr0, h, 0, (unsigned)min(128, iq));
            pv_tile(vl, 0, S[0], O, lane); pv_tile(vl, 1, S[1], O, lane);
          } }
        if (j == 3 && k + 1 < nu) { DL_DESC(k + 1)
            const bf16_t* qrow = qb_ + (size_t)(blk_ * 256 + 32 * wave + c) * rs_;
#pragma unroll
            for (int ks = 0; ks < 4; ++ks) Qn[ks] = *(const bf16x8*)(qrow + 16 * ks + 8 * h); }
        if (f + 1 < total) kv_store(kbuf + (buf ^ 1) * KV_TILE_BYTES, vbuf + (buf ^ 1) * KV_TILE_BYTES, kr, vr, tid);
        buf ^= 1;
        if (j == 5) {
            const int tok = (iq << dsh) + r;
            bf16_t* og = (bf16_t*)(a.ws + WS_BIG + BIG_OG) + (size_t)g * SEQ * D;
            float* lse = (float*)(a.ws + WS_BIG + BIG_LSE) + (size_t)g * SEQ * 16;
            store_o(og + (size_t)tok * D + hh * 64, O, 1.f / l, h);
            if (h == 0) lse[tok * 16 + hh] = m + __builtin_amdgcn_logf(l);
        }
    }
#undef DL_DESC
}
DI void dilated_merge(const Args& a, int b) {
    const int tid = tid_of(a.wv);
    const bf16_t* og = (const bf16_t*)(a.ws + WS_BIG + BIG_OG); const float* lse = (const float*)(a.ws + WS_BIG + BIG_LSE);
    bf16_t* outb = (bf16_t*)(a.ws + WS_ACTB) + (size_t)b * SEQ * D;
    for (int i = blockIdx.x * NTHR + tid; i < SEQ * 128; i += gridDim.x * NTHR) {
        const int tok = i >> 7, c8 = i & 127, hh = c8 >> 3;
        const float l0 = lse[tok * 16 + hh], l1 = lse[SEQ * 16 + tok * 16 + hh], l2 = lse[2 * SEQ * 16 + tok * 16 + hh];
        const float mx = fmaxf(l0, fmaxf(l1, l2));
        float w0 = __builtin_amdgcn_exp2f(l0 - mx), w1 = __builtin_amdgcn_exp2f(l1 - mx), w2 = __builtin_amdgcn_exp2f(l2 - mx);
        const float inv = 1.f / (w0 + w1 + w2); w0 *= inv; w1 *= inv; w2 *= inv;
        const u32x4 a0 = *(const u32x4*)(og + (size_t)tok * D + c8 * 8), a1 = *(const u32x4*)(og + (size_t)SEQ * D + (size_t)tok * D + c8 * 8), a2 = *(const u32x4*)(og + (size_t)2 * SEQ * D + (size_t)tok * D + c8 * 8);
        u32x4 o;
        o.x = pk2(w0 * bf_lo(a0.x) + w1 * bf_lo(a1.x) + w2 * bf_lo(a2.x), w0 * bf_hi(a0.x) + w1 * bf_hi(a1.x) + w2 * bf_hi(a2.x));
        o.y = pk2(w0 * bf_lo(a0.y) + w1 * bf_lo(a1.y) + w2 * bf_lo(a2.y), w0 * bf_hi(a0.y) + w1 * bf_hi(a1.y) + w2 * bf_hi(a2.y));
        o.z = pk2(w0 * bf_lo(a0.z) + w1 * bf_lo(a1.z) + w2 * bf_lo(a2.z), w0 * bf_hi(a0.z) + w1 * bf_hi(a1.z) + w2 * bf_hi(a2.z));
        o.w = pk2(w0 * bf_lo(a0.w) + w1 * bf_lo(a1.w) + w2 * bf_lo(a2.w), w0 * bf_hi(a0.w) + w1 * bf_hi(a1.w) + w2 * bf_hi(a2.w));
        *(u32x4*)(outb + (size_t)tok * D + c8 * 8) = o;
    }
}

constexpr size_t MB_KMEAN = WS_ACTB, MB_SELW = WS_ACTB + 1 * MiB, MB_LIST = WS_ACTB + 4 * MiB;
constexpr size_t BIG_OSEL = 192 * MiB, BIG_LSESEL = 384 * MiB;
constexpr int CW_MBCNT = 32768, CW_MBCUR = 32768 + 2048;
constexpr int CW_NSAQ = 40960;
constexpr int MB_LISTCAP = 49152;
DI void moba_kmean_phase(const Args& a, LAS unsigned char* lds) {
    const int tid = tid_of(a.wv);
    const bf16_t* qkv = (const bf16_t*)(a.ws + WS_BIG);
    float* kmean = (float*)(a.ws + MB_KMEAN);
    LAS float* part = (LAS float*)lds;
    for (int u = blockIdx.x; u < 2048; u += gridDim.x) {
        const int n = u & 63, bh = u >> 6, b = bh >> 4, hh = bh & 15;
        const bf16_t* kp = qkv + ((size_t)b * SEQ + n * 256 + (tid >> 3)) * 3072 + 1024 + hh * 64 + (tid & 7) * 8;
        float s[8];
#pragma unroll
        for (int j = 0; j < 8; ++j) s[j] = 0.f;
#pragma unroll
        for (int i = 0; i < 4; ++i) { const u32x4 v = *(const u32x4*)(kp + (size_t)(64 * i) * 3072);
            s[0] += bf_lo(v.x); s[1] += bf_hi(v.x); s[2] += bf_lo(v.y); s[3] += bf_hi(v.y); s[4] += bf_lo(v.z); s[5] += bf_hi(v.z); s[6] += bf_lo(v.w); s[7] += bf_hi(v.w); }
        __syncthreads();
        *(LAS f32x4*)(part + (tid >> 3) * 64 + (tid & 7) * 8) = (f32x4){s[0], s[1], s[2], s[3]}; *(LAS f32x4*)(part + (tid >> 3) * 64 + (tid & 7) * 8 + 4) = (f32x4){s[4], s[5], s[6], s[7]};
        __syncthreads();
        if (tid < 64) { float acc = 0.f;
#pragma unroll 8
            for (int gq = 0; gq < 64; ++gq) acc += part[gq * 64 + tid];
            kmean[((size_t)bh * 64 + n) * 64 + tid] = acc * (1.f / 256.f); }
    }
}
DI void moba_gate_phase(const Args& a, LAS unsigned char* lds) {
    int tid = tid_of(a.wv); asm volatile("" : "+v"(tid));
    const int lane = tid & 63, wave = __builtin_amdgcn_readfirstlane(tid >> 6), c = lane & 31, h = lane >> 5;
    const bf16_t* qkv = (const bf16_t*)(a.ws + WS_BIG);
    const float* kmean = (const float*)(a.ws + MB_KMEAN);
    unsigned* selw = (unsigned*)(a.ws + MB_SELW);
    unsigned* cnt = (unsigned*)(a.ws + WS_CTL) + CW_MBCNT;
    LAS unsigned char* khi = lds; LAS unsigned char* klo = lds + KV_TILE_BYTES;
    LAS int* hist = (LAS int*)(lds + 2 * KV_TILE_BYTES);
    int cur_bh = -1;
    for (int u = blockIdx.x; u < 2048; u += gridDim.x) {
        const int bh = u & 31, qb = u >> 5, b = bh >> 4, hh = bh & 15;
        const int t = qb * 256 + 32 * wave + c;
        __syncthreads();
        if (bh != cur_bh) { cur_bh = bh;
          const int row = tid >> 3, c16 = tid & 7; const float* kp = kmean + ((size_t)bh * 64 + row) * 64 + c16 * 8;
          const f32x4 v0 = *(const f32x4*)kp, v1 = *(const f32x4*)(kp + 4);
          float v[8] = {v0.x, v0.y, v0.z, v0.w, v1.x, v1.y, v1.z, v1.w}; unsigned hi[8], lo[8];
#pragma unroll
          for (int j = 0; j < 8; ++j) { hi[j] = f2bf(v[j]); lo[j] = f2bf(v[j] - u2f(hi[j] << 16)); }
          u32x4 wh, wl; wh.x = hi[0] | (hi[1] << 16); wh.y = hi[2] | (hi[3] << 16); wh.z = hi[4] | (hi[5] << 16); wh.w = hi[6] | (hi[7] << 16);
          wl.x = lo[0] | (lo[1] << 16); wl.y = lo[2] | (lo[3] << 16); wl.z = lo[4] | (lo[5] << 16); wl.w = lo[6] | (lo[7] << 16);
          kv_store(khi, klo, wh, wl, tid); }
        if (tid < 64) hist[tid] = 0;
        __syncthreads();
        bf16x8 Q[4];
        { const bf16_t* qrow = qkv + ((size_t)b * SEQ + t) * 3072 + hh * 64;
#pragma unroll
          for (int ks = 0; ks < 4; ++ks) Q[ks] = *(const bf16x8*)(qrow + 16 * ks + 8 * h); }
        f32x16 Gs[2];
#pragma unroll
        for (int sub = 0; sub < 2; ++sub) { const f32x16 a0 = qk_tile(khi, sub, Q, lane), a1 = qk_tile(klo, sub, Q, lane);
#pragma unroll
            for (int i = 0; i < 16; ++i) { const int n = sub * 32 + 16 * (i >> 3) + 8 * h + (i & 7); Gs[sub][i] = (n < qb) ? (a0[i] + a1[i]) : -1e30f; } }
        unsigned selpack = 0;
#pragma unroll
        for (int pass = 0; pass < 3; ++pass) {
            float bv = -3e38f; int bn = 64;
#pragma unroll
            for (int sub = 0; sub < 2; ++sub)
#pragma unroll
                for (int i = 0; i < 16; ++i) { const int n = sub * 32 + 16 * (i >> 3) + 8 * h + (i & 7); const float v = Gs[sub][i];
                    if (v > bv || (v == bv && n < bn)) { bv = v; bn = n; } }
            const float pv = __shfl_xor(bv, 32); const int pn = __shfl_xor(bn, 32);
            if (pv > bv || (pv == bv && pn < bn)) { bv = pv; bn = pn; }
            const bool ok = bv > -1e29f;
            selpack |= (ok ? (unsigned)bn : 255u) << (8 * pass);
            if (ok && h == 0) atomicAdd((int*)(hist + bn), 1);
#pragma unroll
            for (int sub = 0; sub < 2; ++sub)
#pragma unroll
                for (int i = 0; i < 16; ++i) { const int n = sub * 32 + 16 * (i >> 3) + 8 * h + (i & 7); if (n == bn) Gs[sub][i] = -3e38f; }
        }
        if (h == 0) selw[(size_t)bh * SEQ + t] = selpack;
        __syncthreads();
        if (tid < 64 && hist[tid] > 0) xb_add(cnt + bh * 64 + tid, (unsigned)hist[tid]);
    }
}
DI void moba_fill_phase(const Args& a, LAS unsigned char* lds) {
    const int tid = tid_of(a.wv);
    const unsigned* selw = (const unsigned*)(a.ws + MB_SELW);
    unsigned* cnt = (unsigned*)(a.ws + WS_CTL) + CW_MBCNT; unsigned* cur = (unsigned*)(a.ws + WS_CTL) + CW_MBCUR;
    unsigned* list = (unsigned*)(a.ws + MB_LIST);
    LAS int* hist = (LAS int*)lds; LAS int* gb = hist + 64; LAS int* off = gb + 64;
    for (int u = blockIdx.x; u < 2048; u += gridDim.x) {
        const int bh = u & 31, qb = u >> 5;
        __syncthreads();
        if (tid < 64) hist[tid] = 0;
        if (tid >= 64 && tid < 128) { const int n = tid - 64; const int v = (int)xb_ld(cnt + bh * 64 + n); int inc = v;
#pragma unroll
            for (int o = 1; o < 64; o <<= 1) { const int tv = __shfl_up(inc, o); if (n >= o) inc += tv; }
            off[n] = inc - v; }
        __syncthreads();
        unsigned sp = 0xffffffffu; int lp[3] = {0, 0, 0};
        if (tid < 256) { sp = selw[(size_t)bh * SEQ + qb * 256 + tid];
#pragma unroll
            for (int k = 0; k < 3; ++k) { const unsigned n = (sp >> (8 * k)) & 255u; if (n < 64u) lp[k] = atomicAdd((int*)(hist + n), 1); } }
        __syncthreads();
        if (tid < 64 && hist[tid] > 0) gb[tid] = (int)xb_add(cur + bh * 64 + tid, (unsigned)hist[tid]);
        __syncthreads();
        if (tid < 256) {
#pragma unroll
            for (int k = 0; k < 3; ++k) { const unsigned n = (sp >> (8 * k)) & 255u;
                if (n < 64u) list[(size_t)bh * MB_LISTCAP + off[n] + gb[n] + lp[k]] = (unsigned)(qb * 256 + tid) | ((unsigned)k << 14); } }
    }
}
DI void moba_sel_phase(const Args& a, LAS unsigned char* lds) {
    int tid = tid_of(a.wv); asm volatile("" : "+v"(tid));
    const int lane = tid & 63, wave = __builtin_amdgcn_readfirstlane(tid >> 6), c = lane & 31, h = lane >> 5;
    const bf16_t* qkv = (const bf16_t*)(a.ws + WS_BIG);
    const unsigned* cnt = (const unsigned*)(a.ws + WS_CTL) + CW_MBCNT;
    const unsigned* list = (const unsigned*)(a.ws + MB_LIST);
    bf16_t* osel = (bf16_t*)(a.ws + WS_BIG + BIG_OSEL); float* lsesel = (float*)(a.ws + WS_BIG + BIG_LSESEL);
    const float* biasG = (const float*)(a.ws + WS_BIASG);
    LAS unsigned char* kbuf = lds; LAS unsigned char* vbuf = lds + 2 * KV_TILE_BYTES;
    LAS float* btab = (LAS float*)(lds + 4 * KV_TILE_BYTES);
    LAS int* cs = (LAS int*)(lds + 4 * KV_TILE_BYTES + BT_LEN * 4);
    LAS int* eo = cs + 2052;
    LAS int* part = eo + 2052;
    { int cc[4], ee[4], sc = 0, se = 0;
#pragma unroll
      for (int j = 0; j < 4; ++j) { const int v = (int)xb_ld((unsigned*)cnt + tid * 4 + j); ee[j] = se; cc[j] = sc; se += v; sc += (v + 255) >> 8; }
      part[tid] = sc; part[512 + tid] = se;
      __syncthreads();
      if (tid == 0) { int a0 = 0, a1 = 0; for (int i = 0; i < 512; ++i) { const int v0 = part[i], v1 = part[512 + i]; part[i] = a0; part[512 + i] = a1; a0 += v0; a1 += v1; } cs[2048] = a0; eo[2048] = a1; }
      __syncthreads();
#pragma unroll
      for (int j = 0; j < 4; ++j) { cs[tid * 4 + j] = part[tid] + cc[j]; eo[tid * 4 + j] = part[512 + tid] + ee[j]; }
      __syncthreads(); }
    const int NC = cs[2048];
    int cur_hh = -1;
    for (int u = blockIdx.x; u < NC; u += gridDim.x) {
        int lo = 0, hi = 2047;
        while (lo < hi) { const int mid = (lo + hi + 1) >> 1; if (cs[mid] <= u) lo = mid; else hi = mid - 1; }
        const int item = lo, bh = item >> 6, n = item & 63, b = bh >> 4, hh = bh & 15;
        const int chunk = u - cs[item], nent = (int)xb_ld((unsigned*)cnt + item) - chunk * 256;
        const size_t ebase = (size_t)bh * MB_LISTCAP + (eo[item] - eo[bh * 64]) + chunk * 256;
        __syncthreads();
        if (hh != cur_hh) { load_bias_table(btab, biasG, hh, 0, tid); cur_hh = hh; }
        const int e = 32 * wave + c; const bool ev = e < nent;
        const unsigned ent = list[ebase + (ev ? e : 0)];
        const int t = ent & 16383, slot = ent >> 14;
        bf16x8 Q[4];
        { const bf16_t* qrow = qkv + ((size_t)b * SEQ + t) * 3072 + hh * 64;
#pragma unroll
          for (int ks = 0; ks < 4; ++ks) Q[ks] = *(const bf16x8*)(qrow + 16 * ks + 8 * h); }
        const bf16_t* kb = qkv + (size_t)b * SEQ * 3072 + 1024 + hh * 64; const bf16_t* vb = kb + 1024;
        f32x16 O[2]; O[0] = zero16(); O[1] = zero16();
        float m = -1e30f, l = 0.f;
        u32x4 kr, vr; int buf = 0;
        kv_fetch(kr, vr, kb, vb, 3072, n * 256, SEQ, tid); kv_store(kbuf, vbuf, kr, vr, tid);
        __syncthreads();
        for (int j = 0; j < 4; ++j) {
            if (j < 3) kv_fetch(kr, vr, kb, vb, 3072, n * 256 + 64 * (j + 1), SEQ, tid);
            const int k0 = n * 256 + 64 * j;
            if (32 * wave < nent) {
                const LAS unsigned char* kl = kbuf + buf * KV_TILE_BYTES; const LAS unsigned char* vl = vbuf + buf * KV_TILE_BYTES;
                f32x16 S[2]; S[0] = qk_tile(kl, 0, Q, lane); S[1] = qk_tile(kl, 1, Q, lane);
                softmax_tile<1, false>(S, m, l, O, btab, t - k0, h, 0, (unsigned)DIST_ANY);
                pv_tile(vl, 0, S[0], O, lane); pv_tile(vl, 1, S[1], O, lane);
            }
            if (j < 3) kv_store(kbuf + (buf ^ 1) * KV_TILE_BYTES, vbuf + (buf ^ 1) * KV_TILE_BYTES, kr, vr, tid);
            __syncthreads();
            buf ^= 1;
        }
        if (ev) { const size_t ob = ((size_t)bh * SEQ + t) * 3 + slot;
            store_o(osel + ob * 64, O, 1.f / l, h);
            if (h == 0) lsesel[ob] = m + __builtin_amdgcn_logf(l); }
    }
}
DI void moba_own_phase(const Args& a, LAS unsigned char* lds) {
    int tid = tid_of(a.wv); asm volatile("" : "+v"(tid));
    const int lane = tid & 63, wave = __builtin_amdgcn_readfirstlane(tid >> 6), c = lane & 31, h = lane >> 5;
    const bf16_t* qkv = (const bf16_t*)(a.ws + WS_BIG);
    const bf16_t* osel = (const bf16_t*)(a.ws + WS_BIG + BIG_OSEL); const float* lsesel = (const float*)(a.ws + WS_BIG + BIG_LSESEL);
    bf16_t* outb = (bf16_t*)(a.ws + WS_ACTB);
    const float* biasG = (const float*)(a.ws + WS_BIASG);
    LAS unsigned char* kbuf = lds; LAS unsigned char* vbuf = lds + 2 * KV_TILE_BYTES;
    LAS float* btab = (LAS float*)(lds + 4 * KV_TILE_BYTES);
    int cur_hh = -1;
    for (int u = blockIdx.x; u < 2048; u += gridDim.x) {
        const int bh = u & 31, qb = u >> 5, b = bh >> 4, hh = bh & 15;
        const int q0w = qb * 256 + 32 * wave, t = q0w + c;
        __syncthreads();
        if (hh != cur_hh) { load_bias_table(btab, biasG, hh, 0, tid); cur_hh = hh; }
        bf16x8 Q[4];
        { const bf16_t* qrow = qkv + ((size_t)b * SEQ + t) * 3072 + hh * 64;
#pragma unroll
          for (int ks = 0; ks < 4; ++ks) Q[ks] = *(const bf16x8*)(qrow + 16 * ks + 8 * h); }
        const bf16_t* kb = qkv + (size_t)b * SEQ * 3072 + 1024 + hh * 64; const bf16_t* vb = kb + 1024;
        f32x16 O[2]; O[0] = zero16(); O[1] = zero16();
        float m = -1e30f, l = 0.f;
        u32x4 kr, vr; int buf = 0;
        kv_fetch(kr, vr, kb, vb, 3072, qb * 256, SEQ, tid); kv_store(kbuf, vbuf, kr, vr, tid);
        __syncthreads();
        for (int j = 0; j < 4; ++j) {
            if (j < 3) kv_fetch(kr, vr, kb, vb, 3072, qb * 256 + 64 * (j + 1), SEQ, tid);
            const int k0 = qb * 256 + 64 * j;
            if (k0 <= q0w + 31) {
                const LAS unsigned char* kl = kbuf + buf * KV_TILE_BYTES; const LAS unsigned char* vl = vbuf + buf * KV_TILE_BYTES;
                f32x16 S[2]; S[0] = qk_tile(kl, 0, Q, lane); S[1] = qk_tile(kl, 1, Q, lane);
                softmax_tile<1, false>(S, m, l, O, btab, t - k0, h, 0, (unsigned)DIST_ANY);
                pv_tile(vl, 0, S[0], O, lane); pv_tile(vl, 1, S[1], O, lane);
            }
            if (j < 3) kv_store(kbuf + (buf ^ 1) * KV_TILE_BYTES, vbuf + (buf ^ 1) * KV_TILE_BYTES, kr, vr, tid);
            __syncthreads();
            buf ^= 1;
        }
        const int nv = qb < 3 ? qb : 3;
        const float lown = m + __builtin_amdgcn_logf(l);
        float ls[3]; float mx = lown;
        const size_t ob = ((size_t)bh * SEQ + t) * 3;
#pragma unroll
        for (int k = 0; k < 3; ++k) { ls[k] = (k < nv) ? lsesel[ob + k] : -1e30f; mx = fmaxf(mx, ls[k]); }
        float wown = __builtin_amdgcn_exp2f(lown - mx), wsum = wown, wk[3];
#pragma unroll
        for (int k = 0; k < 3; ++k) { wk[k] = (k < nv) ? __builtin_amdgcn_exp2f(ls[k] - mx) : 0.f; wsum += wk[k]; }
        const float inv = 1.f / wsum; wown *= inv / l;
#pragma unroll
        for (int dt = 0; dt < 2; ++dt)
#pragma unroll
            for (int i = 0; i < 16; ++i) O[dt][i] *= wown;
#pragma unroll
        for (int k = 0; k < 3; ++k) if (k < nv) { const float w = wk[k] * inv; const bf16_t* orow = osel + (ob + k) * 64;
#pragma unroll
            for (int dt = 0; dt < 2; ++dt)
#pragma unroll
                for (int g = 0; g < 4; ++g) { const u32x2 v = *(const u32x2*)(orow + dt * 32 + 8 * g + 4 * h);
                    O[dt][4 * g] += w * bf_lo(v.x); O[dt][4 * g + 1] += w * bf_hi(v.x); O[dt][4 * g + 2] += w * bf_lo(v.y); O[dt][4 * g + 3] += w * bf_hi(v.y); } }
        store_o(outb + ((size_t)b * SEQ + t) * D + hh * 64, O, 1.f, h);
    }
}

constexpr size_t NS_Q = 0, NS_KV = 64 * MiB, NS_GT = 164 * MiB, NS_HID = 172 * MiB, NS_KC = 180 * MiB, NS_KFR = 182 * MiB, NS_VFR = 198 * MiB;
DI void nsa_kcvc_phase(const Args& a, LAS unsigned char* lds) {
    int tid = tid_of(a.wv); asm volatile("" : "+v"(tid));
    {
        const bf16_t* kv6 = (const bf16_t*)(a.ws + WS_BIG + NS_KV); u32x4* kfr = (u32x4*)(a.ws + WS_BIG + NS_KFR); u32x4* vfr = (u32x4*)(a.ws + WS_BIG + NS_VFR);
        for (int tl = blockIdx.x; tl < 2048; tl += gridDim.x) {
            const int bg = tl >> 8, t0 = (tl & 255) * 64, b = bg >> 2, g = bg & 3;
            __syncthreads();
            { const int row = tid >> 3, c16 = tid & 7; const bf16_t* src_ = kv6 + ((size_t)b * SEQ + t0 + row) * 1536 + 2 * 256 + g * 64 + c16 * 8;
              *(LAS u32x4*)(lds + row * KSTR + c16 * 16) = *(const u32x4*)src_; *(LAS u32x4*)(lds + KV_TILE_BYTES + row * KSTR + c16 * 16) = *(const u32x4*)(src_ + 256); }
            __syncthreads();
            { const int f = tid >> 6, ln = tid & 63, r31 = ln & 31, hh = ln >> 5;
              { const int kt = f >> 2, ks = f & 3, pr = (r31 & ~12) | ((r31 & 4) << 1) | ((r31 & 8) >> 1);
                kfr[((size_t)tl * 8 + f) * 64 + ln] = *(const LAS u32x4*)(lds + (kt * 32 + pr) * KSTR + (16 * ks + 8 * hh) * 2); }
              { const int kt = f >> 2, s = (f >> 1) & 1, dt = f & 1; unsigned v[8];
#pragma unroll
                for (int i = 0; i < 8; ++i) v[i] = *(const LAS unsigned short*)(lds + KV_TILE_BYTES + (kt * 32 + 16 * s + 8 * hh + i) * KSTR + (dt * 32 + r31) * 2);
                u32x4 w; w.x = v[0] | (v[1] << 16); w.y = v[2] | (v[3] << 16); w.z = v[4] | (v[5] << 16); w.w = v[6] | (v[7] << 16);
                vfr[((size_t)tl * 8 + f) * 64 + ln] = w; } }
        }
    }
    const int lane = tid & 63, wave = __builtin_amdgcn_readfirstlane(tid >> 6), c = lane & 31, h = lane >> 5;
    const bf16_t* hidden = (const bf16_t*)(a.ws + WS_BIG + NS_HID); const bf16_t* w2t = (const bf16_t*)(a.ws + WS_WCMP) + 2 * 256 * 2048;
    bf16_t* kcvc = (bf16_t*)(a.ws + WS_BIG + NS_KC);
    for (int task = blockIdx.x * NWAVES + wave; task < 512; task += gridDim.x * NWAVES) {
        const int j = task >> 8, R0 = (task & 255) * 32;
        const bf16_t* hid = hidden + ((size_t)j * 8192 + R0 + c) * 256; const bf16_t* w2 = w2t + j * 64 * 256;
        f32x16 acc[2]; acc[0] = zero16(); acc[1] = zero16();
#pragma unroll
        for (int ks = 0; ks < 16; ++ks) { const bf16x8 Bv = *(const bf16x8*)(hid + 16 * ks + 8 * h);
#pragma unroll
            for (int dt = 0; dt < 2; ++dt) { const bf16x8 Av = *(const bf16x8*)(w2 + (dt * 32 + c) * 256 + 16 * ks + 8 * h); acc[dt] = mfma32(Av, Bv, acc[dt]); } }
        store_o(kcvc + ((size_t)j * 8192 + R0 + c) * 64, acc, 1.f, h);
    }
}
DI void nsa_attn_phase(const Args& a, LAS unsigned char* lds) {
    const int wave = a.wv;
#define NSA_VARS int tid = tid_of(a.wv); const int lane = tid & 63, c = lane & 31, h = lane >> 5, qi = c >> 2, r = c & 3, t = tw0 + qi; \
    const LAS float* bt = btab + r * (BT_LEN + 8); const float* gtp = gates + (tokbase + t) * 48 + 4 * g + r; (void)bt; (void)h; (void)lane; (void)gtp;
    const bf16_t* qb_ = (const bf16_t*)(a.ws + WS_BIG + NS_Q); const bf16_t* kv6 = (const bf16_t*)(a.ws + WS_BIG + NS_KV);
    const float* gates = (const float*)(a.ws + WS_BIG + NS_GT); const bf16_t* kcvc = (const bf16_t*)(a.ws + WS_BIG + NS_KC);
    bf16_t* outb = (bf16_t*)(a.ws + WS_ACTB); const float* biasG = (const float*)(a.ws + WS_BIASG);
    LAS unsigned char* ring = lds;
    LAS float* imp = (LAS float*)(lds + 49152);
    LAS float* btab = (LAS float*)(lds + 116736);
    LAS unsigned* selm = (LAS unsigned*)(lds + 151808);
    LAS unsigned* wm = selm + 512;
    LAS int* blist = (LAS int*)(wm + 64);
    LAS int* Oacc = (LAS int*)imp;
    constexpr int OAS = 66;
    LAS int* lacc = (LAS int*)(lds + 155392);
    constexpr float FXS = 16384.f;
    LAS float* mref = (LAS float*)(lds + 156416);
    LAS unsigned long long* qmask = (LAS unsigned long long*)(lds + 157440);
    LAS int* qsel = (LAS int*)(lds + 159488);
    const bf16x8* kfr = (const bf16x8*)(a.ws + WS_BIG + NS_KFR); const bf16x8* vfr = (const bf16x8*)(a.ws + WS_BIG + NS_VFR);
    int cur_g = -1;
    unsigned* nsa_ctr = (unsigned*)(a.ws + WS_CTL) + CW_NSAQ;
    volatile LAS int* uword = (volatile LAS int*)(lds + MISC_OFF + 160);
    for (;;) {
        const int bg = blockIdx.x & 7;
        __syncthreads();
        if (tid_of(a.wv) == 0) *uword = (int)xb_add(nsa_ctr + bg * 64, 1u);
        __syncthreads();
        const int uidx = *uword; if (uidx >= 256) break;
        const int tile = 255 - uidx, b = bg >> 2, g = bg & 3;
        const int T0 = tile * 64, tw0 = T0 + 8 * wave;
        const size_t tokbase = (size_t)b * SEQ;
        __syncthreads();
        bf16x8 Q[4];
        { NSA_VARS
          if (g != cur_g) { for (int rr = 0; rr < 4; ++rr) load_bias_table(btab + rr * (BT_LEN + 8), biasG, 4 * g + rr, 0, tid); cur_g = g; }
          for (int i = tid; i < 64 * 260; i += NTHR) imp[i] = 0.f;
          const bf16_t* qrow = qb_ + (tokbase + t) * 1024 + (4 * g + r) * 64;
#pragma unroll
          for (int ks = 0; ks < 4; ++ks) Q[ks] = *(const bf16x8*)(qrow + 16 * ks + 8 * h); }
        f32x16 OUT[2]; OUT[0] = zero16(); OUT[1] = zero16();
        const int nct = (T0 + 63 >= 31) ? (((T0 + 32) >> 4) >> 6) + 1 : 0;
        const int j0w = (T0 >= 511) ? ((T0 - 511) >> 6) : 0, nwin = tile - j0w + 1, nd = tile >= 2 ? 3 : tile + 1;
        const int e1 = nct, e2 = 2 * nct, e3 = e2 + nwin, e4 = e3 + nd;
        const bf16_t* kcb = kcvc + (size_t)bg * 1024 * 64; const bf16_t* vcb = kcb + (size_t)8192 * 64;
        const bf16_t* kvb = kv6 + tokbase * 1536 + g * 64;
        f32x16 O[2]; O[0] = zero16(); O[1] = zero16();
        float m = -1e30f, l = 0.f, mc = -1e30f, lc = 0.f, invl = 0.f, mfin = 0.f;
        __syncthreads();
        kv_dma_stream<3>(e4, [&](int fi, LAS unsigned char* slot) {
                const int lane = tid_of(a.wv) & 63;
                if (fi < e2) kv_dma_issue(slot, kcb, vcb, 64, 64 * (fi < e1 ? fi : fi - e1), 1024, wave, lane);
                else if (fi < e3) kv_dma_issue(slot, kvb + 4 * 256, kvb + 5 * 256, 1536, (j0w + fi - e2) * 64, SEQ, wave, lane);
                else { const int i = fi - e3, blk = (i == 0) ? 0 : (tile >= 2 ? tile - 2 + i : i); kv_dma_issue(slot, kvb + 2 * 256, kvb + 3 * 256, 1536, blk * 64, SEQ, wave, lane); }
            }, [&](int fi, const LAS unsigned char* kl, const LAS unsigned char* vl) {
                NSA_VARS
                if (fi < e1) {
                    const int c0 = 64 * fi;
                    if (16 * c0 + 31 <= tw0 + 7) {
                        f32x16 S[2]; S[0] = qk_tile_sw(kl, 0, Q, lane); S[1] = qk_tile_sw(kl, 1, Q, lane);
                        stats_tile<16, false>(S, mc, lc, bt, t - 16 * c0 - 31, h, 0, (unsigned)DIST_ANY);
                    }
                } else if (fi < e2) {
                    if (fi == e1) { invl = lc > 0.f ? 1.f / lc : 0.f; mfin = (mc <= -1e30f) ? 0.f : mc; }
                    const int c0 = 64 * (fi - e1);
                    if (16 * c0 + 31 <= tw0 + 7) {
                        f32x16 S[2]; S[0] = qk_tile_sw(kl, 0, Q, lane); S[1] = qk_tile_sw(kl, 1, Q, lane);
                        (void)logits_tile<16, false>(S, bt, t - 16 * c0 - 31, h, 0, (unsigned)DIST_ANY);
#pragma unroll
                        for (int sub = 0; sub < 2; ++sub)
#pragma unroll
                            for (int i = 0; i < 16; ++i) S[sub][i] = __builtin_amdgcn_exp2f(S[sub][i] - mfin) * invl;
#pragma unroll
                        for (int sub = 0; sub < 2; ++sub)
#pragma unroll
                            for (int s = 0; s < 2; ++s) { const int j0 = (c0 + sub * 32 + 16 * s + 8 * h) >> 2;
                                float a0 = (S[sub][8 * s] + S[sub][8 * s + 1]) + (S[sub][8 * s + 2] + S[sub][8 * s + 3]);
                                float a1 = (S[sub][8 * s + 4] + S[sub][8 * s + 5]) + (S[sub][8 * s + 6] + S[sub][8 * s + 7]) + S[sub][8 * s + 3];
                                float a2 = S[sub][8 * s + 7];
                                a0 += quad_xor1(a0); a1 += quad_xor1(a1); a2 += quad_xor1(a2);
                                a0 += quad_xor2(a0); a1 += quad_xor2(a1); a2 += quad_xor2(a2);
                                if (r == 0) { LAS float* ip = imp + (8 * wave + qi) * 260 + j0; atomicAdd((float*)ip, a0); atomicAdd((float*)(ip + 1), a1); atomicAdd((float*)(ip + 2), a2); } }
                        pv_tile_sw(vl, 0, S[0], O, lane); pv_tile_sw(vl, 1, S[1], O, lane);
                    }
                    if (fi == e2 - 1) { const float gt_cmp = gtp[0];
#pragma unroll
                        for (int dt = 0; dt < 2; ++dt)
#pragma unroll
                            for (int i = 0; i < 16; ++i) { OUT[dt][i] += gt_cmp * O[dt][i]; O[dt][i] = 0.f; } }
                } else if (fi < e3) {
                    const int k0 = (j0w + fi - e2) * 64;
                    if (k0 <= tw0 + 7 && k0 + 63 >= tw0 - 511) {
                        f32x16 S[2]; S[0] = qk_tile_sw(kl, 0, Q, lane); S[1] = qk_tile_sw(kl, 1, Q, lane);
                        if (k0 >= tw0 + 7 - 511) softmax_tile<1, false>(S, m, l, O, bt, t - k0, h, 0, 511u);
                        else softmax_tile<1, true>(S, m, l, O, bt, t - k0, h, 0, 511u);
                        pv_tile_sw(vl, 0, S[0], O, lane); pv_tile_sw(vl, 1, S[1], O, lane);
                    }
                    if (fi == e3 - 1) { const float sc_ = gtp[32] / l;
#pragma unroll
                        for (int dt = 0; dt < 2; ++dt)
#pragma unroll
                            for (int i = 0; i < 16; ++i) { OUT[dt][i] += sc_ * O[dt][i]; O[dt][i] = 0.f; }
                        m = -1e30f; l = 0.f; }
                } else {
                    const int i = fi - e3, blk = (i == 0) ? 0 : (tile >= 2 ? tile - 2 + i : i), k0 = blk * 64;
                    f32x16 S[2]; S[0] = qk_tile_sw(kl, 0, Q, lane); S[1] = qk_tile_sw(kl, 1, Q, lane);
                    softmax_tile<1, false>(S, m, l, O, bt, t - k0, h, 0, (unsigned)DIST_ANY);
                    pv_tile_sw(vl, 0, S[0], O, lane); pv_tile_sw(vl, 1, S[1], O, lane);
                }
            }, ring);
        __syncthreads();
#pragma unroll 1
        for (int qh = 0; qh < 2; ++qh) {
            const int lane = tid_of(a.wv) & 63;
            const int cur = tile;
            unsigned key[4][4];
#pragma unroll
            for (int q4 = 0; q4 < 4; ++q4) { const int ql = 8 * wave + 4 * qh + q4;
#pragma unroll
                for (int kk = 0; kk < 4; ++kk) { const int j = lane + 64 * kk; const bool forced = (j == 0) || (j == cur) || (j + 1 == cur);
                    key[q4][kk] = forced ? 0xffffffffu : ((j <= cur) ? f2u(imp[ql * 260 + j]) + 1u : 0u); } }
            unsigned prefix[4] = {0u, 0u, 0u, 0u};
#pragma unroll 1
            for (int bit = 31; bit >= 0; --bit) {
#pragma unroll
                for (int q4 = 0; q4 < 4; ++q4) { const unsigned cand = prefix[q4] | (1u << bit); int cnt = 0;
#pragma unroll
                    for (int kk = 0; kk < 4; ++kk) cnt += __popcll(__ballot(key[q4][kk] >= cand));
                    if (cnt >= 16) prefix[q4] = cand; } }
            const unsigned long long ltmask = (1ull << lane) - 1ull;
#pragma unroll
            for (int q4 = 0; q4 < 4; ++q4) { const int ql = 8 * wave + 4 * qh + q4; const unsigned pf = prefix[q4];
                int cgt = 0;
#pragma unroll
                for (int kk = 0; kk < 4; ++kk) cgt += __popcll(__ballot(key[q4][kk] > pf));
                const int need = 16 - cgt; int running = 0;
#pragma unroll
                for (int kk = 0; kk < 4; ++kk) { const unsigned long long eqb = __ballot(key[q4][kk] == pf);
                    const bool take = key[q4][kk] > pf || (pf != 0u && key[q4][kk] == pf && running + __popcll(eqb & ltmask) < need);
                    running += __popcll(eqb);
                    const unsigned long long bal = __ballot(take);
                    if (lane == 0) { selm[ql * 8 + 2 * kk] = (unsigned)bal; selm[ql * 8 + 2 * kk + 1] = (unsigned)(bal >> 32); } } }
        }
        __syncthreads();
        { const int tid = tid_of(a.wv);
          if (tid < 8) { unsigned o = 0u;
              if (tid == 0) o |= 1u;
              if ((tile >> 5) == tid) o |= 1u << (tile & 31);
              if (tile >= 1 && ((tile - 1) >> 5) == tid) o |= 1u << ((tile - 1) & 31);
              wm[tid] = o; } }
        __syncthreads();
        { const int lane = tid_of(a.wv) & 63;
#pragma unroll 1
          for (int jj = 0; jj < 32; ++jj) { const int j = wave * 32 + jj; const unsigned w = selm[lane * 8 + (j >> 5)] & ~wm[j >> 5];
              const unsigned long long bal = __ballot((w >> (j & 31)) & 1u); if (lane == 0) qmask[j] = bal; } }
        {
            NSA_VARS
            LAS int* oa = Oacc + ((8 * wave + qi) * 4 + r) * OAS;
#pragma unroll
            for (int dt = 0; dt < 2; ++dt)
#pragma unroll
                for (int g4 = 0; g4 < 4; ++g4) { u32x2 w0, w1; w0.x = (unsigned)(int)(O[dt][4 * g4] * FXS); w0.y = (unsigned)(int)(O[dt][4 * g4 + 1] * FXS); w1.x = (unsigned)(int)(O[dt][4 * g4 + 2] * FXS); w1.y = (unsigned)(int)(O[dt][4 * g4 + 3] * FXS);
                    *(LAS u32x2*)(oa + dt * 32 + 8 * g4 + 4 * h) = w0; *(LAS u32x2*)(oa + dt * 32 + 8 * g4 + 4 * h + 2) = w1; }
            if (h == 0) { lacc[(8 * wave + qi) * 4 + r] = (int)(l * FXS); mref[(8 * wave + qi) * 4 + r] = m; }
        }
        __syncthreads();
        {
            NSA_VARS
            LAS int* qs = qsel + wave * 8;
            const unsigned long long ltm = (1ull << lane) - 1ull;
            int j = wave; unsigned long long qm = 0ull;
            while (j <= tile) { qm = qmask[j]; if (qm != 0ull) break; j += 8; }
            if (j <= tile) {
                int n = __popcll(qm), ch = 0;
                if ((qm >> lane) & 1ull) { const int rk = __popcll(qm & ltm); if (rk < 8) qs[rk] = lane; }
                bool lv = qi < n; int ql = qs[lv ? qi : 0];
                bf16x8 KA[2][4], VA[2][2][2], Qs[4];
                { const bf16x8* kp = kfr + ((size_t)(bg * 256 + j) * 8) * 64 + lane; const bf16x8* vp = vfr + ((size_t)(bg * 256 + j) * 8) * 64 + lane;
                  const bf16_t* qrow = qb_ + (tokbase + T0 + ql) * 1024 + (4 * g + r) * 64;
#pragma unroll
                  for (int ks = 0; ks < 4; ++ks) Qs[ks] = *(const bf16x8*)(qrow + 16 * ks + 8 * h);
#pragma unroll
                  for (int f8 = 0; f8 < 8; ++f8) KA[f8 >> 2][f8 & 3] = kp[f8 * 64];
#pragma unroll
                  for (int f8 = 0; f8 < 8; ++f8) VA[f8 >> 2][(f8 >> 1) & 1][f8 & 1] = vp[f8 * 64]; }
#pragma unroll 1
                for (;;) {
                    int jn = j, chn = ch + 1, nn = n; unsigned long long qmn = qm;
                    if (chn * 8 >= n) { chn = 0; jn = j + 8; qmn = 0ull; while (jn <= tile) { qmn = qmask[jn]; if (qmn != 0ull) break; jn += 8; } nn = __popcll(qmn); }
                    const bool has_next = jn <= tile, newblk = jn != j;
                    f32x16 S[2];
#pragma unroll
                    for (int kt = 0; kt < 2; ++kt) { S[kt] = zero16();
#pragma unroll
                        for (int ks = 0; ks < 4; ++ks) S[kt] = mfma32(KA[kt][ks], Qs[ks], S[kt]); }
                    const int tq = T0 + ql, D0 = tq - j * 64;
                    const float mr = mref[ql * 4 + r];
                    LAS int* oa = Oacc + (ql * 4 + r) * OAS + 4 * h; LAS int* la = lacc + ql * 4 + r;
                    const bool lvc = lv;
                    if (has_next) {
                        if ((qmn >> lane) & 1ull) { const int rk = __popcll(qmn & ltm) - 8 * chn; if (rk >= 0 && rk < 8) qs[rk] = lane; }
                        lv = qi < nn - 8 * chn; ql = qs[lv ? qi : 0];
                        const bf16_t* qrow = qb_ + (tokbase + T0 + ql) * 1024 + (4 * g + r) * 64;
#pragma unroll
                        for (int ks = 0; ks < 4; ++ks) Qs[ks] = *(const bf16x8*)(qrow + 16 * ks + 8 * h);
                        if (newblk) { const bf16x8* kp = kfr + ((size_t)(bg * 256 + jn) * 8) * 64 + lane;
#pragma unroll
                            for (int f8 = 0; f8 < 8; ++f8) KA[f8 >> 2][f8 & 3] = kp[f8 * 64]; }
                    }
                    (void)logits_tile<1, false>(S, bt, D0, h, 0, (unsigned)DIST_ANY);
                    float ls = 0.f;
#pragma unroll
                    for (int kt = 0; kt < 2; ++kt)
#pragma unroll
                        for (int i = 0; i < 16; ++i) { const float p = lvc ? __builtin_amdgcn_exp2f(S[kt][i] - mr) : 0.f; S[kt][i] = p; ls += p; }
                    ls += xor32h(ls, h);
                    f32x16 Oa[2]; Oa[0] = zero16(); Oa[1] = zero16();
#pragma unroll
                    for (int kt = 0; kt < 2; ++kt)
#pragma unroll
                        for (int s = 0; s < 2; ++s) {
                            u32x4 pk; pk.x = cvt_pk_bf16(S[kt][8 * s + 0], S[kt][8 * s + 1]); pk.y = cvt_pk_bf16(S[kt][8 * s + 2], S[kt][8 * s + 3]); pk.z = cvt_pk_bf16(S[kt][8 * s + 4], S[kt][8 * s + 5]); pk.w = cvt_pk_bf16(S[kt][8 * s + 6], S[kt][8 * s + 7]);
                            const bf16x8 Bp = __builtin_bit_cast(bf16x8, pk);
                            Oa[0] = mfma32(VA[kt][s][0], Bp, Oa[0]); Oa[1] = mfma32(VA[kt][s][1], Bp, Oa[1]); }
                    if (has_next && newblk) { const bf16x8* vp = vfr + ((size_t)(bg * 256 + jn) * 8) * 64 + lane;
#pragma unroll
                        for (int f8 = 0; f8 < 8; ++f8) VA[f8 >> 2][(f8 >> 1) & 1][f8 & 1] = vp[f8 * 64]; }
                    if (lvc) {
#pragma unroll
                        for (int dt = 0; dt < 2; ++dt)
#pragma unroll
                            for (int i = 0; i < 16; ++i) atomicAdd((int*)(oa + dt * 32 + (i & 3) + 8 * (i >> 2)), (int)(Oa[dt][i] * FXS));
                        if (h == 0) atomicAdd((int*)la, (int)(ls * FXS)); }
                    if (!has_next) break;
                    j = jn; ch = chn; qm = qmn; n = nn;
                }
            }
        }
        __syncthreads();
        {
            NSA_VARS
            const float gt_sel = gtp[16];
            const LAS int* oa = Oacc + ((8 * wave + qi) * 4 + r) * OAS;
            const float sc_ = gt_sel / (float)lacc[(8 * wave + qi) * 4 + r];
#pragma unroll
            for (int dt = 0; dt < 2; ++dt)
#pragma unroll
                for (int g4 = 0; g4 < 4; ++g4) { const u32x2 v0 = *(const LAS u32x2*)(oa + dt * 32 + 8 * g4 + 4 * h), v1 = *(const LAS u32x2*)(oa + dt * 32 + 8 * g4 + 4 * h + 2);
                    OUT[dt][4 * g4] += sc_ * (float)(int)v0.x; OUT[dt][4 * g4 + 1] += sc_ * (float)(int)v0.y; OUT[dt][4 * g4 + 2] += sc_ * (float)(int)v1.x; OUT[dt][4 * g4 + 3] += sc_ * (float)(int)v1.y; }
        }
        { NSA_VARS
          store_o(outb + (tokbase + t) * D + (4 * g + r) * 64, OUT, 1.f, h); }
    }
#undef NSA_VARS
}

DI void sb_phase(const Args& a, LAS unsigned char* lds) {
    int tid = tid_of(a.wv); asm volatile("" : "+v"(tid));
    const int lane = tid & 63, wave = __builtin_amdgcn_readfirstlane(tid >> 6), c = lane & 31, h = lane >> 5;
    const bf16_t* qkv = (const bf16_t*)(a.ws + WS_BIG);
    bf16_t* outb = (bf16_t*)(a.ws + WS_ACTB);
    LAS unsigned char* kbuf = lds; LAS unsigned char* vbuf = lds + 2 * KV_TILE_BYTES;
    volatile LAS int* flags = (volatile LAS int*)(lds + 4 * KV_TILE_BYTES);
    for (int u = blockIdx.x; u < 2048; u += gridDim.x) {
        const int qb = u & 63, hh = (u >> 6) & 15, b = u >> 10;
        const int q0w = qb * 256 + 32 * wave, t = q0w + c;
        const size_t tokbase = (size_t)b * SEQ;
        const bf16_t* kb = qkv + tokbase * 3072 + 1024 + hh * 64;
        const bf16_t* vb = qkv + tokbase * 3072 + 2048 + hh * 64;
        bf16x8 Q[4];
        { const bf16_t* qrow = qkv + (tokbase + t) * 3072 + hh * 64;
#pragma unroll
          for (int ks = 0; ks < 4; ++ks) Q[ks] = *(const bf16x8*)(qrow + 16 * ks + 8 * h); }
        f32x16 O[2]; O[0] = zero16(); O[1] = zero16();
        float carry = 1.f; bool wdone = false;
        int jt = qb * 4 + 3, buf = 0;
        u32x4 kr, vr;
        kv_fetch(kr, vr, kb, vb, 3072, jt * 64, SEQ, tid); kv_store(kbuf, vbuf, kr, vr, tid);
        __syncthreads();
        for (; jt >= 0; --jt) {
            if (jt > 0) kv_fetch(kr, vr, kb, vb, 3072, (jt - 1) * 64, SEQ, tid);
            const int kb0 = jt * 64;
            if (!wdone && kb0 < q0w + 31) {
                const LAS unsigned char* kl = kbuf + buf * KV_TILE_BYTES; const LAS unsigned char* vl = vbuf + buf * KV_TILE_BYTES;
                f32x16 SP[2], U[2];
                SP[0] = qk_tile(kl, 0, Q, lane); SP[1] = qk_tile(kl, 1, Q, lane);
                float Tc[2][2];
#pragma unroll
                for (int sub = 0; sub < 2; ++sub)
#pragma unroll
                    for (int s = 0; s < 2; ++s) { float acc = 1.f;
#pragma unroll
                        for (int j = 0; j < 8; ++j) { const int i = 8 * s + j; const int key = kb0 + sub * 32 + 16 * s + 8 * h + j;
                            const float z = __builtin_amdgcn_fmed3f(SP[sub][i] * 0.125f, -60.f, 60.f);
                            const float e = __builtin_amdgcn_exp2f(z * LOG2E);
                            const float u = __builtin_amdgcn_rcpf(1.f + e);
                            const bool valid = key < t;
                            SP[sub][i] = valid ? e * u : 0.f; U[sub][i] = valid ? u : 1.f; acc *= U[sub][i]; }
                        Tc[sub][s] = acc; }
                float Tp[2][2], pr[2][2];
#pragma unroll
                for (int sub = 0; sub < 2; ++sub)
#pragma unroll
                    for (int s = 0; s < 2; ++s) { Tp[sub][s] = xor32h(Tc[sub][s], h); pr[sub][s] = Tc[sub][s] * Tp[sub][s]; }
                float offp[2][2];
                offp[1][1] = carry; offp[1][0] = offp[1][1] * pr[1][1]; offp[0][1] = offp[1][0] * pr[1][0]; offp[0][0] = offp[0][1] * pr[0][1];
                carry = offp[0][0] * pr[0][0];
#pragma unroll
                for (int sub = 0; sub < 2; ++sub)
#pragma unroll
                    for (int s = 0; s < 2; ++s) { float run = offp[sub][s] * (h == 0 ? Tp[sub][s] : 1.f);
#pragma unroll
                        for (int j = 7; j >= 0; --j) { const int i = 8 * s + j; SP[sub][i] *= run; run *= U[sub][i]; } }
                pv_tile(vl, 0, SP[0], O, lane); pv_tile(vl, 1, SP[1], O, lane);
                wdone = __all(carry < 1e-38f);
            }
            if (lane == 0) flags[buf * 8 + wave] = wdone ? 1 : 0;
            if (jt > 0) kv_store(kbuf + (buf ^ 1) * KV_TILE_BYTES, vbuf + (buf ^ 1) * KV_TILE_BYTES, kr, vr, tid);
            __syncthreads();
            int alld = 1;
#pragma unroll
            for (int w = 0; w < 8; ++w) alld &= flags[buf * 8 + w];
            buf ^= 1;
            if (alld) break;
        }
        store_o(outb + (tokbase + t) * D + hh * 64, O, 1.f, h);
        __syncthreads();
    }
}

#ifndef DBG
#define DBG 0
#endif
#if DBG
DI float dbg_block_max(float v, LAS float* red) {
#pragma unroll
    for (int o = 1; o < 64; o <<= 1) v = fmaxf(v, __shfl_xor(v, o));
    __syncthreads();
    if ((threadIdx.x & 63) == 0) red[threadIdx.x >> 6] = v;
    __syncthreads();
    float r = red[0];
    for (int i = 1; i < 8; ++i) r = fmaxf(r, red[i]);
    __syncthreads();
    return r;
}
DI float dbg_block_sum(float v, LAS float* red) {
#pragma unroll
    for (int o = 1; o < 64; o <<= 1) v += __shfl_xor(v, o);
    __syncthreads();
    if ((threadIdx.x & 63) == 0) red[threadIdx.x >> 6] = v;
    __syncthreads();
    float r = 0.f;
    for (int i = 0; i < 8; ++i) r += red[i];
    __syncthreads();
    return r;
}
DI void dbg_note(unsigned* ctl, int idx, float err) { if (threadIdx.x == 0) atomicMax(ctl + CW_DBG + idx, __builtin_bit_cast(unsigned, err)); }
template <int layer>
DI void dbg_check(const Args& a, LAS unsigned char* lds, int stage, const MoeMeta& mm) {
    if (blockIdx.x >= 64) return;
    const int tid = threadIdx.x;
    const int t = blockIdx.x * 512 + (blockIdx.x * 37) % 512;
    LAS float* x1 = (LAS float*)(lds);
    LAS float* hh = x1 + 1024;
    LAS float* yy = hh + 512;
    LAS float* red = yy + 2048;
    LAS float* scl = red + 16;
    unsigned* ctl = (unsigned*)(a.ws + WS_CTL);
    float* dbgx1 = (float*)(a.ws + WS_SMALL) + blockIdx.x * 1024;
    const float* xout = a.out; const bf16_t* actb = (const bf16_t*)(a.ws + WS_ACTB);
    const u32x4 ti = *(const u32x4*)(a.ws + WS_TOKINFO + (size_t)t * 16);
    const int e0 = ti.x & 15, p0 = ti.x >> 4, e1 = ti.z & 15, p1 = ti.z >> 4;
    const float w0 = u2f(ti.y), w1 = u2f(ti.w);
    __syncthreads();
    if (tid == 0) { scl[16] = w0; scl[17] = w1; }
    __syncthreads();
    if (stage == 1) {
        const float* xin = (layer == 0) ? a.in[IN_X] : nullptr;
        if (xin) {
            float v0 = ALPHA * xin[(size_t)t * D + tid], v1 = ALPHA * xin[(size_t)t * D + tid + 512];
            const float mean = dbg_block_sum(v0 + v1, red) / D;
            const float var = dbg_block_sum((v0 - mean) * (v0 - mean) + (v1 - mean) * (v1 - mean), red) / D;
            const float rstd = 1.f / sqrtf(var + LN_EPS);
            const float* g = a.in[IN_LN1G] + layer * D; const float* b = a.in[IN_LN1B] + layer * D;
            const float r0 = (v0 - mean) * rstd * g[tid] + b[tid], r1 = (v1 - mean) * rstd * g[tid + 512] + b[tid + 512];
            float e = fmaxf(fabsf(r0 - xout[(size_t)t * D + tid]), fabsf(r1 - xout[(size_t)t * D + tid + 512]));
            dbg_note(ctl, 0, dbg_block_max(e, red));
            const float q0 = __builtin_bit_cast(float, (unsigned)actb[(size_t)t * D + tid] << 16), q1 = __builtin_bit_cast(float, (unsigned)actb[(size_t)t * D + tid + 512] << 16);
            e = fmaxf(fabsf(r0 - q0), fabsf(r1 - q1));
            dbg_note(ctl, 1, dbg_block_max(e, red));
        }
        x1[tid] = xout[(size_t)t * D + tid]; x1[tid + 512] = xout[(size_t)t * D + tid + 512];
        dbgx1[tid] = x1[tid]; dbgx1[tid + 512] = x1[tid + 512];
        __syncthreads();
        if (tid < 16) { float s = 0.f; for (int k = 0; k < D; ++k) s += x1[k] * a.in[IN_RW][k * 16 + tid]; scl[tid] = 1.f / (1.f + expf(-s)); }
        __syncthreads();
        if (tid == 0) {
            float bz[16]; for (int e = 0; e < 16; ++e) bz[e] = scl[e] + a.in[IN_RB][e];
            int bg = 0; float bgs = -1e30f;
            for (int g = 0; g < 4; ++g) { float m1 = -1e30f, m2 = -1e30f; for (int k = 0; k < 4; ++k) { const float v = bz[4 * g + k]; if (v > m1) { m2 = m1; m1 = v; } else if (v > m2) m2 = v; }
                if (m1 + m2 > bgs) { bgs = m1 + m2; bg = g; } }
            int i1 = 0; for (int k = 1; k < 4; ++k) if (bz[4 * bg + k] > bz[4 * bg + i1]) i1 = k;
            int i2 = -1; for (int k = 0; k < 4; ++k) if (k != i1 && (i2 < 0 || bz[4 * bg + k] > bz[4 * bg + i2])) i2 = k;
            const float s1 = scl[4 * bg + i1], s2 = scl[4 * bg + i2];
            float err = 0.f;
            if (e0 != 4 * bg + i1 || e1 != 4 * bg + i2) err = 1.f;
            err = fmaxf(err, fabsf(scl[16] - s1 / (s1 + s2))); err = fmaxf(err, fabsf(scl[17] - s2 / (s1 + s2)));
            if (p0 >= mm.cnt[e0] || p1 >= mm.cnt[e1]) err = 2.f;
            else { const unsigned* list = (const unsigned*)(a.ws + WS_LIST); if (list[e0 * 32768 + p0] != (unsigned)t || list[e1 * 32768 + p1] != (unsigned)t) err = 3.f; }
            atomicMax(ctl + CW_DBG + 2, __builtin_bit_cast(unsigned, err));
        }
        return;
    }
    x1[tid] = dbgx1[tid]; x1[tid + 512] = dbgx1[tid + 512];
    __syncthreads();
    const float* eg = a.in[IN_EG] + (size_t)layer * NE * D * DEXP; const float* eu = a.in[IN_EU] + (size_t)layer * NE * D * DEXP; const float* ed = a.in[IN_ED] + (size_t)layer * NE * DEXP * D;
    { const int k = tid >> 8, j = tid & 255, e = k ? e1 : e0;
      float g = 0.f, u = 0.f; for (int i = 0; i < D; ++i) { g += x1[i] * eg[((size_t)e * D + i) * DEXP + j]; u += x1[i] * eu[((size_t)e * D + i) * DEXP + j]; }
      hh[k * 256 + j] = g / (1.f + expf(-g)) * u; }
    __syncthreads();
    const size_t s0 = (size_t)mm.tstart[e0] * 256 + p0, s1 = (size_t)mm.tstart[e1] * 256 + p1;
    if (stage == 2) {
        const bf16_t* hb = (const bf16_t*)(a.ws + WS_BIG + BIG_H);
        const int k = tid >> 8, j = tid & 255; const size_t s = k ? s1 : s0;
        const float got = __builtin_bit_cast(float, (unsigned)hb[s * DEXP + j] << 16);
        const float ref = hh[tid];
        const float rms = sqrtf(dbg_block_sum(ref * ref, red) / 512.f);
        dbg_note(ctl, 3, dbg_block_max(fabsf(got - ref), red) / (rms + 1e-6f));
        return;
    }
    for (int c = tid; c < 2048; c += 512) { const int k = c >> 10, col = c & 1023, e = k ? e1 : e0; float s = 0.f;
        for (int j = 0; j < DEXP; ++j) s += hh[k * 256 + j] * ed[((size_t)e * DEXP + j) * D + col];
        yy[c] = s; }
    __syncthreads();
    if (stage == 3) {
        const bf16_t* yb = (const bf16_t*)(a.ws + WS_BIG + BIG_YB);
        float e = 0.f, sq = 0.f;
        for (int c = tid; c < 2048; c += 512) { const int k = c >> 10, col = c & 1023; const size_t s = k ? s1 : s0;
            const float got = __builtin_bit_cast(float, (unsigned)yb[s * D + col] << 16); e = fmaxf(e, fabsf(got - yy[c])); sq += yy[c] * yy[c]; }
        const float rms = sqrtf(dbg_block_sum(sq, red) / 2048.f);
        dbg_note(ctl, 4, dbg_block_max(e, red) / (rms + 1e-6f));
        return;
    }
    {
        float v0 = ALPHA * x1[tid] + w0 * yy[tid] + w1 * yy[1024 + tid], v1 = ALPHA * x1[tid + 512] + w0 * yy[tid + 512] + w1 * yy[1024 + tid + 512];
        const float mean = dbg_block_sum(v0 + v1, red) / D;
        const float var = dbg_block_sum((v0 - mean) * (v0 - mean) + (v1 - mean) * (v1 - mean), red) / D;
        const float rstd = 1.f / sqrtf(var + LN_EPS);
        const float* g = a.in[IN_LN2G] + layer * D; const float* b = a.in[IN_LN2B] + layer * D;
        const float r0 = (v0 - mean) * rstd * g[tid] + b[tid], r1 = (v1 - mean) * rstd * g[tid + 512] + b[tid + 512];
        const float e = fmaxf(fabsf(r0 - xout[(size_t)t * D + tid]), fabsf(r1 - xout[(size_t)t * D + tid + 512]));
        dbg_note(ctl, 5, dbg_block_max(e, red));
    }
}
DI void dbg_final(const Args& a) {
    unsigned* ctl = (unsigned*)(a.ws + WS_CTL);
    const float tol[6] = {1e-4f, 2e-2f, 1e-3f, 0.12f, 0.12f, 4e-2f};
    int code = 2;
    for (int i = 5; i >= 0; --i) { const float err = __builtin_bit_cast(float, xb_ld(ctl + CW_DBG + i));
        if (!(err <= tol[i])) { const int dg = !(err < 1.f) ? 9 : err >= 0.3f ? 7 : err >= 0.1f ? 5 : err >= 0.03f ? 3 : 1; code = 10 * (i + 1) + dg; } }
#ifdef PROBE
    { const float p0 = (float)xb_ld(ctl + CW_DBG + 10) / 65536.f, p1 = __builtin_bit_cast(float, xb_ld(ctl + CW_DBG + 9));
      const int d0 = p0 < 0.f ? 0 : p0 >= 1.f ? 9 : (int)(p0 * 9.99f), d1 = p1 < 0.f ? 0 : p1 >= 1.f ? 9 : (int)(p1 * 9.99f); code = 10 * d0 + d1; }
#endif
    if (xb_ld(ctl + CW_BAR + XB_TMO)) code = 95;
    const float c = sqrtf((float)code);
    for (size_t i = (size_t)blockIdx.x * NTHR + threadIdx.x; i < (size_t)T * D; i += (size_t)gridDim.x * NTHR) a.out[i] = c;
}
#endif


#ifndef PROBE_LO
#define PROBE_LO -1
#define PROBE_HI -1
#define PROBE_MULT 0
#endif
#ifndef PROBE_MASK
#define PROBE_MASK 0ull
#endif
DI void probe_tick(LAS unsigned char* lds, int wv) {
    if (PROBE_LO < 0) return;
    volatile LAS unsigned* M = (volatile LAS unsigned*)(lds + MISC_OFF);
    if (tid_of(wv) == 0) { const unsigned long long now = __builtin_amdgcn_s_memrealtime(); const int k = (int)M[16];
        const unsigned long long last = (unsigned long long)M[18] | ((unsigned long long)M[19] << 32);
        if ((k >= PROBE_LO && k <= PROBE_HI) || ((PROBE_MASK >> k) & 1ull)) { unsigned long long acc = (unsigned long long)M[20] | ((unsigned long long)M[21] << 32); acc += now - last; M[20] = (unsigned)acc; M[21] = (unsigned)(acc >> 32); }
        M[16] = (unsigned)(k + 1); M[18] = (unsigned)now; M[19] = (unsigned)(now >> 32); }
}
#define GRID_BAR() do { xcd_barrier(bar); probe_tick(lds, a.wv); } while (0)
constexpr bool HAS_MIXER[4] = {true, true, true, true};
template <int layer>
DI void run_layer(const Args& a, LAS unsigned char* lds, const XcdBarrier& bar) {
    const int wave = a.wv;
    const int G = gridDim.x, bid = blockIdx.x;
    const int gw = bid * NWAVES + wave, NGW = G * NWAVES;
    unsigned char* ws = a.ws;
    unsigned* ctl = (unsigned*)(a.ws + WS_CTL);
    bf16_t* actb = (bf16_t*)(ws + WS_ACTB);
    float* xout = a.out;
    bf16_t* xres = (bf16_t*)a.out;
        bf16_t* bigb = (bf16_t*)(ws + WS_BIG);
        if (layer == 0) {
#pragma unroll 1
            for (int b = 0; b < BATCH; ++b) {
                { pg8::DenseSched S; S.init(actb + (size_t)b * SEQ * D, D * 2, 128, ws + WS_WIN, SEQ, 9216, D, G, bid); pg8::EpiStore E{bigb, (size_t)9216}; pg8::gemm_phase(lds + STAGE_OFF, S, E, a.wv); }
                if (b == 1) dilated_merge(a, 0);
                GRID_BAR();
                dilated_phase(a, lds);
                GRID_BAR();
            }
            dilated_merge(a, 1);
            GRID_BAR();
        }
        if (layer == 1) {
            { pg8::DenseSched S; S.init(xres, D * 2, 128, ws + WS_WIN, T, 3072, D, G, bid); pg8::EpiStore E{bigb, (size_t)3072}; pg8::gemm_phase(lds + STAGE_OFF, S, E, a.wv); }
            GRID_BAR();
            sb_phase(a, lds);
            GRID_BAR();
        }
        if (layer == 2) {
            { pg8::DenseSched S; S.init(xres, D * 2, 128, ws + WS_WIN, T, 2816, D, G, bid);
              pg8::EpiNsa E{(bf16_t*)(ws + WS_BIG + NS_Q), (bf16_t*)(ws + WS_BIG + NS_KV), (float*)(ws + WS_BIG + NS_GT)}; pg8::gemm_phase(lds + STAGE_OFF, S, E, a.wv); }
            GRID_BAR();
            { pg8::CmpSched S; S.kv6 = (const char*)(ws + WS_BIG + NS_KV); S.Bt = (const char*)(ws + WS_WCMP); S.K = 2048; S.lda = 16 * 1536 * 2; S.kstepA = 1536 * 2; S.G = G; S.c = bid;
              pg8::EpiCmp E{(bf16_t*)(ws + WS_BIG + NS_HID), (const float*)(ws + WS_WCMP + 2 * MiB + 64 * 1024)}; pg8::gemm_phase(lds + STAGE_OFF, S, E, a.wv); }
            GRID_BAR();
            nsa_kcvc_phase(a, lds);
            GRID_BAR();
            nsa_attn_phase(a, lds);
            GRID_BAR();
        }
        if (layer == 3) {
            { pg8::DenseSched S; S.init(xres, D * 2, 128, ws + WS_WIN, T, 3072, D, G, bid); pg8::EpiStore E{bigb, (size_t)3072}; pg8::gemm_phase(lds + STAGE_OFF, S, E, a.wv); }
            GRID_BAR();
            moba_kmean_phase(a, lds);
            GRID_BAR();
            moba_gate_phase(a, lds);
            GRID_BAR();
            moba_fill_phase(a, lds);
            GRID_BAR();
            moba_sel_phase(a, lds);
            GRID_BAR();
            moba_own_phase(a, lds);
            GRID_BAR();
        }
        if (HAS_MIXER[layer]) {
            { pg8::DenseSched S; S.init(actb, D * 2, 128, ws + WS_WOUT, T, D, D, G, bid); pg8::EpiStore E{(bf16_t*)(ws + WS_BIG + BIG_Y), (size_t)D}; pg8::gemm_phase(lds + STAGE_OFF, S, E, a.wv); }
            GRID_BAR();
        }
        unsigned* gcount = ctl + CW_MOE + layer * 16 * 64;
        {
            const int tid = tid_of(a.wv), lane = tid & 63;
            constexpr int RWS = 1032;
            LAS bf16_t* rwh = (LAS bf16_t*)(lds + STAGE_OFF);
            LAS bf16_t* rwl = rwh + 17 * RWS;
            LAS int* lcnt = (LAS int*)(lds + STAGE_OFF + 73728);
            LAS int* gbase = lcnt + 16;
            LAS unsigned* le = (LAS unsigned*)(lcnt + 32);
            LAS float* lg = (LAS float*)(le + 256);
            const float* rw = a.in[IN_RW];
            for (int i = tid; i < 1024 * 16; i += NTHR) { const int k = i >> 4, e = i & 15; const float v = rw[i]; const unsigned hi = f2bf(v);
                rwh[e * RWS + k] = (bf16_t)hi; rwl[e * RWS + k] = (bf16_t)f2bf(v - u2f(hi << 16)); }
            for (int i = tid; i < RWS; i += NTHR) { rwh[16 * RWS + i] = 0; rwl[16 * RWS + i] = 0; }
            if (tid < 16) lcnt[tid] = 0;
            const float* xin0 = a.in[IN_X];
            const bf16_t* ybig = (const bf16_t*)(ws + WS_BIG + BIG_Y);
            bf16_t* xlo = (bf16_t*)(ws + WS_BIG + BIG_YB);
            const float* g1 = a.in[IN_LN1G] + layer * D; const float* b1 = a.in[IN_LN1B] + layer * D;
            RowVec gv, bv;
#pragma unroll
            for (int j = 0; j < 4; ++j) { gv.v[j] = *(const f32x4*)(g1 + 4 * lane + 256 * j); bv.v[j] = *(const f32x4*)(b1 + 4 * lane + 256 * j); }
            f32x4 pxf[2][4]; u32x2 pxb[2][4], py[2][4];
#define LN1_LOAD(S_, TR_) { _Pragma("unroll") for (int j = 0; j < 4; ++j) { \
                if (layer == 0) pxf[S_][j] = *(const f32x4*)(xin0 + (size_t)(TR_) * D + 4 * lane + 256 * j); \
                else pxb[S_][j] = *(const u32x2*)(xres + (size_t)(TR_) * D + 4 * lane + 256 * j); \
                py[S_][j] = HAS_MIXER[layer] ? *(const u32x2*)(ybig + (size_t)(TR_) * D + 4 * lane + 256 * j) : (u32x2){0u, 0u}; } }
            LN1_LOAD(0, bid * 128 + wave) LN1_LOAD(1, bid * 128 + wave + NWAVES)
            for (int lt = wave; lt < 128; lt += 2 * NWAVES) {
#pragma unroll
                for (int s = 0; s < 2; ++s) {
                    const int t = bid * 128 + lt + NWAVES * s;
                    RowVec r;
#pragma unroll
                    for (int j = 0; j < 4; ++j) {
                        if (layer == 0) r.v[j] = pxf[s][j] * ALPHA;
                        else { r.v[j].x = ALPHA * bf_lo(pxb[s][j].x); r.v[j].y = ALPHA * bf_hi(pxb[s][j].x); r.v[j].z = ALPHA * bf_lo(pxb[s][j].y); r.v[j].w = ALPHA * bf_hi(pxb[s][j].y); }
                        r.v[j].x += bf_lo(py[s][j].x); r.v[j].y += bf_hi(py[s][j].x); r.v[j].z += bf_lo(py[s][j].y); r.v[j].w += bf_hi(py[s][j].y); }
                    if (lt + 2 * NWAVES < 128) LN1_LOAD(s, t + 2 * NWAVES)
                    float mean, rstd; ln_stats(r, mean, rstd);
#pragma unroll
                    for (int j = 0; j < 4; ++j) { r.v[j] = (r.v[j] - mean) * rstd * gv.v[j] + bv.v[j];
                        const unsigned h0 = f2bf(r.v[j].x), h1 = f2bf(r.v[j].y), h2 = f2bf(r.v[j].z), h3 = f2bf(r.v[j].w);
                        u32x2 w; w.x = h0 | (h1 << 16); w.y = h2 | (h3 << 16);
                        *(u32x2*)(actb + (size_t)t * D + 4 * lane + 256 * j) = w;
                        u32x2 wl; wl.x = pk2(r.v[j].x - u2f(h0 << 16), r.v[j].y - u2f(h1 << 16)); wl.y = pk2(r.v[j].z - u2f(h2 << 16), r.v[j].w - u2f(h3 << 16));
                        *(u32x2*)(xlo + (size_t)t * D + 4 * lane + 256 * j) = wl; }
                }
            }
#undef LN1_LOAD
            asm volatile("s_waitcnt vmcnt(0)" ::: "memory");
            __syncthreads();
            if (wave < 4) {
                const int c = lane & 31, h = lane >> 5, lt = 32 * wave + c, t = bid * 128 + lt;
                const bf16_t* xh_ = actb + (size_t)t * D + 8 * h; const bf16_t* xl_ = xlo + (size_t)t * D + 8 * h;
                const int wr_ = c < 16 ? c : 16;
                const LAS bf16_t* ah = rwh + wr_ * RWS + 8 * h; const LAS bf16_t* al = rwl + wr_ * RWS + 8 * h;
                f32x16 acc = zero16();
#pragma unroll 4
                for (int ks = 0; ks < 64; ++ks) {
                    const bf16x8 bh = *(const bf16x8*)(xh_ + 16 * ks), bl = *(const bf16x8*)(xl_ + 16 * ks);
                    const bf16x8 wh = *(const LAS bf16x8*)(ah + 16 * ks), wl = *(const LAS bf16x8*)(al + 16 * ks);
                    acc = mfma32(wh, bh, acc); acc = mfma32(wh, bl, acc); acc = mfma32(wl, bh, acc);
                }
                float sc[2][4], bz[2][4];
#pragma unroll
                for (int q = 0; q < 2; ++q)
#pragma unroll
                    for (int k = 0; k < 4; ++k) { sc[q][k] = 1.f / (1.f + __expf(-acc[4 * q + k])); bz[q][k] = sc[q][k] + a.in[IN_RB][8 * q + 4 * h + k]; }
                float gs[2]; int i1[2], i2[2];
#pragma unroll
                for (int q = 0; q < 2; ++q) {
                    float m1 = bz[q][0]; int j1 = 0;
#pragma unroll
                    for (int k = 1; k < 4; ++k) if (bz[q][k] > m1) { m1 = bz[q][k]; j1 = k; }
                    float m2 = -1e30f; int j2 = -1;
#pragma unroll
                    for (int k = 0; k < 4; ++k) if (k != j1 && bz[q][k] > m2) { m2 = bz[q][k]; j2 = k; }
                    gs[q] = m1 + m2; i1[q] = j1; i2[q] = j2; }
                const float o0 = __shfl_xor(gs[0], 32), o1 = __shfl_xor(gs[1], 32);
                const float G0 = h ? o0 : gs[0], G1 = h ? gs[0] : o0, G2 = h ? o1 : gs[1], G3 = h ? gs[1] : o1;
                int bg = 0; float bgs = G0;
                if (G1 > bgs) { bgs = G1; bg = 1; }
                if (G2 > bgs) { bgs = G2; bg = 2; }
                if (G3 > bgs) { bgs = G3; bg = 3; }
                if ((bg & 1) == h) {
                    const int q = bg >> 1;
                    const int j1 = q ? i1[1] : i1[0], j2 = q ? i2[1] : i2[0];
                    float sg1 = 0.f, sg2 = 0.f;
#pragma unroll
                    for (int k = 0; k < 4; ++k) { const float sv = q ? sc[1][k] : sc[0][k]; sg1 = (k == j1) ? sv : sg1; sg2 = (k == j2) ? sv : sg2; }
                    const float inv = 1.f / (sg1 + sg2);
                    const int e0 = bg * 4 + j1, e1 = bg * 4 + j2;
                    const int p0 = atomicAdd((int*)(lcnt + e0), 1), p1 = atomicAdd((int*)(lcnt + e1), 1);
                    le[lt * 2] = (unsigned)e0 | ((unsigned)p0 << 8); le[lt * 2 + 1] = (unsigned)e1 | ((unsigned)p1 << 8);
                    lg[lt * 2] = sg1 * inv; lg[lt * 2 + 1] = sg2 * inv;
                }
            }
            __syncthreads();
            if (tid < 16) gbase[tid] = (int)xb_add(gcount + tid * 64, (unsigned)lcnt[tid]);
            __syncthreads();
            if (tid < 256) {
                const int lt = tid >> 1, t = bid * 128 + lt;
                if (t < T) {
                    const unsigned w = le[tid]; const int e = w & 255, pos = gbase[e] + (int)(w >> 8);
                    ((unsigned*)(ws + WS_LIST))[e * 32768 + pos] = (unsigned)t;
                    u32x2 ti; ti.x = (unsigned)e | ((unsigned)pos << 4); ti.y = __builtin_bit_cast(unsigned, lg[tid]);
                    *(u32x2*)(ws + WS_TOKINFO + (size_t)(t * 2 + (tid & 1)) * 8) = ti;
                }
            }
        }
        GRID_BAR();

        MoeMeta mm; mm.tstart = (LAS int*)(lds + MISC_OFF + 256); mm.cnt = mm.tstart + 32;
        if (tid_of(a.wv) == 0) { int acc = 0;
            for (int e = 0; e < 16; ++e) { const int c = (int)xb_ld(gcount + e * 64); mm.cnt[e] = c; mm.tstart[e] = acc; acc += (c + 255) >> 8; }
            mm.tstart[16] = acc; }
        __syncthreads();
        const int ntiles = mm.tstart[16];
#if DBG
        if (layer == DBG_LAYER) { dbg_check<layer>(a, lds, 1, mm); __syncthreads(); }
#endif
        {
            Moe1Sched S; S.A = (const char*)actb; S.Bt = (const char*)(ws + WS_WEXP1); S.K = D; S.lda = D * 2; S.kstepA = 128; S.mm = mm; S.ntiles = ntiles; S.G = G; S.c = bid;
            S.tab = (LAS unsigned*)(lds + AUX_OFF);
            const int tid = tid_of(a.wv);
            pg8::Unit u;
            for (int i = 0; i < 8 && S.next(i, u); ++i) {
                if (tid < 256) { const int pos = (u.pm - mm.tstart[u.e]) * 256 + tid;
                    const unsigned tok = (pos < mm.cnt[u.e]) ? ((const unsigned*)(ws + WS_LIST))[u.e * 32768 + pos] : 0u;
                    S.tab[i * 256 + tid] = tok * (unsigned)(D * 2); }
            }
            __syncthreads();
            pg8::EpiSwiglu E{(bf16_t*)(ws + WS_BIG + BIG_H)};
            pg8::gemm_phase(lds + STAGE_OFF, S, E, a.wv);
        }
        GRID_BAR();
#if DBG
        if (layer == DBG_LAYER) { dbg_check<layer>(a, lds, 2, mm); __syncthreads(); }
#endif
        {
            Moe2Sched S; S.A = (const char*)(ws + WS_BIG + BIG_H); S.Bt = (const char*)(ws + WS_WEXP2); S.K = DEXP; S.lda = DEXP * 2; S.kstepA = 128; S.mm = mm; S.ntiles = ntiles; S.G = G; S.c = bid;
            pg8::EpiStore E{(bf16_t*)(ws + WS_BIG + BIG_YB), (size_t)D};
            pg8::gemm_phase(lds + STAGE_OFF, S, E, a.wv);
        }
        GRID_BAR();
#if DBG
        if (layer == DBG_LAYER) { dbg_check<layer>(a, lds, 3, mm); __syncthreads(); }
#endif
        {
            const int tid = tid_of(a.wv), lane = tid & 63;
            const float* g2 = a.in[IN_LN2G] + layer * D; const float* b2 = a.in[IN_LN2B] + layer * D;
            RowVec gv, bv;
#pragma unroll
            for (int j = 0; j < 4; ++j) { gv.v[j] = *(const f32x4*)(g2 + 4 * lane + 256 * j); bv.v[j] = *(const f32x4*)(b2 + 4 * lane + 256 * j); }
            const bf16_t* yb = (const bf16_t*)(ws + WS_BIG + BIG_YB);
            u32x4 tiN[2]; u32x2 px[2][4], py0[2][4], py1[2][4]; float cw0[2], cw1[2];
#define LN2_LOAD(S_, TR_) { const u32x4 ti_ = tiN[S_]; const int e0 = ti_.x & 15, p0 = ti_.x >> 4, e1 = ti_.z & 15, p1 = ti_.z >> 4; cw0[S_] = u2f(ti_.y); cw1[S_] = u2f(ti_.w); \
                const size_t s0 = (size_t)mm.tstart[e0] * 256 + p0, s1 = (size_t)mm.tstart[e1] * 256 + p1; \
                _Pragma("unroll") for (int j = 0; j < 4; ++j) { px[S_][j] = *(const u32x2*)(actb + (size_t)(TR_) * D + 4 * lane + 256 * j); \
                    py0[S_][j] = *(const u32x2*)(yb + s0 * D + 4 * lane + 256 * j); py1[S_][j] = *(const u32x2*)(yb + s1 * D + 4 * lane + 256 * j); } }
            static_assert(T % (2 * 256 * NWAVES) == 0, "LN2 row pairing");
            tiN[0] = *(const u32x4*)(ws + WS_TOKINFO + (size_t)gw * 16); tiN[1] = *(const u32x4*)(ws + WS_TOKINFO + (size_t)(gw + NGW) * 16);
            LN2_LOAD(0, gw) LN2_LOAD(1, gw + NGW)
            if (gw + 2 * NGW < T) { tiN[0] = *(const u32x4*)(ws + WS_TOKINFO + (size_t)(gw + 2 * NGW) * 16); tiN[1] = *(const u32x4*)(ws + WS_TOKINFO + (size_t)(gw + 3 * NGW) * 16); }
            for (int tb = gw; tb < T; tb += 2 * NGW) {
#pragma unroll
                for (int s = 0; s < 2; ++s) {
                    const int t = tb + s * NGW;
                    const float w0 = cw0[s], w1 = cw1[s];
                    RowVec r;
#pragma unroll
                    for (int j = 0; j < 4; ++j) {
                        const u32x2 xv = px[s][j], y0 = py0[s][j], y1 = py1[s][j];
                        r.v[j].x = ALPHA * bf_lo(xv.x) + w0 * bf_lo(y0.x) + w1 * bf_lo(y1.x);
                        r.v[j].y = ALPHA * bf_hi(xv.x) + w0 * bf_hi(y0.x) + w1 * bf_hi(y1.x);
                        r.v[j].z = ALPHA * bf_lo(xv.y) + w0 * bf_lo(y0.y) + w1 * bf_lo(y1.y);
                        r.v[j].w = ALPHA * bf_hi(xv.y) + w0 * bf_hi(y0.y) + w1 * bf_hi(y1.y);
                    }
                    if (t + 2 * NGW < T) { const int tn = t + 2 * NGW;
                        LN2_LOAD(s, tn)
                        if (tn + 2 * NGW < T) tiN[s] = *(const u32x4*)(ws + WS_TOKINFO + (size_t)(tn + 2 * NGW) * 16); }
                    float mean, rstd; ln_stats(r, mean, rstd);
#pragma unroll
                    for (int j = 0; j < 4; ++j) { r.v[j] = (r.v[j] - mean) * rstd * gv.v[j] + bv.v[j];
                        if (layer == DEPTH - 1) *(f32x4*)(xout + (size_t)t * D + 4 * lane + 256 * j) = r.v[j];
                        else { u32x2 w; w.x = pk2(r.v[j].x, r.v[j].y); w.y = pk2(r.v[j].z, r.v[j].w);
                            *(u32x2*)(xres + (size_t)t * D + 4 * lane + 256 * j) = w; } }
                }
            }
#undef LN2_LOAD
            if (layer + 1 < DEPTH) convert_layer_weights(a, layer + 1, lds, gw, NGW, wave, lane);
        }
        GRID_BAR();
#if DBG
        if (layer == DBG_LAYER) { dbg_check<layer>(a, lds, 4, mm); GRID_BAR(); }
#endif
}

__global__ void __launch_bounds__(NTHR, 2) fwd(Args a_in) {
    Args a = a_in; a.wv = __builtin_amdgcn_readfirstlane((int)(threadIdx.x >> 6));
    extern __shared__ __attribute__((aligned(16))) unsigned char lds_raw[];
    LAS unsigned char* lds = (LAS unsigned char*)lds_raw;
    volatile LAS unsigned* MISC = (volatile LAS unsigned*)(lds + MISC_OFF);
    const int tid = tid_of(a.wv), lane = tid & 63, wave = a.wv;
    const int G = gridDim.x, bid = blockIdx.x;
    const int gw = bid * NWAVES + wave, NGW = G * NWAVES;
    if (tid < 256) MISC[tid] = 0u;
    __syncthreads();
    unsigned* ctl = (unsigned*)(a.ws + WS_CTL);
    XcdBarrier bar = xcd_barrier_post(ctl + CW_BAR, MISC + 8); bar.wv = a.wv;
    if (PROBE_LO >= 0 && tid == 0) { const unsigned long long now = __builtin_amdgcn_s_memrealtime(); MISC[18] = (unsigned)now; MISC[19] = (unsigned)(now >> 32); }
    unsigned char* ws = a.ws;
    bf16_t* actb = (bf16_t*)(ws + WS_ACTB);
    float* xout = a.out;

    convert_layer_weights(a, 0, lds, gw, NGW, wave, lane);
    for (int i = bid * NTHR + tid; i < 16 * 2048; i += G * NTHR) { const int hd = i >> 11, n = i & 2047;
        int bk = n; if (n >= 16) { const float lf = logf((float)n / 16.f) / 4.852030263919617f; bk = 16 + (int)(lf * 16.f); bk = bk > 31 ? 31 : bk; }
        ((float*)(a.ws + WS_BIASG))[i] = a.in[IN_REL][bk * 16 + hd] * LOG2E; }
    { const float* x = a.in[IN_X];
      constexpr size_t XS = (size_t)256 * NTHR * 8;
      static_assert(((size_t)T * D) % (XS * 4) == 0, "x conversion sweep");
      for (size_t i = ((size_t)bid * NTHR + tid) * 8; i < (size_t)T * D; i += XS * 4) {
          f32x4 v0[4], v1[4];
#pragma unroll
          for (int q = 0; q < 4; ++q) { v0[q] = *(const f32x4*)(x + i + q * XS); v1[q] = *(const f32x4*)(x + i + q * XS + 4); }
#pragma unroll
          for (int q = 0; q < 4; ++q) { u32x4 w; w.x = pk2(v0[q].x, v0[q].y); w.y = pk2(v0[q].z, v0[q].w); w.z = pk2(v1[q].x, v1[q].y); w.w = pk2(v1[q].z, v1[q].w);
              *(u32x4*)(actb + i + q * XS) = w; } } }
    GRID_BAR();

    run_layer<0>(a, lds, bar);
#if DBG
    if (DBG_LAYER >= 1) run_layer<1>(a, lds, bar);
    if (DBG_LAYER >= 2) run_layer<2>(a, lds, bar);
    if (DBG_LAYER >= 3) run_layer<3>(a, lds, bar);
    dbg_final(a);
#else
    run_layer<1>(a, lds, bar);
    run_layer<2>(a, lds, bar);
    run_layer<3>(a, lds, bar);
#endif
    if (PROBE_LO >= 0) { __syncthreads(); const unsigned long long acc = (unsigned long long)MISC[20] | ((unsigned long long)MISC[21] << 32); const unsigned long long t0 = __builtin_amdgcn_s_memrealtime();
        while (__builtin_amdgcn_s_memrealtime() - t0 < acc * (unsigned long long)PROBE_MULT) __builtin_amdgcn_s_sleep(8); }
}

extern "C" void kernel_launch(void* const* d_in, const int* in_sizes, int n_in, void* d_out, int out_size, void* d_ws, size_t ws_size, hipStream_t stream) {
    static int grid = 0;
    if (grid == 0) {
        int dev = 0, cus = 0;
        if (n_in != 25 || out_size != T * D || ws_size < WS_END) { fprintf(stderr, "kernel_launch: unexpected shapes (n_in %d out %d ws %zu)\n", n_in, out_size, ws_size); grid = -1; return; }
        if (hipGetDevice(&dev) != hipSuccess || hipDeviceGetAttribute(&cus, hipDeviceAttributeMultiprocessorCount, dev) != hipSuccess) { grid = -1; return; }
        if (hipFuncSetAttribute((const void*)fwd, hipFuncAttributeMaxDynamicSharedMemorySize, LDS_BYTES) != hipSuccess) { grid = -1; return; }
        (void)hipGetLastError();
        grid = cus;
        if (grid != 256) { fprintf(stderr, "kernel_launch: built for 256 CUs, got %d\n", grid); grid = -1; return; }
    }
    if (grid < 0) return;
    (void)hipMemsetAsync(d_ws, 0, 1u << 20, stream);
    Args a{};
    for (int i = 0; i < 25; ++i) a.in[i] = (const float*)d_in[i];
    a.out = (float*)d_out; a.ws = (unsigned char*)d_ws;
    hipLaunchKernelGGL(fwd, dim3(grid), dim3(NTHR), LDS_BYTES, stream, a);
}
```

```cpp
#include <hip/hip_runtime.h>
#include <cstdio>
#include <cstdint>
#define DBG 0
#define DBG_LAYER 0

#define LAS __attribute__((address_space(3)))
#define GAS __attribute__((address_space(1)))
#define DI __device__ __forceinline__
typedef unsigned short bf16_t;
typedef short bf16x8 __attribute__((ext_vector_type(8)));
typedef short s16x4 __attribute__((ext_vector_type(4)));
typedef float f32x2 __attribute__((ext_vector_type(2)));
typedef float f32x4 __attribute__((ext_vector_type(4)));
typedef float f32x16 __attribute__((ext_vector_type(16)));
typedef unsigned u32x2 __attribute__((ext_vector_type(2)));
typedef unsigned u32x4 __attribute__((ext_vector_type(4)));

constexpr int BATCH = 2, SEQ = 16384, D = 1024, T = BATCH * SEQ, DEPTH = 4, NH = 16, HD = 64;
constexpr int NE = 16, DEXP = 256;
constexpr float ALPHA = 1.681792830507429f;
constexpr float LN_EPS = 1e-5f;
constexpr int NWAVES = 8, NTHR = 512;

constexpr size_t MiB = 1u << 20;
constexpr size_t WS_CTL = 0;
constexpr size_t WS_TOKINFO = 1 * MiB;
constexpr size_t WS_SMALL = 1 * MiB + 512 * 1024;
constexpr size_t WS_LIST = 2 * MiB;
constexpr size_t WS_WIN = 4 * MiB;
constexpr size_t WS_WOUT = 22 * MiB;
constexpr size_t WS_WEXP1 = 24 * MiB;
constexpr size_t WS_WEXP2 = 40 * MiB;
constexpr size_t WS_WCMP = 48 * MiB;
constexpr size_t WS_ACTB = 52 * MiB;
constexpr size_t WS_BIG = 116 * MiB;
constexpr size_t WS_END = 512 * MiB;
constexpr size_t BIG_Y = 0;
constexpr size_t BIG_H = 64 * MiB;
constexpr size_t BIG_YB = 100 * MiB;
constexpr size_t BIG_XLO = 240 * MiB;
constexpr int PROWS = 2 * T + NE * 256;

constexpr int CW_BAR = 4096;
constexpr int CW_DBG = 8;
constexpr int CW_MOE = 16384;

constexpr int LDS_BYTES = 160 * 1024;
constexpr int STAGE_OFF = 0;
constexpr int AUX_OFF = 128 * 1024;
constexpr int MISC_OFF = LDS_BYTES - 1024;

DI unsigned f2bf(float f) { unsigned u = __builtin_bit_cast(unsigned, f); return (u + 0x7fffu + ((u >> 16) & 1u)) >> 16; }
DI unsigned pk2(float lo, float hi) { return f2bf(lo) | (f2bf(hi) << 16); }
typedef __bf16 bf16x2_t __attribute__((ext_vector_type(2)));
DI unsigned cvt_pk_bf16(float lo, float hi) { const bf16x2_t r = __builtin_convertvector((f32x2){lo, hi}, bf16x2_t); return __builtin_bit_cast(unsigned, r); }
DI float u2f(unsigned u) { return __builtin_bit_cast(float, u); }
DI unsigned f2u(float f) { return __builtin_bit_cast(unsigned, f); }
DI float bf_lo(unsigned w) { return __builtin_bit_cast(float, w << 16); }
DI float bf_hi(unsigned w) { return __builtin_bit_cast(float, w & 0xffff0000u); }
DI float wave_sum(float v) {
#pragma unroll
    for (int o = 1; o < 64; o <<= 1) v += __shfl_xor(v, o);
    return v;
}
DI int tid_of(int wv) { int l; asm volatile("v_mbcnt_lo_u32_b32 %0, -1, 0\n\tv_mbcnt_hi_u32_b32 %0, -1, %0" : "=v"(l)); return (wv << 6) | l; }
DI float xor32h(float v, int h) { const unsigned u = __builtin_bit_cast(unsigned, v); const u32x2 s = __builtin_amdgcn_permlane32_swap(u, u, false, false);
    return __builtin_bit_cast(float, h ? s.x : s.y); }
DI float quad_xor1(float v) { return __builtin_bit_cast(float, __builtin_amdgcn_update_dpp(0, __builtin_bit_cast(int, v), 0xB1, 0xf, 0xf, false)); }
DI float quad_xor2(float v) { return __builtin_bit_cast(float, __builtin_amdgcn_update_dpp(0, __builtin_bit_cast(int, v), 0x4E, 0xf, 0xf, false)); }
#define LDS_WAIT() asm volatile("s_waitcnt lgkmcnt(0)" ::: "memory")
#define VM_WAIT() asm volatile("s_waitcnt vmcnt(0)" ::: "memory")

#define XB_TMO      128
#define XB_XCNT(j)  (256  + 64 * (j))
#define XB_XSUB(j)  (1280 + 64 * (j))
#define XB_XGEN(j)  (2304 + 64 * (j))
#define XB_TOP      3328
#define XB_TOPGEN   3392
#define XCD_BAR_WORDS 3456
#define XB_SPIN_CAP (1u << 22)
DI unsigned xb_ld(unsigned* p)              { return __hip_atomic_load(p, __ATOMIC_RELAXED, __HIP_MEMORY_SCOPE_AGENT); }
DI unsigned xb_add(unsigned* p, unsigned v) { return __hip_atomic_fetch_add(p, v, __ATOMIC_RELAXED, __HIP_MEMORY_SCOPE_AGENT); }
DI unsigned xb_xcc_id() { return (unsigned)__builtin_amdgcn_s_getreg((3 << 11) | 20) & 0xFu; }
#define XB_SPIN(cond, bar) do { unsigned _sp = 0; while (cond) { __builtin_amdgcn_s_sleep(1); \
    if ((++_sp & 255u) == 0u) { if (xb_ld(&(bar)[XB_TMO])) break; if (_sp > XB_SPIN_CAP) { atomicAdd(&(bar)[XB_TMO], 1u); break; } } } } while (0)
struct XcdBarrier { unsigned* bar; unsigned x; volatile LAS unsigned* st; int wv; };
DI XcdBarrier xcd_barrier_post(unsigned* bar, volatile LAS unsigned* st) {
    XcdBarrier b; b.bar = bar; b.x = xb_xcc_id(); b.st = st;
    if (threadIdx.x == 0) (void)xb_add(&bar[XB_XCNT(b.x)], 1u);
    return b;
}
DI void xcd_barrier_complete(unsigned* bar, unsigned x, unsigned& nloc, unsigned& nx) {
    const unsigned G = gridDim.x * gridDim.y * gridDim.z;
    unsigned sum, cnt, mine, sp = 0u;
    for (;;) {
        sum = 0u; cnt = 0u; mine = 0u;
#pragma unroll
        for (unsigned j = 0; j < 16; ++j) { const unsigned c = xb_ld(&bar[XB_XCNT(j)]); sum += c; cnt += (c > 0u) ? 1u : 0u; mine = (j == x) ? c : mine; }
        if (sum == G) break;
        __builtin_amdgcn_s_sleep(1);
        if ((++sp & 255u) == 0u) { if (xb_ld(&bar[XB_TMO])) break; if (sp > XB_SPIN_CAP) { atomicAdd(&bar[XB_TMO], 1u); break; } }
    }
    nloc = mine > 0u ? mine : 1u; nx = cnt > 0u ? cnt : 1u;
}
DI void xcd_barrier(const XcdBarrier& b) {
    asm volatile("s_waitcnt vmcnt(0)" ::: "memory");
    __syncthreads();
    if (tid_of(b.wv) == 0) {
        unsigned* bar = b.bar;
        const unsigned bx = xb_xcc_id();
        __builtin_amdgcn_s_waitcnt(0);
        unsigned nloc = b.st[0], nx = b.st[1];
        if (nloc == 0u) { xcd_barrier_complete(bar, bx, nloc, nx); b.st[0] = nloc; b.st[1] = nx; }
        const unsigned old = xb_add(&bar[XB_XSUB(bx)], 1u);
        const unsigned gen = old / nloc;
        if (old + 1u == (gen + 1u) * nloc) {
            __builtin_amdgcn_fence(__ATOMIC_RELEASE, "agent");
            asm volatile("s_waitcnt vmcnt(0)" ::: "memory");
            const unsigned og = xb_add(&bar[XB_TOP], 1u);
            const unsigned tg = og / nx;
            if (og + 1u == (tg + 1u) * nx) xb_add(&bar[XB_TOPGEN], 1u);
            else XB_SPIN(xb_ld(&bar[XB_TOPGEN]) == tg, bar);
            __builtin_amdgcn_fence(__ATOMIC_ACQUIRE, "agent");
            xb_add(&bar[XB_XGEN(bx)], 1u);
            asm volatile("s_waitcnt vmcnt(0)" ::: "memory");
        } else {
            XB_SPIN(xb_ld(&bar[XB_XGEN(bx)]) == gen, bar);
            __builtin_amdgcn_fence(__ATOMIC_ACQUIRE, "agent");
            asm volatile("s_waitcnt vmcnt(0)" ::: "memory");
        }
    }
    __syncthreads();
}

namespace pg8 {
constexpr int BM = 256, BK = 64, HALF = 128, HTB = HALF * BK * 2, STAGE_BYTES = 8 * HTB, NXCD = 8, WGM = 8;
__host__ __device__ __forceinline__ int lds_byte(int r, int c) { const int st = (r >> 4) * 2 + (c >> 5), rr = r & 15, cc = c & 31, ob = rr * 64 + cc * 2; return st * 1024 + (ob ^ (((ob >> 9) & 1) << 5)); }
__host__ __device__ __forceinline__ void stage_rc(int b, int& R, int& C) { const int st = b / 1024, sb = b % 1024, swz = sb ^ (((sb >> 9) & 1) << 5); R = (st >> 1) * 16 + swz / 64; C = (st & 1) * 32 + (swz % 64) / 2; }
__host__ __device__ __forceinline__ int perm32(int rho) { const int n = rho >> 4, i = rho & 15; return 8 * (i >> 2) + 4 * n + (i & 3); }

struct Unit { int pm, pn, e; };

struct TileOrder {
    int nM, nN, nwg, G, c;
    DI void init(int nM_, int nN_, int G_, int c_) { nM = nM_; nN = nN_; nwg = nM * nN; G = G_; c = c_; }
    DI bool next(int i, int& pm, int& pn) const {
        const long L = (long)i * G + c; if (L >= nwg) return false;
        int wgid = (int)L; { const int q = nwg / NXCD, r = nwg % NXCD, xcd = wgid % NXCD, off = wgid / NXCD; wgid = (xcd < r ? xcd * (q + 1) : r * (q + 1) + (xcd - r) * q) + off; }
        const int nig = WGM * nN, gid = wgid / nig, fm = gid * WGM, gsz = (nM - fm) < WGM ? (nM - fm) : WGM;
        pm = fm + ((wgid % nig) % gsz); pn = (wgid % nig) / gsz; return true;
    }
};
struct DenseSched {
    static constexpr bool GATHER = false;
    const char* A; const char* Bt; int K; unsigned lda, kstepA; TileOrder ord;
    DI void init(const void* A_, unsigned lda_, unsigned kstepA_, const void* Bt_, int M, int N, int K_, int G, int c) { A = (const char*)A_; Bt = (const char*)Bt_; K = K_; lda = lda_; kstepA = kstepA_; ord.init(M / BM, N / BM, G, c); }
    DI bool next(int i, Unit& u) const { u.e = 0; return ord.next(i, u.pm, u.pn); }
    DI const char* a_base(const Unit& u) const { return A + (size_t)u.pm * BM * lda; }
    DI const char* b_base(const Unit& u) const { return Bt + (size_t)u.pn * BM * K * 2; }
    DI unsigned row_off(int, int) const { return 0u; }
};

template <class Epi, class Sched>
DI void gemm_phase(LAS unsigned char* lds, const Sched& S, const Epi& E, int wv) {
    int tid = tid_of(wv); asm volatile("" : "+v"(tid));
    const int wid = __builtin_amdgcn_readfirstlane(tid >> 6), lane = tid & 63, wr = wid >> 2, wc = wid & 3, fr = lane & 15, fq = lane >> 4;
    const int K = S.K, nt = K / BK;
    unsigned voffB[2]; int Rr[2]; unsigned Cb[2];
#pragma unroll
    for (int i = 0; i < 2; ++i) { int R, C; stage_rc(tid * 16 + i * 8192, R, C); const int Rb = (R & ~31) + perm32(R & 31);
        voffB[i] = (unsigned)(Rb * K + C) * 2u; Rr[i] = R; Cb[i] = (unsigned)C * 2u; }
    const unsigned kstepA = S.kstepA, kstepB = (unsigned)(BK * 2);
    const size_t hstepB = (size_t)HALF * K * 2;
    const unsigned ldsw = (unsigned)wid * 1024u;
    const int aoff = lds_byte(wr * 64 + fr, fq * 8), boff = lds_byte(wc * 32 + fr, fq * 8);
#define PG8_SA(b, h) (((b) * 2 + (h)) * HTB)
#define PG8_SB(b, h) ((4 + (b) * 2 + (h)) * HTB)
#define PG8_STAGE_A(bufoff, basep, vv, h, koff) do { _Pragma("unroll") for (int _i = 0; _i < 2; ++_i) \
        __builtin_amdgcn_global_load_lds((const unsigned*)((basep) + (vv)[h][_i] + (koff)), (LAS unsigned*)(lds + (bufoff) + ldsw + _i * 8192), 16, 0, 0); } while (0)
#define PG8_STAGE_B(bufoff, ptr) do { _Pragma("unroll") for (int _i = 0; _i < 2; ++_i) \
        __builtin_amdgcn_global_load_lds((const unsigned*)((ptr) + voffB[_i]), (LAS unsigned*)(lds + (bufoff) + ldsw + _i * 8192), 16, 0, 0); } while (0)
#define PG8_LDA(dst, b, h) do { _Pragma("unroll") for (int m = 0; m < 4; ++m) _Pragma("unroll") for (int k = 0; k < 2; ++k) dst[m][k] = *(const LAS bf16x8*)(lds + PG8_SA(b, h) + aoff + m * 2048 + k * 1024); } while (0)
#define PG8_LDB(dst, b, h) do { _Pragma("unroll") for (int n = 0; n < 2; ++n) _Pragma("unroll") for (int k = 0; k < 2; ++k) dst[n][k] = *(const LAS bf16x8*)(lds + PG8_SB(b, h) + boff + n * 2048 + k * 1024); } while (0)
#define PG8_MMA(ai, bj, At, Bt) do { __builtin_amdgcn_s_setprio(1); _Pragma("unroll") for (int m = 0; m < 4; ++m) _Pragma("unroll") for (int n = 0; n < 2; ++n) _Pragma("unroll") for (int k = 0; k < 2; ++k) \
        acc[ai][bj][m][n] = __builtin_amdgcn_mfma_f32_16x16x32_bf16(Bt[n][k], At[m][k], acc[ai][bj][m][n], 0, 0, 0); __builtin_amdgcn_s_setprio(0); } while (0)
#define PG8_WAIT_V(n) asm volatile("s_waitcnt vmcnt(" #n ")" ::: "memory")
#define PG8_WAIT_L(n) asm volatile("s_waitcnt lgkmcnt(" #n ")" ::: "memory")
#define PG8_BAR __builtin_amdgcn_s_barrier()
#define PG8_SCHED __builtin_amdgcn_sched_barrier(0)
    Unit cur, nxt; int ui = 0;
    if (!S.next(0, cur)) return;
    unsigned vA[2][2], vN[2][2];
#pragma unroll
    for (int h = 0; h < 2; ++h)
#pragma unroll
        for (int i = 0; i < 2; ++i) { vA[h][i] = (Sched::GATHER ? S.row_off(0, h * HALF + Rr[i]) : (unsigned)(h * HALF + Rr[i]) * S.lda) + Cb[i]; vN[h][i] = vA[h][i]; }
    f32x4 acc[2][2][4][2];
#pragma unroll
    for (int a = 0; a < 2; ++a)
#pragma unroll
        for (int b = 0; b < 2; ++b)
#pragma unroll
            for (int m = 0; m < 4; ++m)
#pragma unroll
                for (int n = 0; n < 2; ++n) acc[a][b][m][n] = (f32x4){0.f, 0.f, 0.f, 0.f};
    bf16x8 At[4][2], B0[2][2], B1[2][2];
    const char* cA = S.a_base(cur); const char* cB = S.b_base(cur);
    PG8_STAGE_B(PG8_SB(0, 0), cB); PG8_STAGE_A(PG8_SA(0, 0), cA, vA, 0, 0u); PG8_STAGE_B(PG8_SB(0, 1), cB + hstepB); PG8_STAGE_A(PG8_SA(0, 1), cA, vA, 1, 0u);
    if (wr == 1) PG8_BAR;
    PG8_WAIT_V(4); PG8_BAR;
    PG8_STAGE_B(PG8_SB(1, 0), cB + kstepB); PG8_STAGE_A(PG8_SA(1, 0), cA, vA, 0, kstepA); PG8_STAGE_B(PG8_SB(1, 1), cB + hstepB + kstepB);
    PG8_WAIT_V(6); PG8_BAR;
    for (;;) {
        const bool has_next = S.next(ui + 1, nxt);
        const char* nA = has_next ? S.a_base(nxt) : cA; const char* nB = has_next ? S.b_base(nxt) : cB;
        if (Sched::GATHER) {
#pragma unroll
            for (int h = 0; h < 2; ++h)
#pragma unroll
                for (int i = 0; i < 2; ++i) vN[h][i] = has_next ? (S.row_off(ui + 1, h * HALF + Rr[i]) + Cb[i]) : vA[h][i];
        }
        for (int t = 0; t < nt; t += 2) {
            const bool last = (t == nt - 2);
            const unsigned k1 = (unsigned)(t + 1) * kstepA;
            const char* a2p = last ? nA : cA; const unsigned k2 = last ? 0u : (unsigned)(t + 2) * kstepA;
            unsigned v2[2][2];
#pragma unroll
            for (int h = 0; h < 2; ++h)
#pragma unroll
                for (int i = 0; i < 2; ++i) v2[h][i] = (Sched::GATHER && last) ? vN[h][i] : vA[h][i];
            const char* b2 = last ? nB : cB + (size_t)(t + 2) * kstepB; const char* b3 = b2 + kstepB;
            PG8_LDB(B0, 0, 0); PG8_SCHED; PG8_LDA(At, 0, 0); PG8_STAGE_A(PG8_SA(1, 1), cA, vA, 1, k1);
            PG8_WAIT_L(8); PG8_BAR; PG8_WAIT_L(0); PG8_MMA(0, 0, At, B0); PG8_BAR; PG8_SCHED;
            PG8_LDB(B1, 0, 1); PG8_STAGE_B(PG8_SB(0, 0), b2);
            PG8_BAR; PG8_WAIT_L(0); PG8_MMA(0, 1, At, B1); PG8_BAR;
            PG8_LDA(At, 0, 1); PG8_STAGE_A(PG8_SA(0, 0), a2p, v2, 0, k2);
            PG8_BAR; PG8_WAIT_L(0); PG8_MMA(1, 0, At, B0); PG8_BAR; PG8_SCHED;
            PG8_STAGE_B(PG8_SB(0, 1), b2 + hstepB);
            PG8_WAIT_V(6); PG8_BAR; PG8_MMA(1, 1, At, B1); PG8_BAR;
            PG8_LDB(B0, 1, 0); PG8_SCHED; PG8_LDA(At, 1, 0); PG8_STAGE_A(PG8_SA(0, 1), a2p, v2, 1, k2);
            PG8_WAIT_L(8); PG8_BAR; PG8_WAIT_L(0); PG8_MMA(0, 0, At, B0); PG8_BAR; PG8_SCHED;
            PG8_LDB(B1, 1, 1); PG8_STAGE_B(PG8_SB(1, 0), b3);
            PG8_BAR; PG8_WAIT_L(0); PG8_MMA(0, 1, At, B1); PG8_BAR;
            PG8_LDA(At, 1, 1); PG8_STAGE_A(PG8_SA(1, 0), a2p, v2, 0, k2 + kstepA);
            PG8_BAR; PG8_WAIT_L(0); PG8_MMA(1, 0, At, B0); PG8_BAR; PG8_SCHED;
            PG8_STAGE_B(PG8_SB(1, 1), b3 + hstepB);
            PG8_WAIT_V(6); PG8_BAR; PG8_MMA(1, 1, At, B1); PG8_BAR;
        }
        E(acc, cur, wr, wc, fr, fq);
        if (!has_next) break;
#pragma unroll
        for (int a = 0; a < 2; ++a)
#pragma unroll
            for (int b = 0; b < 2; ++b)
#pragma unroll
                for (int m = 0; m < 4; ++m)
#pragma unroll
                    for (int n = 0; n < 2; ++n) acc[a][b][m][n] = (f32x4){0.f, 0.f, 0.f, 0.f};
        cur = nxt; cA = nA; cB = nB; ++ui;
#pragma unroll
        for (int h = 0; h < 2; ++h)
#pragma unroll
            for (int i = 0; i < 2; ++i) vA[h][i] = vN[h][i];
    }
    PG8_WAIT_V(0);
    if (wr == 0) PG8_BAR;
    PG8_BAR;
#undef PG8_SA
#undef PG8_SB
#undef PG8_STAGE_A
#undef PG8_STAGE_B
#undef PG8_LDA
#undef PG8_LDB
#undef PG8_MMA
#undef PG8_WAIT_V
#undef PG8_WAIT_L
#undef PG8_BAR
#undef PG8_SCHED
}

struct EpiStore {
    bf16_t* O; size_t ldc;
    DI void operator()(const f32x4 (&acc)[2][2][4][2], const Unit& u, int wr, int wc, int fr, int fq) const {
        const int row0 = u.pm * BM + wr * 64 + fr, col0 = u.pn * BM + wc * 32 + 8 * fq;
#pragma unroll
        for (int ai = 0; ai < 2; ++ai)
#pragma unroll
            for (int m = 0; m < 4; ++m) { bf16_t* rowp = O + (size_t)(row0 + ai * HALF + m * 16) * ldc + col0;
#pragma unroll
                for (int bj = 0; bj < 2; ++bj) { const f32x4 v0 = acc[ai][bj][m][0], v1 = acc[ai][bj][m][1];
                    u32x4 w; w.x = cvt_pk_bf16(v0[0], v0[1]); w.y = cvt_pk_bf16(v0[2], v0[3]); w.z = cvt_pk_bf16(v1[0], v1[1]); w.w = cvt_pk_bf16(v1[2], v1[3]);
                    *(u32x4*)(rowp + bj * HALF) = w; } }
    }
};
struct EpiSwiglu {
    bf16_t* Hb;
    DI void operator()(const f32x4 (&acc)[2][2][4][2], const Unit& u, int wr, int wc, int fr, int fq) const {
        const int row0 = u.pm * BM + wr * 64 + fr, col0 = u.pn * HALF + wc * 32 + 8 * fq;
#pragma unroll
        for (int ai = 0; ai < 2; ++ai)
#pragma unroll
            for (int m = 0; m < 4; ++m) { bf16_t* rowp = Hb + (size_t)(row0 + ai * HALF + m * 16) * DEXP + col0;
                float o[8];
#pragma unroll
                for (int n = 0; n < 2; ++n)
#pragma unroll
                    for (int j = 0; j < 4; ++j) { const float g = acc[ai][0][m][n][j], up = acc[ai][1][m][n][j];
                        o[n * 4 + j] = g * up * __builtin_amdgcn_rcpf(1.0f + __builtin_amdgcn_exp2f(-1.4426950408889634f * g)); }
                u32x4 w; w.x = cvt_pk_bf16(o[0], o[1]); w.y = cvt_pk_bf16(o[2], o[3]); w.z = cvt_pk_bf16(o[4], o[5]); w.w = cvt_pk_bf16(o[6], o[7]);
                *(u32x4*)rowp = w; }
    }
};

struct EpiNsa {
    bf16_t* Q; bf16_t* KV; float* GT;
    DI void operator()(const f32x4 (&acc)[2][2][4][2], const Unit& u, int wr, int wc, int fr, int fq) const {
        const int row0 = u.pm * BM + wr * 64 + fr;
        if (u.pn < 10) {
            bf16_t* base = (u.pn < 4) ? Q + u.pn * BM : KV + (u.pn - 4) * BM; const size_t ldc = (u.pn < 4) ? 1024 : 1536; const int col0 = wc * 32 + 8 * fq;
#pragma unroll
            for (int ai = 0; ai < 2; ++ai)
#pragma unroll
                for (int m = 0; m < 4; ++m) { bf16_t* rowp = base + (size_t)(row0 + ai * HALF + m * 16) * ldc + col0;
#pragma unroll
                    for (int bj = 0; bj < 2; ++bj) { const f32x4 v0 = acc[ai][bj][m][0], v1 = acc[ai][bj][m][1];
                        u32x4 w; w.x = cvt_pk_bf16(v0[0], v0[1]); w.y = cvt_pk_bf16(v0[2], v0[3]); w.z = cvt_pk_bf16(v1[0], v1[1]); w.w = cvt_pk_bf16(v1[2], v1[3]);
                        *(u32x4*)(rowp + bj * HALF) = w; } }
        } else {
            const int col0 = wc * 32 + 8 * fq;
            if (col0 < 48) {
#pragma unroll
                for (int ai = 0; ai < 2; ++ai)
#pragma unroll
                    for (int m = 0; m < 4; ++m) { float* rowp = GT + (size_t)(row0 + ai * HALF + m * 16) * 48 + col0;
#pragma unroll
                        for (int n = 0; n < 2; ++n) { f32x4 v = acc[ai][0][m][n];
#pragma unroll
                            for (int j = 0; j < 4; ++j) v[j] = __builtin_amdgcn_rcpf(1.0f + __builtin_amdgcn_exp2f(-1.4426950408889634f * v[j]));
                            *(f32x4*)(rowp + 4 * n) = v; } }
            }
        }
    }
};
struct EpiCmp {
    bf16_t* Hd; const float* bias;
    DI void operator()(const f32x4 (&acc)[2][2][4][2], const Unit& u, int wr, int wc, int fr, int fq) const {
        const int row0 = u.pm * BM + wr * 64 + fr, col0 = wc * 32 + 8 * fq; const float* bp = bias + u.e * 256;
#pragma unroll
        for (int bj = 0; bj < 2; ++bj) { const f32x4 b0 = *(const f32x4*)(bp + bj * HALF + col0), b1 = *(const f32x4*)(bp + bj * HALF + col0 + 4);
#pragma unroll
            for (int ai = 0; ai < 2; ++ai)
#pragma unroll
                for (int m = 0; m < 4; ++m) { float o[8];
#pragma unroll
                    for (int j = 0; j < 4; ++j) { o[j] = acc[ai][bj][m][0][j] + b0[j]; o[4 + j] = acc[ai][bj][m][1][j] + b1[j]; }
#pragma unroll
                    for (int j = 0; j < 8; ++j) { const float x = o[j], u2 = 1.5957691216057308f * (x + 0.044715f * x * x * x); o[j] = x * __builtin_amdgcn_rcpf(1.0f + __builtin_amdgcn_exp2f(-1.4426950408889634f * u2)); }
                    u32x4 w; w.x = cvt_pk_bf16(o[0], o[1]); w.y = cvt_pk_bf16(o[2], o[3]); w.z = cvt_pk_bf16(o[4], o[5]); w.w = cvt_pk_bf16(o[6], o[7]);
                    *(u32x4*)(Hd + (size_t)(row0 + ai * HALF + m * 16) * 256 + bj * HALF + col0) = w; } }
    }
};
struct CmpSched {
    static constexpr bool GATHER = false;
    const char* kv6; const char* Bt; int K; unsigned lda, kstepA; int G, c;
    DI bool next(int i, Unit& u) const { const int L = i * G + c; if (L >= 64) return false; u.pm = L; u.pn = 0; u.e = L >> 5; return true; }
    DI const char* a_base(const Unit& u) const { const int j = u.pm >> 5, bg = (u.pm >> 2) & 7, cq = u.pm & 3, b = bg >> 2, g = bg & 3;
        return kv6 + (((size_t)b * SEQ + (size_t)cq * 4096) * 1536 + j * 256 + g * 64) * 2; }
    DI const char* b_base(const Unit& u) const { return Bt + (size_t)(u.pm >> 5) * 256 * 2048 * 2; }
    DI unsigned row_off(int, int) const { return 0u; }
};
}

struct MoeMeta { LAS int* tstart; LAS int* cnt; };
DI int moe_expert_of(const MoeMeta& mm, int rt) { int e = 0;
#pragma unroll
    for (int k = 1; k < 16; ++k) e += (rt >= mm.tstart[k]) ? 1 : 0;
    return e; }
struct Moe1Sched {
    static constexpr bool GATHER = true;
    const char* A; const char* Bt; int K; unsigned lda, kstepA; MoeMeta mm; int ntiles, G, c; LAS unsigned* tab;
    DI bool next(int i, pg8::Unit& u) const { const int L = i * G + c; if (L >= ntiles * 2) return false; u.pm = L % ntiles; u.pn = L / ntiles; u.e = moe_expert_of(mm, u.pm); return true; }
    DI const char* a_base(const pg8::Unit&) const { return A; }
    DI const char* b_base(const pg8::Unit& u) const { return Bt + ((size_t)u.e * 512 + (size_t)u.pn * 256) * 1024 * 2; }
    DI unsigned row_off(int slot, int row) const { return tab[slot * 256 + row]; }
};
struct Moe2Sched {
    static constexpr bool GATHER = false;
    const char* A; const char* Bt; int K; unsigned lda, kstepA; MoeMeta mm; int ntiles, G, c;
    DI bool next(int i, pg8::Unit& u) const { const int L = i * G + c; if (L >= ntiles * 4) return false; u.pm = L % ntiles; u.pn = L / ntiles; u.e = moe_expert_of(mm, u.pm); return true; }
    DI const char* a_base(const pg8::Unit& u) const { return A + (size_t)u.pm * 256 * 512; }
    DI const char* b_base(const pg8::Unit& u) const { return Bt + ((size_t)u.e * 1024 + (size_t)u.pn * 256) * 256 * 2; }
    DI unsigned row_off(int, int) const { return 0u; }
};

struct Args { const float* in[25]; float* out; unsigned char* ws; int wv; int pad; };
enum { IN_X = 0, IN_REL, IN_RW, IN_RB, IN_LN1G, IN_LN1B, IN_LN2G, IN_LN2B, IN_EG, IN_EU, IN_ED, IN_DILIN, IN_DILOUT, IN_SBIN, IN_SBOUT,
       IN_NSAIN, IN_NSAOUT, IN_POSK, IN_W1K, IN_W2K, IN_POSV, IN_W1V, IN_W2V, IN_MOBAIN, IN_MOBAOUT };

DI void transpose_item(const float* W, int K, int N, int Nvalid, bf16_t* WT, int drow0, LAS float* scr, int kb, int nb, int lane) {
    const int k0 = 64 * kb, n0 = 32 * nb;
    const int c4 = lane & 7, kr = lane >> 3;
    if (n0 + 32 <= Nvalid) {
#pragma unroll
        for (int i = 0; i < 8; ++i) { const f32x4 v = *(const f32x4*)(W + (size_t)(k0 + kr + 8 * i) * N + n0 + 4 * c4); LAS float* s = scr + (kr + 8 * i) * 33 + 4 * c4;
            s[0] = v.x; s[1] = v.y; s[2] = v.z; s[3] = v.w; }
    } else {
#pragma unroll 8
        for (int i = 0; i < 32; ++i) { const int kk = 2 * i + (lane >> 5); const int n = n0 + (lane & 31); scr[kk * 33 + (lane & 31)] = (n < Nvalid) ? W[(size_t)(k0 + kk) * N + n] : 0.f; }
    }
    LDS_WAIT(); asm volatile("" ::: "memory");
    const int c = lane & 7;
#pragma unroll
    for (int j = 0; j < 4; ++j) { const int n = (lane >> 3) + 8 * j; const LAS float* s = scr + (8 * c) * 33 + n;
        u32x4 o; o.x = pk2(s[0 * 33], s[1 * 33]); o.y = pk2(s[2 * 33], s[3 * 33]); o.z = pk2(s[4 * 33], s[5 * 33]); o.w = pk2(s[6 * 33], s[7 * 33]);
        *(u32x4*)(WT + (size_t)(drow0 + n) * K + k0 + 8 * c) = o; }
    LDS_WAIT(); asm volatile("" ::: "memory");
}
DI void convert_matrix(const float* W, int K, int N, int Npad, bf16_t* WT, LAS float* scr, int gw, int NGW, int lane) {
    const int nblk = Npad / 32, nitems = (K / 64) * nblk;
    for (int it = gw; it < nitems; it += NGW) { const int kb = it / nblk, nb = it % nblk; transpose_item(W, K, N, N, WT, 32 * nb, scr, kb, nb, lane); }
}
DI void convert_layer_weights(const Args& a, int layer, LAS unsigned char* lds, int gw, int NGW, int wave, int lane) {
    LAS float* scr = (LAS float*)(lds + STAGE_OFF + wave * 16384);
    bf16_t* W1 = (bf16_t*)(a.ws + WS_WEXP1); bf16_t* W2 = (bf16_t*)(a.ws + WS_WEXP2);
    const float* eg = a.in[IN_EG] + (size_t)layer * NE * D * DEXP; const float* eu = a.in[IN_EU] + (size_t)layer * NE * D * DEXP; const float* ed = a.in[IN_ED] + (size_t)layer * NE * DEXP * D;
    constexpr int I_G = (D / 64) * (DEXP / 32);
    constexpr int I_D = (DEXP / 64) * (D / 32);
    constexpr int I_E = 2 * I_G + I_D;
    {
        bf16_t* Win = (bf16_t*)(a.ws + WS_WIN); bf16_t* Wout = (bf16_t*)(a.ws + WS_WOUT);
        if (layer == 0) { convert_matrix(a.in[IN_DILIN], D, 9216, 9216, Win, scr, gw, NGW, lane); convert_matrix(a.in[IN_DILOUT], D, D, D, Wout, scr, gw, NGW, lane); }
        if (layer == 1) { convert_matrix(a.in[IN_SBIN], D, 3072, 3072, Win, scr, gw, NGW, lane); convert_matrix(a.in[IN_SBOUT], D, D, D, Wout, scr, gw, NGW, lane); }
        if (layer == 2) { convert_matrix(a.in[IN_NSAIN], D, 2608, 2816, Win, scr, gw, NGW, lane); convert_matrix(a.in[IN_NSAOUT], D, D, D, Wout, scr, gw, NGW, lane);
            bf16_t* wc = (bf16_t*)(a.ws + WS_WCMP);
            convert_matrix(a.in[IN_W1K], 2048, 256, 256, wc, scr, gw, NGW, lane); convert_matrix(a.in[IN_W1V], 2048, 256, 256, wc + 256 * 2048, scr, gw, NGW, lane);
            convert_matrix(a.in[IN_W2K], 256, 64, 64, wc + 2 * 256 * 2048, scr, gw, NGW, lane); convert_matrix(a.in[IN_W2V], 256, 64, 64, wc + 2 * 256 * 2048 + 64 * 256, scr, gw, NGW, lane);
            float* cb = (float*)(a.ws + WS_WCMP + 2 * MiB + 64 * 1024);
            for (int it = gw; it < 512; it += NGW) { const int j = it >> 8, n = it & 255; const float* pos = a.in[j ? IN_POSV : IN_POSK]; const float* w1 = a.in[j ? IN_W1V : IN_W1K];
                float s = 0.f; for (int k = lane; k < 2048; k += 64) s += pos[k] * w1[(size_t)k * 256 + n];
                s = wave_sum(s); if (lane == 0) cb[it] = s; } }
        if (layer == 3) { convert_matrix(a.in[IN_MOBAIN], D, 3072, 3072, Win, scr, gw, NGW, lane); convert_matrix(a.in[IN_MOBAOUT], D, D, D, Wout, scr, gw, NGW, lane); }
    }
    const int NITEMS = NE * I_E;
    for (int it = gw; it < NITEMS; it += NGW) {
        const int e = it / I_E; int r = it % I_E;
        if (r < I_G) { const int kb = r / (DEXP / 32), nb = r % (DEXP / 32); const int n0 = 32 * nb;
            transpose_item(eg + (size_t)e * D * DEXP, D, DEXP, DEXP, W1, e * 512 + ((n0 >> 7) << 8) + (n0 & 127), scr, kb, nb, lane); continue; }
        r -= I_G;
        if (r < I_G) { const int kb = r / (DEXP / 32), nb = r % (DEXP / 32); const int n0 = 32 * nb;
            transpose_item(eu + (size_t)e * D * DEXP, D, DEXP, DEXP, W1, e * 512 + ((n0 >> 7) << 8) + 128 + (n0 & 127), scr, kb, nb, lane); continue; }
        r -= I_G;
        { const int kb = r / (D / 32), nb = r % (D / 32);
          transpose_item(ed + (size_t)e * DEXP * D, DEXP, D, D, W2, e * 1024 + 32 * nb, scr, kb, nb, lane); }
    }
}

struct RowVec { f32x4 v[4]; };
DI void ln_stats(const RowVec& r, float& mean, float& rstd) {
    float s = 0.f;
#pragma unroll
    for (int j = 0; j < 4; ++j) s += (r.v[j].x + r.v[j].y) + (r.v[j].z + r.v[j].w);
    mean = wave_sum(s) * (1.f / D); float s2 = 0.f;
#pragma unroll
    for (int j = 0; j < 4; ++j) { const f32x4 d = r.v[j] - mean; s2 += (d.x * d.x + d.y * d.y) + (d.z * d.z + d.w * d.w); }
    rstd = 1.f / sqrtf(wave_sum(s2) * (1.f / D) + LN_EPS);
}


constexpr int KSTR = 144;
constexpr int KVT = 64;
constexpr int KV_TILE_BYTES = KVT * KSTR;
constexpr float LOG2E = 1.4426950408889634f, LN2F = 0.6931471805599453f;
DI f32x16 mfma32(bf16x8 a, bf16x8 b, f32x16 c) { return __builtin_amdgcn_mfma_f32_32x32x16_bf16(a, b, c, 0, 0, 0); }
DI f32x16 zero16() { f32x16 z; for (int i = 0; i < 16; ++i) z[i] = 0.f; return z; }
DI void kv_fetch(u32x4& kr, u32x4& vr, const bf16_t* kb, const bf16_t* vb, size_t rstride, int row0, int nrows, int tid) {
    asm volatile("" : "+v"(tid));
    const int row = row0 + (tid >> 3), c16 = tid & 7;
    if (row >= 0 && row < nrows) { kr = *(const u32x4*)(kb + (size_t)row * rstride + c16 * 8); vr = *(const u32x4*)(vb + (size_t)row * rstride + c16 * 8); }
    else { kr = (u32x4){0u, 0u, 0u, 0u}; vr = kr; }
}
DI void kv_store(LAS unsigned char* kl, LAS unsigned char* vl, const u32x4& kr, const u32x4& vr, int tid) {
    asm volatile("" ::: "memory"); __builtin_amdgcn_sched_barrier(0);
    asm volatile("" : "+v"(tid));
    const int off = (tid >> 3) * KSTR + (tid & 7) * 16;
    *(LAS u32x4*)(kl + off) = kr; *(LAS u32x4*)(vl + off) = vr;
}
constexpr int DT_BYTES = 16384;
DI void kv_dma_issue(LAS unsigned char* slot, const bf16_t* kb, const bf16_t* vb, size_t rstride, int row0, int nrows, int wave, int lane) {
    asm volatile("" : "+v"(lane));
    const int rr = lane >> 3, row = min(max(row0 + 8 * wave + rr, 0), nrows - 1), ch = (lane & 7) ^ rr;
    const size_t off = (size_t)row * rstride + ch * 8;
    __builtin_amdgcn_global_load_lds((const unsigned*)(kb + off), (LAS unsigned*)(slot + wave * 1024), 16, 0, 0);
    __builtin_amdgcn_global_load_lds((const unsigned*)(vb + off), (LAS unsigned*)(slot + 8192 + wave * 1024), 16, 0, 0);
}
DI f32x16 qk_tile_sw(const LAS unsigned char* kl, int kt, const bf16x8 (&Q)[4], int lane) {
    asm volatile("" : "+v"(lane));
    const int r = lane & 31, h = lane >> 5;
    const int pr = (r & ~12) | ((r & 4) << 1) | ((r & 8) >> 1), sw = pr & 7;
    const LAS unsigned char* p = kl + (kt * 32 + pr) * 128;
    f32x16 S = zero16();
#pragma unroll
    for (int ks = 0; ks < 4; ++ks) { const bf16x8 A = *(const LAS bf16x8*)(p + (((2 * ks + h) ^ sw) << 4)); S = mfma32(A, Q[ks], S); }
    return S;
}
DI void pv_tile_sw(const LAS unsigned char* vl, int kt, const f32x16& P, f32x16 (&O)[2], int lane) {
    asm volatile("" : "+v"(lane));
    const int i16 = lane & 15, q = i16 >> 2, p = i16 & 3, blk = (lane >> 4) & 1, h = lane >> 5;
    const unsigned vp = (unsigned)(size_t)(vl + (kt * 32 + 8 * h + q) * 128 + 8 * (p & 1));
    const int c0 = 2 * blk + (p >> 1), c1 = 4 + c0;
    const unsigned a0 = vp + ((c0 ^ q) << 4), a1 = vp + 512 + ((c0 ^ (q + 4)) << 4), a2 = vp + ((c1 ^ q) << 4), a3 = vp + 512 + ((c1 ^ (q + 4)) << 4);
    s16x4 lo0, hi0, lo1, hi1, lo2, hi2, lo3, hi3;
    asm volatile("ds_read_b64_tr_b16 %0, %8\n\tds_read_b64_tr_b16 %1, %9\n\tds_read_b64_tr_b16 %2, %10\n\tds_read_b64_tr_b16 %3, %11\n\t"
                 "ds_read_b64_tr_b16 %4, %8 offset:2048\n\tds_read_b64_tr_b16 %5, %9 offset:2048\n\tds_read_b64_tr_b16 %6, %10 offset:2048\n\tds_read_b64_tr_b16 %7, %11 offset:2048\n\ts_waitcnt lgkmcnt(0)"
                 : "=&v"(lo0), "=&v"(hi0), "=&v"(lo1), "=&v"(hi1), "=&v"(lo2), "=&v"(hi2), "=&v"(lo3), "=&v"(hi3) : "v"(a0), "v"(a1), "v"(a2), "v"(a3) : "memory");
    { u32x4 pk; pk.x = cvt_pk_bf16(P[0], P[1]); pk.y = cvt_pk_bf16(P[2], P[3]); pk.z = cvt_pk_bf16(P[4], P[5]); pk.w = cvt_pk_bf16(P[6], P[7]);
      const bf16x8 Bp = __builtin_bit_cast(bf16x8, pk);
      O[0] = mfma32(__builtin_shufflevector(lo0, hi0, 0, 1, 2, 3, 4, 5, 6, 7), Bp, O[0]);
      O[1] = mfma32(__builtin_shufflevector(lo1, hi1, 0, 1, 2, 3, 4, 5, 6, 7), Bp, O[1]); }
    { u32x4 pk; pk.x = cvt_pk_bf16(P[8], P[9]); pk.y = cvt_pk_bf16(P[10], P[11]); pk.z = cvt_pk_bf16(P[12], P[13]); pk.w = cvt_pk_bf16(P[14], P[15]);
      const bf16x8 Bp = __builtin_bit_cast(bf16x8, pk);
      O[0] = mfma32(__builtin_shufflevector(lo2, hi2, 0, 1, 2, 3, 4, 5, 6, 7), Bp, O[0]);
      O[1] = mfma32(__builtin_shufflevector(lo3, hi3, 0, 1, 2, 3, 4, 5, 6, 7), Bp, O[1]); }
}
template <int NS, class RowF, class CompF>
DI void kv_dma_pipeline(int n, const RowF& rowf, const CompF& comp, const bf16_t* kb, const bf16_t* vb, size_t rstride, int nrows, LAS unsigned char* ring, int wave, int lane) {
    if (n <= 0) return;
#pragma unroll
    for (int i = 0; i < NS - 1; ++i) if (i < n) kv_dma_issue(ring + i * DT_BYTES, kb, vb, rstride, rowf(i), nrows, wave, lane);
    int sc = 0, sn = NS - 1;
#pragma unroll 1
    for (int j = 0; j < n; ++j) {
        const int rem = min(n - 1 - j, NS - 2);
        if (rem >= 4) asm volatile("s_waitcnt vmcnt(8)" ::: "memory");
        else if (rem == 3) asm volatile("s_waitcnt vmcnt(6)" ::: "memory");
        else if (rem == 2) asm volatile("s_waitcnt vmcnt(4)" ::: "memory");
        else if (rem == 1) asm volatile("s_waitcnt vmcnt(2)" ::: "memory");
        else asm volatile("s_waitcnt vmcnt(0)" ::: "memory");
        __builtin_amdgcn_s_barrier(); asm volatile("" ::: "memory");
        comp(j, ring + sc * DT_BYTES, ring + sc * DT_BYTES + 8192);
        if (j + NS - 1 < n) kv_dma_issue(ring + sn * DT_BYTES, kb, vb, rstride, rowf(j + NS - 1), nrows, wave, lane);
        sc = (sc + 1 == NS) ? 0 : sc + 1; sn = (sn + 1 == NS) ? 0 : sn + 1;
    }
    asm volatile("s_waitcnt lgkmcnt(0)" ::: "memory"); __builtin_amdgcn_s_barrier(); asm volatile("" ::: "memory");
}
template <int NS, class IssueF, class CompF>
DI void kv_dma_stream(int n, const IssueF& issue, const CompF& comp, LAS unsigned char* ring) {
    if (n <= 0) return;
#pragma unroll
    for (int i = 0; i < NS - 1; ++i) if (i < n) issue(i, ring + i * DT_BYTES);
    int sc = 0, sn = NS - 1;
#pragma unroll 1
    for (int j = 0; j < n; ++j) {
        const int rem = min(n - 1 - j, NS - 2);
        if (rem >= 4) asm volatile("s_waitcnt vmcnt(8)" ::: "memory");
        else if (rem == 3) asm volatile("s_waitcnt vmcnt(6)" ::: "memory");
        else if (rem == 2) asm volatile("s_waitcnt vmcnt(4)" ::: "memory");
        else if (rem == 1) asm volatile("s_waitcnt vmcnt(2)" ::: "memory");
        else asm volatile("s_waitcnt vmcnt(0)" ::: "memory");
        __builtin_amdgcn_s_barrier(); asm volatile("" ::: "memory");
        comp(j, ring + sc * DT_BYTES, ring + sc * DT_BYTES + 8192);
        if (j + NS - 1 < n) issue(j + NS - 1, ring + sn * DT_BYTES);
        sc = (sc + 1 == NS) ? 0 : sc + 1; sn = (sn + 1 == NS) ? 0 : sn + 1;
    }
    asm volatile("s_waitcnt lgkmcnt(0)" ::: "memory"); __builtin_amdgcn_s_barrier(); asm volatile("" ::: "memory");
}
DI f32x16 qk_tile(const LAS unsigned char* kl, int kt, const bf16x8 (&Q)[4], int lane) {
    asm volatile("" : "+v"(lane));
    const int r = lane & 31, h = lane >> 5;
    const int pr = (r & ~12) | ((r & 4) << 1) | ((r & 8) >> 1);
    const LAS unsigned char* p = kl + (kt * 32 + pr) * KSTR + h * 16;
    f32x16 S = zero16();
#pragma unroll
    for (int ks = 0; ks < 4; ++ks) { const bf16x8 A = *(const LAS bf16x8*)(p + ks * 32); S = mfma32(A, Q[ks], S); }
    return S;
}
DI void pv_tile(const LAS unsigned char* vl, int kt, const f32x16& P, f32x16 (&O)[2], int lane) {
    asm volatile("" : "+v"(lane));
    const int i16 = lane & 15, q = i16 >> 2, p = i16 & 3, blk = (lane >> 4) & 1, h = lane >> 5;
#pragma unroll
    for (int s = 0; s < 2; ++s) {
        u32x4 pk; pk.x = cvt_pk_bf16(P[8 * s + 0], P[8 * s + 1]); pk.y = cvt_pk_bf16(P[8 * s + 2], P[8 * s + 3]); pk.z = cvt_pk_bf16(P[8 * s + 4], P[8 * s + 5]); pk.w = cvt_pk_bf16(P[8 * s + 6], P[8 * s + 7]);
        const bf16x8 Bp = __builtin_bit_cast(bf16x8, pk);
        const LAS unsigned char* vp = vl + (kt * 32 + 16 * s + 8 * h + q) * KSTR + (16 * blk + 4 * p) * 2;
#pragma unroll
        for (int dt = 0; dt < 2; ++dt) {
            const s16x4 lo = __builtin_amdgcn_ds_read_tr16_b64_v4i16((LAS s16x4*)(vp + dt * 64));
            const s16x4 hi = __builtin_amdgcn_ds_read_tr16_b64_v4i16((LAS s16x4*)(vp + dt * 64 + 4 * KSTR));
            const bf16x8 A = __builtin_shufflevector(lo, hi, 0, 1, 2, 3, 4, 5, 6, 7);
            O[dt] = mfma32(A, Bp, O[dt]);
        }
    }
}
DI void store_o(bf16_t* orow, const f32x16 (&O)[2], float sc, int h) {
#pragma unroll
    for (int dt = 0; dt < 2; ++dt)
#pragma unroll
        for (int g = 0; g < 4; ++g) { u32x2 w; w.x = cvt_pk_bf16(O[dt][4 * g] * sc, O[dt][4 * g + 1] * sc); w.y = cvt_pk_bf16(O[dt][4 * g + 2] * sc, O[dt][4 * g + 3] * sc);
            *(u32x2*)(orow + dt * 32 + 8 * g + 4 * h) = w; }
}

constexpr int BT_PAD = 128, BT_LEN = BT_PAD + 2048;
constexpr int DIST_ANY = 0x3fffffff, DIST_NONE = 0x40000000;
constexpr size_t WS_RW = WS_SMALL;
constexpr size_t WS_BIASG = WS_SMALL + 256 * 1024;
DI void load_bias_table(LAS float* dst, const float* biasG, int head, int dsh, int tid, int hicut = 0x3fffffff) {
    for (int i = tid; i < BT_LEN; i += NTHR) { const int n = i - BT_PAD; dst[i] = (n >= 0 && n <= hicut) ? biasG[head * 2048 + min(n << dsh, 2047)] : -1e30f; }
}
template <int STRIDE, bool MASKED>
DI float logits_tile(f32x16 (&S)[2], const LAS float* P, int D0, int h, int lo, unsigned range) {
    float mx = -1e30f;
    if (!MASKED && __all(D0 - 63 * STRIDE >= 1512)) {
        const float cb = P[BT_PAD + 2047];
#pragma unroll
        for (int sub = 0; sub < 2; ++sub)
#pragma unroll
            for (int i = 0; i < 16; ++i) { const float x = S[sub][i] * (0.125f * LOG2E) + cb; S[sub][i] = x; mx = fmaxf(mx, x); }
        return mx;
    }
#pragma unroll
    for (int sub = 0; sub < 2; ++sub)
#pragma unroll
        for (int s = 0; s < 2; ++s) {
            const int d0 = D0 - (32 * sub + 16 * s + 8 * h) * STRIDE;
            const int base = min(max(d0 - 7 * STRIDE + BT_PAD, 0), BT_LEN - 1 - 7 * STRIDE);
            const LAS float* pb = P + base;
#pragma unroll
            for (int j = 0; j < 8; ++j) { const int i = 8 * s + j;
                float x = S[sub][i] * (0.125f * LOG2E) + pb[(7 - j) * STRIDE];
                if (MASKED) x = ((unsigned)(d0 - j * STRIDE - lo) <= range) ? x : -1e30f;
                S[sub][i] = x; mx = fmaxf(mx, x); }
        }
    return mx;
}
template <int STRIDE, bool MASKED>
DI void softmax_tile(f32x16 (&S)[2], float& m, float& l, f32x16 (&O)[2], const LAS float* P, int D0, int h, int lo, unsigned range) {
    float mx = logits_tile<STRIDE, MASKED>(S, P, D0, h, lo, range);
    mx = fmaxf(mx, xor32h(mx, h));
    const float mnew = fmaxf(m, mx), mm = (mnew <= -1e30f) ? 0.f : mnew;
    float ls = 0.f;
#pragma unroll
    for (int sub = 0; sub < 2; ++sub)
#pragma unroll
        for (int i = 0; i < 16; ++i) { const float p = __builtin_amdgcn_exp2f(S[sub][i] - mm); S[sub][i] = p; ls += p; }
    ls += xor32h(ls, h);
    if (!__all(mnew == m)) {
        const float alpha = __builtin_amdgcn_exp2f(m - mnew);
        l *= alpha;
#pragma unroll
        for (int dt = 0; dt < 2; ++dt)
#pragma unroll
            for (int i = 0; i < 16; ++i) O[dt][i] *= alpha;
    }
    l += ls; m = mnew;
}
template <int STRIDE, bool MASKED>
DI void stats_tile(f32x16 (&S)[2], float& m, float& l, const LAS float* P, int D0, int h, int lo, unsigned range) {
    float mx = logits_tile<STRIDE, MASKED>(S, P, D0, h, lo, range);
    mx = fmaxf(mx, xor32h(mx, h));
    const float mnew = fmaxf(m, mx), mm = (mnew <= -1e30f) ? 0.f : mnew;
    float ls = 0.f;
#pragma unroll
    for (int sub = 0; sub < 2; ++sub)
#pragma unroll
        for (int i = 0; i < 16; ++i) ls += __builtin_amdgcn_exp2f(S[sub][i] - mm);
    ls += xor32h(ls, h);
    l = l * __builtin_amdgcn_exp2f(m - mnew) + ls; m = mnew;
}

constexpr size_t BIG_OG = 288 * MiB;
constexpr size_t BIG_LSE = 384 * MiB;
DI void dilated_phase(const Args& a, LAS unsigned char* lds) {
    int tid = tid_of(a.wv); asm volatile("" : "+v"(tid));
    const int lane = tid & 63, wave = a.wv, c = lane & 31, h = lane >> 5;
    const bf16_t* qkv = (const bf16_t*)(a.ws + WS_BIG);
    LAS unsigned char* kbuf = lds; LAS unsigned char* vbuf = lds + 2 * KV_TILE_BYTES;
    LAS float* btab = (LAS float*)(lds + 4 * KV_TILE_BYTES);
    const float* biasG = (const float*)(a.ws + WS_BIASG);
    const int G = gridDim.x, bid = blockIdx.x;
    const int nu = bid < 3072 ? (3072 - bid + G - 1) / G : 0;
    if (nu == 0) return;
#define DL_DESC(k) const int u_ = bid + (k) * G, hh_ = u_ & 15, g_ = (u_ >> 4) >> 6, idx_ = (u_ >> 4) & 63, dsh_ = 2 * g_, r_ = idx_ & ((1 << dsh_) - 1), blk_ = idx_ >> dsh_; \
        const bf16_t* qb_ = qkv + (size_t)r_ * 9216 + g_ * 3072 + hh_ * 64; const size_t rs_ = (size_t)9216 << dsh_; (void)blk_; (void)qb_; (void)rs_;
    int cur_key = -1, buf = 0;
    int hh = 0, g = 0, dsh = 0, r = 0, Q0 = 0, q0w = 0, iq = 0;
    bf16x8 Q[4], Qn[4];
    f32x16 O[2]; float m = -1e30f, l = 0.f;
    u32x4 kr, vr;
    { DL_DESC(0)
      const bf16_t* qrow = qb_ + (size_t)(blk_ * 256 + 32 * wave + c) * rs_;
#pragma unroll
      for (int ks = 0; ks < 4; ++ks) Qn[ks] = *(const bf16x8*)(qrow + 16 * ks + 8 * h);
      kv_fetch(kr, vr, qb_ + 1024, qb_ + 2048, rs_, blk_ * 256 - 128, SEQ >> dsh_, tid); kv_store(kbuf, vbuf, kr, vr, tid); }
    const int total = nu * 6;
#pragma unroll 1
    for (int f = 0; f < total; ++f) {
        const int k = f / 6, j = f - 6 * k;
        if (j == 0) {
            DL_DESC(k)
            hh = hh_; g = g_; dsh = dsh_; r = r_; Q0 = blk_ * 256; q0w = Q0 + 32 * wave; iq = q0w + c;
#pragma unroll
            for (int ks = 0; ks < 4; ++ks) Q[ks] = Qn[ks];
            O[0] = zero16(); O[1] = zero16(); m = -1e30f; l = 0.f;
            if (hh * 4 + g != cur_key) { __syncthreads(); load_bias_table(btab, biasG, hh, dsh, tid, 128); cur_key = hh * 4 + g; }
        }
        __syncthreads();
        if (f + 1 < total) { const int k1 = (f + 1) / 6, j1 = (f + 1) - 6 * k1; DL_DESC(k1)
            kv_fetch(kr, vr, qb_ + 1024, qb_ + 2048, rs_, blk_ * 256 - 128 + 64 * j1, SEQ >> dsh_, tid); }
        { const int kr0 = Q0 - 128 + 64 * j;
          if (kr0 <= q0w + 31 && kr0 + 63 >= q0w - 128 && kr0 + 63 >= 0) {
            const LAS unsigned char* kl = kbuf + buf * KV_TILE_BYTES; const LAS unsigned char* vl = vbuf + buf * KV_TILE_BYTES;
            f32x16 S[2]; S[0] = qk_tile(kl, 0, Q, lane); S[1] = qk_tile(kl, 1, Q, lane);
            if (Q0 > 0) softmax_tile<1, false>(S, m, l, O, btab, iq - kr0, h, 0, 128u);
            else softmax_tile<1, true>(S, m, l, O, btab, iq - kr0, h, 0, (unsigned)min(128, iq));
            pv_tile(vl, 0, S[0], O, lane); pv_tile(vl, 1, S[1], O, lane);
          } }
        if (j == 3 && k + 1 < nu) { DL_DESC(k + 1)
            const bf16_t* qrow = qb_ + (size_t)(blk_ * 256 + 32 * wave + c) * rs_;
#pragma unroll
            for (int ks = 0; ks < 4; ++ks) Qn[ks] = *(const bf16x8*)(qrow + 16 * ks + 8 * h); }
        if (f + 1 < total) kv_store(kbuf + (buf ^ 1) * KV_TILE_BYTES, vbuf + (buf ^ 1) * KV_TILE_BYTES, kr, vr, tid);
        buf ^= 1;
        if (j == 5) {
            const int tok = (iq << dsh) + r;
            bf16_t* og = (bf16_t*)(a.ws + WS_BIG + BIG_OG) + (size_t)g * SEQ * D;
            float* lse = (float*)(a.ws + WS_BIG + BIG_LSE) + (size_t)g * SEQ * 16;
            store_o(og + (size_t)tok * D + hh * 64, O, 1.f / l, h);
            if (h == 0) lse[tok * 16 + hh] = m + __builtin_amdgcn_logf(l);
        }
    }
#undef DL_DESC
}
DI void dilated_merge(const Args& a, int b) {
    const int tid = tid_of(a.wv);
    const bf16_t* og = (const bf16_t*)(a.ws + WS_BIG + BIG_OG); const float* lse = (const float*)(a.ws + WS_BIG + BIG_LSE);
    bf16_t* outb = (bf16_t*)(a.ws + WS_ACTB) + (size_t)b * SEQ * D;
    for (int i = blockIdx.x * NTHR + tid; i < SEQ * 128; i += gridDim.x * NTHR) {
        const int tok = i >> 7, c8 = i & 127, hh = c8 >> 3;
        const float l0 = lse[tok * 16 + hh], l1 = lse[SEQ * 16 + tok * 16 + hh], l2 = lse[2 * SEQ * 16 + tok * 16 + hh];
        const float mx = fmaxf(l0, fmaxf(l1, l2));
        float w0 = __builtin_amdgcn_exp2f(l0 - mx), w1 = __builtin_amdgcn_exp2f(l1 - mx), w2 = __builtin_amdgcn_exp2f(l2 - mx);
        const float inv = 1.f / (w0 + w1 + w2); w0 *= inv; w1 *= inv; w2 *= inv;
        const u32x4 a0 = *(const u32x4*)(og + (size_t)tok * D + c8 * 8), a1 = *(const u32x4*)(og + (size_t)SEQ * D + (size_t)tok * D + c8 * 8), a2 = *(const u32x4*)(og + (size_t)2 * SEQ * D + (size_t)tok * D + c8 * 8);
        u32x4 o;
        o.x = pk2(w0 * bf_lo(a0.x) + w1 * bf_lo(a1.x) + w2 * bf_lo(a2.x), w0 * bf_hi(a0.x) + w1 * bf_hi(a1.x) + w2 * bf_hi(a2.x));
        o.y = pk2(w0 * bf_lo(a0.y) + w1 * bf_lo(a1.y) + w2 * bf_lo(a2.y), w0 * bf_hi(a0.y) + w1 * bf_hi(a1.y) + w2 * bf_hi(a2.y));
        o.z = pk2(w0 * bf_lo(a0.z) + w1 * bf_lo(a1.z) + w2 * bf_lo(a2.z), w0 * bf_hi(a0.z) + w1 * bf_hi(a1.z) + w2 * bf_hi(a2.z));
        o.w = pk2(w0 * bf_lo(a0.w) + w1 * bf_lo(a1.w) + w2 * bf_lo(a2.w), w0 * bf_hi(a0.w) + w1 * bf_hi(a1.w) + w2 * bf_hi(a2.w));
        *(u32x4*)(outb + (size_t)tok * D + c8 * 8) = o;
    }
}

constexpr size_t MB_KMEAN = WS_ACTB, MB_SELW = WS_ACTB + 1 * MiB, MB_LIST = WS_ACTB + 4 * MiB;
constexpr size_t BIG_OSEL = 192 * MiB, BIG_LSESEL = 384 * MiB;
constexpr int CW_MBCNT = 32768, CW_MBCUR = 32768 + 2048;
constexpr int CW_NSAQ = 40960;
constexpr int MB_LISTCAP = 49152;
DI void moba_kmean_phase(const Args& a, LAS unsigned char* lds) {
    const int tid = tid_of(a.wv);
    const bf16_t* qkv = (const bf16_t*)(a.ws + WS_BIG);
    float* kmean = (float*)(a.ws + MB_KMEAN);
    LAS float* part = (LAS float*)lds;
    for (int u = blockIdx.x; u < 2048; u += gridDim.x) {
        const int n = u & 63, bh = u >> 6, b = bh >> 4, hh = bh & 15;
        const bf16_t* kp = qkv + ((size_t)b * SEQ + n * 256 + (tid >> 3)) * 3072 + 1024 + hh * 64 + (tid & 7) * 8;
        float s[8];
#pragma unroll
        for (int j = 0; j < 8; ++j) s[j] = 0.f;
#pragma unroll
        for (int i = 0; i < 4; ++i) { const u32x4 v = *(const u32x4*)(kp + (size_t)(64 * i) * 3072);
            s[0] += bf_lo(v.x); s[1] += bf_hi(v.x); s[2] += bf_lo(v.y); s[3] += bf_hi(v.y); s[4] += bf_lo(v.z); s[5] += bf_hi(v.z); s[6] += bf_lo(v.w); s[7] += bf_hi(v.w); }
        __syncthreads();
        *(LAS f32x4*)(part + (tid >> 3) * 64 + (tid & 7) * 8) = (f32x4){s[0], s[1], s[2], s[3]}; *(LAS f32x4*)(part + (tid >> 3) * 64 + (tid & 7) * 8 + 4) = (f32x4){s[4], s[5], s[6], s[7]};
        __syncthreads();
        if (tid < 64) { float acc = 0.f;
#pragma unroll 8
            for (int gq = 0; gq < 64; ++gq) acc += part[gq * 64 + tid];
            kmean[((size_t)bh * 64 + n) * 64 + tid] = acc * (1.f / 256.f); }
    }
}
DI void moba_gate_phase(const Args& a, LAS unsigned char* lds) {
    int tid = tid_of(a.wv); asm volatile("" : "+v"(tid));
    const int lane = tid & 63, wave = __builtin_amdgcn_readfirstlane(tid >> 6), c = lane & 31, h = lane >> 5;
    const bf16_t* qkv = (const bf16_t*)(a.ws + WS_BIG);
    const float* kmean = (const float*)(a.ws + MB_KMEAN);
    unsigned* selw = (unsigned*)(a.ws + MB_SELW);
    unsigned* cnt = (unsigned*)(a.ws + WS_CTL) + CW_MBCNT;
    LAS unsigned char* khi = lds; LAS unsigned char* klo = lds + KV_TILE_BYTES;
    LAS int* hist = (LAS int*)(lds + 2 * KV_TILE_BYTES);
    int cur_bh = -1;
    for (int u = blockIdx.x; u < 2048; u += gridDim.x) {
        const int bh = u & 31, qb = u >> 5, b = bh >> 4, hh = bh & 15;
        const int t = qb * 256 + 32 * wave + c;
        __syncthreads();
        if (bh != cur_bh) { cur_bh = bh;
          const int row = tid >> 3, c16 = tid & 7; const float* kp = kmean + ((size_t)bh * 64 + row) * 64 + c16 * 8;
          const f32x4 v0 = *(const f32x4*)kp, v1 = *(const f32x4*)(kp + 4);
          float v[8] = {v0.x, v0.y, v0.z, v0.w, v1.x, v1.y, v1.z, v1.w}; unsigned hi[8], lo[8];
#pragma unroll
          for (int j = 0; j < 8; ++j) { hi[j] = f2bf(v[j]); lo[j] = f2bf(v[j] - u2f(hi[j] << 16)); }
          u32x4 wh, wl; wh.x = hi[0] | (hi[1] << 16); wh.y = hi[2] | (hi[3] << 16); wh.z = hi[4] | (hi[5] << 16); wh.w = hi[6] | (hi[7] << 16);
          wl.x = lo[0] | (lo[1] << 16); wl.y = lo[2] | (lo[3] << 16); wl.z = lo[4] | (lo[5] << 16); wl.w = lo[6] | (lo[7] << 16);
          kv_store(khi, klo, wh, wl, tid); }
        if (tid < 64) hist[tid] = 0;
        __syncthreads();
        bf16x8 Q[4];
        { const bf16_t* qrow = qkv + ((size_t)b * SEQ + t) * 3072 + hh * 64;
#pragma unroll
          for (int ks = 0; ks < 4; ++ks) Q[ks] = *(const bf16x8*)(qrow + 16 * ks + 8 * h); }
        f32x16 Gs[2];
#pragma unroll
        for (int sub = 0; sub < 2; ++sub) { const f32x16 a0 = qk_tile(khi, sub, Q, lane), a1 = qk_tile(klo, sub, Q, lane);
#pragma unroll
            for (int i = 0; i < 16; ++i) { const int n = sub * 32 + 16 * (i >> 3) + 8 * h + (i & 7); Gs[sub][i] = (n < qb) ? (a0[i] + a1[i]) : -1e30f; } }
        unsigned selpack = 0;
#pragma unroll
        for (int pass = 0; pass < 3; ++pass) {
            float bv = -3e38f; int bn = 64;
#pragma unroll
            for (int sub = 0; sub < 2; ++sub)
#pragma unroll
                for (int i = 0; i < 16; ++i) { const int n = sub * 32 + 16 * (i >> 3) + 8 * h + (i & 7); const float v = Gs[sub][i];
                    if (v > bv || (v == bv && n < bn)) { bv = v; bn = n; } }
            const float pv = __shfl_xor(bv, 32); const int pn = __shfl_xor(bn, 32);
            if (pv > bv || (pv == bv && pn < bn)) { bv = pv; bn = pn; }
            const bool ok = bv > -1e29f;
            selpack |= (ok ? (unsigned)bn : 255u) << (8 * pass);
            if (ok && h == 0) atomicAdd((int*)(hist + bn), 1);
#pragma unroll
            for (int sub = 0; sub < 2; ++sub)
#pragma unroll
                for (int i = 0; i < 16; ++i) { const int n = sub * 32 + 16 * (i >> 3) + 8 * h + (i & 7); if (n == bn) Gs[sub][i] = -3e38f; }
        }
        if (h == 0) selw[(size_t)bh * SEQ + t] = selpack;
        __syncthreads();
        if (tid < 64 && hist[tid] > 0) xb_add(cnt + bh * 64 + tid, (unsigned)hist[tid]);
    }
}
DI void moba_fill_phase(const Args& a, LAS unsigned char* lds) {
    const int tid = tid_of(a.wv);
    const unsigned* selw = (const unsigned*)(a.ws + MB_SELW);
    unsigned* cnt = (unsigned*)(a.ws + WS_CTL) + CW_MBCNT; unsigned* cur = (unsigned*)(a.ws + WS_CTL) + CW_MBCUR;
    unsigned* list = (unsigned*)(a.ws + MB_LIST);
    LAS int* hist = (LAS int*)lds; LAS int* gb = hist + 64; LAS int* off = gb + 64;
    for (int u = blockIdx.x; u < 2048; u += gridDim.x) {
        const int bh = u & 31, qb = u >> 5;
        __syncthreads();
        if (tid < 64) hist[tid] = 0;
        if (tid >= 64 && tid < 128) { const int n = tid - 64; const int v = (int)xb_ld(cnt + bh * 64 + n); int inc = v;
#pragma unroll
            for (int o = 1; o < 64; o <<= 1) { const int tv = __shfl_up(inc, o); if (n >= o) inc += tv; }
            off[n] = inc - v; }
        __syncthreads();
        unsigned sp = 0xffffffffu; int lp[3] = {0, 0, 0};
        if (tid < 256) { sp = selw[(size_t)bh * SEQ + qb * 256 + tid];
#pragma unroll
            for (int k = 0; k < 3; ++k) { const unsigned n = (sp >> (8 * k)) & 255u; if (n < 64u) lp[k] = atomicAdd((int*)(hist + n), 1); } }
        __syncthreads();
        if (tid < 64 && hist[tid] > 0) gb[tid] = (int)xb_add(cur + bh * 64 + tid, (unsigned)hist[tid]);
        __syncthreads();
        if (tid < 256) {
#pragma unroll
            for (int k = 0; k < 3; ++k) { const unsigned n = (sp >> (8 * k)) & 255u;
                if (n < 64u) list[(size_t)bh * MB_LISTCAP + off[n] + gb[n] + lp[k]] = (unsigned)(qb * 256 + tid) | ((unsigned)k << 14); } }
    }
}
DI void moba_sel_phase(const Args& a, LAS unsigned char* lds) {
    int tid = tid_of(a.wv); asm volatile("" : "+v"(tid));
    const int lane = tid & 63, wave = __builtin_amdgcn_readfirstlane(tid >> 6), c = lane & 31, h = lane >> 5;
    const bf16_t* qkv = (const bf16_t*)(a.ws + WS_BIG);
    const unsigned* cnt = (const unsigned*)(a.ws + WS_CTL) + CW_MBCNT;
    const unsigned* list = (const unsigned*)(a.ws + MB_LIST);
    bf16_t* osel = (bf16_t*)(a.ws + WS_BIG + BIG_OSEL); float* lsesel = (float*)(a.ws + WS_BIG + BIG_LSESEL);
    const float* biasG = (const float*)(a.ws + WS_BIASG);
    LAS unsigned char* kbuf = lds; LAS unsigned char* vbuf = lds + 2 * KV_TILE_BYTES;
    LAS float* btab = (LAS float*)(lds + 4 * KV_TILE_BYTES);
    LAS int* cs = (LAS int*)(lds + 4 * KV_TILE_BYTES + BT_LEN * 4);
    LAS int* eo = cs + 2052;
    LAS int* part = eo + 2052;
    { int cc[4], ee[4], sc = 0, se = 0;
#pragma unroll
      for (int j = 0; j < 4; ++j) { const int v = (int)xb_ld((unsigned*)cnt + tid * 4 + j); ee[j] = se; cc[j] = sc; se += v; sc += (v + 255) >> 8; }
      part[tid] = sc; part[512 + tid] = se;
      __syncthreads();
      if (tid == 0) { int a0 = 0, a1 = 0; for (int i = 0; i < 512; ++i) { const int v0 = part[i], v1 = part[512 + i]; part[i] = a0; part[512 + i] = a1; a0 += v0; a1 += v1; } cs[2048] = a0; eo[2048] = a1; }
      __syncthreads();
#pragma unroll
      for (int j = 0; j < 4; ++j) { cs[tid * 4 + j] = part[tid] + cc[j]; eo[tid * 4 + j] = part[512 + tid] + ee[j]; }
      __syncthreads(); }
    const int NC = cs[2048];
    int cur_hh = -1;
    for (int u = blockIdx.x; u < NC; u += gridDim.x) {
        int lo = 0, hi = 2047;
        while (lo < hi) { const int mid = (lo + hi + 1) >> 1; if (cs[mid] <= u) lo = mid; else hi = mid - 1; }
        const int item = lo, bh = item >> 6, n = item & 63, b = bh >> 4, hh = bh & 15;
        const int chunk = u - cs[item], nent = (int)xb_ld((unsigned*)cnt + item) - chunk * 256;
        const size_t ebase = (size_t)bh * MB_LISTCAP + (eo[item] - eo[bh * 64]) + chunk * 256;
        __syncthreads();
        if (hh != cur_hh) { load_bias_table(btab, biasG, hh, 0, tid); cur_hh = hh; }
        const int e = 32 * wave + c; const bool ev = e < nent;
        const unsigned ent = list[ebase + (ev ? e : 0)];
        const int t = ent & 16383, slot = ent >> 14;
        bf16x8 Q[4];
        { const bf16_t* qrow = qkv + ((size_t)b * SEQ + t) * 3072 + hh * 64;
#pragma unroll
          for (int ks = 0; ks < 4; ++ks) Q[ks] = *(const bf16x8*)(qrow + 16 * ks + 8 * h); }
        const bf16_t* kb = qkv + (size_t)b * SEQ * 3072 + 1024 + hh * 64; const bf16_t* vb = kb + 1024;
        f32x16 O[2]; O[0] = zero16(); O[1] = zero16();
        float m = -1e30f, l = 0.f;
        u32x4 kr, vr; int buf = 0;
        kv_fetch(kr, vr, kb, vb, 3072, n * 256, SEQ, tid); kv_store(kbuf, vbuf, kr, vr, tid);
        __syncthreads();
        for (int j = 0; j < 4; ++j) {
            if (j < 3) kv_fetch(kr, vr, kb, vb, 3072, n * 256 + 64 * (j + 1), SEQ, tid);
            const int k0 = n * 256 + 64 * j;
            if (32 * wave < nent) {
                const LAS unsigned char* kl = kbuf + buf * KV_TILE_BYTES; const LAS unsigned char* vl = vbuf + buf * KV_TILE_BYTES;
                f32x16 S[2]; S[0] = qk_tile(kl, 0, Q, lane); S[1] = qk_tile(kl, 1, Q, lane);
                softmax_tile<1, false>(S, m, l, O, btab, t - k0, h, 0, (unsigned)DIST_ANY);
                pv_tile(vl, 0, S[0], O, lane); pv_tile(vl, 1, S[1], O, lane);
            }
            if (j < 3) kv_store(kbuf + (buf ^ 1) * KV_TILE_BYTES, vbuf + (buf ^ 1) * KV_TILE_BYTES, kr, vr, tid);
            __syncthreads();
            buf ^= 1;
        }
        if (ev) { const size_t ob = ((size_t)bh * SEQ + t) * 3 + slot;
            store_o(osel + ob * 64, O, 1.f / l, h);
            if (h == 0) lsesel[ob] = m + __builtin_amdgcn_logf(l); }
    }
}
DI void moba_own_phase(const Args& a, LAS unsigned char* lds) {
    int tid = tid_of(a.wv); asm volatile("" : "+v"(tid));
    const int lane = tid & 63, wave = __builtin_amdgcn_readfirstlane(tid >> 6), c = lane & 31, h = lane >> 5;
    const bf16_t* qkv = (const bf16_t*)(a.ws + WS_BIG);
    const bf16_t* osel = (const bf16_t*)(a.ws + WS_BIG + BIG_OSEL); const float* lsesel = (const float*)(a.ws + WS_BIG + BIG_LSESEL);
    bf16_t* outb = (bf16_t*)(a.ws + WS_ACTB);
    const float* biasG = (const float*)(a.ws + WS_BIASG);
    LAS unsigned char* kbuf = lds; LAS unsigned char* vbuf = lds + 2 * KV_TILE_BYTES;
    LAS float* btab = (LAS float*)(lds + 4 * KV_TILE_BYTES);
    int cur_hh = -1;
    for (int u = blockIdx.x; u < 2048; u += gridDim.x) {
        const int bh = u & 31, qb = u >> 5, b = bh >> 4, hh = bh & 15;
        const int q0w = qb * 256 + 32 * wave, t = q0w + c;
        __syncthreads();
        if (hh != cur_hh) { load_bias_table(btab, biasG, hh, 0, tid); cur_hh = hh; }
        bf16x8 Q[4];
        { const bf16_t* qrow = qkv + ((size_t)b * SEQ + t) * 3072 + hh * 64;
#pragma unroll
          for (int ks = 0; ks < 4; ++ks) Q[ks] = *(const bf16x8*)(qrow + 16 * ks + 8 * h); }
        const bf16_t* kb = qkv + (size_t)b * SEQ * 3072 + 1024 + hh * 64; const bf16_t* vb = kb + 1024;
        f32x16 O[2]; O[0] = zero16(); O[1] = zero16();
        float m = -1e30f, l = 0.f;
        u32x4 kr, vr; int buf = 0;
        kv_fetch(kr, vr, kb, vb, 3072, qb * 256, SEQ, tid); kv_store(kbuf, vbuf, kr, vr, tid);
        __syncthreads();
        for (int j = 0; j < 4; ++j) {
            if (j < 3) kv_fetch(kr, vr, kb, vb, 3072, qb * 256 + 64 * (j + 1), SEQ, tid);
            const int k0 = qb * 256 + 64 * j;
            if (k0 <= q0w + 31) {
                const LAS unsigned char* kl = kbuf + buf * KV_TILE_BYTES; const LAS unsigned char* vl = vbuf + buf * KV_TILE_BYTES;
                f32x16 S[2]; S[0] = qk_tile(kl, 0, Q, lane); S[1] = qk_tile(kl, 1, Q, lane);
                softmax_tile<1, false>(S, m, l, O, btab, t - k0, h, 0, (unsigned)DIST_ANY);
                pv_tile(vl, 0, S[0], O, lane); pv_tile(vl, 1, S[1], O, lane);
            }
            if (j < 3) kv_store(kbuf + (buf ^ 1) * KV_TILE_BYTES, vbuf + (buf ^ 1) * KV_TILE_BYTES, kr, vr, tid);
            __syncthreads();
            buf ^= 1;
        }
        const int nv = qb < 3 ? qb : 3;
        const float lown = m + __builtin_amdgcn_logf(l);
        float ls[3]; float mx = lown;
        const size_t ob = ((size_t)bh * SEQ + t) * 3;
#pragma unroll
        for (int k = 0; k < 3; ++k) { ls[k] = (k < nv) ? lsesel[ob + k] : -1e30f; mx = fmaxf(mx, ls[k]); }
        float wown = __builtin_amdgcn_exp2f(lown - mx), wsum = wown, wk[3];
#pragma unroll
        for (int k = 0; k < 3; ++k) { wk[k] = (k < nv) ? __builtin_amdgcn_exp2f(ls[k] - mx) : 0.f; wsum += wk[k]; }
        const float inv = 1.f / wsum; wown *= inv / l;
#pragma unroll
        for (int dt = 0; dt < 2; ++dt)
#pragma unroll
            for (int i = 0; i < 16; ++i) O[dt][i] *= wown;
#pragma unroll
        for (int k = 0; k < 3; ++k) if (k < nv) { const float w = wk[k] * inv; const bf16_t* orow = osel + (ob + k) * 64;
#pragma unroll
            for (int dt = 0; dt < 2; ++dt)
#pragma unroll
                for (int g = 0; g < 4; ++g) { const u32x2 v = *(const u32x2*)(orow + dt * 32 + 8 * g + 4 * h);
                    O[dt][4 * g] += w * bf_lo(v.x); O[dt][4 * g + 1] += w * bf_hi(v.x); O[dt][4 * g + 2] += w * bf_lo(v.y); O[dt][4 * g + 3] += w * bf_hi(v.y); } }
        store_o(outb + ((size_t)b * SEQ + t) * D + hh * 64, O, 1.f, h);
    }
}

constexpr size_t NS_Q = 0, NS_KV = 64 * MiB, NS_GT = 164 * MiB, NS_HID = 172 * MiB, NS_KC = 180 * MiB, NS_KFR = 182 * MiB, NS_VFR = 198 * MiB;
DI void nsa_kcvc_phase(const Args& a, LAS unsigned char* lds) {
    int tid = tid_of(a.wv); asm volatile("" : "+v"(tid));
    {
        const bf16_t* kv6 = (const bf16_t*)(a.ws + WS_BIG + NS_KV); u32x4* kfr = (u32x4*)(a.ws + WS_BIG + NS_KFR); u32x4* vfr = (u32x4*)(a.ws + WS_BIG + NS_VFR);
        for (int tl = blockIdx.x; tl < 2048; tl += gridDim.x) {
            const int bg = tl >> 8, t0 = (tl & 255) * 64, b = bg >> 2, g = bg & 3;
            __syncthreads();
            { const int row = tid >> 3, c16 = tid & 7; const bf16_t* src_ = kv6 + ((size_t)b * SEQ + t0 + row) * 1536 + 2 * 256 + g * 64 + c16 * 8;
              *(LAS u32x4*)(lds + row * KSTR + c16 * 16) = *(const u32x4*)src_; *(LAS u32x4*)(lds + KV_TILE_BYTES + row * KSTR + c16 * 16) = *(const u32x4*)(src_ + 256); }
            __syncthreads();
            { const int f = tid >> 6, ln = tid & 63, r31 = ln & 31, hh = ln >> 5;
              { const int kt = f >> 2, ks = f & 3, pr = (r31 & ~12) | ((r31 & 4) << 1) | ((r31 & 8) >> 1);
                kfr[((size_t)tl * 8 + f) * 64 + ln] = *(const LAS u32x4*)(lds + (kt * 32 + pr) * KSTR + (16 * ks + 8 * hh) * 2); }
              { const int kt = f >> 2, s = (f >> 1) & 1, dt = f & 1; unsigned v[8];
#pragma unroll
                for (int i = 0; i < 8; ++i) v[i] = *(const LAS unsigned short*)(lds + KV_TILE_BYTES + (kt * 32 + 16 * s + 8 * hh + i) * KSTR + (dt * 32 + r31) * 2);
                u32x4 w; w.x = v[0] | (v[1] << 16); w.y = v[2] | (v[3] << 16); w.z = v[4] | (v[5] << 16); w.w = v[6] | (v[7] << 16);
                vfr[((size_t)tl * 8 + f) * 64 + ln] = w; } }
        }
    }
    const int lane = tid & 63, wave = __builtin_amdgcn_readfirstlane(tid >> 6), c = lane & 31, h = lane >> 5;
    const bf16_t* hidden = (const bf16_t*)(a.ws + WS_BIG + NS_HID); const bf16_t* w2t = (const bf16_t*)(a.ws + WS_WCMP) + 2 * 256 * 2048;
    bf16_t* kcvc = (bf16_t*)(a.ws + WS_BIG + NS_KC);
    for (int task = blockIdx.x * NWAVES + wave; task < 512; task += gridDim.x * NWAVES) {
        const int j = task >> 8, R0 = (task & 255) * 32;
        const bf16_t* hid = hidden + ((size_t)j * 8192 + R0 + c) * 256; const bf16_t* w2 = w2t + j * 64 * 256;
        f32x16 acc[2]; acc[0] = zero16(); acc[1] = zero16();
#pragma unroll
        for (int ks = 0; ks < 16; ++ks) { const bf16x8 Bv = *(const bf16x8*)(hid + 16 * ks + 8 * h);
#pragma unroll
            for (int dt = 0; dt < 2; ++dt) { const bf16x8 Av = *(const bf16x8*)(w2 + (dt * 32 + c) * 256 + 16 * ks + 8 * h); acc[dt] = mfma32(Av, Bv, acc[dt]); } }
        store_o(kcvc + ((size_t)j * 8192 + R0 + c) * 64, acc, 1.f, h);
    }
}
DI void nsa_attn_phase(const Args& a, LAS unsigned char* lds) {
    const int wave = a.wv;
#define NSA_VARS int tid = tid_of(a.wv); const int lane = tid & 63, c = lane & 31, h = lane >> 5, qi = c >> 2, r = c & 3, t = tw0 + qi; \
    const LAS float* bt = btab + r * (BT_LEN + 8); const float* gtp = gates + (tokbase + t) * 48 + 4 * g + r; (void)bt; (void)h; (void)lane; (void)gtp;
    const bf16_t* qb_ = (const bf16_t*)(a.ws + WS_BIG + NS_Q); const bf16_t* kv6 = (const bf16_t*)(a.ws + WS_BIG + NS_KV);
    const float* gates = (const float*)(a.ws + WS_BIG + NS_GT); const bf16_t* kcvc = (const bf16_t*)(a.ws + WS_BIG + NS_KC);
    bf16_t* outb = (bf16_t*)(a.ws + WS_ACTB); const float* biasG = (const float*)(a.ws + WS_BIASG);
    LAS unsigned char* ring = lds;
    LAS float* imp = (LAS float*)(lds + 49152);
    LAS float* btab = (LAS float*)(lds + 116736);
    LAS unsigned* selm = (LAS unsigned*)(lds + 151808);
    LAS unsigned* wm = selm + 512;
    LAS int* blist = (LAS int*)(wm + 64);
    LAS int* Oacc = (LAS int*)imp;
    constexpr int OAS = 66;
    LAS int* lacc = (LAS int*)(lds + 155392);
    constexpr float FXS = 16384.f;
    LAS float* mref = (LAS float*)(lds + 156416);
    LAS unsigned long long* qmask = (LAS unsigned long long*)(lds + 157440);
    LAS int* qsel = (LAS int*)(lds + 159488);
    const bf16x8* kfr = (const bf16x8*)(a.ws + WS_BIG + NS_KFR); const bf16x8* vfr = (const bf16x8*)(a.ws + WS_BIG + NS_VFR);
    int cur_g = -1;
    unsigned* nsa_ctr = (unsigned*)(a.ws + WS_CTL) + CW_NSAQ;
    volatile LAS int* uword = (volatile LAS int*)(lds + MISC_OFF + 160);
    for (;;) {
        const int bg = blockIdx.x & 7;
        __syncthreads();
        if (tid_of(a.wv) == 0) *uword = (int)xb_add(nsa_ctr + bg * 64, 1u);
        __syncthreads();
        const int uidx = *uword; if (uidx >= 256) break;
        const int tile = 255 - uidx, b = bg >> 2, g = bg & 3;
        const int T0 = tile * 64, tw0 = T0 + 8 * wave;
        const size_t tokbase = (size_t)b * SEQ;
        __syncthreads();
        bf16x8 Q[4];
        { NSA_VARS
          if (g != cur_g) { for (int rr = 0; rr < 4; ++rr) load_bias_table(btab + rr * (BT_LEN + 8), biasG, 4 * g + rr, 0, tid); cur_g = g; }
          for (int i = tid; i < 64 * 260; i += NTHR) imp[i] = 0.f;
          const bf16_t* qrow = qb_ + (tokbase + t) * 1024 + (4 * g + r) * 64;
#pragma unroll
          for (int ks = 0; ks < 4; ++ks) Q[ks] = *(const bf16x8*)(qrow + 16 * ks + 8 * h); }
        f32x16 OUT[2]; OUT[0] = zero16(); OUT[1] = zero16();
        const int nct = (T0 + 63 >= 31) ? (((T0 + 32) >> 4) >> 6) + 1 : 0;
        const int j0w = (T0 >= 511) ? ((T0 - 511) >> 6) : 0, nwin = tile - j0w + 1, nd = tile >= 2 ? 3 : tile + 1;
        const int e1 = nct, e2 = 2 * nct, e3 = e2 + nwin, e4 = e3 + nd;
        const bf16_t* kcb = kcvc + (size_t)bg * 1024 * 64; const bf16_t* vcb = kcb + (size_t)8192 * 64;
        const bf16_t* kvb = kv6 + tokbase * 1536 + g * 64;
        f32x16 O[2]; O[0] = zero16(); O[1] = zero16();
        float m = -1e30f, l = 0.f, mc = -1e30f, lc = 0.f, invl = 0.f, mfin = 0.f;
        __syncthreads();
        kv_dma_stream<3>(e4, [&](int fi, LAS unsigned char* slot) {
                const int lane = tid_of(a.wv) & 63;
                if (fi < e2) kv_dma_issue(slot, kcb, vcb, 64, 64 * (fi < e1 ? fi : fi - e1), 1024, wave, lane);
                else if (fi < e3) kv_dma_issue(slot, kvb + 4 * 256, kvb + 5 * 256, 1536, (j0w + fi - e2) * 64, SEQ, wave, lane);
                else { const int i = fi - e3, blk = (i == 0) ? 0 : (tile >= 2 ? tile - 2 + i : i); kv_dma_issue(slot, kvb + 2 * 256, kvb + 3 * 256, 1536, blk * 64, SEQ, wave, lane); }
            }, [&](int fi, const LAS unsigned char* kl, const LAS unsigned char* vl) {
                NSA_VARS
                if (fi < e1) {
                    const int c0 = 64 * fi;
                    if (16 * c0 + 31 <= tw0 + 7) {
                        f32x16 S[2]; S[0] = qk_tile_sw(kl, 0, Q, lane); S[1] = qk_tile_sw(kl, 1, Q, lane);
                        stats_tile<16, false>(S, mc, lc, bt, t - 16 * c0 - 31, h, 0, (unsigned)DIST_ANY);
                    }
                } else if (fi < e2) {
                    if (fi == e1) { invl = lc > 0.f ? 1.f / lc : 0.f; mfin = (mc <= -1e30f) ? 0.f : mc; }
                    const int c0 = 64 * (fi - e1);
                    if (16 * c0 + 31 <= tw0 + 7) {
                        f32x16 S[2]; S[0] = qk_tile_sw(kl, 0, Q, lane); S[1] = qk_tile_sw(kl, 1, Q, lane);
                        (void)logits_tile<16, false>(S, bt, t - 16 * c0 - 31, h, 0, (unsigned)DIST_ANY);
#pragma unroll
                        for (int sub = 0; sub < 2; ++sub)
#pragma unroll
                            for (int i = 0; i < 16; ++i) S[sub][i] = __builtin_amdgcn_exp2f(S[sub][i] - mfin) * invl;
#pragma unroll
                        for (int sub = 0; sub < 2; ++sub)
#pragma unroll
                            for (int s = 0; s < 2; ++s) { const int j0 = (c0 + sub * 32 + 16 * s + 8 * h) >> 2;
                                float a0 = (S[sub][8 * s] + S[sub][8 * s + 1]) + (S[sub][8 * s + 2] + S[sub][8 * s + 3]);
                                float a1 = (S[sub][8 * s + 4] + S[sub][8 * s + 5]) + (S[sub][8 * s + 6] + S[sub][8 * s + 7]) + S[sub][8 * s + 3];
                                float a2 = S[sub][8 * s + 7];
                                a0 += quad_xor1(a0); a1 += quad_xor1(a1); a2 += quad_xor1(a2);
                                a0 += quad_xor2(a0); a1 += quad_xor2(a1); a2 += quad_xor2(a2);
                                if (r == 0) { LAS float* ip = imp + (8 * wave + qi) * 260 + j0; atomicAdd((float*)ip, a0); atomicAdd((float*)(ip + 1), a1); atomicAdd((float*)(ip + 2), a2); } }
                        pv_tile_sw(vl, 0, S[0], O, lane); pv_tile_sw(vl, 1, S[1], O, lane);
                    }
                    if (fi == e2 - 1) { const float gt_cmp = gtp[0];
#pragma unroll
                        for (int dt = 0; dt < 2; ++dt)
#pragma unroll
                            for (int i = 0; i < 16; ++i) { OUT[dt][i] += gt_cmp * O[dt][i]; O[dt][i] = 0.f; } }
                } else if (fi < e3) {
                    const int k0 = (j0w + fi - e2) * 64;
                    if (k0 <= tw0 + 7 && k0 + 63 >= tw0 - 511) {
                        f32x16 S[2]; S[0] = qk_tile_sw(kl, 0, Q, lane); S[1] = qk_tile_sw(kl, 1, Q, lane);
                        if (k0 >= tw0 + 7 - 511) softmax_tile<1, false>(S, m, l, O, bt, t - k0, h, 0, 511u);
                        else softmax_tile<1, true>(S, m, l, O, bt, t - k0, h, 0, 511u);
                        pv_tile_sw(vl, 0, S[0], O, lane); pv_tile_sw(vl, 1, S[1], O, lane);
                    }
                    if (fi == e3 - 1) { const float sc_ = gtp[32] / l;
#pragma unroll
                        for (int dt = 0; dt < 2; ++dt)
#pragma unroll
                            for (int i = 0; i < 16; ++i) { OUT[dt][i] += sc_ * O[dt][i]; O[dt][i] = 0.f; }
                        m = -1e30f; l = 0.f; }
                } else {
                    const int i = fi - e3, blk = (i == 0) ? 0 : (tile >= 2 ? tile - 2 + i : i), k0 = blk * 64;
                    f32x16 S[2]; S[0] = qk_tile_sw(kl, 0, Q, lane); S[1] = qk_tile_sw(kl, 1, Q, lane);
                    softmax_tile<1, false>(S, m, l, O, bt, t - k0, h, 0, (unsigned)DIST_ANY);
                    pv_tile_sw(vl, 0, S[0], O, lane); pv_tile_sw(vl, 1, S[1], O, lane);
                }
            }, ring);
        __syncthreads();
#pragma unroll 1
        for (int qh = 0; qh < 2; ++qh) {
            const int lane = tid_of(a.wv) & 63;
            const int cur = tile;
            unsigned key[4][4];
#pragma unroll
            for (int q4 = 0; q4 < 4; ++q4) { const int ql = 8 * wave + 4 * qh + q4;
#pragma unroll
                for (int kk = 0; kk < 4; ++kk) { const int j = lane + 64 * kk; const bool forced = (j == 0) || (j == cur) || (j + 1 == cur);
                    key[q4][kk] = forced ? 0xffffffffu : ((j <= cur) ? f2u(imp[ql * 260 + j]) + 1u : 0u); } }
            unsigned prefix[4] = {0u, 0u, 0u, 0u};
#pragma unroll 1
            for (int bit = 31; bit >= 0; --bit) {
#pragma unroll
                for (int q4 = 0; q4 < 4; ++q4) { const unsigned cand = prefix[q4] | (1u << bit); int cnt = 0;
#pragma unroll
                    for (int kk = 0; kk < 4; ++kk) cnt += __popcll(__ballot(key[q4][kk] >= cand));
                    if (cnt >= 16) prefix[q4] = cand; } }
            const unsigned long long ltmask = (1ull << lane) - 1ull;
#pragma unroll
            for (int q4 = 0; q4 < 4; ++q4) { const int ql = 8 * wave + 4 * qh + q4; const unsigned pf = prefix[q4];
                int cgt = 0;
#pragma unroll
                for (int kk = 0; kk < 4; ++kk) cgt += __popcll(__ballot(key[q4][kk] > pf));
                const int need = 16 - cgt; int running = 0;
#pragma unroll
                for (int kk = 0; kk < 4; ++kk) { const unsigned long long eqb = __ballot(key[q4][kk] == pf);
                    const bool take = key[q4][kk] > pf || (pf != 0u && key[q4][kk] == pf && running + __popcll(eqb & ltmask) < need);
                    running += __popcll(eqb);
                    const unsigned long long bal = __ballot(take);
                    if (lane == 0) { selm[ql * 8 + 2 * kk] = (unsigned)bal; selm[ql * 8 + 2 * kk + 1] = (unsigned)(bal >> 32); } } }
        }
        __syncthreads();
        { const int tid = tid_of(a.wv);
          if (tid < 8) { unsigned o = 0u;
              if (tid == 0) o |= 1u;
              if ((tile >> 5) == tid) o |= 1u << (tile & 31);
              if (tile >= 1 && ((tile - 1) >> 5) == tid) o |= 1u << ((tile - 1) & 31);
              wm[tid] = o; } }
        __syncthreads();
        { const int lane = tid_of(a.wv) & 63;
#pragma unroll 1
          for (int jj = 0; jj < 32; ++jj) { const int j = wave * 32 + jj; const unsigned w = selm[lane * 8 + (j >> 5)] & ~wm[j >> 5];
              const unsigned long long bal = __ballot((w >> (j & 31)) & 1u); if (lane == 0) qmask[j] = bal; } }
        {
            NSA_VARS
            LAS int* oa = Oacc + ((8 * wave + qi) * 4 + r) * OAS;
#pragma unroll
            for (int dt = 0; dt < 2; ++dt)
#pragma unroll
                for (int g4 = 0; g4 < 4; ++g4) { u32x2 w0, w1; w0.x = (unsigned)(int)(O[dt][4 * g4] * FXS); w0.y = (unsigned)(int)(O[dt][4 * g4 + 1] * FXS); w1.x = (unsigned)(int)(O[dt][4 * g4 + 2] * FXS); w1.y = (unsigned)(int)(O[dt][4 * g4 + 3] * FXS);
                    *(LAS u32x2*)(oa + dt * 32 + 8 * g4 + 4 * h) = w0; *(LAS u32x2*)(oa + dt * 32 + 8 * g4 + 4 * h + 2) = w1; }
            if (h == 0) { lacc[(8 * wave + qi) * 4 + r] = (int)(l * FXS); mref[(8 * wave + qi) * 4 + r] = m; }
        }
        __syncthreads();
        {
            NSA_VARS
            LAS int* qs = qsel + wave * 8;
            const unsigned long long ltm = (1ull << lane) - 1ull;
            int j = wave; unsigned long long qm = 0ull;
            while (j <= tile) { qm = qmask[j]; if (qm != 0ull) break; j += 8; }
            if (j <= tile) {
                int n = __popcll(qm), ch = 0;
                if ((qm >> lane) & 1ull) { const int rk = __popcll(qm & ltm); if (rk < 8) qs[rk] = lane; }
                bool lv = qi < n; int ql = qs[lv ? qi : 0];
                bf16x8 KA[2][4], VA[2][2][2], Qs[4];
                { const bf16x8* kp = kfr + ((size_t)(bg * 256 + j) * 8) * 64 + lane; const bf16x8* vp = vfr + ((size_t)(bg * 256 + j) * 8) * 64 + lane;
                  const bf16_t* qrow = qb_ + (tokbase + T0 + ql) * 1024 + (4 * g + r) * 64;
#pragma unroll
                  for (int ks = 0; ks < 4; ++ks) Qs[ks] = *(const bf16x8*)(qrow + 16 * ks + 8 * h);
#pragma unroll
                  for (int f8 = 0; f8 < 8; ++f8) KA[f8 >> 2][f8 & 3] = kp[f8 * 64];
#pragma unroll
                  for (int f8 = 0; f8 < 8; ++f8) VA[f8 >> 2][(f8 >> 1) & 1][f8 & 1] = vp[f8 * 64]; }
#pragma unroll 1
                for (;;) {
                    int jn = j, chn = ch + 1, nn = n; unsigned long long qmn = qm;
                    if (chn * 8 >= n) { chn = 0; jn = j + 8; qmn = 0ull; while (jn <= tile) { qmn = qmask[jn]; if (qmn != 0ull) break; jn += 8; } nn = __popcll(qmn); }
                    const bool has_next = jn <= tile, newblk = jn != j;
                    f32x16 S[2];
#pragma unroll
                    for (int kt = 0; kt < 2; ++kt) { S[kt] = zero16();
#pragma unroll
                        for (int ks = 0; ks < 4; ++ks) S[kt] = mfma32(KA[kt][ks], Qs[ks], S[kt]); }
                    const int tq = T0 + ql, D0 = tq - j * 64;
                    const float mr = mref[ql * 4 + r];
                    LAS int* oa = Oacc + (ql * 4 + r) * OAS + 4 * h; LAS int* la = lacc + ql * 4 + r;
                    const bool lvc = lv;
                    if (has_next) {
                        if ((qmn >> lane) & 1ull) { const int rk = __popcll(qmn & ltm) - 8 * chn; if (rk >= 0 && rk < 8) qs[rk] = lane; }
                        lv = qi < nn - 8 * chn; ql = qs[lv ? qi : 0];
                        const bf16_t* qrow = qb_ + (tokbase + T0 + ql) * 1024 + (4 * g + r) * 64;
#pragma unroll
                        for (int ks = 0; ks < 4; ++ks) Qs[ks] = *(const bf16x8*)(qrow + 16 * ks + 8 * h);
                        if (newblk) { const bf16x8* kp = kfr + ((size_t)(bg * 256 + jn) * 8) * 64 + lane;
#pragma unroll
                            for (int f8 = 0; f8 < 8; ++f8) KA[f8 >> 2][f8 & 3] = kp[f8 * 64]; }
                    }
                    (void)logits_tile<1, false>(S, bt, D0, h, 0, (unsigned)DIST_ANY);
                    float ls = 0.f;
#pragma unroll
                    for (int kt = 0; kt < 2; ++kt)
#pragma unroll
                        for (int i = 0; i < 16; ++i) { const float p = lvc ? __builtin_amdgcn_exp2f(S[kt][i] - mr) : 0.f; S[kt][i] = p; ls += p; }
                    ls += xor32h(ls, h);
                    f32x16 Oa[2]; Oa[0] = zero16(); Oa[1] = zero16();
#pragma unroll
                    for (int kt = 0; kt < 2; ++kt)
#pragma unroll
                        for (int s = 0; s < 2; ++s) {
                            u32x4 pk; pk.x = cvt_pk_bf16(S[kt][8 * s + 0], S[kt][8 * s + 1]); pk.y = cvt_pk_bf16(S[kt][8 * s + 2], S[kt][8 * s + 3]); pk.z = cvt_pk_bf16(S[kt][8 * s + 4], S[kt][8 * s + 5]); pk.w = cvt_pk_bf16(S[kt][8 * s + 6], S[kt][8 * s + 7]);
                            const bf16x8 Bp = __builtin_bit_cast(bf16x8, pk);
                            Oa[0] = mfma32(VA[kt][s][0], Bp, Oa[0]); Oa[1] = mfma32(VA[kt][s][1], Bp, Oa[1]); }
                    if (has_next && newblk) { const bf16x8* vp = vfr + ((size_t)(bg * 256 + jn) * 8) * 64 + lane;
#pragma unroll
                        for (int f8 = 0; f8 < 8; ++f8) VA[f8 >> 2][(f8 >> 1) & 1][f8 & 1] = vp[f8 * 64]; }
                    if (lvc) {
#pragma unroll
                        for (int dt = 0; dt < 2; ++dt)
#pragma unroll
                            for (int i = 0; i < 16; ++i) atomicAdd((int*)(oa + dt * 32 + (i & 3) + 8 * (i >> 2)), (int)(Oa[dt][i] * FXS));
                        if (h == 0) atomicAdd((int*)la, (int)(ls * FXS)); }
                    if (!has_next) break;
                    j = jn; ch = chn; qm = qmn; n = nn;
                }
            }
        }
        __syncthreads();
        {
            NSA_VARS
            const float gt_sel = gtp[16];
            const LAS int* oa = Oacc + ((8 * wave + qi) * 4 + r) * OAS;
            const float sc_ = gt_sel / (float)lacc[(8 * wave + qi) * 4 + r];
#pragma unroll
            for (int dt = 0; dt < 2; ++dt)
#pragma unroll
                for (int g4 = 0; g4 < 4; ++g4) { const u32x2 v0 = *(const LAS u32x2*)(oa + dt * 32 + 8 * g4 + 4 * h), v1 = *(const LAS u32x2*)(oa + dt * 32 + 8 * g4 + 4 * h + 2);
                    OUT[dt][4 * g4] += sc_ * (float)(int)v0.x; OUT[dt][4 * g4 + 1] += sc_ * (float)(int)v0.y; OUT[dt][4 * g4 + 2] += sc_ * (float)(int)v1.x; OUT[dt][4 * g4 + 3] += sc_ * (float)(int)v1.y; }
        }
        { NSA_VARS
          store_o(outb + (tokbase + t) * D + (4 * g + r) * 64, OUT, 1.f, h); }
    }
#undef NSA_VARS
}

DI void sb_phase(const Args& a, LAS unsigned char* lds) {
    int tid = tid_of(a.wv); asm volatile("" : "+v"(tid));
    const int lane = tid & 63, wave = __builtin_amdgcn_readfirstlane(tid >> 6), c = lane & 31, h = lane >> 5;
    const bf16_t* qkv = (const bf16_t*)(a.ws + WS_BIG);
    bf16_t* outb = (bf16_t*)(a.ws + WS_ACTB);
    LAS unsigned char* kbuf = lds; LAS unsigned char* vbuf = lds + 2 * KV_TILE_BYTES;
    volatile LAS int* flags = (volatile LAS int*)(lds + 4 * KV_TILE_BYTES);
    for (int u = blockIdx.x; u < 2048; u += gridDim.x) {
        const int qb = u & 63, hh = (u >> 6) & 15, b = u >> 10;
        const int q0w = qb * 256 + 32 * wave, t = q0w + c;
        const size_t tokbase = (size_t)b * SEQ;
        const bf16_t* kb = qkv + tokbase * 3072 + 1024 + hh * 64;
        const bf16_t* vb = qkv + tokbase * 3072 + 2048 + hh * 64;
        bf16x8 Q[4];
        { const bf16_t* qrow = qkv + (tokbase + t) * 3072 + hh * 64;
#pragma unroll
          for (int ks = 0; ks < 4; ++ks) Q[ks] = *(const bf16x8*)(qrow + 16 * ks + 8 * h); }
        f32x16 O[2]; O[0] = zero16(); O[1] = zero16();
        float carry = 1.f; bool wdone = false;
        int jt = qb * 4 + 3, buf = 0;
        u32x4 kr, vr;
        kv_fetch(kr, vr, kb, vb, 3072, jt * 64, SEQ, tid); kv_store(kbuf, vbuf, kr, vr, tid);
        __syncthreads();
        for (; jt >= 0; --jt) {
            if (jt > 0) kv_fetch(kr, vr, kb, vb, 3072, (jt - 1) * 64, SEQ, tid);
            const int kb0 = jt * 64;
            if (!wdone && kb0 < q0w + 31) {
                const LAS unsigned char* kl = kbuf + buf * KV_TILE_BYTES; const LAS unsigned char* vl = vbuf + buf * KV_TILE_BYTES;
                f32x16 SP[2], U[2];
                SP[0] = qk_tile(kl, 0, Q, lane); SP[1] = qk_tile(kl, 1, Q, lane);
                float Tc[2][2];
#pragma unroll
                for (int sub = 0; sub < 2; ++sub)
#pragma unroll
                    for (int s = 0; s < 2; ++s) { float acc = 1.f;
#pragma unroll
                        for (int j = 0; j < 8; ++j) { const int i = 8 * s + j; const int key = kb0 + sub * 32 + 16 * s + 8 * h + j;
                            const float z = __builtin_amdgcn_fmed3f(SP[sub][i] * 0.125f, -60.f, 60.f);
                            const float e = __builtin_amdgcn_exp2f(z * LOG2E);
                            const float u = __builtin_amdgcn_rcpf(1.f + e);
                            const bool valid = key < t;
                            SP[sub][i] = valid ? e * u : 0.f; U[sub][i] = valid ? u : 1.f; acc *= U[sub][i]; }
                        Tc[sub][s] = acc; }
                float Tp[2][2], pr[2][2];
#pragma unroll
                for (int sub = 0; sub < 2; ++sub)
#pragma unroll
                    for (int s = 0; s < 2; ++s) { Tp[sub][s] = xor32h(Tc[sub][s], h); pr[sub][s] = Tc[sub][s] * Tp[sub][s]; }
                float offp[2][2];
                offp[1][1] = carry; offp[1][0] = offp[1][1] * pr[1][1]; offp[0][1] = offp[1][0] * pr[1][0]; offp[0][0] = offp[0][1] * pr[0][1];
                carry = offp[0][0] * pr[0][0];
#pragma unroll
                for (int sub = 0; sub < 2; ++sub)
#pragma unroll
                    for (int s = 0; s < 2; ++s) { float run = offp[sub][s] * (h == 0 ? Tp[sub][s] : 1.f);
#pragma unroll
                        for (int j = 7; j >= 0; --j) { const int i = 8 * s + j; SP[sub][i] *= run; run *= U[sub][i]; } }
                pv_tile(vl, 0, SP[0], O, lane); pv_tile(vl, 1, SP[1], O, lane);
                wdone = __all(carry < 1e-38f);
            }
            if (lane == 0) flags[buf * 8 + wave] = wdone ? 1 : 0;
            if (jt > 0) kv_store(kbuf + (buf ^ 1) * KV_TILE_BYTES, vbuf + (buf ^ 1) * KV_TILE_BYTES, kr, vr, tid);
            __syncthreads();
            int alld = 1;
#pragma unroll
            for (int w = 0; w < 8; ++w) alld &= flags[buf * 8 + w];
            buf ^= 1;
            if (alld) break;
        }
        store_o(outb + (tokbase + t) * D + hh * 64, O, 1.f, h);
        __syncthreads();
    }
}

#ifndef DBG
#define DBG 0
#endif
#if DBG
DI float dbg_block_max(float v, LAS float* red) {
#pragma unroll
    for (int o = 1; o < 64; o <<= 1) v = fmaxf(v, __shfl_xor(v, o));
    __syncthreads();
    if ((threadIdx.x & 63) == 0) red[threadIdx.x >> 6] = v;
    __syncthreads();
    float r = red[0];
    for (int i = 1; i < 8; ++i) r = fmaxf(r, red[i]);
    __syncthreads();
    return r;
}
DI float dbg_block_sum(float v, LAS float* red) {
#pragma unroll
    for (int o = 1; o < 64; o <<= 1) v += __shfl_xor(v, o);
    __syncthreads();
    if ((threadIdx.x & 63) == 0) red[threadIdx.x >> 6] = v;
    __syncthreads();
    float r = 0.f;
    for (int i = 0; i < 8; ++i) r += red[i];
    __syncthreads();
    return r;
}
DI void dbg_note(unsigned* ctl, int idx, float err) { if (threadIdx.x == 0) atomicMax(ctl + CW_DBG + idx, __builtin_bit_cast(unsigned, err)); }
template <int layer>
DI void dbg_check(const Args& a, LAS unsigned char* lds, int stage, const MoeMeta& mm) {
    if (blockIdx.x >= 64) return;
    const int tid = threadIdx.x;
    const int t = blockIdx.x * 512 + (blockIdx.x * 37) % 512;
    LAS float* x1 = (LAS float*)(lds);
    LAS float* hh = x1 + 1024;
    LAS float* yy = hh + 512;
    LAS float* red = yy + 2048;
    LAS float* scl = red + 16;
    unsigned* ctl = (unsigned*)(a.ws + WS_CTL);
    float* dbgx1 = (float*)(a.ws + WS_SMALL) + blockIdx.x * 1024;
    const float* xout = a.out; const bf16_t* actb = (const bf16_t*)(a.ws + WS_ACTB);
    const u32x4 ti = *(const u32x4*)(a.ws + WS_TOKINFO + (size_t)t * 16);
    const int e0 = ti.x & 15, p0 = ti.x >> 4, e1 = ti.z & 15, p1 = ti.z >> 4;
    const float w0 = u2f(ti.y), w1 = u2f(ti.w);
    __syncthreads();
    if (tid == 0) { scl[16] = w0; scl[17] = w1; }
    __syncthreads();
    if (stage == 1) {
        const float* xin = (layer == 0) ? a.in[IN_X] : nullptr;
        if (xin) {
            float v0 = ALPHA * xin[(size_t)t * D + tid], v1 = ALPHA * xin[(size_t)t * D + tid + 512];
            const float mean = dbg_block_sum(v0 + v1, red) / D;
            const float var = dbg_block_sum((v0 - mean) * (v0 - mean) + (v1 - mean) * (v1 - mean), red) / D;
            const float rstd = 1.f / sqrtf(var + LN_EPS);
            const float* g = a.in[IN_LN1G] + layer * D; const float* b = a.in[IN_LN1B] + layer * D;
            const float r0 = (v0 - mean) * rstd * g[tid] + b[tid], r1 = (v1 - mean) * rstd * g[tid + 512] + b[tid + 512];
            float e = fmaxf(fabsf(r0 - xout[(size_t)t * D + tid]), fabsf(r1 - xout[(size_t)t * D + tid + 512]));
            dbg_note(ctl, 0, dbg_block_max(e, red));
            const float q0 = __builtin_bit_cast(float, (unsigned)actb[(size_t)t * D + tid] << 16), q1 = __builtin_bit_cast(float, (unsigned)actb[(size_t)t * D + tid + 512] << 16);
            e = fmaxf(fabsf(r0 - q0), fabsf(r1 - q1));
            dbg_note(ctl, 1, dbg_block_max(e, red));
        }
        x1[tid] = xout[(size_t)t * D + tid]; x1[tid + 512] = xout[(size_t)t * D + tid + 512];
        dbgx1[tid] = x1[tid]; dbgx1[tid + 512] = x1[tid + 512];
        __syncthreads();
        if (tid < 16) { float s = 0.f; for (int k = 0; k < D; ++k) s += x1[k] * a.in[IN_RW][k * 16 + tid]; scl[tid] = 1.f / (1.f + expf(-s)); }
        __syncthreads();
        if (tid == 0) {
            float bz[16]; for (int e = 0; e < 16; ++e) bz[e] = scl[e] + a.in[IN_RB][e];
            int bg = 0; float bgs = -1e30f;
            for (int g = 0; g < 4; ++g) { float m1 = -1e30f, m2 = -1e30f; for (int k = 0; k < 4; ++k) { const float v = bz[4 * g + k]; if (v > m1) { m2 = m1; m1 = v; } else if (v > m2) m2 = v; }
                if (m1 + m2 > bgs) { bgs = m1 + m2; bg = g; } }
            int i1 = 0; for (int k = 1; k < 4; ++k) if (bz[4 * bg + k] > bz[4 * bg + i1]) i1 = k;
            int i2 = -1; for (int k = 0; k < 4; ++k) if (k != i1 && (i2 < 0 || bz[4 * bg + k] > bz[4 * bg + i2])) i2 = k;
            const float s1 = scl[4 * bg + i1], s2 = scl[4 * bg + i2];
            float err = 0.f;
            if (e0 != 4 * bg + i1 || e1 != 4 * bg + i2) err = 1.f;
            err = fmaxf(err, fabsf(scl[16] - s1 / (s1 + s2))); err = fmaxf(err, fabsf(scl[17] - s2 / (s1 + s2)));
            if (p0 >= mm.cnt[e0] || p1 >= mm.cnt[e1]) err = 2.f;
            else { const unsigned* list = (const unsigned*)(a.ws + WS_LIST); if (list[e0 * 32768 + p0] != (unsigned)t || list[e1 * 32768 + p1] != (unsigned)t) err = 3.f; }
            atomicMax(ctl + CW_DBG + 2, __builtin_bit_cast(unsigned, err));
        }
        return;
    }
    x1[tid] = dbgx1[tid]; x1[tid + 512] = dbgx1[tid + 512];
    __syncthreads();
    const float* eg = a.in[IN_EG] + (size_t)layer * NE * D * DEXP; const float* eu = a.in[IN_EU] + (size_t)layer * NE * D * DEXP; const float* ed = a.in[IN_ED] + (size_t)layer * NE * DEXP * D;
    { const int k = tid >> 8, j = tid & 255, e = k ? e1 : e0;
      float g = 0.f, u = 0.f; for (int i = 0; i < D; ++i) { g += x1[i] * eg[((size_t)e * D + i) * DEXP + j]; u += x1[i] * eu[((size_t)e * D + i) * DEXP + j]; }
      hh[k * 256 + j] = g / (1.f + expf(-g)) * u; }
    __syncthreads();
    const size_t s0 = (size_t)mm.tstart[e0] * 256 + p0, s1 = (size_t)mm.tstart[e1] * 256 + p1;
    if (stage == 2) {
        const bf16_t* hb = (const bf16_t*)(a.ws + WS_BIG + BIG_H);
        const int k = tid >> 8, j = tid & 255; const size_t s = k ? s1 : s0;
        const float got = __builtin_bit_cast(float, (unsigned)hb[s * DEXP + j] << 16);
        const float ref = hh[tid];
        const float rms = sqrtf(dbg_block_sum(ref * ref, red) / 512.f);
        dbg_note(ctl, 3, dbg_block_max(fabsf(got - ref), red) / (rms + 1e-6f));
        return;
    }
    for (int c = tid; c < 2048; c += 512) { const int k = c >> 10, col = c & 1023, e = k ? e1 : e0; float s = 0.f;
        for (int j = 0; j < DEXP; ++j) s += hh[k * 256 + j] * ed[((size_t)e * DEXP + j) * D + col];
        yy[c] = s; }
    __syncthreads();
    if (stage == 3) {
        const bf16_t* yb = (const bf16_t*)(a.ws + WS_BIG + BIG_YB);
        float e = 0.f, sq = 0.f;
        for (int c = tid; c < 2048; c += 512) { const int k = c >> 10, col = c & 1023; const size_t s = k ? s1 : s0;
            const float got = __builtin_bit_cast(float, (unsigned)yb[s * D + col] << 16); e = fmaxf(e, fabsf(got - yy[c])); sq += yy[c] * yy[c]; }
        const float rms = sqrtf(dbg_block_sum(sq, red) / 2048.f);
        dbg_note(ctl, 4, dbg_block_max(e, red) / (rms + 1e-6f));
        return;
    }
    {
        float v0 = ALPHA * x1[tid] + w0 * yy[tid] + w1 * yy[1024 + tid], v1 = ALPHA * x1[tid + 512] + w0 * yy[tid + 512] + w1 * yy[1024 + tid + 512];
        const float mean = dbg_block_sum(v0 + v1, red) / D;
        const float var = dbg_block_sum((v0 - mean) * (v0 - mean) + (v1 - mean) * (v1 - mean), red) / D;
        const float rstd = 1.f / sqrtf(var + LN_EPS);
        const float* g = a.in[IN_LN2G] + layer * D; const float* b = a.in[IN_LN2B] + layer * D;
        const float r0 = (v0 - mean) * rstd * g[tid] + b[tid], r1 = (v1 - mean) * rstd * g[tid + 512] + b[tid + 512];
        const float e = fmaxf(fabsf(r0 - xout[(size_t)t * D + tid]), fabsf(r1 - xout[(size_t)t * D + tid + 512]));
        dbg_note(ctl, 5, dbg_block_max(e, red));
    }
}
DI void dbg_final(const Args& a) {
    unsigned* ctl = (unsigned*)(a.ws + WS_CTL);
    const float tol[6] = {1e-4f, 2e-2f, 1e-3f, 0.12f, 0.12f, 4e-2f};
    int code = 2;
    for (int i = 5; i >= 0; --i) { const float err = __builtin_bit_cast(float, xb_ld(ctl + CW_DBG + i));
        if (!(err <= tol[i])) { const int dg = !(err < 1.f) ? 9 : err >= 0.3f ? 7 : err >= 0.1f ? 5 : err >= 0.03f ? 3 : 1; code = 10 * (i + 1) + dg; } }
#ifdef PROBE
    { const float p0 = (float)xb_ld(ctl + CW_DBG + 10) / 65536.f, p1 = __builtin_bit_cast(float, xb_ld(ctl + CW_DBG + 9));
      const int d0 = p0 < 0.f ? 0 : p0 >= 1.f ? 9 : (int)(p0 * 9.99f), d1 = p1 < 0.f ? 0 : p1 >= 1.f ? 9 : (int)(p1 * 9.99f); code = 10 * d0 + d1; }
#endif
    if (xb_ld(ctl + CW_BAR + XB_TMO)) code = 95;
    const float c = sqrtf((float)code);
    for (size_t i = (size_t)blockIdx.x * NTHR + threadIdx.x; i < (size_t)T * D; i += (size_t)gridDim.x * NTHR) a.out[i] = c;
}
#endif


#ifndef PROBE_LO
#define PROBE_LO -1
#define PROBE_HI -1
#define PROBE_MULT 0
#endif
#ifndef PROBE_MASK
#define PROBE_MASK 0ull
#endif
DI void probe_tick(LAS unsigned char* lds, int wv) {
    if (PROBE_LO < 0) return;
    volatile LAS unsigned* M = (volatile LAS unsigned*)(lds + MISC_OFF);
    if (tid_of(wv) == 0) { const unsigned long long now = __builtin_amdgcn_s_memrealtime(); const int k = (int)M[16];
        const unsigned long long last = (unsigned long long)M[18] | ((unsigned long long)M[19] << 32);
        if ((k >= PROBE_LO && k <= PROBE_HI) || ((PROBE_MASK >> k) & 1ull)) { unsigned long long acc = (unsigned long long)M[20] | ((unsigned long long)M[21] << 32); acc += now - last; M[20] = (unsigned)acc; M[21] = (unsigned)(acc >> 32); }
        M[16] = (unsigned)(k + 1); M[18] = (unsigned)now; M[19] = (unsigned)(now >> 32); }
}
#define GRID_BAR() do { xcd_barrier(bar); probe_tick(lds, a.wv); } while (0)
constexpr bool HAS_MIXER[4] = {true, true, true, true};
template <int layer>
DI void run_layer(const Args& a, LAS unsigned char* lds, const XcdBarrier& bar) {
    const int wave = a.wv;
    const int G = gridDim.x, bid = blockIdx.x;
    const int gw = bid * NWAVES + wave, NGW = G * NWAVES;
    unsigned char* ws = a.ws;
    unsigned* ctl = (unsigned*)(a.ws + WS_CTL);
    bf16_t* actb = (bf16_t*)(ws + WS_ACTB);
    float* xout = a.out;
    bf16_t* xres = (bf16_t*)a.out;
        bf16_t* bigb = (bf16_t*)(ws + WS_BIG);
        if (layer == 0) {
#pragma unroll 1
            for (int b = 0; b < BATCH; ++b) {
                { pg8::DenseSched S; S.init(actb + (size_t)b * SEQ * D, D * 2, 128, ws + WS_WIN, SEQ, 9216, D, G, bid); pg8::EpiStore E{bigb, (size_t)9216}; pg8::gemm_phase(lds + STAGE_OFF, S, E, a.wv); }
                if (b == 1) dilated_merge(a, 0);
                GRID_BAR();
                dilated_phase(a, lds);
                GRID_BAR();
            }
            dilated_merge(a, 1);
            GRID_BAR();
        }
        if (layer == 1) {
            { pg8::DenseSched S; S.init(xres, D * 2, 128, ws + WS_WIN, T, 3072, D, G, bid); pg8::EpiStore E{bigb, (size_t)3072}; pg8::gemm_phase(lds + STAGE_OFF, S, E, a.wv); }
            GRID_BAR();
            sb_phase(a, lds);
            GRID_BAR();
        }
        if (layer == 2) {
            { pg8::DenseSched S; S.init(xres, D * 2, 128, ws + WS_WIN, T, 2816, D, G, bid);
              pg8::EpiNsa E{(bf16_t*)(ws + WS_BIG + NS_Q), (bf16_t*)(ws + WS_BIG + NS_KV), (float*)(ws + WS_BIG + NS_GT)}; pg8::gemm_phase(lds + STAGE_OFF, S, E, a.wv); }
            GRID_BAR();
            { pg8::CmpSched S; S.kv6 = (const char*)(ws + WS_BIG + NS_KV); S.Bt = (const char*)(ws + WS_WCMP); S.K = 2048; S.lda = 16 * 1536 * 2; S.kstepA = 1536 * 2; S.G = G; S.c = bid;
              pg8::EpiCmp E{(bf16_t*)(ws + WS_BIG + NS_HID), (const float*)(ws + WS_WCMP + 2 * MiB + 64 * 1024)}; pg8::gemm_phase(lds + STAGE_OFF, S, E, a.wv); }
            GRID_BAR();
            nsa_kcvc_phase(a, lds);
            GRID_BAR();
            nsa_attn_phase(a, lds);
            GRID_BAR();
        }
        if (layer == 3) {
            { pg8::DenseSched S; S.init(xres, D * 2, 128, ws + WS_WIN, T, 3072, D, G, bid); pg8::EpiStore E{bigb, (size_t)3072}; pg8::gemm_phase(lds + STAGE_OFF, S, E, a.wv); }
            GRID_BAR();
            moba_kmean_phase(a, lds);
            GRID_BAR();
            moba_gate_phase(a, lds);
            GRID_BAR();
            moba_fill_phase(a, lds);
            GRID_BAR();
            moba_sel_phase(a, lds);
            GRID_BAR();
            moba_own_phase(a, lds);
            GRID_BAR();
        }
        if (HAS_MIXER[layer]) {
            { pg8::DenseSched S; S.init(actb, D * 2, 128, ws + WS_WOUT, T, D, D, G, bid); pg8::EpiStore E{(bf16_t*)(ws + WS_BIG + BIG_Y), (size_t)D}; pg8::gemm_phase(lds + STAGE_OFF, S, E, a.wv); }
            GRID_BAR();
        }
        unsigned* gcount = ctl + CW_MOE + layer * 16 * 64;
        {
            const int tid = tid_of(a.wv), lane = tid & 63;
            constexpr int RWS = 1032;
            LAS bf16_t* rwh = (LAS bf16_t*)(lds + STAGE_OFF);
            LAS bf16_t* rwl = rwh + 16 * RWS;
            LAS int* lcnt = (LAS int*)(lds + STAGE_OFF + 73728);
            LAS int* gbase = lcnt + 16;
            LAS unsigned* le = (LAS unsigned*)(lcnt + 32);
            LAS float* lg = (LAS float*)(le + 256);
            const float* xin0 = a.in[IN_X];
            const bf16_t* ybig = (const bf16_t*)(ws + WS_BIG + BIG_Y);
            bf16_t* xlo = (bf16_t*)(ws + WS_BIG + BIG_YB);
            f32x4 pxf[2][4]; u32x2 pxb[2][4], py[2][4];
#define LN1_LOAD(S_, TR_) { _Pragma("unroll") for (int j = 0; j < 4; ++j) { \
                if (layer == 0) pxf[S_][j] = *(const f32x4*)(xin0 + (size_t)(TR_) * D + 4 * lane + 256 * j); \
                else pxb[S_][j] = *(const u32x2*)(xres + (size_t)(TR_) * D + 4 * lane + 256 * j); \
                py[S_][j] = HAS_MIXER[layer] ? *(const u32x2*)(ybig + (size_t)(TR_) * D + 4 * lane + 256 * j) : (u32x2){0u, 0u}; } }
            LN1_LOAD(0, bid * 128 + wave) LN1_LOAD(1, bid * 128 + wave + NWAVES)
            { const u32x4* img = (const u32x4*)(ws + WS_RW); LAS u32x4* dst = (LAS u32x4*)rwh;
              for (int i = tid; i < 2 * 16 * RWS / 8; i += NTHR) dst[i] = img[i]; }
            if (tid < 16) lcnt[tid] = 0;
            const float* g1 = a.in[IN_LN1G] + layer * D; const float* b1 = a.in[IN_LN1B] + layer * D;
            RowVec gv, bv;
#pragma unroll
            for (int j = 0; j < 4; ++j) { gv.v[j] = *(const f32x4*)(g1 + 4 * lane + 256 * j); bv.v[j] = *(const f32x4*)(b1 + 4 * lane + 256 * j); }
            __syncthreads();
            for (int lt = wave; lt < 128; lt += 2 * NWAVES) {
#pragma unroll
                for (int s = 0; s < 2; ++s) {
                    const int t = bid * 128 + lt + NWAVES * s;
                    RowVec r;
#pragma unroll
                    for (int j = 0; j < 4; ++j) {
                        if (layer == 0) r.v[j] = pxf[s][j] * ALPHA;
                        else { r.v[j].x = ALPHA * bf_lo(pxb[s][j].x); r.v[j].y = ALPHA * bf_hi(pxb[s][j].x); r.v[j].z = ALPHA * bf_lo(pxb[s][j].y); r.v[j].w = ALPHA * bf_hi(pxb[s][j].y); }
                        r.v[j].x += bf_lo(py[s][j].x); r.v[j].y += bf_hi(py[s][j].x); r.v[j].z += bf_lo(py[s][j].y); r.v[j].w += bf_hi(py[s][j].y); }
                    if (lt + 2 * NWAVES < 128) LN1_LOAD(s, t + 2 * NWAVES)
                    float mean, rstd; ln_stats(r, mean, rstd);
#pragma unroll
                    for (int j = 0; j < 4; ++j) { r.v[j] = (r.v[j] - mean) * rstd * gv.v[j] + bv.v[j];
                        const unsigned h0 = f2bf(r.v[j].x), h1 = f2bf(r.v[j].y), h2 = f2bf(r.v[j].z), h3 = f2bf(r.v[j].w);
                        u32x2 w; w.x = h0 | (h1 << 16); w.y = h2 | (h3 << 16);
                        *(u32x2*)(actb + (size_t)t * D + 4 * lane + 256 * j) = w;
                        u32x2 wl; wl.x = pk2(r.v[j].x - u2f(h0 << 16), r.v[j].y - u2f(h1 << 16)); wl.y = pk2(r.v[j].z - u2f(h2 << 16), r.v[j].w - u2f(h3 << 16));
                        *(u32x2*)(xlo + (size_t)t * D + 4 * lane + 256 * j) = wl; }
                }
            }
#undef LN1_LOAD
            asm volatile("s_waitcnt vmcnt(0)" ::: "memory");
            {
                const int n = lane & 15, kg = lane >> 4, lt = wave + NWAVES * n, t = bid * 128 + lt;
                const bf16_t* xh_ = actb + (size_t)t * D + 8 * kg; const bf16_t* xl_ = xlo + (size_t)t * D + 8 * kg;
                const LAS bf16_t* ah = rwh + n * RWS + 8 * kg; const LAS bf16_t* al = rwl + n * RWS + 8 * kg;
                f32x4 acc = {0.f, 0.f, 0.f, 0.f};
#pragma unroll 8
                for (int ks = 0; ks < 32; ++ks) {
                    const bf16x8 bh = *(const bf16x8*)(xh_ + 32 * ks), bl = *(const bf16x8*)(xl_ + 32 * ks);
                    const bf16x8 wh = *(const LAS bf16x8*)(ah + 32 * ks), wl = *(const LAS bf16x8*)(al + 32 * ks);
                    acc = __builtin_amdgcn_mfma_f32_16x16x32_bf16(wh, bh, acc, 0, 0, 0);
                    acc = __builtin_amdgcn_mfma_f32_16x16x32_bf16(wh, bl, acc, 0, 0, 0);
                    acc = __builtin_amdgcn_mfma_f32_16x16x32_bf16(wl, bh, acc, 0, 0, 0);
                }
                float sc[4], bz[4];
#pragma unroll
                for (int k = 0; k < 4; ++k) { sc[k] = 1.f / (1.f + __expf(-acc[k])); bz[k] = sc[k] + a.in[IN_RB][4 * kg + k]; }
                float m1 = bz[0]; int j1 = 0;
#pragma unroll
                for (int k = 1; k < 4; ++k) if (bz[k] > m1) { m1 = bz[k]; j1 = k; }
                float m2 = -1e30f; int j2 = -1;
#pragma unroll
                for (int k = 0; k < 4; ++k) if (k != j1 && bz[k] > m2) { m2 = bz[k]; j2 = k; }
                const float gs = m1 + m2;
                const float o1 = __shfl_xor(gs, 16), o2 = __shfl_xor(gs, 32), o3 = __shfl_xor(gs, 48);
                float Gs[4];
#pragma unroll
                for (int g = 0; g < 4; ++g) Gs[g] = (kg == g) ? gs : ((kg ^ 1) == g) ? o1 : ((kg ^ 2) == g) ? o2 : o3;
                int bg = 0; float bgs = Gs[0];
#pragma unroll
                for (int g = 1; g < 4; ++g) if (Gs[g] > bgs) { bgs = Gs[g]; bg = g; }
                if (bg == kg) {
                    float sg1 = 0.f, sg2 = 0.f;
#pragma unroll
                    for (int k = 0; k < 4; ++k) { sg1 = (k == j1) ? sc[k] : sg1; sg2 = (k == j2) ? sc[k] : sg2; }
                    const float inv = 1.f / (sg1 + sg2);
                    const int e0 = bg * 4 + j1, e1 = bg * 4 + j2;
                    const int p0 = atomicAdd((int*)(lcnt + e0), 1), p1 = atomicAdd((int*)(lcnt + e1), 1);
                    le[lt * 2] = (unsigned)e0 | ((unsigned)p0 << 8); le[lt * 2 + 1] = (unsigned)e1 | ((unsigned)p1 << 8);
                    lg[lt * 2] = sg1 * inv; lg[lt * 2 + 1] = sg2 * inv;
                }
            }
            __syncthreads();
            if (tid < 16) gbase[tid] = (int)xb_add(gcount + tid * 64, (unsigned)lcnt[tid]);
            __syncthreads();
            if (tid < 256) {
                const int lt = tid >> 1, t = bid * 128 + lt;
                if (t < T) {
                    const unsigned w = le[tid]; const int e = w & 255, pos = gbase[e] + (int)(w >> 8);
                    ((unsigned*)(ws + WS_LIST))[e * 32768 + pos] = (unsigned)t;
                    u32x2 ti; ti.x = (unsigned)e | ((unsigned)pos << 4); ti.y = __builtin_bit_cast(unsigned, lg[tid]);
                    *(u32x2*)(ws + WS_TOKINFO + (size_t)(t * 2 + (tid & 1)) * 8) = ti;
                }
            }
        }
        GRID_BAR();

        MoeMeta mm; mm.tstart = (LAS int*)(lds + MISC_OFF + 256); mm.cnt = mm.tstart + 32;
        if (tid_of(a.wv) == 0) { int acc = 0;
            for (int e = 0; e < 16; ++e) { const int c = (int)xb_ld(gcount + e * 64); mm.cnt[e] = c; mm.tstart[e] = acc; acc += (c + 255) >> 8; }
            mm.tstart[16] = acc; }
        __syncthreads();
        const int ntiles = mm.tstart[16];
#if DBG
        if (layer == DBG_LAYER) { dbg_check<layer>(a, lds, 1, mm); __syncthreads(); }
#endif
        {
            Moe1Sched S; S.A = (const char*)actb; S.Bt = (const char*)(ws + WS_WEXP1); S.K = D; S.lda = D * 2; S.kstepA = 128; S.mm = mm; S.ntiles = ntiles; S.G = G; S.c = bid;
            S.tab = (LAS unsigned*)(lds + AUX_OFF);
            const int tid = tid_of(a.wv);
            pg8::Unit u;
            for (int i = 0; i < 8 && S.next(i, u); ++i) {
                if (tid < 256) { const int pos = (u.pm - mm.tstart[u.e]) * 256 + tid;
                    const unsigned tok = (pos < mm.cnt[u.e]) ? ((const unsigned*)(ws + WS_LIST))[u.e * 32768 + pos] : 0u;
                    S.tab[i * 256 + tid] = tok * (unsigned)(D * 2); }
            }
            __syncthreads();
            pg8::EpiSwiglu E{(bf16_t*)(ws + WS_BIG + BIG_H)};
            pg8::gemm_phase(lds + STAGE_OFF, S, E, a.wv);
        }
        GRID_BAR();
#if DBG
        if (layer == DBG_LAYER) { dbg_check<layer>(a, lds, 2, mm); __syncthreads(); }
#endif
        {
            Moe2Sched S; S.A = (const char*)(ws + WS_BIG + BIG_H); S.Bt = (const char*)(ws + WS_WEXP2); S.K = DEXP; S.lda = DEXP * 2; S.kstepA = 128; S.mm = mm; S.ntiles = ntiles; S.G = G; S.c = bid;
            pg8::EpiStore E{(bf16_t*)(ws + WS_BIG + BIG_YB), (size_t)D};
            pg8::gemm_phase(lds + STAGE_OFF, S, E, a.wv);
        }
        GRID_BAR();
#if DBG
        if (layer == DBG_LAYER) { dbg_check<layer>(a, lds, 3, mm); __syncthreads(); }
#endif
        {
            const int tid = tid_of(a.wv), lane = tid & 63;
            const float* g2 = a.in[IN_LN2G] + layer * D; const float* b2 = a.in[IN_LN2B] + layer * D;
            RowVec gv, bv;
#pragma unroll
            for (int j = 0; j < 4; ++j) { gv.v[j] = *(const f32x4*)(g2 + 4 * lane + 256 * j); bv.v[j] = *(const f32x4*)(b2 + 4 * lane + 256 * j); }
            const bf16_t* yb = (const bf16_t*)(ws + WS_BIG + BIG_YB);
            u32x4 tiN[2]; u32x2 px[2][4], py0[2][4], py1[2][4]; float cw0[2], cw1[2];
#define LN2_LOAD(S_, TR_) { const u32x4 ti_ = tiN[S_]; const int e0 = ti_.x & 15, p0 = ti_.x >> 4, e1 = ti_.z & 15, p1 = ti_.z >> 4; cw0[S_] = u2f(ti_.y); cw1[S_] = u2f(ti_.w); \
                const size_t s0 = (size_t)mm.tstart[e0] * 256 + p0, s1 = (size_t)mm.tstart[e1] * 256 + p1; \
                _Pragma("unroll") for (int j = 0; j < 4; ++j) { px[S_][j] = *(const u32x2*)(actb + (size_t)(TR_) * D + 4 * lane + 256 * j); \
                    py0[S_][j] = *(const u32x2*)(yb + s0 * D + 4 * lane + 256 * j); py1[S_][j] = *(const u32x2*)(yb + s1 * D + 4 * lane + 256 * j); } }
            static_assert(T % (2 * 256 * NWAVES) == 0, "LN2 row pairing");
            tiN[0] = *(const u32x4*)(ws + WS_TOKINFO + (size_t)gw * 16); tiN[1] = *(const u32x4*)(ws + WS_TOKINFO + (size_t)(gw + NGW) * 16);
            LN2_LOAD(0, gw) LN2_LOAD(1, gw + NGW)
            if (gw + 2 * NGW < T) { tiN[0] = *(const u32x4*)(ws + WS_TOKINFO + (size_t)(gw + 2 * NGW) * 16); tiN[1] = *(const u32x4*)(ws + WS_TOKINFO + (size_t)(gw + 3 * NGW) * 16); }
            for (int tb = gw; tb < T; tb += 2 * NGW) {
#pragma unroll
                for (int s = 0; s < 2; ++s) {
                    const int t = tb + s * NGW;
                    const float w0 = cw0[s], w1 = cw1[s];
                    RowVec r;
#pragma unroll
                    for (int j = 0; j < 4; ++j) {
                        const u32x2 xv = px[s][j], y0 = py0[s][j], y1 = py1[s][j];
                        r.v[j].x = ALPHA * bf_lo(xv.x) + w0 * bf_lo(y0.x) + w1 * bf_lo(y1.x);
                        r.v[j].y = ALPHA * bf_hi(xv.x) + w0 * bf_hi(y0.x) + w1 * bf_hi(y1.x);
                        r.v[j].z = ALPHA * bf_lo(xv.y) + w0 * bf_lo(y0.y) + w1 * bf_lo(y1.y);
                        r.v[j].w = ALPHA * bf_hi(xv.y) + w0 * bf_hi(y0.y) + w1 * bf_hi(y1.y);
                    }
                    if (t + 2 * NGW < T) { const int tn = t + 2 * NGW;
                        LN2_LOAD(s, tn)
                        if (tn + 2 * NGW < T) tiN[s] = *(const u32x4*)(ws + WS_TOKINFO + (size_t)(tn + 2 * NGW) * 16); }
                    float mean, rstd; ln_stats(r, mean, rstd);
#pragma unroll
                    for (int j = 0; j < 4; ++j) { r.v[j] = (r.v[j] - mean) * rstd * gv.v[j] + bv.v[j];
                        if (layer == DEPTH - 1) *(f32x4*)(xout + (size_t)t * D + 4 * lane + 256 * j) = r.v[j];
                        else { u32x2 w; w.x = pk2(r.v[j].x, r.v[j].y); w.y = pk2(r.v[j].z, r.v[j].w);
                            *(u32x2*)(xres + (size_t)t * D + 4 * lane + 256 * j) = w; } }
                }
            }
#undef LN2_LOAD
            if (layer + 1 < DEPTH) convert_layer_weights(a, layer + 1, lds, gw, NGW, wave, lane);
        }
        GRID_BAR();
#if DBG
        if (layer == DBG_LAYER) { dbg_check<layer>(a, lds, 4, mm); GRID_BAR(); }
#endif
}

__global__ void __launch_bounds__(NTHR, 2) fwd(Args a_in) {
    Args a = a_in; a.wv = __builtin_amdgcn_readfirstlane((int)(threadIdx.x >> 6));
    extern __shared__ __attribute__((aligned(16))) unsigned char lds_raw[];
    LAS unsigned char* lds = (LAS unsigned char*)lds_raw;
    volatile LAS unsigned* MISC = (volatile LAS unsigned*)(lds + MISC_OFF);
    const int tid = tid_of(a.wv), lane = tid & 63, wave = a.wv;
    const int G = gridDim.x, bid = blockIdx.x;
    const int gw = bid * NWAVES + wave, NGW = G * NWAVES;
    if (tid < 256) MISC[tid] = 0u;
    __syncthreads();
    unsigned* ctl = (unsigned*)(a.ws + WS_CTL);
    XcdBarrier bar = xcd_barrier_post(ctl + CW_BAR, MISC + 8); bar.wv = a.wv;
    if (PROBE_LO >= 0 && tid == 0) { const unsigned long long now = __builtin_amdgcn_s_memrealtime(); MISC[18] = (unsigned)now; MISC[19] = (unsigned)(now >> 32); }
    unsigned char* ws = a.ws;
    bf16_t* actb = (bf16_t*)(ws + WS_ACTB);
    float* xout = a.out;

    convert_layer_weights(a, 0, lds, gw, NGW, wave, lane);
    for (int i = bid * NTHR + tid; i < 16 * 2048; i += G * NTHR) { const int hd = i >> 11, n = i & 2047;
        int bk = n; if (n >= 16) { const float lf = logf((float)n / 16.f) / 4.852030263919617f; bk = 16 + (int)(lf * 16.f); bk = bk > 31 ? 31 : bk; }
        ((float*)(a.ws + WS_BIASG))[i] = a.in[IN_REL][bk * 16 + hd] * LOG2E; }
    for (int i = bid * NTHR + tid; i < 16 * 1032; i += G * NTHR) { const int e = i / 1032, k = i % 1032; const float v = (k < 1024) ? a.in[IN_RW][k * 16 + e] : 0.f; const unsigned hi = f2bf(v);
        ((bf16_t*)(a.ws + WS_RW))[i] = (bf16_t)hi; ((bf16_t*)(a.ws + WS_RW))[16 * 1032 + i] = (bf16_t)f2bf(v - u2f(hi << 16)); }
    { const float* x = a.in[IN_X];
      constexpr size_t XS = (size_t)256 * NTHR * 8;
      static_assert(((size_t)T * D) % (XS * 4) == 0, "x conversion sweep");
      for (size_t i = ((size_t)bid * NTHR + tid) * 8; i < (size_t)T * D; i += XS * 4) {
          f32x4 v0[4], v1[4];
#pragma unroll
          for (int q = 0; q < 4; ++q) { v0[q] = *(const f32x4*)(x + i + q * XS); v1[q] = *(const f32x4*)(x + i + q * XS + 4); }
#pragma unroll
          for (int q = 0; q < 4; ++q) { u32x4 w; w.x = pk2(v0[q].x, v0[q].y); w.y = pk2(v0[q].z, v0[q].w); w.z = pk2(v1[q].x, v1[q].y); w.w = pk2(v1[q].z, v1[q].w);
              *(u32x4*)(actb + i + q * XS) = w; } } }
    GRID_BAR();

    run_layer<0>(a, lds, bar);
#if DBG
    if (DBG_LAYER >= 1) run_layer<1>(a, lds, bar);
    if (DBG_LAYER >= 2) run_layer<2>(a, lds, bar);
    if (DBG_LAYER >= 3) run_layer<3>(a, lds, bar);
    dbg_final(a);
#else
    run_layer<1>(a, lds, bar);
    run_layer<2>(a, lds, bar);
    run_layer<3>(a, lds, bar);
#endif
    if (PROBE_LO >= 0) { __syncthreads(); const unsigned long long acc = (unsigned long long)MISC[20] | ((unsigned long long)MISC[21] << 32); const unsigned long long t0 = __builtin_amdgcn_s_memrealtime();
        while (__builtin_amdgcn_s_memrealtime() - t0 < acc * (unsigned long long)PROBE_MULT) __builtin_amdgcn_s_sleep(8); }
}

extern "C" void kernel_launch(void* const* d_in, const int* in_sizes, int n_in, void* d_out, int out_size, void* d_ws, size_t ws_size, hipStream_t stream) {
    static int grid = 0;
    if (grid == 0) {
        int dev = 0, cus = 0;
        if (n_in != 25 || out_size != T * D || ws_size < WS_END) { fprintf(stderr, "kernel_launch: unexpected shapes (n_in %d out %d ws %zu)\n", n_in, out_size, ws_size); grid = -1; return; }
        if (hipGetDevice(&dev) != hipSuccess || hipDeviceGetAttribute(&cus, hipDeviceAttributeMultiprocessorCount, dev) != hipSuccess) { grid = -1; return; }
        if (hipFuncSetAttribute((const void*)fwd, hipFuncAttributeMaxDynamicSharedMemorySize, LDS_BYTES) != hipSuccess) { grid = -1; return; }
        (void)hipGetLastError();
        grid = cus;
        if (grid != 256) { fprintf(stderr, "kernel_launch: built for 256 CUs, got %d\n", grid); grid = -1; return; }
    }
    if (grid < 0) return;
    (void)hipMemsetAsync(d_ws, 0, 1u << 20, stream);
    Args a{};
    for (int i = 0; i < 25; ++i) a.in[i] = (const float*)d_in[i];
    a.out = (float*)d_out; a.ws = (unsigned char*)d_ws;
    hipLaunchKernelGGL(fwd, dim3(grid), dim3(NTHR), LDS_BYTES, stream, a);
}
```

```cpp
#include <hip/hip_runtime.h>
#include <cstdio>
#include <cstdint>
#define DBG 0
#define DBG_LAYER 0

#define LAS __attribute__((address_space(3)))
#define GAS __attribute__((address_space(1)))
#define DI __device__ __forceinline__
typedef unsigned short bf16_t;
typedef short bf16x8 __attribute__((ext_vector_type(8)));
typedef short s16x4 __attribute__((ext_vector_type(4)));
typedef float f32x2 __attribute__((ext_vector_type(2)));
typedef float f32x4 __attribute__((ext_vector_type(4)));
typedef float f32x16 __attribute__((ext_vector_type(16)));
typedef unsigned u32x2 __attribute__((ext_vector_type(2)));
typedef unsigned u32x4 __attribute__((ext_vector_type(4)));

constexpr int BATCH = 2, SEQ = 16384, D = 1024, T = BATCH * SEQ, DEPTH = 4, NH = 16, HD = 64;
constexpr int NE = 16, DEXP = 256;
constexpr float ALPHA = 1.681792830507429f;
constexpr float LN_EPS = 1e-5f;
constexpr int NWAVES = 8, NTHR = 512;

constexpr size_t MiB = 1u << 20;
constexpr size_t WS_CTL = 0;
constexpr size_t WS_TOKINFO = 1 * MiB;
constexpr size_t WS_SMALL = 1 * MiB + 512 * 1024;
constexpr size_t WS_LIST = 2 * MiB;
constexpr size_t WS_WIN = 4 * MiB;
constexpr size_t WS_WOUT = 22 * MiB;
constexpr size_t WS_WEXP1 = 24 * MiB;
constexpr size_t WS_WEXP2 = 40 * MiB;
constexpr size_t WS_WCMP = 48 * MiB;
constexpr size_t WS_ACTB = 52 * MiB;
constexpr size_t WS_BIG = 116 * MiB;
constexpr size_t WS_END = 512 * MiB;
constexpr size_t BIG_Y = 0;
constexpr size_t BIG_H = 64 * MiB;
constexpr size_t BIG_YB = 100 * MiB;
constexpr size_t BIG_XLO = 240 * MiB;
constexpr int PROWS = 2 * T + NE * 256;

constexpr int CW_BAR = 4096;
constexpr int CW_DBG = 8;
constexpr int CW_MOE = 16384;

constexpr int LDS_BYTES = 160 * 1024;
constexpr int STAGE_OFF = 0;
constexpr int AUX_OFF = 128 * 1024;
constexpr int MISC_OFF = LDS_BYTES - 1024;

DI unsigned f2bf(float f) { unsigned u = __builtin_bit_cast(unsigned, f); return (u + 0x7fffu + ((u >> 16) & 1u)) >> 16; }
DI unsigned pk2(float lo, float hi) { return f2bf(lo) | (f2bf(hi) << 16); }
typedef __bf16 bf16x2_t __attribute__((ext_vector_type(2)));
DI unsigned cvt_pk_bf16(float lo, float hi) { const bf16x2_t r = __builtin_convertvector((f32x2){lo, hi}, bf16x2_t); return __builtin_bit_cast(unsigned, r); }
DI float u2f(unsigned u) { return __builtin_bit_cast(float, u); }
DI unsigned f2u(float f) { return __builtin_bit_cast(unsigned, f); }
DI float bf_lo(unsigned w) { return __builtin_bit_cast(float, w << 16); }
DI float bf_hi(unsigned w) { return __builtin_bit_cast(float, w & 0xffff0000u); }
DI float wave_sum(float v) {
#pragma unroll
    for (int o = 1; o < 64; o <<= 1) v += __shfl_xor(v, o);
    return v;
}
DI int tid_of(int wv) { int l; asm volatile("v_mbcnt_lo_u32_b32 %0, -1, 0\n\tv_mbcnt_hi_u32_b32 %0, -1, %0" : "=v"(l)); return (wv << 6) | l; }
DI float xor32h(float v, int h) { const unsigned u = __builtin_bit_cast(unsigned, v); const u32x2 s = __builtin_amdgcn_permlane32_swap(u, u, false, false);
    return __builtin_bit_cast(float, h ? s.x : s.y); }
DI float quad_xor1(float v) { return __builtin_bit_cast(float, __builtin_amdgcn_update_dpp(0, __builtin_bit_cast(int, v), 0xB1, 0xf, 0xf, false)); }
DI float quad_xor2(float v) { return __builtin_bit_cast(float, __builtin_amdgcn_update_dpp(0, __builtin_bit_cast(int, v), 0x4E, 0xf, 0xf, false)); }
#define LDS_WAIT() asm volatile("s_waitcnt lgkmcnt(0)" ::: "memory")
#define VM_WAIT() asm volatile("s_waitcnt vmcnt(0)" ::: "memory")

#define XB_TMO      128
#define XB_XCNT(j)  (256  + 64 * (j))
#define XB_XSUB(j)  (1280 + 64 * (j))
#define XB_XGEN(j)  (2304 + 64 * (j))
#define XB_TOP      3328
#define XB_TOPGEN   3392
#define XCD_BAR_WORDS 3456
#define XB_SPIN_CAP (1u << 22)
DI unsigned xb_ld(unsigned* p)              { return __hip_atomic_load(p, __ATOMIC_RELAXED, __HIP_MEMORY_SCOPE_AGENT); }
DI unsigned xb_add(unsigned* p, unsigned v) { return __hip_atomic_fetch_add(p, v, __ATOMIC_RELAXED, __HIP_MEMORY_SCOPE_AGENT); }
DI unsigned xb_xcc_id() { return (unsigned)__builtin_amdgcn_s_getreg((3 << 11) | 20) & 0xFu; }
#define XB_SPIN(cond, bar) do { unsigned _sp = 0; while (cond) { __builtin_amdgcn_s_sleep(1); \
    if ((++_sp & 255u) == 0u) { if (xb_ld(&(bar)[XB_TMO])) break; if (_sp > XB_SPIN_CAP) { atomicAdd(&(bar)[XB_TMO], 1u); break; } } } } while (0)
struct XcdBarrier { unsigned* bar; unsigned x; volatile LAS unsigned* st; int wv; };
DI XcdBarrier xcd_barrier_post(unsigned* bar, volatile LAS unsigned* st) {
    XcdBarrier b; b.bar = bar; b.x = xb_xcc_id(); b.st = st;
    if (threadIdx.x == 0) (void)xb_add(&bar[XB_XCNT(b.x)], 1u);
    return b;
}
DI void xcd_barrier_complete(unsigned* bar, unsigned x, unsigned& nloc, unsigned& nx) {
    const unsigned G = gridDim.x * gridDim.y * gridDim.z;
    unsigned sum, cnt, mine, sp = 0u;
    for (;;) {
        sum = 0u; cnt = 0u; mine = 0u;
#pragma unroll
        for (unsigned j = 0; j < 16; ++j) { const unsigned c = xb_ld(&bar[XB_XCNT(j)]); sum += c; cnt += (c > 0u) ? 1u : 0u; mine = (j == x) ? c : mine; }
        if (sum == G) break;
        __builtin_amdgcn_s_sleep(1);
        if ((++sp & 255u) == 0u) { if (xb_ld(&bar[XB_TMO])) break; if (sp > XB_SPIN_CAP) { atomicAdd(&bar[XB_TMO], 1u); break; } }
    }
    nloc = mine > 0u ? mine : 1u; nx = cnt > 0u ? cnt : 1u;
}
DI void xcd_barrier(const XcdBarrier& b) {
    asm volatile("s_waitcnt vmcnt(0)" ::: "memory");
    __syncthreads();
    if (tid_of(b.wv) == 0) {
        unsigned* bar = b.bar;
        const unsigned bx = xb_xcc_id();
        __builtin_amdgcn_s_waitcnt(0);
        unsigned nloc = b.st[0], nx = b.st[1];
        if (nloc == 0u) { xcd_barrier_complete(bar, bx, nloc, nx); b.st[0] = nloc; b.st[1] = nx; }
        const unsigned old = xb_add(&bar[XB_XSUB(bx)], 1u);
        const unsigned gen = old / nloc;
        if (old + 1u == (gen + 1u) * nloc) {
            __builtin_amdgcn_fence(__ATOMIC_RELEASE, "agent");
            asm volatile("s_waitcnt vmcnt(0)" ::: "memory");
            const unsigned og = xb_add(&bar[XB_TOP], 1u);
            const unsigned tg = og / nx;
            if (og + 1u == (tg + 1u) * nx) xb_add(&bar[XB_TOPGEN], 1u);
            else XB_SPIN(xb_ld(&bar[XB_TOPGEN]) == tg, bar);
            __builtin_amdgcn_fence(__ATOMIC_ACQUIRE, "agent");
            xb_add(&bar[XB_XGEN(bx)], 1u);
            asm volatile("s_waitcnt vmcnt(0)" ::: "memory");
        } else {
            XB_SPIN(xb_ld(&bar[XB_XGEN(bx)]) == gen, bar);
            __builtin_amdgcn_fence(__ATOMIC_ACQUIRE, "agent");
            asm volatile("s_waitcnt vmcnt(0)" ::: "memory");
        }
    }
    __syncthreads();
}

namespace pg8 {
constexpr int BM = 256, BK = 64, HALF = 128, HTB = HALF * BK * 2, STAGE_BYTES = 8 * HTB, NXCD = 8, WGM = 8;
__host__ __device__ __forceinline__ int lds_byte(int r, int c) { const int st = (r >> 4) * 2 + (c >> 5), rr = r & 15, cc = c & 31, ob = rr * 64 + cc * 2; return st * 1024 + (ob ^ (((ob >> 9) & 1) << 5)); }
__host__ __device__ __forceinline__ void stage_rc(int b, int& R, int& C) { const int st = b / 1024, sb = b % 1024, swz = sb ^ (((sb >> 9) & 1) << 5); R = (st >> 1) * 16 + swz / 64; C = (st & 1) * 32 + (swz % 64) / 2; }
__host__ __device__ __forceinline__ int perm32(int rho) { const int n = rho >> 4, i = rho & 15; return 8 * (i >> 2) + 4 * n + (i & 3); }

struct Unit { int pm, pn, e; };

struct TileOrder {
    int nM, nN, nwg, G, c;
    DI void init(int nM_, int nN_, int G_, int c_) { nM = nM_; nN = nN_; nwg = nM * nN; G = G_; c = c_; }
    DI bool next(int i, int& pm, int& pn) const {
        const long L = (long)i * G + c; if (L >= nwg) return false;
        int wgid = (int)L; { const int q = nwg / NXCD, r = nwg % NXCD, xcd = wgid % NXCD, off = wgid / NXCD; wgid = (xcd < r ? xcd * (q + 1) : r * (q + 1) + (xcd - r) * q) + off; }
        const int nig = WGM * nN, gid = wgid / nig, fm = gid * WGM, gsz = (nM - fm) < WGM ? (nM - fm) : WGM;
        pm = fm + ((wgid % nig) % gsz); pn = (wgid % nig) / gsz; return true;
    }
};
struct DenseSched {
    static constexpr bool GATHER = false;
    const char* A; const char* Bt; int K; unsigned lda, kstepA; TileOrder ord;
    DI void init(const void* A_, unsigned lda_, unsigned kstepA_, const void* Bt_, int M, int N, int K_, int G, int c) { A = (const char*)A_; Bt = (const char*)Bt_; K = K_; lda = lda_; kstepA = kstepA_; ord.init(M / BM, N / BM, G, c); }
    DI bool next(int i, Unit& u) const { u.e = 0; return ord.next(i, u.pm, u.pn); }
    DI const char* a_base(const Unit& u) const { return A + (size_t)u.pm * BM * lda; }
    DI const char* b_base(const Unit& u) const { return Bt + (size_t)u.pn * BM * K * 2; }
    DI unsigned row_off(int, int) const { return 0u; }
};

template <class Epi, class Sched>
DI void gemm_phase(LAS unsigned char* lds, const Sched& S, const Epi& E, int wv) {
    int tid = tid_of(wv); asm volatile("" : "+v"(tid));
    const int wid = __builtin_amdgcn_readfirstlane(tid >> 6), lane = tid & 63, wr = wid >> 2, wc = wid & 3, fr = lane & 15, fq = lane >> 4;
    const int K = S.K, nt = K / BK;
    unsigned voffB[2]; int Rr[2]; unsigned Cb[2];
#pragma unroll
    for (int i = 0; i < 2; ++i) { int R, C; stage_rc(tid * 16 + i * 8192, R, C); const int Rb = (R & ~31) + perm32(R & 31);
        voffB[i] = (unsigned)(Rb * K + C) * 2u; Rr[i] = R; Cb[i] = (unsigned)C * 2u; }
    const unsigned kstepA = S.kstepA, kstepB = (unsigned)(BK * 2);
    const size_t hstepB = (size_t)HALF * K * 2;
    const unsigned ldsw = (unsigned)wid * 1024u;
    const int aoff = lds_byte(wr * 64 + fr, fq * 8), boff = lds_byte(wc * 32 + fr, fq * 8);
#define PG8_SA(b, h) (((b) * 2 + (h)) * HTB)
#define PG8_SB(b, h) ((4 + (b) * 2 + (h)) * HTB)
#define PG8_STAGE_A(bufoff, basep, vv, h, koff) do { _Pragma("unroll") for (int _i = 0; _i < 2; ++_i) \
        __builtin_amdgcn_global_load_lds((const unsigned*)((basep) + (vv)[h][_i] + (koff)), (LAS unsigned*)(lds + (bufoff) + ldsw + _i * 8192), 16, 0, 0); } while (0)
#define PG8_STAGE_B(bufoff, ptr) do { _Pragma("unroll") for (int _i = 0; _i < 2; ++_i) \
        __builtin_amdgcn_global_load_lds((const unsigned*)((ptr) + voffB[_i]), (LAS unsigned*)(lds + (bufoff) + ldsw + _i * 8192), 16, 0, 0); } while (0)
#define PG8_LDA(dst, b, h) do { _Pragma("unroll") for (int m = 0; m < 4; ++m) _Pragma("unroll") for (int k = 0; k < 2; ++k) dst[m][k] = *(const LAS bf16x8*)(lds + PG8_SA(b, h) + aoff + m * 2048 + k * 1024); } while (0)
#define PG8_LDB(dst, b, h) do { _Pragma("unroll") for (int n = 0; n < 2; ++n) _Pragma("unroll") for (int k = 0; k < 2; ++k) dst[n][k] = *(const LAS bf16x8*)(lds + PG8_SB(b, h) + boff + n * 2048 + k * 1024); } while (0)
#define PG8_MMA(ai, bj, At, Bt) do { __builtin_amdgcn_s_setprio(1); _Pragma("unroll") for (int m = 0; m < 4; ++m) _Pragma("unroll") for (int n = 0; n < 2; ++n) _Pragma("unroll") for (int k = 0; k < 2; ++k) \
        acc[ai][bj][m][n] = __builtin_amdgcn_mfma_f32_16x16x32_bf16(Bt[n][k], At[m][k], acc[ai][bj][m][n], 0, 0, 0); __builtin_amdgcn_s_setprio(0); } while (0)
#define PG8_WAIT_V(n) asm volatile("s_waitcnt vmcnt(" #n ")" ::: "memory")
#define PG8_WAIT_L(n) asm volatile("s_waitcnt lgkmcnt(" #n ")" ::: "memory")
#define PG8_BAR __builtin_amdgcn_s_barrier()
#define PG8_SCHED __builtin_amdgcn_sched_barrier(0)
    Unit cur, nxt; int ui = 0;
    if (!S.next(0, cur)) return;
    unsigned vA[2][2], vN[2][2];
#pragma unroll
    for (int h = 0; h < 2; ++h)
#pragma unroll
        for (int i = 0; i < 2; ++i) { vA[h][i] = (Sched::GATHER ? S.row_off(0, h * HALF + Rr[i]) : (unsigned)(h * HALF + Rr[i]) * S.lda) + Cb[i]; vN[h][i] = vA[h][i]; }
    f32x4 acc[2][2][4][2];
#pragma unroll
    for (int a = 0; a < 2; ++a)
#pragma unroll
        for (int b = 0; b < 2; ++b)
#pragma unroll
            for (int m = 0; m < 4; ++m)
#pragma unroll
                for (int n = 0; n < 2; ++n) acc[a][b][m][n] = (f32x4){0.f, 0.f, 0.f, 0.f};
    bf16x8 At[4][2], B0[2][2], B1[2][2];
    const char* cA = S.a_base(cur); const char* cB = S.b_base(cur);
    PG8_STAGE_B(PG8_SB(0, 0), cB); PG8_STAGE_A(PG8_SA(0, 0), cA, vA, 0, 0u); PG8_STAGE_B(PG8_SB(0, 1), cB + hstepB); PG8_STAGE_A(PG8_SA(0, 1), cA, vA, 1, 0u);
    if (wr == 1) PG8_BAR;
    PG8_WAIT_V(4); PG8_BAR;
    PG8_STAGE_B(PG8_SB(1, 0), cB + kstepB); PG8_STAGE_A(PG8_SA(1, 0), cA, vA, 0, kstepA); PG8_STAGE_B(PG8_SB(1, 1), cB + hstepB + kstepB);
    PG8_WAIT_V(6); PG8_BAR;
    for (;;) {
        const bool has_next = S.next(ui + 1, nxt);
        const char* nA = has_next ? S.a_base(nxt) : cA; const char* nB = has_next ? S.b_base(nxt) : cB;
        if (Sched::GATHER) {
#pragma unroll
            for (int h = 0; h < 2; ++h)
#pragma unroll
                for (int i = 0; i < 2; ++i) vN[h][i] = has_next ? (S.row_off(ui + 1, h * HALF + Rr[i]) + Cb[i]) : vA[h][i];
        }
        for (int t = 0; t < nt; t += 2) {
            const bool last = (t == nt - 2);
            const unsigned k1 = (unsigned)(t + 1) * kstepA;
            const char* a2p = last ? nA : cA; const unsigned k2 = last ? 0u : (unsigned)(t + 2) * kstepA;
            unsigned v2[2][2];
#pragma unroll
            for (int h = 0; h < 2; ++h)
#pragma unroll
                for (int i = 0; i < 2; ++i) v2[h][i] = (Sched::GATHER && last) ? vN[h][i] : vA[h][i];
            const char* b2 = last ? nB : cB + (size_t)(t + 2) * kstepB; const char* b3 = b2 + kstepB;
            PG8_LDB(B0, 0, 0); PG8_SCHED; PG8_LDA(At, 0, 0); PG8_STAGE_A(PG8_SA(1, 1), cA, vA, 1, k1);
            PG8_WAIT_L(8); PG8_BAR; PG8_WAIT_L(0); PG8_MMA(0, 0, At, B0); PG8_BAR; PG8_SCHED;
            PG8_LDB(B1, 0, 1); PG8_STAGE_B(PG8_SB(0, 0), b2);
            PG8_BAR; PG8_WAIT_L(0); PG8_MMA(0, 1, At, B1); PG8_BAR;
            PG8_LDA(At, 0, 1); PG8_STAGE_A(PG8_SA(0, 0), a2p, v2, 0, k2);
            PG8_BAR; PG8_WAIT_L(0); PG8_MMA(1, 0, At, B0); PG8_BAR; PG8_SCHED;
            PG8_STAGE_B(PG8_SB(0, 1), b2 + hstepB);
            PG8_WAIT_V(6); PG8_BAR; PG8_MMA(1, 1, At, B1); PG8_BAR;
            PG8_LDB(B0, 1, 0); PG8_SCHED; PG8_LDA(At, 1, 0); PG8_STAGE_A(PG8_SA(0, 1), a2p, v2, 1, k2);
            PG8_WAIT_L(8); PG8_BAR; PG8_WAIT_L(0); PG8_MMA(0, 0, At, B0); PG8_BAR; PG8_SCHED;
            PG8_LDB(B1, 1, 1); PG8_STAGE_B(PG8_SB(1, 0), b3);
            PG8_BAR; PG8_WAIT_L(0); PG8_MMA(0, 1, At, B1); PG8_BAR;
            PG8_LDA(At, 1, 1); PG8_STAGE_A(PG8_SA(1, 0), a2p, v2, 0, k2 + kstepA);
            PG8_BAR; PG8_WAIT_L(0); PG8_MMA(1, 0, At, B0); PG8_BAR; PG8_SCHED;
            PG8_STAGE_B(PG8_SB(1, 1), b3 + hstepB);
            PG8_WAIT_V(6); PG8_BAR; PG8_MMA(1, 1, At, B1); PG8_BAR;
        }
        E(acc, cur, wr, wc, fr, fq);
        if (!has_next) break;
#pragma unroll
        for (int a = 0; a < 2; ++a)
#pragma unroll
            for (int b = 0; b < 2; ++b)
#pragma unroll
                for (int m = 0; m < 4; ++m)
#pragma unroll
                    for (int n = 0; n < 2; ++n) acc[a][b][m][n] = (f32x4){0.f, 0.f, 0.f, 0.f};
        cur = nxt; cA = nA; cB = nB; ++ui;
#pragma unroll
        for (int h = 0; h < 2; ++h)
#pragma unroll
            for (int i = 0; i < 2; ++i) vA[h][i] = vN[h][i];
    }
    PG8_WAIT_V(0);
    if (wr == 0) PG8_BAR;
    PG8_BAR;
#undef PG8_SA
#undef PG8_SB
#undef PG8_STAGE_A
#undef PG8_STAGE_B
#undef PG8_LDA
#undef PG8_LDB
#undef PG8_MMA
#undef PG8_WAIT_V
#undef PG8_WAIT_L
#undef PG8_BAR
#undef PG8_SCHED
}

struct EpiStore {
    bf16_t* O; size_t ldc;
    DI void operator()(const f32x4 (&acc)[2][2][4][2], const Unit& u, int wr, int wc, int fr, int fq) const {
        const int row0 = u.pm * BM + wr * 64 + fr, col0 = u.pn * BM + wc * 32 + 8 * fq;
#pragma unroll
        for (int ai = 0; ai < 2; ++ai)
#pragma unroll
            for (int m = 0; m < 4; ++m) { bf16_t* rowp = O + (size_t)(row0 + ai * HALF + m * 16) * ldc + col0;
#pragma unroll
                for (int bj = 0; bj < 2; ++bj) { const f32x4 v0 = acc[ai][bj][m][0], v1 = acc[ai][bj][m][1];
                    u32x4 w; w.x = cvt_pk_bf16(v0[0], v0[1]); w.y = cvt_pk_bf16(v0[2], v0[3]); w.z = cvt_pk_bf16(v1[0], v1[1]); w.w = cvt_pk_bf16(v1[2], v1[3]);
                    *(u32x4*)(rowp + bj * HALF) = w; } }
    }
};
struct EpiSwiglu {
    bf16_t* Hb;
    DI void operator()(const f32x4 (&acc)[2][2][4][2], const Unit& u, int wr, int wc, int fr, int fq) const {
        const int row0 = u.pm * BM + wr * 64 + fr, col0 = u.pn * HALF + wc * 32 + 8 * fq;
#pragma unroll
        for (int ai = 0; ai < 2; ++ai)
#pragma unroll
            for (int m = 0; m < 4; ++m) { bf16_t* rowp = Hb + (size_t)(row0 + ai * HALF + m * 16) * DEXP + col0;
                float o[8];
#pragma unroll
                for (int n = 0; n < 2; ++n)
#pragma unroll
                    for (int j = 0; j < 4; ++j) { const float g = acc[ai][0][m][n][j], up = acc[ai][1][m][n][j];
                        o[n * 4 + j] = g * up * __builtin_amdgcn_rcpf(1.0f + __builtin_amdgcn_exp2f(-1.4426950408889634f * g)); }
                u32x4 w; w.x = cvt_pk_bf16(o[0], o[1]); w.y = cvt_pk_bf16(o[2], o[3]); w.z = cvt_pk_bf16(o[4], o[5]); w.w = cvt_pk_bf16(o[6], o[7]);
                *(u32x4*)rowp = w; }
    }
};

struct EpiNsa {
    bf16_t* Q; bf16_t* KV; float* GT;
    DI void operator()(const f32x4 (&acc)[2][2][4][2], const Unit& u, int wr, int wc, int fr, int fq) const {
        const int row0 = u.pm * BM + wr * 64 + fr;
        if (u.pn < 10) {
            bf16_t* base = (u.pn < 4) ? Q + u.pn * BM : KV + (u.pn - 4) * BM; const size_t ldc = (u.pn < 4) ? 1024 : 1536; const int col0 = wc * 32 + 8 * fq;
#pragma unroll
            for (int ai = 0; ai < 2; ++ai)
#pragma unroll
                for (int m = 0; m < 4; ++m) { bf16_t* rowp = base + (size_t)(row0 + ai * HALF + m * 16) * ldc + col0;
#pragma unroll
                    for (int bj = 0; bj < 2; ++bj) { const f32x4 v0 = acc[ai][bj][m][0], v1 = acc[ai][bj][m][1];
                        u32x4 w; w.x = cvt_pk_bf16(v0[0], v0[1]); w.y = cvt_pk_bf16(v0[2], v0[3]); w.z = cvt_pk_bf16(v1[0], v1[1]); w.w = cvt_pk_bf16(v1[2], v1[3]);
                        *(u32x4*)(rowp + bj * HALF) = w; } }
        } else {
            const int col0 = wc * 32 + 8 * fq;
            if (col0 < 48) {
#pragma unroll
                for (int ai = 0; ai < 2; ++ai)
#pragma unroll
                    for (int m = 0; m < 4; ++m) { float* rowp = GT + (size_t)(row0 + ai * HALF + m * 16) * 48 + col0;
#pragma unroll
                        for (int n = 0; n < 2; ++n) { f32x4 v = acc[ai][0][m][n];
#pragma unroll
                            for (int j = 0; j < 4; ++j) v[j] = __builtin_amdgcn_rcpf(1.0f + __builtin_amdgcn_exp2f(-1.4426950408889634f * v[j]));
                            *(f32x4*)(rowp + 4 * n) = v; } }
            }
        }
    }
};
struct EpiCmp {
    bf16_t* Hd; const float* bias;
    DI void operator()(const f32x4 (&acc)[2][2][4][2], const Unit& u, int wr, int wc, int fr, int fq) const {
        const int row0 = u.pm * BM + wr * 64 + fr, col0 = wc * 32 + 8 * fq; const float* bp = bias + u.e * 256;
#pragma unroll
        for (int bj = 0; bj < 2; ++bj) { const f32x4 b0 = *(const f32x4*)(bp + bj * HALF + col0), b1 = *(const f32x4*)(bp + bj * HALF + col0 + 4);
#pragma unroll
            for (int ai = 0; ai < 2; ++ai)
#pragma unroll
                for (int m = 0; m < 4; ++m) { float o[8];
#pragma unroll
                    for (int j = 0; j < 4; ++j) { o[j] = acc[ai][bj][m][0][j] + b0[j]; o[4 + j] = acc[ai][bj][m][1][j] + b1[j]; }
#pragma unroll
                    for (int j = 0; j < 8; ++j) { const float x = o[j], u2 = 1.5957691216057308f * (x + 0.044715f * x * x * x); o[j] = x * __builtin_amdgcn_rcpf(1.0f + __builtin_amdgcn_exp2f(-1.4426950408889634f * u2)); }
                    u32x4 w; w.x = cvt_pk_bf16(o[0], o[1]); w.y = cvt_pk_bf16(o[2], o[3]); w.z = cvt_pk_bf16(o[4], o[5]); w.w = cvt_pk_bf16(o[6], o[7]);
                    *(u32x4*)(Hd + (size_t)(row0 + ai * HALF + m * 16) * 256 + bj * HALF + col0) = w; } }
    }
};
struct CmpSched {
    static constexpr bool GATHER = false;
    const char* kv6; const char* Bt; int K; unsigned lda, kstepA; int G, c;
    DI bool next(int i, Unit& u) const { const int L = i * G + c; if (L >= 64) return false; u.pm = L; u.pn = 0; u.e = L >> 5; return true; }
    DI const char* a_base(const Unit& u) const { const int j = u.pm >> 5, bg = (u.pm >> 2) & 7, cq = u.pm & 3, b = bg >> 2, g = bg & 3;
        return kv6 + (((size_t)b * SEQ + (size_t)cq * 4096) * 1536 + j * 256 + g * 64) * 2; }
    DI const char* b_base(const Unit& u) const { return Bt + (size_t)(u.pm >> 5) * 256 * 2048 * 2; }
    DI unsigned row_off(int, int) const { return 0u; }
};
}

struct MoeMeta { LAS int* tstart; LAS int* cnt; };
DI int moe_expert_of(const MoeMeta& mm, int rt) { int e = 0;
#pragma unroll
    for (int k = 1; k < 16; ++k) e += (rt >= mm.tstart[k]) ? 1 : 0;
    return e; }
struct Moe1Sched {
    static constexpr bool GATHER = true;
    const char* A; const char* Bt; int K; unsigned lda, kstepA; MoeMeta mm; int ntiles, G, c; LAS unsigned* tab;
    DI bool next(int i, pg8::Unit& u) const { const int L = i * G + c; if (L >= ntiles * 2) return false; u.pm = L % ntiles; u.pn = L / ntiles; u.e = moe_expert_of(mm, u.pm); return true; }
    DI const char* a_base(const pg8::Unit&) const { return A; }
    DI const char* b_base(const pg8::Unit& u) const { return Bt + ((size_t)u.e * 512 + (size_t)u.pn * 256) * 1024 * 2; }
    DI unsigned row_off(int slot, int row) const { return tab[slot * 256 + row]; }
};
struct Moe2Sched {
    static constexpr bool GATHER = false;
    const char* A; const char* Bt; int K; unsigned lda, kstepA; MoeMeta mm; int ntiles, G, c;
    DI bool next(int i, pg8::Unit& u) const { const int L = i * G + c; if (L >= ntiles * 4) return false; u.pm = L % ntiles; u.pn = L / ntiles; u.e = moe_expert_of(mm, u.pm); return true; }
    DI const char* a_base(const pg8::Unit& u) const { return A + (size_t)u.pm * 256 * 512; }
    DI const char* b_base(const pg8::Unit& u) const { return Bt + ((size_t)u.e * 1024 + (size_t)u.pn * 256) * 256 * 2; }
    DI unsigned row_off(int, int) const { return 0u; }
};

struct Args { const float* in[25]; float* out; unsigned char* ws; int wv; int pad; };
enum { IN_X = 0, IN_REL, IN_RW, IN_RB, IN_LN1G, IN_LN1B, IN_LN2G, IN_LN2B, IN_EG, IN_EU, IN_ED, IN_DILIN, IN_DILOUT, IN_SBIN, IN_SBOUT,
       IN_NSAIN, IN_NSAOUT, IN_POSK, IN_W1K, IN_W2K, IN_POSV, IN_W1V, IN_W2V, IN_MOBAIN, IN_MOBAOUT };

DI void transpose_item(const float* W, int K, int N, int Nvalid, bf16_t* WT, int drow0, LAS float* scr, int kb, int nb, int lane) {
    const int k0 = 64 * kb, n0 = 32 * nb;
    const int c4 = lane & 7, kr = lane >> 3;
    if (n0 + 32 <= Nvalid) {
#pragma unroll
        for (int i = 0; i < 8; ++i) { const f32x4 v = *(const f32x4*)(W + (size_t)(k0 + kr + 8 * i) * N + n0 + 4 * c4); LAS float* s = scr + (kr + 8 * i) * 33 + 4 * c4;
            s[0] = v.x; s[1] = v.y; s[2] = v.z; s[3] = v.w; }
    } else {
#pragma unroll 8
        for (int i = 0; i < 32; ++i) { const int kk = 2 * i + (lane >> 5); const int n = n0 + (lane & 31); scr[kk * 33 + (lane & 31)] = (n < Nvalid) ? W[(size_t)(k0 + kk) * N + n] : 0.f; }
    }
    LDS_WAIT(); asm volatile("" ::: "memory");
    const int c = lane & 7;
#pragma unroll
    for (int j = 0; j < 4; ++j) { const int n = (lane >> 3) + 8 * j; const LAS float* s = scr + (8 * c) * 33 + n;
        u32x4 o; o.x = pk2(s[0 * 33], s[1 * 33]); o.y = pk2(s[2 * 33], s[3 * 33]); o.z = pk2(s[4 * 33], s[5 * 33]); o.w = pk2(s[6 * 33], s[7 * 33]);
        *(u32x4*)(WT + (size_t)(drow0 + n) * K + k0 + 8 * c) = o; }
    LDS_WAIT(); asm volatile("" ::: "memory");
}
DI void convert_matrix(const float* W, int K, int N, int Npad, bf16_t* WT, LAS float* scr, int gw, int NGW, int lane) {
    const int nblk = Npad / 32, nitems = (K / 64) * nblk;
    for (int it = gw; it < nitems; it += NGW) { const int kb = it / nblk, nb = it % nblk; transpose_item(W, K, N, N, WT, 32 * nb, scr, kb, nb, lane); }
}
DI void convert_layer_weights(const Args& a, int layer, LAS unsigned char* lds, int gw, int NGW, int wave, int lane) {
    LAS float* scr = (LAS float*)(lds + STAGE_OFF + wave * 16384);
    bf16_t* W1 = (bf16_t*)(a.ws + WS_WEXP1); bf16_t* W2 = (bf16_t*)(a.ws + WS_WEXP2);
    const float* eg = a.in[IN_EG] + (size_t)layer * NE * D * DEXP; const float* eu = a.in[IN_EU] + (size_t)layer * NE * D * DEXP; const float* ed = a.in[IN_ED] + (size_t)layer * NE * DEXP * D;
    constexpr int I_G = (D / 64) * (DEXP / 32);
    constexpr int I_D = (DEXP / 64) * (D / 32);
    constexpr int I_E = 2 * I_G + I_D;
    {
        bf16_t* Win = (bf16_t*)(a.ws + WS_WIN); bf16_t* Wout = (bf16_t*)(a.ws + WS_WOUT);
        if (layer == 0) { convert_matrix(a.in[IN_DILIN], D, 9216, 9216, Win, scr, gw, NGW, lane); convert_matrix(a.in[IN_DILOUT], D, D, D, Wout, scr, gw, NGW, lane); }
        if (layer == 1) { convert_matrix(a.in[IN_SBIN], D, 3072, 3072, Win, scr, gw, NGW, lane); convert_matrix(a.in[IN_SBOUT], D, D, D, Wout, scr, gw, NGW, lane); }
        if (layer == 2) { convert_matrix(a.in[IN_NSAIN], D, 2608, 2816, Win, scr, gw, NGW, lane); convert_matrix(a.in[IN_NSAOUT], D, D, D, Wout, scr, gw, NGW, lane);
            bf16_t* wc = (bf16_t*)(a.ws + WS_WCMP);
            convert_matrix(a.in[IN_W1K], 2048, 256, 256, wc, scr, gw, NGW, lane); convert_matrix(a.in[IN_W1V], 2048, 256, 256, wc + 256 * 2048, scr, gw, NGW, lane);
            convert_matrix(a.in[IN_W2K], 256, 64, 64, wc + 2 * 256 * 2048, scr, gw, NGW, lane); convert_matrix(a.in[IN_W2V], 256, 64, 64, wc + 2 * 256 * 2048 + 64 * 256, scr, gw, NGW, lane);
            float* cb = (float*)(a.ws + WS_WCMP + 2 * MiB + 64 * 1024);
            for (int it = gw; it < 512; it += NGW) { const int j = it >> 8, n = it & 255; const float* pos = a.in[j ? IN_POSV : IN_POSK]; const float* w1 = a.in[j ? IN_W1V : IN_W1K];
                float s = 0.f; for (int k = lane; k < 2048; k += 64) s += pos[k] * w1[(size_t)k * 256 + n];
                s = wave_sum(s); if (lane == 0) cb[it] = s; } }
        if (layer == 3) { convert_matrix(a.in[IN_MOBAIN], D, 3072, 3072, Win, scr, gw, NGW, lane); convert_matrix(a.in[IN_MOBAOUT], D, D, D, Wout, scr, gw, NGW, lane); }
    }
    const int NITEMS = NE * I_E;
    for (int it = gw; it < NITEMS; it += NGW) {
        const int e = it / I_E; int r = it % I_E;
        if (r < I_G) { const int kb = r / (DEXP / 32), nb = r % (DEXP / 32); const int n0 = 32 * nb;
            transpose_item(eg + (size_t)e * D * DEXP, D, DEXP, DEXP, W1, e * 512 + ((n0 >> 7) << 8) + (n0 & 127), scr, kb, nb, lane); continue; }
        r -= I_G;
        if (r < I_G) { const int kb = r / (DEXP / 32), nb = r % (DEXP / 32); const int n0 = 32 * nb;
            transpose_item(eu + (size_t)e * D * DEXP, D, DEXP, DEXP, W1, e * 512 + ((n0 >> 7) << 8) + 128 + (n0 & 127), scr, kb, nb, lane); continue; }
        r -= I_G;
        { const int kb = r / (D / 32), nb = r % (D / 32);
          transpose_item(ed + (size_t)e * DEXP * D, DEXP, D, D, W2, e * 1024 + 32 * nb, scr, kb, nb, lane); }
    }
}

struct RowVec { f32x4 v[4]; };
DI void ln_stats(const RowVec& r, float& mean, float& rstd) {
    float s = 0.f;
#pragma unroll
    for (int j = 0; j < 4; ++j) s += (r.v[j].x + r.v[j].y) + (r.v[j].z + r.v[j].w);
    mean = wave_sum(s) * (1.f / D); float s2 = 0.f;
#pragma unroll
    for (int j = 0; j < 4; ++j) { const f32x4 d = r.v[j] - mean; s2 += (d.x * d.x + d.y * d.y) + (d.z * d.z + d.w * d.w); }
    rstd = 1.f / sqrtf(wave_sum(s2) * (1.f / D) + LN_EPS);
}


constexpr int KSTR = 144;
constexpr int KVT = 64;
constexpr int KV_TILE_BYTES = KVT * KSTR;
constexpr float LOG2E = 1.4426950408889634f, LN2F = 0.6931471805599453f;
DI f32x16 mfma32(bf16x8 a, bf16x8 b, f32x16 c) { return __builtin_amdgcn_mfma_f32_32x32x16_bf16(a, b, c, 0, 0, 0); }
DI f32x16 zero16() { f32x16 z; for (int i = 0; i < 16; ++i) z[i] = 0.f; return z; }
DI void kv_fetch(u32x4& kr, u32x4& vr, const bf16_t* kb, const bf16_t* vb, size_t rstride, int row0, int nrows, int tid) {
    asm volatile("" : "+v"(tid));
    const int row = row0 + (tid >> 3), c16 = tid & 7;
    if (row >= 0 && row < nrows) { kr = *(const u32x4*)(kb + (size_t)row * rstride + c16 * 8); vr = *(const u32x4*)(vb + (size_t)row * rstride + c16 * 8); }
    else { kr = (u32x4){0u, 0u, 0u, 0u}; vr = kr; }
}
DI void kv_store(LAS unsigned char* kl, LAS unsigned char* vl, const u32x4& kr, const u32x4& vr, int tid) {
    asm volatile("" ::: "memory"); __builtin_amdgcn_sched_barrier(0);
    asm volatile("" : "+v"(tid));
    const int off = (tid >> 3) * KSTR + (tid & 7) * 16;
    *(LAS u32x4*)(kl + off) = kr; *(LAS u32x4*)(vl + off) = vr;
}
constexpr int DT_BYTES = 16384;
DI void kv_dma_issue(LAS unsigned char* slot, const bf16_t* kb, const bf16_t* vb, size_t rstride, int row0, int nrows, int wave, int lane) {
    asm volatile("" : "+v"(lane));
    const int rr = lane >> 3, row = min(max(row0 + 8 * wave + rr, 0), nrows - 1), ch = (lane & 7) ^ rr;
    const size_t off = (size_t)row * rstride + ch * 8;
    __builtin_amdgcn_global_load_lds((const unsigned*)(kb + off), (LAS unsigned*)(slot + wave * 1024), 16, 0, 0);
    __builtin_amdgcn_global_load_lds((const unsigned*)(vb + off), (LAS unsigned*)(slot + 8192 + wave * 1024), 16, 0, 0);
}
DI f32x16 qk_tile_sw(const LAS unsigned char* kl, int kt, const bf16x8 (&Q)[4], int lane) {
    asm volatile("" : "+v"(lane));
    const int r = lane & 31, h = lane >> 5;
    const int pr = (r & ~12) | ((r & 4) << 1) | ((r & 8) >> 1), sw = pr & 7;
    const LAS unsigned char* p = kl + (kt * 32 + pr) * 128;
    f32x16 S = zero16();
#pragma unroll
    for (int ks = 0; ks < 4; ++ks) { const bf16x8 A = *(const LAS bf16x8*)(p + (((2 * ks + h) ^ sw) << 4)); S = mfma32(A, Q[ks], S); }
    return S;
}
DI void pv_tile_sw(const LAS unsigned char* vl, int kt, const f32x16& P, f32x16 (&O)[2], int lane) {
    asm volatile("" : "+v"(lane));
    const int i16 = lane & 15, q = i16 >> 2, p = i16 & 3, blk = (lane >> 4) & 1, h = lane >> 5;
    const unsigned vp = (unsigned)(size_t)(vl + (kt * 32 + 8 * h + q) * 128 + 8 * (p & 1));
    const int c0 = 2 * blk + (p >> 1), c1 = 4 + c0;
    const unsigned a0 = vp + ((c0 ^ q) << 4), a1 = vp + 512 + ((c0 ^ (q + 4)) << 4), a2 = vp + ((c1 ^ q) << 4), a3 = vp + 512 + ((c1 ^ (q + 4)) << 4);
    s16x4 lo0, hi0, lo1, hi1, lo2, hi2, lo3, hi3;
    asm volatile("ds_read_b64_tr_b16 %0, %8\n\tds_read_b64_tr_b16 %1, %9\n\tds_read_b64_tr_b16 %2, %10\n\tds_read_b64_tr_b16 %3, %11\n\t"
                 "ds_read_b64_tr_b16 %4, %8 offset:2048\n\tds_read_b64_tr_b16 %5, %9 offset:2048\n\tds_read_b64_tr_b16 %6, %10 offset:2048\n\tds_read_b64_tr_b16 %7, %11 offset:2048\n\ts_waitcnt lgkmcnt(0)"
                 : "=&v"(lo0), "=&v"(hi0), "=&v"(lo1), "=&v"(hi1), "=&v"(lo2), "=&v"(hi2), "=&v"(lo3), "=&v"(hi3) : "v"(a0), "v"(a1), "v"(a2), "v"(a3) : "memory");
    { u32x4 pk; pk.x = cvt_pk_bf16(P[0], P[1]); pk.y = cvt_pk_bf16(P[2], P[3]); pk.z = cvt_pk_bf16(P[4], P[5]); pk.w = cvt_pk_bf16(P[6], P[7]);
      const bf16x8 Bp = __builtin_bit_cast(bf16x8, pk);
      O[0] = mfma32(__builtin_shufflevector(lo0, hi0, 0, 1, 2, 3, 4, 5, 6, 7), Bp, O[0]);
      O[1] = mfma32(__builtin_shufflevector(lo1, hi1, 0, 1, 2, 3, 4, 5, 6, 7), Bp, O[1]); }
    { u32x4 pk; pk.x = cvt_pk_bf16(P[8], P[9]); pk.y = cvt_pk_bf16(P[10], P[11]); pk.z = cvt_pk_bf16(P[12], P[13]); pk.w = cvt_pk_bf16(P[14], P[15]);
      const bf16x8 Bp = __builtin_bit_cast(bf16x8, pk);
      O[0] = mfma32(__builtin_shufflevector(lo2, hi2, 0, 1, 2, 3, 4, 5, 6, 7), Bp, O[0]);
      O[1] = mfma32(__builtin_shufflevector(lo3, hi3, 0, 1, 2, 3, 4, 5, 6, 7), Bp, O[1]); }
}
template <int NS, class RowF, class CompF>
DI void kv_dma_pipeline(int n, const RowF& rowf, const CompF& comp, const bf16_t* kb, const bf16_t* vb, size_t rstride, int nrows, LAS unsigned char* ring, int wave, int lane) {
    if (n <= 0) return;
#pragma unroll
    for (int i = 0; i < NS - 1; ++i) if (i < n) kv_dma_issue(ring + i * DT_BYTES, kb, vb, rstride, rowf(i), nrows, wave, lane);
    int sc = 0, sn = NS - 1;
#pragma unroll 1
    for (int j = 0; j < n; ++j) {
        const int rem = min(n - 1 - j, NS - 2);
        if (rem >= 4) asm volatile("s_waitcnt vmcnt(8)" ::: "memory");
        else if (rem == 3) asm volatile("s_waitcnt vmcnt(6)" ::: "memory");
        else if (rem == 2) asm volatile("s_waitcnt vmcnt(4)" ::: "memory");
        else if (rem == 1) asm volatile("s_waitcnt vmcnt(2)" ::: "memory");
        else asm volatile("s_waitcnt vmcnt(0)" ::: "memory");
        __builtin_amdgcn_s_barrier(); asm volatile("" ::: "memory");
        comp(j, ring + sc * DT_BYTES, ring + sc * DT_BYTES + 8192);
        if (j + NS - 1 < n) kv_dma_issue(ring + sn * DT_BYTES, kb, vb, rstride, rowf(j + NS - 1), nrows, wave, lane);
        sc = (sc + 1 == NS) ? 0 : sc + 1; sn = (sn + 1 == NS) ? 0 : sn + 1;
    }
    asm volatile("s_waitcnt lgkmcnt(0)" ::: "memory"); __builtin_amdgcn_s_barrier(); asm volatile("" ::: "memory");
}
template <int NS, class IssueF, class CompF>
DI void kv_dma_stream(int n, const IssueF& issue, const CompF& comp, LAS unsigned char* ring) {
    if (n <= 0) return;
#pragma unroll
    for (int i = 0; i < NS - 1; ++i) if (i < n) issue(i, ring + i * DT_BYTES);
    int sc = 0, sn = NS - 1;
#pragma unroll 1
    for (int j = 0; j < n; ++j) {
        const int rem = min(n - 1 - j, NS - 2);
        if (rem >= 4) asm volatile("s_waitcnt vmcnt(8)" ::: "memory");
        else if (rem == 3) asm volatile("s_waitcnt vmcnt(6)" ::: "memory");
        else if (rem == 2) asm volatile("s_waitcnt vmcnt(4)" ::: "memory");
        else if (rem == 1) asm volatile("s_waitcnt vmcnt(2)" ::: "memory");
        else asm volatile("s_waitcnt vmcnt(0)" ::: "memory");
        __builtin_amdgcn_s_barrier(); asm volatile("" ::: "memory");
        comp(j, ring + sc * DT_BYTES, ring + sc * DT_BYTES + 8192);
        if (j + NS - 1 < n) issue(j + NS - 1, ring + sn * DT_BYTES);
        sc = (sc + 1 == NS) ? 0 : sc + 1; sn = (sn + 1 == NS) ? 0 : sn + 1;
    }
    asm volatile("s_waitcnt lgkmcnt(0)" ::: "memory"); __builtin_amdgcn_s_barrier(); asm volatile("" ::: "memory");
}
DI f32x16 qk_tile(const LAS unsigned char* kl, int kt, const bf16x8 (&Q)[4], int lane) {
    asm volatile("" : "+v"(lane));
    const int r = lane & 31, h = lane >> 5;
    const int pr = (r & ~12) | ((r & 4) << 1) | ((r & 8) >> 1);
    const LAS unsigned char* p = kl + (kt * 32 + pr) * KSTR + h * 16;
    f32x16 S = zero16();
#pragma unroll
    for (int ks = 0; ks < 4; ++ks) { const bf16x8 A = *(const LAS bf16x8*)(p + ks * 32); S = mfma32(A, Q[ks], S); }
    return S;
}
DI void pv_tile(const LAS unsigned char* vl, int kt, const f32x16& P, f32x16 (&O)[2], int lane) {
    asm volatile("" : "+v"(lane));
    const int i16 = lane & 15, q = i16 >> 2, p = i16 & 3, blk = (lane >> 4) & 1, h = lane >> 5;
#pragma unroll
    for (int s = 0; s < 2; ++s) {
        u32x4 pk; pk.x = cvt_pk_bf16(P[8 * s + 0], P[8 * s + 1]); pk.y = cvt_pk_bf16(P[8 * s + 2], P[8 * s + 3]); pk.z = cvt_pk_bf16(P[8 * s + 4], P[8 * s + 5]); pk.w = cvt_pk_bf16(P[8 * s + 6], P[8 * s + 7]);
        const bf16x8 Bp = __builtin_bit_cast(bf16x8, pk);
        const LAS unsigned char* vp = vl + (kt * 32 + 16 * s + 8 * h + q) * KSTR + (16 * blk + 4 * p) * 2;
#pragma unroll
        for (int dt = 0; dt < 2; ++dt) {
            const s16x4 lo = __builtin_amdgcn_ds_read_tr16_b64_v4i16((LAS s16x4*)(vp + dt * 64));
            const s16x4 hi = __builtin_amdgcn_ds_read_tr16_b64_v4i16((LAS s16x4*)(vp + dt * 64 + 4 * KSTR));
            const bf16x8 A = __builtin_shufflevector(lo, hi, 0, 1, 2, 3, 4, 5, 6, 7);
            O[dt] = mfma32(A, Bp, O[dt]);
        }
    }
}
DI void store_o(bf16_t* orow, const f32x16 (&O)[2], float sc, int h) {
#pragma unroll
    for (int dt = 0; dt < 2; ++dt)
#pragma unroll
        for (int g = 0; g < 4; ++g) { u32x2 w; w.x = cvt_pk_bf16(O[dt][4 * g] * sc, O[dt][4 * g + 1] * sc); w.y = cvt_pk_bf16(O[dt][4 * g + 2] * sc, O[dt][4 * g + 3] * sc);
            *(u32x2*)(orow + dt * 32 + 8 * g + 4 * h) = w; }
}

constexpr int BT_PAD = 128, BT_LEN = BT_PAD + 2048;
constexpr int DIST_ANY = 0x3fffffff, DIST_NONE = 0x40000000;
constexpr size_t WS_RW = WS_SMALL;
constexpr size_t WS_BIASG = WS_SMALL + 256 * 1024;
DI void load_bias_table(LAS float* dst, const float* biasG, int head, int dsh, int tid, int hicut = 0x3fffffff) {
    for (int i = tid; i < BT_LEN; i += NTHR) { const int n = i - BT_PAD; dst[i] = (n >= 0 && n <= hicut) ? biasG[head * 2048 + min(n << dsh, 2047)] : -1e30f; }
}
template <int STRIDE, bool MASKED>
DI float logits_tile(f32x16 (&S)[2], const LAS float* P, int D0, int h, int lo, unsigned range) {
    float mx = -1e30f;
    if (!MASKED && __all(D0 - 63 * STRIDE >= 1512)) {
        const float cb = P[BT_PAD + 2047];
#pragma unroll
        for (int sub = 0; sub < 2; ++sub)
#pragma unroll
            for (int i = 0; i < 16; ++i) { const float x = S[sub][i] * (0.125f * LOG2E) + cb; S[sub][i] = x; mx = fmaxf(mx, x); }
        return mx;
    }
#pragma unroll
    for (int sub = 0; sub < 2; ++sub)
#pragma unroll
        for (int s = 0; s < 2; ++s) {
            const int d0 = D0 - (32 * sub + 16 * s + 8 * h) * STRIDE;
            const int base = min(max(d0 - 7 * STRIDE + BT_PAD, 0), BT_LEN - 1 - 7 * STRIDE);
            const LAS float* pb = P + base;
#pragma unroll
            for (int j = 0; j < 8; ++j) { const int i = 8 * s + j;
                float x = S[sub][i] * (0.125f * LOG2E) + pb[(7 - j) * STRIDE];
                if (MASKED) x = ((unsigned)(d0 - j * STRIDE - lo) <= range) ? x : -1e30f;
                S[sub][i] = x; mx = fmaxf(mx, x); }
        }
    return mx;
}
template <int STRIDE, bool MASKED>
DI void softmax_tile(f32x16 (&S)[2], float& m, float& l, f32x16 (&O)[2], const LAS float* P, int D0, int h, int lo, unsigned range) {
    float mx = logits_tile<STRIDE, MASKED>(S, P, D0, h, lo, range);
    mx = fmaxf(mx, xor32h(mx, h));
    const float mnew = fmaxf(m, mx), mm = (mnew <= -1e30f) ? 0.f : mnew;
    float ls = 0.f;
#pragma unroll
    for (int sub = 0; sub < 2; ++sub)
#pragma unroll
        for (int i = 0; i < 16; ++i) { const float p = __builtin_amdgcn_exp2f(S[sub][i] - mm); S[sub][i] = p; ls += p; }
    ls += xor32h(ls, h);
    if (!__all(mnew == m)) {
        const float alpha = __builtin_amdgcn_exp2f(m - mnew);
        l *= alpha;
#pragma unroll
        for (int dt = 0; dt < 2; ++dt)
#pragma unroll
            for (int i = 0; i < 16; ++i) O[dt][i] *= alpha;
    }
    l += ls; m = mnew;
}
template <int STRIDE, bool MASKED>
DI void stats_tile(f32x16 (&S)[2], float& m, float& l, const LAS float* P, int D0, int h, int lo, unsigned range) {
    float mx = logits_tile<STRIDE, MASKED>(S, P, D0, h, lo, range);
    mx = fmaxf(mx, xor32h(mx, h));
    const float mnew = fmaxf(m, mx), mm = (mnew <= -1e30f) ? 0.f : mnew;
    float ls = 0.f;
#pragma unroll
    for (int sub = 0; sub < 2; ++sub)
#pragma unroll
        for (int i = 0; i < 16; ++i) ls += __builtin_amdgcn_exp2f(S[sub][i] - mm);
    ls += xor32h(ls, h);
    l = l * __builtin_amdgcn_exp2f(m - mnew) + ls; m = mnew;
}

constexpr size_t BIG_OG = 288 * MiB;
constexpr size_t BIG_LSE = 384 * MiB;
DI void dilated_phase(const Args& a, LAS unsigned char* lds) {
    int tid = tid_of(a.wv); asm volatile("" : "+v"(tid));
    const int lane = tid & 63, wave = a.wv, c = lane & 31, h = lane >> 5;
    const bf16_t* qkv = (const bf16_t*)(a.ws + WS_BIG);
    LAS unsigned char* kbuf = lds; LAS unsigned char* vbuf = lds + 2 * KV_TILE_BYTES;
    LAS float* btab = (LAS float*)(lds + 4 * KV_TILE_BYTES);
    const float* biasG = (const float*)(a.ws + WS_BIASG);
    const int G = gridDim.x, bid = blockIdx.x;
    const int nu = bid < 3072 ? (3072 - bid + G - 1) / G : 0;
    if (nu == 0) return;
#define DL_DESC(k) const int u_ = bid + (k) * G, hh_ = u_ & 15, g_ = (u_ >> 4) >> 6, idx_ = (u_ >> 4) & 63, dsh_ = 2 * g_, r_ = idx_ & ((1 << dsh_) - 1), blk_ = idx_ >> dsh_; \
        const bf16_t* qb_ = qkv + (size_t)r_ * 9216 + g_ * 3072 + hh_ * 64; const size_t rs_ = (size_t)9216 << dsh_; (void)blk_; (void)qb_; (void)rs_;
    int cur_key = -1, buf = 0;
    int hh = 0, g = 0, dsh = 0, r = 0, Q0 = 0, q0w = 0, iq = 0;
    bf16x8 Q[4], Qn[4];
    f32x16 O[2]; float m = -1e30f, l = 0.f;
    u32x4 kr, vr;
    { DL_DESC(0)
      const bf16_t* qrow = qb_ + (size_t)(blk_ * 256 + 32 * wave + c) * rs_;
#pragma unroll
      for (int ks = 0; ks < 4; ++ks) Qn[ks] = *(const bf16x8*)(qrow + 16 * ks + 8 * h);
      kv_fetch(kr, vr, qb_ + 1024, qb_ + 2048, rs_, blk_ * 256 - 128, SEQ >> dsh_, tid); kv_store(kbuf, vbuf, kr, vr, tid); }
    const int total = nu * 6;
#pragma unroll 1
    for (int f = 0; f < total; ++f) {
        const int k = f / 6, j = f - 6 * k;
        if (j == 0) {
            DL_DESC(k)
            hh = hh_; g = g_; dsh = dsh_; r = r_; Q0 = blk_ * 256; q0w = Q0 + 32 * wave; iq = q0w + c;
#pragma unroll
            for (int ks = 0; ks < 4; ++ks) Q[ks] = Qn[ks];
            O[0] = zero16(); O[1] = zero16(); m = -1e30f; l = 0.f;
            if (hh * 4 + g != cur_key) { __syncthreads(); load_bias_table(btab, biasG, hh, dsh, tid, 128); cur_key = hh * 4 + g; }
        }
        __syncthreads();
        if (f + 1 < total) { const int k1 = (f + 1) / 6, j1 = (f + 1) - 6 * k1; DL_DESC(k1)
            kv_fetch(kr, vr, qb_ + 1024, qb_ + 2048, rs_, blk_ * 256 - 128 + 64 * j1, SEQ >> dsh_, tid); }
        { const int kr0 = Q0 - 128 + 64 * j;
          if (kr0 <= q0w + 31 && kr0 + 63 >= q0w - 128 && kr0 + 63 >= 0) {
            const LAS unsigned char* kl = kbuf + buf * KV_TILE_BYTES; const LAS unsigned char* vl = vbuf + buf * KV_TILE_BYTES;
            f32x16 S[2]; S[0] = qk_tile(kl, 0, Q, lane); S[1] = qk_tile(kl, 1, Q, lane);
            if (Q0 > 0) softmax_tile<1, false>(S, m, l, O, btab, iq - kr0, h, 0, 128u);
            else softmax_tile<1, true>(S, m, l, O, btab, iq - kr0, h, 0, (unsigned)min(128, iq));
            pv_tile(vl, 0, S[0], O, lane); pv_tile(vl, 1, S[1], O, lane);
          } }
        if (j == 3 && k + 1 < nu) { DL_DESC(k + 1)
            const bf16_t* qrow = qb_ + (size_t)(blk_ * 256 + 32 * wave + c) * rs_;
#pragma unroll
            for (int ks = 0; ks < 4; ++ks) Qn[ks] = *(const bf16x8*)(qrow + 16 * ks + 8 * h); }
        if (f + 1 < total) kv_store(kbuf + (buf ^ 1) * KV_TILE_BYTES, vbuf + (buf ^ 1) * KV_TILE_BYTES, kr, vr, tid);
        buf ^= 1;
        if (j == 5) {
            const int tok = (iq << dsh) + r;
            bf16_t* og = (bf16_t*)(a.ws + WS_BIG + BIG_OG) + (size_t)g * SEQ * D;
            float* lse = (float*)(a.ws + WS_BIG + BIG_LSE) + (size_t)g * SEQ * 16;
            store_o(og + (size_t)tok * D + hh * 64, O, 1.f / l, h);
            if (h == 0) lse[tok * 16 + hh] = m + __builtin_amdgcn_logf(l);
        }
    }
#undef DL_DESC
}
DI void dilated_merge(const Args& a, int b) {
    const int tid = tid_of(a.wv);
    const bf16_t* og = (const bf16_t*)(a.ws + WS_BIG + BIG_OG); const float* lse = (const float*)(a.ws + WS_BIG + BIG_LSE);
    bf16_t* outb = (bf16_t*)(a.ws + WS_ACTB) + (size_t)b * SEQ * D;
    for (int i = blockIdx.x * NTHR + tid; i < SEQ * 128; i += gridDim.x * NTHR) {
        const int tok = i >> 7, c8 = i & 127, hh = c8 >> 3;
        const float l0 = lse[tok * 16 + hh], l1 = lse[SEQ * 16 + tok * 16 + hh], l2 = lse[2 * SEQ * 16 + tok * 16 + hh];
        const float mx = fmaxf(l0, fmaxf(l1, l2));
        float w0 = __builtin_amdgcn_exp2f(l0 - mx), w1 = __builtin_amdgcn_exp2f(l1 - mx), w2 = __builtin_amdgcn_exp2f(l2 - mx);
        const float inv = 1.f / (w0 + w1 + w2); w0 *= inv; w1 *= inv; w2 *= inv;
        const u32x4 a0 = *(const u32x4*)(og + (size_t)tok * D + c8 * 8), a1 = *(const u32x4*)(og + (size_t)SEQ * D + (size_t)tok * D + c8 * 8), a2 = *(const u32x4*)(og + (size_t)2 * SEQ * D + (size_t)tok * D + c8 * 8);
        u32x4 o;
        o.x = pk2(w0 * bf_lo(a0.x) + w1 * bf_lo(a1.x) + w2 * bf_lo(a2.x), w0 * bf_hi(a0.x) + w1 * bf_hi(a1.x) + w2 * bf_hi(a2.x));
        o.y = pk2(w0 * bf_lo(a0.y) + w1 * bf_lo(a1.y) + w2 * bf_lo(a2.y), w0 * bf_hi(a0.y) + w1 * bf_hi(a1.y) + w2 * bf_hi(a2.y));
        o.z = pk2(w0 * bf_lo(a0.z) + w1 * bf_lo(a1.z) + w2 * bf_lo(a2.z), w0 * bf_hi(a0.z) + w1 * bf_hi(a1.z) + w2 * bf_hi(a2.z));
        o.w = pk2(w0 * bf_lo(a0.w) + w1 * bf_lo(a1.w) + w2 * bf_lo(a2.w), w0 * bf_hi(a0.w) + w1 * bf_hi(a1.w) + w2 * bf_hi(a2.w));
        *(u32x4*)(outb + (size_t)tok * D + c8 * 8) = o;
    }
}

constexpr size_t MB_KMEAN = WS_ACTB, MB_SELW = WS_ACTB + 1 * MiB, MB_LIST = WS_ACTB + 4 * MiB;
constexpr size_t BIG_OSEL = 192 * MiB, BIG_LSESEL = 384 * MiB;
constexpr int CW_MBCNT = 32768, CW_MBCUR = 32768 + 2048;
constexpr int CW_NSAQ = 40960;
constexpr int MB_LISTCAP = 49152;
DI void moba_kmean_phase(const Args& a, LAS unsigned char* lds) {
    const int tid = tid_of(a.wv);
    const bf16_t* qkv = (const bf16_t*)(a.ws + WS_BIG);
    float* kmean = (float*)(a.ws + MB_KMEAN);
    LAS float* part = (LAS float*)lds;
    for (int u = blockIdx.x; u < 2048; u += gridDim.x) {
        const int n = u & 63, bh = u >> 6, b = bh >> 4, hh = bh & 15;
        const bf16_t* kp = qkv + ((size_t)b * SEQ + n * 256 + (tid >> 3)) * 3072 + 1024 + hh * 64 + (tid & 7) * 8;
        float s[8];
#pragma unroll
        for (int j = 0; j < 8; ++j) s[j] = 0.f;
#pragma unroll
        for (int i = 0; i < 4; ++i) { const u32x4 v = *(const u32x4*)(kp + (size_t)(64 * i) * 3072);
            s[0] += bf_lo(v.x); s[1] += bf_hi(v.x); s[2] += bf_lo(v.y); s[3] += bf_hi(v.y); s[4] += bf_lo(v.z); s[5] += bf_hi(v.z); s[6] += bf_lo(v.w); s[7] += bf_hi(v.w); }
        __syncthreads();
        *(LAS f32x4*)(part + (tid >> 3) * 64 + (tid & 7) * 8) = (f32x4){s[0], s[1], s[2], s[3]}; *(LAS f32x4*)(part + (tid >> 3) * 64 + (tid & 7) * 8 + 4) = (f32x4){s[4], s[5], s[6], s[7]};
        __syncthreads();
        if (tid < 64) { float acc = 0.f;
#pragma unroll 8
            for (int gq = 0; gq < 64; ++gq) acc += part[gq * 64 + tid];
            kmean[((size_t)bh * 64 + n) * 64 + tid] = acc * (1.f / 256.f); }
    }
}
DI void moba_gate_phase(const Args& a, LAS unsigned char* lds) {
    int tid = tid_of(a.wv); asm volatile("" : "+v"(tid));
    const int lane = tid & 63, wave = __builtin_amdgcn_readfirstlane(tid >> 6), c = lane & 31, h = lane >> 5;
    const bf16_t* qkv = (const bf16_t*)(a.ws + WS_BIG);
    const float* kmean = (const float*)(a.ws + MB_KMEAN);
    unsigned* selw = (unsigned*)(a.ws + MB_SELW);
    unsigned* cnt = (unsigned*)(a.ws + WS_CTL) + CW_MBCNT;
    LAS unsigned char* khi = lds; LAS unsigned char* klo = lds + KV_TILE_BYTES;
    LAS int* hist = (LAS int*)(lds + 2 * KV_TILE_BYTES);
    int cur_bh = -1;
    for (int u = blockIdx.x; u < 2048; u += gridDim.x) {
        const int bh = u & 31, qb = u >> 5, b = bh >> 4, hh = bh & 15;
        const int t = qb * 256 + 32 * wave + c;
        __syncthreads();
        if (bh != cur_bh) { cur_bh = bh;
          const int row = tid >> 3, c16 = tid & 7; const float* kp = kmean + ((size_t)bh * 64 + row) * 64 + c16 * 8;
          const f32x4 v0 = *(const f32x4*)kp, v1 = *(const f32x4*)(kp + 4);
          float v[8] = {v0.x, v0.y, v0.z, v0.w, v1.x, v1.y, v1.z, v1.w}; unsigned hi[8], lo[8];
#pragma unroll
          for (int j = 0; j < 8; ++j) { hi[j] = f2bf(v[j]); lo[j] = f2bf(v[j] - u2f(hi[j] << 16)); }
          u32x4 wh, wl; wh.x = hi[0] | (hi[1] << 16); wh.y = hi[2] | (hi[3] << 16); wh.z = hi[4] | (hi[5] << 16); wh.w = hi[6] | (hi[7] << 16);
          wl.x = lo[0] | (lo[1] << 16); wl.y = lo[2] | (lo[3] << 16); wl.z = lo[4] | (lo[5] << 16); wl.w = lo[6] | (lo[7] << 16);
          kv_store(khi, klo, wh, wl, tid); }
        if (tid < 64) hist[tid] = 0;
        __syncthreads();
        bf16x8 Q[4];
        { const bf16_t* qrow = qkv + ((size_t)b * SEQ + t) * 3072 + hh * 64;
#pragma unroll
          for (int ks = 0; ks < 4; ++ks) Q[ks] = *(const bf16x8*)(qrow + 16 * ks + 8 * h); }
        f32x16 Gs[2];
#pragma unroll
        for (int sub = 0; sub < 2; ++sub) { const f32x16 a0 = qk_tile(khi, sub, Q, lane), a1 = qk_tile(klo, sub, Q, lane);
#pragma unroll
            for (int i = 0; i < 16; ++i) { const int n = sub * 32 + 16 * (i >> 3) + 8 * h + (i & 7); Gs[sub][i] = (n < qb) ? (a0[i] + a1[i]) : -1e30f; } }
        unsigned selpack = 0;
#pragma unroll
        for (int pass = 0; pass < 3; ++pass) {
            float bv = -3e38f; int bn = 64;
#pragma unroll
            for (int sub = 0; sub < 2; ++sub)
#pragma unroll
                for (int i = 0; i < 16; ++i) { const int n = sub * 32 + 16 * (i >> 3) + 8 * h + (i & 7); const float v = Gs[sub][i];
                    if (v > bv || (v == bv && n < bn)) { bv = v; bn = n; } }
            const float pv = __shfl_xor(bv, 32); const int pn = __shfl_xor(bn, 32);
            if (pv > bv || (pv == bv && pn < bn)) { bv = pv; bn = pn; }
            const bool ok = bv > -1e29f;
            selpack |= (ok ? (unsigned)bn : 255u) << (8 * pass);
            if (ok && h == 0) atomicAdd((int*)(hist + bn), 1);
#pragma unroll
            for (int sub = 0; sub < 2; ++sub)
#pragma unroll
                for (int i = 0; i < 16; ++i) { const int n = sub * 32 + 16 * (i >> 3) + 8 * h + (i & 7); if (n == bn) Gs[sub][i] = -3e38f; }
        }
        if (h == 0) selw[(size_t)bh * SEQ + t] = selpack;
        __syncthreads();
        if (tid < 64 && hist[tid] > 0) xb_add(cnt + bh * 64 + tid, (unsigned)hist[tid]);
    }
}
DI void moba_fill_phase(const Args& a, LAS unsigned char* lds) {
    const int tid = tid_of(a.wv);
    const unsigned* selw = (const unsigned*)(a.ws + MB_SELW);
    unsigned* cnt = (unsigned*)(a.ws + WS_CTL) + CW_MBCNT; unsigned* cur = (unsigned*)(a.ws + WS_CTL) + CW_MBCUR;
    unsigned* list = (unsigned*)(a.ws + MB_LIST);
    LAS int* hist = (LAS int*)lds; LAS int* gb = hist + 64; LAS int* off = gb + 64;
    for (int u = blockIdx.x; u < 2048; u += gridDim.x) {
        const int bh = u & 31, qb = u >> 5;
        __syncthreads();
        if (tid < 64) hist[tid] = 0;
        if (tid >= 64 && tid < 128) { const int n = tid - 64; const int v = (int)xb_ld(cnt + bh * 64 + n); int inc = v;
#pragma unroll
            for (int o = 1; o < 64; o <<= 1) { const int tv = __shfl_up(inc, o); if (n >= o) inc += tv; }
            off[n] = inc - v; }
        __syncthreads();
        unsigned sp = 0xffffffffu; int lp[3] = {0, 0, 0};
        if (tid < 256) { sp = selw[(size_t)bh * SEQ + qb * 256 + tid];
#pragma unroll
            for (int k = 0; k < 3; ++k) { const unsigned n = (sp >> (8 * k)) & 255u; if (n < 64u) lp[k] = atomicAdd((int*)(hist + n), 1); } }
        __syncthreads();
        if (tid < 64 && hist[tid] > 0) gb[tid] = (int)xb_add(cur + bh * 64 + tid, (unsigned)hist[tid]);
        __syncthreads();
        if (tid < 256) {
#pragma unroll
            for (int k = 0; k < 3; ++k) { const unsigned n = (sp >> (8 * k)) & 255u;
                if (n < 64u) list[(size_t)bh * MB_LISTCAP + off[n] + gb[n] + lp[k]] = (unsigned)(qb * 256 + tid) | ((unsigned)k << 14); } }
    }
}
DI void moba_sel_phase(const Args& a, LAS unsigned char* lds) {
    int tid = tid_of(a.wv); asm volatile("" : "+v"(tid));
    const int lane = tid & 63, wave = __builtin_amdgcn_readfirstlane(tid >> 6), c = lane & 31, h = lane >> 5;
    const bf16_t* qkv = (const bf16_t*)(a.ws + WS_BIG);
    const unsigned* cnt = (const unsigned*)(a.ws + WS_CTL) + CW_MBCNT;
    const unsigned* list = (const unsigned*)(a.ws + MB_LIST);
    bf16_t* osel = (bf16_t*)(a.ws + WS_BIG + BIG_OSEL); float* lsesel = (float*)(a.ws + WS_BIG + BIG_LSESEL);
    const float* biasG = (const float*)(a.ws + WS_BIASG);
    LAS unsigned char* kbuf = lds; LAS unsigned char* vbuf = lds + 2 * KV_TILE_BYTES;
    LAS float* btab = (LAS float*)(lds + 4 * KV_TILE_BYTES);
    LAS int* cs = (LAS int*)(lds + 4 * KV_TILE_BYTES + BT_LEN * 4);
    LAS int* eo = cs + 2052;
    LAS int* part = eo + 2052;
    { int cc[4], ee[4], sc = 0, se = 0;
#pragma unroll
      for (int j = 0; j < 4; ++j) { const int v = (int)xb_ld((unsigned*)cnt + tid * 4 + j); ee[j] = se; cc[j] = sc; se += v; sc += (v + 255) >> 8; }
      part[tid] = sc; part[512 + tid] = se;
      __syncthreads();
      if (tid == 0) { int a0 = 0, a1 = 0; for (int i = 0; i < 512; ++i) { const int v0 = part[i], v1 = part[512 + i]; part[i] = a0; part[512 + i] = a1; a0 += v0; a1 += v1; } cs[2048] = a0; eo[2048] = a1; }
      __syncthreads();
#pragma unroll
      for (int j = 0; j < 4; ++j) { cs[tid * 4 + j] = part[tid] + cc[j]; eo[tid * 4 + j] = part[512 + tid] + ee[j]; }
      __syncthreads(); }
    const int NC = cs[2048];
    int cur_hh = -1;
    for (int u = blockIdx.x; u < NC; u += gridDim.x) {
        int lo = 0, hi = 2047;
        while (lo < hi) { const int mid = (lo + hi + 1) >> 1; if (cs[mid] <= u) lo = mid; else hi = mid - 1; }
        const int item = lo, bh = item >> 6, n = item & 63, b = bh >> 4, hh = bh & 15;
        const int chunk = u - cs[item], nent = (int)xb_ld((unsigned*)cnt + item) - chunk * 256;
        const size_t ebase = (size_t)bh * MB_LISTCAP + (eo[item] - eo[bh * 64]) + chunk * 256;
        __syncthreads();
        if (hh != cur_hh) { load_bias_table(btab, biasG, hh, 0, tid); cur_hh = hh; }
        const int e = 32 * wave + c; const bool ev = e < nent;
        const unsigned ent = list[ebase + (ev ? e : 0)];
        const int t = ent & 16383, slot = ent >> 14;
        bf16x8 Q[4];
        { const bf16_t* qrow = qkv + ((size_t)b * SEQ + t) * 3072 + hh * 64;
#pragma unroll
          for (int ks = 0; ks < 4; ++ks) Q[ks] = *(const bf16x8*)(qrow + 16 * ks + 8 * h); }
        const bf16_t* kb = qkv + (size_t)b * SEQ * 3072 + 1024 + hh * 64; const bf16_t* vb = kb + 1024;
        f32x16 O[2]; O[0] = zero16(); O[1] = zero16();
        float m = -1e30f, l = 0.f;
        u32x4 kr, vr; int buf = 0;
        kv_fetch(kr, vr, kb, vb, 3072, n * 256, SEQ, tid); kv_store(kbuf, vbuf, kr, vr, tid);
        __syncthreads();
        for (int j = 0; j < 4; ++j) {
            if (j < 3) kv_fetch(kr, vr, kb, vb, 3072, n * 256 + 64 * (j + 1), SEQ, tid);
            const int k0 = n * 256 + 64 * j;
            if (32 * wave < nent) {
                const LAS unsigned char* kl = kbuf + buf * KV_TILE_BYTES; const LAS unsigned char* vl = vbuf + buf * KV_TILE_BYTES;
                f32x16 S[2]; S[0] = qk_tile(kl, 0, Q, lane); S[1] = qk_tile(kl, 1, Q, lane);
                softmax_tile<1, false>(S, m, l, O, btab, t - k0, h, 0, (unsigned)DIST_ANY);
                pv_tile(vl, 0, S[0], O, lane); pv_tile(vl, 1, S[1], O, lane);
            }
            if (j < 3) kv_store(kbuf + (buf ^ 1) * KV_TILE_BYTES, vbuf + (buf ^ 1) * KV_TILE_BYTES, kr, vr, tid);
            __syncthreads();
            buf ^= 1;
        }
        if (ev) { const size_t ob = ((size_t)bh * SEQ + t) * 3 + slot;
            store_o(osel + ob * 64, O, 1.f / l, h);
            if (h == 0) lsesel[ob] = m + __builtin_amdgcn_logf(l); }
    }
}
DI void moba_own_phase(const Args& a, LAS unsigned char* lds) {
    int tid = tid_of(a.wv); asm volatile("" : "+v"(tid));
    const int lane = tid & 63, wave = __builtin_amdgcn_readfirstlane(tid >> 6), c = lane & 31, h = lane >> 5;
    const bf16_t* qkv = (const bf16_t*)(a.ws + WS_BIG);
    const bf16_t* osel = (const bf16_t*)(a.ws + WS_BIG + BIG_OSEL); const float* lsesel = (const float*)(a.ws + WS_BIG + BIG_LSESEL);
    bf16_t* outb = (bf16_t*)(a.ws + WS_ACTB);
    const float* biasG = (const float*)(a.ws + WS_BIASG);
    LAS unsigned char* kbuf = lds; LAS unsigned char* vbuf = lds + 2 * KV_TILE_BYTES;
    LAS float* btab = (LAS float*)(lds + 4 * KV_TILE_BYTES);
    int cur_hh = -1;
    for (int u = blockIdx.x; u < 2048; u += gridDim.x) {
        const int bh = u & 31, qb = u >> 5, b = bh >> 4, hh = bh & 15;
        const int q0w = qb * 256 + 32 * wave, t = q0w + c;
        __syncthreads();
        if (hh != cur_hh) { load_bias_table(btab, biasG, hh, 0, tid); cur_hh = hh; }
        bf16x8 Q[4];
        { const bf16_t* qrow = qkv + ((size_t)b * SEQ + t) * 3072 + hh * 64;
#pragma unroll
          for (int ks = 0; ks < 4; ++ks) Q[ks] = *(const bf16x8*)(qrow + 16 * ks + 8 * h); }
        const bf16_t* kb = qkv + (size_t)b * SEQ * 3072 + 1024 + hh * 64; const bf16_t* vb = kb + 1024;
        f32x16 O[2]; O[0] = zero16(); O[1] = zero16();
        float m = -1e30f, l = 0.f;
        u32x4 kr, vr; int buf = 0;
        kv_fetch(kr, vr, kb, vb, 3072, qb * 256, SEQ, tid); kv_store(kbuf, vbuf, kr, vr, tid);
        __syncthreads();
        for (int j = 0; j < 4; ++j) {
            if (j < 3) kv_fetch(kr, vr, kb, vb, 3072, qb * 256 + 64 * (j + 1), SEQ, tid);
            const int k0 = qb * 256 + 64 * j;
            if (k0 <= q0w + 31) {
                const LAS unsigned char* kl = kbuf + buf * KV_TILE_BYTES; const LAS unsigned char* vl = vbuf + buf * KV_TILE_BYTES;
                f32x16 S[2]; S[0] = qk_tile(kl, 0, Q, lane); S[1] = qk_tile(kl, 1, Q, lane);
                softmax_tile<1, false>(S, m, l, O, btab, t - k0, h, 0, (unsigned)DIST_ANY);
                pv_tile(vl, 0, S[0], O, lane); pv_tile(vl, 1, S[1], O, lane);
            }
            if (j < 3) kv_store(kbuf + (buf ^ 1) * KV_TILE_BYTES, vbuf + (buf ^ 1) * KV_TILE_BYTES, kr, vr, tid);
            __syncthreads();
            buf ^= 1;
        }
        const int nv = qb < 3 ? qb : 3;
        const float lown = m + __builtin_amdgcn_logf(l);
        float ls[3]; float mx = lown;
        const size_t ob = ((size_t)bh * SEQ + t) * 3;
#pragma unroll
        for (int k = 0; k < 3; ++k) { ls[k] = (k < nv) ? lsesel[ob + k] : -1e30f; mx = fmaxf(mx, ls[k]); }
        float wown = __builtin_amdgcn_exp2f(lown - mx), wsum = wown, wk[3];
#pragma unroll
        for (int k = 0; k < 3; ++k) { wk[k] = (k < nv) ? __builtin_amdgcn_exp2f(ls[k] - mx) : 0.f; wsum += wk[k]; }
        const float inv = 1.f / wsum; wown *= inv / l;
#pragma unroll
        for (int dt = 0; dt < 2; ++dt)
#pragma unroll
            for (int i = 0; i < 16; ++i) O[dt][i] *= wown;
#pragma unroll
        for (int k = 0; k < 3; ++k) if (k < nv) { const float w = wk[k] * inv; const bf16_t* orow = osel + (ob + k) * 64;
#pragma unroll
            for (int dt = 0; dt < 2; ++dt)
#pragma unroll
                for (int g = 0; g < 4; ++g) { const u32x2 v = *(const u32x2*)(orow + dt * 32 + 8 * g + 4 * h);
                    O[dt][4 * g] += w * bf_lo(v.x); O[dt][4 * g + 1] += w * bf_hi(v.x); O[dt][4 * g + 2] += w * bf_lo(v.y); O[dt][4 * g + 3] += w * bf_hi(v.y); } }
        store_o(outb + ((size_t)b * SEQ + t) * D + hh * 64, O, 1.f, h);
    }
}

constexpr size_t NS_Q = 0, NS_KV = 64 * MiB, NS_GT = 164 * MiB, NS_HID = 172 * MiB, NS_KC = 180 * MiB, NS_KFR = 182 * MiB, NS_VFR = 198 * MiB;
DI void nsa_kcvc_phase(const Args& a, LAS unsigned char* lds) {
    int tid = tid_of(a.wv); asm volatile("" : "+v"(tid));
    {
        const bf16_t* kv6 = (const bf16_t*)(a.ws + WS_BIG + NS_KV); u32x4* kfr = (u32x4*)(a.ws + WS_BIG + NS_KFR); u32x4* vfr = (u32x4*)(a.ws + WS_BIG + NS_VFR);
        for (int tl = blockIdx.x; tl < 2048; tl += gridDim.x) {
            const int bg = tl >> 8, t0 = (tl & 255) * 64, b = bg >> 2, g = bg & 3;
            __syncthreads();
            { const int row = tid >> 3, c16 = tid & 7; const bf16_t* src_ = kv6 + ((size_t)b * SEQ + t0 + row) * 1536 + 2 * 256 + g * 64 + c16 * 8;
              *(LAS u32x4*)(lds + row * KSTR + c16 * 16) = *(const u32x4*)src_; *(LAS u32x4*)(lds + KV_TILE_BYTES + row * KSTR + c16 * 16) = *(const u32x4*)(src_ + 256); }
            __syncthreads();
            { const int f = tid >> 6, ln = tid & 63, r31 = ln & 31, hh = ln >> 5;
              { const int kt = f >> 2, ks = f & 3, pr = (r31 & ~12) | ((r31 & 4) << 1) | ((r31 & 8) >> 1);
                kfr[((size_t)tl * 8 + f) * 64 + ln] = *(const LAS u32x4*)(lds + (kt * 32 + pr) * KSTR + (16 * ks + 8 * hh) * 2); }
              { const int kt = f >> 2, s = (f >> 1) & 1, dt = f & 1; unsigned v[8];
#pragma unroll
                for (int i = 0; i < 8; ++i) v[i] = *(const LAS unsigned short*)(lds + KV_TILE_BYTES + (kt * 32 + 16 * s + 8 * hh + i) * KSTR + (dt * 32 + r31) * 2);
                u32x4 w; w.x = v[0] | (v[1] << 16); w.y = v[2] | (v[3] << 16); w.z = v[4] | (v[5] << 16); w.w = v[6] | (v[7] << 16);
                vfr[((size_t)tl * 8 + f) * 64 + ln] = w; } }
        }
    }
    const int lane = tid & 63, wave = __builtin_amdgcn_readfirstlane(tid >> 6), c = lane & 31, h = lane >> 5;
    const bf16_t* hidden = (const bf16_t*)(a.ws + WS_BIG + NS_HID); const bf16_t* w2t = (const bf16_t*)(a.ws + WS_WCMP) + 2 * 256 * 2048;
    bf16_t* kcvc = (bf16_t*)(a.ws + WS_BIG + NS_KC);
    for (int task = blockIdx.x * NWAVES + wave; task < 512; task += gridDim.x * NWAVES) {
        const int j = task >> 8, R0 = (task & 255) * 32;
        const bf16_t* hid = hidden + ((size_t)j * 8192 + R0 + c) * 256; const bf16_t* w2 = w2t + j * 64 * 256;
        f32x16 acc[2]; acc[0] = zero16(); acc[1] = zero16();
#pragma unroll
        for (int ks = 0; ks < 16; ++ks) { const bf16x8 Bv = *(const bf16x8*)(hid + 16 * ks + 8 * h);
#pragma unroll
            for (int dt = 0; dt < 2; ++dt) { const bf16x8 Av = *(const bf16x8*)(w2 + (dt * 32 + c) * 256 + 16 * ks + 8 * h); acc[dt] = mfma32(Av, Bv, acc[dt]); } }
        store_o(kcvc + ((size_t)j * 8192 + R0 + c) * 64, acc, 1.f, h);
    }
}
DI void nsa_attn_phase(const Args& a, LAS unsigned char* lds) {
    const int wave = a.wv;
#define NSA_VARS int tid = tid_of(a.wv); const int lane = tid & 63, c = lane & 31, h = lane >> 5, qi = c >> 2, r = c & 3, t = tw0 + qi; \
    const LAS float* bt = btab + r * (BT_LEN + 8); const float* gtp = gates + (tokbase + t) * 48 + 4 * g + r; (void)bt; (void)h; (void)lane; (void)gtp;
    const bf16_t* qb_ = (const bf16_t*)(a.ws + WS_BIG + NS_Q); const bf16_t* kv6 = (const bf16_t*)(a.ws + WS_BIG + NS_KV);
    const float* gates = (const float*)(a.ws + WS_BIG + NS_GT); const bf16_t* kcvc = (const bf16_t*)(a.ws + WS_BIG + NS_KC);
    bf16_t* outb = (bf16_t*)(a.ws + WS_ACTB); const float* biasG = (const float*)(a.ws + WS_BIASG);
    LAS unsigned char* ring = lds;
    LAS float* imp = (LAS float*)(lds + 49152);
    LAS float* btab = (LAS float*)(lds + 116736);
    LAS unsigned* selm = (LAS unsigned*)(lds + 151808);
    LAS unsigned* wm = selm + 512;
    LAS int* blist = (LAS int*)(wm + 64);
    LAS int* Oacc = (LAS int*)imp;
    constexpr int OAS = 66;
    LAS int* lacc = (LAS int*)(lds + 155392);
    constexpr float FXS = 16384.f;
    LAS float* mref = (LAS float*)(lds + 156416);
    LAS unsigned long long* qmask = (LAS unsigned long long*)(lds + 157440);
    LAS int* qsel = (LAS int*)(lds + 159488);
    const bf16x8* kfr = (const bf16x8*)(a.ws + WS_BIG + NS_KFR); const bf16x8* vfr = (const bf16x8*)(a.ws + WS_BIG + NS_VFR);
    int cur_g = -1;
    unsigned* nsa_ctr = (unsigned*)(a.ws + WS_CTL) + CW_NSAQ;
    volatile LAS int* uword = (volatile LAS int*)(lds + MISC_OFF + 160);
    for (;;) {
        const int bg = blockIdx.x & 7;
        __syncthreads();
        if (tid_of(a.wv) == 0) *uword = (int)xb_add(nsa_ctr + bg * 64, 1u);
        __syncthreads();
        const int uidx = *uword; if (uidx >= 256) break;
        const int tile = 255 - uidx, b = bg >> 2, g = bg & 3;
        const int T0 = tile * 64, tw0 = T0 + 8 * wave;
        const size_t tokbase = (size_t)b * SEQ;
        __syncthreads();
        bf16x8 Q[4];
        { NSA_VARS
          if (g != cur_g) { for (int rr = 0; rr < 4; ++rr) load_bias_table(btab + rr * (BT_LEN + 8), biasG, 4 * g + rr, 0, tid); cur_g = g; }
          for (int i = tid; i < 64 * 260; i += NTHR) imp[i] = 0.f;
          const bf16_t* qrow = qb_ + (tokbase + t) * 1024 + (4 * g + r) * 64;
#pragma unroll
          for (int ks = 0; ks < 4; ++ks) Q[ks] = *(const bf16x8*)(qrow + 16 * ks + 8 * h); }
        f32x16 OUT[2]; OUT[0] = zero16(); OUT[1] = zero16();
        const int nct = (T0 + 63 >= 31) ? (((T0 + 32) >> 4) >> 6) + 1 : 0;
        const int j0w = (T0 >= 511) ? ((T0 - 511) >> 6) : 0, nwin = tile - j0w + 1, nd = tile >= 2 ? 3 : tile + 1;
        const int e1 = nct, e2 = 2 * nct, e3 = e2 + nwin, e4 = e3 + nd;
        const bf16_t* kcb = kcvc + (size_t)bg * 1024 * 64; const bf16_t* vcb = kcb + (size_t)8192 * 64;
        const bf16_t* kvb = kv6 + tokbase * 1536 + g * 64;
        f32x16 O[2]; O[0] = zero16(); O[1] = zero16();
        float m = -1e30f, l = 0.f, mc = -1e30f, lc = 0.f, invl = 0.f, mfin = 0.f;
        __syncthreads();
        kv_dma_stream<3>(e4, [&](int fi, LAS unsigned char* slot) {
                const int lane = tid_of(a.wv) & 63;
                if (fi < e2) kv_dma_issue(slot, kcb, vcb, 64, 64 * (fi < e1 ? fi : fi - e1), 1024, wave, lane);
                else if (fi < e3) kv_dma_issue(slot, kvb + 4 * 256, kvb + 5 * 256, 1536, (j0w + fi - e2) * 64, SEQ, wave, lane);
                else { const int i = fi - e3, blk = (i == 0) ? 0 : (tile >= 2 ? tile - 2 + i : i); kv_dma_issue(slot, kvb + 2 * 256, kvb + 3 * 256, 1536, blk * 64, SEQ, wave, lane); }
            }, [&](int fi, const LAS unsigned char* kl, const LAS unsigned char* vl) {
                NSA_VARS
                if (fi < e1) {
                    const int c0 = 64 * fi;
                    if (16 * c0 + 31 <= tw0 + 7) {
                        f32x16 S[2]; S[0] = qk_tile_sw(kl, 0, Q, lane); S[1] = qk_tile_sw(kl, 1, Q, lane);
                        stats_tile<16, false>(S, mc, lc, bt, t - 16 * c0 - 31, h, 0, (unsigned)DIST_ANY);
                    }
                } else if (fi < e2) {
                    if (fi == e1) { invl = lc > 0.f ? 1.f / lc : 0.f; mfin = (mc <= -1e30f) ? 0.f : mc; }
                    const int c0 = 64 * (fi - e1);
                    if (16 * c0 + 31 <= tw0 + 7) {
                        f32x16 S[2]; S[0] = qk_tile_sw(kl, 0, Q, lane); S[1] = qk_tile_sw(kl, 1, Q, lane);
                        (void)logits_tile<16, false>(S, bt, t - 16 * c0 - 31, h, 0, (unsigned)DIST_ANY);
#pragma unroll
                        for (int sub = 0; sub < 2; ++sub)
#pragma unroll
                            for (int i = 0; i < 16; ++i) S[sub][i] = __builtin_amdgcn_exp2f(S[sub][i] - mfin) * invl;
#pragma unroll
                        for (int sub = 0; sub < 2; ++sub)
#pragma unroll
                            for (int s = 0; s < 2; ++s) { const int j0 = (c0 + sub * 32 + 16 * s + 8 * h) >> 2;
                                float a0 = (S[sub][8 * s] + S[sub][8 * s + 1]) + (S[sub][8 * s + 2] + S[sub][8 * s + 3]);
                                float a1 = (S[sub][8 * s + 4] + S[sub][8 * s + 5]) + (S[sub][8 * s + 6] + S[sub][8 * s + 7]) + S[sub][8 * s + 3];
                                float a2 = S[sub][8 * s + 7];
                                a0 += quad_xor1(a0); a1 += quad_xor1(a1); a2 += quad_xor1(a2);
                                a0 += quad_xor2(a0); a1 += quad_xor2(a1); a2 += quad_xor2(a2);
                                if (r == 0) { LAS float* ip = imp + (8 * wave + qi) * 260 + j0; atomicAdd((float*)ip, a0); atomicAdd((float*)(ip + 1), a1); atomicAdd((float*)(ip + 2), a2); } }
                        pv_tile_sw(vl, 0, S[0], O, lane); pv_tile_sw(vl, 1, S[1], O, lane);
                    }
                    if (fi == e2 - 1) { const float gt_cmp = gtp[0];
#pragma unroll
                        for (int dt = 0; dt < 2; ++dt)
#pragma unroll
                            for (int i = 0; i < 16; ++i) { OUT[dt][i] += gt_cmp * O[dt][i]; O[dt][i] = 0.f; } }
                } else if (fi < e3) {
                    const int k0 = (j0w + fi - e2) * 64;
                    if (k0 <= tw0 + 7 && k0 + 63 >= tw0 - 511) {
                        f32x16 S[2]; S[0] = qk_tile_sw(kl, 0, Q, lane); S[1] = qk_tile_sw(kl, 1, Q, lane);
                        if (k0 >= tw0 + 7 - 511) softmax_tile<1, false>(S, m, l, O, bt, t - k0, h, 0, 511u);
                        else softmax_tile<1, true>(S, m, l, O, bt, t - k0, h, 0, 511u);
                        pv_tile_sw(vl, 0, S[0], O, lane); pv_tile_sw(vl, 1, S[1], O, lane);
                    }
                    if (fi == e3 - 1) { const float sc_ = gtp[32] / l;
#pragma unroll
                        for (int dt = 0; dt < 2; ++dt)
#pragma unroll
                            for (int i = 0; i < 16; ++i) { OUT[dt][i] += sc_ * O[dt][i]; O[dt][i] = 0.f; }
                        m = -1e30f; l = 0.f; }
                } else {
                    const int i = fi - e3, blk = (i == 0) ? 0 : (tile >= 2 ? tile - 2 + i : i), k0 = blk * 64;
                    f32x16 S[2]; S[0] = qk_tile_sw(kl, 0, Q, lane); S[1] = qk_tile_sw(kl, 1, Q, lane);
                    softmax_tile<1, false>(S, m, l, O, bt, t - k0, h, 0, (unsigned)DIST_ANY);
                    pv_tile_sw(vl, 0, S[0], O, lane); pv_tile_sw(vl, 1, S[1], O, lane);
                }
            }, ring);
        __syncthreads();
#pragma unroll 1
        for (int qh = 0; qh < 2; ++qh) {
            const int lane = tid_of(a.wv) & 63;
            const int cur = tile;
            unsigned key[4][4];
#pragma unroll
            for (int q4 = 0; q4 < 4; ++q4) { const int ql = 8 * wave + 4 * qh + q4;
#pragma unroll
                for (int kk = 0; kk < 4; ++kk) { const int j = lane + 64 * kk; const bool forced = (j == 0) || (j == cur) || (j + 1 == cur);
                    key[q4][kk] = forced ? 0xffffffffu : ((j <= cur) ? f2u(imp[ql * 260 + j]) + 1u : 0u); } }
            unsigned prefix[4] = {0u, 0u, 0u, 0u};
#pragma unroll 1
            for (int bit = 31; bit >= 0; --bit) {
#pragma unroll
                for (int q4 = 0; q4 < 4; ++q4) { const unsigned cand = prefix[q4] | (1u << bit); int cnt = 0;
#pragma unroll
                    for (int kk = 0; kk < 4; ++kk) cnt += __popcll(__ballot(key[q4][kk] >= cand));
                    if (cnt >= 16) prefix[q4] = cand; } }
            const unsigned long long ltmask = (1ull << lane) - 1ull;
#pragma unroll
            for (int q4 = 0; q4 < 4; ++q4) { const int ql = 8 * wave + 4 * qh + q4; const unsigned pf = prefix[q4];
                int cgt = 0;
#pragma unroll
                for (int kk = 0; kk < 4; ++kk) cgt += __popcll(__ballot(key[q4][kk] > pf));
                const int need = 16 - cgt; int running = 0;
#pragma unroll
                for (int kk = 0; kk < 4; ++kk) { const unsigned long long eqb = __ballot(key[q4][kk] == pf);
                    const bool take = key[q4][kk] > pf || (pf != 0u && key[q4][kk] == pf && running + __popcll(eqb & ltmask) < need);
                    running += __popcll(eqb);
                    const unsigned long long bal = __ballot(take);
                    if (lane == 0) { selm[ql * 8 + 2 * kk] = (unsigned)bal; selm[ql * 8 + 2 * kk + 1] = (unsigned)(bal >> 32); } } }
        }
        __syncthreads();
        { const int tid = tid_of(a.wv);
          if (tid < 8) { unsigned o = 0u;
              if (tid == 0) o |= 1u;
              if ((tile >> 5) == tid) o |= 1u << (tile & 31);
              if (tile >= 1 && ((tile - 1) >> 5) == tid) o |= 1u << ((tile - 1) & 31);
              wm[tid] = o; } }
        __syncthreads();
        { const int lane = tid_of(a.wv) & 63;
#pragma unroll 1
          for (int jj = 0; jj < 32; ++jj) { const int j = wave * 32 + jj; const unsigned w = selm[lane * 8 + (j >> 5)] & ~wm[j >> 5];
              const unsigned long long bal = __ballot((w >> (j & 31)) & 1u); if (lane == 0) qmask[j] = bal; } }
        {
            NSA_VARS
            LAS int* oa = Oacc + ((8 * wave + qi) * 4 + r) * OAS;
#pragma unroll
            for (int dt = 0; dt < 2; ++dt)
#pragma unroll
                for (int g4 = 0; g4 < 4; ++g4) { u32x2 w0, w1; w0.x = (unsigned)(int)(O[dt][4 * g4] * FXS); w0.y = (unsigned)(int)(O[dt][4 * g4 + 1] * FXS); w1.x = (unsigned)(int)(O[dt][4 * g4 + 2] * FXS); w1.y = (unsigned)(int)(O[dt][4 * g4 + 3] * FXS);
                    *(LAS u32x2*)(oa + dt * 32 + 8 * g4 + 4 * h) = w0; *(LAS u32x2*)(oa + dt * 32 + 8 * g4 + 4 * h + 2) = w1; }
            if (h == 0) { lacc[(8 * wave + qi) * 4 + r] = (int)(l * FXS); mref[(8 * wave + qi) * 4 + r] = m; }
        }
        __syncthreads();
        {
            NSA_VARS
            LAS int* qs = qsel + wave * 8;
            const unsigned long long ltm = (1ull << lane) - 1ull;
            int j = wave; unsigned long long qm = 0ull;
            while (j <= tile) { qm = qmask[j]; if (qm != 0ull) break; j += 8; }
            if (j <= tile) {
                int n = __popcll(qm), ch = 0;
                if ((qm >> lane) & 1ull) { const int rk = __popcll(qm & ltm); if (rk < 8) qs[rk] = lane; }
                bool lv = qi < n; int ql = qs[lv ? qi : 0];
                bf16x8 KA[2][4], VA[2][2][2], Qs[4];
                { const bf16x8* kp = kfr + ((size_t)(bg * 256 + j) * 8) * 64 + lane; const bf16x8* vp = vfr + ((size_t)(bg * 256 + j) * 8) * 64 + lane;
                  const bf16_t* qrow = qb_ + (tokbase + T0 + ql) * 1024 + (4 * g + r) * 64;
#pragma unroll
                  for (int ks = 0; ks < 4; ++ks) Qs[ks] = *(const bf16x8*)(qrow + 16 * ks + 8 * h);
#pragma unroll
                  for (int f8 = 0; f8 < 8; ++f8) KA[f8 >> 2][f8 & 3] = kp[f8 * 64];
#pragma unroll
                  for (int f8 = 0; f8 < 8; ++f8) VA[f8 >> 2][(f8 >> 1) & 1][f8 & 1] = vp[f8 * 64]; }
#pragma unroll 1
                for (;;) {
                    int jn = j, chn = ch + 1, nn = n; unsigned long long qmn = qm;
                    if (chn * 8 >= n) { chn = 0; jn = j + 8; qmn = 0ull; while (jn <= tile) { qmn = qmask[jn]; if (qmn != 0ull) break; jn += 8; } nn = __popcll(qmn); }
                    const bool has_next = jn <= tile, newblk = jn != j;
                    f32x16 S[2];
#pragma unroll
                    for (int kt = 0; kt < 2; ++kt) { S[kt] = zero16();
#pragma unroll
                        for (int ks = 0; ks < 4; ++ks) S[kt] = mfma32(KA[kt][ks], Qs[ks], S[kt]); }
                    const int tq = T0 + ql, D0 = tq - j * 64;
                    const float mr = mref[ql * 4 + r];
                    LAS int* oa = Oacc + (ql * 4 + r) * OAS + 4 * h; LAS int* la = lacc + ql * 4 + r;
                    const bool lvc = lv;
                    if (has_next) {
                        if ((qmn >> lane) & 1ull) { const int rk = __popcll(qmn & ltm) - 8 * chn; if (rk >= 0 && rk < 8) qs[rk] = lane; }
                        lv = qi < nn - 8 * chn; ql = qs[lv ? qi : 0];
                        const bf16_t* qrow = qb_ + (tokbase + T0 + ql) * 1024 + (4 * g + r) * 64;
#pragma unroll
                        for (int ks = 0; ks < 4; ++ks) Qs[ks] = *(const bf16x8*)(qrow + 16 * ks + 8 * h);
                        if (newblk) { const bf16x8* kp = kfr + ((size_t)(bg * 256 + jn) * 8) * 64 + lane;
#pragma unroll
                            for (int f8 = 0; f8 < 8; ++f8) KA[f8 >> 2][f8 & 3] = kp[f8 * 64]; }
                    }
                    (void)logits_tile<1, false>(S, bt, D0, h, 0, (unsigned)DIST_ANY);
                    float ls = 0.f;
#pragma unroll
                    for (int kt = 0; kt < 2; ++kt)
#pragma unroll
                        for (int i = 0; i < 16; ++i) { const float p = lvc ? __builtin_amdgcn_exp2f(S[kt][i] - mr) : 0.f; S[kt][i] = p; ls += p; }
                    ls += xor32h(ls, h);
                    f32x16 Oa[2]; Oa[0] = zero16(); Oa[1] = zero16();
#pragma unroll
                    for (int kt = 0; kt < 2; ++kt)
#pragma unroll
                        for (int s = 0; s < 2; ++s) {
                            u32x4 pk; pk.x = cvt_pk_bf16(S[kt][8 * s + 0], S[kt][8 * s + 1]); pk.y = cvt_pk_bf16(S[kt][8 * s + 2], S[kt][8 * s + 3]); pk.z = cvt_pk_bf16(S[kt][8 * s + 4], S[kt][8 * s + 5]); pk.w = cvt_pk_bf16(S[kt][8 * s + 6], S[kt][8 * s + 7]);
                            const bf16x8 Bp = __builtin_bit_cast(bf16x8, pk);
                            Oa[0] = mfma32(VA[kt][s][0], Bp, Oa[0]); Oa[1] = mfma32(VA[kt][s][1], Bp, Oa[1]); }
                    if (has_next && newblk) { const bf16x8* vp = vfr + ((size_t)(bg * 256 + jn) * 8) * 64 + lane;
#pragma unroll
                        for (int f8 = 0; f8 < 8; ++f8) VA[f8 >> 2][(f8 >> 1) & 1][f8 & 1] = vp[f8 * 64]; }
                    if (lvc) {
#pragma unroll
                        for (int dt = 0; dt < 2; ++dt)
#pragma unroll
                            for (int i = 0; i < 16; ++i) atomicAdd((int*)(oa + dt * 32 + (i & 3) + 8 * (i >> 2)), (int)(Oa[dt][i] * FXS));
                        if (h == 0) atomicAdd((int*)la, (int)(ls * FXS)); }
                    if (!has_next) break;
                    j = jn; ch = chn; qm = qmn; n = nn;
                }
            }
        }
        __syncthreads();
        {
            NSA_VARS
            const float gt_sel = gtp[16];
            const LAS int* oa = Oacc + ((8 * wave + qi) * 4 + r) * OAS;
            const float sc_ = gt_sel / (float)lacc[(8 * wave + qi) * 4 + r];
#pragma unroll
            for (int dt = 0; dt < 2; ++dt)
#pragma unroll
                for (int g4 = 0; g4 < 4; ++g4) { const u32x2 v0 = *(const LAS u32x2*)(oa + dt * 32 + 8 * g4 + 4 * h), v1 = *(const LAS u32x2*)(oa + dt * 32 + 8 * g4 + 4 * h + 2);
                    OUT[dt][4 * g4] += sc_ * (float)(int)v0.x; OUT[dt][4 * g4 + 1] += sc_ * (float)(int)v0.y; OUT[dt][4 * g4 + 2] += sc_ * (float)(int)v1.x; OUT[dt][4 * g4 + 3] += sc_ * (float)(int)v1.y; }
        }
        { NSA_VARS
          store_o(outb + (tokbase + t) * D + (4 * g + r) * 64, OUT, 1.f, h); }
    }
#undef NSA_VARS
}

DI void sb_phase(const Args& a, LAS unsigned char* lds) {
    int tid = tid_of(a.wv); asm volatile("" : "+v"(tid));
    const int lane = tid & 63, wave = __builtin_amdgcn_readfirstlane(tid >> 6), c = lane & 31, h = lane >> 5;
    const bf16_t* qkv = (const bf16_t*)(a.ws + WS_BIG);
    bf16_t* outb = (bf16_t*)(a.ws + WS_ACTB);
    LAS unsigned char* kbuf = lds; LAS unsigned char* vbuf = lds + 2 * KV_TILE_BYTES;
    volatile LAS int* flags = (volatile LAS int*)(lds + 4 * KV_TILE_BYTES);
    for (int u = blockIdx.x; u < 2048; u += gridDim.x) {
        const int qb = u & 63, hh = (u >> 6) & 15, b = u >> 10;
        const int q0w = qb * 256 + 32 * wave, t = q0w + c;
        const size_t tokbase = (size_t)b * SEQ;
        const bf16_t* kb = qkv + tokbase * 3072 + 1024 + hh * 64;
        const bf16_t* vb = qkv + tokbase * 3072 + 2048 + hh * 64;
        bf16x8 Q[4];
        { const bf16_t* qrow = qkv + (tokbase + t) * 3072 + hh * 64;
#pragma unroll
          for (int ks = 0; ks < 4; ++ks) Q[ks] = *(const bf16x8*)(qrow + 16 * ks + 8 * h); }
        f32x16 O[2]; O[0] = zero16(); O[1] = zero16();
        float carry = 1.f; bool wdone = false;
        int jt = qb * 4 + 3, buf = 0;
        u32x4 kr, vr;
        kv_fetch(kr, vr, kb, vb, 3072, jt * 64, SEQ, tid); kv_store(kbuf, vbuf, kr, vr, tid);
        __syncthreads();
        for (; jt >= 0; --jt) {
            if (jt > 0) kv_fetch(kr, vr, kb, vb, 3072, (jt - 1) * 64, SEQ, tid);
            const int kb0 = jt * 64;
            if (!wdone && kb0 < q0w + 31) {
                const LAS unsigned char* kl = kbuf + buf * KV_TILE_BYTES; const LAS unsigned char* vl = vbuf + buf * KV_TILE_BYTES;
                f32x16 SP[2], U[2];
                SP[0] = qk_tile(kl, 0, Q, lane); SP[1] = qk_tile(kl, 1, Q, lane);
                float Tc[2][2];
#pragma unroll
                for (int sub = 0; sub < 2; ++sub)
#pragma unroll
                    for (int s = 0; s < 2; ++s) { float acc = 1.f;
#pragma unroll
                        for (int j = 0; j < 8; ++j) { const int i = 8 * s + j; const int key = kb0 + sub * 32 + 16 * s + 8 * h + j;
                            const float z = __builtin_amdgcn_fmed3f(SP[sub][i] * 0.125f, -60.f, 60.f);
                            const float e = __builtin_amdgcn_exp2f(z * LOG2E);
                            const float u = __builtin_amdgcn_rcpf(1.f + e);
                            const bool valid = key < t;
                            SP[sub][i] = valid ? e * u : 0.f; U[sub][i] = valid ? u : 1.f; acc *= U[sub][i]; }
                        Tc[sub][s] = acc; }
                float Tp[2][2], pr[2][2];
#pragma unroll
                for (int sub = 0; sub < 2; ++sub)
#pragma unroll
                    for (int s = 0; s < 2; ++s) { Tp[sub][s] = xor32h(Tc[sub][s], h); pr[sub][s] = Tc[sub][s] * Tp[sub][s]; }
                float offp[2][2];
                offp[1][1] = carry; offp[1][0] = offp[1][1] * pr[1][1]; offp[0][1] = offp[1][0] * pr[1][0]; offp[0][0] = offp[0][1] * pr[0][1];
                carry = offp[0][0] * pr[0][0];
#pragma unroll
                for (int sub = 0; sub < 2; ++sub)
#pragma unroll
                    for (int s = 0; s < 2; ++s) { float run = offp[sub][s] * (h == 0 ? Tp[sub][s] : 1.f);
#pragma unroll
                        for (int j = 7; j >= 0; --j) { const int i = 8 * s + j; SP[sub][i] *= run; run *= U[sub][i]; } }
                pv_tile(vl, 0, SP[0], O, lane); pv_tile(vl, 1, SP[1], O, lane);
                wdone = __all(carry < 1e-38f);
            }
            if (lane == 0) flags[buf * 8 + wave] = wdone ? 1 : 0;
            if (jt > 0) kv_store(kbuf + (buf ^ 1) * KV_TILE_BYTES, vbuf + (buf ^ 1) * KV_TILE_BYTES, kr, vr, tid);
            __syncthreads();
            int alld = 1;
#pragma unroll
            for (int w = 0; w < 8; ++w) alld &= flags[buf * 8 + w];
            buf ^= 1;
            if (alld) break;
        }
        store_o(outb + (tokbase + t) * D + hh * 64, O, 1.f, h);
        __syncthreads();
    }
}

#ifndef DBG
#define DBG 0
#endif
#if DBG
DI float dbg_block_max(float v, LAS float* red) {
#pragma unroll
    for (int o = 1; o < 64; o <<= 1) v = fmaxf(v, __shfl_xor(v, o));
    __syncthreads();
    if ((threadIdx.x & 63) == 0) red[threadIdx.x >> 6] = v;
    __syncthreads();
    float r = red[0];
    for (int i = 1; i < 8; ++i) r = fmaxf(r, red[i]);
    __syncthreads();
    return r;
}
DI float dbg_block_sum(float v, LAS float* red) {
#pragma unroll
    for (int o = 1; o < 64; o <<= 1) v += __shfl_xor(v, o);
    __syncthreads();
    if ((threadIdx.x & 63) == 0) red[threadIdx.x >> 6] = v;
    __syncthreads();
    float r = 0.f;
    for (int i = 0; i < 8; ++i) r += red[i];
    __syncthreads();
    return r;
}
DI void dbg_note(unsigned* ctl, int idx, float err) { if (threadIdx.x == 0) atomicMax(ctl + CW_DBG + idx, __builtin_bit_cast(unsigned, err)); }
template <int layer>
DI void dbg_check(const Args& a, LAS unsigned char* lds, int stage, const MoeMeta& mm) {
    if (blockIdx.x >= 64) return;
    const int tid = threadIdx.x;
    const int t = blockIdx.x * 512 + (blockIdx.x * 37) % 512;
    LAS float* x1 = (LAS float*)(lds);
    LAS float* hh = x1 + 1024;
    LAS float* yy = hh + 512;
    LAS float* red = yy + 2048;
    LAS float* scl = red + 16;
    unsigned* ctl = (unsigned*)(a.ws + WS_CTL);
    float* dbgx1 = (float*)(a.ws + WS_SMALL) + blockIdx.x * 1024;
    const float* xout = a.out; const bf16_t* actb = (const bf16_t*)(a.ws + WS_ACTB);
    const u32x4 ti = *(const u32x4*)(a.ws + WS_TOKINFO + (size_t)t * 16);
    const int e0 = ti.x & 15, p0 = ti.x >> 4, e1 = ti.z & 15, p1 = ti.z >> 4;
    const float w0 = u2f(ti.y), w1 = u2f(ti.w);
    __syncthreads();
    if (tid == 0) { scl[16] = w0; scl[17] = w1; }
    __syncthreads();
    if (stage == 1) {
        const float* xin = (layer == 0) ? a.in[IN_X] : nullptr;
        if (xin) {
            float v0 = ALPHA * xin[(size_t)t * D + tid], v1 = ALPHA * xin[(size_t)t * D + tid + 512];
            const float mean = dbg_block_sum(v0 + v1, red) / D;
            const float var = dbg_block_sum((v0 - mean) * (v0 - mean) + (v1 - mean) * (v1 - mean), red) / D;
            const float rstd = 1.f / sqrtf(var + LN_EPS);
            const float* g = a.in[IN_LN1G] + layer * D; const float* b = a.in[IN_LN1B] + layer * D;
            const float r0 = (v0 - mean) * rstd * g[tid] + b[tid], r1 = (v1 - mean) * rstd * g[tid + 512] + b[tid + 512];
            float e = fmaxf(fabsf(r0 - xout[(size_t)t * D + tid]), fabsf(r1 - xout[(size_t)t * D + tid + 512]));
            dbg_note(ctl, 0, dbg_block_max(e, red));
            const float q0 = __builtin_bit_cast(float, (unsigned)actb[(size_t)t * D + tid] << 16), q1 = __builtin_bit_cast(float, (unsigned)actb[(size_t)t * D + tid + 512] << 16);
            e = fmaxf(fabsf(r0 - q0), fabsf(r1 - q1));
            dbg_note(ctl, 1, dbg_block_max(e, red));
        }
        x1[tid] = xout[(size_t)t * D + tid]; x1[tid + 512] = xout[(size_t)t * D + tid + 512];
        dbgx1[tid] = x1[tid]; dbgx1[tid + 512] = x1[tid + 512];
        __syncthreads();
        if (tid < 16) { float s = 0.f; for (int k = 0; k < D; ++k) s += x1[k] * a.in[IN_RW][k * 16 + tid]; scl[tid] = 1.f / (1.f + expf(-s)); }
        __syncthreads();
        if (tid == 0) {
            float bz[16]; for (int e = 0; e < 16; ++e) bz[e] = scl[e] + a.in[IN_RB][e];
            int bg = 0; float bgs = -1e30f;
            for (int g = 0; g < 4; ++g) { float m1 = -1e30f, m2 = -1e30f; for (int k = 0; k < 4; ++k) { const float v = bz[4 * g + k]; if (v > m1) { m2 = m1; m1 = v; } else if (v > m2) m2 = v; }
                if (m1 + m2 > bgs) { bgs = m1 + m2; bg = g; } }
            int i1 = 0; for (int k = 1; k < 4; ++k) if (bz[4 * bg + k] > bz[4 * bg + i1]) i1 = k;
            int i2 = -1; for (int k = 0; k < 4; ++k) if (k != i1 && (i2 < 0 || bz[4 * bg + k] > bz[4 * bg + i2])) i2 = k;
            const float s1 = scl[4 * bg + i1], s2 = scl[4 * bg + i2];
            float err = 0.f;
            if (e0 != 4 * bg + i1 || e1 != 4 * bg + i2) err = 1.f;
            err = fmaxf(err, fabsf(scl[16] - s1 / (s1 + s2))); err = fmaxf(err, fabsf(scl[17] - s2 / (s1 + s2)));
            if (p0 >= mm.cnt[e0] || p1 >= mm.cnt[e1]) err = 2.f;
            else { const unsigned* list = (const unsigned*)(a.ws + WS_LIST); if (list[e0 * 32768 + p0] != (unsigned)t || list[e1 * 32768 + p1] != (unsigned)t) err = 3.f; }
            atomicMax(ctl + CW_DBG + 2, __builtin_bit_cast(unsigned, err));
        }
        return;
    }
    x1[tid] = dbgx1[tid]; x1[tid + 512] = dbgx1[tid + 512];
    __syncthreads();
    const float* eg = a.in[IN_EG] + (size_t)layer * NE * D * DEXP; const float* eu = a.in[IN_EU] + (size_t)layer * NE * D * DEXP; const float* ed = a.in[IN_ED] + (size_t)layer * NE * DEXP * D;
    { const int k = tid >> 8, j = tid & 255, e = k ? e1 : e0;
      float g = 0.f, u = 0.f; for (int i = 0; i < D; ++i) { g += x1[i] * eg[((size_t)e * D + i) * DEXP + j]; u += x1[i] * eu[((size_t)e * D + i) * DEXP + j]; }
      hh[k * 256 + j] = g / (1.f + expf(-g)) * u; }
    __syncthreads();
    const size_t s0 = (size_t)mm.tstart[e0] * 256 + p0, s1 = (size_t)mm.tstart[e1] * 256 + p1;
    if (stage == 2) {
        const bf16_t* hb = (const bf16_t*)(a.ws + WS_BIG + BIG_H);
        const int k = tid >> 8, j = tid & 255; const size_t s = k ? s1 : s0;
        const float got = __builtin_bit_cast(float, (unsigned)hb[s * DEXP + j] << 16);
        const float ref = hh[tid];
        const float rms = sqrtf(dbg_block_sum(ref * ref, red) / 512.f);
        dbg_note(ctl, 3, dbg_block_max(fabsf(got - ref), red) / (rms + 1e-6f));
        return;
    }
    for (int c = tid; c < 2048; c += 512) { const int k = c >> 10, col = c & 1023, e = k ? e1 : e0; float s = 0.f;
        for (int j = 0; j < DEXP; ++j) s += hh[k * 256 + j] * ed[((size_t)e * DEXP + j) * D + col];
        yy[c] = s; }
    __syncthreads();
    if (stage == 3) {
        const bf16_t* yb = (const bf16_t*)(a.ws + WS_BIG + BIG_YB);
        float e = 0.f, sq = 0.f;
        for (int c = tid; c < 2048; c += 512) { const int k = c >> 10, col = c & 1023; const size_t s = k ? s1 : s0;
            const float got = __builtin_bit_cast(float, (unsigned)yb[s * D + col] << 16); e = fmaxf(e, fabsf(got - yy[c])); sq += yy[c] * yy[c]; }
        const float rms = sqrtf(dbg_block_sum(sq, red) / 2048.f);
        dbg_note(ctl, 4, dbg_block_max(e, red) / (rms + 1e-6f));
        return;
    }
    {
        float v0 = ALPHA * x1[tid] + w0 * yy[tid] + w1 * yy[1024 + tid], v1 = ALPHA * x1[tid + 512] + w0 * yy[tid + 512] + w1 * yy[1024 + tid + 512];
        const float mean = dbg_block_sum(v0 + v1, red) / D;
        const float var = dbg_block_sum((v0 - mean) * (v0 - mean) + (v1 - mean) * (v1 - mean), red) / D;
        const float rstd = 1.f / sqrtf(var + LN_EPS);
        const float* g = a.in[IN_LN2G] + layer * D; const float* b = a.in[IN_LN2B] + layer * D;
        const float r0 = (v0 - mean) * rstd * g[tid] + b[tid], r1 = (v1 - mean) * rstd * g[tid + 512] + b[tid + 512];
        const float e = fmaxf(fabsf(r0 - xout[(size_t)t * D + tid]), fabsf(r1 - xout[(size_t)t * D + tid + 512]));
        dbg_note(ctl, 5, dbg_block_max(e, red));
    }
}
DI void dbg_final(const Args& a) {
    unsigned* ctl = (unsigned*)(a.ws + WS_CTL);
    const float tol[6] = {1e-4f, 2e-2f, 1e-3f, 0.12f, 0.12f, 4e-2f};
    int code = 2;
    for (int i = 5; i >= 0; --i) { const float err = __builtin_bit_cast(float, xb_ld(ctl + CW_DBG + i));
        if (!(err <= tol[i])) { const int dg = !(err < 1.f) ? 9 : err >= 0.3f ? 7 : err >= 0.1f ? 5 : err >= 0.03f ? 3 : 1; code = 10 * (i + 1) + dg; } }
#ifdef PROBE
    { const float p0 = (float)xb_ld(ctl + CW_DBG + 10) / 65536.f, p1 = __builtin_bit_cast(float, xb_ld(ctl + CW_DBG + 9));
      const int d0 = p0 < 0.f ? 0 : p0 >= 1.f ? 9 : (int)(p0 * 9.99f), d1 = p1 < 0.f ? 0 : p1 >= 1.f ? 9 : (int)(p1 * 9.99f); code = 10 * d0 + d1; }
#endif
    if (xb_ld(ctl + CW_BAR + XB_TMO)) code = 95;
    const float c = sqrtf((float)code);
    for (size_t i = (size_t)blockIdx.x * NTHR + threadIdx.x; i < (size_t)T * D; i += (size_t)gridDim.x * NTHR) a.out[i] = c;
}
#endif


#ifndef PROBE_LO
#define PROBE_LO -1
#define PROBE_HI -1
#define PROBE_MULT 0
#endif
#ifndef PROBE_MASK
#define PROBE_MASK 0ull
#endif
DI void probe_tick(LAS unsigned char* lds, int wv) {
    if (PROBE_LO < 0) return;
    volatile LAS unsigned* M = (volatile LAS unsigned*)(lds + MISC_OFF);
    if (tid_of(wv) == 0) { const unsigned long long now = __builtin_amdgcn_s_memrealtime(); const int k = (int)M[16];
        const unsigned long long last = (unsigned long long)M[18] | ((unsigned long long)M[19] << 32);
        if ((k >= PROBE_LO && k <= PROBE_HI) || ((PROBE_MASK >> k) & 1ull)) { unsigned long long acc = (unsigned long long)M[20] | ((unsigned long long)M[21] << 32); acc += now - last; M[20] = (unsigned)acc; M[21] = (unsigned)(acc >> 32); }
        M[16] = (unsigned)(k + 1); M[18] = (unsigned)now; M[19] = (unsigned)(now >> 32); }
}
#define GRID_BAR() do { xcd_barrier(bar); probe_tick(lds, a.wv); } while (0)
constexpr bool HAS_MIXER[4] = {true, true, true, true};
template <int layer>
DI void run_layer(const Args& a, LAS unsigned char* lds, const XcdBarrier& bar) {
    const int wave = a.wv;
    const int G = gridDim.x, bid = blockIdx.x;
    const int gw = bid * NWAVES + wave, NGW = G * NWAVES;
    unsigned char* ws = a.ws;
    unsigned* ctl = (unsigned*)(a.ws + WS_CTL);
    bf16_t* actb = (bf16_t*)(ws + WS_ACTB);
    float* xout = a.out;
    bf16_t* xres = (bf16_t*)a.out;
        bf16_t* bigb = (bf16_t*)(ws + WS_BIG);
        if (layer == 0) {
#pragma unroll 1
            for (int b = 0; b < BATCH; ++b) {
                { pg8::DenseSched S; S.init(xres + (size_t)b * SEQ * D, D * 2, 128, ws + WS_WIN, SEQ, 9216, D, G, bid); pg8::EpiStore E{bigb, (size_t)9216}; pg8::gemm_phase(lds + STAGE_OFF, S, E, a.wv); }
                if (b == 1) dilated_merge(a, 0);
                GRID_BAR();
                dilated_phase(a, lds);
                GRID_BAR();
            }
            dilated_merge(a, 1);
            GRID_BAR();
        }
        if (layer == 1) {
            { pg8::DenseSched S; S.init(xres, D * 2, 128, ws + WS_WIN, T, 3072, D, G, bid); pg8::EpiStore E{bigb, (size_t)3072}; pg8::gemm_phase(lds + STAGE_OFF, S, E, a.wv); }
            GRID_BAR();
            sb_phase(a, lds);
            GRID_BAR();
        }
        if (layer == 2) {
            { pg8::DenseSched S; S.init(xres, D * 2, 128, ws + WS_WIN, T, 2816, D, G, bid);
              pg8::EpiNsa E{(bf16_t*)(ws + WS_BIG + NS_Q), (bf16_t*)(ws + WS_BIG + NS_KV), (float*)(ws + WS_BIG + NS_GT)}; pg8::gemm_phase(lds + STAGE_OFF, S, E, a.wv); }
            GRID_BAR();
            { pg8::CmpSched S; S.kv6 = (const char*)(ws + WS_BIG + NS_KV); S.Bt = (const char*)(ws + WS_WCMP); S.K = 2048; S.lda = 16 * 1536 * 2; S.kstepA = 1536 * 2; S.G = G; S.c = bid;
              pg8::EpiCmp E{(bf16_t*)(ws + WS_BIG + NS_HID), (const float*)(ws + WS_WCMP + 2 * MiB + 64 * 1024)}; pg8::gemm_phase(lds + STAGE_OFF, S, E, a.wv); }
            GRID_BAR();
            nsa_kcvc_phase(a, lds);
            GRID_BAR();
            nsa_attn_phase(a, lds);
            GRID_BAR();
        }
        if (layer == 3) {
            { pg8::DenseSched S; S.init(xres, D * 2, 128, ws + WS_WIN, T, 3072, D, G, bid); pg8::EpiStore E{bigb, (size_t)3072}; pg8::gemm_phase(lds + STAGE_OFF, S, E, a.wv); }
            GRID_BAR();
            moba_kmean_phase(a, lds);
            GRID_BAR();
            moba_gate_phase(a, lds);
            GRID_BAR();
            moba_fill_phase(a, lds);
            GRID_BAR();
            moba_sel_phase(a, lds);
            GRID_BAR();
            moba_own_phase(a, lds);
            GRID_BAR();
        }
        if (HAS_MIXER[layer]) {
            { pg8::DenseSched S; S.init(actb, D * 2, 128, ws + WS_WOUT, T, D, D, G, bid); pg8::EpiStore E{(bf16_t*)(ws + WS_BIG + BIG_Y), (size_t)D}; pg8::gemm_phase(lds + STAGE_OFF, S, E, a.wv); }
            GRID_BAR();
        }
        unsigned* gcount = ctl + CW_MOE + layer * 16 * 64;
        {
            const int tid = tid_of(a.wv), lane = tid & 63, j4 = lane & 3, cg = lane >> 2;
            LAS float* rwf = (LAS float*)(lds + STAGE_OFF);
            LAS float* gbl = rwf + 16384;
            LAS int* lcnt = (LAS int*)(lds + STAGE_OFF + 73728);
            LAS int* gbase = lcnt + 16;
            LAS unsigned* le = (LAS unsigned*)(lcnt + 32);
            LAS float* lg = (LAS float*)(le + 256);
            const bf16_t* ybig = (const bf16_t*)(ws + WS_BIG + BIG_Y);
            u32x4 pxb[8], py[8];
#define LN1_LOADX(Q_) { const size_t rb_ = (size_t)(bid * 128 + 4 * (wave + NWAVES * (Q_)) + j4) * D + 8 * cg; \
                _Pragma("unroll") for (int i_ = 0; i_ < 8; ++i_) { \
                    pxb[i_] = *(const u32x4*)(xres + rb_ + 128 * i_); } }
#define LN1_LOADY(Q_) { const size_t rb_ = (size_t)(bid * 128 + 4 * (wave + NWAVES * (Q_)) + j4) * D + 8 * cg; \
                _Pragma("unroll") for (int i_ = 0; i_ < 8; ++i_) py[i_] = HAS_MIXER[layer] ? *(const u32x4*)(ybig + rb_ + 128 * i_) : (u32x4){0u, 0u, 0u, 0u}; }
            LN1_LOADX(0) LN1_LOADY(0)
            { const u32x4* img = (const u32x4*)(ws + WS_RW); LAS u32x4* dst = (LAS u32x4*)rwf;
              for (int i = tid; i < 4096; i += NTHR) dst[i] = img[i];
              const float* g1 = a.in[IN_LN1G] + layer * D; const float* b1 = a.in[IN_LN1B] + layer * D;
              for (int i = tid; i < 256; i += NTHR) { *(LAS f32x4*)(gbl + 4 * i) = *(const f32x4*)(g1 + 4 * i); *(LAS f32x4*)(gbl + 1024 + 4 * i) = *(const f32x4*)(b1 + 4 * i); } }
            if (tid < 16) lcnt[tid] = 0;
            __syncthreads();
#pragma unroll 1
            for (int q = 0; q < 4; ++q) {
                const int lt = 4 * (wave + NWAVES * q) + j4, t = bid * 128 + lt;
                float r[64];
#pragma unroll
                for (int i = 0; i < 8; ++i) {
                    { r[8 * i] = ALPHA * bf_lo(pxb[i].x); r[8 * i + 1] = ALPHA * bf_hi(pxb[i].x); r[8 * i + 2] = ALPHA * bf_lo(pxb[i].y); r[8 * i + 3] = ALPHA * bf_hi(pxb[i].y);
                        r[8 * i + 4] = ALPHA * bf_lo(pxb[i].z); r[8 * i + 5] = ALPHA * bf_hi(pxb[i].z); r[8 * i + 6] = ALPHA * bf_lo(pxb[i].w); r[8 * i + 7] = ALPHA * bf_hi(pxb[i].w); }
                    r[8 * i] += bf_lo(py[i].x); r[8 * i + 1] += bf_hi(py[i].x); r[8 * i + 2] += bf_lo(py[i].y); r[8 * i + 3] += bf_hi(py[i].y);
                    r[8 * i + 4] += bf_lo(py[i].z); r[8 * i + 5] += bf_hi(py[i].z); r[8 * i + 6] += bf_lo(py[i].w); r[8 * i + 7] += bf_hi(py[i].w); }
                if (q < 3) LN1_LOADY(q + 1)
                float s = 0.f;
#pragma unroll
                for (int i = 0; i < 64; i += 4) s += (r[i] + r[i + 1]) + (r[i + 2] + r[i + 3]);
                s += __shfl_xor(s, 4); s += __shfl_xor(s, 8); s += __shfl_xor(s, 16); s += __shfl_xor(s, 32);
                const float mean = s * (1.f / D);
                float s2 = 0.f;
#pragma unroll
                for (int i = 0; i < 64; i += 4) { const float d0 = r[i] - mean, d1 = r[i + 1] - mean, d2 = r[i + 2] - mean, d3 = r[i + 3] - mean; s2 += (d0 * d0 + d1 * d1) + (d2 * d2 + d3 * d3); }
                s2 += __shfl_xor(s2, 4); s2 += __shfl_xor(s2, 8); s2 += __shfl_xor(s2, 16); s2 += __shfl_xor(s2, 32);
                const float rstd = 1.f / sqrtf(s2 * (1.f / D) + LN_EPS);
                f32x4 acc[4];
#pragma unroll
                for (int eg = 0; eg < 4; ++eg) acc[eg] = (f32x4){0.f, 0.f, 0.f, 0.f};
#pragma unroll
                for (int i = 0; i < 8; ++i) {
                    const LAS float* gp = gbl + 8 * cg + 128 * i;
                    const f32x4 ga = *(const LAS f32x4*)gp, gb_ = *(const LAS f32x4*)(gp + 4), ba = *(const LAS f32x4*)(gp + 1024), bb = *(const LAS f32x4*)(gp + 1028);
                    r[8 * i] = (r[8 * i] - mean) * rstd * ga.x + ba.x; r[8 * i + 1] = (r[8 * i + 1] - mean) * rstd * ga.y + ba.y;
                    r[8 * i + 2] = (r[8 * i + 2] - mean) * rstd * ga.z + ba.z; r[8 * i + 3] = (r[8 * i + 3] - mean) * rstd * ga.w + ba.w;
                    r[8 * i + 4] = (r[8 * i + 4] - mean) * rstd * gb_.x + bb.x; r[8 * i + 5] = (r[8 * i + 5] - mean) * rstd * gb_.y + bb.y;
                    r[8 * i + 6] = (r[8 * i + 6] - mean) * rstd * gb_.z + bb.z; r[8 * i + 7] = (r[8 * i + 7] - mean) * rstd * gb_.w + bb.w;
                    u32x4 w; w.x = pk2(r[8 * i], r[8 * i + 1]); w.y = pk2(r[8 * i + 2], r[8 * i + 3]); w.z = pk2(r[8 * i + 4], r[8 * i + 5]); w.w = pk2(r[8 * i + 6], r[8 * i + 7]);
                    *(u32x4*)(actb + (size_t)t * D + 8 * cg + 128 * i) = w;
                    if (i == 4 && q < 3) LN1_LOADX(q + 1)
#pragma unroll
                    for (int ep = 0; ep < 2; ++ep) {
                        f32x4 wa[2], wb[2];
#pragma unroll
                        for (int e2 = 0; e2 < 2; ++e2) { const LAS float* wp = rwf + (2 * ep + e2) * 4096 + (cg + 16 * i) * 32 + j4 * 8; wa[e2] = *(const LAS f32x4*)wp; wb[e2] = *(const LAS f32x4*)(wp + 4); }
#pragma unroll
                        for (int e8 = 0; e8 < 8; ++e8)
#pragma unroll
                            for (int e2 = 0; e2 < 2; ++e2) acc[2 * ep + e2] = __builtin_amdgcn_mfma_f32_4x4x1f32(e8 < 4 ? wa[e2][e8 & 3] : wb[e2][e8 & 3], r[8 * i + e8], acc[2 * ep + e2], 0, 0, 0);
                    }
                }
                float lgt[16];
#pragma unroll
                for (int eg = 0; eg < 4; ++eg)
#pragma unroll
                    for (int k = 0; k < 4; ++k) { float v = acc[eg][k]; v += __shfl_xor(v, 4); v += __shfl_xor(v, 8); v += __shfl_xor(v, 16); v += __shfl_xor(v, 32); lgt[4 * eg + k] = v; }
                if (cg == 0) {
                    float sc[16], gs[4]; int i1[4], i2[4];
#pragma unroll
                    for (int eg = 0; eg < 4; ++eg) { float bz[4];
#pragma unroll
                        for (int k = 0; k < 4; ++k) { sc[4 * eg + k] = 1.f / (1.f + __expf(-lgt[4 * eg + k])); bz[k] = sc[4 * eg + k] + a.in[IN_RB][4 * eg + k]; }
                        float m1 = bz[0]; int j1 = 0;
#pragma unroll
                        for (int k = 1; k < 4; ++k) if (bz[k] > m1) { m1 = bz[k]; j1 = k; }
                        float m2 = -1e30f; int j2 = -1;
#pragma unroll
                        for (int k = 0; k < 4; ++k) if (k != j1 && bz[k] > m2) { m2 = bz[k]; j2 = k; }
                        gs[eg] = m1 + m2; i1[eg] = j1; i2[eg] = j2; }
                    int bg = 0; float bgs = gs[0];
#pragma unroll
                    for (int eg = 1; eg < 4; ++eg) if (gs[eg] > bgs) { bgs = gs[eg]; bg = eg; }
                    int j1 = 0, j2 = 0;
#pragma unroll
                    for (int eg = 0; eg < 4; ++eg) { j1 = (bg == eg) ? i1[eg] : j1; j2 = (bg == eg) ? i2[eg] : j2; }
                    const int e0 = bg * 4 + j1, e1 = bg * 4 + j2;
                    float sg1 = 0.f, sg2 = 0.f;
#pragma unroll
                    for (int k = 0; k < 16; ++k) { sg1 = (k == e0) ? sc[k] : sg1; sg2 = (k == e1) ? sc[k] : sg2; }
                    const float inv = 1.f / (sg1 + sg2);
                    const int p0 = atomicAdd((int*)(lcnt + e0), 1), p1 = atomicAdd((int*)(lcnt + e1), 1);
                    le[lt * 2] = (unsigned)e0 | ((unsigned)p0 << 8); le[lt * 2 + 1] = (unsigned)e1 | ((unsigned)p1 << 8);
                    lg[lt * 2] = sg1 * inv; lg[lt * 2 + 1] = sg2 * inv;
                }
            }
#undef LN1_LOADX
#undef LN1_LOADY
            __syncthreads();
            if (tid < 16) gbase[tid] = (int)xb_add(gcount + tid * 64, (unsigned)lcnt[tid]);
            __syncthreads();
            if (tid < 256) {
                const int lt = tid >> 1, t = bid * 128 + lt;
                if (t < T) {
                    const unsigned w = le[tid]; const int e = w & 255, pos = gbase[e] + (int)(w >> 8);
                    ((unsigned*)(ws + WS_LIST))[e * 32768 + pos] = (unsigned)t;
                    u32x2 ti; ti.x = (unsigned)e | ((unsigned)pos << 4); ti.y = __builtin_bit_cast(unsigned, lg[tid]);
                    *(u32x2*)(ws + WS_TOKINFO + (size_t)(t * 2 + (tid & 1)) * 8) = ti;
                }
            }
        }
        GRID_BAR();

        MoeMeta mm; mm.tstart = (LAS int*)(lds + MISC_OFF + 256); mm.cnt = mm.tstart + 32;
        if (tid_of(a.wv) == 0) { int acc = 0;
            for (int e = 0; e < 16; ++e) { const int c = (int)xb_ld(gcount + e * 64); mm.cnt[e] = c; mm.tstart[e] = acc; acc += (c + 255) >> 8; }
            mm.tstart[16] = acc; }
        __syncthreads();
        const int ntiles = mm.tstart[16];
#if DBG
        if (layer == DBG_LAYER) { dbg_check<layer>(a, lds, 1, mm); __syncthreads(); }
#endif
        {
            Moe1Sched S; S.A = (const char*)actb; S.Bt = (const char*)(ws + WS_WEXP1); S.K = D; S.lda = D * 2; S.kstepA = 128; S.mm = mm; S.ntiles = ntiles; S.G = G; S.c = bid;
            S.tab = (LAS unsigned*)(lds + AUX_OFF);
            const int tid = tid_of(a.wv);
            pg8::Unit u;
            for (int i = 0; i < 8 && S.next(i, u); ++i) {
                if (tid < 256) { const int pos = (u.pm - mm.tstart[u.e]) * 256 + tid;
                    const unsigned tok = (pos < mm.cnt[u.e]) ? ((const unsigned*)(ws + WS_LIST))[u.e * 32768 + pos] : 0u;
                    S.tab[i * 256 + tid] = tok * (unsigned)(D * 2); }
            }
            __syncthreads();
            pg8::EpiSwiglu E{(bf16_t*)(ws + WS_BIG + BIG_H)};
            pg8::gemm_phase(lds + STAGE_OFF, S, E, a.wv);
        }
        GRID_BAR();
#if DBG
        if (layer == DBG_LAYER) { dbg_check<layer>(a, lds, 2, mm); __syncthreads(); }
#endif
        {
            Moe2Sched S; S.A = (const char*)(ws + WS_BIG + BIG_H); S.Bt = (const char*)(ws + WS_WEXP2); S.K = DEXP; S.lda = DEXP * 2; S.kstepA = 128; S.mm = mm; S.ntiles = ntiles; S.G = G; S.c = bid;
            pg8::EpiStore E{(bf16_t*)(ws + WS_BIG + BIG_YB), (size_t)D};
            pg8::gemm_phase(lds + STAGE_OFF, S, E, a.wv);
        }
        GRID_BAR();
#if DBG
        if (layer == DBG_LAYER) { dbg_check<layer>(a, lds, 3, mm); __syncthreads(); }
#endif
        {
            const int tid = tid_of(a.wv), lane = tid & 63;
            const float* g2 = a.in[IN_LN2G] + layer * D; const float* b2 = a.in[IN_LN2B] + layer * D;
            RowVec gv, bv;
#pragma unroll
            for (int j = 0; j < 4; ++j) { gv.v[j] = *(const f32x4*)(g2 + 4 * lane + 256 * j); bv.v[j] = *(const f32x4*)(b2 + 4 * lane + 256 * j); }
            const bf16_t* yb = (const bf16_t*)(ws + WS_BIG + BIG_YB);
            u32x4 tiN[2]; u32x2 px[2][4], py0[2][4], py1[2][4]; float cw0[2], cw1[2];
#define LN2_LOAD(S_, TR_) { const u32x4 ti_ = tiN[S_]; const int e0 = ti_.x & 15, p0 = ti_.x >> 4, e1 = ti_.z & 15, p1 = ti_.z >> 4; cw0[S_] = u2f(ti_.y); cw1[S_] = u2f(ti_.w); \
                const size_t s0 = (size_t)mm.tstart[e0] * 256 + p0, s1 = (size_t)mm.tstart[e1] * 256 + p1; \
                _Pragma("unroll") for (int j = 0; j < 4; ++j) { px[S_][j] = *(const u32x2*)(actb + (size_t)(TR_) * D + 4 * lane + 256 * j); \
                    py0[S_][j] = *(const u32x2*)(yb + s0 * D + 4 * lane + 256 * j); py1[S_][j] = *(const u32x2*)(yb + s1 * D + 4 * lane + 256 * j); } }
            static_assert(T % (2 * 256 * NWAVES) == 0, "LN2 row pairing");
            tiN[0] = *(const u32x4*)(ws + WS_TOKINFO + (size_t)gw * 16); tiN[1] = *(const u32x4*)(ws + WS_TOKINFO + (size_t)(gw + NGW) * 16);
            LN2_LOAD(0, gw) LN2_LOAD(1, gw + NGW)
            if (gw + 2 * NGW < T) { tiN[0] = *(const u32x4*)(ws + WS_TOKINFO + (size_t)(gw + 2 * NGW) * 16); tiN[1] = *(const u32x4*)(ws + WS_TOKINFO + (size_t)(gw + 3 * NGW) * 16); }
            for (int tb = gw; tb < T; tb += 2 * NGW) {
#pragma unroll
                for (int s = 0; s < 2; ++s) {
                    const int t = tb + s * NGW;
                    const float w0 = cw0[s], w1 = cw1[s];
                    RowVec r;
#pragma unroll
                    for (int j = 0; j < 4; ++j) {
                        const u32x2 xv = px[s][j], y0 = py0[s][j], y1 = py1[s][j];
                        r.v[j].x = ALPHA * bf_lo(xv.x) + w0 * bf_lo(y0.x) + w1 * bf_lo(y1.x);
                        r.v[j].y = ALPHA * bf_hi(xv.x) + w0 * bf_hi(y0.x) + w1 * bf_hi(y1.x);
                        r.v[j].z = ALPHA * bf_lo(xv.y) + w0 * bf_lo(y0.y) + w1 * bf_lo(y1.y);
                        r.v[j].w = ALPHA * bf_hi(xv.y) + w0 * bf_hi(y0.y) + w1 * bf_hi(y1.y);
                    }
                    if (t + 2 * NGW < T) { const int tn = t + 2 * NGW;
                        LN2_LOAD(s, tn)
                        if (tn + 2 * NGW < T) tiN[s] = *(const u32x4*)(ws + WS_TOKINFO + (size_t)(tn + 2 * NGW) * 16); }
                    float mean, rstd; ln_stats(r, mean, rstd);
#pragma unroll
                    for (int j = 0; j < 4; ++j) { r.v[j] = (r.v[j] - mean) * rstd * gv.v[j] + bv.v[j];
                        if (layer == DEPTH - 1) *(f32x4*)(xout + (size_t)t * D + 4 * lane + 256 * j) = r.v[j];
                        else { u32x2 w; w.x = pk2(r.v[j].x, r.v[j].y); w.y = pk2(r.v[j].z, r.v[j].w);
                            *(u32x2*)(xres + (size_t)t * D + 4 * lane + 256 * j) = w; } }
                }
            }
#undef LN2_LOAD
            if (layer + 1 < DEPTH) convert_layer_weights(a, layer + 1, lds, gw, NGW, wave, lane);
        }
        GRID_BAR();
#if DBG
        if (layer == DBG_LAYER) { dbg_check<layer>(a, lds, 4, mm); GRID_BAR(); }
#endif
}

__global__ void __launch_bounds__(NTHR, 2) fwd(Args a_in) {
    Args a = a_in; a.wv = __builtin_amdgcn_readfirstlane((int)(threadIdx.x >> 6));
    extern __shared__ __attribute__((aligned(16))) unsigned char lds_raw[];
    LAS unsigned char* lds = (LAS unsigned char*)lds_raw;
    volatile LAS unsigned* MISC = (volatile LAS unsigned*)(lds + MISC_OFF);
    const int tid = tid_of(a.wv), lane = tid & 63, wave = a.wv;
    const int G = gridDim.x, bid = blockIdx.x;
    const int gw = bid * NWAVES + wave, NGW = G * NWAVES;
    if (tid < 256) MISC[tid] = 0u;
    __syncthreads();
    unsigned* ctl = (unsigned*)(a.ws + WS_CTL);
    XcdBarrier bar = xcd_barrier_post(ctl + CW_BAR, MISC + 8); bar.wv = a.wv;
    if (PROBE_LO >= 0 && tid == 0) { const unsigned long long now = __builtin_amdgcn_s_memrealtime(); MISC[18] = (unsigned)now; MISC[19] = (unsigned)(now >> 32); }
    unsigned char* ws = a.ws;
    bf16_t* actb = (bf16_t*)(ws + WS_ACTB);
    float* xout = a.out;

    convert_layer_weights(a, 0, lds, gw, NGW, wave, lane);
    for (int i = bid * NTHR + tid; i < 16 * 2048; i += G * NTHR) { const int hd = i >> 11, n = i & 2047;
        int bk = n; if (n >= 16) { const float lf = logf((float)n / 16.f) / 4.852030263919617f; bk = 16 + (int)(lf * 16.f); bk = bk > 31 ? 31 : bk; }
        ((float*)(a.ws + WS_BIASG))[i] = a.in[IN_REL][bk * 16 + hd] * LOG2E; }
    for (int i = bid * NTHR + tid; i < 16384; i += G * NTHR) { const int e8 = i & 7, ei = (i >> 3) & 3, ch = (i >> 5) & 127, eg = i >> 12;
        ((float*)(a.ws + WS_RW))[i] = a.in[IN_RW][(8 * ch + e8) * 16 + 4 * eg + ei]; }
    { const float* x = a.in[IN_X];
      constexpr size_t XS = (size_t)256 * NTHR * 8;
      static_assert(((size_t)T * D) % (XS * 4) == 0, "x conversion sweep");
      for (size_t i = ((size_t)bid * NTHR + tid) * 8; i < (size_t)T * D; i += XS * 4) {
          f32x4 v0[4], v1[4];
#pragma unroll
          for (int q = 0; q < 4; ++q) { v0[q] = *(const f32x4*)(x + i + q * XS); v1[q] = *(const f32x4*)(x + i + q * XS + 4); }
#pragma unroll
          for (int q = 0; q < 4; ++q) { u32x4 w; w.x = pk2(v0[q].x, v0[q].y); w.y = pk2(v0[q].z, v0[q].w); w.z = pk2(v1[q].x, v1[q].y); w.w = pk2(v1[q].z, v1[q].w);
              *(u32x4*)((bf16_t*)xout + i + q * XS) = w; } } }
    GRID_BAR();

    run_layer<0>(a, lds, bar);
#if DBG
    if (DBG_LAYER >= 1) run_layer<1>(a, lds, bar);
    if (DBG_LAYER >= 2) run_layer<2>(a, lds, bar);
    if (DBG_LAYER >= 3) run_layer<3>(a, lds, bar);
    dbg_final(a);
#else
    run_layer<1>(a, lds, bar);
    run_layer<2>(a, lds, bar);
    run_layer<3>(a, lds, bar);
#endif
    if (PROBE_LO >= 0) { __syncthreads(); const unsigned long long acc = (unsigned long long)MISC[20] | ((unsigned long long)MISC[21] << 32); const unsigned long long t0 = __builtin_amdgcn_s_memrealtime();
        while (__builtin_amdgcn_s_memrealtime() - t0 < acc * (unsigned long long)PROBE_MULT) __builtin_amdgcn_s_sleep(8); }
}

extern "C" void kernel_launch(void* const* d_in, const int* in_sizes, int n_in, void* d_out, int out_size, void* d_ws, size_t ws_size, hipStream_t stream) {
    static int grid = 0;
    if (grid == 0) {
        int dev = 0, cus = 0;
        if (n_in != 25 || out_size != T * D || ws_size < WS_END) { fprintf(stderr, "kernel_launch: unexpected shapes (n_in %d out %d ws %zu)\n", n_in, out_size, ws_size); grid = -1; return; }
        if (hipGetDevice(&dev) != hipSuccess || hipDeviceGetAttribute(&cus, hipDeviceAttributeMultiprocessorCount, dev) != hipSuccess) { grid = -1; return; }
        if (hipFuncSetAttribute((const void*)fwd, hipFuncAttributeMaxDynamicSharedMemorySize, LDS_BYTES) != hipSuccess) { grid = -1; return; }
        (void)hipGetLastError();
        grid = cus;
        if (grid != 256) { fprintf(stderr, "kernel_launch: built for 256 CUs, got %d\n", grid); grid = -1; return; }
    }
    if (grid < 0) return;
    (void)hipMemsetAsync(d_ws, 0, 1u << 20, stream);
    Args a{};
    for (int i = 0; i < 25; ++i) a.in[i] = (const float*)d_in[i];
    a.out = (float*)d_out; a.ws = (unsigned char*)d_ws;
    hipLaunchKernelGGL(fwd, dim3(grid), dim3(NTHR), LDS_BYTES, stream, a);
}
```

```cpp
#include <hip/hip_runtime.h>
#include <cstdio>
#include <cstdint>
#define DBG 0
#define DBG_LAYER 0

#define LAS __attribute__((address_space(3)))
#define GAS __attribute__((address_space(1)))
#define DI __device__ __forceinline__
typedef unsigned short bf16_t;
typedef short bf16x8 __attribute__((ext_vector_type(8)));
typedef short s16x4 __attribute__((ext_vector_type(4)));
typedef float f32x2 __attribute__((ext_vector_type(2)));
typedef float f32x4 __attribute__((ext_vector_type(4)));
typedef float f32x16 __attribute__((ext_vector_type(16)));
typedef unsigned u32x2 __attribute__((ext_vector_type(2)));
typedef unsigned u32x4 __attribute__((ext_vector_type(4)));

constexpr int BATCH = 2, SEQ = 16384, D = 1024, T = BATCH * SEQ, DEPTH = 4, NH = 16, HD = 64;
constexpr int NE = 16, DEXP = 256;
constexpr float ALPHA = 1.681792830507429f;
constexpr float LN_EPS = 1e-5f;
constexpr int NWAVES = 8, NTHR = 512;

constexpr size_t MiB = 1u << 20;
constexpr size_t WS_CTL = 0;
constexpr size_t WS_TOKINFO = 1 * MiB;
constexpr size_t WS_SMALL = 1 * MiB + 512 * 1024;
constexpr size_t WS_LIST = 2 * MiB;
constexpr size_t WS_WIN = 4 * MiB;
constexpr size_t WS_WOUT = 22 * MiB;
constexpr size_t WS_WEXP1 = 24 * MiB;
constexpr size_t WS_WEXP2 = 40 * MiB;
constexpr size_t WS_WCMP = 48 * MiB;
constexpr size_t WS_ACTB = 52 * MiB;
constexpr size_t WS_BIG = 116 * MiB;
constexpr size_t WS_END = 512 * MiB;
constexpr size_t BIG_Y = 0;
constexpr size_t BIG_H = 64 * MiB;
constexpr size_t BIG_YB = 100 * MiB;
constexpr size_t BIG_XLO = 240 * MiB;
constexpr int PROWS = 2 * T + NE * 256;

constexpr int CW_BAR = 4096;
constexpr int CW_DBG = 8;
constexpr int CW_MOE = 16384;

constexpr int LDS_BYTES = 160 * 1024;
constexpr int STAGE_OFF = 0;
constexpr int AUX_OFF = 128 * 1024;
constexpr int MISC_OFF = LDS_BYTES - 1024;

DI unsigned f2bf(float f) { unsigned u = __builtin_bit_cast(unsigned, f); return (u + 0x7fffu + ((u >> 16) & 1u)) >> 16; }
DI unsigned pk2(float lo, float hi) { return f2bf(lo) | (f2bf(hi) << 16); }
typedef __bf16 bf16x2_t __attribute__((ext_vector_type(2)));
DI unsigned cvt_pk_bf16(float lo, float hi) { const bf16x2_t r = __builtin_convertvector((f32x2){lo, hi}, bf16x2_t); return __builtin_bit_cast(unsigned, r); }
DI float u2f(unsigned u) { return __builtin_bit_cast(float, u); }
DI unsigned f2u(float f) { return __builtin_bit_cast(unsigned, f); }
DI float bf_lo(unsigned w) { return __builtin_bit_cast(float, w << 16); }
DI float bf_hi(unsigned w) { return __builtin_bit_cast(float, w & 0xffff0000u); }
DI float wave_sum(float v) {
#pragma unroll
    for (int o = 1; o < 64; o <<= 1) v += __shfl_xor(v, o);
    return v;
}
DI int tid_of(int wv) { int l; asm volatile("v_mbcnt_lo_u32_b32 %0, -1, 0\n\tv_mbcnt_hi_u32_b32 %0, -1, %0" : "=v"(l)); return (wv << 6) | l; }
DI float xor32h(float v, int h) { const unsigned u = __builtin_bit_cast(unsigned, v); const u32x2 s = __builtin_amdgcn_permlane32_swap(u, u, false, false);
    return __builtin_bit_cast(float, h ? s.x : s.y); }
DI float quad_xor1(float v) { return __builtin_bit_cast(float, __builtin_amdgcn_update_dpp(0, __builtin_bit_cast(int, v), 0xB1, 0xf, 0xf, false)); }
DI float quad_xor2(float v) { return __builtin_bit_cast(float, __builtin_amdgcn_update_dpp(0, __builtin_bit_cast(int, v), 0x4E, 0xf, 0xf, false)); }
DI float row_ror4(float v) { return __builtin_bit_cast(float, __builtin_amdgcn_update_dpp(0, __builtin_bit_cast(int, v), 0x124, 0xf, 0xf, false)); }
DI float row_ror8(float v) { return __builtin_bit_cast(float, __builtin_amdgcn_update_dpp(0, __builtin_bit_cast(int, v), 0x128, 0xf, 0xf, false)); }
#define LDS_WAIT() asm volatile("s_waitcnt lgkmcnt(0)" ::: "memory")
#define VM_WAIT() asm volatile("s_waitcnt vmcnt(0)" ::: "memory")

#define XB_TMO      128
#define XB_XCNT(j)  (256  + 64 * (j))
#define XB_XSUB(j)  (1280 + 64 * (j))
#define XB_XGEN(j)  (2304 + 64 * (j))
#define XB_TOP      3328
#define XB_TOPGEN   3392
#define XCD_BAR_WORDS 3456
#define XB_SPIN_CAP (1u << 22)
DI unsigned xb_ld(unsigned* p)              { return __hip_atomic_load(p, __ATOMIC_RELAXED, __HIP_MEMORY_SCOPE_AGENT); }
DI unsigned xb_add(unsigned* p, unsigned v) { return __hip_atomic_fetch_add(p, v, __ATOMIC_RELAXED, __HIP_MEMORY_SCOPE_AGENT); }
DI unsigned xb_xcc_id() { return (unsigned)__builtin_amdgcn_s_getreg((3 << 11) | 20) & 0xFu; }
#define XB_SPIN(cond, bar) do { unsigned _sp = 0; while (cond) { __builtin_amdgcn_s_sleep(1); \
    if ((++_sp & 255u) == 0u) { if (xb_ld(&(bar)[XB_TMO])) break; if (_sp > XB_SPIN_CAP) { atomicAdd(&(bar)[XB_TMO], 1u); break; } } } } while (0)
struct XcdBarrier { unsigned* bar; unsigned x; volatile LAS unsigned* st; int wv; };
DI XcdBarrier xcd_barrier_post(unsigned* bar, volatile LAS unsigned* st) {
    XcdBarrier b; b.bar = bar; b.x = xb_xcc_id(); b.st = st;
    if (threadIdx.x == 0) (void)xb_add(&bar[XB_XCNT(b.x)], 1u);
    return b;
}
DI void xcd_barrier_complete(unsigned* bar, unsigned x, unsigned& nloc, unsigned& nx) {
    const unsigned G = gridDim.x * gridDim.y * gridDim.z;
    unsigned sum, cnt, mine, sp = 0u;
    for (;;) {
        sum = 0u; cnt = 0u; mine = 0u;
#pragma unroll
        for (unsigned j = 0; j < 16; ++j) { const unsigned c = xb_ld(&bar[XB_XCNT(j)]); sum += c; cnt += (c > 0u) ? 1u : 0u; mine = (j == x) ? c : mine; }
        if (sum == G) break;
        __builtin_amdgcn_s_sleep(1);
        if ((++sp & 255u) == 0u) { if (xb_ld(&bar[XB_TMO])) break; if (sp > XB_SPIN_CAP) { atomicAdd(&bar[XB_TMO], 1u); break; } }
    }
    nloc = mine > 0u ? mine : 1u; nx = cnt > 0u ? cnt : 1u;
}
DI void xcd_barrier(const XcdBarrier& b) {
    asm volatile("s_waitcnt vmcnt(0)" ::: "memory");
    __syncthreads();
    if (tid_of(b.wv) == 0) {
        unsigned* bar = b.bar;
        const unsigned bx = xb_xcc_id();
        __builtin_amdgcn_s_waitcnt(0);
        unsigned nloc = b.st[0], nx = b.st[1];
        if (nloc == 0u) { xcd_barrier_complete(bar, bx, nloc, nx); b.st[0] = nloc; b.st[1] = nx; }
        const unsigned old = xb_add(&bar[XB_XSUB(bx)], 1u);
        const unsigned gen = old / nloc;
        if (old + 1u == (gen + 1u) * nloc) {
            __builtin_amdgcn_fence(__ATOMIC_RELEASE, "agent");
            asm volatile("s_waitcnt vmcnt(0)" ::: "memory");
            (void)xb_add(&bar[XB_TOP], 1u);
        }
        XB_SPIN(xb_ld(&bar[XB_TOP]) < (gen + 1u) * nx, bar);
        __builtin_amdgcn_fence(__ATOMIC_ACQUIRE, "agent");
        asm volatile("s_waitcnt vmcnt(0)" ::: "memory");
    }
    __syncthreads();
}

namespace pg8 {
constexpr int BM = 256, BK = 64, HALF = 128, HTB = HALF * BK * 2, STAGE_BYTES = 8 * HTB, NXCD = 8, WGM = 8;
__host__ __device__ __forceinline__ int lds_byte(int r, int c) { const int st = (r >> 4) * 2 + (c >> 5), rr = r & 15, cc = c & 31, ob = rr * 64 + cc * 2; return st * 1024 + (ob ^ (((ob >> 9) & 1) << 5)); }
__host__ __device__ __forceinline__ void stage_rc(int b, int& R, int& C) { const int st = b / 1024, sb = b % 1024, swz = sb ^ (((sb >> 9) & 1) << 5); R = (st >> 1) * 16 + swz / 64; C = (st & 1) * 32 + (swz % 64) / 2; }
__host__ __device__ __forceinline__ int perm32(int rho) { const int n = rho >> 4, i = rho & 15; return 8 * (i >> 2) + 4 * n + (i & 3); }

struct Unit { int pm, pn, e; };

struct TileOrder {
    int nM, nN, nwg, G, c;
    DI void init(int nM_, int nN_, int G_, int c_) { nM = nM_; nN = nN_; nwg = nM * nN; G = G_; c = c_; }
    DI bool next(int i, int& pm, int& pn) const {
        const long L = (long)i * G + c; if (L >= nwg) return false;
        int wgid = (int)L; { const int q = nwg / NXCD, r = nwg % NXCD, xcd = wgid % NXCD, off = wgid / NXCD; wgid = (xcd < r ? xcd * (q + 1) : r * (q + 1) + (xcd - r) * q) + off; }
        const int nig = WGM * nN, gid = wgid / nig, fm = gid * WGM, gsz = (nM - fm) < WGM ? (nM - fm) : WGM;
        pm = fm + ((wgid % nig) % gsz); pn = (wgid % nig) / gsz; return true;
    }
};
struct DenseSched {
    static constexpr bool GATHER = false;
    const char* A; const char* Bt; int K; unsigned lda, kstepA; TileOrder ord;
    DI void init(const void* A_, unsigned lda_, unsigned kstepA_, const void* Bt_, int M, int N, int K_, int G, int c) { A = (const char*)A_; Bt = (const char*)Bt_; K = K_; lda = lda_; kstepA = kstepA_; ord.init(M / BM, N / BM, G, c); }
    DI bool next(int i, Unit& u) const { u.e = 0; return ord.next(i, u.pm, u.pn); }
    DI const char* a_base(const Unit& u) const { return A + (size_t)u.pm * BM * lda; }
    DI const char* b_base(const Unit& u) const { return Bt + (size_t)u.pn * BM * K * 2; }
    DI unsigned row_off(int, int) const { return 0u; }
};

struct ColTileSched {
    static constexpr bool GATHER = false;
    const char* A; const char* Bt; int K; unsigned lda, kstepA; int pn, nunits, nranks, rank;
    DI bool next(int i, Unit& u) const { if (rank < 0) return false; const int L = i * nranks + rank; if (L >= nunits) return false; u.pm = L; u.pn = pn; u.e = 0; return true; }
    DI const char* a_base(const Unit& u) const { return A + (size_t)u.pm * BM * lda; }
    DI const char* b_base(const Unit& u) const { return Bt + (size_t)u.pn * BM * K * 2; }
    DI unsigned row_off(int, int) const { return 0u; }
};

template <class Epi, class Sched>
DI void gemm_phase(LAS unsigned char* lds, const Sched& S, const Epi& E, int wv) {
    int tid = tid_of(wv); asm volatile("" : "+v"(tid));
    const int wid = __builtin_amdgcn_readfirstlane(tid >> 6), lane = tid & 63, wr = wid >> 2, wc = wid & 3, fr = lane & 15, fq = lane >> 4;
    const int K = S.K, nt = K / BK;
    unsigned voffB[2]; int Rr[2]; unsigned Cb[2];
#pragma unroll
    for (int i = 0; i < 2; ++i) { int R, C; stage_rc(tid * 16 + i * 8192, R, C); const int Rb = (R & ~31) + perm32(R & 31);
        voffB[i] = (unsigned)(Rb * K + C) * 2u; Rr[i] = R; Cb[i] = (unsigned)C * 2u; }
    const unsigned kstepA = S.kstepA, kstepB = (unsigned)(BK * 2);
    const size_t hstepB = (size_t)HALF * K * 2;
    const unsigned ldsw = (unsigned)wid * 1024u;
    const int aoff = lds_byte(wr * 64 + fr, fq * 8), boff = lds_byte(wc * 32 + fr, fq * 8);
#define PG8_SA(b, h) (((b) * 2 + (h)) * HTB)
#define PG8_SB(b, h) ((4 + (b) * 2 + (h)) * HTB)
#define PG8_STAGE_A(bufoff, basep, vv, h, koff) do { _Pragma("unroll") for (int _i = 0; _i < 2; ++_i) \
        __builtin_amdgcn_global_load_lds((const unsigned*)((basep) + (vv)[h][_i] + (koff)), (LAS unsigned*)(lds + (bufoff) + ldsw + _i * 8192), 16, 0, 0); } while (0)
#define PG8_STAGE_B(bufoff, ptr) do { _Pragma("unroll") for (int _i = 0; _i < 2; ++_i) \
        __builtin_amdgcn_global_load_lds((const unsigned*)((ptr) + voffB[_i]), (LAS unsigned*)(lds + (bufoff) + ldsw + _i * 8192), 16, 0, 0); } while (0)
#define PG8_LDA(dst, b, h) do { _Pragma("unroll") for (int m = 0; m < 4; ++m) _Pragma("unroll") for (int k = 0; k < 2; ++k) dst[m][k] = *(const LAS bf16x8*)(lds + PG8_SA(b, h) + aoff + m * 2048 + k * 1024); } while (0)
#define PG8_LDB(dst, b, h) do { _Pragma("unroll") for (int n = 0; n < 2; ++n) _Pragma("unroll") for (int k = 0; k < 2; ++k) dst[n][k] = *(const LAS bf16x8*)(lds + PG8_SB(b, h) + boff + n * 2048 + k * 1024); } while (0)
#define PG8_MMA(ai, bj, At, Bt) do { __builtin_amdgcn_s_setprio(1); _Pragma("unroll") for (int m = 0; m < 4; ++m) _Pragma("unroll") for (int n = 0; n < 2; ++n) _Pragma("unroll") for (int k = 0; k < 2; ++k) \
        acc[ai][bj][m][n] = __builtin_amdgcn_mfma_f32_16x16x32_bf16(Bt[n][k], At[m][k], acc[ai][bj][m][n], 0, 0, 0); __builtin_amdgcn_s_setprio(0); } while (0)
#define PG8_WAIT_V(n) asm volatile("s_waitcnt vmcnt(" #n ")" ::: "memory")
#define PG8_WAIT_L(n) asm volatile("s_waitcnt lgkmcnt(" #n ")" ::: "memory")
#define PG8_BAR __builtin_amdgcn_s_barrier()
#define PG8_SCHED __builtin_amdgcn_sched_barrier(0)
    Unit cur, nxt; int ui = 0;
    if (!S.next(0, cur)) return;
    unsigned vA[2][2], vN[2][2];
#pragma unroll
    for (int h = 0; h < 2; ++h)
#pragma unroll
        for (int i = 0; i < 2; ++i) { vA[h][i] = (Sched::GATHER ? S.row_off(0, h * HALF + Rr[i]) : (unsigned)(h * HALF + Rr[i]) * S.lda) + Cb[i]; vN[h][i] = vA[h][i]; }
    f32x4 acc[2][2][4][2];
#pragma unroll
    for (int a = 0; a < 2; ++a)
#pragma unroll
        for (int b = 0; b < 2; ++b)
#pragma unroll
            for (int m = 0; m < 4; ++m)
#pragma unroll
                for (int n = 0; n < 2; ++n) acc[a][b][m][n] = (f32x4){0.f, 0.f, 0.f, 0.f};
    bf16x8 At[4][2], B0[2][2], B1[2][2];
    const char* cA = S.a_base(cur); const char* cB = S.b_base(cur);
    PG8_STAGE_B(PG8_SB(0, 0), cB); PG8_STAGE_A(PG8_SA(0, 0), cA, vA, 0, 0u); PG8_STAGE_B(PG8_SB(0, 1), cB + hstepB); PG8_STAGE_A(PG8_SA(0, 1), cA, vA, 1, 0u);
    if (wr == 1) PG8_BAR;
    PG8_WAIT_V(4); PG8_BAR;
    PG8_STAGE_B(PG8_SB(1, 0), cB + kstepB); PG8_STAGE_A(PG8_SA(1, 0), cA, vA, 0, kstepA); PG8_STAGE_B(PG8_SB(1, 1), cB + hstepB + kstepB);
    PG8_WAIT_V(6); PG8_BAR;
    for (;;) {
        const bool has_next = S.next(ui + 1, nxt);
        const char* nA = has_next ? S.a_base(nxt) : cA; const char* nB = has_next ? S.b_base(nxt) : cB;
        if (Sched::GATHER) {
#pragma unroll
            for (int h = 0; h < 2; ++h)
#pragma unroll
                for (int i = 0; i < 2; ++i) vN[h][i] = has_next ? (S.row_off(ui + 1, h * HALF + Rr[i]) + Cb[i]) : vA[h][i];
        }
        for (int t = 0; t < nt; t += 2) {
            const bool last = (t == nt - 2);
            const unsigned k1 = (unsigned)(t + 1) * kstepA;
            const char* a2p = last ? nA : cA; const unsigned k2 = last ? 0u : (unsigned)(t + 2) * kstepA;
            unsigned v2[2][2];
#pragma unroll
            for (int h = 0; h < 2; ++h)
#pragma unroll
                for (int i = 0; i < 2; ++i) v2[h][i] = (Sched::GATHER && last) ? vN[h][i] : vA[h][i];
            const char* b2 = last ? nB : cB + (size_t)(t + 2) * kstepB; const char* b3 = b2 + kstepB;
            PG8_LDB(B0, 0, 0); PG8_SCHED; PG8_LDA(At, 0, 0); PG8_STAGE_A(PG8_SA(1, 1), cA, vA, 1, k1);
            PG8_WAIT_L(8); PG8_BAR; PG8_WAIT_L(0); PG8_MMA(0, 0, At, B0); PG8_BAR; PG8_SCHED;
            PG8_LDB(B1, 0, 1); PG8_STAGE_B(PG8_SB(0, 0), b2);
            PG8_BAR; PG8_WAIT_L(0); PG8_MMA(0, 1, At, B1); PG8_BAR;
            PG8_LDA(At, 0, 1); PG8_STAGE_A(PG8_SA(0, 0), a2p, v2, 0, k2);
            PG8_BAR; PG8_WAIT_L(0); PG8_MMA(1, 0, At, B0); PG8_BAR; PG8_SCHED;
            PG8_STAGE_B(PG8_SB(0, 1), b2 + hstepB);
            PG8_WAIT_V(6); PG8_BAR; PG8_MMA(1, 1, At, B1); PG8_BAR;
            PG8_LDB(B0, 1, 0); PG8_SCHED; PG8_LDA(At, 1, 0); PG8_STAGE_A(PG8_SA(0, 1), a2p, v2, 1, k2);
            PG8_WAIT_L(8); PG8_BAR; PG8_WAIT_L(0); PG8_MMA(0, 0, At, B0); PG8_BAR; PG8_SCHED;
            PG8_LDB(B1, 1, 1); PG8_STAGE_B(PG8_SB(1, 0), b3);
            PG8_BAR; PG8_WAIT_L(0); PG8_MMA(0, 1, At, B1); PG8_BAR;
            PG8_LDA(At, 1, 1); PG8_STAGE_A(PG8_SA(1, 0), a2p, v2, 0, k2 + kstepA);
            PG8_BAR; PG8_WAIT_L(0); PG8_MMA(1, 0, At, B0); PG8_BAR; PG8_SCHED;
            PG8_STAGE_B(PG8_SB(1, 1), b3 + hstepB);
            PG8_WAIT_V(6); PG8_BAR; PG8_MMA(1, 1, At, B1); PG8_BAR;
        }
        E(acc, cur, wr, wc, fr, fq);
        if (!has_next) break;
#pragma unroll
        for (int a = 0; a < 2; ++a)
#pragma unroll
            for (int b = 0; b < 2; ++b)
#pragma unroll
                for (int m = 0; m < 4; ++m)
#pragma unroll
                    for (int n = 0; n < 2; ++n) acc[a][b][m][n] = (f32x4){0.f, 0.f, 0.f, 0.f};
        cur = nxt; cA = nA; cB = nB; ++ui;
#pragma unroll
        for (int h = 0; h < 2; ++h)
#pragma unroll
            for (int i = 0; i < 2; ++i) vA[h][i] = vN[h][i];
    }
    PG8_WAIT_V(0);
    if (wr == 0) PG8_BAR;
    PG8_BAR;
#undef PG8_SA
#undef PG8_SB
#undef PG8_STAGE_A
#undef PG8_STAGE_B
#undef PG8_LDA
#undef PG8_LDB
#undef PG8_MMA
#undef PG8_WAIT_V
#undef PG8_WAIT_L
#undef PG8_BAR
#undef PG8_SCHED
}

struct EpiStore {
    bf16_t* O; size_t ldc;
    DI void operator()(const f32x4 (&acc)[2][2][4][2], const Unit& u, int wr, int wc, int fr, int fq) const {
        const int row0 = u.pm * BM + wr * 64 + fr, col0 = u.pn * BM + wc * 32 + 8 * fq;
#pragma unroll
        for (int ai = 0; ai < 2; ++ai)
#pragma unroll
            for (int m = 0; m < 4; ++m) { bf16_t* rowp = O + (size_t)(row0 + ai * HALF + m * 16) * ldc + col0;
#pragma unroll
                for (int bj = 0; bj < 2; ++bj) { const f32x4 v0 = acc[ai][bj][m][0], v1 = acc[ai][bj][m][1];
                    u32x4 w; w.x = cvt_pk_bf16(v0[0], v0[1]); w.y = cvt_pk_bf16(v0[2], v0[3]); w.z = cvt_pk_bf16(v1[0], v1[1]); w.w = cvt_pk_bf16(v1[2], v1[3]);
                    *(u32x4*)(rowp + bj * HALF) = w; } }
    }
};
struct EpiSwiglu {
    bf16_t* Hb;
    DI void operator()(const f32x4 (&acc)[2][2][4][2], const Unit& u, int wr, int wc, int fr, int fq) const {
        const int row0 = u.pm * BM + wr * 64 + fr, col0 = u.pn * HALF + wc * 32 + 8 * fq;
#pragma unroll
        for (int ai = 0; ai < 2; ++ai)
#pragma unroll
            for (int m = 0; m < 4; ++m) { bf16_t* rowp = Hb + (size_t)(row0 + ai * HALF + m * 16) * DEXP + col0;
                float o[8];
#pragma unroll
                for (int n = 0; n < 2; ++n)
#pragma unroll
                    for (int j = 0; j < 4; ++j) { const float g = acc[ai][0][m][n][j], up = acc[ai][1][m][n][j];
                        o[n * 4 + j] = g * up * __builtin_amdgcn_rcpf(1.0f + __builtin_amdgcn_exp2f(-1.4426950408889634f * g)); }
                u32x4 w; w.x = cvt_pk_bf16(o[0], o[1]); w.y = cvt_pk_bf16(o[2], o[3]); w.z = cvt_pk_bf16(o[4], o[5]); w.w = cvt_pk_bf16(o[6], o[7]);
                *(u32x4*)rowp = w; }
    }
};

struct EpiNsa {
    bf16_t* Q; bf16_t* KV; float* GT;
    DI void operator()(const f32x4 (&acc)[2][2][4][2], const Unit& u, int wr, int wc, int fr, int fq) const {
        const int row0 = u.pm * BM + wr * 64 + fr;
        if (u.pn < 10) {
            bf16_t* base = (u.pn < 4) ? Q + u.pn * BM : KV + (u.pn - 4) * BM; const size_t ldc = (u.pn < 4) ? 1024 : 1536; const int col0 = wc * 32 + 8 * fq;
#pragma unroll
            for (int ai = 0; ai < 2; ++ai)
#pragma unroll
                for (int m = 0; m < 4; ++m) { bf16_t* rowp = base + (size_t)(row0 + ai * HALF + m * 16) * ldc + col0;
#pragma unroll
                    for (int bj = 0; bj < 2; ++bj) { const f32x4 v0 = acc[ai][bj][m][0], v1 = acc[ai][bj][m][1];
                        u32x4 w; w.x = cvt_pk_bf16(v0[0], v0[1]); w.y = cvt_pk_bf16(v0[2], v0[3]); w.z = cvt_pk_bf16(v1[0], v1[1]); w.w = cvt_pk_bf16(v1[2], v1[3]);
                        *(u32x4*)(rowp + bj * HALF) = w; } }
        } else {
            const int col0 = wc * 32 + 8 * fq;
            if (col0 < 48) {
#pragma unroll
                for (int ai = 0; ai < 2; ++ai)
#pragma unroll
                    for (int m = 0; m < 4; ++m) { float* rowp = GT + (size_t)(row0 + ai * HALF + m * 16) * 48 + col0;
#pragma unroll
                        for (int n = 0; n < 2; ++n) { f32x4 v = acc[ai][0][m][n];
#pragma unroll
                            for (int j = 0; j < 4; ++j) v[j] = __builtin_amdgcn_rcpf(1.0f + __builtin_amdgcn_exp2f(-1.4426950408889634f * v[j]));
                            *(f32x4*)(rowp + 4 * n) = v; } }
            }
        }
    }
};
struct EpiCmp {
    bf16_t* Hd; const float* bias;
    DI void operator()(const f32x4 (&acc)[2][2][4][2], const Unit& u, int wr, int wc, int fr, int fq) const {
        const int row0 = u.pm * BM + wr * 64 + fr, col0 = wc * 32 + 8 * fq; const float* bp = bias + u.e * 256;
#pragma unroll
        for (int bj = 0; bj < 2; ++bj) { const f32x4 b0 = *(const f32x4*)(bp + bj * HALF + col0), b1 = *(const f32x4*)(bp + bj * HALF + col0 + 4);
#pragma unroll
            for (int ai = 0; ai < 2; ++ai)
#pragma unroll
                for (int m = 0; m < 4; ++m) { float o[8];
#pragma unroll
                    for (int j = 0; j < 4; ++j) { o[j] = acc[ai][bj][m][0][j] + b0[j]; o[4 + j] = acc[ai][bj][m][1][j] + b1[j]; }
#pragma unroll
                    for (int j = 0; j < 8; ++j) { const float x = o[j], u2 = 1.5957691216057308f * (x + 0.044715f * x * x * x); o[j] = x * __builtin_amdgcn_rcpf(1.0f + __builtin_amdgcn_exp2f(-1.4426950408889634f * u2)); }
                    u32x4 w; w.x = cvt_pk_bf16(o[0], o[1]); w.y = cvt_pk_bf16(o[2], o[3]); w.z = cvt_pk_bf16(o[4], o[5]); w.w = cvt_pk_bf16(o[6], o[7]);
                    *(u32x4*)(Hd + (size_t)(row0 + ai * HALF + m * 16) * 256 + bj * HALF + col0) = w; } }
    }
};
struct CmpSched {
    static constexpr bool GATHER = false;
    const char* kv6; const char* Bt; int K; unsigned lda, kstepA; int G, c;
    DI bool next(int i, Unit& u) const { const int L = i * G + c; if (L >= 64) return false; u.pm = L; u.pn = 0; u.e = L >> 5; return true; }
    DI const char* a_base(const Unit& u) const { const int j = u.pm >> 5, bg = (u.pm >> 2) & 7, cq = u.pm & 3, b = bg >> 2, g = bg & 3;
        return kv6 + (((size_t)b * SEQ + (size_t)cq * 4096) * 1536 + j * 256 + g * 64) * 2; }
    DI const char* b_base(const Unit& u) const { return Bt + (size_t)(u.pm >> 5) * 256 * 2048 * 2; }
    DI unsigned row_off(int, int) const { return 0u; }
};
}

struct MoeMeta { LAS int* tstart; LAS int* cnt; };
DI int moe_expert_of(const MoeMeta& mm, int rt) { int e = 0;
#pragma unroll
    for (int k = 1; k < 16; ++k) e += (rt >= mm.tstart[k]) ? 1 : 0;
    return e; }
struct Moe1Sched {
    static constexpr bool GATHER = true;
    const char* A; const char* Bt; int K; unsigned lda, kstepA; MoeMeta mm; int ntiles, G, c; LAS unsigned* tab;
    DI bool next(int i, pg8::Unit& u) const { pg8::TileOrder o; o.init(ntiles, 2, G, c); if (!o.next(i, u.pm, u.pn)) return false; u.e = moe_expert_of(mm, u.pm); return true; }
    DI const char* a_base(const pg8::Unit&) const { return A; }
    DI const char* b_base(const pg8::Unit& u) const { return Bt + ((size_t)u.e * 512 + (size_t)u.pn * 256) * 1024 * 2; }
    DI unsigned row_off(int slot, int row) const { return tab[slot * 256 + row]; }
};
struct Moe2Sched {
    static constexpr bool GATHER = false;
    const char* A; const char* Bt; int K; unsigned lda, kstepA; MoeMeta mm; int ntiles, G, c;
    DI bool next(int i, pg8::Unit& u) const { pg8::TileOrder o; o.init(ntiles, 4, G, c); if (!o.next(i, u.pm, u.pn)) return false; u.e = moe_expert_of(mm, u.pm); return true; }
    DI const char* a_base(const pg8::Unit& u) const { return A + (size_t)u.pm * 256 * 512; }
    DI const char* b_base(const pg8::Unit& u) const { return Bt + ((size_t)u.e * 1024 + (size_t)u.pn * 256) * 256 * 2; }
    DI unsigned row_off(int, int) const { return 0u; }
};

struct Args { const float* in[25]; float* out; unsigned char* ws; int wv; int pad; };
enum { IN_X = 0, IN_REL, IN_RW, IN_RB, IN_LN1G, IN_LN1B, IN_LN2G, IN_LN2B, IN_EG, IN_EU, IN_ED, IN_DILIN, IN_DILOUT, IN_SBIN, IN_SBOUT,
       IN_NSAIN, IN_NSAOUT, IN_POSK, IN_W1K, IN_W2K, IN_POSV, IN_W1V, IN_W2V, IN_MOBAIN, IN_MOBAOUT };

DI void transpose_item(const float* W, int K, int N, int Nvalid, bf16_t* WT, int drow0, LAS float* scr, int kb, int nb, int lane) {
    const int k0 = 64 * kb, n0 = 32 * nb;
    const int c4 = lane & 7, kr = lane >> 3;
    if (n0 + 32 <= Nvalid) {
#pragma unroll
        for (int i = 0; i < 8; ++i) { const f32x4 v = __builtin_nontemporal_load((const f32x4*)(W + (size_t)(k0 + kr + 8 * i) * N + n0 + 4 * c4)); LAS float* s = scr + (kr + 8 * i) * 33 + 4 * c4;
            s[0] = v.x; s[1] = v.y; s[2] = v.z; s[3] = v.w; }
    } else {
#pragma unroll 8
        for (int i = 0; i < 32; ++i) { const int kk = 2 * i + (lane >> 5); const int n = n0 + (lane & 31); scr[kk * 33 + (lane & 31)] = (n < Nvalid) ? W[(size_t)(k0 + kk) * N + n] : 0.f; }
    }
    LDS_WAIT(); asm volatile("" ::: "memory");
    const int c = lane & 7;
#pragma unroll
    for (int j = 0; j < 4; ++j) { const int n = (lane >> 3) + 8 * j; const LAS float* s = scr + (8 * c) * 33 + n;
        u32x4 o; o.x = pk2(s[0 * 33], s[1 * 33]); o.y = pk2(s[2 * 33], s[3 * 33]); o.z = pk2(s[4 * 33], s[5 * 33]); o.w = pk2(s[6 * 33], s[7 * 33]);
        *(u32x4*)(WT + (size_t)(drow0 + n) * K + k0 + 8 * c) = o; }
    LDS_WAIT(); asm volatile("" ::: "memory");
}
DI void convert_matrix(const float* W, int K, int N, int Npad, bf16_t* WT, LAS float* scr, int gw, int NGW, int lane) {
    const int nblk = Npad / 32, nitems = (K / 64) * nblk;
    for (int it = gw; it < nitems; it += NGW) { const int kb = it / nblk, nb = it % nblk; transpose_item(W, K, N, N, WT, 32 * nb, scr, kb, nb, lane); }
}
DI void convert_layer_weights(const Args& a, int layer, LAS unsigned char* lds, int gw, int NGW, int wave, int lane, int parts = 7) {
    LAS float* scr = (LAS float*)(lds + STAGE_OFF + wave * 16384);
    bf16_t* W1 = (bf16_t*)(a.ws + WS_WEXP1); bf16_t* W2 = (bf16_t*)(a.ws + WS_WEXP2);
    const float* eg = a.in[IN_EG] + (size_t)layer * NE * D * DEXP; const float* eu = a.in[IN_EU] + (size_t)layer * NE * D * DEXP; const float* ed = a.in[IN_ED] + (size_t)layer * NE * DEXP * D;
    constexpr int I_G = (D / 64) * (DEXP / 32);
    constexpr int I_D = (DEXP / 64) * (D / 32);
    constexpr int I_E = 2 * I_G + I_D;
    if (parts & 1) {
        bf16_t* Win = (bf16_t*)(a.ws + WS_WIN); bf16_t* Wout = (bf16_t*)(a.ws + WS_WOUT);
        if (layer == 0) { convert_matrix(a.in[IN_DILIN], D, 9216, 9216, Win, scr, gw, NGW, lane); convert_matrix(a.in[IN_DILOUT], D, D, D, Wout, scr, gw, NGW, lane); }
        if (layer == 1) { convert_matrix(a.in[IN_SBIN], D, 3072, 3072, Win, scr, gw, NGW, lane); convert_matrix(a.in[IN_SBOUT], D, D, D, Wout, scr, gw, NGW, lane); }
        if (layer == 2) { convert_matrix(a.in[IN_NSAIN], D, 2608, 2816, Win, scr, gw, NGW, lane); convert_matrix(a.in[IN_NSAOUT], D, D, D, Wout, scr, gw, NGW, lane);
            bf16_t* wc = (bf16_t*)(a.ws + WS_WCMP);
            convert_matrix(a.in[IN_W1K], 2048, 256, 256, wc, scr, gw, NGW, lane); convert_matrix(a.in[IN_W1V], 2048, 256, 256, wc + 256 * 2048, scr, gw, NGW, lane);
            convert_matrix(a.in[IN_W2K], 256, 64, 64, wc + 2 * 256 * 2048, scr, gw, NGW, lane); convert_matrix(a.in[IN_W2V], 256, 64, 64, wc + 2 * 256 * 2048 + 64 * 256, scr, gw, NGW, lane);
            float* cb = (float*)(a.ws + WS_WCMP + 2 * MiB + 64 * 1024);
            for (int it = gw; it < 512; it += NGW) { const int j = it >> 8, n = it & 255; const float* pos = a.in[j ? IN_POSV : IN_POSK]; const float* w1 = a.in[j ? IN_W1V : IN_W1K];
                float s = 0.f; for (int k = lane; k < 2048; k += 64) s += pos[k] * w1[(size_t)k * 256 + n];
                s = wave_sum(s); if (lane == 0) cb[it] = s; } }
        if (layer == 3) { convert_matrix(a.in[IN_MOBAIN], D, 3072, 3072, Win, scr, gw, NGW, lane); convert_matrix(a.in[IN_MOBAOUT], D, D, D, Wout, scr, gw, NGW, lane); }
    }
    (void)I_E;
    if (parts & 2) for (int it = gw; it < NE * 2 * I_G; it += NGW) {
        const int e = it / (2 * I_G); int r = it % (2 * I_G);
        if (r < I_G) { const int kb = r / (DEXP / 32), nb = r % (DEXP / 32); const int n0 = 32 * nb;
            transpose_item(eg + (size_t)e * D * DEXP, D, DEXP, DEXP, W1, e * 512 + ((n0 >> 7) << 8) + (n0 & 127), scr, kb, nb, lane); continue; }
        r -= I_G;
        { const int kb = r / (DEXP / 32), nb = r % (DEXP / 32); const int n0 = 32 * nb;
            transpose_item(eu + (size_t)e * D * DEXP, D, DEXP, DEXP, W1, e * 512 + ((n0 >> 7) << 8) + 128 + (n0 & 127), scr, kb, nb, lane); }
    }
    if (parts & 4) for (int it = gw; it < NE * I_D; it += NGW) {
        const int e = it / I_D, r = it % I_D;
        { const int kb = r / (D / 32), nb = r % (D / 32);
          transpose_item(ed + (size_t)e * DEXP * D, DEXP, D, D, W2, e * 1024 + 32 * nb, scr, kb, nb, lane); }
    }
}

struct RowVec { f32x4 v[4]; };
DI void ln_stats(const RowVec& r, float& mean, float& rstd) {
    float s = 0.f;
#pragma unroll
    for (int j = 0; j < 4; ++j) s += (r.v[j].x + r.v[j].y) + (r.v[j].z + r.v[j].w);
    mean = wave_sum(s) * (1.f / D); float s2 = 0.f;
#pragma unroll
    for (int j = 0; j < 4; ++j) { const f32x4 d = r.v[j] - mean; s2 += (d.x * d.x + d.y * d.y) + (d.z * d.z + d.w * d.w); }
    rstd = 1.f / sqrtf(wave_sum(s2) * (1.f / D) + LN_EPS);
}


constexpr int KSTR = 144;
constexpr int KVT = 64;
constexpr int KV_TILE_BYTES = KVT * KSTR;
constexpr float LOG2E = 1.4426950408889634f, LN2F = 0.6931471805599453f;
DI f32x16 mfma32(bf16x8 a, bf16x8 b, f32x16 c) { return __builtin_amdgcn_mfma_f32_32x32x16_bf16(a, b, c, 0, 0, 0); }
DI f32x16 zero16() { f32x16 z; for (int i = 0; i < 16; ++i) z[i] = 0.f; return z; }
DI void kv_fetch(u32x4& kr, u32x4& vr, const bf16_t* kb, const bf16_t* vb, size_t rstride, int row0, int nrows, int tid) {
    asm volatile("" : "+v"(tid));
    const int row = row0 + (tid >> 3), c16 = tid & 7;
    if (row >= 0 && row < nrows) { kr = *(const u32x4*)(kb + (size_t)row * rstride + c16 * 8); vr = *(const u32x4*)(vb + (size_t)row * rstride + c16 * 8); }
    else { kr = (u32x4){0u, 0u, 0u, 0u}; vr = kr; }
}
DI void kv_store(LAS unsigned char* kl, LAS unsigned char* vl, const u32x4& kr, const u32x4& vr, int tid) {
    asm volatile("" ::: "memory"); __builtin_amdgcn_sched_barrier(0);
    asm volatile("" : "+v"(tid));
    const int off = (tid >> 3) * KSTR + (tid & 7) * 16;
    *(LAS u32x4*)(kl + off) = kr; *(LAS u32x4*)(vl + off) = vr;
}
constexpr int DT_BYTES = 16384;
DI void kv_dma_issue(LAS unsigned char* slot, const bf16_t* kb, const bf16_t* vb, size_t rstride, int row0, int nrows, int wave, int lane) {
    asm volatile("" : "+v"(lane));
    const int rr = lane >> 3, row = min(max(row0 + 8 * wave + rr, 0), nrows - 1), ch = (lane & 7) ^ rr;
    const size_t off = (size_t)row * rstride + ch * 8;
    __builtin_amdgcn_global_load_lds((const unsigned*)(kb + off), (LAS unsigned*)(slot + wave * 1024), 16, 0, 0);
    __builtin_amdgcn_global_load_lds((const unsigned*)(vb + off), (LAS unsigned*)(slot + 8192 + wave * 1024), 16, 0, 0);
}
DI f32x16 qk_tile_sw(const LAS unsigned char* kl, int kt, const bf16x8 (&Q)[4], int lane) {
    asm volatile("" : "+v"(lane));
    const int r = lane & 31, h = lane >> 5;
    const int pr = (r & ~12) | ((r & 4) << 1) | ((r & 8) >> 1), sw = pr & 7;
    const LAS unsigned char* p = kl + (kt * 32 + pr) * 128;
    f32x16 S = zero16();
#pragma unroll
    for (int ks = 0; ks < 4; ++ks) { const bf16x8 A = *(const LAS bf16x8*)(p + (((2 * ks + h) ^ sw) << 4)); S = mfma32(A, Q[ks], S); }
    return S;
}
DI void pv_tile_sw(const LAS unsigned char* vl, int kt, const f32x16& P, f32x16 (&O)[2], int lane) {
    asm volatile("" : "+v"(lane));
    const int i16 = lane & 15, q = i16 >> 2, p = i16 & 3, blk = (lane >> 4) & 1, h = lane >> 5;
    const unsigned vp = (unsigned)(size_t)(vl + (kt * 32 + 8 * h + q) * 128 + 8 * (p & 1));
    const int c0 = 2 * blk + (p >> 1), c1 = 4 + c0;
    const unsigned a0 = vp + ((c0 ^ q) << 4), a1 = vp + 512 + ((c0 ^ (q + 4)) << 4), a2 = vp + ((c1 ^ q) << 4), a3 = vp + 512 + ((c1 ^ (q + 4)) << 4);
    s16x4 lo0, hi0, lo1, hi1, lo2, hi2, lo3, hi3;
    asm volatile("ds_read_b64_tr_b16 %0, %8\n\tds_read_b64_tr_b16 %1, %9\n\tds_read_b64_tr_b16 %2, %10\n\tds_read_b64_tr_b16 %3, %11\n\t"
                 "ds_read_b64_tr_b16 %4, %8 offset:2048\n\tds_read_b64_tr_b16 %5, %9 offset:2048\n\tds_read_b64_tr_b16 %6, %10 offset:2048\n\tds_read_b64_tr_b16 %7, %11 offset:2048\n\ts_waitcnt lgkmcnt(0)"
                 : "=&v"(lo0), "=&v"(hi0), "=&v"(lo1), "=&v"(hi1), "=&v"(lo2), "=&v"(hi2), "=&v"(lo3), "=&v"(hi3) : "v"(a0), "v"(a1), "v"(a2), "v"(a3) : "memory");
    { u32x4 pk; pk.x = cvt_pk_bf16(P[0], P[1]); pk.y = cvt_pk_bf16(P[2], P[3]); pk.z = cvt_pk_bf16(P[4], P[5]); pk.w = cvt_pk_bf16(P[6], P[7]);
      const bf16x8 Bp = __builtin_bit_cast(bf16x8, pk);
      O[0] = mfma32(__builtin_shufflevector(lo0, hi0, 0, 1, 2, 3, 4, 5, 6, 7), Bp, O[0]);
      O[1] = mfma32(__builtin_shufflevector(lo1, hi1, 0, 1, 2, 3, 4, 5, 6, 7), Bp, O[1]); }
    { u32x4 pk; pk.x = cvt_pk_bf16(P[8], P[9]); pk.y = cvt_pk_bf16(P[10], P[11]); pk.z = cvt_pk_bf16(P[12], P[13]); pk.w = cvt_pk_bf16(P[14], P[15]);
      const bf16x8 Bp = __builtin_bit_cast(bf16x8, pk);
      O[0] = mfma32(__builtin_shufflevector(lo2, hi2, 0, 1, 2, 3, 4, 5, 6, 7), Bp, O[0]);
      O[1] = mfma32(__builtin_shufflevector(lo3, hi3, 0, 1, 2, 3, 4, 5, 6, 7), Bp, O[1]); }
}
template <int NS, class RowF, class CompF>
DI void kv_dma_pipeline(int n, const RowF& rowf, const CompF& comp, const bf16_t* kb, const bf16_t* vb, size_t rstride, int nrows, LAS unsigned char* ring, int wave, int lane) {
    if (n <= 0) return;
#pragma unroll
    for (int i = 0; i < NS - 1; ++i) if (i < n) kv_dma_issue(ring + i * DT_BYTES, kb, vb, rstride, rowf(i), nrows, wave, lane);
    int sc = 0, sn = NS - 1;
#pragma unroll 1
    for (int j = 0; j < n; ++j) {
        const int rem = min(n - 1 - j, NS - 2);
        if (rem >= 4) asm volatile("s_waitcnt vmcnt(8)" ::: "memory");
        else if (rem == 3) asm volatile("s_waitcnt vmcnt(6)" ::: "memory");
        else if (rem == 2) asm volatile("s_waitcnt vmcnt(4)" ::: "memory");
        else if (rem == 1) asm volatile("s_waitcnt vmcnt(2)" ::: "memory");
        else asm volatile("s_waitcnt vmcnt(0)" ::: "memory");
        __builtin_amdgcn_s_barrier(); asm volatile("" ::: "memory");
        comp(j, ring + sc * DT_BYTES, ring + sc * DT_BYTES + 8192);
        if (j + NS - 1 < n) kv_dma_issue(ring + sn * DT_BYTES, kb, vb, rstride, rowf(j + NS - 1), nrows, wave, lane);
        sc = (sc + 1 == NS) ? 0 : sc + 1; sn = (sn + 1 == NS) ? 0 : sn + 1;
    }
    asm volatile("s_waitcnt lgkmcnt(0)" ::: "memory"); __builtin_amdgcn_s_barrier(); asm volatile("" ::: "memory");
}
template <int NS, class IssueF, class CompF>
DI void kv_dma_stream(int n, const IssueF& issue, const CompF& comp, LAS unsigned char* ring) {
    if (n <= 0) return;
#pragma unroll
    for (int i = 0; i < NS - 1; ++i) if (i < n) issue(i, ring + i * DT_BYTES);
    int sc = 0, sn = NS - 1;
#pragma unroll 1
    for (int j = 0; j < n; ++j) {
        const int rem = min(n - 1 - j, NS - 2);
        if (rem >= 4) asm volatile("s_waitcnt vmcnt(8)" ::: "memory");
        else if (rem == 3) asm volatile("s_waitcnt vmcnt(6)" ::: "memory");
        else if (rem == 2) asm volatile("s_waitcnt vmcnt(4)" ::: "memory");
        else if (rem == 1) asm volatile("s_waitcnt vmcnt(2)" ::: "memory");
        else asm volatile("s_waitcnt vmcnt(0)" ::: "memory");
        __builtin_amdgcn_s_barrier(); asm volatile("" ::: "memory");
        comp(j, ring + sc * DT_BYTES, ring + sc * DT_BYTES + 8192);
        if (j + NS - 1 < n) issue(j + NS - 1, ring + sn * DT_BYTES);
        sc = (sc + 1 == NS) ? 0 : sc + 1; sn = (sn + 1 == NS) ? 0 : sn + 1;
    }
    asm volatile("s_waitcnt lgkmcnt(0)" ::: "memory"); __builtin_amdgcn_s_barrier(); asm volatile("" ::: "memory");
}
DI f32x16 qk_tile(const LAS unsigned char* kl, int kt, const bf16x8 (&Q)[4], int lane) {
    asm volatile("" : "+v"(lane));
    const int r = lane & 31, h = lane >> 5;
    const int pr = (r & ~12) | ((r & 4) << 1) | ((r & 8) >> 1);
    const LAS unsigned char* p = kl + (kt * 32 + pr) * KSTR + h * 16;
    f32x16 S = zero16();
#pragma unroll
    for (int ks = 0; ks < 4; ++ks) { const bf16x8 A = *(const LAS bf16x8*)(p + ks * 32); S = mfma32(A, Q[ks], S); }
    return S;
}
DI void pv_tile(const LAS unsigned char* vl, int kt, const f32x16& P, f32x16 (&O)[2], int lane) {
    asm volatile("" : "+v"(lane));
    const int i16 = lane & 15, q = i16 >> 2, p = i16 & 3, blk = (lane >> 4) & 1, h = lane >> 5;
#pragma unroll
    for (int s = 0; s < 2; ++s) {
        u32x4 pk; pk.x = cvt_pk_bf16(P[8 * s + 0], P[8 * s + 1]); pk.y = cvt_pk_bf16(P[8 * s + 2], P[8 * s + 3]); pk.z = cvt_pk_bf16(P[8 * s + 4], P[8 * s + 5]); pk.w = cvt_pk_bf16(P[8 * s + 6], P[8 * s + 7]);
        const bf16x8 Bp = __builtin_bit_cast(bf16x8, pk);
        const LAS unsigned char* vp = vl + (kt * 32 + 16 * s + 8 * h + q) * KSTR + (16 * blk + 4 * p) * 2;
#pragma unroll
        for (int dt = 0; dt < 2; ++dt) {
            const s16x4 lo = __builtin_amdgcn_ds_read_tr16_b64_v4i16((LAS s16x4*)(vp + dt * 64));
            const s16x4 hi = __builtin_amdgcn_ds_read_tr16_b64_v4i16((LAS s16x4*)(vp + dt * 64 + 4 * KSTR));
            const bf16x8 A = __builtin_shufflevector(lo, hi, 0, 1, 2, 3, 4, 5, 6, 7);
            O[dt] = mfma32(A, Bp, O[dt]);
        }
    }
}
DI void store_o(bf16_t* orow, const f32x16 (&O)[2], float sc, int h) {
#pragma unroll
    for (int dt = 0; dt < 2; ++dt)
#pragma unroll
        for (int g = 0; g < 4; ++g) { u32x2 w; w.x = cvt_pk_bf16(O[dt][4 * g] * sc, O[dt][4 * g + 1] * sc); w.y = cvt_pk_bf16(O[dt][4 * g + 2] * sc, O[dt][4 * g + 3] * sc);
            *(u32x2*)(orow + dt * 32 + 8 * g + 4 * h) = w; }
}

constexpr int BT_PAD = 128, BT_LEN = BT_PAD + 2048;
constexpr int DIST_ANY = 0x3fffffff, DIST_NONE = 0x40000000;
constexpr size_t WS_RW = WS_SMALL;
constexpr size_t WS_BIASG = WS_SMALL + 256 * 1024;
DI void load_bias_table(LAS float* dst, const float* biasG, int head, int dsh, int tid, int hicut = 0x3fffffff) {
    for (int i = tid; i < BT_LEN; i += NTHR) { const int n = i - BT_PAD; dst[i] = (n >= 0 && n <= hicut) ? biasG[head * 2048 + min(n << dsh, 2047)] : -1e30f; }
}
template <int STRIDE, bool MASKED>
DI float logits_tile(f32x16 (&S)[2], const LAS float* P, int D0, int h, int lo, unsigned range) {
    float mx = -1e30f;
    if (!MASKED && __all(D0 - 63 * STRIDE >= 1512)) {
        const float cb = P[BT_PAD + 2047];
#pragma unroll
        for (int sub = 0; sub < 2; ++sub)
#pragma unroll
            for (int i = 0; i < 16; ++i) { float x = S[sub][i] * (0.125f * LOG2E) + cb; asm("" : "+v"(x)); S[sub][i] = x; mx = fmaxf(mx, x); }
        return mx;
    }
#pragma unroll
    for (int sub = 0; sub < 2; ++sub)
#pragma unroll
        for (int s = 0; s < 2; ++s) {
            const int d0 = D0 - (32 * sub + 16 * s + 8 * h) * STRIDE;
            const int base = min(max(d0 - 7 * STRIDE + BT_PAD, 0), BT_LEN - 1 - 7 * STRIDE);
            const LAS float* pb = P + base;
#pragma unroll
            for (int j = 0; j < 8; ++j) { const int i = 8 * s + j;
                float x = S[sub][i] * (0.125f * LOG2E) + pb[(7 - j) * STRIDE]; asm("" : "+v"(x));
                if (MASKED) x = ((unsigned)(d0 - j * STRIDE - lo) <= range) ? x : -1e30f;
                S[sub][i] = x; mx = fmaxf(mx, x); }
        }
    return mx;
}
template <int STRIDE, bool MASKED>
DI void softmax_tile(f32x16 (&S)[2], float& m, float& l, f32x16 (&O)[2], const LAS float* P, int D0, int h, int lo, unsigned range) {
    float mx = logits_tile<STRIDE, MASKED>(S, P, D0, h, lo, range);
    mx = fmaxf(mx, xor32h(mx, h));
    const float mnew = fmaxf(m, mx), mm = (mnew <= -1e30f) ? 0.f : mnew;
    float ls = 0.f;
#pragma unroll
    for (int sub = 0; sub < 2; ++sub)
#pragma unroll
        for (int i = 0; i < 16; ++i) { const float p = __builtin_amdgcn_exp2f(S[sub][i] - mm); S[sub][i] = p; ls += p; }
    ls += xor32h(ls, h);
    if (!__all(mnew == m)) {
        const float alpha = __builtin_amdgcn_exp2f(m - mnew);
        l *= alpha;
#pragma unroll
        for (int dt = 0; dt < 2; ++dt)
#pragma unroll
            for (int i = 0; i < 16; ++i) O[dt][i] *= alpha;
    }
    l += ls; m = mnew;
}
template <int STRIDE, bool MASKED>
DI void stats_tile(f32x16 (&S)[2], float& m, float& l, const LAS float* P, int D0, int h, int lo, unsigned range) {
    float mx = logits_tile<STRIDE, MASKED>(S, P, D0, h, lo, range);
    mx = fmaxf(mx, xor32h(mx, h));
    const float mnew = fmaxf(m, mx), mm = (mnew <= -1e30f) ? 0.f : mnew;
    float ls = 0.f;
#pragma unroll
    for (int sub = 0; sub < 2; ++sub)
#pragma unroll
        for (int i = 0; i < 16; ++i) ls += __builtin_amdgcn_exp2f(S[sub][i] - mm);
    ls += xor32h(ls, h);
    l = l * __builtin_amdgcn_exp2f(m - mnew) + ls; m = mnew;
}

constexpr size_t BIG_OG = 288 * MiB;
constexpr size_t BIG_LSE = 384 * MiB;
DI void dilated_phase(const Args& a, LAS unsigned char* lds) {
    int tid = tid_of(a.wv); asm volatile("" : "+v"(tid));
    const int lane = tid & 63, wave = a.wv, c = lane & 31, h = lane >> 5;
    const bf16_t* qkv = (const bf16_t*)(a.ws + WS_BIG);
    LAS unsigned char* kbuf = lds; LAS unsigned char* vbuf = lds + 6 * KV_TILE_BYTES;
    LAS float* btab = (LAS float*)(lds + 12 * KV_TILE_BYTES);
    static_assert(12 * KV_TILE_BYTES + BT_LEN * 4 <= MISC_OFF, "dilated-phase LDS");
    const float* biasG = (const float*)(a.ws + WS_BIASG);
    const int G = gridDim.x, bid = blockIdx.x;
    const int nu = bid < 3072 ? (3072 - bid + G - 1) / G : 0;
    if (nu == 0) return;
#define DL_DESC(k) const int u_ = bid + (k) * G, hh_ = u_ & 15, g_ = (u_ >> 4) >> 6, idx_ = (u_ >> 4) & 63, dsh_ = 2 * g_, r_ = idx_ & ((1 << dsh_) - 1), blk_ = idx_ >> dsh_; \
        const bf16_t* qb_ = qkv + (size_t)r_ * 9216 + g_ * 3072 + hh_ * 64; const size_t rs_ = (size_t)9216 << dsh_; (void)blk_; (void)qb_; (void)rs_;
#define DL_FETCH(k) { DL_DESC(k) \
        const bf16_t* qrow = qb_ + (size_t)(blk_ * 256 + 32 * wave + c) * rs_; \
        _Pragma("unroll") for (int ks = 0; ks < 4; ++ks) Qn[ks] = *(const bf16x8*)(qrow + 16 * ks + 8 * h); \
        _Pragma("unroll") for (int j_ = 0; j_ < 6; ++j_) kv_fetch(kr[j_], vr[j_], qb_ + 1024, qb_ + 2048, rs_, blk_ * 256 - 128 + 64 * j_, SEQ >> dsh_, tid); }
    int cur_key = -1;
    bf16x8 Q[4], Qn[4];
    u32x4 kr[6], vr[6];
    DL_FETCH(0)
#pragma unroll 1
    for (int k = 0; k < nu; ++k) {
        DL_DESC(k)
        const int hh = hh_, g = g_, dsh = dsh_, r = r_, Q0 = blk_ * 256, q0w = Q0 + 32 * wave, iq = q0w + c;
#pragma unroll
        for (int ks = 0; ks < 4; ++ks) Q[ks] = Qn[ks];
        f32x16 O[2]; O[0] = zero16(); O[1] = zero16(); float m = -1e30f, l = 0.f;
        __syncthreads();
        if (hh * 4 + g != cur_key) { load_bias_table(btab, biasG, hh, dsh, tid, 128); cur_key = hh * 4 + g; }
#pragma unroll
        for (int j = 0; j < 6; ++j) kv_store(kbuf + j * KV_TILE_BYTES, vbuf + j * KV_TILE_BYTES, kr[j], vr[j], tid);
        __syncthreads();
        if (k + 1 < nu) DL_FETCH(k + 1)
#pragma unroll 1
        for (int j = 0; j < 6; ++j) {
            const int kr0 = Q0 - 128 + 64 * j;
            if (kr0 <= q0w + 31 && kr0 + 63 >= q0w - 128 && kr0 + 63 >= 0) {
                const LAS unsigned char* kl = kbuf + j * KV_TILE_BYTES; const LAS unsigned char* vl = vbuf + j * KV_TILE_BYTES;
                f32x16 S[2]; S[0] = qk_tile(kl, 0, Q, lane); S[1] = qk_tile(kl, 1, Q, lane);
                if (Q0 > 0) softmax_tile<1, false>(S, m, l, O, btab, iq - kr0, h, 0, 128u);
                else softmax_tile<1, true>(S, m, l, O, btab, iq - kr0, h, 0, (unsigned)min(128, iq));
                pv_tile(vl, 0, S[0], O, lane); pv_tile(vl, 1, S[1], O, lane);
            }
        }
        {
            const int tok = (iq << dsh) + r;
            bf16_t* og = (bf16_t*)(a.ws + WS_BIG + BIG_OG) + (size_t)g * SEQ * D;
            float* lse = (float*)(a.ws + WS_BIG + BIG_LSE) + (size_t)g * SEQ * 16;
            store_o(og + (size_t)tok * D + hh * 64, O, 1.f / l, h);
            if (h == 0) lse[tok * 16 + hh] = m + __builtin_amdgcn_logf(l);
        }
    }
#undef DL_FETCH
#undef DL_DESC
}
DI void dilated_merge(const Args& a, int b) {
    const int tid = tid_of(a.wv);
    const bf16_t* og = (const bf16_t*)(a.ws + WS_BIG + BIG_OG); const float* lse = (const float*)(a.ws + WS_BIG + BIG_LSE);
    bf16_t* outb = (bf16_t*)(a.ws + WS_ACTB) + (size_t)b * SEQ * D;
    for (int i = blockIdx.x * NTHR + tid; i < SEQ * 128; i += gridDim.x * NTHR) {
        const int tok = i >> 7, c8 = i & 127, hh = c8 >> 3;
        const float l0 = lse[tok * 16 + hh], l1 = lse[SEQ * 16 + tok * 16 + hh], l2 = lse[2 * SEQ * 16 + tok * 16 + hh];
        const float mx = fmaxf(l0, fmaxf(l1, l2));
        float w0 = __builtin_amdgcn_exp2f(l0 - mx), w1 = __builtin_amdgcn_exp2f(l1 - mx), w2 = __builtin_amdgcn_exp2f(l2 - mx);
        const float inv = 1.f / (w0 + w1 + w2); w0 *= inv; w1 *= inv; w2 *= inv;
        const u32x4 a0 = __builtin_nontemporal_load((const u32x4*)(og + (size_t)tok * D + c8 * 8)), a1 = __builtin_nontemporal_load((const u32x4*)(og + (size_t)SEQ * D + (size_t)tok * D + c8 * 8)), a2 = __builtin_nontemporal_load((const u32x4*)(og + (size_t)2 * SEQ * D + (size_t)tok * D + c8 * 8));
        u32x4 o;
        o.x = pk2(w0 * bf_lo(a0.x) + w1 * bf_lo(a1.x) + w2 * bf_lo(a2.x), w0 * bf_hi(a0.x) + w1 * bf_hi(a1.x) + w2 * bf_hi(a2.x));
        o.y = pk2(w0 * bf_lo(a0.y) + w1 * bf_lo(a1.y) + w2 * bf_lo(a2.y), w0 * bf_hi(a0.y) + w1 * bf_hi(a1.y) + w2 * bf_hi(a2.y));
        o.z = pk2(w0 * bf_lo(a0.z) + w1 * bf_lo(a1.z) + w2 * bf_lo(a2.z), w0 * bf_hi(a0.z) + w1 * bf_hi(a1.z) + w2 * bf_hi(a2.z));
        o.w = pk2(w0 * bf_lo(a0.w) + w1 * bf_lo(a1.w) + w2 * bf_lo(a2.w), w0 * bf_hi(a0.w) + w1 * bf_hi(a1.w) + w2 * bf_hi(a2.w));
        *(u32x4*)(outb + (size_t)tok * D + c8 * 8) = o;
    }
}

constexpr size_t MB_KMEAN = WS_ACTB, MB_SELW = WS_ACTB + 1 * MiB, MB_LIST = WS_ACTB + 4 * MiB;
constexpr size_t BIG_OSEL = 192 * MiB, BIG_LSESEL = 384 * MiB;
constexpr int CW_MBCNT = 32768, CW_MBCUR = 32768 + 2048;
constexpr int CW_NSAQ = 40960;
constexpr int MB_LISTCAP = 49152;
DI void moba_kmean_phase(const Args& a, LAS unsigned char* lds) {
    const int tid = tid_of(a.wv);
    const bf16_t* qkv = (const bf16_t*)(a.ws + WS_BIG);
    float* kmean = (float*)(a.ws + MB_KMEAN);
    LAS float* part = (LAS float*)lds;
    for (int u = blockIdx.x; u < 2048; u += gridDim.x) {
        const int n = u & 63, bh = u >> 6, b = bh >> 4, hh = bh & 15;
        const bf16_t* kp = qkv + ((size_t)b * SEQ + n * 256 + (tid >> 3)) * 3072 + 1024 + hh * 64 + (tid & 7) * 8;
        float s[8];
#pragma unroll
        for (int j = 0; j < 8; ++j) s[j] = 0.f;
#pragma unroll
        for (int i = 0; i < 4; ++i) { const u32x4 v = *(const u32x4*)(kp + (size_t)(64 * i) * 3072);
            s[0] += bf_lo(v.x); s[1] += bf_hi(v.x); s[2] += bf_lo(v.y); s[3] += bf_hi(v.y); s[4] += bf_lo(v.z); s[5] += bf_hi(v.z); s[6] += bf_lo(v.w); s[7] += bf_hi(v.w); }
        __syncthreads();
        *(LAS f32x4*)(part + (tid >> 3) * 64 + (tid & 7) * 8) = (f32x4){s[0], s[1], s[2], s[3]}; *(LAS f32x4*)(part + (tid >> 3) * 64 + (tid & 7) * 8 + 4) = (f32x4){s[4], s[5], s[6], s[7]};
        __syncthreads();
        if (tid < 64) { float acc = 0.f;
#pragma unroll 8
            for (int gq = 0; gq < 64; ++gq) acc += part[gq * 64 + tid];
            kmean[((size_t)bh * 64 + n) * 64 + tid] = acc * (1.f / 256.f); }
    }
}
DI void moba_gate_phase(const Args& a, LAS unsigned char* lds) {
    int tid = tid_of(a.wv); asm volatile("" : "+v"(tid));
    const int lane = tid & 63, wave = __builtin_amdgcn_readfirstlane(tid >> 6), c = lane & 31, h = lane >> 5;
    const bf16_t* qkv = (const bf16_t*)(a.ws + WS_BIG);
    const float* kmean = (const float*)(a.ws + MB_KMEAN);
    unsigned* selw = (unsigned*)(a.ws + MB_SELW);
    unsigned* cnt = (unsigned*)(a.ws + WS_CTL) + CW_MBCNT;
    LAS unsigned char* khi = lds; LAS unsigned char* klo = lds + KV_TILE_BYTES;
    LAS int* hist = (LAS int*)(lds + 2 * KV_TILE_BYTES);
    int cur_bh = -1;
    bf16x8 Q[4], Qn[4];
    if (blockIdx.x < 2048) { const int u = blockIdx.x, bh = u & 31, qb = u >> 5, b = bh >> 4, hh = bh & 15, t = qb * 256 + 32 * wave + c;
        const bf16_t* qrow = qkv + ((size_t)b * SEQ + t) * 3072 + hh * 64;
#pragma unroll
        for (int ks = 0; ks < 4; ++ks) Qn[ks] = *(const bf16x8*)(qrow + 16 * ks + 8 * h); }
    for (int u = blockIdx.x; u < 2048; u += gridDim.x) {
        const int bh = u & 31, qb = u >> 5, b = bh >> 4, hh = bh & 15;
        const int t = qb * 256 + 32 * wave + c;
#pragma unroll
        for (int ks = 0; ks < 4; ++ks) Q[ks] = Qn[ks];
        if (u + (int)gridDim.x < 2048) { const int u2 = u + gridDim.x, bh2 = u2 & 31, qb2 = u2 >> 5, b2 = bh2 >> 4, hh2 = bh2 & 15, t2 = qb2 * 256 + 32 * wave + c;
            const bf16_t* qrow = qkv + ((size_t)b2 * SEQ + t2) * 3072 + hh2 * 64;
#pragma unroll
            for (int ks = 0; ks < 4; ++ks) Qn[ks] = *(const bf16x8*)(qrow + 16 * ks + 8 * h); }
        if (bh != cur_bh) {
          __syncthreads();
          if (cur_bh >= 0 && tid < 64 && hist[tid] > 0) xb_add(cnt + cur_bh * 64 + tid, (unsigned)hist[tid]);
          __syncthreads();
          cur_bh = bh;
          if (tid < 64) hist[tid] = 0;
          const int row = tid >> 3, c16 = tid & 7; const float* kp = kmean + ((size_t)bh * 64 + row) * 64 + c16 * 8;
          const f32x4 v0 = *(const f32x4*)kp, v1 = *(const f32x4*)(kp + 4);
          float v[8] = {v0.x, v0.y, v0.z, v0.w, v1.x, v1.y, v1.z, v1.w}; unsigned hi[8], lo[8];
#pragma unroll
          for (int j = 0; j < 8; ++j) { hi[j] = f2bf(v[j]); lo[j] = f2bf(v[j] - u2f(hi[j] << 16)); }
          u32x4 wh, wl; wh.x = hi[0] | (hi[1] << 16); wh.y = hi[2] | (hi[3] << 16); wh.z = hi[4] | (hi[5] << 16); wh.w = hi[6] | (hi[7] << 16);
          wl.x = lo[0] | (lo[1] << 16); wl.y = lo[2] | (lo[3] << 16); wl.z = lo[4] | (lo[5] << 16); wl.w = lo[6] | (lo[7] << 16);
          kv_store(khi, klo, wh, wl, tid);
          __syncthreads(); }
        f32x16 Gs[2];
#pragma unroll
        for (int sub = 0; sub < 2; ++sub) { const f32x16 a0 = qk_tile(khi, sub, Q, lane), a1 = qk_tile(klo, sub, Q, lane);
#pragma unroll
            for (int i = 0; i < 16; ++i) { const int n = sub * 32 + 16 * (i >> 3) + 8 * h + (i & 7); Gs[sub][i] = (n < qb) ? (a0[i] + a1[i]) : -1e30f; } }
        unsigned selpack = 0;
#pragma unroll
        for (int pass = 0; pass < 3; ++pass) {
            float bv = -3e38f;
#pragma unroll
            for (int sub = 0; sub < 2; ++sub)
#pragma unroll
                for (int i = 0; i < 16; i += 2) bv = __builtin_fmaxf(bv, __builtin_fmaxf(Gs[sub][i], Gs[sub][i + 1]));
            int bn0 = 64;
#pragma unroll
            for (int sub = 0; sub < 2; ++sub)
#pragma unroll
                for (int i = 0; i < 16; ++i) { const int nb = sub * 32 + 16 * (i >> 3) + (i & 7); bn0 = (Gs[sub][i] == bv) ? min(bn0, nb) : bn0; }
            int bn = bn0 + 8 * h;
            const float pv = __shfl_xor(bv, 32); const int pn = __shfl_xor(bn, 32);
            if (pv > bv || (pv == bv && pn < bn)) { bv = pv; bn = pn; }
            const bool ok = bv > -1e29f;
            selpack |= (ok ? (unsigned)bn : 255u) << (8 * pass);
            if (ok && h == 0) atomicAdd((int*)(hist + bn), 1);
#pragma unroll
            for (int sub = 0; sub < 2; ++sub)
#pragma unroll
                for (int i = 0; i < 16; ++i) { const int n = sub * 32 + 16 * (i >> 3) + 8 * h + (i & 7); if (n == bn) Gs[sub][i] = -3e38f; }
        }
        if (h == 0) selw[(size_t)bh * SEQ + t] = selpack;
    }
    __syncthreads();
    if (cur_bh >= 0 && tid < 64 && hist[tid] > 0) xb_add(cnt + cur_bh * 64 + tid, (unsigned)hist[tid]);
}
DI void moba_fill_phase(const Args& a, LAS unsigned char* lds) {
    const int tid = tid_of(a.wv);
    const unsigned* selw = (const unsigned*)(a.ws + MB_SELW);
    unsigned* cnt = (unsigned*)(a.ws + WS_CTL) + CW_MBCNT; unsigned* cur = (unsigned*)(a.ws + WS_CTL) + CW_MBCUR;
    unsigned* list = (unsigned*)(a.ws + MB_LIST);
    LAS int* hist = (LAS int*)lds; LAS int* gb = hist + 64; LAS int* off = gb + 64;
    for (int u = blockIdx.x; u < 2048; u += gridDim.x) {
        const int bh = u & 31, qb = u >> 5;
        __syncthreads();
        if (tid < 64) hist[tid] = 0;
        if (tid >= 64 && tid < 128) { const int n = tid - 64; const int v = (int)xb_ld(cnt + bh * 64 + n); int inc = v;
#pragma unroll
            for (int o = 1; o < 64; o <<= 1) { const int tv = __shfl_up(inc, o); if (n >= o) inc += tv; }
            off[n] = inc - v; }
        __syncthreads();
        unsigned sp = 0xffffffffu; int lp[3] = {0, 0, 0};
        if (tid < 256) { sp = selw[(size_t)bh * SEQ + qb * 256 + tid];
#pragma unroll
            for (int k = 0; k < 3; ++k) { const unsigned n = (sp >> (8 * k)) & 255u; if (n < 64u) lp[k] = atomicAdd((int*)(hist + n), 1); } }
        __syncthreads();
        if (tid < 64 && hist[tid] > 0) gb[tid] = (int)xb_add(cur + bh * 64 + tid, (unsigned)hist[tid]);
        __syncthreads();
        if (tid < 256) {
#pragma unroll
            for (int k = 0; k < 3; ++k) { const unsigned n = (sp >> (8 * k)) & 255u;
                if (n < 64u) list[(size_t)bh * MB_LISTCAP + off[n] + gb[n] + lp[k]] = (unsigned)(qb * 256 + tid) | ((unsigned)k << 14); } }
    }
}
DI void moba_sel_phase(const Args& a, LAS unsigned char* lds) {
    int tid = tid_of(a.wv); asm volatile("" : "+v"(tid));
    const int lane = tid & 63, wave = __builtin_amdgcn_readfirstlane(tid >> 6), c = lane & 31, h = lane >> 5;
    const bf16_t* qkv = (const bf16_t*)(a.ws + WS_BIG);
    const unsigned* cnt = (const unsigned*)(a.ws + WS_CTL) + CW_MBCNT;
    const unsigned* list = (const unsigned*)(a.ws + MB_LIST);
    bf16_t* osel = (bf16_t*)(a.ws + WS_BIG + BIG_OSEL); float* lsesel = (float*)(a.ws + WS_BIG + BIG_LSESEL);
    const float* biasG = (const float*)(a.ws + WS_BIASG);
    LAS unsigned char* kbuf = lds; LAS unsigned char* vbuf = lds + 4 * KV_TILE_BYTES;
    LAS float* btab = (LAS float*)(lds + 8 * KV_TILE_BYTES);
    LAS int* cs = (LAS int*)(lds + 8 * KV_TILE_BYTES + BT_LEN * 4);
    LAS int* eo = cs + 2052;
    LAS int* part = eo + 2052;
    { int cc[4], ee[4], sc = 0, se = 0;
#pragma unroll
      for (int j = 0; j < 4; ++j) { const int v = (int)xb_ld((unsigned*)cnt + tid * 4 + j); ee[j] = se; cc[j] = sc; se += v; sc += (v + 255) >> 8; }
      part[tid] = sc; part[512 + tid] = se;
      __syncthreads();
      if (tid == 0) { int a0 = 0, a1 = 0; for (int i = 0; i < 512; ++i) { const int v0 = part[i], v1 = part[512 + i]; part[i] = a0; part[512 + i] = a1; a0 += v0; a1 += v1; } cs[2048] = a0; eo[2048] = a1; }
      __syncthreads();
#pragma unroll
      for (int j = 0; j < 4; ++j) { cs[tid * 4 + j] = part[tid] + cc[j]; eo[tid * 4 + j] = part[512 + tid] + ee[j]; }
      __syncthreads(); }
    const int NC = cs[2048];
    const int u0 = (int)(((long long)NC * blockIdx.x) / gridDim.x), u1 = (int)(((long long)NC * (blockIdx.x + 1)) / gridDim.x);
    int cur_hh = -1, cur_item = -1, item = 0;
    { int lo = 0, hi = 2047;
      while (lo < hi) { const int mid = (lo + hi + 1) >> 1; if (cs[mid] <= u0) lo = mid; else hi = mid - 1; }
      item = lo; }
    int it0 = item, nent0 = 0; size_t eb0 = 0; bool act0 = false; unsigned ent0 = 0u; bf16x8 Q0[4];
    if (u0 < u1) {
        while (cs[item + 1] <= u0) ++item;
        it0 = item; const int chunk = u0 - cs[item]; nent0 = (eo[item + 1] - eo[item]) - chunk * 256; eb0 = (size_t)(item >> 6) * MB_LISTCAP + (eo[item] - eo[(item >> 6) * 64]) + chunk * 256;
        act0 = 32 * wave < nent0;
        if (act0) { const int e = 32 * wave + c; ent0 = list[eb0 + (e < nent0 ? e : 0)];
            const bf16_t* qrow = qkv + ((size_t)(it0 >> 10) * SEQ + (ent0 & 16383)) * 3072 + ((it0 >> 6) & 15) * 64;
#pragma unroll
            for (int ks = 0; ks < 4; ++ks) Q0[ks] = *(const bf16x8*)(qrow + 16 * ks + 8 * h); }
    }
    for (int u = u0; u < u1; ++u) {
        const int bh = it0 >> 6, n = it0 & 63, b = bh >> 4, hh = bh & 15;
        int it1 = it0, nent1 = 0; size_t eb1 = 0; bool act1 = false; unsigned ent1 = 0u;
        if (u + 1 < u1) {
            while (cs[item + 1] <= u + 1) ++item;
            it1 = item; const int chunk = u + 1 - cs[item]; nent1 = (eo[item + 1] - eo[item]) - chunk * 256; eb1 = (size_t)(item >> 6) * MB_LISTCAP + (eo[item] - eo[(item >> 6) * 64]) + chunk * 256;
            act1 = 32 * wave < nent1;
            if (act1) { const int e = 32 * wave + c; ent1 = list[eb1 + (e < nent1 ? e : 0)]; }
        }
        if (it0 != cur_item) {
            const bf16_t* kb = qkv + (size_t)b * SEQ * 3072 + 1024 + hh * 64; const bf16_t* vb = kb + 1024;
            __syncthreads();
            if (hh != cur_hh) { load_bias_table(btab, biasG, hh, 0, tid); cur_hh = hh; }
            u32x4 kr[4], vr[4];
#pragma unroll
            for (int j = 0; j < 4; ++j) kv_fetch(kr[j], vr[j], kb, vb, 3072, n * 256 + 64 * j, SEQ, tid);
#pragma unroll
            for (int j = 0; j < 4; ++j) kv_store(kbuf + j * KV_TILE_BYTES, vbuf + j * KV_TILE_BYTES, kr[j], vr[j], tid);
            __syncthreads();
            cur_item = it0;
        }
        bf16x8 Q1[4];
#pragma unroll
        for (int ks = 0; ks < 4; ++ks) Q1[ks] = Q0[ks];
        const bf16_t* qrow1 = qkv + ((size_t)(it1 >> 10) * SEQ + (ent1 & 16383)) * 3072 + ((it1 >> 6) & 15) * 64;
        if (act0) {
            const int e = 32 * wave + c; const bool ev = e < nent0;
            const int t = ent0 & 16383, slot = ent0 >> 14;
            f32x16 O[2]; O[0] = zero16(); O[1] = zero16();
            float m = -1e30f, l = 0.f;
#pragma unroll
            for (int j = 0; j < 4; ++j) {
                const int k0 = n * 256 + 64 * j;
                const LAS unsigned char* kl = kbuf + j * KV_TILE_BYTES; const LAS unsigned char* vl = vbuf + j * KV_TILE_BYTES;
                f32x16 S[2]; S[0] = qk_tile(kl, 0, Q0, lane); S[1] = qk_tile(kl, 1, Q0, lane);
                if (j == 2 && act1) {
#pragma unroll
                    for (int ks = 0; ks < 4; ++ks) Q1[ks] = *(const bf16x8*)(qrow1 + 16 * ks + 8 * h); }
                softmax_tile<1, false>(S, m, l, O, btab, t - k0, h, 0, (unsigned)DIST_ANY);
                pv_tile(vl, 0, S[0], O, lane); pv_tile(vl, 1, S[1], O, lane);
            }
            if (ev) { const size_t ob = ((size_t)bh * SEQ + t) * 3 + slot;
                store_o(osel + ob * 64, O, 1.f / l, h);
                if (h == 0) lsesel[ob] = m + __builtin_amdgcn_logf(l); }
        } else if (act1) {
#pragma unroll
            for (int ks = 0; ks < 4; ++ks) Q1[ks] = *(const bf16x8*)(qrow1 + 16 * ks + 8 * h);
        }
#pragma unroll
        for (int ks = 0; ks < 4; ++ks) Q0[ks] = Q1[ks];
        it0 = it1; nent0 = nent1; eb0 = eb1; act0 = act1; ent0 = ent1;
    }
    (void)eb0;
}
DI void moba_own_phase(const Args& a, LAS unsigned char* lds) {
    int tid = tid_of(a.wv); asm volatile("" : "+v"(tid));
    const int lane = tid & 63, wave = __builtin_amdgcn_readfirstlane(tid >> 6), c = lane & 31, h = lane >> 5;
    const bf16_t* qkv = (const bf16_t*)(a.ws + WS_BIG);
    const bf16_t* osel = (const bf16_t*)(a.ws + WS_BIG + BIG_OSEL); const float* lsesel = (const float*)(a.ws + WS_BIG + BIG_LSESEL);
    bf16_t* outb = (bf16_t*)(a.ws + WS_ACTB);
    const float* biasG = (const float*)(a.ws + WS_BIASG);
    LAS unsigned char* kbuf = lds; LAS unsigned char* vbuf = lds + 2 * KV_TILE_BYTES;
    LAS float* btab = (LAS float*)(lds + 4 * KV_TILE_BYTES);
    int cur_hh = -1;
    for (int u = blockIdx.x; u < 2048; u += gridDim.x) {
        const int bh = u & 31, qb = u >> 5, b = bh >> 4, hh = bh & 15;
        const int q0w = qb * 256 + 32 * wave, t = q0w + c;
        __syncthreads();
        if (hh != cur_hh) { load_bias_table(btab, biasG, hh, 0, tid); cur_hh = hh; }
        bf16x8 Q[4];
        { const bf16_t* qrow = qkv + ((size_t)b * SEQ + t) * 3072 + hh * 64;
#pragma unroll
          for (int ks = 0; ks < 4; ++ks) Q[ks] = *(const bf16x8*)(qrow + 16 * ks + 8 * h); }
        const bf16_t* kb = qkv + (size_t)b * SEQ * 3072 + 1024 + hh * 64; const bf16_t* vb = kb + 1024;
        f32x16 O[2]; O[0] = zero16(); O[1] = zero16();
        float m = -1e30f, l = 0.f;
        u32x4 kr, vr; int buf = 0;
        kv_fetch(kr, vr, kb, vb, 3072, qb * 256, SEQ, tid); kv_store(kbuf, vbuf, kr, vr, tid);
        __syncthreads();
        for (int j = 0; j < 4; ++j) {
            if (j < 3) kv_fetch(kr, vr, kb, vb, 3072, qb * 256 + 64 * (j + 1), SEQ, tid);
            const int k0 = qb * 256 + 64 * j;
            if (k0 <= q0w + 31) {
                const LAS unsigned char* kl = kbuf + buf * KV_TILE_BYTES; const LAS unsigned char* vl = vbuf + buf * KV_TILE_BYTES;
                f32x16 S[2]; S[0] = qk_tile(kl, 0, Q, lane); S[1] = qk_tile(kl, 1, Q, lane);
                softmax_tile<1, false>(S, m, l, O, btab, t - k0, h, 0, (unsigned)DIST_ANY);
                pv_tile(vl, 0, S[0], O, lane); pv_tile(vl, 1, S[1], O, lane);
            }
            if (j < 3) kv_store(kbuf + (buf ^ 1) * KV_TILE_BYTES, vbuf + (buf ^ 1) * KV_TILE_BYTES, kr, vr, tid);
            __syncthreads();
            buf ^= 1;
        }
        const int nv = qb < 3 ? qb : 3;
        const float lown = m + __builtin_amdgcn_logf(l);
        float ls[3]; float mx = lown;
        const size_t ob = ((size_t)bh * SEQ + t) * 3;
#pragma unroll
        for (int k = 0; k < 3; ++k) { ls[k] = (k < nv) ? lsesel[ob + k] : -1e30f; mx = fmaxf(mx, ls[k]); }
        float wown = __builtin_amdgcn_exp2f(lown - mx), wsum = wown, wk[3];
#pragma unroll
        for (int k = 0; k < 3; ++k) { wk[k] = (k < nv) ? __builtin_amdgcn_exp2f(ls[k] - mx) : 0.f; wsum += wk[k]; }
        const float inv = 1.f / wsum; wown *= inv / l;
#pragma unroll
        for (int dt = 0; dt < 2; ++dt)
#pragma unroll
            for (int i = 0; i < 16; ++i) O[dt][i] *= wown;
#pragma unroll
        for (int k = 0; k < 3; ++k) if (k < nv) { const float w = wk[k] * inv; const bf16_t* orow = osel + (ob + k) * 64;
#pragma unroll
            for (int dt = 0; dt < 2; ++dt)
#pragma unroll
                for (int g = 0; g < 4; ++g) { const u32x2 v = *(const u32x2*)(orow + dt * 32 + 8 * g + 4 * h);
                    O[dt][4 * g] += w * bf_lo(v.x); O[dt][4 * g + 1] += w * bf_hi(v.x); O[dt][4 * g + 2] += w * bf_lo(v.y); O[dt][4 * g + 3] += w * bf_hi(v.y); } }
        store_o(outb + ((size_t)b * SEQ + t) * D + hh * 64, O, 1.f, h);
    }
}

constexpr size_t NS_Q = 0, NS_KV = 64 * MiB, NS_GT = 164 * MiB, NS_HID = 172 * MiB, NS_KC = 180 * MiB, NS_KFR = 182 * MiB, NS_VFR = 198 * MiB;
DI void nsa_pretile(const Args& a, LAS unsigned char* lds, int first, int step, int end) {
    int tid = tid_of(a.wv); asm volatile("" : "+v"(tid));
    {
        const bf16_t* kv6 = (const bf16_t*)(a.ws + WS_BIG + NS_KV); u32x4* kfr = (u32x4*)(a.ws + WS_BIG + NS_KFR); u32x4* vfr = (u32x4*)(a.ws + WS_BIG + NS_VFR);
        for (int tl = first; tl < end; tl += step) {
            const int bg = tl >> 8, t0 = (tl & 255) * 64, b = bg >> 2, g = bg & 3;
            __syncthreads();
            { const int row = tid >> 3, c16 = tid & 7; const bf16_t* src_ = kv6 + ((size_t)b * SEQ + t0 + row) * 1536 + 2 * 256 + g * 64 + c16 * 8;
              *(LAS u32x4*)(lds + row * KSTR + c16 * 16) = *(const u32x4*)src_; *(LAS u32x4*)(lds + KV_TILE_BYTES + row * KSTR + c16 * 16) = *(const u32x4*)(src_ + 256); }
            __syncthreads();
            { const int f = tid >> 6, ln = tid & 63, r31 = ln & 31, hh = ln >> 5;
              { const int kt = f >> 2, ks = f & 3, pr = (r31 & ~12) | ((r31 & 4) << 1) | ((r31 & 8) >> 1);
                kfr[((size_t)tl * 8 + f) * 64 + ln] = *(const LAS u32x4*)(lds + (kt * 32 + pr) * KSTR + (16 * ks + 8 * hh) * 2); }
              { const int kt = f >> 2, s = (f >> 1) & 1, dt = f & 1; unsigned v[8];
#pragma unroll
                for (int i = 0; i < 8; ++i) v[i] = *(const LAS unsigned short*)(lds + KV_TILE_BYTES + (kt * 32 + 16 * s + 8 * hh + i) * KSTR + (dt * 32 + r31) * 2);
                u32x4 w; w.x = v[0] | (v[1] << 16); w.y = v[2] | (v[3] << 16); w.z = v[4] | (v[5] << 16); w.w = v[6] | (v[7] << 16);
                vfr[((size_t)tl * 8 + f) * 64 + ln] = w; } }
        }
    }
}
DI void nsa_kcvc_phase(const Args& a, LAS unsigned char* lds) {
    int tid = tid_of(a.wv); asm volatile("" : "+v"(tid)); (void)lds;
    const int lane = tid & 63, wave = __builtin_amdgcn_readfirstlane(tid >> 6), c = lane & 31, h = lane >> 5;
    const bf16_t* hidden = (const bf16_t*)(a.ws + WS_BIG + NS_HID); const bf16_t* w2t = (const bf16_t*)(a.ws + WS_WCMP) + 2 * 256 * 2048;
    bf16_t* kcvc = (bf16_t*)(a.ws + WS_BIG + NS_KC);
    for (int task = blockIdx.x * NWAVES + wave; task < 512; task += gridDim.x * NWAVES) {
        const int j = task >> 8, R0 = (task & 255) * 32;
        const bf16_t* hid = hidden + ((size_t)j * 8192 + R0 + c) * 256; const bf16_t* w2 = w2t + j * 64 * 256;
        f32x16 acc[2]; acc[0] = zero16(); acc[1] = zero16();
#pragma unroll
        for (int ks = 0; ks < 16; ++ks) { const bf16x8 Bv = *(const bf16x8*)(hid + 16 * ks + 8 * h);
#pragma unroll
            for (int dt = 0; dt < 2; ++dt) { const bf16x8 Av = *(const bf16x8*)(w2 + (dt * 32 + c) * 256 + 16 * ks + 8 * h); acc[dt] = mfma32(Av, Bv, acc[dt]); } }
        store_o(kcvc + ((size_t)j * 8192 + R0 + c) * 64, acc, 1.f, h);
    }
}
DI void nsa_kcvc_own_unit(const Args& a, int pm) {
    int tid = tid_of(a.wv); asm volatile("" : "+v"(tid));
    const int lane = tid & 63, wave = __builtin_amdgcn_readfirstlane(tid >> 6), c = lane & 31, h = lane >> 5;
    const bf16_t* hidden = (const bf16_t*)(a.ws + WS_BIG + NS_HID); const bf16_t* w2t = (const bf16_t*)(a.ws + WS_WCMP) + 2 * 256 * 2048;
    bf16_t* kcvc = (bf16_t*)(a.ws + WS_BIG + NS_KC);
    const int j = pm >> 5; const size_t frow = (size_t)pm * 256 + 32 * wave + c;
    const bf16_t* hid = hidden + frow * 256; const bf16_t* w2 = w2t + j * 64 * 256;
    f32x16 acc[2]; acc[0] = zero16(); acc[1] = zero16();
#pragma unroll
    for (int ks = 0; ks < 16; ++ks) { const bf16x8 Bv = *(const bf16x8*)(hid + 16 * ks + 8 * h);
#pragma unroll
        for (int dt = 0; dt < 2; ++dt) { const bf16x8 Av = *(const bf16x8*)(w2 + (dt * 32 + c) * 256 + 16 * ks + 8 * h); acc[dt] = mfma32(Av, Bv, acc[dt]); } }
    store_o(kcvc + frow * 64, acc, 1.f, h);
}
DI void nsa_attn_phase(const Args& a, LAS unsigned char* lds) {
    const int wave = a.wv;
#define NSA_VARS int tid = tid_of(a.wv); const int lane = tid & 63, c = lane & 31, h = lane >> 5, qi = c >> 2, r = c & 3, t = tw0 + qi; \
    const LAS float* bt = btab + r * (BT_LEN + 8); const float* gtp = gates + (tokbase + t) * 48 + 4 * g + r; (void)bt; (void)h; (void)lane; (void)gtp;
    const bf16_t* qb_ = (const bf16_t*)(a.ws + WS_BIG + NS_Q); const bf16_t* kv6 = (const bf16_t*)(a.ws + WS_BIG + NS_KV);
    const float* gates = (const float*)(a.ws + WS_BIG + NS_GT); const bf16_t* kcvc = (const bf16_t*)(a.ws + WS_BIG + NS_KC);
    bf16_t* outb = (bf16_t*)(a.ws + WS_ACTB); const float* biasG = (const float*)(a.ws + WS_BIASG);
    LAS unsigned char* ring = lds;
    LAS float* imp = (LAS float*)(lds + 49152);
    LAS float* btab = (LAS float*)(lds + 116736);
    LAS unsigned* selm = (LAS unsigned*)(lds + 151808);
    LAS unsigned* wm = selm + 512;
    LAS int* blist = (LAS int*)(wm + 64);
    LAS int* Oacc = (LAS int*)imp;
    constexpr int OAS = 66;
    LAS int* lacc = (LAS int*)(lds + 155392);
    constexpr float FXS = 16384.f;
    LAS float* mref = (LAS float*)(lds + 156416);
    LAS unsigned long long* qmask = (LAS unsigned long long*)(lds + 157440);
    LAS int* qsel = (LAS int*)(lds + 159488);
    const bf16x8* kfr = (const bf16x8*)(a.ws + WS_BIG + NS_KFR); const bf16x8* vfr = (const bf16x8*)(a.ws + WS_BIG + NS_VFR);
    int cur_g = -1;
    unsigned* nsa_ctr = (unsigned*)(a.ws + WS_CTL) + CW_NSAQ;
    volatile LAS int* uword = (volatile LAS int*)(lds + MISC_OFF + 160);
    int nxt_uidx = 0;
    if (tid_of(a.wv) == 0) *uword = (int)xb_add(nsa_ctr + (blockIdx.x & 7) * 64, 1u);
    for (;;) {
        const int bg = blockIdx.x & 7;
        __syncthreads();
        const int uidx = *uword; if (uidx >= 256) break;
        const int tile = 255 - uidx, b = bg >> 2, g = bg & 3;
        const int T0 = tile * 64, tw0 = T0 + 8 * wave;
        const size_t tokbase = (size_t)b * SEQ;
        __syncthreads();
        if (tid_of(a.wv) == 0) nxt_uidx = (int)xb_add(nsa_ctr + bg * 64, 1u);
        bf16x8 Q[4];
        { NSA_VARS
          if (g != cur_g) { for (int rr = 0; rr < 4; ++rr) load_bias_table(btab + rr * (BT_LEN + 8), biasG, 4 * g + rr, 0, tid); cur_g = g; }
          for (int i = tid; i < 64 * 260; i += NTHR) imp[i] = 0.f;
          const bf16_t* qrow = qb_ + (tokbase + t) * 1024 + (4 * g + r) * 64;
#pragma unroll
          for (int ks = 0; ks < 4; ++ks) Q[ks] = *(const bf16x8*)(qrow + 16 * ks + 8 * h); }
        f32x16 OUT[2]; OUT[0] = zero16(); OUT[1] = zero16();
        const int nct = (T0 + 63 >= 31) ? (((T0 + 32) >> 4) >> 6) + 1 : 0;
        const int j0w = (T0 >= 511) ? ((T0 - 511) >> 6) : 0, nwin = tile - j0w + 1, nd = tile >= 2 ? 3 : tile + 1;
        const int e1 = nct, e2 = 2 * nct, e3 = e2 + nwin, e4 = e3 + nd;
        const bf16_t* kcb = kcvc + (size_t)bg * 1024 * 64; const bf16_t* vcb = kcb + (size_t)8192 * 64;
        const bf16_t* kvb = kv6 + tokbase * 1536 + g * 64;
        f32x16 O[2]; O[0] = zero16(); O[1] = zero16();
        float m = -1e30f, l = 0.f, mc = -1e30f, lc = 0.f, invl = 0.f, mfin = 0.f;
        __syncthreads();
        kv_dma_stream<3>(e4, [&](int fi, LAS unsigned char* slot) {
                const int lane = tid_of(a.wv) & 63;
                if (fi < e2) kv_dma_issue(slot, kcb, vcb, 64, 64 * (fi < e1 ? fi : fi - e1), 1024, wave, lane);
                else if (fi < e3) kv_dma_issue(slot, kvb + 4 * 256, kvb + 5 * 256, 1536, (j0w + fi - e2) * 64, SEQ, wave, lane);
                else { const int i = fi - e3, blk = (i == 0) ? 0 : (tile >= 2 ? tile - 2 + i : i); kv_dma_issue(slot, kvb + 2 * 256, kvb + 3 * 256, 1536, blk * 64, SEQ, wave, lane); }
            }, [&](int fi, const LAS unsigned char* kl, const LAS unsigned char* vl) {
                NSA_VARS
                if (fi < e1) {
                    const int c0 = 64 * fi;
                    if (16 * c0 + 31 <= tw0 + 7) {
                        f32x16 S[2]; S[0] = qk_tile_sw(kl, 0, Q, lane); S[1] = qk_tile_sw(kl, 1, Q, lane);
                        stats_tile<16, false>(S, mc, lc, bt, t - 16 * c0 - 31, h, 0, (unsigned)DIST_ANY);
                    }
                } else if (fi < e2) {
                    if (fi == e1) { invl = lc > 0.f ? 1.f / lc : 0.f; mfin = (mc <= -1e30f) ? 0.f : mc; }
                    const int c0 = 64 * (fi - e1);
                    if (16 * c0 + 31 <= tw0 + 7) {
                        f32x16 S[2]; S[0] = qk_tile_sw(kl, 0, Q, lane); S[1] = qk_tile_sw(kl, 1, Q, lane);
                        (void)logits_tile<16, false>(S, bt, t - 16 * c0 - 31, h, 0, (unsigned)DIST_ANY);
#pragma unroll
                        for (int sub = 0; sub < 2; ++sub)
#pragma unroll
                            for (int i = 0; i < 16; ++i) S[sub][i] = __builtin_amdgcn_exp2f(S[sub][i] - mfin) * invl;
#pragma unroll
                        for (int sub = 0; sub < 2; ++sub)
#pragma unroll
                            for (int s = 0; s < 2; ++s) { const int j0 = (c0 + sub * 32 + 16 * s + 8 * h) >> 2;
                                float a0 = (S[sub][8 * s] + S[sub][8 * s + 1]) + (S[sub][8 * s + 2] + S[sub][8 * s + 3]);
                                float a1 = (S[sub][8 * s + 4] + S[sub][8 * s + 5]) + (S[sub][8 * s + 6] + S[sub][8 * s + 7]) + S[sub][8 * s + 3];
                                float a2 = S[sub][8 * s + 7];
                                a0 += quad_xor1(a0); a1 += quad_xor1(a1); a2 += quad_xor1(a2);
                                a0 += quad_xor2(a0); a1 += quad_xor2(a1); a2 += quad_xor2(a2);
                                if (r == 0) { LAS float* ip = imp + (8 * wave + qi) * 260 + j0; atomicAdd((float*)ip, a0); atomicAdd((float*)(ip + 1), a1); atomicAdd((float*)(ip + 2), a2); } }
                        pv_tile_sw(vl, 0, S[0], O, lane); pv_tile_sw(vl, 1, S[1], O, lane);
                    }
                    if (fi == e2 - 1) { const float gt_cmp = gtp[0];
#pragma unroll
                        for (int dt = 0; dt < 2; ++dt)
#pragma unroll
                            for (int i = 0; i < 16; ++i) { OUT[dt][i] += gt_cmp * O[dt][i]; O[dt][i] = 0.f; } }
                } else if (fi < e3) {
                    const int k0 = (j0w + fi - e2) * 64;
                    if (k0 <= tw0 + 7 && k0 + 63 >= tw0 - 511) {
                        f32x16 S[2]; S[0] = qk_tile_sw(kl, 0, Q, lane); S[1] = qk_tile_sw(kl, 1, Q, lane);
                        if (k0 >= tw0 + 7 - 511) softmax_tile<1, false>(S, m, l, O, bt, t - k0, h, 0, 511u);
                        else softmax_tile<1, true>(S, m, l, O, bt, t - k0, h, 0, 511u);
                        pv_tile_sw(vl, 0, S[0], O, lane); pv_tile_sw(vl, 1, S[1], O, lane);
                    }
                    if (fi == e3 - 1) { const float sc_ = gtp[32] / l;
#pragma unroll
                        for (int dt = 0; dt < 2; ++dt)
#pragma unroll
                            for (int i = 0; i < 16; ++i) { OUT[dt][i] += sc_ * O[dt][i]; O[dt][i] = 0.f; }
                        m = -1e30f; l = 0.f; }
                } else {
                    const int i = fi - e3, blk = (i == 0) ? 0 : (tile >= 2 ? tile - 2 + i : i), k0 = blk * 64;
                    f32x16 S[2]; S[0] = qk_tile_sw(kl, 0, Q, lane); S[1] = qk_tile_sw(kl, 1, Q, lane);
                    softmax_tile<1, false>(S, m, l, O, bt, t - k0, h, 0, (unsigned)DIST_ANY);
                    pv_tile_sw(vl, 0, S[0], O, lane); pv_tile_sw(vl, 1, S[1], O, lane);
                }
            }, ring);
        __syncthreads();
        {
            const int lane = tid_of(a.wv) & 63;
            const int cur = tile;
            unsigned key[8][4];
#pragma unroll
            for (int q4 = 0; q4 < 8; ++q4) { const int ql = 8 * wave + q4;
#pragma unroll
                for (int kk = 0; kk < 4; ++kk) { const int j = lane + 64 * kk; const bool forced = (j == 0) || (j == cur) || (j + 1 == cur);
                    key[q4][kk] = forced ? 0xffffffffu : ((j <= cur) ? f2u(imp[ql * 260 + j]) + 1u : 0u); } }
            unsigned prefix[8] = {0u, 0u, 0u, 0u, 0u, 0u, 0u, 0u}; unsigned settled = 0u;
#pragma unroll 1
            for (int bit = 31; bit >= 0; --bit) {
#pragma unroll
                for (int q4 = 0; q4 < 8; ++q4) { const unsigned cand = prefix[q4] | (1u << bit); int cnt = 0;
#pragma unroll
                    for (int kk = 0; kk < 4; ++kk) cnt += __popcll(__ballot(key[q4][kk] >= cand));
                    if (cnt >= 16) prefix[q4] = cand;
                    if (cnt == 16) settled |= 1u << q4; }
                if (settled == 0xffu) break; }
            const unsigned long long ltmask = (1ull << lane) - 1ull;
#pragma unroll
            for (int q4 = 0; q4 < 8; ++q4) { const int ql = 8 * wave + q4; const unsigned pf = prefix[q4];
                int cgt = 0;
#pragma unroll
                for (int kk = 0; kk < 4; ++kk) cgt += __popcll(__ballot(key[q4][kk] > pf));
                const int need = 16 - cgt; int running = 0;
#pragma unroll
                for (int kk = 0; kk < 4; ++kk) { const unsigned long long eqb = __ballot(key[q4][kk] == pf);
                    const bool take = key[q4][kk] > pf || (pf != 0u && key[q4][kk] == pf && running + __popcll(eqb & ltmask) < need);
                    running += __popcll(eqb);
                    const unsigned long long bal = __ballot(take);
                    if (lane == 0) { selm[ql * 8 + 2 * kk] = (unsigned)bal; selm[ql * 8 + 2 * kk + 1] = (unsigned)(bal >> 32); } } }
        }
        __syncthreads();
        { const int tid = tid_of(a.wv);
          if (tid < 8) { unsigned o = 0u;
              if (tid == 0) o |= 1u;
              if ((tile >> 5) == tid) o |= 1u << (tile & 31);
              if (tile >= 1 && ((tile - 1) >> 5) == tid) o |= 1u << ((tile - 1) & 31);
              wm[tid] = o; } }
        __syncthreads();
        { const int lane = tid_of(a.wv) & 63;
#pragma unroll 1
          for (int jj = 0; jj < 32; ++jj) { const int j = wave * 32 + jj; const unsigned w = selm[lane * 8 + (j >> 5)] & ~wm[j >> 5];
              const unsigned long long bal = __ballot((w >> (j & 31)) & 1u); if (lane == 0) qmask[j] = bal; } }
        {
            NSA_VARS
            LAS int* oa = Oacc + ((8 * wave + qi) * 4 + r) * OAS;
#pragma unroll
            for (int dt = 0; dt < 2; ++dt)
#pragma unroll
                for (int g4 = 0; g4 < 4; ++g4) { u32x2 w0, w1; w0.x = (unsigned)(int)(O[dt][4 * g4] * FXS); w0.y = (unsigned)(int)(O[dt][4 * g4 + 1] * FXS); w1.x = (unsigned)(int)(O[dt][4 * g4 + 2] * FXS); w1.y = (unsigned)(int)(O[dt][4 * g4 + 3] * FXS);
                    *(LAS u32x2*)(oa + dt * 32 + 8 * g4 + 4 * h) = w0; *(LAS u32x2*)(oa + dt * 32 + 8 * g4 + 4 * h + 2) = w1; }
            if (h == 0) { lacc[(8 * wave + qi) * 4 + r] = (int)(l * FXS); mref[(8 * wave + qi) * 4 + r] = m; }
        }
        __syncthreads();
        {
            NSA_VARS
            LAS int* qs = qsel + wave * 8;
            const unsigned long long ltm = (1ull << lane) - 1ull;
            int j = wave; unsigned long long qm = 0ull;
            while (j <= tile) { qm = qmask[j]; if (qm != 0ull) break; j += 8; }
            if (j <= tile) {
                int n = __popcll(qm), ch = 0;
                if ((qm >> lane) & 1ull) { const int rk = __popcll(qm & ltm); if (rk < 8) qs[rk] = lane; }
                bool lv = qi < n; int ql = qs[lv ? qi : 0];
                bf16x8 KA[2][4], VA[2][2][2], Qs[4];
                { const bf16x8* kp = kfr + ((size_t)(bg * 256 + j) * 8) * 64 + lane; const bf16x8* vp = vfr + ((size_t)(bg * 256 + j) * 8) * 64 + lane;
                  const bf16_t* qrow = qb_ + (tokbase + T0 + ql) * 1024 + (4 * g + r) * 64;
#pragma unroll
                  for (int ks = 0; ks < 4; ++ks) Qs[ks] = *(const bf16x8*)(qrow + 16 * ks + 8 * h);
#pragma unroll
                  for (int f8 = 0; f8 < 8; ++f8) KA[f8 >> 2][f8 & 3] = kp[f8 * 64];
#pragma unroll
                  for (int f8 = 0; f8 < 8; ++f8) VA[f8 >> 2][(f8 >> 1) & 1][f8 & 1] = vp[f8 * 64]; }
#pragma unroll 1
                for (;;) {
                    int jn = j, chn = ch + 1, nn = n; unsigned long long qmn = qm;
                    if (chn * 8 >= n) { chn = 0; jn = j + 8; qmn = 0ull; while (jn <= tile) { qmn = qmask[jn]; if (qmn != 0ull) break; jn += 8; } nn = __popcll(qmn); }
                    const bool has_next = jn <= tile, newblk = jn != j;
                    f32x16 S[2];
#pragma unroll
                    for (int kt = 0; kt < 2; ++kt) { S[kt] = zero16();
#pragma unroll
                        for (int ks = 0; ks < 4; ++ks) S[kt] = mfma32(KA[kt][ks], Qs[ks], S[kt]); }
                    const int tq = T0 + ql, D0 = tq - j * 64;
                    const float mr = mref[ql * 4 + r];
                    LAS int* oa = Oacc + (ql * 4 + r) * OAS + 4 * h; LAS int* la = lacc + ql * 4 + r;
                    const bool lvc = lv;
                    if (has_next) {
                        if ((qmn >> lane) & 1ull) { const int rk = __popcll(qmn & ltm) - 8 * chn; if (rk >= 0 && rk < 8) qs[rk] = lane; }
                        lv = qi < nn - 8 * chn; ql = qs[lv ? qi : 0];
                        const bf16_t* qrow = qb_ + (tokbase + T0 + ql) * 1024 + (4 * g + r) * 64;
#pragma unroll
                        for (int ks = 0; ks < 4; ++ks) Qs[ks] = *(const bf16x8*)(qrow + 16 * ks + 8 * h);
                        if (newblk) { const bf16x8* kp = kfr + ((size_t)(bg * 256 + jn) * 8) * 64 + lane;
#pragma unroll
                            for (int f8 = 0; f8 < 8; ++f8) KA[f8 >> 2][f8 & 3] = kp[f8 * 64]; }
                    }
                    (void)logits_tile<1, false>(S, bt, D0, h, 0, (unsigned)DIST_ANY);
                    float ls = 0.f;
#pragma unroll
                    for (int kt = 0; kt < 2; ++kt)
#pragma unroll
                        for (int i = 0; i < 16; ++i) { const float p = lvc ? __builtin_amdgcn_exp2f(S[kt][i] - mr) : 0.f; S[kt][i] = p; ls += p; }
                    ls += xor32h(ls, h);
                    f32x16 Oa[2]; Oa[0] = zero16(); Oa[1] = zero16();
#pragma unroll
                    for (int kt = 0; kt < 2; ++kt)
#pragma unroll
                        for (int s = 0; s < 2; ++s) {
                            u32x4 pk; pk.x = cvt_pk_bf16(S[kt][8 * s + 0], S[kt][8 * s + 1]); pk.y = cvt_pk_bf16(S[kt][8 * s + 2], S[kt][8 * s + 3]); pk.z = cvt_pk_bf16(S[kt][8 * s + 4], S[kt][8 * s + 5]); pk.w = cvt_pk_bf16(S[kt][8 * s + 6], S[kt][8 * s + 7]);
                            const bf16x8 Bp = __builtin_bit_cast(bf16x8, pk);
                            Oa[0] = mfma32(VA[kt][s][0], Bp, Oa[0]); Oa[1] = mfma32(VA[kt][s][1], Bp, Oa[1]); }
                    if (has_next && newblk) { const bf16x8* vp = vfr + ((size_t)(bg * 256 + jn) * 8) * 64 + lane;
#pragma unroll
                        for (int f8 = 0; f8 < 8; ++f8) VA[f8 >> 2][(f8 >> 1) & 1][f8 & 1] = vp[f8 * 64]; }
                    if (lvc) {
#pragma unroll
                        for (int dt = 0; dt < 2; ++dt)
#pragma unroll
                            for (int i = 0; i < 16; ++i) atomicAdd((int*)(oa + dt * 32 + (i & 3) + 8 * (i >> 2)), (int)(Oa[dt][i] * FXS));
                        if (h == 0) atomicAdd((int*)la, (int)(ls * FXS)); }
                    if (!has_next) break;
                    j = jn; ch = chn; qm = qmn; n = nn;
                }
            }
        }
        __syncthreads();
        {
            NSA_VARS
            const float gt_sel = gtp[16];
            const LAS int* oa = Oacc + ((8 * wave + qi) * 4 + r) * OAS;
            const float sc_ = gt_sel / (float)lacc[(8 * wave + qi) * 4 + r];
#pragma unroll
            for (int dt = 0; dt < 2; ++dt)
#pragma unroll
                for (int g4 = 0; g4 < 4; ++g4) { const u32x2 v0 = *(const LAS u32x2*)(oa + dt * 32 + 8 * g4 + 4 * h), v1 = *(const LAS u32x2*)(oa + dt * 32 + 8 * g4 + 4 * h + 2);
                    OUT[dt][4 * g4] += sc_ * (float)(int)v0.x; OUT[dt][4 * g4 + 1] += sc_ * (float)(int)v0.y; OUT[dt][4 * g4 + 2] += sc_ * (float)(int)v1.x; OUT[dt][4 * g4 + 3] += sc_ * (float)(int)v1.y; }
        }
        { NSA_VARS
          store_o(outb + (tokbase + t) * D + (4 * g + r) * 64, OUT, 1.f, h); }
        if (tid_of(a.wv) == 0) *uword = nxt_uidx;
    }
#undef NSA_VARS
}

template <bool DIAG>
DI void sb_probs(f32x16 (&SP)[2], f32x16 (&U)[2], float (&Tc)[2][2], int kb0, int t, int h) {
#pragma unroll
    for (int sub = 0; sub < 2; ++sub)
#pragma unroll
        for (int s = 0; s < 2; ++s) { float acc = 1.f;
#pragma unroll
            for (int j = 0; j < 8; ++j) { const int i = 8 * s + j;
                const float z2 = __builtin_amdgcn_fmed3f(SP[sub][i] * (0.125f * LOG2E), -60.f * LOG2E, 60.f * LOG2E);
                const float e = __builtin_amdgcn_exp2f(z2);
                const float u = __builtin_amdgcn_rcpf(1.f + e);
                if (DIAG) { const bool valid = kb0 + sub * 32 + 16 * s + 8 * h + j < t; SP[sub][i] = valid ? e * u : 0.f; U[sub][i] = valid ? u : 1.f; }
                else { SP[sub][i] = e * u; U[sub][i] = u; }
                acc *= U[sub][i]; }
            Tc[sub][s] = acc; }
}
DI void sb_phase(const Args& a, LAS unsigned char* lds) {
    int tid = tid_of(a.wv); asm volatile("" : "+v"(tid));
    const int lane = tid & 63, wave = __builtin_amdgcn_readfirstlane(tid >> 6), c = lane & 31, h = lane >> 5;
    const bf16_t* qkv = (const bf16_t*)(a.ws + WS_BIG);
    bf16_t* outb = (bf16_t*)(a.ws + WS_ACTB);
    LAS unsigned char* kbuf = lds; LAS unsigned char* vbuf = lds + 2 * KV_TILE_BYTES;
    volatile LAS int* flags = (volatile LAS int*)(lds + 4 * KV_TILE_BYTES);
    for (int u = blockIdx.x; u < 2048; u += gridDim.x) {
        const int qb = u & 63, hh = (u >> 6) & 15, b = u >> 10;
        const int q0w = qb * 256 + 32 * wave, t = q0w + c;
        const size_t tokbase = (size_t)b * SEQ;
        const bf16_t* kb = qkv + tokbase * 3072 + 1024 + hh * 64;
        const bf16_t* vb = qkv + tokbase * 3072 + 2048 + hh * 64;
        bf16x8 Q[4];
        { const bf16_t* qrow = qkv + (tokbase + t) * 3072 + hh * 64;
#pragma unroll
          for (int ks = 0; ks < 4; ++ks) Q[ks] = *(const bf16x8*)(qrow + 16 * ks + 8 * h); }
        f32x16 O[2]; O[0] = zero16(); O[1] = zero16();
        float carry = 1.f; bool wdone = false;
        int jt = qb * 4 + 3, buf = 0;
        u32x4 kr, vr;
        kv_fetch(kr, vr, kb, vb, 3072, jt * 64, SEQ, tid); kv_store(kbuf, vbuf, kr, vr, tid);
        __syncthreads();
        for (; jt >= 0; --jt) {
            if (jt > 0) kv_fetch(kr, vr, kb, vb, 3072, (jt - 1) * 64, SEQ, tid);
            const int kb0 = jt * 64;
            if (!wdone && kb0 < q0w + 31) {
                const LAS unsigned char* kl = kbuf + buf * KV_TILE_BYTES; const LAS unsigned char* vl = vbuf + buf * KV_TILE_BYTES;
                f32x16 SP[2], U[2];
                SP[0] = qk_tile(kl, 0, Q, lane); SP[1] = qk_tile(kl, 1, Q, lane);
                float Tc[2][2];
                if (kb0 + 63 < q0w) sb_probs<false>(SP, U, Tc, kb0, t, h);
                else sb_probs<true>(SP, U, Tc, kb0, t, h);
                float Tp[2][2], pr[2][2];
#pragma unroll
                for (int sub = 0; sub < 2; ++sub)
#pragma unroll
                    for (int s = 0; s < 2; ++s) { Tp[sub][s] = xor32h(Tc[sub][s], h); pr[sub][s] = Tc[sub][s] * Tp[sub][s]; }
                float offp[2][2];
                offp[1][1] = carry; offp[1][0] = offp[1][1] * pr[1][1]; offp[0][1] = offp[1][0] * pr[1][0]; offp[0][0] = offp[0][1] * pr[0][1];
                carry = offp[0][0] * pr[0][0];
#pragma unroll
                for (int sub = 0; sub < 2; ++sub)
#pragma unroll
                    for (int s = 0; s < 2; ++s) { float run = offp[sub][s] * (h == 0 ? Tp[sub][s] : 1.f);
#pragma unroll
                        for (int j = 7; j >= 0; --j) { const int i = 8 * s + j; SP[sub][i] *= run; run *= U[sub][i]; } }
                pv_tile(vl, 0, SP[0], O, lane); pv_tile(vl, 1, SP[1], O, lane);
                wdone = __all(carry < 1e-38f);
            }
            if (lane == 0) flags[buf * 8 + wave] = wdone ? 1 : 0;
            if (jt > 0) kv_store(kbuf + (buf ^ 1) * KV_TILE_BYTES, vbuf + (buf ^ 1) * KV_TILE_BYTES, kr, vr, tid);
            __syncthreads();
            int alld = 1;
#pragma unroll
            for (int w = 0; w < 8; ++w) alld &= flags[buf * 8 + w];
            buf ^= 1;
            if (alld) break;
        }
        store_o(outb + (tokbase + t) * D + hh * 64, O, 1.f, h);
        __syncthreads();
    }
}

#ifndef DBG
#define DBG 0
#endif
#if DBG
DI float dbg_block_max(float v, LAS float* red) {
#pragma unroll
    for (int o = 1; o < 64; o <<= 1) v = fmaxf(v, __shfl_xor(v, o));
    __syncthreads();
    if ((threadIdx.x & 63) == 0) red[threadIdx.x >> 6] = v;
    __syncthreads();
    float r = red[0];
    for (int i = 1; i < 8; ++i) r = fmaxf(r, red[i]);
    __syncthreads();
    return r;
}
DI float dbg_block_sum(float v, LAS float* red) {
#pragma unroll
    for (int o = 1; o < 64; o <<= 1) v += __shfl_xor(v, o);
    __syncthreads();
    if ((threadIdx.x & 63) == 0) red[threadIdx.x >> 6] = v;
    __syncthreads();
    float r = 0.f;
    for (int i = 0; i < 8; ++i) r += red[i];
    __syncthreads();
    return r;
}
DI void dbg_note(unsigned* ctl, int idx, float err) { if (threadIdx.x == 0) atomicMax(ctl + CW_DBG + idx, __builtin_bit_cast(unsigned, err)); }
template <int layer>
DI void dbg_check(const Args& a, LAS unsigned char* lds, int stage, const MoeMeta& mm) {
    if (blockIdx.x >= 64) return;
    const int tid = threadIdx.x;
    const int t = blockIdx.x * 512 + (blockIdx.x * 37) % 512;
    LAS float* x1 = (LAS float*)(lds);
    LAS float* hh = x1 + 1024;
    LAS float* yy = hh + 512;
    LAS float* red = yy + 2048;
    LAS float* scl = red + 16;
    unsigned* ctl = (unsigned*)(a.ws + WS_CTL);
    float* dbgx1 = (float*)(a.ws + WS_SMALL) + blockIdx.x * 1024;
    const float* xout = a.out; const bf16_t* actb = (const bf16_t*)(a.ws + WS_ACTB);
    const u32x4 ti = *(const u32x4*)(a.ws + WS_TOKINFO + (size_t)t * 16);
    const int e0 = ti.x & 15, p0 = ti.x >> 4, e1 = ti.z & 15, p1 = ti.z >> 4;
    const float w0 = u2f(ti.y), w1 = u2f(ti.w);
    __syncthreads();
    if (tid == 0) { scl[16] = w0; scl[17] = w1; }
    __syncthreads();
    if (stage == 1) {
        const float* xin = (layer == 0) ? a.in[IN_X] : nullptr;
        if (xin) {
            float v0 = ALPHA * xin[(size_t)t * D + tid], v1 = ALPHA * xin[(size_t)t * D + tid + 512];
            const float mean = dbg_block_sum(v0 + v1, red) / D;
            const float var = dbg_block_sum((v0 - mean) * (v0 - mean) + (v1 - mean) * (v1 - mean), red) / D;
            const float rstd = 1.f / sqrtf(var + LN_EPS);
            const float* g = a.in[IN_LN1G] + layer * D; const float* b = a.in[IN_LN1B] + layer * D;
            const float r0 = (v0 - mean) * rstd * g[tid] + b[tid], r1 = (v1 - mean) * rstd * g[tid + 512] + b[tid + 512];
            float e = fmaxf(fabsf(r0 - xout[(size_t)t * D + tid]), fabsf(r1 - xout[(size_t)t * D + tid + 512]));
            dbg_note(ctl, 0, dbg_block_max(e, red));
            const float q0 = __builtin_bit_cast(float, (unsigned)actb[(size_t)t * D + tid] << 16), q1 = __builtin_bit_cast(float, (unsigned)actb[(size_t)t * D + tid + 512] << 16);
            e = fmaxf(fabsf(r0 - q0), fabsf(r1 - q1));
            dbg_note(ctl, 1, dbg_block_max(e, red));
        }
        x1[tid] = xout[(size_t)t * D + tid]; x1[tid + 512] = xout[(size_t)t * D + tid + 512];
        dbgx1[tid] = x1[tid]; dbgx1[tid + 512] = x1[tid + 512];
        __syncthreads();
        if (tid < 16) { float s = 0.f; for (int k = 0; k < D; ++k) s += x1[k] * a.in[IN_RW][k * 16 + tid]; scl[tid] = 1.f / (1.f + expf(-s)); }
        __syncthreads();
        if (tid == 0) {
            float bz[16]; for (int e = 0; e < 16; ++e) bz[e] = scl[e] + a.in[IN_RB][e];
            int bg = 0; float bgs = -1e30f;
            for (int g = 0; g < 4; ++g) { float m1 = -1e30f, m2 = -1e30f; for (int k = 0; k < 4; ++k) { const float v = bz[4 * g + k]; if (v > m1) { m2 = m1; m1 = v; } else if (v > m2) m2 = v; }
                if (m1 + m2 > bgs) { bgs = m1 + m2; bg = g; } }
            int i1 = 0; for (int k = 1; k < 4; ++k) if (bz[4 * bg + k] > bz[4 * bg + i1]) i1 = k;
            int i2 = -1; for (int k = 0; k < 4; ++k) if (k != i1 && (i2 < 0 || bz[4 * bg + k] > bz[4 * bg + i2])) i2 = k;
            const float s1 = scl[4 * bg + i1], s2 = scl[4 * bg + i2];
            float err = 0.f;
            if (e0 != 4 * bg + i1 || e1 != 4 * bg + i2) err = 1.f;
            err = fmaxf(err, fabsf(scl[16] - s1 / (s1 + s2))); err = fmaxf(err, fabsf(scl[17] - s2 / (s1 + s2)));
            if (p0 >= mm.cnt[e0] || p1 >= mm.cnt[e1]) err = 2.f;
            else { const unsigned* list = (const unsigned*)(a.ws + WS_LIST); if (list[e0 * 32768 + p0] != (unsigned)t || list[e1 * 32768 + p1] != (unsigned)t) err = 3.f; }
            atomicMax(ctl + CW_DBG + 2, __builtin_bit_cast(unsigned, err));
        }
        return;
    }
    x1[tid] = dbgx1[tid]; x1[tid + 512] = dbgx1[tid + 512];
    __syncthreads();
    const float* eg = a.in[IN_EG] + (size_t)layer * NE * D * DEXP; const float* eu = a.in[IN_EU] + (size_t)layer * NE * D * DEXP; const float* ed = a.in[IN_ED] + (size_t)layer * NE * DEXP * D;
    { const int k = tid >> 8, j = tid & 255, e = k ? e1 : e0;
      float g = 0.f, u = 0.f; for (int i = 0; i < D; ++i) { g += x1[i] * eg[((size_t)e * D + i) * DEXP + j]; u += x1[i] * eu[((size_t)e * D + i) * DEXP + j]; }
      hh[k * 256 + j] = g / (1.f + expf(-g)) * u; }
    __syncthreads();
    const size_t s0 = (size_t)mm.tstart[e0] * 256 + p0, s1 = (size_t)mm.tstart[e1] * 256 + p1;
    if (stage == 2) {
        const bf16_t* hb = (const bf16_t*)(a.ws + WS_BIG + BIG_H);
        const int k = tid >> 8, j = tid & 255; const size_t s = k ? s1 : s0;
        const float got = __builtin_bit_cast(float, (unsigned)hb[s * DEXP + j] << 16);
        const float ref = hh[tid];
        const float rms = sqrtf(dbg_block_sum(ref * ref, red) / 512.f);
        dbg_note(ctl, 3, dbg_block_max(fabsf(got - ref), red) / (rms + 1e-6f));
        return;
    }
    for (int c = tid; c < 2048; c += 512) { const int k = c >> 10, col = c & 1023, e = k ? e1 : e0; float s = 0.f;
        for (int j = 0; j < DEXP; ++j) s += hh[k * 256 + j] * ed[((size_t)e * DEXP + j) * D + col];
        yy[c] = s; }
    __syncthreads();
    if (stage == 3) {
        const bf16_t* yb = (const bf16_t*)(a.ws + WS_BIG + BIG_YB);
        float e = 0.f, sq = 0.f;
        for (int c = tid; c < 2048; c += 512) { const int k = c >> 10, col = c & 1023; const size_t s = k ? s1 : s0;
            const float got = __builtin_bit_cast(float, (unsigned)yb[s * D + col] << 16); e = fmaxf(e, fabsf(got - yy[c])); sq += yy[c] * yy[c]; }
        const float rms = sqrtf(dbg_block_sum(sq, red) / 2048.f);
        dbg_note(ctl, 4, dbg_block_max(e, red) / (rms + 1e-6f));
        return;
    }
    {
        float v0 = ALPHA * x1[tid] + w0 * yy[tid] + w1 * yy[1024 + tid], v1 = ALPHA * x1[tid + 512] + w0 * yy[tid + 512] + w1 * yy[1024 + tid + 512];
        const float mean = dbg_block_sum(v0 + v1, red) / D;
        const float var = dbg_block_sum((v0 - mean) * (v0 - mean) + (v1 - mean) * (v1 - mean), red) / D;
        const float rstd = 1.f / sqrtf(var + LN_EPS);
        const float* g = a.in[IN_LN2G] + layer * D; const float* b = a.in[IN_LN2B] + layer * D;
        const float r0 = (v0 - mean) * rstd * g[tid] + b[tid], r1 = (v1 - mean) * rstd * g[tid + 512] + b[tid + 512];
        const float e = fmaxf(fabsf(r0 - xout[(size_t)t * D + tid]), fabsf(r1 - xout[(size_t)t * D + tid + 512]));
        dbg_note(ctl, 5, dbg_block_max(e, red));
    }
}
DI void dbg_final(const Args& a) {
    unsigned* ctl = (unsigned*)(a.ws + WS_CTL);
    const float tol[6] = {1e-4f, 2e-2f, 1e-3f, 0.12f, 0.12f, 4e-2f};
    int code = 2;
    for (int i = 5; i >= 0; --i) { const float err = __builtin_bit_cast(float, xb_ld(ctl + CW_DBG + i));
        if (!(err <= tol[i])) { const int dg = !(err < 1.f) ? 9 : err >= 0.3f ? 7 : err >= 0.1f ? 5 : err >= 0.03f ? 3 : 1; code = 10 * (i + 1) + dg; } }
#ifdef PROBE
    { const float p0 = (float)xb_ld(ctl + CW_DBG + 10) / 65536.f, p1 = __builtin_bit_cast(float, xb_ld(ctl + CW_DBG + 9));
      const int d0 = p0 < 0.f ? 0 : p0 >= 1.f ? 9 : (int)(p0 * 9.99f), d1 = p1 < 0.f ? 0 : p1 >= 1.f ? 9 : (int)(p1 * 9.99f); code = 10 * d0 + d1; }
#endif
    if (xb_ld(ctl + CW_BAR + XB_TMO)) code = 95;
    const float c = sqrtf((float)code);
    for (size_t i = (size_t)blockIdx.x * NTHR + threadIdx.x; i < (size_t)T * D; i += (size_t)gridDim.x * NTHR) a.out[i] = c;
}
#endif


#ifndef PROBE_LO
#define PROBE_LO -1
#define PROBE_HI -1
#define PROBE_MULT 0
#endif
#ifndef PROBE_MASK
#define PROBE_MASK 0ull
#endif
DI void probe_tick(LAS unsigned char* lds, int wv) {
    if (PROBE_LO < 0) return;
    volatile LAS unsigned* M = (volatile LAS unsigned*)(lds + MISC_OFF);
    if (tid_of(wv) == 0) { const unsigned long long now = __builtin_amdgcn_s_memrealtime(); const int k = (int)M[16];
        const unsigned long long last = (unsigned long long)M[18] | ((unsigned long long)M[19] << 32);
        if ((k >= PROBE_LO && k <= PROBE_HI) || ((PROBE_MASK >> k) & 1ull)) { unsigned long long acc = (unsigned long long)M[20] | ((unsigned long long)M[21] << 32); acc += now - last; M[20] = (unsigned)acc; M[21] = (unsigned)(acc >> 32); }
        M[16] = (unsigned)(k + 1); M[18] = (unsigned)now; M[19] = (unsigned)(now >> 32); }
}
#define GRID_BAR() do { xcd_barrier(bar); probe_tick(lds, a.wv); } while (0)
constexpr bool HAS_MIXER[4] = {true, true, true, true};
template <int layer>
DI void run_layer(const Args& a, LAS unsigned char* lds, const XcdBarrier& bar) {
    const int wave = a.wv;
    const int G = gridDim.x, bid = blockIdx.x;
    const int gw = bid * NWAVES + wave, NGW = G * NWAVES;
    unsigned char* ws = a.ws;
    unsigned* ctl = (unsigned*)(a.ws + WS_CTL);
    bf16_t* actb = (bf16_t*)(ws + WS_ACTB);
    float* xout = a.out;
    bf16_t* xres = (bf16_t*)a.out;
        bf16_t* bigb = (bf16_t*)(ws + WS_BIG);
        if (layer == 0) {
#pragma unroll 1
            for (int b = 0; b < BATCH; ++b) {
                { pg8::DenseSched S; S.init(xres + (size_t)b * SEQ * D, D * 2, 128, ws + WS_WIN, SEQ, 9216, D, G, bid); pg8::EpiStore E{bigb, (size_t)9216}; pg8::gemm_phase(lds + STAGE_OFF, S, E, a.wv); }
                if (b == 1) dilated_merge(a, 0);
                GRID_BAR();
                dilated_phase(a, lds);
                GRID_BAR();
            }
            dilated_merge(a, 1);
            GRID_BAR();
        }
        if (layer == 1) {
            { pg8::DenseSched S; S.init(xres, D * 2, 128, ws + WS_WIN, T, 3072, D, G, bid); pg8::EpiStore E{bigb, (size_t)3072}; pg8::gemm_phase(lds + STAGE_OFF, S, E, a.wv); }
            GRID_BAR();
            sb_phase(a, lds);
            GRID_BAR();
        }
        if (layer == 2) {
            { pg8::DenseSched S; S.init(xres, D * 2, 128, ws + WS_WIN, T, (G == 256) ? 2560 : 2816, D, G, bid);
              pg8::EpiNsa E{(bf16_t*)(ws + WS_BIG + NS_Q), (bf16_t*)(ws + WS_BIG + NS_KV), (float*)(ws + WS_BIG + NS_GT)}; pg8::gemm_phase(lds + STAGE_OFF, S, E, a.wv); }
            GRID_BAR();
            { pg8::CmpSched S; S.kv6 = (const char*)(ws + WS_BIG + NS_KV); S.Bt = (const char*)(ws + WS_WCMP); S.K = 2048; S.lda = 16 * 1536 * 2; S.kstepA = 1536 * 2; S.G = G; S.c = bid;
              pg8::EpiCmp E{(bf16_t*)(ws + WS_BIG + NS_HID), (const float*)(ws + WS_WCMP + 2 * MiB + 64 * 1024)}; pg8::gemm_phase(lds + STAGE_OFF, S, E, a.wv); }
            if (G == 256 && bid < 64) {
                asm volatile("s_waitcnt vmcnt(0)" ::: "memory");
                __syncthreads();
                nsa_kcvc_own_unit(a, bid);
            }
            if (G == 256) {
                { pg8::ColTileSched S; S.A = (const char*)xres; S.Bt = (const char*)(ws + WS_WIN); S.K = D; S.lda = D * 2; S.kstepA = 128; S.pn = 10; S.nunits = T / 256; S.nranks = 128;
                  S.rank = (bid >= 64 && bid < 192) ? bid - 64 : -1;
                  pg8::EpiNsa E{(bf16_t*)(ws + WS_BIG + NS_Q), (bf16_t*)(ws + WS_BIG + NS_KV), (float*)(ws + WS_BIG + NS_GT)}; pg8::gemm_phase(lds + STAGE_OFF, S, E, a.wv); }
                if (bid >= 64 && bid < 192) nsa_pretile(a, lds, bid - 64, 128, 1024);
                else if (bid >= 192) nsa_pretile(a, lds, 1024 + (bid - 192), 64, 2048);
            } else nsa_pretile(a, lds, bid, G, 2048);
            GRID_BAR();
            if (G != 256) { nsa_kcvc_phase(a, lds); GRID_BAR(); }
            nsa_attn_phase(a, lds);
            GRID_BAR();
        }
        if (layer == 3) {
            { pg8::DenseSched S; S.init(xres, D * 2, 128, ws + WS_WIN, T, 3072, D, G, bid); pg8::EpiStore E{bigb, (size_t)3072}; pg8::gemm_phase(lds + STAGE_OFF, S, E, a.wv); }
            GRID_BAR();
            moba_kmean_phase(a, lds);
            GRID_BAR();
            moba_gate_phase(a, lds);
            GRID_BAR();
            moba_fill_phase(a, lds);
            GRID_BAR();
            moba_sel_phase(a, lds);
            GRID_BAR();
            moba_own_phase(a, lds);
            GRID_BAR();
        }
        if (HAS_MIXER[layer]) {
            { pg8::DenseSched S; S.init(actb, D * 2, 128, ws + WS_WOUT, T, D, D, G, bid); pg8::EpiStore E{(bf16_t*)(ws + WS_BIG + BIG_Y), (size_t)D}; pg8::gemm_phase(lds + STAGE_OFF, S, E, a.wv); }
            GRID_BAR();
        }
        unsigned* gcount = ctl + CW_MOE + layer * 16 * 64;
        {
            const int tid = tid_of(a.wv), lane = tid & 63, j4 = lane & 3, cg = lane >> 2;
            LAS float* rwf = (LAS float*)(lds + STAGE_OFF);
            LAS float* gbl = rwf + 16384;
            LAS int* lcnt = (LAS int*)(lds + STAGE_OFF + 73728);
            LAS int* gbase = lcnt + 16;
            LAS unsigned* le = (LAS unsigned*)(lcnt + 32);
            LAS float* lg = (LAS float*)(le + 256);
            const bf16_t* ybig = (const bf16_t*)(ws + WS_BIG + BIG_Y);
            u32x4 pxb[8], py[8];
#define LN1_LOADX(Q_) { const size_t rb_ = (size_t)(bid * 128 + 4 * (wave + NWAVES * (Q_)) + j4) * D + 8 * cg; \
                _Pragma("unroll") for (int i_ = 0; i_ < 8; ++i_) { \
                    pxb[i_] = __builtin_nontemporal_load((const u32x4*)(xres + rb_ + 128 * i_)); } }
#define LN1_LOADY(Q_) { const size_t rb_ = (size_t)(bid * 128 + 4 * (wave + NWAVES * (Q_)) + j4) * D + 8 * cg; \
                _Pragma("unroll") for (int i_ = 0; i_ < 8; ++i_) py[i_] = HAS_MIXER[layer] ? __builtin_nontemporal_load((const u32x4*)(ybig + rb_ + 128 * i_)) : (u32x4){0u, 0u, 0u, 0u}; }
            LN1_LOADX(0) LN1_LOADY(0)
            { const u32x4* img = (const u32x4*)(ws + WS_RW); LAS u32x4* dst = (LAS u32x4*)rwf;
              for (int i = tid; i < 4096; i += NTHR) dst[i] = img[i];
              const float* g1 = a.in[IN_LN1G] + layer * D; const float* b1 = a.in[IN_LN1B] + layer * D;
              for (int i = tid; i < 256; i += NTHR) { const int cg_ = i & 15, half = (i >> 4) & 1, ii = i >> 5, col = 8 * (cg_ + 16 * ii) + 4 * half;
                  *(LAS f32x4*)(gbl + 4 * i) = *(const f32x4*)(g1 + col); *(LAS f32x4*)(gbl + 1024 + 4 * i) = *(const f32x4*)(b1 + col); } }
            if (tid < 16) lcnt[tid] = 0;
            __syncthreads();
#pragma unroll 1
            for (int q = 0; q < 4; ++q) {
                const int lt = 4 * (wave + NWAVES * q) + j4, t = bid * 128 + lt;
                float r[64];
#pragma unroll
                for (int i = 0; i < 8; ++i) {
                    { r[8 * i] = ALPHA * bf_lo(pxb[i].x); r[8 * i + 1] = ALPHA * bf_hi(pxb[i].x); r[8 * i + 2] = ALPHA * bf_lo(pxb[i].y); r[8 * i + 3] = ALPHA * bf_hi(pxb[i].y);
                        r[8 * i + 4] = ALPHA * bf_lo(pxb[i].z); r[8 * i + 5] = ALPHA * bf_hi(pxb[i].z); r[8 * i + 6] = ALPHA * bf_lo(pxb[i].w); r[8 * i + 7] = ALPHA * bf_hi(pxb[i].w); }
                    r[8 * i] += bf_lo(py[i].x); r[8 * i + 1] += bf_hi(py[i].x); r[8 * i + 2] += bf_lo(py[i].y); r[8 * i + 3] += bf_hi(py[i].y);
                    r[8 * i + 4] += bf_lo(py[i].z); r[8 * i + 5] += bf_hi(py[i].z); r[8 * i + 6] += bf_lo(py[i].w); r[8 * i + 7] += bf_hi(py[i].w); }
                if (q < 3) LN1_LOADY(q + 1)
                float s = 0.f;
#pragma unroll
                for (int i = 0; i < 64; i += 4) s += (r[i] + r[i + 1]) + (r[i + 2] + r[i + 3]);
                s += row_ror4(s); s += row_ror8(s); s += __shfl_xor(s, 16); s += xor32h(s, lane >> 5);
                const float mean = s * (1.f / D);
                float s2 = 0.f;
#pragma unroll
                for (int i = 0; i < 64; i += 4) { const float d0 = r[i] - mean, d1 = r[i + 1] - mean, d2 = r[i + 2] - mean, d3 = r[i + 3] - mean; s2 += (d0 * d0 + d1 * d1) + (d2 * d2 + d3 * d3); }
                s2 += row_ror4(s2); s2 += row_ror8(s2); s2 += __shfl_xor(s2, 16); s2 += xor32h(s2, lane >> 5);
                const float rstd = 1.f / sqrtf(s2 * (1.f / D) + LN_EPS);
                f32x4 acc[4];
#pragma unroll
                for (int eg = 0; eg < 4; ++eg) acc[eg] = (f32x4){0.f, 0.f, 0.f, 0.f};
#pragma unroll
                for (int i = 0; i < 8; ++i) {
                    const LAS float* gp = gbl + 128 * i + 4 * cg;
                    const f32x4 ga = *(const LAS f32x4*)gp, gb_ = *(const LAS f32x4*)(gp + 64), ba = *(const LAS f32x4*)(gp + 1024), bb = *(const LAS f32x4*)(gp + 1088);
                    r[8 * i] = (r[8 * i] - mean) * rstd * ga.x + ba.x; r[8 * i + 1] = (r[8 * i + 1] - mean) * rstd * ga.y + ba.y;
                    r[8 * i + 2] = (r[8 * i + 2] - mean) * rstd * ga.z + ba.z; r[8 * i + 3] = (r[8 * i + 3] - mean) * rstd * ga.w + ba.w;
                    r[8 * i + 4] = (r[8 * i + 4] - mean) * rstd * gb_.x + bb.x; r[8 * i + 5] = (r[8 * i + 5] - mean) * rstd * gb_.y + bb.y;
                    r[8 * i + 6] = (r[8 * i + 6] - mean) * rstd * gb_.z + bb.z; r[8 * i + 7] = (r[8 * i + 7] - mean) * rstd * gb_.w + bb.w;
                    u32x4 w; w.x = pk2(r[8 * i], r[8 * i + 1]); w.y = pk2(r[8 * i + 2], r[8 * i + 3]); w.z = pk2(r[8 * i + 4], r[8 * i + 5]); w.w = pk2(r[8 * i + 6], r[8 * i + 7]);
                    *(u32x4*)(actb + (size_t)t * D + 8 * cg + 128 * i) = w;
                    if (i == 2 && q < 3) LN1_LOADX(q + 1)
#pragma unroll
                    for (int ep = 0; ep < 2; ++ep) {
                        f32x4 wa[2], wb[2];
#pragma unroll
                        for (int e2 = 0; e2 < 2; ++e2) { const LAS float* wp = rwf + (2 * ep + e2) * 4096 + i * 512 + lane * 4; wa[e2] = *(const LAS f32x4*)wp; wb[e2] = *(const LAS f32x4*)(wp + 256); }
#pragma unroll
                        for (int e8 = 0; e8 < 8; ++e8)
#pragma unroll
                            for (int e2 = 0; e2 < 2; ++e2) acc[2 * ep + e2] = __builtin_amdgcn_mfma_f32_4x4x1f32(e8 < 4 ? wa[e2][e8 & 3] : wb[e2][e8 & 3], r[8 * i + e8], acc[2 * ep + e2], 0, 0, 0);
                    }
                }
                float lgt[16], l16[16];
#pragma unroll
                for (int k = 0; k < 16; ++k) { float v = acc[k >> 2][k & 3]; v += row_ror4(v); v += row_ror8(v); lgt[k] = v; }
#pragma unroll
                for (int k = 0; k < 16; ++k) l16[k] = __shfl_xor(lgt[k], 16);
#pragma unroll
                for (int k = 0; k < 16; ++k) { float v = lgt[k] + l16[k]; v += xor32h(v, lane >> 5); lgt[k] = v; }
                if (cg == 0) {
                    float sc[16], gs[4]; int i1[4], i2[4];
#pragma unroll
                    for (int eg = 0; eg < 4; ++eg) { float bz[4];
#pragma unroll
                        for (int k = 0; k < 4; ++k) { sc[4 * eg + k] = 1.f / (1.f + __expf(-lgt[4 * eg + k])); bz[k] = sc[4 * eg + k] + a.in[IN_RB][4 * eg + k]; }
                        float m1 = bz[0]; int j1 = 0;
#pragma unroll
                        for (int k = 1; k < 4; ++k) if (bz[k] > m1) { m1 = bz[k]; j1 = k; }
                        float m2 = -1e30f; int j2 = -1;
#pragma unroll
                        for (int k = 0; k < 4; ++k) if (k != j1 && bz[k] > m2) { m2 = bz[k]; j2 = k; }
                        gs[eg] = m1 + m2; i1[eg] = j1; i2[eg] = j2; }
                    int bg = 0; float bgs = gs[0];
#pragma unroll
                    for (int eg = 1; eg < 4; ++eg) if (gs[eg] > bgs) { bgs = gs[eg]; bg = eg; }
                    int j1 = 0, j2 = 0;
#pragma unroll
                    for (int eg = 0; eg < 4; ++eg) { j1 = (bg == eg) ? i1[eg] : j1; j2 = (bg == eg) ? i2[eg] : j2; }
                    const int e0 = bg * 4 + j1, e1 = bg * 4 + j2;
                    float sg1 = 0.f, sg2 = 0.f;
#pragma unroll
                    for (int k = 0; k < 16; ++k) { sg1 = (k == e0) ? sc[k] : sg1; sg2 = (k == e1) ? sc[k] : sg2; }
                    const float inv = 1.f / (sg1 + sg2);
                    const int p0 = atomicAdd((int*)(lcnt + e0), 1), p1 = atomicAdd((int*)(lcnt + e1), 1);
                    le[lt * 2] = (unsigned)e0 | ((unsigned)p0 << 8); le[lt * 2 + 1] = (unsigned)e1 | ((unsigned)p1 << 8);
                    lg[lt * 2] = sg1 * inv; lg[lt * 2 + 1] = sg2 * inv;
                }
            }
#undef LN1_LOADX
#undef LN1_LOADY
            __syncthreads();
            if (tid < 16) gbase[tid] = (int)xb_add(gcount + tid * 64, (unsigned)lcnt[tid]);
            __syncthreads();
            if (tid < 256) {
                const int lt = tid >> 1, t = bid * 128 + lt;
                if (t < T) {
                    const unsigned w = le[tid]; const int e = w & 255, pos = gbase[e] + (int)(w >> 8);
                    ((unsigned*)(ws + WS_LIST))[e * 32768 + pos] = (unsigned)t;
                    u32x2 ti; ti.x = (unsigned)e | ((unsigned)pos << 4); ti.y = __builtin_bit_cast(unsigned, lg[tid]);
                    *(u32x2*)(ws + WS_TOKINFO + (size_t)(t * 2 + (tid & 1)) * 8) = ti;
                }
            }
        }
        GRID_BAR();

        MoeMeta mm; mm.tstart = (LAS int*)(lds + MISC_OFF + 256); mm.cnt = mm.tstart + 32;
        if (tid_of(a.wv) == 0) { int acc = 0;
            for (int e = 0; e < 16; ++e) { const int c = (int)xb_ld(gcount + e * 64); mm.cnt[e] = c; mm.tstart[e] = acc; acc += (c + 255) >> 8; }
            mm.tstart[16] = acc; }
        __syncthreads();
        const int ntiles = mm.tstart[16];
#if DBG
        if (layer == DBG_LAYER) { dbg_check<layer>(a, lds, 1, mm); __syncthreads(); }
#endif
        {
            Moe1Sched S; S.A = (const char*)actb; S.Bt = (const char*)(ws + WS_WEXP1); S.K = D; S.lda = D * 2; S.kstepA = 128; S.mm = mm; S.ntiles = ntiles; S.G = G; S.c = bid;
            S.tab = (LAS unsigned*)(lds + AUX_OFF);
            const int tid = tid_of(a.wv);
            pg8::Unit u;
            for (int i = 0; i < 8 && S.next(i, u); ++i) {
                if (tid < 256) { const int pos = (u.pm - mm.tstart[u.e]) * 256 + tid;
                    const unsigned tok = (pos < mm.cnt[u.e]) ? ((const unsigned*)(ws + WS_LIST))[u.e * 32768 + pos] : 0u;
                    S.tab[i * 256 + tid] = tok * (unsigned)(D * 2); }
            }
            __syncthreads();
            pg8::EpiSwiglu E{(bf16_t*)(ws + WS_BIG + BIG_H)};
            pg8::gemm_phase(lds + STAGE_OFF, S, E, a.wv);
            if (layer + 1 < DEPTH) {
                const int rem = (2 * ntiles) % G;
                if (bid >= rem) { __syncthreads(); convert_layer_weights(a, layer + 1, lds, (bid - rem) * NWAVES + wave, (G - rem) * NWAVES, wave, tid & 63, 1); }
            }
        }
        GRID_BAR();
#if DBG
        if (layer == DBG_LAYER) { dbg_check<layer>(a, lds, 2, mm); __syncthreads(); }
#endif
        {
            Moe2Sched S; S.A = (const char*)(ws + WS_BIG + BIG_H); S.Bt = (const char*)(ws + WS_WEXP2); S.K = DEXP; S.lda = DEXP * 2; S.kstepA = 128; S.mm = mm; S.ntiles = ntiles; S.G = G; S.c = bid;
            pg8::EpiStore E{(bf16_t*)(ws + WS_BIG + BIG_YB), (size_t)D};
            pg8::gemm_phase(lds + STAGE_OFF, S, E, a.wv);
            if (layer + 1 < DEPTH) {
                const int rem = (4 * ntiles) % G;
                if (bid >= rem) { __syncthreads(); const int tid = tid_of(a.wv); convert_layer_weights(a, layer + 1, lds, (bid - rem) * NWAVES + wave, (G - rem) * NWAVES, wave, tid & 63, 2); }
            }
        }
        GRID_BAR();
#if DBG
        if (layer == DBG_LAYER) { dbg_check<layer>(a, lds, 3, mm); __syncthreads(); }
#endif
        {
            const int tid = tid_of(a.wv), lane = tid & 63;
            const float* g2 = a.in[IN_LN2G] + layer * D; const float* b2 = a.in[IN_LN2B] + layer * D;
            RowVec gv, bv;
#pragma unroll
            for (int j = 0; j < 4; ++j) { gv.v[j] = *(const f32x4*)(g2 + 4 * lane + 256 * j); bv.v[j] = *(const f32x4*)(b2 + 4 * lane + 256 * j); }
            const bf16_t* yb = (const bf16_t*)(ws + WS_BIG + BIG_YB);
            constexpr int NPF = 4;
            u32x4 tiN[NPF]; u32x2 px[NPF][4], py0[NPF][4], py1[NPF][4]; float cw0[NPF], cw1[NPF];
#define LN2_LOAD(S_, TR_) { const u32x4 ti_ = tiN[S_]; const int e0 = ti_.x & 15, p0 = ti_.x >> 4, e1 = ti_.z & 15, p1 = ti_.z >> 4; cw0[S_] = u2f(ti_.y); cw1[S_] = u2f(ti_.w); \
                const size_t s0 = (size_t)mm.tstart[e0] * 256 + p0, s1 = (size_t)mm.tstart[e1] * 256 + p1; \
                _Pragma("unroll") for (int j = 0; j < 4; ++j) { px[S_][j] = __builtin_nontemporal_load((const u32x2*)(actb + (size_t)(TR_) * D + 4 * lane + 256 * j)); \
                    py0[S_][j] = __builtin_nontemporal_load((const u32x2*)(yb + s0 * D + 4 * lane + 256 * j)); py1[S_][j] = __builtin_nontemporal_load((const u32x2*)(yb + s1 * D + 4 * lane + 256 * j)); } }
            static_assert(T % (NPF * 256 * NWAVES) == 0, "LN2 row grouping");
#pragma unroll
            for (int s = 0; s < NPF; ++s) tiN[s] = *(const u32x4*)(ws + WS_TOKINFO + (size_t)(gw + s * NGW) * 16);
#pragma unroll
            for (int s = 0; s < NPF; ++s) LN2_LOAD(s, gw + s * NGW)
            if (gw + NPF * NGW < T) {
#pragma unroll
                for (int s = 0; s < NPF; ++s) tiN[s] = *(const u32x4*)(ws + WS_TOKINFO + (size_t)(gw + (NPF + s) * NGW) * 16); }
            for (int tb = gw; tb < T; tb += NPF * NGW) {
#pragma unroll
                for (int s = 0; s < NPF; ++s) {
                    const int t = tb + s * NGW;
                    const float w0 = cw0[s], w1 = cw1[s];
                    RowVec r;
#pragma unroll
                    for (int j = 0; j < 4; ++j) {
                        const u32x2 xv = px[s][j], y0 = py0[s][j], y1 = py1[s][j];
                        r.v[j].x = ALPHA * bf_lo(xv.x) + w0 * bf_lo(y0.x) + w1 * bf_lo(y1.x);
                        r.v[j].y = ALPHA * bf_hi(xv.x) + w0 * bf_hi(y0.x) + w1 * bf_hi(y1.x);
                        r.v[j].z = ALPHA * bf_lo(xv.y) + w0 * bf_lo(y0.y) + w1 * bf_lo(y1.y);
                        r.v[j].w = ALPHA * bf_hi(xv.y) + w0 * bf_hi(y0.y) + w1 * bf_hi(y1.y);
                    }
                    if (t + NPF * NGW < T) { const int tn = t + NPF * NGW;
                        LN2_LOAD(s, tn)
                        if (tn + NPF * NGW < T) tiN[s] = *(const u32x4*)(ws + WS_TOKINFO + (size_t)(tn + NPF * NGW) * 16); }
                    float mean, rstd; ln_stats(r, mean, rstd);
#pragma unroll
                    for (int j = 0; j < 4; ++j) { r.v[j] = (r.v[j] - mean) * rstd * gv.v[j] + bv.v[j];
                        if (layer == DEPTH - 1) __builtin_nontemporal_store(r.v[j], (f32x4*)(xout + (size_t)t * D + 4 * lane + 256 * j));
                        else { u32x2 w; w.x = pk2(r.v[j].x, r.v[j].y); w.y = pk2(r.v[j].z, r.v[j].w);
                            *(u32x2*)(xres + (size_t)t * D + 4 * lane + 256 * j) = w; } }
                }
            }
#undef LN2_LOAD
            if (layer + 1 < DEPTH) convert_layer_weights(a, layer + 1, lds, gw, NGW, wave, lane, 4);
        }
        GRID_BAR();
#if DBG
        if (layer == DBG_LAYER) { dbg_check<layer>(a, lds, 4, mm); GRID_BAR(); }
#endif
}

__global__ void __launch_bounds__(NTHR, 2) fwd(Args a_in) {
    Args a = a_in; a.wv = __builtin_amdgcn_readfirstlane((int)(threadIdx.x >> 6));
    extern __shared__ __attribute__((aligned(16))) unsigned char lds_raw[];
    LAS unsigned char* lds = (LAS unsigned char*)lds_raw;
    volatile LAS unsigned* MISC = (volatile LAS unsigned*)(lds + MISC_OFF);
    const int tid = tid_of(a.wv), lane = tid & 63, wave = a.wv;
    const int G = gridDim.x, bid = blockIdx.x;
    const int gw = bid * NWAVES + wave, NGW = G * NWAVES;
    if (tid < 256) MISC[tid] = 0u;
    __syncthreads();
    unsigned* ctl = (unsigned*)(a.ws + WS_CTL);
    XcdBarrier bar = xcd_barrier_post(ctl + CW_BAR, MISC + 8); bar.wv = a.wv;
    if (PROBE_LO >= 0 && tid == 0) { const unsigned long long now = __builtin_amdgcn_s_memrealtime(); MISC[18] = (unsigned)now; MISC[19] = (unsigned)(now >> 32); }
    unsigned char* ws = a.ws;
    bf16_t* actb = (bf16_t*)(ws + WS_ACTB);
    float* xout = a.out;

    convert_layer_weights(a, 0, lds, gw, NGW, wave, lane);
    for (int i = bid * NTHR + tid; i < 16 * 2048; i += G * NTHR) { const int hd = i >> 11, n = i & 2047;
        int bk = n; if (n >= 16) { const float lf = logf((float)n / 16.f) / 4.852030263919617f; bk = 16 + (int)(lf * 16.f); bk = bk > 31 ? 31 : bk; }
        ((float*)(a.ws + WS_BIASG))[i] = a.in[IN_REL][bk * 16 + hd] * LOG2E; }
    for (int i = bid * NTHR + tid; i < 16384; i += G * NTHR) {
        const int e4 = i & 3, ln = (i >> 2) & 63, half = (i >> 8) & 1, ii = (i >> 9) & 7, eg = i >> 12;
        ((float*)(a.ws + WS_RW))[i] = a.in[IN_RW][(8 * ((ln >> 2) + 16 * ii) + 4 * half + e4) * 16 + 4 * eg + (ln & 3)]; }
    { const float* x = a.in[IN_X];
      constexpr size_t XS = (size_t)256 * NTHR * 4;
      static_assert(((size_t)T * D) % (XS * 8) == 0, "x conversion sweep");
      for (size_t i = ((size_t)bid * NTHR + tid) * 4; i < (size_t)T * D; i += XS * 8) {
          f32x4 v[8];
#pragma unroll
          for (int q = 0; q < 8; ++q) v[q] = __builtin_nontemporal_load((const f32x4*)(x + i + q * XS));
#pragma unroll
          for (int q = 0; q < 8; ++q) { u32x2 w; w.x = pk2(v[q].x, v[q].y); w.y = pk2(v[q].z, v[q].w);
              *(u32x2*)((bf16_t*)xout + i + q * XS) = w; } } }
    GRID_BAR();

    run_layer<0>(a, lds, bar);
#if DBG
    if (DBG_LAYER >= 1) run_layer<1>(a, lds, bar);
    if (DBG_LAYER >= 2) run_layer<2>(a, lds, bar);
    if (DBG_LAYER >= 3) run_layer<3>(a, lds, bar);
    dbg_final(a);
#else
    run_layer<1>(a, lds, bar);
    run_layer<2>(a, lds, bar);
    run_layer<3>(a, lds, bar);
#endif
    if (PROBE_LO >= 0) { __syncthreads(); const unsigned long long acc = (unsigned long long)MISC[20] | ((unsigned long long)MISC[21] << 32); const unsigned long long t0 = __builtin_amdgcn_s_memrealtime();
        while (__builtin_amdgcn_s_memrealtime() - t0 < acc * (unsigned long long)PROBE_MULT) __builtin_amdgcn_s_sleep(8); }
}

extern "C" void kernel_launch(void* const* d_in, const int* in_sizes, int n_in, void* d_out, int out_size, void* d_ws, size_t ws_size, hipStream_t stream) {
    static int grid = 0;
    if (grid == 0) {
        int dev = 0, cus = 0;
        if (n_in != 25 || out_size != T * D || ws_size < WS_END) { fprintf(stderr, "kernel_launch: unexpected shapes (n_in %d out %d ws %zu)\n", n_in, out_size, ws_size); grid = -1; return; }
        if (hipGetDevice(&dev) != hipSuccess || hipDeviceGetAttribute(&cus, hipDeviceAttributeMultiprocessorCount, dev) != hipSuccess) { grid = -1; return; }
        if (hipFuncSetAttribute((const void*)fwd, hipFuncAttributeMaxDynamicSharedMemorySize, LDS_BYTES) != hipSuccess) { grid = -1; return; }
        (void)hipGetLastError();
        grid = cus;
        if (grid != 256) { fprintf(stderr, "kernel_launch: built for 256 CUs, got %d\n", grid); grid = -1; return; }
    }
    if (grid < 0) return;
    (void)hipMemsetAsync(d_ws, 0, 1u << 20, stream);
    Args a{};
    for (int i = 0; i < 25; ++i) a.in[i] = (const float*)d_in[i];
    a.out = (float*)d_out; a.ws = (unsigned char*)d_ws;
    hipLaunchKernelGGL(fwd, dim3(grid), dim3(NTHR), LDS_BYTES, stream, a);
}
```
